# Optimizing an MI355X kernel written in HIP

```python
import jax, jax.numpy as jnp
from jax import lax
import numpy as np

D_MODEL = 1024
BATCH = 4
SEQ = 4096
DEPTH = 2

GRID_W = 64
CTX_LEN = 256
N_MIXERS = 2
N_HEADS = 16
HEAD_DIM = D_MODEL // N_HEADS
WIN_ROWS = 8
WIN_COLS = 16
FOURIER_GROUPS = 4
GROUP_DIM = D_MODEL // FOURIER_GROUPS
D_FF = 4 * D_MODEL
N_ATTN_LAYERS = (DEPTH + 1) // 2
N_FOURIER_LAYERS = DEPTH // 2
EPS = 1e-6

kernel_name = "hybrid_natten_fnet_dit_block"


def _rmsnorm(x, g):
    x32 = x.astype(jnp.float32)
    y = x32 * lax.rsqrt(jnp.mean(x32 * x32, axis=-1, keepdims=True) + EPS)
    return (y * g.astype(jnp.float32)).astype(x.dtype)


def _modulate(h, shift, scale):
    return h * (1 + scale) + shift


def _squared_relu_mlp(h, w1, w2):
    return jnp.square(jax.nn.relu(h @ w1)) @ w2


def _fourier_mix(h, w):
    b, n, d = h.shape
    hg = h.astype(jnp.float32).reshape(b, n, FOURIER_GROUPS, GROUP_DIM)
    f = jnp.fft.fft2(hg, axes=(1, 3), norm="ortho").real
    return f.reshape(b, n, d).astype(h.dtype) @ w


def _neighbourhood_attention(h, hc, wqkv, wo, gq, gk, rpb, ctx_out):
    b, n, d = h.shape
    rows = n // GRID_W
    kh = min(WIN_ROWS, rows)
    scale = HEAD_DIM ** -0.5

    def proj(t):
        qkv = (t @ wqkv).reshape(t.shape[0], t.shape[1], 3, N_HEADS, HEAD_DIM)
        return _rmsnorm(qkv[:, :, 0], gq), _rmsnorm(qkv[:, :, 1], gk), qkv[:, :, 2]

    q, k, v = proj(h)
    qc, kc, vc = proj(hc)
    q_grid = q.reshape(b, rows, GRID_W, N_HEADS, HEAD_DIM)

    cols = jnp.arange(GRID_W)
    col_start = jnp.clip(cols - WIN_COLS // 2, 0, GRID_W - WIN_COLS)
    col_ok = (cols[None, :] >= col_start[:, None]) & (cols[None, :] < col_start[:, None] + WIN_COLS)
    dc_idx = jnp.clip(cols[None, :] - cols[:, None] + WIN_COLS - 1, 0, 2 * WIN_COLS - 2)

    def row_block(r):
        rs = jnp.clip(r - kh // 2, 0, rows - kh)
        k_win = lax.dynamic_slice_in_dim(k, rs * GRID_W, kh * GRID_W, axis=1).reshape(b, kh, GRID_W, N_HEADS, HEAD_DIM)
        v_win = lax.dynamic_slice_in_dim(v, rs * GRID_W, kh * GRID_W, axis=1).reshape(b, kh, GRID_W, N_HEADS, HEAD_DIM)
        q_r = lax.dynamic_index_in_dim(q_grid, r, axis=1, keepdims=False)
        dr = rs + jnp.arange(kh) - r
        bias = jnp.take(jnp.take(rpb, dr + WIN_ROWS - 1, axis=1), dc_idx, axis=2)
        bias = jnp.transpose(bias, (0, 2, 1, 3)).astype(jnp.float32)
        s_lat = jnp.einsum('bqhd,bikhd->bhqik', q_r, k_win).astype(jnp.float32) * scale + bias
        s_lat = jnp.where(col_ok[:, None, :], s_lat, -jnp.inf)
        s_ctx = jnp.einsum('bqhd,bkhd->bhqk', q_r, kc).astype(jnp.float32) * scale
        s = jnp.concatenate([s_lat.reshape(b, N_HEADS, GRID_W, kh * GRID_W), s_ctx], axis=-1)
        p = jax.nn.softmax(s, axis=-1).astype(v.dtype)
        p_lat = p[..., :kh * GRID_W].reshape(b, N_HEADS, GRID_W, kh, GRID_W)
        p_ctx = p[..., kh * GRID_W:]
        return (jnp.einsum('bhqik,bikhd->bqhd', p_lat, v_win)
                + jnp.einsum('bhqk,bkhd->bqhd', p_ctx, vc))

    o = lax.map(row_block, jnp.arange(rows))
    y = jnp.moveaxis(o, 0, 1).reshape(b, n, d) @ wo
    if not ctx_out:
        return y, None
    s_cc = jnp.einsum('bqhd,bkhd->bhqk', qc, kc).astype(jnp.float32) * scale
    p_cc = jax.nn.softmax(s_cc, axis=-1).astype(vc.dtype)
    oc = jnp.einsum('bhqk,bkhd->bqhd', p_cc, vc).reshape(hc.shape[0], hc.shape[1], d)
    return y, oc @ wo


def setup_inputs(seed: int = 0) -> dict:
    key = jax.random.key(seed)
    ks = jax.random.split(key, 15)
    nrm = jax.random.normal
    return {
        "x": nrm(ks[0], (BATCH, SEQ, D_MODEL), jnp.float32),
        "c": nrm(ks[1], (BATCH, D_MODEL), jnp.float32),
        "ctx": nrm(ks[2], (BATCH, CTX_LEN, D_MODEL), jnp.float32),
        "c_ctx": nrm(ks[3], (D_MODEL,), jnp.float32),
        "ada_w": nrm(ks[4], (DEPTH, D_MODEL, 6 * D_MODEL), jnp.float32) * D_MODEL ** -0.5,
        "ada_b": 0.02 * nrm(ks[5], (DEPTH, 6 * D_MODEL), jnp.float32),
        "norm_g": 1.0 + 0.05 * nrm(ks[6], (DEPTH, 2, D_MODEL), jnp.float32),
        "attn_wqkv": nrm(ks[7], (N_ATTN_LAYERS, D_MODEL, 3 * D_MODEL), jnp.float32) * D_MODEL ** -0.5,
        "attn_wo": nrm(ks[8], (N_ATTN_LAYERS, D_MODEL, D_MODEL), jnp.float32) * D_MODEL ** -0.5,
        "q_norm_g": 1.0 + 0.05 * nrm(ks[9], (N_ATTN_LAYERS, HEAD_DIM), jnp.float32),
        "k_norm_g": 1.0 + 0.05 * nrm(ks[10], (N_ATTN_LAYERS, HEAD_DIM), jnp.float32),
        "rpb": 0.1 * nrm(ks[11], (N_ATTN_LAYERS, N_HEADS, 2 * WIN_ROWS - 1, 2 * WIN_COLS - 1), jnp.float32),
        "fourier_w": nrm(ks[12], (N_FOURIER_LAYERS, D_MODEL, D_MODEL), jnp.float32) * D_MODEL ** -0.5,
        "mlp_w1": nrm(ks[13], (DEPTH, D_MODEL, D_FF), jnp.float32) * D_MODEL ** -0.5,
        "mlp_w2": nrm(ks[14], (DEPTH, D_FF, D_MODEL), jnp.float32) * D_FF ** -0.5,
    }


def reference(x, c, ctx, c_ctx, ada_w, ada_b, norm_g, attn_wqkv, attn_wo, q_norm_g, k_norm_g, rpb,
              fourier_w, mlp_w1, mlp_w2):
    for layer in range(DEPTH):
        is_attn = layer % N_MIXERS == 0
        idx = layer // N_MIXERS
        need_ctx = layer < DEPTH - 1
        uses_ctx = need_ctx or is_attn

        mods = jnp.split(jax.nn.silu(c) @ ada_w[layer] + ada_b[layer], 6, axis=-1)
        sh1, sc1, g1, sh2, sc2, g2 = [m[:, None, :] for m in mods]
        h = _modulate(_rmsnorm(x, norm_g[layer, 0]), sh1, sc1)
        if uses_ctx:
            csh1, csc1, cg1, csh2, csc2, cg2 = jnp.split(
                jax.nn.silu(c_ctx) @ ada_w[layer] + ada_b[layer], 6, axis=-1)
            hc = _modulate(_rmsnorm(ctx, norm_g[layer, 0]), csh1, csc1)

        if is_attn:
            y, yc = _neighbourhood_attention(h, hc, attn_wqkv[idx], attn_wo[idx], q_norm_g[idx],
                                             k_norm_g[idx], rpb[idx], need_ctx)
        else:
            y = _fourier_mix(h, fourier_w[idx])
            yc = _fourier_mix(hc, fourier_w[idx]) if need_ctx else None

        x = x + g1 * y
        x = x + g2 * _squared_relu_mlp(_modulate(_rmsnorm(x, norm_g[layer, 1]), sh2, sc2),
                                       mlp_w1[layer], mlp_w2[layer])
        if need_ctx:
            ctx = ctx + cg1 * yc
            ctx = ctx + cg2 * _squared_relu_mlp(_modulate(_rmsnorm(ctx, norm_g[layer, 1]), csh2, csc2),
                                               mlp_w1[layer], mlp_w2[layer])
    return x
```

```cpp
#include <hip/hip_runtime.h>
#include <hip/hip_cooperative_groups.h>
#include <cstdio>
#include <cstdint>
namespace cg = cooperative_groups;

#define LAS __attribute__((address_space(3)))
typedef unsigned short bf16_t;
typedef short bf16x8 __attribute__((ext_vector_type(8)));
typedef short s16x4 __attribute__((ext_vector_type(4)));
typedef float f32x4 __attribute__((ext_vector_type(4)));
typedef unsigned u32x4 __attribute__((ext_vector_type(4)));
typedef unsigned u32x2 __attribute__((ext_vector_type(2)));

constexpr int DM = 1024, NB = 4, SEQ = 4096, CTXL = 256, FF = 4096;
constexpr int ML = NB * SEQ;
constexpr int MT = ML + NB * CTXL;
constexpr float LOG2E = 1.4426950408889634f;
constexpr float EPS = 1e-6f;

constexpr size_t MiB = 1u << 20;
constexpr size_t WS_MODS = 0;
constexpr size_t WS_SB = 512 * 1024;
constexpr size_t WS_CS = 2 * MiB;
constexpr size_t WS_D = 2 * MiB + 512 * 1024;
constexpr size_t WS_E = 3 * MiB;
constexpr size_t WS_WQK = 4 * MiB, WS_WV = 8 * MiB, WS_WO = 10 * MiB, WS_FW = 12 * MiB;
constexpr size_t WS_W1 = 14 * MiB;
constexpr size_t WS_W2 = 30 * MiB;
constexpr size_t WS_H = 48 * MiB;
constexpr size_t WS_R = 82 * MiB;
constexpr size_t WS_QK = WS_R;
constexpr size_t WS_VT = WS_R + 68 * MiB;
constexpr size_t WS_O = WS_R + 102 * MiB;
constexpr size_t WS_HMID = WS_R;
constexpr size_t WS_Z0 = WS_R;
constexpr size_t WS_Z1 = WS_R + 64 * MiB;
constexpr size_t WS_F = WS_R + 128 * MiB;
constexpr size_t WS_END = 256 * MiB;
static_assert(WS_F + 32 * MiB <= WS_END && WS_HMID + 128 * MiB <= WS_END && WS_O + 32 * MiB <= WS_END, "ws map");

constexpr int LDS_BYTES = 147456;

typedef __bf16 bf16v2_t __attribute__((ext_vector_type(2)));
typedef float f32v2_t __attribute__((ext_vector_type(2)));
__device__ __forceinline__ unsigned cvt_pk_bf16(float lo, float hi) { const f32v2_t v = {lo, hi}; const bf16v2_t r = __builtin_convertvector(v, bf16v2_t); return __builtin_bit_cast(unsigned, r); }
__device__ __forceinline__ f32x4 mfma16(bf16x8 a, bf16x8 b, f32x4 c) { return __builtin_amdgcn_mfma_f32_16x16x32_bf16(a, b, c, 0, 0, 0); }

namespace pg8 {
constexpr int BM = 256, BK = 64, HALF = 128, HTB = HALF * BK * 2, STAGE_BYTES = 8 * HTB;
__device__ __forceinline__ int lds_byte(int r, int c) { const int st = (r >> 4) * 2 + (c >> 5), rr = r & 15, cc = c & 31, ob = rr * 64 + cc * 2; return st * 1024 + (ob ^ (((ob >> 9) & 1) << 5)); }
__device__ __forceinline__ void stage_rc(int b, int& R, int& C) { const int st = b / 1024, sb = b % 1024, swz = sb ^ (((sb >> 9) & 1) << 5); R = (st >> 1) * 16 + swz / 64; C = (st & 1) * 32 + (swz % 64) / 2; }
__device__ __forceinline__ int perm32(int rho) { const int n = rho >> 4, i = rho & 15; return 8 * (i >> 2) + 4 * n + (i & 3); }

struct Unit { int pm, pn, kind, aux; const char* a; const char* b; };

template <class Epi, class Sched, bool BMAP>
__device__ __forceinline__ void gemm_phase(LAS unsigned char* lds, const int K, const int lda, const int ldb, const Sched& S, const Epi& E) {
    int tid = threadIdx.x; asm volatile("" : "+v"(tid));
    const int wid = __builtin_amdgcn_readfirstlane(tid >> 6), lane = tid & 63, wr = wid >> 2, wc = wid & 3, fr = lane & 15, fq = lane >> 4;
    int nt = K / BK; asm volatile("" : "+s"(nt));
    unsigned voffA[2], voffB[2];
#pragma unroll
    for (int i = 0; i < 2; ++i) { int R, C; stage_rc(tid * 16 + i * 8192, R, C); const int Rb = (R & ~31) + perm32(R & 31);
        voffA[i] = (unsigned)(R * lda + C) * 2u;
        voffB[i] = BMAP ? (unsigned)((64 * (Rb & 63) + (Rb >> 6)) * ldb + C) * 2u : (unsigned)(Rb * ldb + C) * 2u; }
    const size_t kstep = (size_t)(BK * 2);
    const size_t hstepA = (size_t)HALF * lda * 2;
    const size_t hstepB = BMAP ? (size_t)2 * ldb * 2 : (size_t)HALF * ldb * 2;
    const unsigned ldsw = (unsigned)wid * 1024u;
    const int aoff = lds_byte(wr * 64 + fr, fq * 8), boff = lds_byte(wc * 32 + fr, fq * 8);
#define PG8_SA(b, h) (((b) * 2 + (h)) * HTB)
#define PG8_SB(b, h) ((4 + (b) * 2 + (h)) * HTB)
#define PG8_STAGE(bufoff, gbase, voff) do { _Pragma("unroll") for (int _i = 0; _i < 2; ++_i) \
        __builtin_amdgcn_global_load_lds((const unsigned*)((const char*)(gbase) + (voff)[_i]), (LAS unsigned*)(lds + (bufoff) + ldsw + _i * 8192), 16, 0, 0); } while (0)
#define PG8_LDA(dst, b, h) do { _Pragma("unroll") for (int m = 0; m < 4; ++m) _Pragma("unroll") for (int k = 0; k < 2; ++k) dst[m][k] = *(const LAS bf16x8*)(lds + PG8_SA(b, h) + aoff + m * 2048 + k * 1024); } while (0)
#define PG8_LDB(dst, b, h) do { _Pragma("unroll") for (int n = 0; n < 2; ++n) _Pragma("unroll") for (int k = 0; k < 2; ++k) dst[n][k] = *(const LAS bf16x8*)(lds + PG8_SB(b, h) + boff + n * 2048 + k * 1024); } while (0)
#define PG8_MMA(ai, bj, At, Bt) do { __builtin_amdgcn_s_setprio(1); _Pragma("unroll") for (int m = 0; m < 4; ++m) _Pragma("unroll") for (int n = 0; n < 2; ++n) _Pragma("unroll") for (int k = 0; k < 2; ++k) \
        acc[ai][bj][m][n] = __builtin_amdgcn_mfma_f32_16x16x32_bf16(Bt[n][k], At[m][k], acc[ai][bj][m][n], 0, 0, 0); __builtin_amdgcn_s_setprio(0); } while (0)
#define PG8_WAIT_V(n) asm volatile("s_waitcnt vmcnt(" #n ")" ::: "memory")
#define PG8_WAIT_L(n) asm volatile("s_waitcnt lgkmcnt(" #n ")" ::: "memory")
#define PG8_BAR __builtin_amdgcn_s_barrier()
#define PG8_SCHED __builtin_amdgcn_sched_barrier(0)
    Unit cur, nxt; int ui = 0;
    if (!S.next(0, cur)) return;
    f32x4 acc[2][2][4][2];
#pragma unroll
    for (int a = 0; a < 2; ++a)
#pragma unroll
        for (int b = 0; b < 2; ++b)
#pragma unroll
            for (int m = 0; m < 4; ++m)
#pragma unroll
                for (int n = 0; n < 2; ++n) acc[a][b][m][n] = (f32x4){0.f, 0.f, 0.f, 0.f};
    bf16x8 At[4][2], B0[2][2], B1[2][2];
    const char* cA = cur.a; const char* cB = cur.b;
    PG8_STAGE(PG8_SB(0, 0), cB, voffB); PG8_STAGE(PG8_SB(0, 1), cB + hstepB, voffB); PG8_STAGE(PG8_SA(0, 0), cA, voffA); PG8_STAGE(PG8_SA(0, 1), cA + hstepA, voffA);
    if (wr == 1) PG8_BAR;
    PG8_WAIT_V(2); PG8_BAR;
    PG8_STAGE(PG8_SB(1, 0), cB + kstep, voffB); PG8_STAGE(PG8_SA(1, 0), cA + kstep, voffA); PG8_STAGE(PG8_SB(1, 1), cB + hstepB + kstep, voffB);
    PG8_WAIT_V(6); PG8_BAR;
    for (;;) {
        const bool has_next = S.next(ui + 1, nxt);
        const char* nA = has_next ? nxt.a : cA; const char* nB = has_next ? nxt.b : cB;
        for (int t = 0; t < nt; t += 2) {
            const bool last = (t == nt - 2);
            const char* a1 = cA + (size_t)(t + 1) * kstep;
            const char* a2 = last ? nA : cA + (size_t)(t + 2) * kstep; const char* b2 = last ? nB : cB + (size_t)(t + 2) * kstep;
            const char* a3 = a2 + kstep; const char* b3 = b2 + kstep;
            PG8_LDB(B0, 0, 0); PG8_LDB(B1, 0, 1); PG8_SCHED; PG8_LDA(At, 0, 0); PG8_STAGE(PG8_SA(1, 1), a1 + hstepA, voffA);
            PG8_WAIT_V(8); PG8_WAIT_L(0); PG8_BAR; PG8_MMA(0, 0, At, B0); PG8_MMA(0, 1, At, B1); PG8_BAR; PG8_SCHED;
            PG8_LDA(At, 0, 1); PG8_STAGE(PG8_SB(0, 0), b2, voffB); PG8_STAGE(PG8_SB(0, 1), b2 + hstepB, voffB); PG8_STAGE(PG8_SA(0, 0), a2, voffA);
            PG8_WAIT_V(8); PG8_WAIT_L(0); PG8_BAR; PG8_MMA(1, 0, At, B0); PG8_MMA(1, 1, At, B1); PG8_BAR; PG8_SCHED;
            PG8_LDB(B0, 1, 0); PG8_LDB(B1, 1, 1); PG8_SCHED; PG8_LDA(At, 1, 0); PG8_STAGE(PG8_SA(0, 1), a2 + hstepA, voffA);
            PG8_WAIT_V(8); PG8_WAIT_L(0); PG8_BAR; PG8_MMA(0, 0, At, B0); PG8_MMA(0, 1, At, B1); PG8_BAR; PG8_SCHED;
            PG8_LDA(At, 1, 1); PG8_STAGE(PG8_SB(1, 0), b3, voffB); PG8_STAGE(PG8_SB(1, 1), b3 + hstepB, voffB); PG8_STAGE(PG8_SA(1, 0), a3, voffA);
            PG8_WAIT_V(8); PG8_WAIT_L(0); PG8_BAR; PG8_MMA(1, 0, At, B0); PG8_MMA(1, 1, At, B1); PG8_BAR; PG8_SCHED;
        }
        if (wr == 0) PG8_BAR;
        E(acc, cur, wr, wc, fr, fq);
        if (!has_next) break;
#pragma unroll
        for (int a = 0; a < 2; ++a)
#pragma unroll
            for (int b = 0; b < 2; ++b)
#pragma unroll
                for (int m = 0; m < 4; ++m)
#pragma unroll
                    for (int n = 0; n < 2; ++n) acc[a][b][m][n] = (f32x4){0.f, 0.f, 0.f, 0.f};
        cur = nxt; cA = nA; cB = nB; ++ui;
        if (wr == 1) PG8_BAR;
    }
    PG8_WAIT_V(0);
    PG8_BAR;
#undef PG8_SA
#undef PG8_SB
#undef PG8_STAGE
#undef PG8_LDA
#undef PG8_LDB
#undef PG8_MMA
#undef PG8_WAIT_V
#undef PG8_WAIT_L
#undef PG8_BAR
#undef PG8_SCHED
}

struct SchedStd {
    const char* A; const char* Bt; size_t tsA, tsB; int nM, nN, nwg, G, c;
    __device__ void init(const void* A_, const void* Bt_, int M, int N, int lda, int ldb, int G_, int c_) { A = (const char*)A_; Bt = (const char*)Bt_; tsA = (size_t)BM * lda * 2; tsB = (size_t)BM * ldb * 2; nM = M / BM; nN = N / BM; nwg = nM * nN; G = G_; c = c_; }
    __device__ bool next(int i, Unit& u) const {
        const long L = (long)i * G + c; if (L >= nwg) return false;
        int wgid = (int)L; { const int q = nwg / 8, r = nwg % 8, xcd = wgid % 8, off = wgid / 8; wgid = (xcd < r ? xcd * (q + 1) : r * (q + 1) + (xcd - r) * q) + off; }
        const int nig = 8 * nN, gid = wgid / nig, fm = gid * 8, gsz = (nM - fm) < 8 ? (nM - fm) : 8;
        u.pm = fm + ((wgid % nig) % gsz); u.pn = (wgid % nig) / gsz; u.kind = 0; u.aux = 0;
        u.a = A + (size_t)u.pm * tsA; u.b = Bt + (size_t)u.pn * tsB; return true;
    }
};
struct SchedQKV {
    const char* H; const char* Wqk; const char* Wv; int G, c;
    __device__ bool next(int i, Unit& u) const {
        const long Ll = (long)i * G + c; if (Ll >= 800) return false;
        const int L = (int)Ll; const size_t ts = (size_t)BM * 1024 * 2; u.aux = 0;
        if (L < 512) { const int x = L & 7, off = L >> 3; u.kind = 0; u.pm = 8 * x + (off & 7); u.pn = off >> 3; }
        else if (L < 768) { const int l2 = L - 512, x = l2 & 7, off = l2 >> 3; u.kind = 1; u.pm = off & 3; u.pn = 8 * x + (off >> 2); }
        else if (L < 784) { const int l2 = L - 768; u.kind = 0; u.pm = 64 + (l2 & 3); u.pn = 4 + (l2 >> 2); }
        else { const int l2 = L - 784; u.kind = 1; u.pm = l2 & 3; u.pn = 64 + (l2 >> 2); }
        if (u.kind == 0) { u.a = H + (size_t)u.pm * ts; u.b = Wqk + (size_t)u.pn * ts; }
        else { u.a = Wv + (size_t)u.pm * ts; u.b = H + (size_t)u.pn * ts; }
        return true;
    }
};
struct SchedF1 {
    const char* CS; const char* H; int G, c;
    __device__ bool next(int i, Unit& u) const {
        const long Ll = (long)i * G + c; if (Ll >= 512) return false;
        const int L = (int)Ll; const int t = L & 15, b = (L >> 4) & 3, g = (L >> 6) & 3, ri = L >> 8;
        u.pm = ri; u.pn = t; u.kind = g; u.aux = b;
        u.a = CS + (size_t)ri * 256 * 256 * 2; u.b = H + ((size_t)(b * 4096 + 4 * t) * 1024 + g * 256) * 2; return true;
    }
};

typedef f32x4 Acc[2][2][4][2];
__device__ __forceinline__ u32x4 pack8(f32x4 v0, f32x4 v1) { u32x4 w; w.x = cvt_pk_bf16(v0[0], v0[1]); w.y = cvt_pk_bf16(v0[2], v0[3]); w.z = cvt_pk_bf16(v1[0], v1[1]); w.w = cvt_pk_bf16(v1[2], v1[3]); return w; }

struct EpiQKV { bf16_t* QK; bf16_t* VT; const float* gq; const float* gk;
    __device__ __forceinline__ void operator()(const Acc& acc, const Unit& u, int wr, int wc, int fr, int fq) const {
        if (u.kind == 0) {
            const bool isq = u.pn < 4; const float* gp = isq ? gq : gk; const float qs = isq ? 0.125f * LOG2E : 1.0f;
            f32x4 gv[2][2];
#pragma unroll
            for (int bj = 0; bj < 2; ++bj)
#pragma unroll
                for (int n = 0; n < 2; ++n) gv[bj][n] = *(const f32x4*)(gp + 32 * bj + 8 * fq + 4 * n) * qs;
#pragma unroll
            for (int ai = 0; ai < 2; ++ai)
#pragma unroll
                for (int m = 0; m < 4; ++m) {
                    const int row = u.pm * BM + ai * HALF + wr * 64 + m * 16 + fr;
                    float ss = 0.f;
#pragma unroll
                    for (int bj = 0; bj < 2; ++bj)
#pragma unroll
                        for (int n = 0; n < 2; ++n) { const f32x4 x = acc[ai][bj][m][n]; ss += (x[0] * x[0] + x[1] * x[1]) + (x[2] * x[2] + x[3] * x[3]); }
                    ss += __shfl_xor(ss, 16); ss += __shfl_xor(ss, 32);
                    const float rstd = rsqrtf(ss * (1.0f / 64.0f) + EPS);
                    bf16_t* rowp = QK + (size_t)row * 2048 + u.pn * 256 + wc * 64 + 8 * fq;
#pragma unroll
                    for (int bj = 0; bj < 2; ++bj) *(u32x4*)(rowp + 32 * bj) = pack8(acc[ai][bj][m][0] * rstd * gv[bj][0], acc[ai][bj][m][1] * rstd * gv[bj][1]);
                }
        } else {
#pragma unroll
            for (int ai = 0; ai < 2; ++ai)
#pragma unroll
                for (int m = 0; m < 4; ++m) {
                    const int row = u.pm * BM + ai * HALF + wr * 64 + m * 16 + fr;
                    bf16_t* rowp = VT + (size_t)row * MT + u.pn * 256 + wc * 32 + 8 * fq;
#pragma unroll
                    for (int bj = 0; bj < 2; ++bj) *(u32x4*)(rowp + bj * HALF) = pack8(acc[ai][bj][m][0], acc[ai][bj][m][1]);
                }
        }
    }
};
struct EpiRelu2 { bf16_t* O; int ldc;
    __device__ __forceinline__ void operator()(const Acc& acc, const Unit& u, int wr, int wc, int fr, int fq) const {
#pragma unroll
        for (int ai = 0; ai < 2; ++ai)
#pragma unroll
            for (int m = 0; m < 4; ++m) {
                const int row = u.pm * BM + ai * HALF + wr * 64 + m * 16 + fr;
                bf16_t* rowp = O + (size_t)row * ldc + u.pn * 256 + wc * 32 + 8 * fq;
#pragma unroll
                for (int bj = 0; bj < 2; ++bj) { f32x4 v0 = acc[ai][bj][m][0], v1 = acc[ai][bj][m][1];
#pragma unroll
                    for (int e = 0; e < 4; ++e) { const float a = fmaxf(v0[e], 0.f), b = fmaxf(v1[e], 0.f); v0[e] = a * a; v1[e] = b * b; }
                    *(u32x4*)(rowp + bj * HALF) = pack8(v0, v1); }
            }
    }
};
struct EpiRes { const float* base; float* out; const float* gate;
    __device__ __forceinline__ void operator()(const Acc& acc, const Unit& u, int wr, int wc, int fr, int fq) const {
        const int col0 = u.pn * 256 + wc * 32 + 8 * fq;
        const float* gp = gate + (size_t)(u.pm >> 4) * 6144 + col0;
        f32x4 gv[2][2];
#pragma unroll
        for (int bj = 0; bj < 2; ++bj)
#pragma unroll
            for (int n = 0; n < 2; ++n) gv[bj][n] = *(const f32x4*)(gp + bj * HALF + 4 * n);
#pragma unroll
        for (int ai = 0; ai < 2; ++ai)
#pragma unroll
            for (int m = 0; m < 4; ++m) {
                const size_t off = (size_t)(u.pm * BM + ai * HALF + wr * 64 + m * 16 + fr) * 1024 + col0;
#pragma unroll
                for (int bj = 0; bj < 2; ++bj)
#pragma unroll
                    for (int n = 0; n < 2; ++n) { const f32x4 bs = *(const f32x4*)(base + off + bj * HALF + 4 * n);
                        *(f32x4*)(out + off + bj * HALF + 4 * n) = bs + gv[bj][n] * acc[ai][bj][m][n]; }
            }
    }
};
struct EpiZ0 { bf16_t* Z0;
    __device__ __forceinline__ void operator()(const Acc& acc, const Unit& u, int wr, int wc, int fr, int fq) const {
        const int ri = u.pm, t = u.pn, g = u.kind, b = u.aux;
        bf16_t* p0 = Z0 + ((size_t)(((b * 4 + g) * 256 + wr * 64 + fr) * 64 + 4 * t + (wc >> 1))) * 128 + ri * 64 + 32 * (wc & 1) + 8 * fq;
#pragma unroll
        for (int ai = 0; ai < 2; ++ai)
#pragma unroll
            for (int m = 0; m < 4; ++m) {
#pragma unroll
                for (int bj = 0; bj < 2; ++bj)
                    *(u32x4*)(p0 + (size_t)(ai * HALF + m * 16) * 8192 + bj * 256) = pack8(acc[ai][bj][m][0], acc[ai][bj][m][1]);
                asm volatile("" ::: "memory");
            }
    }
};
}

__device__ __forceinline__ void p0_mods_unit(const float* c, const float* cctx, const float* ada_w, const float* ada_b, float* mods, LAS unsigned char* lds, int unit) {
    LAS float* s = (LAS float*)lds;
    LAS float* red = s + 5 * 1024;
    int tid = threadIdx.x; asm volatile("" : "+v"(tid));
    for (int i = tid; i < 5 * 1024; i += 512) { const int v = i >> 10, k = i & 1023; const float x = v < 4 ? c[v * 1024 + k] : cctx[k]; s[i] = x / (1.0f + __expf(-x)); }
    __syncthreads();
    const int l = unit / 96, col0 = (unit % 96) * 64, kc = tid >> 6, cl = tid & 63;
    const float* w = ada_w + (size_t)l * 1024 * 6144 + col0 + cl;
    float a0 = 0.f, a1 = 0.f, a2 = 0.f, a3 = 0.f, a4 = 0.f;
    for (int k = kc * 128; k < kc * 128 + 128; k += 8) {
        float wv[8];
#pragma unroll
        for (int j = 0; j < 8; ++j) wv[j] = w[(size_t)(k + j) * 6144];
#pragma unroll
        for (int j = 0; j < 8; ++j) { a0 += s[k + j] * wv[j]; a1 += s[1024 + k + j] * wv[j]; a2 += s[2048 + k + j] * wv[j]; a3 += s[3072 + k + j] * wv[j]; a4 += s[4096 + k + j] * wv[j]; }
    }
    red[(kc * 5 + 0) * 64 + cl] = a0; red[(kc * 5 + 1) * 64 + cl] = a1; red[(kc * 5 + 2) * 64 + cl] = a2; red[(kc * 5 + 3) * 64 + cl] = a3; red[(kc * 5 + 4) * 64 + cl] = a4;
    __syncthreads();
    if (tid < 320) { const int v = tid >> 6, cc = tid & 63; float t = 0.f;
#pragma unroll
        for (int kk = 0; kk < 8; ++kk) t += red[(kk * 5 + v) * 64 + cc];
        mods[(size_t)(l * 5 + v) * 6144 + col0 + cc] = t + ada_b[l * 6144 + col0 + cc]; }
    __syncthreads();
}

__device__ __forceinline__ void p0_transpose_item(const float* W, int K, int N, bf16_t* WT, bf16_t* WT2, int mode, LAS float* scr, int item, int lane) {
    const int nblk = N / 32, kb = item / nblk, nb = item % nblk, k0 = 64 * kb, n0 = 32 * nb;
#pragma unroll 8
    for (int i = 0; i < 32; ++i) { const int kk = 2 * i + (lane >> 5); scr[kk * 33 + (lane & 31)] = W[(size_t)(k0 + kk) * N + n0 + (lane & 31)]; }
    asm volatile("s_waitcnt lgkmcnt(0)" ::: "memory");
    const int cch = lane & 7;
#pragma unroll
    for (int j = 0; j < 4; ++j) { const int n = (lane >> 3) + 8 * j; const LAS float* s = scr + (8 * cch) * 33 + n;
        u32x4 o; o.x = cvt_pk_bf16(s[0 * 33], s[1 * 33]); o.y = cvt_pk_bf16(s[2 * 33], s[3 * 33]); o.z = cvt_pk_bf16(s[4 * 33], s[5 * 33]); o.w = cvt_pk_bf16(s[6 * 33], s[7 * 33]);
        const int ng = n0 + n; bf16_t* dst;
        if (mode == 0) dst = WT + (size_t)ng * K;
        else if (ng < 2048) { const int pn = ng >> 8, hh = (ng >> 6) & 3, d = ng & 63; const int tpos = (d >> 5) * 128 + hh * 32 + (d & 31); dst = WT + (size_t)(pn * 256 + tpos) * K; }
        else dst = WT2 + (size_t)(ng - 2048) * K;
        *(u32x4*)(dst + k0 + 8 * cch) = o; }
    asm volatile("s_waitcnt lgkmcnt(0)" ::: "memory");
}

__device__ __forceinline__ float wave_sum(float v) {
#pragma unroll
    for (int o = 1; o < 64; o <<= 1) v += __shfl_xor(v, o);
    return v;
}
__device__ __forceinline__ void norm_rows(const float* xlat, const float* xctx, int nrows, const float* g, const float* modsl, int sh_off, int sc_off, bf16_t* H, int gw, int NGW, int lane) {
    f32x4 gv[4];
#pragma unroll
    for (int j = 0; j < 4; ++j) gv[j] = *(const f32x4*)(g + lane * 4 + 256 * j);
    for (int row = gw; row < nrows; row += NGW) {
        const float* src = row < ML ? xlat + (size_t)row * 1024 : xctx + (size_t)(row - ML) * 1024;
        const int v = row < ML ? (row >> 12) : 4;
        const float* mp = modsl + (size_t)v * 6144;
        f32x4 x[4]; float ss = 0.f;
#pragma unroll
        for (int j = 0; j < 4; ++j) { x[j] = *(const f32x4*)(src + lane * 4 + 256 * j); ss += (x[j][0] * x[j][0] + x[j][1] * x[j][1]) + (x[j][2] * x[j][2] + x[j][3] * x[j][3]); }
        const float rstd = rsqrtf(wave_sum(ss) * (1.0f / 1024.0f) + EPS);
#pragma unroll
        for (int j = 0; j < 4; ++j) {
            const f32x4 sh = *(const f32x4*)(mp + sh_off + lane * 4 + 256 * j), sc = *(const f32x4*)(mp + sc_off + lane * 4 + 256 * j);
            const f32x4 y = (x[j] * rstd * gv[j]) * (sc + 1.0f) + sh;
            u32x2 w; w.x = cvt_pk_bf16(y[0], y[1]); w.y = cvt_pk_bf16(y[2], y[3]);
            *(u32x2*)(H + (size_t)row * 1024 + lane * 4 + 256 * j) = w;
        }
    }
}

__device__ __forceinline__ void attn_phase(const bf16_t* QK, const bf16_t* VT, bf16_t* O, const float* rpb, const float* sbound, LAS unsigned char* lds, int G, int c) {
    LAS float* rp = (LAS float*)lds;
    int tid = threadIdx.x; asm volatile("" : "+v"(tid));
    const int lane = tid & 63, wid = tid >> 6, fr = lane & 15, g = lane >> 4;
    for (int i = tid; i < 16 * 465; i += 512) rp[i] = rpb[i] * LOG2E;
    __syncthreads();
    const float Mb = *sbound;
    for (int it = 0;; ++it) {
        const long Ll = (long)it * G + c; if (Ll >= 2048) break;
        const int L = (int)Ll, x = L & 7, q = L >> 3, rpair = q & 31, bh = 8 * (q >> 5) + x, b = bh >> 4, h = bh & 15;
        const int r = 2 * rpair + (wid >> 2), j = wid & 3;
        const int w0 = (j == 0) ? 0 : (j == 1) ? 8 : (j == 2) ? 24 : 32;
        const int rs = min(max(r - 4, 0), 56);
        const int cq = 16 * j + fr, cs = min(max(cq - 8, 0), 48);
        const int qrow = b * 4096 + r * 64 + cq;
        bf16x8 Qf[2];
#pragma unroll
        for (int kk = 0; kk < 2; ++kk) Qf[kk] = *(const bf16x8*)(QK + (size_t)qrow * 2048 + h * 64 + 32 * kk + 8 * g);
        const int eX = w0 + 4 * g - cs;
        const int dX = w0 + 4 * g - cq + 15;
        f32x4 acc[4];
#pragma unroll
        for (int db = 0; db < 4; ++db) acc[db] = (f32x4){0.f, 0.f, 0.f, 0.f};
        float lsum = 0.f;
        bf16x8 KX[2], KY[2]; s16x4 VX[4], VY[4];
#define ATT_TOK(blk) ((blk) < 8 ? (b * 4096 + (rs + (blk)) * 64 + w0) : (ML + b * 256 + 32 * ((blk) - 8)))
#define ATT_LOAD(blk, kx, ky, vx, vy) do { const int tb_ = ATT_TOK(blk); const bf16_t* kp_ = QK + (size_t)(tb_ + fr) * 2048 + 1024 + h * 64 + 8 * g; \
        _Pragma("unroll") for (int kk = 0; kk < 2; ++kk) { kx[kk] = *(const bf16x8*)(kp_ + 32 * kk); ky[kk] = *(const bf16x8*)(kp_ + 16 * 2048 + 32 * kk); } \
        const bf16_t* vp_ = VT + (size_t)(h * 64 + fr) * MT + tb_ + 4 * g; \
        _Pragma("unroll") for (int db = 0; db < 4; ++db) { vx[db] = *(const s16x4*)(vp_ + (size_t)(16 * db) * MT); vy[db] = *(const s16x4*)(vp_ + (size_t)(16 * db) * MT + 16); } } while (0)
        ATT_LOAD(0, KX, KY, VX, VY);
#pragma unroll
        for (int blk = 0; blk < 16; ++blk) {
            bf16x8 nKX[2], nKY[2]; s16x4 nVX[4], nVY[4];
            if (blk + 1 < 16) ATT_LOAD(blk + 1, nKX, nKY, nVX, nVY);
            f32x4 sX = mfma16(KX[0], Qf[0], (f32x4){0.f, 0.f, 0.f, 0.f}); sX = mfma16(KX[1], Qf[1], sX);
            f32x4 sY = mfma16(KY[0], Qf[0], (f32x4){0.f, 0.f, 0.f, 0.f}); sY = mfma16(KY[1], Qf[1], sY);
            f32x4 pX, pY;
            if (blk < 8) {
                const int base = h * 465 + (rs + blk - r + 7) * 31;
#pragma unroll
                for (int ii = 0; ii < 4; ++ii) {
                    const int dcx = min(max(dX + ii, 0), 30), dcy = min(max(dX + 16 + ii, 0), 30);
                    const float bx = rp[base + dcx], by = rp[base + dcy];
                    const bool okx = (unsigned)(eX + ii) < 16u, oky = (unsigned)(eX + 16 + ii) < 16u;
                    pX[ii] = okx ? __builtin_amdgcn_exp2f(sX[ii] + bx - Mb) : 0.f;
                    pY[ii] = oky ? __builtin_amdgcn_exp2f(sY[ii] + by - Mb) : 0.f;
                }
            } else {
#pragma unroll
                for (int ii = 0; ii < 4; ++ii) { pX[ii] = __builtin_amdgcn_exp2f(sX[ii] - Mb); pY[ii] = __builtin_amdgcn_exp2f(sY[ii] - Mb); }
            }
            lsum += ((pX[0] + pX[1]) + (pX[2] + pX[3])) + ((pY[0] + pY[1]) + (pY[2] + pY[3]));
            const u32x4 pw = pg8::pack8(pX, pY);
            const bf16x8 Pf = __builtin_bit_cast(bf16x8, pw);
#pragma unroll
            for (int db = 0; db < 4; ++db) {
                bf16x8 Vf; Vf[0] = VX[db][0]; Vf[1] = VX[db][1]; Vf[2] = VX[db][2]; Vf[3] = VX[db][3]; Vf[4] = VY[db][0]; Vf[5] = VY[db][1]; Vf[6] = VY[db][2]; Vf[7] = VY[db][3];
                acc[db] = mfma16(Vf, Pf, acc[db]);
            }
            if (blk + 1 < 16) {
#pragma unroll
                for (int kk = 0; kk < 2; ++kk) { KX[kk] = nKX[kk]; KY[kk] = nKY[kk]; }
#pragma unroll
                for (int db = 0; db < 4; ++db) { VX[db] = nVX[db]; VY[db] = nVY[db]; }
            }
        }
#undef ATT_LOAD
#undef ATT_TOK
        lsum += __shfl_xor(lsum, 16); lsum += __shfl_xor(lsum, 32);
        const float inv = 1.0f / lsum;
        bf16_t* op = O + (size_t)qrow * 1024 + h * 64 + 4 * g;
#pragma unroll
        for (int db = 0; db < 4; ++db) { u32x2 w; w.x = cvt_pk_bf16(acc[db][0] * inv, acc[db][1] * inv); w.y = cvt_pk_bf16(acc[db][2] * inv, acc[db][3] * inv); *(u32x2*)(op + 16 * db) = w; }
    }
    __syncthreads();
}

__device__ __forceinline__ void s1_phase(const bf16_t* Z0, const bf16_t* Dg, bf16_t* Z1, LAS unsigned char* lds, int gw, int NGW) {
    constexpr int DP = 136;
    LAS bf16_t* Dl = (LAS bf16_t*)lds;
    int tid = threadIdx.x; asm volatile("" : "+v"(tid));
    const int lane = tid & 63, fr = lane & 15, g = lane >> 4;
    for (int i = tid; i < 128 * 16; i += 512) { const int row = i >> 4, ch = i & 15; *(LAS u32x4*)(Dl + row * DP + ch * 8) = *(const u32x4*)(Dg + row * 128 + ch * 8); }
    __syncthreads();
    for (int colM = gw; colM < 4096; colM += NGW) {
        bf16x8 A[4][4];
#pragma unroll
        for (int ib = 0; ib < 4; ++ib)
#pragma unroll
            for (int kb = 0; kb < 4; ++kb) A[ib][kb] = *(const bf16x8*)(Z0 + ((size_t)colM * 64 + 16 * ib + fr) * 128 + 32 * kb + 8 * g);
#pragma unroll 2
        for (int jb = 0; jb < 8; ++jb) {
            bf16x8 Bf[4];
#pragma unroll
            for (int kb = 0; kb < 4; ++kb) Bf[kb] = *(const LAS bf16x8*)(Dl + (16 * jb + fr) * DP + 32 * kb + 8 * g);
            const int n = 16 * jb + fr, ka = n >> 1, rip = n & 1;
#pragma unroll
            for (int ib = 0; ib < 4; ++ib) {
                f32x4 a = (f32x4){0.f, 0.f, 0.f, 0.f};
#pragma unroll
                for (int kb = 0; kb < 4; ++kb) a = mfma16(A[ib][kb], Bf[kb], a);
                u32x2 w; w.x = cvt_pk_bf16(a[0], a[1]); w.y = cvt_pk_bf16(a[2], a[3]);
                *(u32x2*)(Z1 + (((size_t)ka * 4096 + colM) * 2 + rip) * 64 + 16 * ib + 4 * g) = w;
            }
        }
    }
    __syncthreads();
}
__device__ __forceinline__ void s2_phase(const bf16_t* Z1, const bf16_t* Eg, bf16_t* F, int gw, int NGW, int lane) {
    const int fr = lane & 15, g = lane >> 4;
    for (int it = gw; it < 2048; it += NGW) {
        const int ka = it & 63, chunk = it >> 6;
        bf16x8 Bf[4][4];
#pragma unroll
        for (int jb = 0; jb < 4; ++jb)
#pragma unroll
            for (int kb = 0; kb < 4; ++kb) Bf[jb][kb] = *(const bf16x8*)(Eg + ((size_t)ka * 64 + 16 * jb + fr) * 128 + 32 * kb + 8 * g);
        for (int ib = 0; ib < 8; ++ib) {
            const int colM0 = chunk * 128 + ib * 16;
            bf16x8 A[4];
#pragma unroll
            for (int kb = 0; kb < 4; ++kb) A[kb] = *(const bf16x8*)(Z1 + ((size_t)ka * 4096 + colM0 + fr) * 128 + 32 * kb + 8 * g);
            const int cm = colM0 + 4 * g, b = cm >> 10, ch = cm & 1023;
#pragma unroll
            for (int jb = 0; jb < 4; ++jb) {
                f32x4 a = (f32x4){0.f, 0.f, 0.f, 0.f};
#pragma unroll
                for (int kb = 0; kb < 4; ++kb) a = mfma16(A[kb], Bf[jb][kb], a);
                const int kbk = 16 * jb + fr;
                u32x2 w; w.x = cvt_pk_bf16(a[0], a[1]); w.y = cvt_pk_bf16(a[2], a[3]);
                *(u32x2*)(F + ((size_t)b * 4096 + ka + 64 * kbk) * 1024 + ch) = w;
            }
        }
    }
}


#ifndef MK_DEBUG
#define MK_DEBUG 0
#endif
__device__ __forceinline__ void dbg_scan16(const bf16_t* p, size_t n, unsigned* flags, unsigned bit, int gt, int NT) {
    bool bad = false; for (size_t i = gt; i < n; i += NT) bad |= ((p[i] & 0x7f80u) == 0x7f80u);
    if (bad) atomicOr(flags, 1u << bit);
}
__device__ __forceinline__ void dbg_scan32(const float* p, size_t n, unsigned* flags, unsigned bit, int gt, int NT) {
    bool bad = false; for (size_t i = gt; i < n; i += NT) bad |= ((__float_as_uint(p[i]) & 0x7f800000u) == 0x7f800000u);
    if (bad) atomicOr(flags, 1u << bit);
}
struct Args { const float* in[15]; float* out; unsigned char* ws; int ph_lo, ph_hi; };
static_assert(sizeof(Args) == 15 * 8 + 8 + 8 + 8, "no padding");

__global__ void __launch_bounds__(512, 2) fwd_kernel(Args args) {
    extern __shared__ __attribute__((aligned(16))) unsigned char lds_raw[];
    LAS unsigned char* lds = (LAS unsigned char*)lds_raw;
    const int G = gridDim.x, c = blockIdx.x;
    const int vcu = (G % 8 == 0) ? (c % 8) * (G / 8) + c / 8 : c;
    const int NGW = G * 8;
#define PHASE_IDS int tid_ = threadIdx.x; asm volatile("" : "+v"(tid_)); const int lane = tid_ & 63, wid = __builtin_amdgcn_readfirstlane(tid_ >> 6); const int gw = vcu * 8 + wid; (void)lane; (void)gw
    unsigned char* ws = args.ws;
    const float* x = args.in[0]; const float* cvec = args.in[1]; const float* ctx = args.in[2]; const float* cctx = args.in[3];
    const float* ada_w = args.in[4]; const float* ada_b = args.in[5]; const float* norm_g = args.in[6];
    const float* wqkv = args.in[7]; const float* wo = args.in[8]; const float* gq = args.in[9]; const float* gk = args.in[10]; const float* rpb = args.in[11];
    const float* fw = args.in[12]; const float* w1 = args.in[13]; const float* w2 = args.in[14];
    float* out = args.out;
    float* mods = (float*)(ws + WS_MODS); float* sbound = (float*)(ws + WS_SB);
    bf16_t* CS = (bf16_t*)(ws + WS_CS); bf16_t* Dt = (bf16_t*)(ws + WS_D); bf16_t* Et = (bf16_t*)(ws + WS_E);
    bf16_t* WQK = (bf16_t*)(ws + WS_WQK); bf16_t* WV = (bf16_t*)(ws + WS_WV); bf16_t* WO = (bf16_t*)(ws + WS_WO); bf16_t* FWt = (bf16_t*)(ws + WS_FW);
    bf16_t* W1t = (bf16_t*)(ws + WS_W1); bf16_t* W2t = (bf16_t*)(ws + WS_W2);
    bf16_t* H = (bf16_t*)(ws + WS_H); bf16_t* QK = (bf16_t*)(ws + WS_QK); bf16_t* VT = (bf16_t*)(ws + WS_VT); bf16_t* O = (bf16_t*)(ws + WS_O);
    bf16_t* HMID = (bf16_t*)(ws + WS_HMID); bf16_t* Z0 = (bf16_t*)(ws + WS_Z0); bf16_t* Z1 = (bf16_t*)(ws + WS_Z1); bf16_t* Fb = (bf16_t*)(ws + WS_F);
    const int lo = args.ph_lo, hi = args.ph_hi;
    cg::grid_group grid = cg::this_grid();
#define IN(k) (lo <= (k) && (k) < hi)
#define SEAM(k) do { if (IN(k) && IN((k) + 1)) grid.sync(); } while (0)

    unsigned* dflags = (unsigned*)(ws + WS_SB + 256);
#define DBG16(k, bit, p, n) do { if (MK_DEBUG && IN(k)) { int t_ = threadIdx.x; asm volatile("" : "+v"(t_)); dbg_scan16(p, n, dflags, bit, (vcu * 512) + t_, G * 512); } } while (0)
#define DBG32(k, bit, p, n) do { if (MK_DEBUG && IN(k)) { int t_ = threadIdx.x; asm volatile("" : "+v"(t_)); dbg_scan32(p, n, dflags, bit, (vcu * 512) + t_, G * 512); } } while (0)
    if (IN(0)) {
        PHASE_IDS;
        if (MK_DEBUG && c == 0 && tid_ == 0) *dflags = 0u;
        for (int u = c; u < 192; u += G) p0_mods_unit(cvec, cctx, ada_w, ada_b, mods, lds, u);
        __syncthreads();
        {
            LAS float* scr = (LAS float*)(lds + wid * 16384);
            constexpr int I_QKV = 16 * 96, I_SQ = 16 * 32, I_1 = 16 * 128, I_2 = 64 * 32;
            constexpr int NITEMS = I_QKV + 2 * I_SQ + 2 * I_1 + 2 * I_2;
            for (int it = NITEMS - 1 - gw; it >= 0; it -= NGW) {
                int r = it;
                if (r < I_QKV) { p0_transpose_item(wqkv, 1024, 3072, WQK, WV, 1, scr, r, lane); continue; } r -= I_QKV;
                if (r < I_SQ) { p0_transpose_item(wo, 1024, 1024, WO, nullptr, 0, scr, r, lane); continue; } r -= I_SQ;
                if (r < I_SQ) { p0_transpose_item(fw, 1024, 1024, FWt, nullptr, 0, scr, r, lane); continue; } r -= I_SQ;
                if (r < 2 * I_1) { const int l = r / I_1; p0_transpose_item(w1 + (size_t)l * 1024 * 4096, 1024, 4096, W1t + (size_t)l * 4096 * 1024, nullptr, 0, scr, r % I_1, lane); continue; } r -= 2 * I_1;
                { const int l = r / I_2; p0_transpose_item(w2 + (size_t)l * 4096 * 1024, 4096, 1024, W2t + (size_t)l * 1024 * 4096, nullptr, 0, scr, r % I_2, lane); }
            }
        }
        {
            const int gt = gw * 64 + lane, NT = NGW * 64;
            for (int i = gt; i < 512 * 256; i += NT) { const int m = i >> 8, cc = i & 255, ri = m >> 8, k2 = m & 255; float sn, cs; sincospif(2.0f * (float)((cc * k2) & 255) / 256.0f, &sn, &cs);
                const float v = (ri == 0 ? cs : -sn) * (1.0f / 16.0f); CS[i] = (bf16_t)(cvt_pk_bf16(v, 0.f) & 0xffffu); }
            for (int i = gt; i < 128 * 128; i += NT) { const int n = i >> 7, kp = i & 127, ka = n >> 1, rip = n & 1, ri = kp >> 6, a = kp & 63; float sn, cs; sincospif(2.0f * (float)((a * ka) & 63) / 64.0f, &sn, &cs);
                const float v = (rip == 0 ? (ri == 0 ? cs : sn) : (ri == 0 ? -sn : cs)) * 0.125f; Dt[i] = (bf16_t)(cvt_pk_bf16(v, 0.f) & 0xffffu); }
            for (int i = gt; i < 64 * 64 * 128; i += NT) { const int kp = i & 127, kbk = (i >> 7) & 63, ka = i >> 13, rip = kp >> 6, bp = kp & 63; float sn, cs; sincospif(2.0f * (float)((bp * (ka + 64 * kbk)) & 4095) / 4096.0f, &sn, &cs);
                const float v = (rip == 0 ? cs : sn) * 0.125f; Et[i] = (bf16_t)(cvt_pk_bf16(v, 0.f) & 0xffffu); }
        }
        if (c == G - 1 && wid == 7) {
            float mq = fabsf(gq[lane]), mk = fabsf(gk[lane]), mr = 0.f;
            for (int i = lane; i < 16 * 465; i += 64) mr = fmaxf(mr, fabsf(rpb[i]));
#pragma unroll
            for (int o = 1; o < 64; o <<= 1) { mq = fmaxf(mq, __shfl_xor(mq, o)); mk = fmaxf(mk, __shfl_xor(mk, o)); mr = fmaxf(mr, __shfl_xor(mr, o)); }
            if (lane == 0) *sbound = (8.0f * mq * mk + mr) * LOG2E;
        }
    }
    SEAM(0);
    if (IN(1)) { PHASE_IDS; norm_rows(x, ctx, MT, norm_g, mods, 0, 1024, H, gw, NGW, lane); }
    SEAM(1);
    DBG16(2, 0, H, (size_t)MT * 1024);
    if (IN(2)) { pg8::SchedQKV S{(const char*)H, (const char*)WQK, (const char*)WV, G, c}; pg8::EpiQKV E{QK, VT, gq, gk};
        pg8::gemm_phase<pg8::EpiQKV, pg8::SchedQKV, false>(lds, 1024, 1024, 1024, S, E); }
    SEAM(2);
    DBG16(3, 1, QK, (size_t)ML * 2048); DBG16(3, 2, VT, (size_t)1024 * MT); DBG32(3, 13, mods, (size_t)10 * 6144);
    if (IN(3)) attn_phase(QK, VT, O, rpb, sbound, lds, G, c);
    SEAM(3);
    DBG16(4, 3, O, (size_t)ML * 1024);
    if (IN(4)) { pg8::SchedStd S; S.init(O, WO, ML, 1024, 1024, 1024, G, c); pg8::EpiRes E{x, out, mods + 2048};
        pg8::gemm_phase<pg8::EpiRes, pg8::SchedStd, false>(lds, 1024, 1024, 1024, S, E); }
    SEAM(4);
    DBG32(5, 4, out, (size_t)ML * 1024);
    if (IN(5)) { PHASE_IDS; norm_rows(out, out, ML, norm_g + 1024, mods, 3072, 4096, H, gw, NGW, lane); }
    SEAM(5);
    if (IN(6)) { pg8::SchedStd S; S.init(H, W1t, ML, 4096, 1024, 1024, G, c); pg8::EpiRelu2 E{HMID, 4096};
        pg8::gemm_phase<pg8::EpiRelu2, pg8::SchedStd, false>(lds, 1024, 1024, 1024, S, E); }
    SEAM(6);
    DBG16(7, 5, HMID, (size_t)ML * 4096);
    if (IN(7)) { pg8::SchedStd S; S.init(HMID, W2t, ML, 1024, 4096, 4096, G, c); pg8::EpiRes E{out, out, mods + 5120};
        pg8::gemm_phase<pg8::EpiRes, pg8::SchedStd, false>(lds, 4096, 4096, 4096, S, E); }
    SEAM(7);
    const float* mods1 = mods + 5 * 6144;
    DBG32(8, 6, out, (size_t)ML * 1024);
    if (IN(8)) { PHASE_IDS; norm_rows(out, out, ML, norm_g + 2048, mods1, 0, 1024, H, gw, NGW, lane); }
    SEAM(8);
    if (IN(9)) { pg8::SchedF1 S{(const char*)CS, (const char*)H, G, c}; pg8::EpiZ0 E{Z0};
        pg8::gemm_phase<pg8::EpiZ0, pg8::SchedF1, true>(lds, 256, 256, 1024, S, E); }
    SEAM(9);
    DBG16(10, 7, Z0, (size_t)262144 * 128);
    if (IN(10)) { PHASE_IDS; s1_phase(Z0, Dt, Z1, lds, gw, NGW); }
    SEAM(10);
    DBG16(11, 8, Z1, (size_t)262144 * 128);
    if (IN(11)) { PHASE_IDS; s2_phase(Z1, Et, Fb, gw, NGW, lane); }
    SEAM(11);
    DBG16(12, 9, Fb, (size_t)ML * 1024);
    if (IN(12)) { pg8::SchedStd S; S.init(Fb, FWt, ML, 1024, 1024, 1024, G, c); pg8::EpiRes E{out, out, mods1 + 2048};
        pg8::gemm_phase<pg8::EpiRes, pg8::SchedStd, false>(lds, 1024, 1024, 1024, S, E); }
    SEAM(12);
    DBG32(13, 10, out, (size_t)ML * 1024);
    if (IN(13)) { PHASE_IDS; norm_rows(out, out, ML, norm_g + 3072, mods1, 3072, 4096, H, gw, NGW, lane); }
    SEAM(13);
    if (IN(14)) { pg8::SchedStd S; S.init(H, W1t + (size_t)4096 * 1024, ML, 4096, 1024, 1024, G, c); pg8::EpiRelu2 E{HMID, 4096};
        pg8::gemm_phase<pg8::EpiRelu2, pg8::SchedStd, false>(lds, 1024, 1024, 1024, S, E); }
    SEAM(14);
    DBG16(15, 11, HMID, (size_t)ML * 4096);
    if (IN(15)) { pg8::SchedStd S; S.init(HMID, W2t + (size_t)1024 * 4096, ML, 1024, 4096, 4096, G, c); pg8::EpiRes E{out, out, mods1 + 5120};
        pg8::gemm_phase<pg8::EpiRes, pg8::SchedStd, false>(lds, 4096, 4096, 4096, S, E); }
    SEAM(15);
    if (MK_DEBUG && IN(16)) {
        int t_ = threadIdx.x; asm volatile("" : "+v"(t_));
        bool bad = false;
        for (size_t i = (size_t)vcu * 512 + t_; i < (size_t)ML * 1024; i += (size_t)G * 512) { if ((__float_as_uint(out[i]) & 0x7f800000u) == 0x7f800000u) { bad = true; out[i] = 0.f; } }
        if (bad) atomicOr(dflags, 1u << 12);
    }
    SEAM(16);
    if (MK_DEBUG && IN(17)) {
        if (c == 0 && threadIdx.x == 0) { const unsigned f = *dflags; if (f) out[0] = 1.0e6f * (float)(__builtin_ctz(f) + 1) + 1.0e4f * (float)__builtin_popcount(f); }
    }
#undef IN
#undef SEAM
}

constexpr int NPHASE = MK_DEBUG ? 18 : 16;
#ifndef MK_PER_PHASE
#define MK_PER_PHASE 0
#endif

extern "C" void kernel_launch(void* const* d_in, const int* in_sizes, int n_in, void* d_out, int out_size, void* d_ws, size_t ws_size, hipStream_t stream) {
    static int grid = 0;
    if (grid == 0) {
        if (n_in != 15 || out_size != ML * DM || ws_size < WS_END) { fprintf(stderr, "kernel_launch: unexpected shapes (n_in %d out %d ws %zu)\n", n_in, out_size, ws_size); grid = -1; return; }
        int dev = 0, cus = 0, per_cu = 0;
        hipGetDevice(&dev); hipDeviceGetAttribute(&cus, hipDeviceAttributeMultiprocessorCount, dev);
        hipFuncSetAttribute((const void*)fwd_kernel, hipFuncAttributeMaxDynamicSharedMemorySize, LDS_BYTES);
        if (hipOccupancyMaxActiveBlocksPerMultiprocessor(&per_cu, (const void*)fwd_kernel, 512, LDS_BYTES) != hipSuccess || per_cu < 1) { fprintf(stderr, "kernel_launch: occupancy query failed (%d)\n", per_cu); (void)hipGetLastError(); per_cu = 1; }
        grid = cus * 1;
        if (grid <= 0) grid = 256;
    }
    if (grid < 0) return;
    Args a{};
    for (int i = 0; i < 15; ++i) a.in[i] = (const float*)d_in[i];
    a.out = (float*)d_out; a.ws = (unsigned char*)d_ws;
#if MK_PER_PHASE
    for (int p = 0; p < NPHASE; ++p) { a.ph_lo = p; a.ph_hi = p + 1; hipLaunchKernelGGL(fwd_kernel, dim3(grid), dim3(512), LDS_BYTES, stream, a); }
#else
    a.ph_lo = 0; a.ph_hi = NPHASE;
    void* kargs[] = {&a};
    hipError_t e = hipLaunchCooperativeKernel((const void*)fwd_kernel, dim3(grid), dim3(512), kargs, LDS_BYTES, stream);
    if (e != hipSuccess) fprintf(stderr, "cooperative launch failed: %s (grid %d)\n", hipGetErrorString(e), grid);
#endif
}
```

```cpp
#include <hip/hip_runtime.h>
#include <hip/hip_cooperative_groups.h>
#include <cstdio>
#include <cstdint>
namespace cg = cooperative_groups;

#define LAS __attribute__((address_space(3)))
typedef unsigned short bf16_t;
typedef short bf16x8 __attribute__((ext_vector_type(8)));
typedef short s16x4 __attribute__((ext_vector_type(4)));
typedef float f32x4 __attribute__((ext_vector_type(4)));
typedef unsigned u32x4 __attribute__((ext_vector_type(4)));
typedef unsigned u32x2 __attribute__((ext_vector_type(2)));

constexpr int DM = 1024, NB = 4, SEQ = 4096, CTXL = 256, FF = 4096;
constexpr int ML = NB * SEQ;
constexpr int MT = ML + NB * CTXL;
constexpr float LOG2E = 1.4426950408889634f;
constexpr float EPS = 1e-6f;

constexpr size_t MiB = 1u << 20;
constexpr size_t WS_MODS = 0;
constexpr size_t WS_SB = 512 * 1024;
constexpr size_t WS_BAR = 1 * MiB;
constexpr size_t BAR_BYTES = 16384;
constexpr size_t WS_CS = 2 * MiB;
constexpr size_t WS_D = 2 * MiB + 512 * 1024;
constexpr size_t WS_E = 3 * MiB;
constexpr size_t WS_WQK = 4 * MiB, WS_WV = 8 * MiB, WS_WO = 10 * MiB, WS_FW = 12 * MiB;
constexpr size_t WS_W1 = 14 * MiB;
constexpr size_t WS_W2 = 30 * MiB;
constexpr size_t WS_H = 48 * MiB;
constexpr size_t WS_R = 82 * MiB;
constexpr size_t WS_QK = WS_R;
constexpr size_t WS_VT = WS_R + 68 * MiB;
constexpr size_t WS_O = WS_R + 102 * MiB;
constexpr size_t WS_HMID = WS_R;
constexpr size_t WS_Z0 = WS_R;
constexpr size_t WS_Z1 = WS_R + 64 * MiB;
constexpr size_t WS_F = WS_R + 128 * MiB;
constexpr size_t WS_END = 256 * MiB;
static_assert(WS_F + 32 * MiB <= WS_END && WS_HMID + 128 * MiB <= WS_END && WS_O + 32 * MiB <= WS_END, "ws map");

constexpr int LDS_BYTES = 147456;

typedef __bf16 bf16v2_t __attribute__((ext_vector_type(2)));
typedef float f32v2_t __attribute__((ext_vector_type(2)));
__device__ __forceinline__ unsigned cvt_pk_bf16(float lo, float hi) { const f32v2_t v = {lo, hi}; const bf16v2_t r = __builtin_convertvector(v, bf16v2_t); return __builtin_bit_cast(unsigned, r); }
__device__ __forceinline__ f32x4 mfma16(bf16x8 a, bf16x8 b, f32x4 c) { return __builtin_amdgcn_mfma_f32_16x16x32_bf16(a, b, c, 0, 0, 0); }

namespace pg8 {
constexpr int BM = 256, BK = 64, HALF = 128, HTB = HALF * BK * 2, STAGE_BYTES = 8 * HTB;
__device__ __forceinline__ int lds_byte(int r, int c) { const int st = (r >> 4) * 2 + (c >> 5), rr = r & 15, cc = c & 31, ob = rr * 64 + cc * 2; return st * 1024 + (ob ^ (((ob >> 9) & 1) << 5)); }
__device__ __forceinline__ void stage_rc(int b, int& R, int& C) { const int st = b / 1024, sb = b % 1024, swz = sb ^ (((sb >> 9) & 1) << 5); R = (st >> 1) * 16 + swz / 64; C = (st & 1) * 32 + (swz % 64) / 2; }
__device__ __forceinline__ int perm32(int rho) { const int n = rho >> 4, i = rho & 15; return 8 * (i >> 2) + 4 * n + (i & 3); }

struct Unit { int pm, pn, kind, aux; const char* a; const char* b; };

template <class Epi, class Sched, bool BMAP>
__device__ __forceinline__ void gemm_phase(LAS unsigned char* lds, const int K, const int lda, const int ldb, const Sched& S, const Epi& E) {
    int tid = threadIdx.x; asm volatile("" : "+v"(tid));
    const int wid = __builtin_amdgcn_readfirstlane(tid >> 6), lane = tid & 63, wr = wid >> 2, wc = wid & 3, fr = lane & 15, fq = lane >> 4;
    int nt = K / BK; asm volatile("" : "+s"(nt));
    unsigned voffA[2], voffB[2];
#pragma unroll
    for (int i = 0; i < 2; ++i) { int R, C; stage_rc(tid * 16 + i * 8192, R, C); const int Rb = (R & ~31) + perm32(R & 31);
        voffA[i] = (unsigned)(R * lda + C) * 2u;
        voffB[i] = BMAP ? (unsigned)((64 * (Rb & 63) + (Rb >> 6)) * ldb + C) * 2u : (unsigned)(Rb * ldb + C) * 2u; }
    const size_t kstep = (size_t)(BK * 2);
    const size_t hstepA = (size_t)HALF * lda * 2;
    const size_t hstepB = BMAP ? (size_t)2 * ldb * 2 : (size_t)HALF * ldb * 2;
    const unsigned ldsw = (unsigned)wid * 1024u;
    const int aoff = lds_byte(wr * 64 + fr, fq * 8), boff = lds_byte(wc * 32 + fr, fq * 8);
#define PG8_SA(b, h) (((b) * 2 + (h)) * HTB)
#define PG8_SB(b, h) ((4 + (b) * 2 + (h)) * HTB)
#define PG8_STAGE(bufoff, gbase, voff) do { _Pragma("unroll") for (int _i = 0; _i < 2; ++_i) \
        __builtin_amdgcn_global_load_lds((const unsigned*)((const char*)(gbase) + (voff)[_i]), (LAS unsigned*)(lds + (bufoff) + ldsw + _i * 8192), 16, 0, 0); } while (0)
#define PG8_LDA(dst, b, h) do { _Pragma("unroll") for (int m = 0; m < 4; ++m) _Pragma("unroll") for (int k = 0; k < 2; ++k) dst[m][k] = *(const LAS bf16x8*)(lds + PG8_SA(b, h) + aoff + m * 2048 + k * 1024); } while (0)
#define PG8_LDB(dst, b, h) do { _Pragma("unroll") for (int n = 0; n < 2; ++n) _Pragma("unroll") for (int k = 0; k < 2; ++k) dst[n][k] = *(const LAS bf16x8*)(lds + PG8_SB(b, h) + boff + n * 2048 + k * 1024); } while (0)
#define PG8_MMA(ai, bj, At, Bt) do { __builtin_amdgcn_s_setprio(1); _Pragma("unroll") for (int m = 0; m < 4; ++m) _Pragma("unroll") for (int n = 0; n < 2; ++n) _Pragma("unroll") for (int k = 0; k < 2; ++k) \
        acc[ai][bj][m][n] = __builtin_amdgcn_mfma_f32_16x16x32_bf16(Bt[n][k], At[m][k], acc[ai][bj][m][n], 0, 0, 0); __builtin_amdgcn_s_setprio(0); } while (0)
#define PG8_WAIT_V(n) asm volatile("s_waitcnt vmcnt(" #n ")" ::: "memory")
#define PG8_WAIT_L(n) asm volatile("s_waitcnt lgkmcnt(" #n ")" ::: "memory")
#define PG8_BAR __builtin_amdgcn_s_barrier()
#define PG8_SCHED __builtin_amdgcn_sched_barrier(0)
    Unit cur, nxt; int ui = 0;
    if (!S.next(0, cur)) return;
    f32x4 acc[2][2][4][2];
#pragma unroll
    for (int a = 0; a < 2; ++a)
#pragma unroll
        for (int b = 0; b < 2; ++b)
#pragma unroll
            for (int m = 0; m < 4; ++m)
#pragma unroll
                for (int n = 0; n < 2; ++n) acc[a][b][m][n] = (f32x4){0.f, 0.f, 0.f, 0.f};
    bf16x8 At[4][2], B0[2][2], B1[2][2];
    const char* cA = cur.a; const char* cB = cur.b;
    PG8_STAGE(PG8_SB(0, 0), cB, voffB); PG8_STAGE(PG8_SB(0, 1), cB + hstepB, voffB); PG8_STAGE(PG8_SA(0, 0), cA, voffA); PG8_STAGE(PG8_SA(0, 1), cA + hstepA, voffA);
    if (wr == 1) PG8_BAR;
    PG8_WAIT_V(2); PG8_BAR;
    PG8_STAGE(PG8_SB(1, 0), cB + kstep, voffB); PG8_STAGE(PG8_SA(1, 0), cA + kstep, voffA); PG8_STAGE(PG8_SB(1, 1), cB + hstepB + kstep, voffB);
    PG8_WAIT_V(6); PG8_BAR;
    for (;;) {
        const bool has_next = S.next(ui + 1, nxt);
        const char* nA = has_next ? nxt.a : cA; const char* nB = has_next ? nxt.b : cB;
        for (int t = 0; t < nt; t += 2) {
            const bool last = (t == nt - 2);
            const char* a1 = cA + (size_t)(t + 1) * kstep;
            const char* a2 = last ? nA : cA + (size_t)(t + 2) * kstep; const char* b2 = last ? nB : cB + (size_t)(t + 2) * kstep;
            const char* a3 = a2 + kstep; const char* b3 = b2 + kstep;
            PG8_LDB(B0, 0, 0); PG8_LDB(B1, 0, 1); PG8_SCHED; PG8_LDA(At, 0, 0); PG8_STAGE(PG8_SA(1, 1), a1 + hstepA, voffA);
            PG8_WAIT_V(8); PG8_WAIT_L(0); PG8_BAR; PG8_MMA(0, 0, At, B0); PG8_MMA(0, 1, At, B1); PG8_BAR; PG8_SCHED;
            PG8_LDA(At, 0, 1); PG8_STAGE(PG8_SB(0, 0), b2, voffB); PG8_STAGE(PG8_SB(0, 1), b2 + hstepB, voffB); PG8_STAGE(PG8_SA(0, 0), a2, voffA);
            PG8_WAIT_V(8); PG8_WAIT_L(0); PG8_BAR; PG8_MMA(1, 0, At, B0); PG8_MMA(1, 1, At, B1); PG8_BAR; PG8_SCHED;
            PG8_LDB(B0, 1, 0); PG8_LDB(B1, 1, 1); PG8_SCHED; PG8_LDA(At, 1, 0); PG8_STAGE(PG8_SA(0, 1), a2 + hstepA, voffA);
            PG8_WAIT_V(8); PG8_WAIT_L(0); PG8_BAR; PG8_MMA(0, 0, At, B0); PG8_MMA(0, 1, At, B1); PG8_BAR; PG8_SCHED;
            PG8_LDA(At, 1, 1); PG8_STAGE(PG8_SB(1, 0), b3, voffB); PG8_STAGE(PG8_SB(1, 1), b3 + hstepB, voffB); PG8_STAGE(PG8_SA(1, 0), a3, voffA);
            PG8_WAIT_V(8); PG8_WAIT_L(0); PG8_BAR; PG8_MMA(1, 0, At, B0); PG8_MMA(1, 1, At, B1); PG8_BAR; PG8_SCHED;
        }
        if (wr == 0) PG8_BAR;
        E(acc, cur, wr, wc, fr, fq);
        if (!has_next) break;
#pragma unroll
        for (int a = 0; a < 2; ++a)
#pragma unroll
            for (int b = 0; b < 2; ++b)
#pragma unroll
                for (int m = 0; m < 4; ++m)
#pragma unroll
                    for (int n = 0; n < 2; ++n) acc[a][b][m][n] = (f32x4){0.f, 0.f, 0.f, 0.f};
        cur = nxt; cA = nA; cB = nB; ++ui;
        if (wr == 1) PG8_BAR;
    }
    PG8_WAIT_V(0);
    PG8_BAR;
#undef PG8_SA
#undef PG8_SB
#undef PG8_STAGE
#undef PG8_LDA
#undef PG8_LDB
#undef PG8_MMA
#undef PG8_WAIT_V
#undef PG8_WAIT_L
#undef PG8_BAR
#undef PG8_SCHED
}

struct SchedStd {
    const char* A; const char* Bt; size_t tsA, tsB; int nM, nN, nwg, G, c;
    __device__ void init(const void* A_, const void* Bt_, int M, int N, int lda, int ldb, int G_, int c_) { A = (const char*)A_; Bt = (const char*)Bt_; tsA = (size_t)BM * lda * 2; tsB = (size_t)BM * ldb * 2; nM = M / BM; nN = N / BM; nwg = nM * nN; G = G_; c = c_; }
    __device__ bool next(int i, Unit& u) const {
        const long L = (long)i * G + c; if (L >= nwg) return false;
        int wgid = (int)L; { const int q = nwg / 8, r = nwg % 8, xcd = wgid % 8, off = wgid / 8; wgid = (xcd < r ? xcd * (q + 1) : r * (q + 1) + (xcd - r) * q) + off; }
        const int nig = 8 * nN, gid = wgid / nig, fm = gid * 8, gsz = (nM - fm) < 8 ? (nM - fm) : 8;
        u.pm = fm + ((wgid % nig) % gsz); u.pn = (wgid % nig) / gsz; u.kind = 0; u.aux = 0;
        u.a = A + (size_t)u.pm * tsA; u.b = Bt + (size_t)u.pn * tsB; return true;
    }
};
struct SchedQKV {
    const char* H; const char* Wqk; const char* Wv; int G, c;
    __device__ bool next(int i, Unit& u) const {
        const long Ll = (long)i * G + c; if (Ll >= 800) return false;
        const int L = (int)Ll; const size_t ts = (size_t)BM * 1024 * 2; u.aux = 0;
        if (L < 512) { const int x = L & 7, off = L >> 3; u.kind = 0; u.pm = 8 * x + (off & 7); u.pn = off >> 3; }
        else if (L < 768) { const int l2 = L - 512, x = l2 & 7, off = l2 >> 3; u.kind = 1; u.pm = off & 3; u.pn = 8 * x + (off >> 2); }
        else if (L < 784) { const int l2 = L - 768; u.kind = 0; u.pm = 64 + (l2 & 3); u.pn = 4 + (l2 >> 2); }
        else { const int l2 = L - 784; u.kind = 1; u.pm = l2 & 3; u.pn = 64 + (l2 >> 2); }
        if (u.kind == 0) { u.a = H + (size_t)u.pm * ts; u.b = Wqk + (size_t)u.pn * ts; }
        else { u.a = Wv + (size_t)u.pm * ts; u.b = H + (size_t)u.pn * ts; }
        return true;
    }
};
struct SchedF1 {
    const char* CS; const char* H; int G, c;
    __device__ bool next(int i, Unit& u) const {
        const long Ll = (long)i * G + c; if (Ll >= 512) return false;
        const int L = (int)Ll; const int t = L & 15, b = (L >> 4) & 3, g = (L >> 6) & 3, ri = L >> 8;
        u.pm = ri; u.pn = t; u.kind = g; u.aux = b;
        u.a = CS + (size_t)ri * 256 * 256 * 2; u.b = H + ((size_t)(b * 4096 + 4 * t) * 1024 + g * 256) * 2; return true;
    }
};

typedef f32x4 Acc[2][2][4][2];
__device__ __forceinline__ u32x4 pack8(f32x4 v0, f32x4 v1) { u32x4 w; w.x = cvt_pk_bf16(v0[0], v0[1]); w.y = cvt_pk_bf16(v0[2], v0[3]); w.z = cvt_pk_bf16(v1[0], v1[1]); w.w = cvt_pk_bf16(v1[2], v1[3]); return w; }

struct EpiQKV { bf16_t* QK; bf16_t* VT; const float* gq; const float* gk;
    __device__ __forceinline__ void operator()(const Acc& acc, const Unit& u, int wr, int wc, int fr, int fq) const {
        if (u.kind == 0) {
            const bool isq = u.pn < 4; const float* gp = isq ? gq : gk; const float qs = isq ? 0.125f * LOG2E : 1.0f;
            f32x4 gv[2][2];
#pragma unroll
            for (int bj = 0; bj < 2; ++bj)
#pragma unroll
                for (int n = 0; n < 2; ++n) gv[bj][n] = *(const f32x4*)(gp + 32 * bj + 8 * fq + 4 * n) * qs;
#pragma unroll
            for (int ai = 0; ai < 2; ++ai)
#pragma unroll
                for (int m = 0; m < 4; ++m) {
                    const int row = u.pm * BM + ai * HALF + wr * 64 + m * 16 + fr;
                    float ss = 0.f;
#pragma unroll
                    for (int bj = 0; bj < 2; ++bj)
#pragma unroll
                        for (int n = 0; n < 2; ++n) { const f32x4 x = acc[ai][bj][m][n]; ss += (x[0] * x[0] + x[1] * x[1]) + (x[2] * x[2] + x[3] * x[3]); }
                    ss += __shfl_xor(ss, 16); ss += __shfl_xor(ss, 32);
                    const float rstd = rsqrtf(ss * (1.0f / 64.0f) + EPS);
                    bf16_t* rowp = QK + (size_t)row * 2048 + u.pn * 256 + wc * 64 + 8 * fq;
#pragma unroll
                    for (int bj = 0; bj < 2; ++bj) *(u32x4*)(rowp + 32 * bj) = pack8(acc[ai][bj][m][0] * rstd * gv[bj][0], acc[ai][bj][m][1] * rstd * gv[bj][1]);
                }
        } else {
#pragma unroll
            for (int ai = 0; ai < 2; ++ai)
#pragma unroll
                for (int m = 0; m < 4; ++m) {
                    const int row = u.pm * BM + ai * HALF + wr * 64 + m * 16 + fr;
                    bf16_t* rowp = VT + (size_t)row * MT + u.pn * 256 + wc * 32 + 8 * fq;
#pragma unroll
                    for (int bj = 0; bj < 2; ++bj) *(u32x4*)(rowp + bj * HALF) = pack8(acc[ai][bj][m][0], acc[ai][bj][m][1]);
                }
        }
    }
};
struct EpiRelu2 { bf16_t* O; int ldc;
    __device__ __forceinline__ void operator()(const Acc& acc, const Unit& u, int wr, int wc, int fr, int fq) const {
#pragma unroll
        for (int ai = 0; ai < 2; ++ai)
#pragma unroll
            for (int m = 0; m < 4; ++m) {
                const int row = u.pm * BM + ai * HALF + wr * 64 + m * 16 + fr;
                bf16_t* rowp = O + (size_t)row * ldc + u.pn * 256 + wc * 32 + 8 * fq;
#pragma unroll
                for (int bj = 0; bj < 2; ++bj) { f32x4 v0 = acc[ai][bj][m][0], v1 = acc[ai][bj][m][1];
#pragma unroll
                    for (int e = 0; e < 4; ++e) { const float a = fmaxf(v0[e], 0.f), b = fmaxf(v1[e], 0.f); v0[e] = a * a; v1[e] = b * b; }
                    *(u32x4*)(rowp + bj * HALF) = pack8(v0, v1); }
            }
    }
};
struct EpiRes { const float* base; float* out; const float* gate;
    __device__ __forceinline__ void operator()(const Acc& acc, const Unit& u, int wr, int wc, int fr, int fq) const {
        const int col0 = u.pn * 256 + wc * 32 + 8 * fq;
        const float* gp = gate + (size_t)(u.pm >> 4) * 6144 + col0;
        f32x4 gv[2][2];
#pragma unroll
        for (int bj = 0; bj < 2; ++bj)
#pragma unroll
            for (int n = 0; n < 2; ++n) gv[bj][n] = *(const f32x4*)(gp + bj * HALF + 4 * n);
#pragma unroll
        for (int ai = 0; ai < 2; ++ai)
#pragma unroll
            for (int m = 0; m < 4; ++m) {
                const size_t off = (size_t)(u.pm * BM + ai * HALF + wr * 64 + m * 16 + fr) * 1024 + col0;
#pragma unroll
                for (int bj = 0; bj < 2; ++bj)
#pragma unroll
                    for (int n = 0; n < 2; ++n) { const f32x4 bs = *(const f32x4*)(base + off + bj * HALF + 4 * n);
                        *(f32x4*)(out + off + bj * HALF + 4 * n) = bs + gv[bj][n] * acc[ai][bj][m][n]; }
            }
    }
};
struct EpiZ0 { bf16_t* Z0;
    __device__ __forceinline__ void operator()(const Acc& acc, const Unit& u, int wr, int wc, int fr, int fq) const {
        const int ri = u.pm, t = u.pn, g = u.kind, b = u.aux;
        bf16_t* p0 = Z0 + ((size_t)(((b * 4 + g) * 256 + wr * 64 + fr) * 64 + 4 * t + (wc >> 1))) * 128 + ri * 64 + 32 * (wc & 1) + 8 * fq;
#pragma unroll
        for (int ai = 0; ai < 2; ++ai)
#pragma unroll
            for (int m = 0; m < 4; ++m) {
#pragma unroll
                for (int bj = 0; bj < 2; ++bj)
                    *(u32x4*)(p0 + (size_t)(ai * HALF + m * 16) * 8192 + bj * 256) = pack8(acc[ai][bj][m][0], acc[ai][bj][m][1]);
                asm volatile("" ::: "memory");
            }
    }
};
}


#define XB_TMO      128
#define XB_XCNT(j)  (256  + 64 * (j))
#define XB_XSUB(j)  (1280 + 64 * (j))
#define XB_XGEN(j)  (2304 + 64 * (j))
#define XB_TOP      3328
#define XB_TOPGEN   3392
#define XCD_BAR_WORDS 3456
#define XB_SPIN_CAP (1u << 18)
__device__ __forceinline__ unsigned xb_ld(unsigned* p)              { return __hip_atomic_load(p, __ATOMIC_RELAXED, __HIP_MEMORY_SCOPE_AGENT); }
__device__ __forceinline__ unsigned xb_add(unsigned* p, unsigned v) { return __hip_atomic_fetch_add(p, v, __ATOMIC_RELAXED, __HIP_MEMORY_SCOPE_AGENT); }
__device__ __forceinline__ unsigned xb_xcc_id() { return (unsigned)__builtin_amdgcn_s_getreg((3 << 11) | 20) & 0xFu; }
#define XB_SPIN(cond, bar) do { unsigned _sp = 0; while (cond) { __builtin_amdgcn_s_sleep(1); \
    if ((++_sp & 255u) == 0u) { if (xb_ld(&(bar)[XB_TMO])) break; if (_sp > XB_SPIN_CAP) { atomicAdd(&(bar)[XB_TMO], 1u); break; } } } } while (0)
struct XcdBarrier { unsigned* bar; unsigned x; volatile LAS unsigned* st; };
__device__ __forceinline__ XcdBarrier xcd_barrier_post(unsigned* bar, volatile LAS unsigned* st) {
    XcdBarrier b; b.bar = bar; b.x = xb_xcc_id(); b.st = st;
    if (threadIdx.x == 0) (void)xb_add(&bar[XB_XCNT(b.x)], 1u);
    return b;
}
__device__ __forceinline__ void xcd_barrier_complete(unsigned* bar, unsigned x, unsigned& nloc, unsigned& nx) {
    const unsigned G = gridDim.x * gridDim.y * gridDim.z;
    unsigned sum, cnt, mine, sp = 0u;
    for (;;) {
        sum = 0u; cnt = 0u; mine = 0u;
#pragma unroll
        for (unsigned j = 0; j < 16; ++j) { const unsigned c = xb_ld(&bar[XB_XCNT(j)]); sum += c; cnt += (c > 0u) ? 1u : 0u; mine = (j == x) ? c : mine; }
        if (sum == G) break;
        __builtin_amdgcn_s_sleep(1);
        if ((++sp & 255u) == 0u) { if (xb_ld(&bar[XB_TMO])) break; if (sp > XB_SPIN_CAP) { atomicAdd(&bar[XB_TMO], 1u); break; } }
    }
    nloc = mine > 0u ? mine : 1u; nx = cnt > 0u ? cnt : 1u;
}
__device__ __forceinline__ void xcd_barrier(const XcdBarrier& b) {
    asm volatile("s_waitcnt vmcnt(0)" ::: "memory");
    __syncthreads();
    if (threadIdx.x == 0) {
        unsigned* bar = b.bar;
        __builtin_amdgcn_s_waitcnt(0);
        unsigned nloc = b.st[0], nx = b.st[1];
        if (nloc == 0u) { xcd_barrier_complete(bar, b.x, nloc, nx); b.st[0] = nloc; b.st[1] = nx; }
        const unsigned old = xb_add(&bar[XB_XSUB(b.x)], 1u);
        const unsigned gen = old / nloc;
        if (old + 1u == (gen + 1u) * nloc) {
            __builtin_amdgcn_fence(__ATOMIC_RELEASE, "agent");
            asm volatile("s_waitcnt vmcnt(0)" ::: "memory");
            const unsigned og = xb_add(&bar[XB_TOP], 1u);
            const unsigned tg = og / nx;
            if (og + 1u == (tg + 1u) * nx) xb_add(&bar[XB_TOPGEN], 1u);
            else XB_SPIN(xb_ld(&bar[XB_TOPGEN]) == tg, bar);
            __builtin_amdgcn_fence(__ATOMIC_ACQUIRE, "agent");
            xb_add(&bar[XB_XGEN(b.x)], 1u);
            asm volatile("s_waitcnt vmcnt(0)" ::: "memory");
        } else {
            XB_SPIN(xb_ld(&bar[XB_XGEN(b.x)]) == gen, bar);
            __builtin_amdgcn_fence(__ATOMIC_ACQUIRE, "agent");
            asm volatile("s_waitcnt vmcnt(0)" ::: "memory");
        }
    }
    __syncthreads();
}
__device__ __forceinline__ void p0_mods_unit(const float* c, const float* cctx, const float* ada_w, const float* ada_b, float* mods, LAS unsigned char* lds, int unit) {
    LAS float* s = (LAS float*)lds;
    LAS float* red = s + 5 * 1024;
    int tid = threadIdx.x; asm volatile("" : "+v"(tid));
    for (int i = tid; i < 5 * 1024; i += 512) { const int v = i >> 10, k = i & 1023; const float x = v < 4 ? c[v * 1024 + k] : cctx[k]; s[i] = x / (1.0f + __expf(-x)); }
    __syncthreads();
    const int l = unit / 96, col0 = (unit % 96) * 64, kc = tid >> 6, cl = tid & 63;
    const float* w = ada_w + (size_t)l * 1024 * 6144 + col0 + cl;
    float a0 = 0.f, a1 = 0.f, a2 = 0.f, a3 = 0.f, a4 = 0.f;
    for (int k = kc * 128; k < kc * 128 + 128; k += 8) {
        float wv[8];
#pragma unroll
        for (int j = 0; j < 8; ++j) wv[j] = w[(size_t)(k + j) * 6144];
#pragma unroll
        for (int j = 0; j < 8; ++j) { a0 += s[k + j] * wv[j]; a1 += s[1024 + k + j] * wv[j]; a2 += s[2048 + k + j] * wv[j]; a3 += s[3072 + k + j] * wv[j]; a4 += s[4096 + k + j] * wv[j]; }
    }
    red[(kc * 5 + 0) * 64 + cl] = a0; red[(kc * 5 + 1) * 64 + cl] = a1; red[(kc * 5 + 2) * 64 + cl] = a2; red[(kc * 5 + 3) * 64 + cl] = a3; red[(kc * 5 + 4) * 64 + cl] = a4;
    __syncthreads();
    if (tid < 320) { const int v = tid >> 6, cc = tid & 63; float t = 0.f;
#pragma unroll
        for (int kk = 0; kk < 8; ++kk) t += red[(kk * 5 + v) * 64 + cc];
        mods[(size_t)(l * 5 + v) * 6144 + col0 + cc] = t + ada_b[l * 6144 + col0 + cc]; }
    __syncthreads();
}

__device__ __forceinline__ void p0_transpose_item(const float* W, int K, int N, bf16_t* WT, bf16_t* WT2, int mode, LAS float* scr, int item, int lane) {
    const int nblk = N / 32, kb = item / nblk, nb = item % nblk, k0 = 64 * kb, n0 = 32 * nb;
#pragma unroll 8
    for (int i = 0; i < 32; ++i) { const int kk = 2 * i + (lane >> 5); scr[kk * 33 + (lane & 31)] = W[(size_t)(k0 + kk) * N + n0 + (lane & 31)]; }
    asm volatile("s_waitcnt lgkmcnt(0)" ::: "memory");
    const int cch = lane & 7;
#pragma unroll
    for (int j = 0; j < 4; ++j) { const int n = (lane >> 3) + 8 * j; const LAS float* s = scr + (8 * cch) * 33 + n;
        u32x4 o; o.x = cvt_pk_bf16(s[0 * 33], s[1 * 33]); o.y = cvt_pk_bf16(s[2 * 33], s[3 * 33]); o.z = cvt_pk_bf16(s[4 * 33], s[5 * 33]); o.w = cvt_pk_bf16(s[6 * 33], s[7 * 33]);
        const int ng = n0 + n; bf16_t* dst;
        if (mode == 0) dst = WT + (size_t)ng * K;
        else if (ng < 2048) { const int pn = ng >> 8, hh = (ng >> 6) & 3, d = ng & 63; const int tpos = (d >> 5) * 128 + hh * 32 + (d & 31); dst = WT + (size_t)(pn * 256 + tpos) * K; }
        else dst = WT2 + (size_t)(ng - 2048) * K;
        *(u32x4*)(dst + k0 + 8 * cch) = o; }
    asm volatile("s_waitcnt lgkmcnt(0)" ::: "memory");
}

__device__ __forceinline__ float wave_sum(float v) {
#pragma unroll
    for (int o = 1; o < 64; o <<= 1) v += __shfl_xor(v, o);
    return v;
}
__device__ __forceinline__ void norm_rows(const float* xlat, const float* xctx, int nrows, const float* g, const float* modsl, int sh_off, int sc_off, bf16_t* H, int gw, int NGW, int lane) {
    f32x4 gv[4];
#pragma unroll
    for (int j = 0; j < 4; ++j) gv[j] = *(const f32x4*)(g + lane * 4 + 256 * j);
    for (int row = gw; row < nrows; row += NGW) {
        const float* src = row < ML ? xlat + (size_t)row * 1024 : xctx + (size_t)(row - ML) * 1024;
        const int v = row < ML ? (row >> 12) : 4;
        const float* mp = modsl + (size_t)v * 6144;
        f32x4 x[4]; float ss = 0.f;
#pragma unroll
        for (int j = 0; j < 4; ++j) { x[j] = *(const f32x4*)(src + lane * 4 + 256 * j); ss += (x[j][0] * x[j][0] + x[j][1] * x[j][1]) + (x[j][2] * x[j][2] + x[j][3] * x[j][3]); }
        const float rstd = rsqrtf(wave_sum(ss) * (1.0f / 1024.0f) + EPS);
#pragma unroll
        for (int j = 0; j < 4; ++j) {
            const f32x4 sh = *(const f32x4*)(mp + sh_off + lane * 4 + 256 * j), sc = *(const f32x4*)(mp + sc_off + lane * 4 + 256 * j);
            const f32x4 y = (x[j] * rstd * gv[j]) * (sc + 1.0f) + sh;
            u32x2 w; w.x = cvt_pk_bf16(y[0], y[1]); w.y = cvt_pk_bf16(y[2], y[3]);
            *(u32x2*)(H + (size_t)row * 1024 + lane * 4 + 256 * j) = w;
        }
    }
}

__device__ __forceinline__ void attn_phase(const bf16_t* QK, const bf16_t* VT, bf16_t* O, const float* rpb, const float* sbound, LAS unsigned char* lds, int G, int c) {
    LAS float* rp = (LAS float*)lds;
    int tid = threadIdx.x; asm volatile("" : "+v"(tid));
    const int lane = tid & 63, wid = tid >> 6, fr = lane & 15, g = lane >> 4;
    for (int i = tid; i < 16 * 465; i += 512) rp[i] = rpb[i] * LOG2E;
    __syncthreads();
    const float Mb = *sbound;
    for (int it = 0;; ++it) {
        const long Ll = (long)it * G + c; if (Ll >= 2048) break;
        const int L = (int)Ll, x = L & 7, q = L >> 3, rpair = q & 31, bh = 8 * (q >> 5) + x, b = bh >> 4, h = bh & 15;
        const int r = 2 * rpair + (wid >> 2), j = wid & 3;
        const int w0 = (j == 0) ? 0 : (j == 1) ? 8 : (j == 2) ? 24 : 32;
        const int rs = min(max(r - 4, 0), 56);
        const int cq = 16 * j + fr, cs = min(max(cq - 8, 0), 48);
        const int qrow = b * 4096 + r * 64 + cq;
        bf16x8 Qf[2];
#pragma unroll
        for (int kk = 0; kk < 2; ++kk) Qf[kk] = *(const bf16x8*)(QK + (size_t)qrow * 2048 + h * 64 + 32 * kk + 8 * g);
        const int eX = w0 + 4 * g - cs;
        const int dX = w0 + 4 * g - cq + 15;
        f32x4 acc[4];
#pragma unroll
        for (int db = 0; db < 4; ++db) acc[db] = (f32x4){0.f, 0.f, 0.f, 0.f};
        float lsum = 0.f;
        bf16x8 KX[2], KY[2]; s16x4 VX[4], VY[4];
#define ATT_TOK(blk) ((blk) < 8 ? (b * 4096 + (rs + (blk)) * 64 + w0) : (ML + b * 256 + 32 * ((blk) - 8)))
#define ATT_LOAD(blk, kx, ky, vx, vy) do { const int tb_ = ATT_TOK(blk); const bf16_t* kp_ = QK + (size_t)(tb_ + fr) * 2048 + 1024 + h * 64 + 8 * g; \
        _Pragma("unroll") for (int kk = 0; kk < 2; ++kk) { kx[kk] = *(const bf16x8*)(kp_ + 32 * kk); ky[kk] = *(const bf16x8*)(kp_ + 16 * 2048 + 32 * kk); } \
        const bf16_t* vp_ = VT + (size_t)(h * 64 + fr) * MT + tb_ + 4 * g; \
        _Pragma("unroll") for (int db = 0; db < 4; ++db) { vx[db] = *(const s16x4*)(vp_ + (size_t)(16 * db) * MT); vy[db] = *(const s16x4*)(vp_ + (size_t)(16 * db) * MT + 16); } } while (0)
        ATT_LOAD(0, KX, KY, VX, VY);
#pragma unroll
        for (int blk = 0; blk < 16; ++blk) {
            bf16x8 nKX[2], nKY[2]; s16x4 nVX[4], nVY[4];
            if (blk + 1 < 16) ATT_LOAD(blk + 1, nKX, nKY, nVX, nVY);
            f32x4 sX = mfma16(KX[0], Qf[0], (f32x4){0.f, 0.f, 0.f, 0.f}); sX = mfma16(KX[1], Qf[1], sX);
            f32x4 sY = mfma16(KY[0], Qf[0], (f32x4){0.f, 0.f, 0.f, 0.f}); sY = mfma16(KY[1], Qf[1], sY);
            f32x4 pX, pY;
            if (blk < 8) {
                const int base = h * 465 + (rs + blk - r + 7) * 31;
#pragma unroll
                for (int ii = 0; ii < 4; ++ii) {
                    const int dcx = min(max(dX + ii, 0), 30), dcy = min(max(dX + 16 + ii, 0), 30);
                    const float bx = rp[base + dcx], by = rp[base + dcy];
                    const bool okx = (unsigned)(eX + ii) < 16u, oky = (unsigned)(eX + 16 + ii) < 16u;
                    pX[ii] = okx ? __builtin_amdgcn_exp2f(sX[ii] + bx - Mb) : 0.f;
                    pY[ii] = oky ? __builtin_amdgcn_exp2f(sY[ii] + by - Mb) : 0.f;
                }
            } else {
#pragma unroll
                for (int ii = 0; ii < 4; ++ii) { pX[ii] = __builtin_amdgcn_exp2f(sX[ii] - Mb); pY[ii] = __builtin_amdgcn_exp2f(sY[ii] - Mb); }
            }
            lsum += ((pX[0] + pX[1]) + (pX[2] + pX[3])) + ((pY[0] + pY[1]) + (pY[2] + pY[3]));
            const u32x4 pw = pg8::pack8(pX, pY);
            const bf16x8 Pf = __builtin_bit_cast(bf16x8, pw);
#pragma unroll
            for (int db = 0; db < 4; ++db) {
                bf16x8 Vf; Vf[0] = VX[db][0]; Vf[1] = VX[db][1]; Vf[2] = VX[db][2]; Vf[3] = VX[db][3]; Vf[4] = VY[db][0]; Vf[5] = VY[db][1]; Vf[6] = VY[db][2]; Vf[7] = VY[db][3];
                acc[db] = mfma16(Vf, Pf, acc[db]);
            }
            if (blk + 1 < 16) {
#pragma unroll
                for (int kk = 0; kk < 2; ++kk) { KX[kk] = nKX[kk]; KY[kk] = nKY[kk]; }
#pragma unroll
                for (int db = 0; db < 4; ++db) { VX[db] = nVX[db]; VY[db] = nVY[db]; }
            }
        }
#undef ATT_LOAD
#undef ATT_TOK
        lsum += __shfl_xor(lsum, 16); lsum += __shfl_xor(lsum, 32);
        const float inv = 1.0f / lsum;
        bf16_t* op = O + (size_t)qrow * 1024 + h * 64 + 4 * g;
#pragma unroll
        for (int db = 0; db < 4; ++db) { u32x2 w; w.x = cvt_pk_bf16(acc[db][0] * inv, acc[db][1] * inv); w.y = cvt_pk_bf16(acc[db][2] * inv, acc[db][3] * inv); *(u32x2*)(op + 16 * db) = w; }
    }
    __syncthreads();
}

__device__ __forceinline__ void s1_phase(const bf16_t* Z0, const bf16_t* Dg, bf16_t* Z1, LAS unsigned char* lds, int gw, int NGW) {
    constexpr int DP = 136;
    LAS bf16_t* Dl = (LAS bf16_t*)lds;
    int tid = threadIdx.x; asm volatile("" : "+v"(tid));
    const int lane = tid & 63, fr = lane & 15, g = lane >> 4;
    for (int i = tid; i < 128 * 16; i += 512) { const int row = i >> 4, ch = i & 15; *(LAS u32x4*)(Dl + row * DP + ch * 8) = *(const u32x4*)(Dg + row * 128 + ch * 8); }
    __syncthreads();
    for (int colM = gw; colM < 4096; colM += NGW) {
        bf16x8 A[4][4];
#pragma unroll
        for (int ib = 0; ib < 4; ++ib)
#pragma unroll
            for (int kb = 0; kb < 4; ++kb) A[ib][kb] = *(const bf16x8*)(Z0 + ((size_t)colM * 64 + 16 * ib + fr) * 128 + 32 * kb + 8 * g);
#pragma unroll 2
        for (int jb = 0; jb < 8; ++jb) {
            bf16x8 Bf[4];
#pragma unroll
            for (int kb = 0; kb < 4; ++kb) Bf[kb] = *(const LAS bf16x8*)(Dl + (16 * jb + fr) * DP + 32 * kb + 8 * g);
            const int n = 16 * jb + fr, ka = n >> 1, rip = n & 1;
#pragma unroll
            for (int ib = 0; ib < 4; ++ib) {
                f32x4 a = (f32x4){0.f, 0.f, 0.f, 0.f};
#pragma unroll
                for (int kb = 0; kb < 4; ++kb) a = mfma16(A[ib][kb], Bf[kb], a);
                u32x2 w; w.x = cvt_pk_bf16(a[0], a[1]); w.y = cvt_pk_bf16(a[2], a[3]);
                *(u32x2*)(Z1 + (((size_t)ka * 4096 + colM) * 2 + rip) * 64 + 16 * ib + 4 * g) = w;
            }
        }
    }
    __syncthreads();
}
__device__ __forceinline__ void s2_phase(const bf16_t* Z1, const bf16_t* Eg, bf16_t* F, int gw, int NGW, int lane) {
    const int fr = lane & 15, g = lane >> 4;
    for (int it = gw; it < 2048; it += NGW) {
        const int ka = it & 63, chunk = it >> 6;
        bf16x8 Bf[4][4];
#pragma unroll
        for (int jb = 0; jb < 4; ++jb)
#pragma unroll
            for (int kb = 0; kb < 4; ++kb) Bf[jb][kb] = *(const bf16x8*)(Eg + ((size_t)ka * 64 + 16 * jb + fr) * 128 + 32 * kb + 8 * g);
        for (int ib = 0; ib < 8; ++ib) {
            const int colM0 = chunk * 128 + ib * 16;
            bf16x8 A[4];
#pragma unroll
            for (int kb = 0; kb < 4; ++kb) A[kb] = *(const bf16x8*)(Z1 + ((size_t)ka * 4096 + colM0 + fr) * 128 + 32 * kb + 8 * g);
            const int cm = colM0 + 4 * g, b = cm >> 10, ch = cm & 1023;
#pragma unroll
            for (int jb = 0; jb < 4; ++jb) {
                f32x4 a = (f32x4){0.f, 0.f, 0.f, 0.f};
#pragma unroll
                for (int kb = 0; kb < 4; ++kb) a = mfma16(A[kb], Bf[jb][kb], a);
                const int kbk = 16 * jb + fr;
                u32x2 w; w.x = cvt_pk_bf16(a[0], a[1]); w.y = cvt_pk_bf16(a[2], a[3]);
                *(u32x2*)(F + ((size_t)b * 4096 + ka + 64 * kbk) * 1024 + ch) = w;
            }
        }
    }
}


#ifndef MK_DEBUG
#define MK_DEBUG 0
#endif
__device__ __forceinline__ void dbg_scan16(const bf16_t* p, size_t n, unsigned* flags, unsigned bit, int gt, int NT) {
    bool bad = false; for (size_t i = gt; i < n; i += NT) bad |= ((p[i] & 0x7f80u) == 0x7f80u);
    if (bad) atomicOr(flags, 1u << bit);
}
__device__ __forceinline__ void dbg_scan32(const float* p, size_t n, unsigned* flags, unsigned bit, int gt, int NT) {
    bool bad = false; for (size_t i = gt; i < n; i += NT) bad |= ((__float_as_uint(p[i]) & 0x7f800000u) == 0x7f800000u);
    if (bad) atomicOr(flags, 1u << bit);
}
struct Args { const float* in[15]; float* out; unsigned char* ws; int ph_lo, ph_hi; };
static_assert(sizeof(Args) == 15 * 8 + 8 + 8 + 8, "no padding");

__global__ void __launch_bounds__(512, 2) fwd_kernel(Args args) {
    extern __shared__ __attribute__((aligned(16))) unsigned char lds_raw[];
    LAS unsigned char* lds = (LAS unsigned char*)lds_raw;
    const int G = gridDim.x, c = blockIdx.x;
    const int vcu = (G % 8 == 0) ? (c % 8) * (G / 8) + c / 8 : c;
    const int NGW = G * 8;
#define PHASE_IDS int tid_ = threadIdx.x; asm volatile("" : "+v"(tid_)); const int lane = tid_ & 63, wid = __builtin_amdgcn_readfirstlane(tid_ >> 6); const int gw = vcu * 8 + wid; (void)lane; (void)gw
    unsigned char* ws = args.ws;
    const float* x = args.in[0]; const float* cvec = args.in[1]; const float* ctx = args.in[2]; const float* cctx = args.in[3];
    const float* ada_w = args.in[4]; const float* ada_b = args.in[5]; const float* norm_g = args.in[6];
    const float* wqkv = args.in[7]; const float* wo = args.in[8]; const float* gq = args.in[9]; const float* gk = args.in[10]; const float* rpb = args.in[11];
    const float* fw = args.in[12]; const float* w1 = args.in[13]; const float* w2 = args.in[14];
    float* out = args.out;
    float* mods = (float*)(ws + WS_MODS); float* sbound = (float*)(ws + WS_SB);
    bf16_t* CS = (bf16_t*)(ws + WS_CS); bf16_t* Dt = (bf16_t*)(ws + WS_D); bf16_t* Et = (bf16_t*)(ws + WS_E);
    bf16_t* WQK = (bf16_t*)(ws + WS_WQK); bf16_t* WV = (bf16_t*)(ws + WS_WV); bf16_t* WO = (bf16_t*)(ws + WS_WO); bf16_t* FWt = (bf16_t*)(ws + WS_FW);
    bf16_t* W1t = (bf16_t*)(ws + WS_W1); bf16_t* W2t = (bf16_t*)(ws + WS_W2);
    bf16_t* H = (bf16_t*)(ws + WS_H); bf16_t* QK = (bf16_t*)(ws + WS_QK); bf16_t* VT = (bf16_t*)(ws + WS_VT); bf16_t* O = (bf16_t*)(ws + WS_O);
    bf16_t* HMID = (bf16_t*)(ws + WS_HMID); bf16_t* Z0 = (bf16_t*)(ws + WS_Z0); bf16_t* Z1 = (bf16_t*)(ws + WS_Z1); bf16_t* Fb = (bf16_t*)(ws + WS_F);
    const int lo = args.ph_lo, hi = args.ph_hi;
    cg::grid_group grid = cg::this_grid();
#define IN(k) (lo <= (k) && (k) < hi)
#ifndef REP_SYNC
#define REP_SYNC 1
#endif
#ifndef REP_NORM
#define REP_NORM 1
#endif
#ifndef REP_S12
#define REP_S12 1
#endif
#ifndef REP_P0
#define REP_P0 1
#endif
#ifndef USE_XB
#define USE_XB 1
#endif
#define SEAM(k) do { if (IN(k) && IN((k) + 1)) { for (int r_ = 0; r_ < REP_SYNC; ++r_) { if (!USE_XB || (k) == 0) grid.sync(); else xcd_barrier(xbar); } } } while (0)
    { volatile LAS unsigned* st_ = (volatile LAS unsigned*)(lds + LDS_BYTES - 64); if (threadIdx.x < 2) st_[threadIdx.x] = 0u; __syncthreads(); }
    XcdBarrier xbar; xbar.bar = (unsigned*)(ws + WS_BAR); xbar.x = 0; xbar.st = (volatile LAS unsigned*)(lds + LDS_BYTES - 64);
    if (USE_XB && hi - lo > 1) xbar = xcd_barrier_post((unsigned*)(ws + WS_BAR), (volatile LAS unsigned*)(lds + LDS_BYTES - 64));

    unsigned* dflags = (unsigned*)(ws + WS_SB + 256);
#define DBG16(k, bit, p, n) do { if (MK_DEBUG && IN(k)) { int t_ = threadIdx.x; asm volatile("" : "+v"(t_)); dbg_scan16(p, n, dflags, bit, (vcu * 512) + t_, G * 512); } } while (0)
#define DBG32(k, bit, p, n) do { if (MK_DEBUG && IN(k)) { int t_ = threadIdx.x; asm volatile("" : "+v"(t_)); dbg_scan32(p, n, dflags, bit, (vcu * 512) + t_, G * 512); } } while (0)
    if (IN(0)) {
        PHASE_IDS;
        if (MK_DEBUG && c == 0 && tid_ == 0) *dflags = 0u;
        for (int r0_ = 0; r0_ < REP_P0; ++r0_) {
        for (int u = c; u < 192; u += G) p0_mods_unit(cvec, cctx, ada_w, ada_b, mods, lds, u);
        __syncthreads();
        {
            LAS float* scr = (LAS float*)(lds + wid * 16384);
            constexpr int I_QKV = 16 * 96, I_SQ = 16 * 32, I_1 = 16 * 128, I_2 = 64 * 32;
            constexpr int NITEMS = I_QKV + 2 * I_SQ + 2 * I_1 + 2 * I_2;
            for (int it = NITEMS - 1 - gw; it >= 0; it -= NGW) {
                int r = it;
                if (r < I_QKV) { p0_transpose_item(wqkv, 1024, 3072, WQK, WV, 1, scr, r, lane); continue; } r -= I_QKV;
                if (r < I_SQ) { p0_transpose_item(wo, 1024, 1024, WO, nullptr, 0, scr, r, lane); continue; } r -= I_SQ;
                if (r < I_SQ) { p0_transpose_item(fw, 1024, 1024, FWt, nullptr, 0, scr, r, lane); continue; } r -= I_SQ;
                if (r < 2 * I_1) { const int l = r / I_1; p0_transpose_item(w1 + (size_t)l * 1024 * 4096, 1024, 4096, W1t + (size_t)l * 4096 * 1024, nullptr, 0, scr, r % I_1, lane); continue; } r -= 2 * I_1;
                { const int l = r / I_2; p0_transpose_item(w2 + (size_t)l * 4096 * 1024, 4096, 1024, W2t + (size_t)l * 1024 * 4096, nullptr, 0, scr, r % I_2, lane); }
            }
        }
        {
            const int gt = gw * 64 + lane, NT = NGW * 64;
            for (int i = gt; i < 512 * 256; i += NT) { const int m = i >> 8, cc = i & 255, ri = m >> 8, k2 = m & 255; float sn, cs; sincospif(2.0f * (float)((cc * k2) & 255) / 256.0f, &sn, &cs);
                const float v = (ri == 0 ? cs : -sn) * (1.0f / 16.0f); CS[i] = (bf16_t)(cvt_pk_bf16(v, 0.f) & 0xffffu); }
            for (int i = gt; i < 128 * 128; i += NT) { const int n = i >> 7, kp = i & 127, ka = n >> 1, rip = n & 1, ri = kp >> 6, a = kp & 63; float sn, cs; sincospif(2.0f * (float)((a * ka) & 63) / 64.0f, &sn, &cs);
                const float v = (rip == 0 ? (ri == 0 ? cs : sn) : (ri == 0 ? -sn : cs)) * 0.125f; Dt[i] = (bf16_t)(cvt_pk_bf16(v, 0.f) & 0xffffu); }
            for (int i = gt; i < 64 * 64 * 128; i += NT) { const int kp = i & 127, kbk = (i >> 7) & 63, ka = i >> 13, rip = kp >> 6, bp = kp & 63; float sn, cs; sincospif(2.0f * (float)((bp * (ka + 64 * kbk)) & 4095) / 4096.0f, &sn, &cs);
                const float v = (rip == 0 ? cs : sn) * 0.125f; Et[i] = (bf16_t)(cvt_pk_bf16(v, 0.f) & 0xffffu); }
        }
        if (c == G - 1 && wid == 7) {
            float mq = fabsf(gq[lane]), mk = fabsf(gk[lane]), mr = 0.f;
            for (int i = lane; i < 16 * 465; i += 64) mr = fmaxf(mr, fabsf(rpb[i]));
#pragma unroll
            for (int o = 1; o < 64; o <<= 1) { mq = fmaxf(mq, __shfl_xor(mq, o)); mk = fmaxf(mk, __shfl_xor(mk, o)); mr = fmaxf(mr, __shfl_xor(mr, o)); }
            if (lane == 0) *sbound = (8.0f * mq * mk + mr) * LOG2E;
        }
        __syncthreads();
        }
    }
    SEAM(0);
    if (IN(1)) { PHASE_IDS; for (int r_ = 0; r_ < REP_NORM; ++r_) norm_rows(x, ctx, MT, norm_g, mods, 0, 1024, H, gw, NGW, lane); }
    SEAM(1);
    DBG16(2, 0, H, (size_t)MT * 1024);
    if (IN(2)) { pg8::SchedQKV S{(const char*)H, (const char*)WQK, (const char*)WV, G, c}; pg8::EpiQKV E{QK, VT, gq, gk};
        pg8::gemm_phase<pg8::EpiQKV, pg8::SchedQKV, false>(lds, 1024, 1024, 1024, S, E); }
    SEAM(2);
    DBG16(3, 1, QK, (size_t)ML * 2048); DBG16(3, 2, VT, (size_t)1024 * MT); DBG32(3, 13, mods, (size_t)10 * 6144);
#ifndef REP_ATT
#define REP_ATT 1
#endif
    if (IN(3)) { for (int rep = 0; rep < REP_ATT; ++rep) attn_phase(QK, VT, O, rpb, sbound, lds, G, c); }
    SEAM(3);
    DBG16(4, 3, O, (size_t)ML * 1024);
    if (IN(4)) { pg8::SchedStd S; S.init(O, WO, ML, 1024, 1024, 1024, G, c); pg8::EpiRes E{x, out, mods + 2048};
        pg8::gemm_phase<pg8::EpiRes, pg8::SchedStd, false>(lds, 1024, 1024, 1024, S, E); }
    SEAM(4);
    DBG32(5, 4, out, (size_t)ML * 1024);
    if (IN(5)) { PHASE_IDS; for (int r_ = 0; r_ < REP_NORM; ++r_) norm_rows(out, out, ML, norm_g + 1024, mods, 3072, 4096, H, gw, NGW, lane); }
    SEAM(5);
    if (IN(6)) { pg8::SchedStd S; S.init(H, W1t, ML, 4096, 1024, 1024, G, c); pg8::EpiRelu2 E{HMID, 4096};
        pg8::gemm_phase<pg8::EpiRelu2, pg8::SchedStd, false>(lds, 1024, 1024, 1024, S, E); }
    SEAM(6);
    DBG16(7, 5, HMID, (size_t)ML * 4096);
    if (IN(7)) { pg8::SchedStd S; S.init(HMID, W2t, ML, 1024, 4096, 4096, G, c); pg8::EpiRes E{out, out, mods + 5120};
        pg8::gemm_phase<pg8::EpiRes, pg8::SchedStd, false>(lds, 4096, 4096, 4096, S, E); }
    SEAM(7);
    const float* mods1 = mods + 5 * 6144;
    DBG32(8, 6, out, (size_t)ML * 1024);
    if (IN(8)) { PHASE_IDS; for (int r_ = 0; r_ < REP_NORM; ++r_) norm_rows(out, out, ML, norm_g + 2048, mods1, 0, 1024, H, gw, NGW, lane); }
    SEAM(8);
    if (IN(9)) { pg8::SchedF1 S{(const char*)CS, (const char*)H, G, c}; pg8::EpiZ0 E{Z0};
        pg8::gemm_phase<pg8::EpiZ0, pg8::SchedF1, true>(lds, 256, 256, 1024, S, E); }
    SEAM(9);
    DBG16(10, 7, Z0, (size_t)262144 * 128);
    if (IN(10)) { PHASE_IDS; for (int r_ = 0; r_ < REP_S12; ++r_) s1_phase(Z0, Dt, Z1, lds, gw, NGW); }
    SEAM(10);
    DBG16(11, 8, Z1, (size_t)262144 * 128);
    if (IN(11)) { PHASE_IDS; for (int r_ = 0; r_ < REP_S12; ++r_) s2_phase(Z1, Et, Fb, gw, NGW, lane); }
    SEAM(11);
    DBG16(12, 9, Fb, (size_t)ML * 1024);
    if (IN(12)) { pg8::SchedStd S; S.init(Fb, FWt, ML, 1024, 1024, 1024, G, c); pg8::EpiRes E{out, out, mods1 + 2048};
        pg8::gemm_phase<pg8::EpiRes, pg8::SchedStd, false>(lds, 1024, 1024, 1024, S, E); }
    SEAM(12);
    DBG32(13, 10, out, (size_t)ML * 1024);
    if (IN(13)) { PHASE_IDS; for (int r_ = 0; r_ < REP_NORM; ++r_) norm_rows(out, out, ML, norm_g + 3072, mods1, 3072, 4096, H, gw, NGW, lane); }
    SEAM(13);
    if (IN(14)) { pg8::SchedStd S; S.init(H, W1t + (size_t)4096 * 1024, ML, 4096, 1024, 1024, G, c); pg8::EpiRelu2 E{HMID, 4096};
        pg8::gemm_phase<pg8::EpiRelu2, pg8::SchedStd, false>(lds, 1024, 1024, 1024, S, E); }
    SEAM(14);
    DBG16(15, 11, HMID, (size_t)ML * 4096);
    if (IN(15)) { pg8::SchedStd S; S.init(HMID, W2t + (size_t)1024 * 4096, ML, 1024, 4096, 4096, G, c); pg8::EpiRes E{out, out, mods1 + 5120};
        pg8::gemm_phase<pg8::EpiRes, pg8::SchedStd, false>(lds, 4096, 4096, 4096, S, E); }
    SEAM(15);
    if (MK_DEBUG && IN(16)) {
        int t_ = threadIdx.x; asm volatile("" : "+v"(t_));
        bool bad = false;
        for (size_t i = (size_t)vcu * 512 + t_; i < (size_t)ML * 1024; i += (size_t)G * 512) { if ((__float_as_uint(out[i]) & 0x7f800000u) == 0x7f800000u) { bad = true; out[i] = 0.f; } }
        if (bad) atomicOr(dflags, 1u << 12);
    }
    SEAM(16);
    if (MK_DEBUG && IN(17)) {
        if (c == 0 && threadIdx.x == 0) { const unsigned f = *dflags; if (f) out[0] = 1.0e6f * (float)(__builtin_ctz(f) + 1) + 1.0e4f * (float)__builtin_popcount(f); }
    }
#undef IN
#undef SEAM
}

constexpr int NPHASE = MK_DEBUG ? 18 : 16;
#ifndef MK_PER_PHASE
#define MK_PER_PHASE 0
#endif

extern "C" void kernel_launch(void* const* d_in, const int* in_sizes, int n_in, void* d_out, int out_size, void* d_ws, size_t ws_size, hipStream_t stream) {
    static int grid = 0;
    if (grid == 0) {
        if (n_in != 15 || out_size != ML * DM || ws_size < WS_END) { fprintf(stderr, "kernel_launch: unexpected shapes (n_in %d out %d ws %zu)\n", n_in, out_size, ws_size); grid = -1; return; }
        int dev = 0, cus = 0, per_cu = 0;
        hipGetDevice(&dev); hipDeviceGetAttribute(&cus, hipDeviceAttributeMultiprocessorCount, dev);
        hipFuncSetAttribute((const void*)fwd_kernel, hipFuncAttributeMaxDynamicSharedMemorySize, LDS_BYTES);
        if (hipOccupancyMaxActiveBlocksPerMultiprocessor(&per_cu, (const void*)fwd_kernel, 512, LDS_BYTES) != hipSuccess || per_cu < 1) { fprintf(stderr, "kernel_launch: occupancy query failed (%d)\n", per_cu); (void)hipGetLastError(); per_cu = 1; }
        grid = cus * 1;
        if (grid <= 0) grid = 256;
    }
    if (grid < 0) return;
    if (hipMemsetAsync((char*)d_ws + WS_BAR, 0, BAR_BYTES, stream) != hipSuccess) { fprintf(stderr, "kernel_launch: memset failed\n"); return; }
    Args a{};
    for (int i = 0; i < 15; ++i) a.in[i] = (const float*)d_in[i];
    a.out = (float*)d_out; a.ws = (unsigned char*)d_ws;
#if MK_PER_PHASE
    for (int p = 0; p < NPHASE; ++p) { a.ph_lo = p; a.ph_hi = p + 1; hipLaunchKernelGGL(fwd_kernel, dim3(grid), dim3(512), LDS_BYTES, stream, a); }
#else
    a.ph_lo = 0; a.ph_hi = NPHASE;
    void* kargs[] = {&a};
    hipError_t e = hipLaunchCooperativeKernel((const void*)fwd_kernel, dim3(grid), dim3(512), kargs, LDS_BYTES, stream);
    if (e != hipSuccess) fprintf(stderr, "cooperative launch failed: %s (grid %d)\n", hipGetErrorString(e), grid);
#endif
}
```

```cpp
#include <hip/hip_runtime.h>
#include <hip/hip_cooperative_groups.h>
#include <cstdio>
#include <cstdint>
namespace cg = cooperative_groups;

#define LAS __attribute__((address_space(3)))
typedef unsigned short bf16_t;
typedef short bf16x8 __attribute__((ext_vector_type(8)));
typedef short s16x4 __attribute__((ext_vector_type(4)));
typedef float f32x4 __attribute__((ext_vector_type(4)));
typedef unsigned u32x4 __attribute__((ext_vector_type(4)));
typedef unsigned u32x2 __attribute__((ext_vector_type(2)));

constexpr int DM = 1024, NB = 4, SEQ = 4096, CTXL = 256, FF = 4096;
constexpr int ML = NB * SEQ;
constexpr int MT = ML + NB * CTXL;
constexpr float LOG2E = 1.4426950408889634f;
constexpr float EPS = 1e-6f;

constexpr size_t MiB = 1u << 20;
constexpr size_t WS_MODS = 0;
constexpr size_t WS_SB = 512 * 1024;
constexpr size_t WS_BAR = 1 * MiB;
constexpr size_t BAR_BYTES = 16384;
constexpr size_t WS_CS = 2 * MiB;
constexpr size_t WS_D = 2 * MiB + 512 * 1024;
constexpr size_t WS_E = 3 * MiB;
constexpr size_t WS_WQK = 4 * MiB, WS_WV = 8 * MiB, WS_WO = 10 * MiB, WS_FW = 12 * MiB;
constexpr size_t WS_W1 = 14 * MiB;
constexpr size_t WS_W2 = 30 * MiB;
constexpr size_t WS_H = 48 * MiB;
constexpr size_t WS_R = 82 * MiB;
constexpr size_t WS_QK = WS_R;
constexpr size_t WS_VT = WS_R + 68 * MiB;
constexpr size_t WS_O = WS_R + 102 * MiB;
constexpr size_t WS_HMID = WS_R;
constexpr size_t WS_Z0 = WS_R;
constexpr size_t WS_Z1 = WS_R + 64 * MiB;
constexpr size_t WS_F = WS_R + 128 * MiB;
constexpr size_t WS_END = 256 * MiB;
static_assert(WS_F + 32 * MiB <= WS_END && WS_HMID + 128 * MiB <= WS_END && WS_O + 32 * MiB <= WS_END, "ws map");

constexpr int LDS_BYTES = 147456;

typedef __bf16 bf16v2_t __attribute__((ext_vector_type(2)));
typedef float f32v2_t __attribute__((ext_vector_type(2)));
__device__ __forceinline__ unsigned cvt_pk_bf16(float lo, float hi) { const f32v2_t v = {lo, hi}; const bf16v2_t r = __builtin_convertvector(v, bf16v2_t); return __builtin_bit_cast(unsigned, r); }
__device__ __forceinline__ f32x4 mfma16(bf16x8 a, bf16x8 b, f32x4 c) { return __builtin_amdgcn_mfma_f32_16x16x32_bf16(a, b, c, 0, 0, 0); }

namespace pg8 {
constexpr int BM = 256, BK = 64, HALF = 128, HTB = HALF * BK * 2, STAGE_BYTES = 8 * HTB;
__device__ __forceinline__ int lds_byte(int r, int c) { const int st = (r >> 4) * 2 + (c >> 5), rr = r & 15, cc = c & 31, ob = rr * 64 + cc * 2; return st * 1024 + (ob ^ (((ob >> 9) & 1) << 5)); }
__device__ __forceinline__ void stage_rc(int b, int& R, int& C) { const int st = b / 1024, sb = b % 1024, swz = sb ^ (((sb >> 9) & 1) << 5); R = (st >> 1) * 16 + swz / 64; C = (st & 1) * 32 + (swz % 64) / 2; }
__device__ __forceinline__ int perm32(int rho) { const int n = rho >> 4, i = rho & 15; return 8 * (i >> 2) + 4 * n + (i & 3); }

struct Unit { int pm, pn, kind, aux; const char* a; const char* b; };

template <class Epi, class Sched, bool BMAP>
__device__ __forceinline__ void gemm_phase(LAS unsigned char* lds, const int K, const int lda, const int ldb, const Sched& S, const Epi& E) {
    int tid = threadIdx.x; asm volatile("" : "+v"(tid));
    const int wid = __builtin_amdgcn_readfirstlane(tid >> 6), lane = tid & 63, wr = wid >> 2, wc = wid & 3, fr = lane & 15, fq = lane >> 4;
    int nt = K / BK; asm volatile("" : "+s"(nt));
    unsigned voffA[2], voffB[2];
#pragma unroll
    for (int i = 0; i < 2; ++i) { int R, C; stage_rc(tid * 16 + i * 8192, R, C); const int Rb = (R & ~31) + perm32(R & 31);
        voffA[i] = (unsigned)(R * lda + C) * 2u;
        voffB[i] = BMAP ? (unsigned)((64 * (Rb & 63) + (Rb >> 6)) * ldb + C) * 2u : (unsigned)(Rb * ldb + C) * 2u; }
    const size_t kstep = (size_t)(BK * 2);
    const size_t hstepA = (size_t)HALF * lda * 2;
    const size_t hstepB = BMAP ? (size_t)2 * ldb * 2 : (size_t)HALF * ldb * 2;
    const unsigned ldsw = (unsigned)wid * 1024u;
    const int aoff = lds_byte(wr * 64 + fr, fq * 8), boff = lds_byte(wc * 32 + fr, fq * 8);
#define PG8_SA(b, h) (((b) * 2 + (h)) * HTB)
#define PG8_SB(b, h) ((4 + (b) * 2 + (h)) * HTB)
#define PG8_STAGE(bufoff, gbase, voff) do { _Pragma("unroll") for (int _i = 0; _i < 2; ++_i) \
        __builtin_amdgcn_global_load_lds((const unsigned*)((const char*)(gbase) + (voff)[_i]), (LAS unsigned*)(lds + (bufoff) + ldsw + _i * 8192), 16, 0, 0); } while (0)
#define PG8_LDA(dst, b, h) do { _Pragma("unroll") for (int m = 0; m < 4; ++m) _Pragma("unroll") for (int k = 0; k < 2; ++k) dst[m][k] = *(const LAS bf16x8*)(lds + PG8_SA(b, h) + aoff + m * 2048 + k * 1024); } while (0)
#define PG8_LDB(dst, b, h) do { _Pragma("unroll") for (int n = 0; n < 2; ++n) _Pragma("unroll") for (int k = 0; k < 2; ++k) dst[n][k] = *(const LAS bf16x8*)(lds + PG8_SB(b, h) + boff + n * 2048 + k * 1024); } while (0)
#define PG8_MMA(ai, bj, At, Bt) do { __builtin_amdgcn_s_setprio(1); _Pragma("unroll") for (int m = 0; m < 4; ++m) _Pragma("unroll") for (int n = 0; n < 2; ++n) _Pragma("unroll") for (int k = 0; k < 2; ++k) \
        acc[ai][bj][m][n] = __builtin_amdgcn_mfma_f32_16x16x32_bf16(Bt[n][k], At[m][k], acc[ai][bj][m][n], 0, 0, 0); __builtin_amdgcn_s_setprio(0); } while (0)
#define PG8_WAIT_V(n) asm volatile("s_waitcnt vmcnt(" #n ")" ::: "memory")
#define PG8_WAIT_L(n) asm volatile("s_waitcnt lgkmcnt(" #n ")" ::: "memory")
#define PG8_BAR __builtin_amdgcn_s_barrier()
#define PG8_SCHED __builtin_amdgcn_sched_barrier(0)
    Unit cur, nxt; int ui = 0;
    if (!S.next(0, cur)) return;
    f32x4 acc[2][2][4][2];
#pragma unroll
    for (int a = 0; a < 2; ++a)
#pragma unroll
        for (int b = 0; b < 2; ++b)
#pragma unroll
            for (int m = 0; m < 4; ++m)
#pragma unroll
                for (int n = 0; n < 2; ++n) acc[a][b][m][n] = (f32x4){0.f, 0.f, 0.f, 0.f};
    bf16x8 At[4][2], B0[2][2], B1[2][2];
    const char* cA = cur.a; const char* cB = cur.b;
    PG8_STAGE(PG8_SB(0, 0), cB, voffB); PG8_STAGE(PG8_SB(0, 1), cB + hstepB, voffB); PG8_STAGE(PG8_SA(0, 0), cA, voffA); PG8_STAGE(PG8_SA(0, 1), cA + hstepA, voffA);
    if (wr == 1) PG8_BAR;
    PG8_WAIT_V(2); PG8_BAR;
    PG8_STAGE(PG8_SB(1, 0), cB + kstep, voffB); PG8_STAGE(PG8_SA(1, 0), cA + kstep, voffA); PG8_STAGE(PG8_SB(1, 1), cB + hstepB + kstep, voffB);
    PG8_WAIT_V(6); PG8_BAR;
    for (;;) {
        const bool has_next = S.next(ui + 1, nxt);
        const char* nA = has_next ? nxt.a : cA; const char* nB = has_next ? nxt.b : cB;
        for (int t = 0; t < nt; t += 2) {
            const bool last = (t == nt - 2);
            const char* a1 = cA + (size_t)(t + 1) * kstep;
            const char* a2 = last ? nA : cA + (size_t)(t + 2) * kstep; const char* b2 = last ? nB : cB + (size_t)(t + 2) * kstep;
            const char* a3 = a2 + kstep; const char* b3 = b2 + kstep;
            PG8_LDB(B0, 0, 0); PG8_LDB(B1, 0, 1); PG8_SCHED; PG8_LDA(At, 0, 0); PG8_STAGE(PG8_SA(1, 1), a1 + hstepA, voffA);
            PG8_WAIT_V(8); PG8_WAIT_L(0); PG8_BAR; PG8_MMA(0, 0, At, B0); PG8_MMA(0, 1, At, B1); PG8_BAR; PG8_SCHED;
            PG8_LDA(At, 0, 1); PG8_STAGE(PG8_SB(0, 0), b2, voffB); PG8_STAGE(PG8_SB(0, 1), b2 + hstepB, voffB); PG8_STAGE(PG8_SA(0, 0), a2, voffA);
            PG8_WAIT_V(8); PG8_WAIT_L(0); PG8_BAR; PG8_MMA(1, 0, At, B0); PG8_MMA(1, 1, At, B1); PG8_BAR; PG8_SCHED;
            PG8_LDB(B0, 1, 0); PG8_LDB(B1, 1, 1); PG8_SCHED; PG8_LDA(At, 1, 0); PG8_STAGE(PG8_SA(0, 1), a2 + hstepA, voffA);
            PG8_WAIT_V(8); PG8_WAIT_L(0); PG8_BAR; PG8_MMA(0, 0, At, B0); PG8_MMA(0, 1, At, B1); PG8_BAR; PG8_SCHED;
            PG8_LDA(At, 1, 1); PG8_STAGE(PG8_SB(1, 0), b3, voffB); PG8_STAGE(PG8_SB(1, 1), b3 + hstepB, voffB); PG8_STAGE(PG8_SA(1, 0), a3, voffA);
            PG8_WAIT_V(8); PG8_WAIT_L(0); PG8_BAR; PG8_MMA(1, 0, At, B0); PG8_MMA(1, 1, At, B1); PG8_BAR; PG8_SCHED;
        }
        if (wr == 0) PG8_BAR;
        E(acc, cur, wr, wc, fr, fq);
        if (!has_next) break;
#pragma unroll
        for (int a = 0; a < 2; ++a)
#pragma unroll
            for (int b = 0; b < 2; ++b)
#pragma unroll
                for (int m = 0; m < 4; ++m)
#pragma unroll
                    for (int n = 0; n < 2; ++n) acc[a][b][m][n] = (f32x4){0.f, 0.f, 0.f, 0.f};
        cur = nxt; cA = nA; cB = nB; ++ui;
        if (wr == 1) PG8_BAR;
    }
    PG8_WAIT_V(0);
    PG8_BAR;
#undef PG8_SA
#undef PG8_SB
#undef PG8_STAGE
#undef PG8_LDA
#undef PG8_LDB
#undef PG8_MMA
#undef PG8_WAIT_V
#undef PG8_WAIT_L
#undef PG8_BAR
#undef PG8_SCHED
}

struct SchedStd {
    const char* A; const char* Bt; size_t tsA, tsB; int nM, nN, nwg, G, c;
    __device__ void init(const void* A_, const void* Bt_, int M, int N, int lda, int ldb, int G_, int c_) { A = (const char*)A_; Bt = (const char*)Bt_; tsA = (size_t)BM * lda * 2; tsB = (size_t)BM * ldb * 2; nM = M / BM; nN = N / BM; nwg = nM * nN; G = G_; c = c_; }
    __device__ bool next(int i, Unit& u) const {
        const long L = (long)i * G + c; if (L >= nwg) return false;
        int wgid = (int)L; { const int q = nwg / 8, r = nwg % 8, xcd = wgid % 8, off = wgid / 8; wgid = (xcd < r ? xcd * (q + 1) : r * (q + 1) + (xcd - r) * q) + off; }
        const int nig = 8 * nN, gid = wgid / nig, fm = gid * 8, gsz = (nM - fm) < 8 ? (nM - fm) : 8;
        u.pm = fm + ((wgid % nig) % gsz); u.pn = (wgid % nig) / gsz; u.kind = 0; u.aux = 0;
        u.a = A + (size_t)u.pm * tsA; u.b = Bt + (size_t)u.pn * tsB; return true;
    }
};
struct SchedQKV {
    const char* H; const char* Wqk; const char* Wv; int G, c;
    __device__ bool next(int i, Unit& u) const {
        const long Ll = (long)i * G + c; if (Ll >= 800) return false;
        const int L = (int)Ll; const size_t ts = (size_t)BM * 1024 * 2; u.aux = 0;
        if (L < 512) { const int x = L & 7, off = L >> 3; u.kind = 0; u.pm = 8 * x + (off & 7); u.pn = off >> 3; }
        else if (L < 768) { const int l2 = L - 512, x = l2 & 7, off = l2 >> 3; u.kind = 1; u.pm = off & 3; u.pn = 8 * x + (off >> 2); }
        else if (L < 784) { const int l2 = L - 768; u.kind = 0; u.pm = 64 + (l2 & 3); u.pn = 4 + (l2 >> 2); }
        else { const int l2 = L - 784; u.kind = 1; u.pm = l2 & 3; u.pn = 64 + (l2 >> 2); }
        if (u.kind == 0) { u.a = H + (size_t)u.pm * ts; u.b = Wqk + (size_t)u.pn * ts; }
        else { u.a = Wv + (size_t)u.pm * ts; u.b = H + (size_t)u.pn * ts; }
        return true;
    }
};
struct SchedF1 {
    const char* CS; const char* H; int G, c;
    __device__ bool next(int i, Unit& u) const {
        const long Ll = (long)i * G + c; if (Ll >= 512) return false;
        const int L = (int)Ll; const int t = L & 15, b = (L >> 4) & 3, g = (L >> 6) & 3, ri = L >> 8;
        u.pm = ri; u.pn = t; u.kind = g; u.aux = b;
        u.a = CS + (size_t)ri * 256 * 256 * 2; u.b = H + ((size_t)(b * 4096 + 4 * t) * 1024 + g * 256) * 2; return true;
    }
};

typedef f32x4 Acc[2][2][4][2];
__device__ __forceinline__ u32x4 pack8(f32x4 v0, f32x4 v1) { u32x4 w; w.x = cvt_pk_bf16(v0[0], v0[1]); w.y = cvt_pk_bf16(v0[2], v0[3]); w.z = cvt_pk_bf16(v1[0], v1[1]); w.w = cvt_pk_bf16(v1[2], v1[3]); return w; }

struct EpiQKV { bf16_t* QK; bf16_t* VT; const float* gq; const float* gk;
    __device__ __forceinline__ void operator()(const Acc& acc, const Unit& u, int wr, int wc, int fr, int fq) const {
        if (u.kind == 0) {
            const bool isq = u.pn < 4; const float* gp = isq ? gq : gk; const float qs = isq ? 0.125f * LOG2E : 1.0f;
            f32x4 gv[2][2];
#pragma unroll
            for (int bj = 0; bj < 2; ++bj)
#pragma unroll
                for (int n = 0; n < 2; ++n) gv[bj][n] = *(const f32x4*)(gp + 32 * bj + 8 * fq + 4 * n) * qs;
#pragma unroll
            for (int ai = 0; ai < 2; ++ai)
#pragma unroll
                for (int m = 0; m < 4; ++m) {
                    const int row = u.pm * BM + ai * HALF + wr * 64 + m * 16 + fr;
                    float ss = 0.f;
#pragma unroll
                    for (int bj = 0; bj < 2; ++bj)
#pragma unroll
                        for (int n = 0; n < 2; ++n) { const f32x4 x = acc[ai][bj][m][n]; ss += (x[0] * x[0] + x[1] * x[1]) + (x[2] * x[2] + x[3] * x[3]); }
                    ss += __shfl_xor(ss, 16); ss += __shfl_xor(ss, 32);
                    const float rstd = rsqrtf(ss * (1.0f / 64.0f) + EPS);
                    bf16_t* rowp = QK + (size_t)row * 2048 + u.pn * 256 + wc * 64 + 8 * fq;
#pragma unroll
                    for (int bj = 0; bj < 2; ++bj) *(u32x4*)(rowp + 32 * bj) = pack8(acc[ai][bj][m][0] * rstd * gv[bj][0], acc[ai][bj][m][1] * rstd * gv[bj][1]);
                }
        } else {
#pragma unroll
            for (int ai = 0; ai < 2; ++ai)
#pragma unroll
                for (int m = 0; m < 4; ++m) {
                    const int row = u.pm * BM + ai * HALF + wr * 64 + m * 16 + fr;
                    bf16_t* rowp = VT + (size_t)row * MT + u.pn * 256 + wc * 32 + 8 * fq;
#pragma unroll
                    for (int bj = 0; bj < 2; ++bj) *(u32x4*)(rowp + bj * HALF) = pack8(acc[ai][bj][m][0], acc[ai][bj][m][1]);
                }
        }
    }
};
struct EpiRelu2 { bf16_t* O; int ldc;
    __device__ __forceinline__ void operator()(const Acc& acc, const Unit& u, int wr, int wc, int fr, int fq) const {
#pragma unroll
        for (int ai = 0; ai < 2; ++ai)
#pragma unroll
            for (int m = 0; m < 4; ++m) {
                const int row = u.pm * BM + ai * HALF + wr * 64 + m * 16 + fr;
                bf16_t* rowp = O + (size_t)row * ldc + u.pn * 256 + wc * 32 + 8 * fq;
#pragma unroll
                for (int bj = 0; bj < 2; ++bj) { f32x4 v0 = acc[ai][bj][m][0], v1 = acc[ai][bj][m][1];
#pragma unroll
                    for (int e = 0; e < 4; ++e) { const float a = fmaxf(v0[e], 0.f), b = fmaxf(v1[e], 0.f); v0[e] = a * a; v1[e] = b * b; }
                    *(u32x4*)(rowp + bj * HALF) = pack8(v0, v1); }
            }
    }
};
struct EpiRes { const float* base; float* out; const float* gate;
    __device__ __forceinline__ void operator()(const Acc& acc, const Unit& u, int wr, int wc, int fr, int fq) const {
        const int col0 = u.pn * 256 + wc * 32 + 8 * fq;
        const float* gp = gate + (size_t)(u.pm >> 4) * 6144 + col0;
        f32x4 gv[2][2];
#pragma unroll
        for (int bj = 0; bj < 2; ++bj)
#pragma unroll
            for (int n = 0; n < 2; ++n) gv[bj][n] = *(const f32x4*)(gp + bj * HALF + 4 * n);
#pragma unroll
        for (int ai = 0; ai < 2; ++ai)
#pragma unroll
            for (int m = 0; m < 4; ++m) {
                const size_t off = (size_t)(u.pm * BM + ai * HALF + wr * 64 + m * 16 + fr) * 1024 + col0;
#pragma unroll
                for (int bj = 0; bj < 2; ++bj)
#pragma unroll
                    for (int n = 0; n < 2; ++n) { const f32x4 bs = *(const f32x4*)(base + off + bj * HALF + 4 * n);
                        *(f32x4*)(out + off + bj * HALF + 4 * n) = bs + gv[bj][n] * acc[ai][bj][m][n]; }
            }
    }
};
struct EpiZ0 { bf16_t* Z0;
    __device__ __forceinline__ void operator()(const Acc& acc, const Unit& u, int wr, int wc, int fr, int fq) const {
        const int ri = u.pm, t = u.pn, g = u.kind, b = u.aux;
        bf16_t* p0 = Z0 + ((size_t)(((b * 4 + g) * 256 + wr * 64 + fr) * 64 + 4 * t + (wc >> 1))) * 128 + ri * 64 + 32 * (wc & 1) + 8 * fq;
#pragma unroll
        for (int ai = 0; ai < 2; ++ai)
#pragma unroll
            for (int m = 0; m < 4; ++m) {
#pragma unroll
                for (int bj = 0; bj < 2; ++bj)
                    *(u32x4*)(p0 + (size_t)(ai * HALF + m * 16) * 8192 + bj * 256) = pack8(acc[ai][bj][m][0], acc[ai][bj][m][1]);
                asm volatile("" ::: "memory");
            }
    }
};
}


#define XB_TMO      128
#define XB_XCNT(j)  (256  + 64 * (j))
#define XB_XSUB(j)  (1280 + 64 * (j))
#define XB_XGEN(j)  (2304 + 64 * (j))
#define XB_TOP      3328
#define XB_TOPGEN   3392
#define XCD_BAR_WORDS 3456
#define XB_SPIN_CAP (1u << 18)
__device__ __forceinline__ unsigned xb_ld(unsigned* p)              { return __hip_atomic_load(p, __ATOMIC_RELAXED, __HIP_MEMORY_SCOPE_AGENT); }
__device__ __forceinline__ unsigned xb_add(unsigned* p, unsigned v) { return __hip_atomic_fetch_add(p, v, __ATOMIC_RELAXED, __HIP_MEMORY_SCOPE_AGENT); }
__device__ __forceinline__ unsigned xb_xcc_id() { return (unsigned)__builtin_amdgcn_s_getreg((3 << 11) | 20) & 0xFu; }
#define XB_SPIN(cond, bar) do { unsigned _sp = 0; while (cond) { __builtin_amdgcn_s_sleep(1); \
    if ((++_sp & 255u) == 0u) { if (xb_ld(&(bar)[XB_TMO])) break; if (_sp > XB_SPIN_CAP) { atomicAdd(&(bar)[XB_TMO], 1u); break; } } } } while (0)
struct XcdBarrier { unsigned* bar; unsigned x; volatile LAS unsigned* st; };
__device__ __forceinline__ XcdBarrier xcd_barrier_post(unsigned* bar, volatile LAS unsigned* st) {
    XcdBarrier b; b.bar = bar; b.x = xb_xcc_id(); b.st = st;
    if (threadIdx.x == 0) (void)xb_add(&bar[XB_XCNT(b.x)], 1u);
    return b;
}
__device__ __forceinline__ void xcd_barrier_complete(unsigned* bar, unsigned x, unsigned& nloc, unsigned& nx) {
    const unsigned G = gridDim.x * gridDim.y * gridDim.z;
    unsigned sum, cnt, mine, sp = 0u;
    for (;;) {
        sum = 0u; cnt = 0u; mine = 0u;
#pragma unroll
        for (unsigned j = 0; j < 16; ++j) { const unsigned c = xb_ld(&bar[XB_XCNT(j)]); sum += c; cnt += (c > 0u) ? 1u : 0u; mine = (j == x) ? c : mine; }
        if (sum == G) break;
        __builtin_amdgcn_s_sleep(1);
        if ((++sp & 255u) == 0u) { if (xb_ld(&bar[XB_TMO])) break; if (sp > XB_SPIN_CAP) { atomicAdd(&bar[XB_TMO], 1u); break; } }
    }
    nloc = mine > 0u ? mine : 1u; nx = cnt > 0u ? cnt : 1u;
}
__device__ __forceinline__ void xcd_barrier(const XcdBarrier& b) {
    asm volatile("s_waitcnt vmcnt(0)" ::: "memory");
    __syncthreads();
    if (threadIdx.x == 0) {
        unsigned* bar = b.bar;
        __builtin_amdgcn_s_waitcnt(0);
        unsigned nloc = b.st[0], nx = b.st[1];
        if (nloc == 0u) { xcd_barrier_complete(bar, b.x, nloc, nx); b.st[0] = nloc; b.st[1] = nx; }
        const unsigned old = xb_add(&bar[XB_XSUB(b.x)], 1u);
        const unsigned gen = old / nloc;
        if (old + 1u == (gen + 1u) * nloc) {
            __builtin_amdgcn_fence(__ATOMIC_RELEASE, "agent");
            asm volatile("s_waitcnt vmcnt(0)" ::: "memory");
            const unsigned og = xb_add(&bar[XB_TOP], 1u);
            const unsigned tg = og / nx;
            if (og + 1u == (tg + 1u) * nx) xb_add(&bar[XB_TOPGEN], 1u);
            else XB_SPIN(xb_ld(&bar[XB_TOPGEN]) == tg, bar);
            __builtin_amdgcn_fence(__ATOMIC_ACQUIRE, "agent");
            xb_add(&bar[XB_XGEN(b.x)], 1u);
            asm volatile("s_waitcnt vmcnt(0)" ::: "memory");
        } else {
            XB_SPIN(xb_ld(&bar[XB_XGEN(b.x)]) == gen, bar);
            __builtin_amdgcn_fence(__ATOMIC_ACQUIRE, "agent");
            asm volatile("s_waitcnt vmcnt(0)" ::: "memory");
        }
    }
    __syncthreads();
}
__device__ __forceinline__ void p0_mods_unit(const float* c, const float* cctx, const float* ada_w, const float* ada_b, float* mods, LAS unsigned char* lds, int unit) {
    LAS float* s = (LAS float*)lds;
    LAS float* red = s + 5 * 1024;
    int tid = threadIdx.x; asm volatile("" : "+v"(tid));
    for (int i = tid; i < 5 * 1024; i += 512) { const int v = i >> 10, k = i & 1023; const float x = v < 4 ? c[v * 1024 + k] : cctx[k]; s[i] = x / (1.0f + __expf(-x)); }
    __syncthreads();
    const int l = unit / 96, col0 = (unit % 96) * 64, kc = tid >> 6, cl = tid & 63;
    const float* w = ada_w + (size_t)l * 1024 * 6144 + col0 + cl;
    float a0 = 0.f, a1 = 0.f, a2 = 0.f, a3 = 0.f, a4 = 0.f;
    for (int k = kc * 128; k < kc * 128 + 128; k += 8) {
        float wv[8];
#pragma unroll
        for (int j = 0; j < 8; ++j) wv[j] = w[(size_t)(k + j) * 6144];
#pragma unroll
        for (int j = 0; j < 8; ++j) { a0 += s[k + j] * wv[j]; a1 += s[1024 + k + j] * wv[j]; a2 += s[2048 + k + j] * wv[j]; a3 += s[3072 + k + j] * wv[j]; a4 += s[4096 + k + j] * wv[j]; }
    }
    red[(kc * 5 + 0) * 64 + cl] = a0; red[(kc * 5 + 1) * 64 + cl] = a1; red[(kc * 5 + 2) * 64 + cl] = a2; red[(kc * 5 + 3) * 64 + cl] = a3; red[(kc * 5 + 4) * 64 + cl] = a4;
    __syncthreads();
    if (tid < 320) { const int v = tid >> 6, cc = tid & 63; float t = 0.f;
#pragma unroll
        for (int kk = 0; kk < 8; ++kk) t += red[(kk * 5 + v) * 64 + cc];
        mods[(size_t)(l * 5 + v) * 6144 + col0 + cc] = t + ada_b[l * 6144 + col0 + cc]; }
    __syncthreads();
}

__device__ __forceinline__ void p0_transpose_item(const float* W, int K, int N, bf16_t* WT, bf16_t* WT2, int mode, LAS float* scr, int item, int lane) {
    const int nblk = N / 32, kb = item / nblk, nb = item % nblk, k0 = 64 * kb, n0 = 32 * nb;
#pragma unroll 8
    for (int i = 0; i < 32; ++i) { const int kk = 2 * i + (lane >> 5); scr[kk * 33 + (lane & 31)] = W[(size_t)(k0 + kk) * N + n0 + (lane & 31)]; }
    asm volatile("s_waitcnt lgkmcnt(0)" ::: "memory");
    const int cch = lane & 7;
#pragma unroll
    for (int j = 0; j < 4; ++j) { const int n = (lane >> 3) + 8 * j; const LAS float* s = scr + (8 * cch) * 33 + n;
        u32x4 o; o.x = cvt_pk_bf16(s[0 * 33], s[1 * 33]); o.y = cvt_pk_bf16(s[2 * 33], s[3 * 33]); o.z = cvt_pk_bf16(s[4 * 33], s[5 * 33]); o.w = cvt_pk_bf16(s[6 * 33], s[7 * 33]);
        const int ng = n0 + n; bf16_t* dst;
        if (mode == 0) dst = WT + (size_t)ng * K;
        else if (ng < 2048) { const int pn = ng >> 8, hh = (ng >> 6) & 3, d = ng & 63; const int tpos = (d >> 5) * 128 + hh * 32 + (d & 31); dst = WT + (size_t)(pn * 256 + tpos) * K; }
        else dst = WT2 + (size_t)(ng - 2048) * K;
        *(u32x4*)(dst + k0 + 8 * cch) = o; }
    asm volatile("s_waitcnt lgkmcnt(0)" ::: "memory");
}

__device__ __forceinline__ float wave_sum(float v) {
#pragma unroll
    for (int o = 1; o < 64; o <<= 1) v += __shfl_xor(v, o);
    return v;
}
__device__ __forceinline__ void norm_rows(const float* xlat, const float* xctx, int nrows, const float* g, const float* modsl, int sh_off, int sc_off, bf16_t* H, int gw, int NGW, int lane) {
    f32x4 gv[4];
#pragma unroll
    for (int j = 0; j < 4; ++j) gv[j] = *(const f32x4*)(g + lane * 4 + 256 * j);
    for (int row = gw; row < nrows; row += NGW) {
        const float* src = row < ML ? xlat + (size_t)row * 1024 : xctx + (size_t)(row - ML) * 1024;
        const int v = row < ML ? (row >> 12) : 4;
        const float* mp = modsl + (size_t)v * 6144;
        f32x4 x[4]; float ss = 0.f;
#pragma unroll
        for (int j = 0; j < 4; ++j) { x[j] = *(const f32x4*)(src + lane * 4 + 256 * j); ss += (x[j][0] * x[j][0] + x[j][1] * x[j][1]) + (x[j][2] * x[j][2] + x[j][3] * x[j][3]); }
        const float rstd = rsqrtf(wave_sum(ss) * (1.0f / 1024.0f) + EPS);
#pragma unroll
        for (int j = 0; j < 4; ++j) {
            const f32x4 sh = *(const f32x4*)(mp + sh_off + lane * 4 + 256 * j), sc = *(const f32x4*)(mp + sc_off + lane * 4 + 256 * j);
            const f32x4 y = (x[j] * rstd * gv[j]) * (sc + 1.0f) + sh;
            u32x2 w; w.x = cvt_pk_bf16(y[0], y[1]); w.y = cvt_pk_bf16(y[2], y[3]);
            *(u32x2*)(H + (size_t)row * 1024 + lane * 4 + 256 * j) = w;
        }
    }
}

template <bool MASKED>
__device__ __forceinline__ void attn_block(const LAS bf16_t* Ks, const LAS bf16_t* Vs, int kcol0, int fr, int g, const bf16x8 (&Qf)[2], f32x4 (&acc)[4], float& lsum,
                                           const LAS float* rp, int base, int dX, int eX, float Mb) {
    bf16x8 KX[2], KY[2];
#pragma unroll
    for (int kk = 0; kk < 2; ++kk) { KX[kk] = *(const LAS bf16x8*)(Ks + (kcol0 + fr) * 72 + kk * 32 + g * 8); KY[kk] = *(const LAS bf16x8*)(Ks + (kcol0 + 16 + fr) * 72 + kk * 32 + g * 8); }
    s16x4 VX[4], VY[4];
#pragma unroll
    for (int db = 0; db < 4; ++db) { VX[db] = *(const LAS s16x4*)(Vs + (16 * db + fr) * 72 + kcol0 + 4 * g); VY[db] = *(const LAS s16x4*)(Vs + (16 * db + fr) * 72 + kcol0 + 16 + 4 * g); }
    f32x4 sX = mfma16(KX[0], Qf[0], (f32x4){0.f, 0.f, 0.f, 0.f}); sX = mfma16(KX[1], Qf[1], sX);
    f32x4 sY = mfma16(KY[0], Qf[0], (f32x4){0.f, 0.f, 0.f, 0.f}); sY = mfma16(KY[1], Qf[1], sY);
    f32x4 pX, pY;
    if (MASKED) {
#pragma unroll
        for (int ii = 0; ii < 4; ++ii) {
            const int dcx = min(max(dX + ii, 0), 30), dcy = min(max(dX + 16 + ii, 0), 30);
            const float bx = rp[base + dcx], by = rp[base + dcy];
            const bool okx = (unsigned)(eX + ii) < 16u, oky = (unsigned)(eX + 16 + ii) < 16u;
            pX[ii] = okx ? __builtin_amdgcn_exp2f(sX[ii] + bx - Mb) : 0.f;
            pY[ii] = oky ? __builtin_amdgcn_exp2f(sY[ii] + by - Mb) : 0.f;
        }
    } else {
#pragma unroll
        for (int ii = 0; ii < 4; ++ii) { pX[ii] = __builtin_amdgcn_exp2f(sX[ii] - Mb); pY[ii] = __builtin_amdgcn_exp2f(sY[ii] - Mb); }
    }
    lsum += ((pX[0] + pX[1]) + (pX[2] + pX[3])) + ((pY[0] + pY[1]) + (pY[2] + pY[3]));
    const u32x4 pw = pg8::pack8(pX, pY);
    const bf16x8 Pf = __builtin_bit_cast(bf16x8, pw);
#pragma unroll
    for (int db = 0; db < 4; ++db) {
        bf16x8 Vf; Vf[0] = VX[db][0]; Vf[1] = VX[db][1]; Vf[2] = VX[db][2]; Vf[3] = VX[db][3]; Vf[4] = VY[db][0]; Vf[5] = VY[db][1]; Vf[6] = VY[db][2]; Vf[7] = VY[db][3];
        acc[db] = mfma16(Vf, Pf, acc[db]);
    }
}
__device__ __forceinline__ void attn_phase(const bf16_t* QK, const bf16_t* VT, bf16_t* O, const float* rpb, const float* sbound, LAS unsigned char* lds, int G, int c) {
    constexpr int RP_BYTES = 30720, TILE_B = 64 * 72 * 2, SLOT_B = 2 * TILE_B, NSTEP = 13;
    LAS float* rp = (LAS float*)lds;
    int tid = threadIdx.x; asm volatile("" : "+v"(tid));
    const int lane = tid & 63, wid = __builtin_amdgcn_readfirstlane(tid >> 6), fr = lane & 15, g = lane >> 4;
    for (int i = tid; i < 16 * 465; i += 512) rp[i] = rpb[i] * LOG2E;
    const float Mb = *sbound;
    const int nunits = (2048 - c + G - 1) / G;
    const int NT = nunits * NSTEP;
    const int trow = tid >> 3, tch = tid & 7;
    const int ldsoff = (trow * 72 + tch * 8) * 2;
#define ATT_DEC(L_, b_, h_, rp_) do { const int x_ = (L_) & 7, q_ = (L_) >> 3; rp_ = q_ & 31; const int bh_ = 8 * (q_ >> 5) + x_; b_ = bh_ >> 4; h_ = bh_ & 15; } while (0)
#define ATT_GLOAD(T_, pk_, pv_) do { const int u_ = (T_) / NSTEP, t_ = (T_) - u_ * NSTEP; int b_, h_, rp_; ATT_DEC(u_ * G + c, b_, h_, rp_); \
        const int rs0_ = min(max(2 * rp_ - 4, 0), 56); const int tok0_ = t_ < 9 ? b_ * 4096 + min(rs0_ + t_, 63) * 64 : ML + b_ * 256 + 64 * (t_ - 9); \
        pk_ = *(const u32x4*)(QK + (size_t)(tok0_ + trow) * 2048 + 1024 + h_ * 64 + tch * 8); \
        pv_ = *(const u32x4*)(VT + (size_t)(h_ * 64 + trow) * MT + tok0_ + tch * 8); } while (0)
#define ATT_LWRITE(slot_, pk_, pv_) do { *(LAS u32x4*)(lds + RP_BYTES + (slot_) * SLOT_B + ldsoff) = pk_; *(LAS u32x4*)(lds + RP_BYTES + (slot_) * SLOT_B + TILE_B + ldsoff) = pv_; } while (0)
    u32x4 pk, pv;
    ATT_GLOAD(0, pk, pv); ATT_LWRITE(0, pk, pv);
    if (NT > 1) ATT_GLOAD(1, pk, pv);
    __syncthreads();
    int b = 0, h = 0, rpair = 0, r = 0, rs0 = 0, rsr = 0, qrow = 0, eX = 0, dX = 0;
    const int j = wid & 3, w0 = (j == 0) ? 0 : (j == 1) ? 8 : (j == 2) ? 24 : 32;
    bf16x8 Qf[2]; f32x4 acc[4]; float lsum = 0.f;
    int t = 0, u = 0;
    for (int T = 0; T < NT; ++T) {
        const int slot = T & 1;
        if (T + 1 < NT) ATT_LWRITE(slot ^ 1, pk, pv);
        if (T + 2 < NT) ATT_GLOAD(T + 2, pk, pv);
        if (t == 0) {
            ATT_DEC(u * G + c, b, h, rpair);
            r = 2 * rpair + (wid >> 2); rs0 = min(max(2 * rpair - 4, 0), 56); rsr = min(max(r - 4, 0), 56);
            const int cq = 16 * j + fr, cs = min(max(cq - 8, 0), 48);
            qrow = b * 4096 + r * 64 + cq; eX = w0 + 4 * g - cs; dX = w0 + 4 * g - cq + 15;
#pragma unroll
            for (int kk = 0; kk < 2; ++kk) Qf[kk] = *(const bf16x8*)(QK + (size_t)qrow * 2048 + h * 64 + 32 * kk + 8 * g);
#pragma unroll
            for (int db = 0; db < 4; ++db) acc[db] = (f32x4){0.f, 0.f, 0.f, 0.f};
            lsum = 0.f;
        }
        const LAS bf16_t* Ks = (const LAS bf16_t*)(lds + RP_BYTES + slot * SLOT_B);
        const LAS bf16_t* Vs = (const LAS bf16_t*)(lds + RP_BYTES + slot * SLOT_B + TILE_B);
        if (t < 9) {
            const int kr = rs0 + t, i = kr - rsr;
            if (i >= 0 && i < 8) attn_block<true>(Ks, Vs, w0, fr, g, Qf, acc, lsum, rp, h * 465 + (kr - r + 7) * 31, dX, eX, Mb);
        } else {
            attn_block<false>(Ks, Vs, 0, fr, g, Qf, acc, lsum, rp, 0, 0, 0, Mb);
            attn_block<false>(Ks, Vs, 32, fr, g, Qf, acc, lsum, rp, 0, 0, 0, Mb);
        }
        if (t == NSTEP - 1) {
            float ls = lsum; ls += __shfl_xor(ls, 16); ls += __shfl_xor(ls, 32);
            const float inv = 1.0f / ls;
            bf16_t* op = O + (size_t)qrow * 1024 + h * 64 + 4 * g;
#pragma unroll
            for (int db = 0; db < 4; ++db) { u32x2 w; w.x = cvt_pk_bf16(acc[db][0] * inv, acc[db][1] * inv); w.y = cvt_pk_bf16(acc[db][2] * inv, acc[db][3] * inv); *(u32x2*)(op + 16 * db) = w; }
            t = 0; ++u;
        } else ++t;
        __syncthreads();
    }
#undef ATT_DEC
#undef ATT_GLOAD
#undef ATT_LWRITE
}

__device__ __forceinline__ void s1_phase(const bf16_t* Z0, const bf16_t* Dg, bf16_t* Z1, LAS unsigned char* lds, int gw, int NGW) {
    constexpr int DP = 136;
    LAS bf16_t* Dl = (LAS bf16_t*)lds;
    int tid = threadIdx.x; asm volatile("" : "+v"(tid));
    const int lane = tid & 63, fr = lane & 15, g = lane >> 4;
    for (int i = tid; i < 128 * 16; i += 512) { const int row = i >> 4, ch = i & 15; *(LAS u32x4*)(Dl + row * DP + ch * 8) = *(const u32x4*)(Dg + row * 128 + ch * 8); }
    __syncthreads();
    for (int colM = gw; colM < 4096; colM += NGW) {
        bf16x8 A[4][4];
#pragma unroll
        for (int ib = 0; ib < 4; ++ib)
#pragma unroll
            for (int kb = 0; kb < 4; ++kb) A[ib][kb] = *(const bf16x8*)(Z0 + ((size_t)colM * 64 + 16 * ib + fr) * 128 + 32 * kb + 8 * g);
#pragma unroll 2
        for (int jb = 0; jb < 8; ++jb) {
            bf16x8 Bf[4];
#pragma unroll
            for (int kb = 0; kb < 4; ++kb) Bf[kb] = *(const LAS bf16x8*)(Dl + (16 * jb + fr) * DP + 32 * kb + 8 * g);
            const int n = 16 * jb + fr, ka = n >> 1, rip = n & 1;
#pragma unroll
            for (int ib = 0; ib < 4; ++ib) {
                f32x4 a = (f32x4){0.f, 0.f, 0.f, 0.f};
#pragma unroll
                for (int kb = 0; kb < 4; ++kb) a = mfma16(A[ib][kb], Bf[kb], a);
                u32x2 w; w.x = cvt_pk_bf16(a[0], a[1]); w.y = cvt_pk_bf16(a[2], a[3]);
                *(u32x2*)(Z1 + (((size_t)ka * 4096 + colM) * 2 + rip) * 64 + 16 * ib + 4 * g) = w;
            }
        }
    }
    __syncthreads();
}
__device__ __forceinline__ void s2_phase(const bf16_t* Z1, const bf16_t* Eg, bf16_t* F, int gw, int NGW, int lane) {
    const int fr = lane & 15, g = lane >> 4;
    for (int it = gw; it < 2048; it += NGW) {
        const int ka = it & 63, chunk = it >> 6;
        bf16x8 Bf[4][4];
#pragma unroll
        for (int jb = 0; jb < 4; ++jb)
#pragma unroll
            for (int kb = 0; kb < 4; ++kb) Bf[jb][kb] = *(const bf16x8*)(Eg + ((size_t)ka * 64 + 16 * jb + fr) * 128 + 32 * kb + 8 * g);
        for (int ib = 0; ib < 8; ++ib) {
            const int colM0 = chunk * 128 + ib * 16;
            bf16x8 A[4];
#pragma unroll
            for (int kb = 0; kb < 4; ++kb) A[kb] = *(const bf16x8*)(Z1 + ((size_t)ka * 4096 + colM0 + fr) * 128 + 32 * kb + 8 * g);
            const int cm = colM0 + 4 * g, b = cm >> 10, ch = cm & 1023;
#pragma unroll
            for (int jb = 0; jb < 4; ++jb) {
                f32x4 a = (f32x4){0.f, 0.f, 0.f, 0.f};
#pragma unroll
                for (int kb = 0; kb < 4; ++kb) a = mfma16(A[kb], Bf[jb][kb], a);
                const int kbk = 16 * jb + fr;
                u32x2 w; w.x = cvt_pk_bf16(a[0], a[1]); w.y = cvt_pk_bf16(a[2], a[3]);
                *(u32x2*)(F + ((size_t)b * 4096 + ka + 64 * kbk) * 1024 + ch) = w;
            }
        }
    }
}


#ifndef MK_DEBUG
#define MK_DEBUG 0
#endif
__device__ __forceinline__ void dbg_scan16(const bf16_t* p, size_t n, unsigned* flags, unsigned bit, int gt, int NT) {
    bool bad = false; for (size_t i = gt; i < n; i += NT) bad |= ((p[i] & 0x7f80u) == 0x7f80u);
    if (bad) atomicOr(flags, 1u << bit);
}
__device__ __forceinline__ void dbg_scan32(const float* p, size_t n, unsigned* flags, unsigned bit, int gt, int NT) {
    bool bad = false; for (size_t i = gt; i < n; i += NT) bad |= ((__float_as_uint(p[i]) & 0x7f800000u) == 0x7f800000u);
    if (bad) atomicOr(flags, 1u << bit);
}
struct Args { const float* in[15]; float* out; unsigned char* ws; int ph_lo, ph_hi; };
static_assert(sizeof(Args) == 15 * 8 + 8 + 8 + 8, "no padding");

__global__ void __launch_bounds__(512, 2) fwd_kernel(Args args) {
    extern __shared__ __attribute__((aligned(16))) unsigned char lds_raw[];
    LAS unsigned char* lds = (LAS unsigned char*)lds_raw;
    const int G = gridDim.x, c = blockIdx.x;
    const int vcu = (G % 8 == 0) ? (c % 8) * (G / 8) + c / 8 : c;
    const int NGW = G * 8;
#define PHASE_IDS int tid_ = threadIdx.x; asm volatile("" : "+v"(tid_)); const int lane = tid_ & 63, wid = __builtin_amdgcn_readfirstlane(tid_ >> 6); const int gw = vcu * 8 + wid; (void)lane; (void)gw
    unsigned char* ws = args.ws;
    const float* x = args.in[0]; const float* cvec = args.in[1]; const float* ctx = args.in[2]; const float* cctx = args.in[3];
    const float* ada_w = args.in[4]; const float* ada_b = args.in[5]; const float* norm_g = args.in[6];
    const float* wqkv = args.in[7]; const float* wo = args.in[8]; const float* gq = args.in[9]; const float* gk = args.in[10]; const float* rpb = args.in[11];
    const float* fw = args.in[12]; const float* w1 = args.in[13]; const float* w2 = args.in[14];
    float* out = args.out;
    float* mods = (float*)(ws + WS_MODS); float* sbound = (float*)(ws + WS_SB);
    bf16_t* CS = (bf16_t*)(ws + WS_CS); bf16_t* Dt = (bf16_t*)(ws + WS_D); bf16_t* Et = (bf16_t*)(ws + WS_E);
    bf16_t* WQK = (bf16_t*)(ws + WS_WQK); bf16_t* WV = (bf16_t*)(ws + WS_WV); bf16_t* WO = (bf16_t*)(ws + WS_WO); bf16_t* FWt = (bf16_t*)(ws + WS_FW);
    bf16_t* W1t = (bf16_t*)(ws + WS_W1); bf16_t* W2t = (bf16_t*)(ws + WS_W2);
    bf16_t* H = (bf16_t*)(ws + WS_H); bf16_t* QK = (bf16_t*)(ws + WS_QK); bf16_t* VT = (bf16_t*)(ws + WS_VT); bf16_t* O = (bf16_t*)(ws + WS_O);
    bf16_t* HMID = (bf16_t*)(ws + WS_HMID); bf16_t* Z0 = (bf16_t*)(ws + WS_Z0); bf16_t* Z1 = (bf16_t*)(ws + WS_Z1); bf16_t* Fb = (bf16_t*)(ws + WS_F);
    const int lo = args.ph_lo, hi = args.ph_hi;
    cg::grid_group grid = cg::this_grid();
#define IN(k) (lo <= (k) && (k) < hi)
#ifndef REP_SYNC
#define REP_SYNC 1
#endif
#ifndef REP_NORM
#define REP_NORM 1
#endif
#ifndef REP_S12
#define REP_S12 1
#endif
#ifndef REP_P0
#define REP_P0 1
#endif
#ifndef USE_XB
#define USE_XB 1
#endif
#define SEAM(k) do { if (IN(k) && IN((k) + 1)) { for (int r_ = 0; r_ < REP_SYNC; ++r_) { if (!USE_XB || (k) == 0) grid.sync(); else xcd_barrier(xbar); } } } while (0)
    { volatile LAS unsigned* st_ = (volatile LAS unsigned*)(lds + LDS_BYTES - 64); if (threadIdx.x < 2) st_[threadIdx.x] = 0u; __syncthreads(); }
    XcdBarrier xbar; xbar.bar = (unsigned*)(ws + WS_BAR); xbar.x = 0; xbar.st = (volatile LAS unsigned*)(lds + LDS_BYTES - 64);
    if (USE_XB && hi - lo > 1) xbar = xcd_barrier_post((unsigned*)(ws + WS_BAR), (volatile LAS unsigned*)(lds + LDS_BYTES - 64));

    unsigned* dflags = (unsigned*)(ws + WS_SB + 256);
#define DBG16(k, bit, p, n) do { if (MK_DEBUG && IN(k)) { int t_ = threadIdx.x; asm volatile("" : "+v"(t_)); dbg_scan16(p, n, dflags, bit, (vcu * 512) + t_, G * 512); } } while (0)
#define DBG32(k, bit, p, n) do { if (MK_DEBUG && IN(k)) { int t_ = threadIdx.x; asm volatile("" : "+v"(t_)); dbg_scan32(p, n, dflags, bit, (vcu * 512) + t_, G * 512); } } while (0)
    if (IN(0)) {
        PHASE_IDS;
        if (MK_DEBUG && c == 0 && tid_ == 0) *dflags = 0u;
        for (int r0_ = 0; r0_ < REP_P0; ++r0_) {
        for (int u = c; u < 192; u += G) p0_mods_unit(cvec, cctx, ada_w, ada_b, mods, lds, u);
        __syncthreads();
        {
            LAS float* scr = (LAS float*)(lds + wid * 16384);
            constexpr int I_QKV = 16 * 96, I_SQ = 16 * 32, I_1 = 16 * 128, I_2 = 64 * 32;
            constexpr int NITEMS = I_QKV + 2 * I_SQ + 2 * I_1 + 2 * I_2;
            for (int it = NITEMS - 1 - gw; it >= 0; it -= NGW) {
                int r = it;
                if (r < I_QKV) { p0_transpose_item(wqkv, 1024, 3072, WQK, WV, 1, scr, r, lane); continue; } r -= I_QKV;
                if (r < I_SQ) { p0_transpose_item(wo, 1024, 1024, WO, nullptr, 0, scr, r, lane); continue; } r -= I_SQ;
                if (r < I_SQ) { p0_transpose_item(fw, 1024, 1024, FWt, nullptr, 0, scr, r, lane); continue; } r -= I_SQ;
                if (r < 2 * I_1) { const int l = r / I_1; p0_transpose_item(w1 + (size_t)l * 1024 * 4096, 1024, 4096, W1t + (size_t)l * 4096 * 1024, nullptr, 0, scr, r % I_1, lane); continue; } r -= 2 * I_1;
                { const int l = r / I_2; p0_transpose_item(w2 + (size_t)l * 4096 * 1024, 4096, 1024, W2t + (size_t)l * 1024 * 4096, nullptr, 0, scr, r % I_2, lane); }
            }
        }
        {
            const int gt = gw * 64 + lane, NT = NGW * 64;
            for (int i = gt; i < 512 * 256; i += NT) { const int m = i >> 8, cc = i & 255, ri = m >> 8, k2 = m & 255; float sn, cs; sincospif(2.0f * (float)((cc * k2) & 255) / 256.0f, &sn, &cs);
                const float v = (ri == 0 ? cs : -sn) * (1.0f / 16.0f); CS[i] = (bf16_t)(cvt_pk_bf16(v, 0.f) & 0xffffu); }
            for (int i = gt; i < 128 * 128; i += NT) { const int n = i >> 7, kp = i & 127, ka = n >> 1, rip = n & 1, ri = kp >> 6, a = kp & 63; float sn, cs; sincospif(2.0f * (float)((a * ka) & 63) / 64.0f, &sn, &cs);
                const float v = (rip == 0 ? (ri == 0 ? cs : sn) : (ri == 0 ? -sn : cs)) * 0.125f; Dt[i] = (bf16_t)(cvt_pk_bf16(v, 0.f) & 0xffffu); }
            for (int i = gt; i < 64 * 64 * 128; i += NT) { const int kp = i & 127, kbk = (i >> 7) & 63, ka = i >> 13, rip = kp >> 6, bp = kp & 63; float sn, cs; sincospif(2.0f * (float)((bp * (ka + 64 * kbk)) & 4095) / 4096.0f, &sn, &cs);
                const float v = (rip == 0 ? cs : sn) * 0.125f; Et[i] = (bf16_t)(cvt_pk_bf16(v, 0.f) & 0xffffu); }
        }
        if (c == G - 1 && wid == 7) {
            float mq = fabsf(gq[lane]), mk = fabsf(gk[lane]), mr = 0.f;
            for (int i = lane; i < 16 * 465; i += 64) mr = fmaxf(mr, fabsf(rpb[i]));
#pragma unroll
            for (int o = 1; o < 64; o <<= 1) { mq = fmaxf(mq, __shfl_xor(mq, o)); mk = fmaxf(mk, __shfl_xor(mk, o)); mr = fmaxf(mr, __shfl_xor(mr, o)); }
            if (lane == 0) *sbound = (8.0f * mq * mk + mr) * LOG2E;
        }
        __syncthreads();
        }
    }
    SEAM(0);
    if (IN(1)) { PHASE_IDS; for (int r_ = 0; r_ < REP_NORM; ++r_) norm_rows(x, ctx, MT, norm_g, mods, 0, 1024, H, gw, NGW, lane); }
    SEAM(1);
    DBG16(2, 0, H, (size_t)MT * 1024);
    if (IN(2)) { pg8::SchedQKV S{(const char*)H, (const char*)WQK, (const char*)WV, G, c}; pg8::EpiQKV E{QK, VT, gq, gk};
        pg8::gemm_phase<pg8::EpiQKV, pg8::SchedQKV, false>(lds, 1024, 1024, 1024, S, E); }
    SEAM(2);
    DBG16(3, 1, QK, (size_t)ML * 2048); DBG16(3, 2, VT, (size_t)1024 * MT); DBG32(3, 13, mods, (size_t)10 * 6144);
#ifndef REP_ATT
#define REP_ATT 1
#endif
    if (IN(3)) { for (int rep = 0; rep < REP_ATT; ++rep) attn_phase(QK, VT, O, rpb, sbound, lds, G, c); }
    SEAM(3);
    DBG16(4, 3, O, (size_t)ML * 1024);
    if (IN(4)) { pg8::SchedStd S; S.init(O, WO, ML, 1024, 1024, 1024, G, c); pg8::EpiRes E{x, out, mods + 2048};
        pg8::gemm_phase<pg8::EpiRes, pg8::SchedStd, false>(lds, 1024, 1024, 1024, S, E); }
    SEAM(4);
    DBG32(5, 4, out, (size_t)ML * 1024);
    if (IN(5)) { PHASE_IDS; for (int r_ = 0; r_ < REP_NORM; ++r_) norm_rows(out, out, ML, norm_g + 1024, mods, 3072, 4096, H, gw, NGW, lane); }
    SEAM(5);
    if (IN(6)) { pg8::SchedStd S; S.init(H, W1t, ML, 4096, 1024, 1024, G, c); pg8::EpiRelu2 E{HMID, 4096};
        pg8::gemm_phase<pg8::EpiRelu2, pg8::SchedStd, false>(lds, 1024, 1024, 1024, S, E); }
    SEAM(6);
    DBG16(7, 5, HMID, (size_t)ML * 4096);
    if (IN(7)) { pg8::SchedStd S; S.init(HMID, W2t, ML, 1024, 4096, 4096, G, c); pg8::EpiRes E{out, out, mods + 5120};
        pg8::gemm_phase<pg8::EpiRes, pg8::SchedStd, false>(lds, 4096, 4096, 4096, S, E); }
    SEAM(7);
    const float* mods1 = mods + 5 * 6144;
    DBG32(8, 6, out, (size_t)ML * 1024);
    if (IN(8)) { PHASE_IDS; for (int r_ = 0; r_ < REP_NORM; ++r_) norm_rows(out, out, ML, norm_g + 2048, mods1, 0, 1024, H, gw, NGW, lane); }
    SEAM(8);
    if (IN(9)) { pg8::SchedF1 S{(const char*)CS, (const char*)H, G, c}; pg8::EpiZ0 E{Z0};
        pg8::gemm_phase<pg8::EpiZ0, pg8::SchedF1, true>(lds, 256, 256, 1024, S, E); }
    SEAM(9);
    DBG16(10, 7, Z0, (size_t)262144 * 128);
    if (IN(10)) { PHASE_IDS; for (int r_ = 0; r_ < REP_S12; ++r_) s1_phase(Z0, Dt, Z1, lds, gw, NGW); }
    SEAM(10);
    DBG16(11, 8, Z1, (size_t)262144 * 128);
    if (IN(11)) { PHASE_IDS; for (int r_ = 0; r_ < REP_S12; ++r_) s2_phase(Z1, Et, Fb, gw, NGW, lane); }
    SEAM(11);
    DBG16(12, 9, Fb, (size_t)ML * 1024);
    if (IN(12)) { pg8::SchedStd S; S.init(Fb, FWt, ML, 1024, 1024, 1024, G, c); pg8::EpiRes E{out, out, mods1 + 2048};
        pg8::gemm_phase<pg8::EpiRes, pg8::SchedStd, false>(lds, 1024, 1024, 1024, S, E); }
    SEAM(12);
    DBG32(13, 10, out, (size_t)ML * 1024);
    if (IN(13)) { PHASE_IDS; for (int r_ = 0; r_ < REP_NORM; ++r_) norm_rows(out, out, ML, norm_g + 3072, mods1, 3072, 4096, H, gw, NGW, lane); }
    SEAM(13);
    if (IN(14)) { pg8::SchedStd S; S.init(H, W1t + (size_t)4096 * 1024, ML, 4096, 1024, 1024, G, c); pg8::EpiRelu2 E{HMID, 4096};
        pg8::gemm_phase<pg8::EpiRelu2, pg8::SchedStd, false>(lds, 1024, 1024, 1024, S, E); }
    SEAM(14);
    DBG16(15, 11, HMID, (size_t)ML * 4096);
    if (IN(15)) { pg8::SchedStd S; S.init(HMID, W2t + (size_t)1024 * 4096, ML, 1024, 4096, 4096, G, c); pg8::EpiRes E{out, out, mods1 + 5120};
        pg8::gemm_phase<pg8::EpiRes, pg8::SchedStd, false>(lds, 4096, 4096, 4096, S, E); }
    SEAM(15);
    if (MK_DEBUG && IN(16)) {
        int t_ = threadIdx.x; asm volatile("" : "+v"(t_));
        bool bad = false;
        for (size_t i = (size_t)vcu * 512 + t_; i < (size_t)ML * 1024; i += (size_t)G * 512) { if ((__float_as_uint(out[i]) & 0x7f800000u) == 0x7f800000u) { bad = true; out[i] = 0.f; } }
        if (bad) atomicOr(dflags, 1u << 12);
    }
    SEAM(16);
    if (MK_DEBUG && IN(17)) {
        if (c == 0 && threadIdx.x == 0) { const unsigned f = *dflags; if (f) out[0] = 1.0e6f * (float)(__builtin_ctz(f) + 1) + 1.0e4f * (float)__builtin_popcount(f); }
    }
#undef IN
#undef SEAM
}

constexpr int NPHASE = MK_DEBUG ? 18 : 16;
#ifndef MK_PER_PHASE
#define MK_PER_PHASE 0
#endif

extern "C" void kernel_launch(void* const* d_in, const int* in_sizes, int n_in, void* d_out, int out_size, void* d_ws, size_t ws_size, hipStream_t stream) {
    static int grid = 0;
    if (grid == 0) {
        if (n_in != 15 || out_size != ML * DM || ws_size < WS_END) { fprintf(stderr, "kernel_launch: unexpected shapes (n_in %d out %d ws %zu)\n", n_in, out_size, ws_size); grid = -1; return; }
        int dev = 0, cus = 0, per_cu = 0;
        hipGetDevice(&dev); hipDeviceGetAttribute(&cus, hipDeviceAttributeMultiprocessorCount, dev);
        hipFuncSetAttribute((const void*)fwd_kernel, hipFuncAttributeMaxDynamicSharedMemorySize, LDS_BYTES);
        if (hipOccupancyMaxActiveBlocksPerMultiprocessor(&per_cu, (const void*)fwd_kernel, 512, LDS_BYTES) != hipSuccess || per_cu < 1) { fprintf(stderr, "kernel_launch: occupancy query failed (%d)\n", per_cu); (void)hipGetLastError(); per_cu = 1; }
        grid = cus * 1;
        if (grid <= 0) grid = 256;
    }
    if (grid < 0) return;
    if (hipMemsetAsync((char*)d_ws + WS_BAR, 0, BAR_BYTES, stream) != hipSuccess) { fprintf(stderr, "kernel_launch: memset failed\n"); return; }
    Args a{};
    for (int i = 0; i < 15; ++i) a.in[i] = (const float*)d_in[i];
    a.out = (float*)d_out; a.ws = (unsigned char*)d_ws;
#if MK_PER_PHASE
    for (int p = 0; p < NPHASE; ++p) { a.ph_lo = p; a.ph_hi = p + 1; hipLaunchKernelGGL(fwd_kernel, dim3(grid), dim3(512), LDS_BYTES, stream, a); }
#else
    a.ph_lo = 0; a.ph_hi = NPHASE;
    void* kargs[] = {&a};
    hipError_t e = hipLaunchCooperativeKernel((const void*)fwd_kernel, dim3(grid), dim3(512), kargs, LDS_BYTES, stream);
    if (e != hipSuccess) fprintf(stderr, "cooperative launch failed: %s (grid %d)\n", hipGetErrorString(e), grid);
#endif
}
```

```cpp
#include <hip/hip_runtime.h>
#include <hip/hip_cooperative_groups.h>
#include <cstdio>
#include <cstdint>
namespace cg = cooperative_groups;

#define LAS __attribute__((address_space(3)))
typedef unsigned short bf16_t;
typedef short bf16x8 __attribute__((ext_vector_type(8)));
typedef short s16x4 __attribute__((ext_vector_type(4)));
typedef float f32x4 __attribute__((ext_vector_type(4)));
typedef unsigned u32x4 __attribute__((ext_vector_type(4)));
typedef unsigned u32x2 __attribute__((ext_vector_type(2)));

constexpr int DM = 1024, NB = 4, SEQ = 4096, CTXL = 256, FF = 4096;
constexpr int ML = NB * SEQ;
constexpr int MT = ML + NB * CTXL;
constexpr float LOG2E = 1.4426950408889634f;
constexpr float EPS = 1e-6f;

constexpr size_t MiB = 1u << 20;
constexpr size_t WS_MODS = 0;
constexpr size_t WS_SB = 512 * 1024;
constexpr size_t WS_BAR = 1 * MiB;
constexpr size_t BAR_BYTES = 16384;
constexpr size_t WS_CS = 2 * MiB;
constexpr size_t WS_D = 2 * MiB + 512 * 1024;
constexpr size_t WS_E = 3 * MiB;
constexpr size_t WS_WQK = 4 * MiB, WS_WV = 8 * MiB, WS_WO = 10 * MiB, WS_FW = 12 * MiB;
constexpr size_t WS_W1 = 14 * MiB;
constexpr size_t WS_W2 = 30 * MiB;
constexpr size_t WS_SSQ = 46 * MiB;
constexpr size_t WS_BV = 47 * MiB;
constexpr size_t WS_H = 48 * MiB;
constexpr size_t WS_R = 82 * MiB;
constexpr size_t WS_QK = WS_R;
constexpr size_t WS_VT = WS_R + 68 * MiB;
constexpr size_t WS_O = WS_R + 102 * MiB;
constexpr size_t WS_HMID = WS_R;
constexpr size_t WS_Z0 = WS_R;
constexpr size_t WS_Z1 = WS_R + 64 * MiB;
constexpr size_t WS_F = WS_R + 128 * MiB;
constexpr size_t WS_END = 256 * MiB;
static_assert(WS_F + 32 * MiB <= WS_END && WS_HMID + 128 * MiB <= WS_END && WS_O + 32 * MiB <= WS_END, "ws map");

constexpr int LDS_BYTES = 147456;

typedef __bf16 bf16v2_t __attribute__((ext_vector_type(2)));
typedef float f32v2_t __attribute__((ext_vector_type(2)));
__device__ __forceinline__ unsigned cvt_pk_bf16(float lo, float hi) { const f32v2_t v = {lo, hi}; const bf16v2_t r = __builtin_convertvector(v, bf16v2_t); return __builtin_bit_cast(unsigned, r); }
__device__ __forceinline__ f32x4 mfma16(bf16x8 a, bf16x8 b, f32x4 c) { return __builtin_amdgcn_mfma_f32_16x16x32_bf16(a, b, c, 0, 0, 0); }

namespace pg8 {
constexpr int BM = 256, BK = 64, HALF = 128, HTB = HALF * BK * 2, STAGE_BYTES = 8 * HTB;
__device__ __forceinline__ int lds_byte(int r, int c) { const int st = (r >> 4) * 2 + (c >> 5), rr = r & 15, cc = c & 31, ob = rr * 64 + cc * 2; return st * 1024 + (ob ^ (((ob >> 9) & 1) << 5)); }
__device__ __forceinline__ void stage_rc(int b, int& R, int& C) { const int st = b / 1024, sb = b % 1024, swz = sb ^ (((sb >> 9) & 1) << 5); R = (st >> 1) * 16 + swz / 64; C = (st & 1) * 32 + (swz % 64) / 2; }
__device__ __forceinline__ int perm32(int rho) { const int n = rho >> 4, i = rho & 15; return 8 * (i >> 2) + 4 * n + (i & 3); }

struct Unit { int pm, pn, kind, aux; const char* a; const char* b; };

template <class Epi, class Sched, bool BMAP>
__device__ __forceinline__ void gemm_phase(LAS unsigned char* lds, const int K, const int lda, const int ldb, const Sched& S, const Epi& E) {
    int tid = threadIdx.x; asm volatile("" : "+v"(tid));
    const int wid = __builtin_amdgcn_readfirstlane(tid >> 6), lane = tid & 63, wr = wid >> 2, wc = wid & 3, fr = lane & 15, fq = lane >> 4;
    int nt = K / BK; asm volatile("" : "+s"(nt));
    unsigned voffA[2], voffB[2];
#pragma unroll
    for (int i = 0; i < 2; ++i) { int R, C; stage_rc(tid * 16 + i * 8192, R, C); const int Rb = (R & ~31) + perm32(R & 31);
        voffA[i] = (unsigned)(R * lda + C) * 2u;
        voffB[i] = BMAP ? (unsigned)((64 * (Rb & 63) + (Rb >> 6)) * ldb + C) * 2u : (unsigned)(Rb * ldb + C) * 2u; }
    const size_t kstep = (size_t)(BK * 2);
    const size_t hstepA = (size_t)HALF * lda * 2;
    const size_t hstepB = BMAP ? (size_t)2 * ldb * 2 : (size_t)HALF * ldb * 2;
    const unsigned ldsw = (unsigned)wid * 1024u;
    const int aoff = lds_byte(wr * 64 + fr, fq * 8), boff = lds_byte(wc * 32 + fr, fq * 8);
#define PG8_SA(b, h) (((b) * 2 + (h)) * HTB)
#define PG8_SB(b, h) ((4 + (b) * 2 + (h)) * HTB)
#define PG8_STAGE(bufoff, gbase, voff) do { _Pragma("unroll") for (int _i = 0; _i < 2; ++_i) \
        __builtin_amdgcn_global_load_lds((const unsigned*)((const char*)(gbase) + (voff)[_i]), (LAS unsigned*)(lds + (bufoff) + ldsw + _i * 8192), 16, 0, 0); } while (0)
#define PG8_LDA(dst, b, h) do { _Pragma("unroll") for (int m = 0; m < 4; ++m) _Pragma("unroll") for (int k = 0; k < 2; ++k) dst[m][k] = *(const LAS bf16x8*)(lds + PG8_SA(b, h) + aoff + m * 2048 + k * 1024); } while (0)
#define PG8_LDB(dst, b, h) do { _Pragma("unroll") for (int n = 0; n < 2; ++n) _Pragma("unroll") for (int k = 0; k < 2; ++k) dst[n][k] = *(const LAS bf16x8*)(lds + PG8_SB(b, h) + boff + n * 2048 + k * 1024); } while (0)
#define PG8_MMA(ai, bj, At, Bt) do { __builtin_amdgcn_s_setprio(1); _Pragma("unroll") for (int m = 0; m < 4; ++m) _Pragma("unroll") for (int n = 0; n < 2; ++n) _Pragma("unroll") for (int k = 0; k < 2; ++k) \
        acc[ai][bj][m][n] = __builtin_amdgcn_mfma_f32_16x16x32_bf16(Bt[n][k], At[m][k], acc[ai][bj][m][n], 0, 0, 0); __builtin_amdgcn_s_setprio(0); } while (0)
#define PG8_WAIT_V(n) asm volatile("s_waitcnt vmcnt(" #n ")" ::: "memory")
#define PG8_WAIT_L(n) asm volatile("s_waitcnt lgkmcnt(" #n ")" ::: "memory")
#define PG8_BAR __builtin_amdgcn_s_barrier()
#define PG8_SCHED __builtin_amdgcn_sched_barrier(0)
    Unit cur, nxt; int ui = 0;
    if (!S.next(0, cur)) return;
    f32x4 acc[2][2][4][2];
#pragma unroll
    for (int a = 0; a < 2; ++a)
#pragma unroll
        for (int b = 0; b < 2; ++b)
#pragma unroll
            for (int m = 0; m < 4; ++m)
#pragma unroll
                for (int n = 0; n < 2; ++n) acc[a][b][m][n] = (f32x4){0.f, 0.f, 0.f, 0.f};
    bf16x8 At[4][2], B0[2][2], B1[2][2];
    const char* cA = cur.a; const char* cB = cur.b;
    if constexpr (Epi::PREP) E.prep(cur, lds, 0, tid);
    PG8_STAGE(PG8_SB(0, 0), cB, voffB); PG8_STAGE(PG8_SB(0, 1), cB + hstepB, voffB); PG8_STAGE(PG8_SA(0, 0), cA, voffA); PG8_STAGE(PG8_SA(0, 1), cA + hstepA, voffA);
    if (wr == 1) PG8_BAR;
    PG8_WAIT_V(2); PG8_BAR;
    PG8_STAGE(PG8_SB(1, 0), cB + kstep, voffB); PG8_STAGE(PG8_SA(1, 0), cA + kstep, voffA); PG8_STAGE(PG8_SB(1, 1), cB + hstepB + kstep, voffB);
    PG8_WAIT_V(6); PG8_BAR;
    for (;;) {
        const bool has_next = S.next(ui + 1, nxt);
        const char* nA = has_next ? nxt.a : cA; const char* nB = has_next ? nxt.b : cB;
        for (int t = 0; t < nt; t += 2) {
            const bool last = (t == nt - 2);
            const char* a1 = cA + (size_t)(t + 1) * kstep;
            const char* a2 = last ? nA : cA + (size_t)(t + 2) * kstep; const char* b2 = last ? nB : cB + (size_t)(t + 2) * kstep;
            const char* a3 = a2 + kstep; const char* b3 = b2 + kstep;
            PG8_LDB(B0, 0, 0); PG8_LDB(B1, 0, 1); PG8_SCHED; PG8_LDA(At, 0, 0); PG8_STAGE(PG8_SA(1, 1), a1 + hstepA, voffA);
            PG8_WAIT_V(8); PG8_WAIT_L(0); PG8_BAR; PG8_MMA(0, 0, At, B0); PG8_MMA(0, 1, At, B1); PG8_BAR; PG8_SCHED;
            PG8_LDA(At, 0, 1); PG8_STAGE(PG8_SB(0, 0), b2, voffB); PG8_STAGE(PG8_SB(0, 1), b2 + hstepB, voffB); PG8_STAGE(PG8_SA(0, 0), a2, voffA);
            PG8_WAIT_V(8); PG8_WAIT_L(0); PG8_BAR; PG8_MMA(1, 0, At, B0); PG8_MMA(1, 1, At, B1); PG8_BAR; PG8_SCHED;
            PG8_LDB(B0, 1, 0); PG8_LDB(B1, 1, 1); PG8_SCHED; PG8_LDA(At, 1, 0); PG8_STAGE(PG8_SA(0, 1), a2 + hstepA, voffA);
            PG8_WAIT_V(8); PG8_WAIT_L(0); PG8_BAR; PG8_MMA(0, 0, At, B0); PG8_MMA(0, 1, At, B1); PG8_BAR; PG8_SCHED;
            PG8_LDA(At, 1, 1); PG8_STAGE(PG8_SB(1, 0), b3, voffB); PG8_STAGE(PG8_SB(1, 1), b3 + hstepB, voffB); PG8_STAGE(PG8_SA(1, 0), a3, voffA);
            PG8_WAIT_V(8); PG8_WAIT_L(0); PG8_BAR; PG8_MMA(1, 0, At, B0); PG8_MMA(1, 1, At, B1); PG8_BAR; PG8_SCHED;
        }
        if (wr == 0) PG8_BAR;
        E(acc, cur, wr, wc, fr, fq, lds, ui & 1);
        if (!has_next) break;
        if constexpr (Epi::PREP) E.prep(nxt, lds, (ui + 1) & 1, tid);
#pragma unroll
        for (int a = 0; a < 2; ++a)
#pragma unroll
            for (int b = 0; b < 2; ++b)
#pragma unroll
                for (int m = 0; m < 4; ++m)
#pragma unroll
                    for (int n = 0; n < 2; ++n) acc[a][b][m][n] = (f32x4){0.f, 0.f, 0.f, 0.f};
        cur = nxt; cA = nA; cB = nB; ++ui;
        if (wr == 1) PG8_BAR;
    }
    PG8_WAIT_V(0);
    PG8_BAR;
#undef PG8_SA
#undef PG8_SB
#undef PG8_STAGE
#undef PG8_LDA
#undef PG8_LDB
#undef PG8_MMA
#undef PG8_WAIT_V
#undef PG8_WAIT_L
#undef PG8_BAR
#undef PG8_SCHED
}

struct SchedStd {
    const char* A; const char* Bt; size_t tsA, tsB; int nM, nN, nwg, G, c;
    __device__ void init(const void* A_, const void* Bt_, int M, int N, int lda, int ldb, int G_, int c_) { A = (const char*)A_; Bt = (const char*)Bt_; tsA = (size_t)BM * lda * 2; tsB = (size_t)BM * ldb * 2; nM = M / BM; nN = N / BM; nwg = nM * nN; G = G_; c = c_; }
    __device__ bool next(int i, Unit& u) const {
        const long L = (long)i * G + c; if (L >= nwg) return false;
        int wgid = (int)L; { const int q = nwg / 8, r = nwg % 8, xcd = wgid % 8, off = wgid / 8; wgid = (xcd < r ? xcd * (q + 1) : r * (q + 1) + (xcd - r) * q) + off; }
        const int nig = 8 * nN, gid = wgid / nig, fm = gid * 8, gsz = (nM - fm) < 8 ? (nM - fm) : 8;
        u.pm = fm + ((wgid % nig) % gsz); u.pn = (wgid % nig) / gsz; u.kind = 0; u.aux = 0;
        u.a = A + (size_t)u.pm * tsA; u.b = Bt + (size_t)u.pn * tsB; return true;
    }
};
struct SchedQKV {
    const char* H; const char* Wqk; const char* Wv; int G, c, nunits;
    __device__ bool next(int i, Unit& u) const {
        const long Ll = (long)i * G + c; if (Ll >= nunits) return false;
        const int L = (int)Ll; const size_t ts = (size_t)BM * 1024 * 2; u.aux = 0;
        if (L < 512) { const int x = L & 7, off = L >> 3; u.kind = 0; u.pm = 8 * x + (off & 7); u.pn = off >> 3; }
        else if (L < 768) { const int l2 = L - 512, x = l2 & 7, off = l2 >> 3; u.kind = 1; u.pm = off & 3; u.pn = 8 * x + (off >> 2); }
        else if (L < 784) { const int l2 = L - 768; u.kind = 0; u.pm = 64 + (l2 & 3); u.pn = 4 + (l2 >> 2); }
        else { const int l2 = L - 784; u.kind = 1; u.pm = l2 & 3; u.pn = 64 + (l2 >> 2); }
        if (u.kind == 0) { u.a = H + (size_t)u.pm * ts; u.b = Wqk + (size_t)u.pn * ts; }
        else { u.a = Wv + (size_t)u.pm * ts; u.b = H + (size_t)u.pn * ts; }
        return true;
    }
};
struct SchedOne { Unit u;
    __device__ __forceinline__ bool next(int i, Unit& o) const { if (i > 0) return false; o = u; return true; }
};
struct SchedF1 {
    const char* CS; const char* H; int G, c;
    __device__ bool next(int i, Unit& u) const {
        const long Ll = (long)i * G + c; if (Ll >= 512) return false;
        const int L = (int)Ll; const int t = L & 15, b = (L >> 4) & 3, g = (L >> 6) & 3, ri = L >> 8;
        u.pm = ri; u.pn = t; u.kind = g; u.aux = b;
        u.a = CS + (size_t)ri * 256 * 256 * 2; u.b = H + ((size_t)(b * 4096 + 4 * t) * 1024 + g * 256) * 2; return true;
    }
};

typedef f32x4 Acc[2][2][4][2];
__device__ __forceinline__ u32x4 pack8(f32x4 v0, f32x4 v1) { u32x4 w; w.x = cvt_pk_bf16(v0[0], v0[1]); w.y = cvt_pk_bf16(v0[2], v0[3]); w.z = cvt_pk_bf16(v1[0], v1[1]); w.w = cvt_pk_bf16(v1[2], v1[3]); return w; }

struct EpiQKV { static constexpr bool PREP = false; bf16_t* QK; bf16_t* VT; const float* gq; const float* gk;
    __device__ __forceinline__ void operator()(const Acc& acc, const Unit& u, int wr, int wc, int fr, int fq, LAS unsigned char*, int) const {
        if (u.kind == 0) {
            const bool isq = u.pn < 4; const float* gp = isq ? gq : gk; const float qs = isq ? 0.125f * LOG2E : 1.0f;
            f32x4 gv[2][2];
#pragma unroll
            for (int bj = 0; bj < 2; ++bj)
#pragma unroll
                for (int n = 0; n < 2; ++n) gv[bj][n] = *(const f32x4*)(gp + 32 * bj + 8 * fq + 4 * n) * qs;
#pragma unroll
            for (int ai = 0; ai < 2; ++ai)
#pragma unroll
                for (int m = 0; m < 4; ++m) {
                    const int row = u.pm * BM + ai * HALF + wr * 64 + m * 16 + fr;
                    float ss = 0.f;
#pragma unroll
                    for (int bj = 0; bj < 2; ++bj)
#pragma unroll
                        for (int n = 0; n < 2; ++n) { const f32x4 x = acc[ai][bj][m][n]; ss += (x[0] * x[0] + x[1] * x[1]) + (x[2] * x[2] + x[3] * x[3]); }
                    ss += __shfl_xor(ss, 16); ss += __shfl_xor(ss, 32);
                    const float rstd = rsqrtf(ss * (1.0f / 64.0f) + EPS);
                    bf16_t* rowp = QK + (size_t)row * 2048 + u.pn * 256 + wc * 64 + 8 * fq;
#pragma unroll
                    for (int bj = 0; bj < 2; ++bj) *(u32x4*)(rowp + 32 * bj) = pack8(acc[ai][bj][m][0] * rstd * gv[bj][0], acc[ai][bj][m][1] * rstd * gv[bj][1]);
                }
        } else {
#pragma unroll
            for (int ai = 0; ai < 2; ++ai)
#pragma unroll
                for (int m = 0; m < 4; ++m) {
                    const int row = u.pm * BM + ai * HALF + wr * 64 + m * 16 + fr;
                    bf16_t* rowp = VT + (size_t)row * MT + u.pn * 256 + wc * 32 + 8 * fq;
#pragma unroll
                    for (int bj = 0; bj < 2; ++bj) *(u32x4*)(rowp + bj * HALF) = pack8(acc[ai][bj][m][0], acc[ai][bj][m][1]);
                }
        }
    }
};
struct EpiRelu2 { static constexpr bool PREP = false; bf16_t* O; int ldc;
    __device__ __forceinline__ void operator()(const Acc& acc, const Unit& u, int wr, int wc, int fr, int fq, LAS unsigned char*, int) const {
#pragma unroll
        for (int ai = 0; ai < 2; ++ai)
#pragma unroll
            for (int m = 0; m < 4; ++m) {
                const int row = u.pm * BM + ai * HALF + wr * 64 + m * 16 + fr;
                bf16_t* rowp = O + (size_t)row * ldc + u.pn * 256 + wc * 32 + 8 * fq;
#pragma unroll
                for (int bj = 0; bj < 2; ++bj) { f32x4 v0 = acc[ai][bj][m][0], v1 = acc[ai][bj][m][1];
#pragma unroll
                    for (int e = 0; e < 4; ++e) { const float a = fmaxf(v0[e], 0.f), b = fmaxf(v1[e], 0.f); v0[e] = a * a; v1[e] = b * b; }
                    *(u32x4*)(rowp + bj * HALF) = pack8(v0, v1); }
            }
    }
};
struct EpiRes { static constexpr bool PREP = false; const float* base; float* out; const float* gate;
    __device__ __forceinline__ void operator()(const Acc& acc, const Unit& u, int wr, int wc, int fr, int fq, LAS unsigned char*, int) const {
        const int col0 = u.pn * 256 + wc * 32 + 8 * fq;
        const float* gp = gate + (size_t)(u.pm >> 4) * 6144 + col0;
        f32x4 gv[2][2];
#pragma unroll
        for (int bj = 0; bj < 2; ++bj)
#pragma unroll
            for (int n = 0; n < 2; ++n) gv[bj][n] = *(const f32x4*)(gp + bj * HALF + 4 * n);
#pragma unroll
        for (int ai = 0; ai < 2; ++ai)
#pragma unroll
            for (int m = 0; m < 4; ++m) {
                const size_t off = (size_t)(u.pm * BM + ai * HALF + wr * 64 + m * 16 + fr) * 1024 + col0;
#pragma unroll
                for (int bj = 0; bj < 2; ++bj)
#pragma unroll
                    for (int n = 0; n < 2; ++n) { const f32x4 bs = *(const f32x4*)(base + off + bj * HALF + 4 * n);
                        *(f32x4*)(out + off + bj * HALF + 4 * n) = bs + gv[bj][n] * acc[ai][bj][m][n]; }
            }
    }
};
struct EpiZ0 { static constexpr bool PREP = false; bf16_t* Z0;
    __device__ __forceinline__ void operator()(const Acc& acc, const Unit& u, int wr, int wc, int fr, int fq, LAS unsigned char*, int) const {
        const int ri = u.pm, t = u.pn, g = u.kind, b = u.aux;
        bf16_t* p0 = Z0 + ((size_t)(((b * 4 + g) * 256 + wr * 64 + fr) * 64 + 4 * t + (wc >> 1))) * 128 + ri * 64 + 32 * (wc & 1) + 8 * fq;
#pragma unroll
        for (int ai = 0; ai < 2; ++ai)
#pragma unroll
            for (int m = 0; m < 4; ++m) {
#pragma unroll
                for (int bj = 0; bj < 2; ++bj)
                    *(u32x4*)(p0 + (size_t)(ai * HALF + m * 16) * 8192 + bj * 256) = pack8(acc[ai][bj][m][0], acc[ai][bj][m][1]);
                asm volatile("" ::: "memory");
            }
    }
};

constexpr int AUX_OFF = 131072;
struct EpiResF { static constexpr bool PREP = false; const float* base; float* out; const float* gate; const float* gm; bf16_t* XB; float* SSQ;
    __device__ __forceinline__ void operator()(const Acc& acc, const Unit& u, int wr, int wc, int fr, int fq, LAS unsigned char*, int) const {
        const int col0 = u.pn * 256 + wc * 32 + 8 * fq, b = u.pm >> 4;
        f32x4 gv[2][2], mv[2][2];
#pragma unroll
        for (int bj = 0; bj < 2; ++bj)
#pragma unroll
            for (int n = 0; n < 2; ++n) { gv[bj][n] = *(const f32x4*)(gate + (size_t)b * 6144 + col0 + bj * HALF + 4 * n); mv[bj][n] = *(const f32x4*)(gm + b * 1024 + col0 + bj * HALF + 4 * n); }
#pragma unroll
        for (int ai = 0; ai < 2; ++ai)
#pragma unroll
            for (int m = 0; m < 4; ++m) {
                const int row = u.pm * BM + ai * HALF + wr * 64 + m * 16 + fr;
                const size_t off = (size_t)row * 1024 + col0;
                float ss = 0.f;
#pragma unroll
                for (int bj = 0; bj < 2; ++bj) {
                    const f32x4 v0 = *(const f32x4*)(base + off + bj * HALF) + gv[bj][0] * acc[ai][bj][m][0];
                    const f32x4 v1 = *(const f32x4*)(base + off + bj * HALF + 4) + gv[bj][1] * acc[ai][bj][m][1];
                    *(f32x4*)(out + off + bj * HALF) = v0; *(f32x4*)(out + off + bj * HALF + 4) = v1;
                    ss += ((v0[0] * v0[0] + v0[1] * v0[1]) + (v0[2] * v0[2] + v0[3] * v0[3])) + ((v1[0] * v1[0] + v1[1] * v1[1]) + (v1[2] * v1[2] + v1[3] * v1[3]));
                    *(u32x4*)(XB + off + bj * HALF) = pack8(v0 * mv[bj][0], v1 * mv[bj][1]);
                }
                ss += __shfl_xor(ss, 16); ss += __shfl_xor(ss, 32);
                if (fq == 0) SSQ[(size_t)row * 16 + u.pn * 4 + wc] = ss;
                asm volatile("" ::: "memory");
            }
    }
};
__device__ __forceinline__ float ssq_rstd(const float* SSQ, int row, int half) {
    const f32x4 a = *(const f32x4*)(SSQ + (size_t)row * 16 + half * 8), b = *(const f32x4*)(SSQ + (size_t)row * 16 + half * 8 + 4);
    float s = ((a[0] + a[1]) + (a[2] + a[3])) + ((b[0] + b[1]) + (b[2] + b[3]));
    s += __shfl_xor(s, 1);
    return rsqrtf(s * (1.0f / 1024.0f) + EPS);
}
struct EpiRelu2F { static constexpr bool PREP = true; bf16_t* O; int ldc; const float* BV; const float* SSQ;
    __device__ __forceinline__ void prep(const Unit& u, LAS unsigned char* lds, int slot, int tid) const {
        const float r = ssq_rstd(SSQ, u.pm * BM + (tid >> 1), tid & 1);
        if (!(tid & 1)) ((LAS float*)(lds + AUX_OFF))[slot * 256 + (tid >> 1)] = r;
    }
    __device__ __forceinline__ void operator()(const Acc& acc, const Unit& u, int wr, int wc, int fr, int fq, LAS unsigned char* lds, int slot) const {
        const LAS float* rt = (const LAS float*)(lds + AUX_OFF) + slot * 256;
        const int col0 = u.pn * 256 + wc * 32 + 8 * fq, b = u.pm >> 4;
        f32x4 bv[2][2];
#pragma unroll
        for (int bj = 0; bj < 2; ++bj)
#pragma unroll
            for (int n = 0; n < 2; ++n) bv[bj][n] = *(const f32x4*)(BV + (size_t)b * 4096 + col0 + bj * HALF + 4 * n);
#pragma unroll
        for (int ai = 0; ai < 2; ++ai)
#pragma unroll
            for (int m = 0; m < 4; ++m) {
                const int rl = ai * HALF + wr * 64 + m * 16 + fr; const float rs = rt[rl];
                bf16_t* rowp = O + (size_t)(u.pm * BM + rl) * ldc + col0;
#pragma unroll
                for (int bj = 0; bj < 2; ++bj) { f32x4 v0 = acc[ai][bj][m][0] * rs + bv[bj][0], v1 = acc[ai][bj][m][1] * rs + bv[bj][1];
#pragma unroll
                    for (int e = 0; e < 4; ++e) { const float a = fmaxf(v0[e], 0.f), c2 = fmaxf(v1[e], 0.f); v0[e] = a * a; v1[e] = c2 * c2; }
                    *(u32x4*)(rowp + bj * HALF) = pack8(v0, v1); }
            }
    }
};
struct EpiZ0F { static constexpr bool PREP = true; bf16_t* Z0; const float* BVF; const float* SSQ;
    __device__ __forceinline__ void prep(const Unit& u, LAS unsigned char* lds, int slot, int tid) const {
        const int nl = tid >> 1, tok = u.aux * 4096 + 64 * (nl & 63) + 4 * u.pn + (nl >> 6);
        const float r = ssq_rstd(SSQ, tok, tid & 1);
        if (!(tid & 1)) ((LAS float*)(lds + AUX_OFF))[slot * 256 + nl] = r;
    }
    __device__ __forceinline__ void operator()(const Acc& acc, const Unit& u, int wr, int wc, int fr, int fq, LAS unsigned char* lds, int slot) const {
        const LAS float* rt = (const LAS float*)(lds + AUX_OFF) + slot * 256;
        const int ri = u.pm, t = u.pn, g = u.kind, b = u.aux;
        f32x4 rs[2][2];
#pragma unroll
        for (int bj = 0; bj < 2; ++bj)
#pragma unroll
            for (int n = 0; n < 2; ++n) rs[bj][n] = *(const LAS f32x4*)(rt + bj * HALF + wc * 32 + 8 * fq + 4 * n);
        const float* bz = BVF + (size_t)(b * 4 + g) * 512 + ri * 256 + wr * 64 + fr;
        bf16_t* p0 = Z0 + ((size_t)(((b * 4 + g) * 256 + wr * 64 + fr) * 64 + 4 * t + (wc >> 1))) * 128 + ri * 64 + 32 * (wc & 1) + 8 * fq;
#pragma unroll
        for (int ai = 0; ai < 2; ++ai)
#pragma unroll
            for (int m = 0; m < 4; ++m) {
                const float bb = bz[ai * HALF + m * 16];
#pragma unroll
                for (int bj = 0; bj < 2; ++bj)
                    *(u32x4*)(p0 + (size_t)(ai * HALF + m * 16) * 8192 + bj * 256) = pack8(acc[ai][bj][m][0] * rs[bj][0] + bb, acc[ai][bj][m][1] * rs[bj][1] + bb);
                asm volatile("" ::: "memory");
            }
    }
};
}


#define XB_TMO      128
#define XB_XCNT(j)  (256  + 64 * (j))
#define XB_XSUB(j)  (1280 + 64 * (j))
#define XB_XGEN(j)  (2304 + 64 * (j))
#define XB_TOP      3328
#define XB_TOPGEN   3392
#define XCD_BAR_WORDS 3456
#define XB_SPIN_CAP (1u << 18)
__device__ __forceinline__ unsigned xb_ld(unsigned* p)              { return __hip_atomic_load(p, __ATOMIC_RELAXED, __HIP_MEMORY_SCOPE_AGENT); }
__device__ __forceinline__ unsigned xb_add(unsigned* p, unsigned v) { return __hip_atomic_fetch_add(p, v, __ATOMIC_RELAXED, __HIP_MEMORY_SCOPE_AGENT); }
__device__ __forceinline__ unsigned xb_xcc_id() { return (unsigned)__builtin_amdgcn_s_getreg((3 << 11) | 20) & 0xFu; }
#define XB_SPIN(cond, bar) do { unsigned _sp = 0; while (cond) { __builtin_amdgcn_s_sleep(1); \
    if ((++_sp & 255u) == 0u) { if (xb_ld(&(bar)[XB_TMO])) break; if (_sp > XB_SPIN_CAP) { atomicAdd(&(bar)[XB_TMO], 1u); break; } } } } while (0)
struct XcdBarrier { unsigned* bar; unsigned x; volatile LAS unsigned* st; };
__device__ __forceinline__ XcdBarrier xcd_barrier_post(unsigned* bar, volatile LAS unsigned* st) {
    XcdBarrier b; b.bar = bar; b.x = xb_xcc_id(); b.st = st;
    if (threadIdx.x == 0) (void)xb_add(&bar[XB_XCNT(b.x)], 1u);
    return b;
}
__device__ __forceinline__ void xcd_barrier_complete(unsigned* bar, unsigned x, unsigned& nloc, unsigned& nx) {
    const unsigned G = gridDim.x * gridDim.y * gridDim.z;
    unsigned sum, cnt, mine, sp = 0u;
    for (;;) {
        sum = 0u; cnt = 0u; mine = 0u;
#pragma unroll
        for (unsigned j = 0; j < 16; ++j) { const unsigned c = xb_ld(&bar[XB_XCNT(j)]); sum += c; cnt += (c > 0u) ? 1u : 0u; mine = (j == x) ? c : mine; }
        if (sum == G) break;
        __builtin_amdgcn_s_sleep(1);
        if ((++sp & 255u) == 0u) { if (xb_ld(&bar[XB_TMO])) break; if (sp > XB_SPIN_CAP) { atomicAdd(&bar[XB_TMO], 1u); break; } }
    }
    nloc = mine > 0u ? mine : 1u; nx = cnt > 0u ? cnt : 1u;
}
__device__ __forceinline__ void xcd_barrier(const XcdBarrier& b) {
    asm volatile("s_waitcnt vmcnt(0)" ::: "memory");
    __syncthreads();
    if (threadIdx.x == 0) {
        unsigned* bar = b.bar;
        __builtin_amdgcn_s_waitcnt(0);
        unsigned nloc = b.st[0], nx = b.st[1];
        if (nloc == 0u) { xcd_barrier_complete(bar, b.x, nloc, nx); b.st[0] = nloc; b.st[1] = nx; }
        const unsigned old = xb_add(&bar[XB_XSUB(b.x)], 1u);
        const unsigned gen = old / nloc;
        if (old + 1u == (gen + 1u) * nloc) {
            __builtin_amdgcn_fence(__ATOMIC_RELEASE, "agent");
            asm volatile("s_waitcnt vmcnt(0)" ::: "memory");
            const unsigned og = xb_add(&bar[XB_TOP], 1u);
            const unsigned tg = og / nx;
            if (og + 1u == (tg + 1u) * nx) xb_add(&bar[XB_TOPGEN], 1u);
            else XB_SPIN(xb_ld(&bar[XB_TOPGEN]) == tg, bar);
            __builtin_amdgcn_fence(__ATOMIC_ACQUIRE, "agent");
            xb_add(&bar[XB_XGEN(b.x)], 1u);
            asm volatile("s_waitcnt vmcnt(0)" ::: "memory");
        } else {
            XB_SPIN(xb_ld(&bar[XB_XGEN(b.x)]) == gen, bar);
            __builtin_amdgcn_fence(__ATOMIC_ACQUIRE, "agent");
            asm volatile("s_waitcnt vmcnt(0)" ::: "memory");
        }
    }
    __syncthreads();
}
__device__ __forceinline__ void p0_mods_unit(const float* c, const float* cctx, const float* ada_w, const float* ada_b, float* mods, LAS unsigned char* lds, int unit) {
    LAS float* s = (LAS float*)lds;
    LAS float* red = s + 5 * 1024;
    int tid = threadIdx.x; asm volatile("" : "+v"(tid));
    for (int i = tid; i < 5 * 1024; i += 512) { const int v = i >> 10, k = i & 1023; const float x = v < 4 ? c[v * 1024 + k] : cctx[k]; s[i] = x / (1.0f + __expf(-x)); }
    __syncthreads();
    const int l = unit / 96, col0 = (unit % 96) * 64, kc = tid >> 6, cl = tid & 63;
    const float* w = ada_w + (size_t)l * 1024 * 6144 + col0 + cl;
    float a0 = 0.f, a1 = 0.f, a2 = 0.f, a3 = 0.f, a4 = 0.f;
    for (int k = kc * 128; k < kc * 128 + 128; k += 8) {
        float wv[8];
#pragma unroll
        for (int j = 0; j < 8; ++j) wv[j] = w[(size_t)(k + j) * 6144];
#pragma unroll
        for (int j = 0; j < 8; ++j) { a0 += s[k + j] * wv[j]; a1 += s[1024 + k + j] * wv[j]; a2 += s[2048 + k + j] * wv[j]; a3 += s[3072 + k + j] * wv[j]; a4 += s[4096 + k + j] * wv[j]; }
    }
    red[(kc * 5 + 0) * 64 + cl] = a0; red[(kc * 5 + 1) * 64 + cl] = a1; red[(kc * 5 + 2) * 64 + cl] = a2; red[(kc * 5 + 3) * 64 + cl] = a3; red[(kc * 5 + 4) * 64 + cl] = a4;
    __syncthreads();
    if (tid < 320) { const int v = tid >> 6, cc = tid & 63; float t = 0.f;
#pragma unroll
        for (int kk = 0; kk < 8; ++kk) t += red[(kk * 5 + v) * 64 + cc];
        mods[(size_t)(l * 5 + v) * 6144 + col0 + cc] = t + ada_b[l * 6144 + col0 + cc]; }
    __syncthreads();
}

__device__ __forceinline__ void p0_transpose_item(const float* W, int K, int N, bf16_t* WT, bf16_t* WT2, int mode, LAS float* scr, int item, int lane) {
    const int nblk = N / 32, kb = item / nblk, nb = item % nblk, k0 = 64 * kb, n0 = 32 * nb;
#pragma unroll 8
    for (int i = 0; i < 32; ++i) { const int kk = 2 * i + (lane >> 5); scr[kk * 33 + (lane & 31)] = W[(size_t)(k0 + kk) * N + n0 + (lane & 31)]; }
    asm volatile("s_waitcnt lgkmcnt(0)" ::: "memory");
    const int cch = lane & 7;
#pragma unroll
    for (int j = 0; j < 4; ++j) { const int n = (lane >> 3) + 8 * j; const LAS float* s = scr + (8 * cch) * 33 + n;
        u32x4 o; o.x = cvt_pk_bf16(s[0 * 33], s[1 * 33]); o.y = cvt_pk_bf16(s[2 * 33], s[3 * 33]); o.z = cvt_pk_bf16(s[4 * 33], s[5 * 33]); o.w = cvt_pk_bf16(s[6 * 33], s[7 * 33]);
        const int ng = n0 + n; bf16_t* dst;
        if (mode == 0) dst = WT + (size_t)ng * K;
        else if (ng < 2048) { const int pn = ng >> 8, hh = (ng >> 6) & 3, d = ng & 63; const int tpos = (d >> 5) * 128 + hh * 32 + (d & 31); dst = WT + (size_t)(pn * 256 + tpos) * K; }
        else dst = WT2 + (size_t)(ng - 2048) * K;
        *(u32x4*)(dst + k0 + 8 * cch) = o; }
    asm volatile("s_waitcnt lgkmcnt(0)" ::: "memory");
}

__device__ __forceinline__ float wave_sum(float v) {
#pragma unroll
    for (int o = 1; o < 64; o <<= 1) v += __shfl_xor(v, o);
    return v;
}
__device__ __forceinline__ void norm_rows(const float* xlat, const float* xctx, int nrows, const float* g, const float* modsl, int sh_off, int sc_off, bf16_t* H, int gw, int NGW, int lane) {
    f32x4 gv[4];
#pragma unroll
    for (int j = 0; j < 4; ++j) gv[j] = *(const f32x4*)(g + lane * 4 + 256 * j);
    for (int row = gw; row < nrows; row += NGW) {
        const float* src = row < ML ? xlat + (size_t)row * 1024 : xctx + (size_t)(row - ML) * 1024;
        const int v = row < ML ? (row >> 12) : 4;
        const float* mp = modsl + (size_t)v * 6144;
        f32x4 x[4]; float ss = 0.f;
#pragma unroll
        for (int j = 0; j < 4; ++j) { x[j] = *(const f32x4*)(src + lane * 4 + 256 * j); ss += (x[j][0] * x[j][0] + x[j][1] * x[j][1]) + (x[j][2] * x[j][2] + x[j][3] * x[j][3]); }
        const float rstd = rsqrtf(wave_sum(ss) * (1.0f / 1024.0f) + EPS);
#pragma unroll
        for (int j = 0; j < 4; ++j) {
            const f32x4 sh = *(const f32x4*)(mp + sh_off + lane * 4 + 256 * j), sc = *(const f32x4*)(mp + sc_off + lane * 4 + 256 * j);
            const f32x4 y = (x[j] * rstd * gv[j]) * (sc + 1.0f) + sh;
            u32x2 w; w.x = cvt_pk_bf16(y[0], y[1]); w.y = cvt_pk_bf16(y[2], y[3]);
            *(u32x2*)(H + (size_t)row * 1024 + lane * 4 + 256 * j) = w;
        }
    }
}


__device__ __forceinline__ void bias_items(const bf16_t* W1t, const bf16_t* CS, const float* mods, float* BV0, float* BV1, float* BVF, int w, int NW, int lane) {
    for (int it = w; it < 8192 + 2048; it += NW) {
        float a0 = 0.f, a1 = 0.f, a2 = 0.f, a3 = 0.f; float* dst; int dstride;
        if (it < 8192) {
            const int l = it >> 12, n = it & 4095;
            const bf16_t* wr_ = W1t + (size_t)l * 4096 * 1024 + (size_t)n * 1024 + lane * 16;
            const u32x4 w0 = *(const u32x4*)wr_, w1 = *(const u32x4*)(wr_ + 8);
            const float* sh = mods + (size_t)l * 5 * 6144 + 3072 + lane * 16;
            float wf[16];
#pragma unroll
            for (int e = 0; e < 4; ++e) { wf[2 * e] = __uint_as_float(w0[e] << 16); wf[2 * e + 1] = __uint_as_float(w0[e] & 0xffff0000u); wf[8 + 2 * e] = __uint_as_float(w1[e] << 16); wf[8 + 2 * e + 1] = __uint_as_float(w1[e] & 0xffff0000u); }
#pragma unroll
            for (int q = 0; q < 4; ++q) {
                const f32x4 s0 = *(const f32x4*)(sh + 4 * q), s1 = *(const f32x4*)(sh + 6144 + 4 * q), s2 = *(const f32x4*)(sh + 2 * 6144 + 4 * q), s3 = *(const f32x4*)(sh + 3 * 6144 + 4 * q);
#pragma unroll
                for (int e = 0; e < 4; ++e) { a0 += s0[e] * wf[4 * q + e]; a1 += s1[e] * wf[4 * q + e]; a2 += s2[e] * wf[4 * q + e]; a3 += s3[e] * wf[4 * q + e]; }
            }
            dst = (l == 0 ? BV0 : BV1) + n; dstride = 4096;
        } else {
            const int idx = it - 8192, g = idx >> 9, m = idx & 511;
            const u32x2 w0 = *(const u32x2*)(CS + (size_t)m * 256 + lane * 4);
            const float wf0 = __uint_as_float(w0[0] << 16), wf1 = __uint_as_float(w0[0] & 0xffff0000u), wf2 = __uint_as_float(w0[1] << 16), wf3 = __uint_as_float(w0[1] & 0xffff0000u);
            const float* sh = mods + (size_t)5 * 6144 + g * 256 + lane * 4;
            const f32x4 s0 = *(const f32x4*)(sh), s1 = *(const f32x4*)(sh + 6144), s2 = *(const f32x4*)(sh + 2 * 6144), s3 = *(const f32x4*)(sh + 3 * 6144);
            a0 = s0[0] * wf0 + s0[1] * wf1 + s0[2] * wf2 + s0[3] * wf3; a1 = s1[0] * wf0 + s1[1] * wf1 + s1[2] * wf2 + s1[3] * wf3;
            a2 = s2[0] * wf0 + s2[1] * wf1 + s2[2] * wf2 + s2[3] * wf3; a3 = s3[0] * wf0 + s3[1] * wf1 + s3[2] * wf2 + s3[3] * wf3;
            dst = BVF + g * 512 + m; dstride = 2048;
        }
        a0 = wave_sum(a0); a1 = wave_sum(a1); a2 = wave_sum(a2); a3 = wave_sum(a3);
        if (lane == 0) { dst[0] = a0; dst[dstride] = a1; dst[2 * dstride] = a2; dst[3 * dstride] = a3; }
    }
}
template <bool MASKED>
__device__ __forceinline__ void attn_block(const LAS bf16_t* Ks, const LAS bf16_t* Vs, int kcol0, int fr, int g, const bf16x8 (&Qf)[2], f32x4 (&acc)[4], float& lsum,
                                           const LAS float* rp, int base, int dX, int eX, float Mb) {
    bf16x8 KX[2], KY[2];
#pragma unroll
    for (int kk = 0; kk < 2; ++kk) { KX[kk] = *(const LAS bf16x8*)(Ks + (kcol0 + fr) * 72 + kk * 32 + g * 8); KY[kk] = *(const LAS bf16x8*)(Ks + (kcol0 + 16 + fr) * 72 + kk * 32 + g * 8); }
    s16x4 VX[4], VY[4];
#pragma unroll
    for (int db = 0; db < 4; ++db) { VX[db] = *(const LAS s16x4*)(Vs + (16 * db + fr) * 72 + kcol0 + 4 * g); VY[db] = *(const LAS s16x4*)(Vs + (16 * db + fr) * 72 + kcol0 + 16 + 4 * g); }
    f32x4 sX = mfma16(KX[0], Qf[0], (f32x4){0.f, 0.f, 0.f, 0.f}); sX = mfma16(KX[1], Qf[1], sX);
    f32x4 sY = mfma16(KY[0], Qf[0], (f32x4){0.f, 0.f, 0.f, 0.f}); sY = mfma16(KY[1], Qf[1], sY);
    f32x4 pX, pY;
    if (MASKED) {
#pragma unroll
        for (int ii = 0; ii < 4; ++ii) {
            const int dcx = min(max(dX + ii, 0), 30), dcy = min(max(dX + 16 + ii, 0), 30);
            const float bx = rp[base + dcx], by = rp[base + dcy];
            const bool okx = (unsigned)(eX + ii) < 16u, oky = (unsigned)(eX + 16 + ii) < 16u;
            pX[ii] = okx ? __builtin_amdgcn_exp2f(sX[ii] + bx - Mb) : 0.f;
            pY[ii] = oky ? __builtin_amdgcn_exp2f(sY[ii] + by - Mb) : 0.f;
        }
    } else {
#pragma unroll
        for (int ii = 0; ii < 4; ++ii) { pX[ii] = __builtin_amdgcn_exp2f(sX[ii] - Mb); pY[ii] = __builtin_amdgcn_exp2f(sY[ii] - Mb); }
    }
    lsum += ((pX[0] + pX[1]) + (pX[2] + pX[3])) + ((pY[0] + pY[1]) + (pY[2] + pY[3]));
    const u32x4 pw = pg8::pack8(pX, pY);
    const bf16x8 Pf = __builtin_bit_cast(bf16x8, pw);
#pragma unroll
    for (int db = 0; db < 4; ++db) {
        bf16x8 Vf; Vf[0] = VX[db][0]; Vf[1] = VX[db][1]; Vf[2] = VX[db][2]; Vf[3] = VX[db][3]; Vf[4] = VY[db][0]; Vf[5] = VY[db][1]; Vf[6] = VY[db][2]; Vf[7] = VY[db][3];
        acc[db] = mfma16(Vf, Pf, acc[db]);
    }
}
__device__ __forceinline__ void attn_phase(const bf16_t* QK, const bf16_t* VT, bf16_t* O, const float* rpb, const float* sbound, LAS unsigned char* lds, int G, int c) {
    constexpr int RP_BYTES = 30720, TILE_B = 64 * 72 * 2, SLOT_B = 2 * TILE_B, NSTEP = 13;
    LAS float* rp = (LAS float*)lds;
    int tid = threadIdx.x; asm volatile("" : "+v"(tid));
    const int lane = tid & 63, wid = __builtin_amdgcn_readfirstlane(tid >> 6), fr = lane & 15, g = lane >> 4;
    for (int i = tid; i < 16 * 465; i += 512) rp[i] = rpb[i] * LOG2E;
    const float Mb = *sbound;
    const int nunits = (2048 - c + G - 1) / G;
    const int NT = nunits * NSTEP;
    const int trow = tid >> 3, tch = tid & 7;
    const int ldsoff = (trow * 72 + tch * 8) * 2;
#define ATT_DEC(L_, b_, h_, rp_) do { const int x_ = (L_) & 7, q_ = (L_) >> 3; rp_ = q_ & 31; const int bh_ = 8 * (q_ >> 5) + x_; b_ = bh_ >> 4; h_ = bh_ & 15; } while (0)
#define ATT_GLOAD(T_, pk_, pv_) do { const int u_ = (T_) / NSTEP, t_ = (T_) - u_ * NSTEP; int b_, h_, rp_; ATT_DEC(u_ * G + c, b_, h_, rp_); \
        const int rs0_ = min(max(2 * rp_ - 4, 0), 56); const int tok0_ = t_ < 9 ? b_ * 4096 + min(rs0_ + t_, 63) * 64 : ML + b_ * 256 + 64 * (t_ - 9); \
        pk_ = *(const u32x4*)(QK + (size_t)(tok0_ + trow) * 2048 + 1024 + h_ * 64 + tch * 8); \
        pv_ = *(const u32x4*)(VT + (size_t)(h_ * 64 + trow) * MT + tok0_ + tch * 8); } while (0)
#define ATT_LWRITE(slot_, pk_, pv_) do { *(LAS u32x4*)(lds + RP_BYTES + (slot_) * SLOT_B + ldsoff) = pk_; *(LAS u32x4*)(lds + RP_BYTES + (slot_) * SLOT_B + TILE_B + ldsoff) = pv_; } while (0)
    u32x4 pk, pv;
    ATT_GLOAD(0, pk, pv); ATT_LWRITE(0, pk, pv);
    if (NT > 1) ATT_GLOAD(1, pk, pv);
    __syncthreads();
    int b = 0, h = 0, rpair = 0, r = 0, rs0 = 0, rsr = 0, qrow = 0, eX = 0, dX = 0;
    const int j = wid & 3, w0 = (j == 0) ? 0 : (j == 1) ? 8 : (j == 2) ? 24 : 32;
    bf16x8 Qf[2]; f32x4 acc[4]; float lsum = 0.f;
    int t = 0, u = 0;
    for (int T = 0; T < NT; ++T) {
        const int slot = T & 1;
        if (T + 1 < NT) ATT_LWRITE(slot ^ 1, pk, pv);
        if (T + 2 < NT) ATT_GLOAD(T + 2, pk, pv);
        if (t == 0) {
            ATT_DEC(u * G + c, b, h, rpair);
            r = 2 * rpair + (wid >> 2); rs0 = min(max(2 * rpair - 4, 0), 56); rsr = min(max(r - 4, 0), 56);
            const int cq = 16 * j + fr, cs = min(max(cq - 8, 0), 48);
            qrow = b * 4096 + r * 64 + cq; eX = w0 + 4 * g - cs; dX = w0 + 4 * g - cq + 15;
#pragma unroll
            for (int kk = 0; kk < 2; ++kk) Qf[kk] = *(const bf16x8*)(QK + (size_t)qrow * 2048 + h * 64 + 32 * kk + 8 * g);
#pragma unroll
            for (int db = 0; db < 4; ++db) acc[db] = (f32x4){0.f, 0.f, 0.f, 0.f};
            lsum = 0.f;
        }
        const LAS bf16_t* Ks = (const LAS bf16_t*)(lds + RP_BYTES + slot * SLOT_B);
        const LAS bf16_t* Vs = (const LAS bf16_t*)(lds + RP_BYTES + slot * SLOT_B + TILE_B);
        if (t < 9) {
            const int kr = rs0 + t, i = kr - rsr;
            if (i >= 0 && i < 8) attn_block<true>(Ks, Vs, w0, fr, g, Qf, acc, lsum, rp, h * 465 + (kr - r + 7) * 31, dX, eX, Mb);
        } else {
            attn_block<false>(Ks, Vs, 0, fr, g, Qf, acc, lsum, rp, 0, 0, 0, Mb);
            attn_block<false>(Ks, Vs, 32, fr, g, Qf, acc, lsum, rp, 0, 0, 0, Mb);
        }
        if (t == NSTEP - 1) {
            float ls = lsum; ls += __shfl_xor(ls, 16); ls += __shfl_xor(ls, 32);
            const float inv = 1.0f / ls;
            bf16_t* op = O + (size_t)qrow * 1024 + h * 64 + 4 * g;
#pragma unroll
            for (int db = 0; db < 4; ++db) { u32x2 w; w.x = cvt_pk_bf16(acc[db][0] * inv, acc[db][1] * inv); w.y = cvt_pk_bf16(acc[db][2] * inv, acc[db][3] * inv); *(u32x2*)(op + 16 * db) = w; }
            t = 0; ++u;
        } else ++t;
        __syncthreads();
    }
#undef ATT_DEC
#undef ATT_GLOAD
#undef ATT_LWRITE
}

__device__ __forceinline__ void s1_phase(const bf16_t* Z0, const bf16_t* Dg, bf16_t* Z1, LAS unsigned char* lds, int gw, int NGW) {
    constexpr int DP = 136;
    LAS bf16_t* Dl = (LAS bf16_t*)lds;
    int tid = threadIdx.x; asm volatile("" : "+v"(tid));
    const int lane = tid & 63, fr = lane & 15, g = lane >> 4;
    for (int i = tid; i < 128 * 16; i += 512) { const int row = i >> 4, ch = i & 15; *(LAS u32x4*)(Dl + row * DP + ch * 8) = *(const u32x4*)(Dg + row * 128 + ch * 8); }
    __syncthreads();
    for (int colM = gw; colM < 4096; colM += NGW) {
        bf16x8 A[4][4];
#pragma unroll
        for (int ib = 0; ib < 4; ++ib)
#pragma unroll
            for (int kb = 0; kb < 4; ++kb) A[ib][kb] = *(const bf16x8*)(Z0 + ((size_t)colM * 64 + 16 * ib + fr) * 128 + 32 * kb + 8 * g);
#pragma unroll 2
        for (int jb = 0; jb < 8; ++jb) {
            bf16x8 Bf[4];
#pragma unroll
            for (int kb = 0; kb < 4; ++kb) Bf[kb] = *(const LAS bf16x8*)(Dl + (16 * jb + fr) * DP + 32 * kb + 8 * g);
            const int n = 16 * jb + fr, ka = n >> 1, rip = n & 1;
#pragma unroll
            for (int ib = 0; ib < 4; ++ib) {
                f32x4 a = (f32x4){0.f, 0.f, 0.f, 0.f};
#pragma unroll
                for (int kb = 0; kb < 4; ++kb) a = mfma16(A[ib][kb], Bf[kb], a);
                u32x2 w; w.x = cvt_pk_bf16(a[0], a[1]); w.y = cvt_pk_bf16(a[2], a[3]);
                *(u32x2*)(Z1 + (((size_t)ka * 4096 + colM) * 2 + rip) * 64 + 16 * ib + 4 * g) = w;
            }
        }
    }
    __syncthreads();
}
__device__ __forceinline__ void s2_phase(const bf16_t* Z1, const bf16_t* Eg, bf16_t* F, int gw, int NGW, int lane) {
    const int fr = lane & 15, g = lane >> 4;
    for (int it = gw; it < 2048; it += NGW) {
        const int ka = it & 63, chunk = it >> 6;
        bf16x8 Bf[4][4];
#pragma unroll
        for (int jb = 0; jb < 4; ++jb)
#pragma unroll
            for (int kb = 0; kb < 4; ++kb) Bf[jb][kb] = *(const bf16x8*)(Eg + ((size_t)ka * 64 + 16 * jb + fr) * 128 + 32 * kb + 8 * g);
        for (int ib = 0; ib < 8; ++ib) {
            const int colM0 = chunk * 128 + ib * 16;
            bf16x8 A[4];
#pragma unroll
            for (int kb = 0; kb < 4; ++kb) A[kb] = *(const bf16x8*)(Z1 + ((size_t)ka * 4096 + colM0 + fr) * 128 + 32 * kb + 8 * g);
            const int cm = colM0 + 4 * g, b = cm >> 10, ch = cm & 1023;
#pragma unroll
            for (int jb = 0; jb < 4; ++jb) {
                f32x4 a = (f32x4){0.f, 0.f, 0.f, 0.f};
#pragma unroll
                for (int kb = 0; kb < 4; ++kb) a = mfma16(A[kb], Bf[jb][kb], a);
                const int kbk = 16 * jb + fr;
                u32x2 w; w.x = cvt_pk_bf16(a[0], a[1]); w.y = cvt_pk_bf16(a[2], a[3]);
                *(u32x2*)(F + ((size_t)b * 4096 + ka + 64 * kbk) * 1024 + ch) = w;
            }
        }
    }
}


#ifndef MK_DEBUG
#define MK_DEBUG 0
#endif
__device__ __forceinline__ void dbg_scan16(const bf16_t* p, size_t n, unsigned* flags, unsigned bit, int gt, int NT) {
    bool bad = false; for (size_t i = gt; i < n; i += NT) bad |= ((p[i] & 0x7f80u) == 0x7f80u);
    if (bad) atomicOr(flags, 1u << bit);
}
__device__ __forceinline__ void dbg_scan32(const float* p, size_t n, unsigned* flags, unsigned bit, int gt, int NT) {
    bool bad = false; for (size_t i = gt; i < n; i += NT) bad |= ((__float_as_uint(p[i]) & 0x7f800000u) == 0x7f800000u);
    if (bad) atomicOr(flags, 1u << bit);
}
struct Args { const float* in[15]; float* out; unsigned char* ws; int ph_lo, ph_hi, use_cg, pad; };
static_assert(sizeof(Args) == 15 * 8 + 8 + 8 + 16, "no padding");

__global__ void __launch_bounds__(512, 2) fwd_kernel(Args args) {
    extern __shared__ __attribute__((aligned(16))) unsigned char lds_raw[];
    LAS unsigned char* lds = (LAS unsigned char*)lds_raw;
    const int G = gridDim.x, c = blockIdx.x;
    const int vcu = (G % 8 == 0) ? (c % 8) * (G / 8) + c / 8 : c;
    const int NGW = G * 8;
#define PHASE_IDS int tid_ = threadIdx.x; asm volatile("" : "+v"(tid_)); const int lane = tid_ & 63, wid = __builtin_amdgcn_readfirstlane(tid_ >> 6); const int gw = vcu * 8 + wid; (void)lane; (void)gw
    unsigned char* ws = args.ws;
    const float* x = args.in[0]; const float* cvec = args.in[1]; const float* ctx = args.in[2]; const float* cctx = args.in[3];
    const float* ada_w = args.in[4]; const float* ada_b = args.in[5]; const float* norm_g = args.in[6];
    const float* wqkv = args.in[7]; const float* wo = args.in[8]; const float* gq = args.in[9]; const float* gk = args.in[10]; const float* rpb = args.in[11];
    const float* fw = args.in[12]; const float* w1 = args.in[13]; const float* w2 = args.in[14];
    float* out = args.out;
    float* mods = (float*)(ws + WS_MODS); float* sbound = (float*)(ws + WS_SB);
    bf16_t* CS = (bf16_t*)(ws + WS_CS); bf16_t* Dt = (bf16_t*)(ws + WS_D); bf16_t* Et = (bf16_t*)(ws + WS_E);
    bf16_t* WQK = (bf16_t*)(ws + WS_WQK); bf16_t* WV = (bf16_t*)(ws + WS_WV); bf16_t* WO = (bf16_t*)(ws + WS_WO); bf16_t* FWt = (bf16_t*)(ws + WS_FW);
    bf16_t* W1t = (bf16_t*)(ws + WS_W1); bf16_t* W2t = (bf16_t*)(ws + WS_W2);
    bf16_t* H = (bf16_t*)(ws + WS_H); bf16_t* QK = (bf16_t*)(ws + WS_QK); bf16_t* VT = (bf16_t*)(ws + WS_VT); bf16_t* O = (bf16_t*)(ws + WS_O);
    bf16_t* HMID = (bf16_t*)(ws + WS_HMID); bf16_t* Z0 = (bf16_t*)(ws + WS_Z0); bf16_t* Z1 = (bf16_t*)(ws + WS_Z1); bf16_t* Fb = (bf16_t*)(ws + WS_F);
    float* SSQ = (float*)(ws + WS_SSQ); float* BV0 = (float*)(ws + WS_BV); float* BV1 = BV0 + 4 * 4096; float* BVF = BV1 + 4 * 4096; float* GM = BVF + 16 * 512;
    const int lo = args.ph_lo, hi = args.ph_hi;
    cg::grid_group grid = cg::this_grid();
#define IN(k) (lo <= (k) && (k) < hi)
#ifndef REP_SYNC
#define REP_SYNC 1
#endif
#ifndef REP_NORM
#define REP_NORM 1
#endif
#ifndef REP_S12
#define REP_S12 1
#endif
#ifndef REP_P0
#define REP_P0 1
#endif
#ifndef USE_XB
#define USE_XB 1
#endif
#define SEAM(k) do { if (IN(k) && IN((k) + 1)) { for (int r_ = 0; r_ < REP_SYNC; ++r_) { if (use_cg) grid.sync(); else xcd_barrier(xbar); } } } while (0)
    { volatile LAS unsigned* st_ = (volatile LAS unsigned*)(lds + LDS_BYTES - 64); if (threadIdx.x < 2) st_[threadIdx.x] = 0u; __syncthreads(); }
    XcdBarrier xbar; xbar.bar = (unsigned*)(ws + WS_BAR); xbar.x = 0; xbar.st = (volatile LAS unsigned*)(lds + LDS_BYTES - 64);
    const bool use_cg = (args.use_cg != 0);
    if (!use_cg && hi - lo > 1) xbar = xcd_barrier_post((unsigned*)(ws + WS_BAR), (volatile LAS unsigned*)(lds + LDS_BYTES - 64));

    unsigned* dflags = (unsigned*)(ws + WS_SB + 256);
#define DBG16(k, bit, p, n) do { if (MK_DEBUG && IN(k)) { int t_ = threadIdx.x; asm volatile("" : "+v"(t_)); dbg_scan16(p, n, dflags, bit, (vcu * 512) + t_, G * 512); } } while (0)
#define DBG32(k, bit, p, n) do { if (MK_DEBUG && IN(k)) { int t_ = threadIdx.x; asm volatile("" : "+v"(t_)); dbg_scan32(p, n, dflags, bit, (vcu * 512) + t_, G * 512); } } while (0)
    if (IN(0)) {
        PHASE_IDS;
        if (MK_DEBUG && c == 0 && tid_ == 0) *dflags = 0u;
        for (int r0_ = 0; r0_ < REP_P0; ++r0_) {
        for (int u = c; u < 192; u += G) p0_mods_unit(cvec, cctx, ada_w, ada_b, mods, lds, u);
        __syncthreads();
        {
            LAS float* scr = (LAS float*)(lds + wid * 16384);
            constexpr int I_QKV = 16 * 96, I_SQ = 16 * 32, I_1 = 16 * 128, I_2 = 64 * 32;
            constexpr int NITEMS = I_QKV + 2 * I_SQ + 2 * I_1 + 2 * I_2;
            for (int it = NITEMS - 1 - gw; it >= 0; it -= NGW) {
                int r = it;
                if (r < I_QKV) { p0_transpose_item(wqkv, 1024, 3072, WQK, WV, 1, scr, r, lane); continue; } r -= I_QKV;
                if (r < I_SQ) { p0_transpose_item(wo, 1024, 1024, WO, nullptr, 0, scr, r, lane); continue; } r -= I_SQ;
                if (r < I_SQ) { p0_transpose_item(fw, 1024, 1024, FWt, nullptr, 0, scr, r, lane); continue; } r -= I_SQ;
                if (r < 2 * I_1) { const int l = r / I_1; p0_transpose_item(w1 + (size_t)l * 1024 * 4096, 1024, 4096, W1t + (size_t)l * 4096 * 1024, nullptr, 0, scr, r % I_1, lane); continue; } r -= 2 * I_1;
                { const int l = r / I_2; p0_transpose_item(w2 + (size_t)l * 4096 * 1024, 4096, 1024, W2t + (size_t)l * 1024 * 4096, nullptr, 0, scr, r % I_2, lane); }
            }
        }
        {
            const int gt = gw * 64 + lane, NT = NGW * 64;
            for (int i = gt; i < 512 * 256; i += NT) { const int m = i >> 8, cc = i & 255, ri = m >> 8, k2 = m & 255; float sn, cs; sincospif(2.0f * (float)((cc * k2) & 255) / 256.0f, &sn, &cs);
                const float v = (ri == 0 ? cs : -sn) * (1.0f / 16.0f); CS[i] = (bf16_t)(cvt_pk_bf16(v, 0.f) & 0xffffu); }
            for (int i = gt; i < 128 * 128; i += NT) { const int n = i >> 7, kp = i & 127, ka = n >> 1, rip = n & 1, ri = kp >> 6, a = kp & 63; float sn, cs; sincospif(2.0f * (float)((a * ka) & 63) / 64.0f, &sn, &cs);
                const float v = (rip == 0 ? (ri == 0 ? cs : sn) : (ri == 0 ? -sn : cs)) * 0.125f; Dt[i] = (bf16_t)(cvt_pk_bf16(v, 0.f) & 0xffffu); }
            for (int i = gt; i < 64 * 64 * 128; i += NT) { const int kp = i & 127, kbk = (i >> 7) & 63, ka = i >> 13, rip = kp >> 6, bp = kp & 63; float sn, cs; sincospif(2.0f * (float)((bp * (ka + 64 * kbk)) & 4095) / 4096.0f, &sn, &cs);
                const float v = (rip == 0 ? cs : sn) * 0.125f; Et[i] = (bf16_t)(cvt_pk_bf16(v, 0.f) & 0xffffu); }
        }
        if (c == G - 1 && wid == 7) {
            float mq = fabsf(gq[lane]), mk = fabsf(gk[lane]), mr = 0.f;
            for (int i = lane; i < 16 * 465; i += 64) mr = fmaxf(mr, fabsf(rpb[i]));
#pragma unroll
            for (int o = 1; o < 64; o <<= 1) { mq = fmaxf(mq, __shfl_xor(mq, o)); mk = fmaxf(mk, __shfl_xor(mk, o)); mr = fmaxf(mr, __shfl_xor(mr, o)); }
            if (lane == 0) *sbound = (8.0f * mq * mk + mr) * LOG2E;
        }
        __syncthreads();
        }
    }
    SEAM(0);
    const bool ctx_in_p1 = false;
    if (IN(1)) { PHASE_IDS;
        if (c == G - 1) {
            for (int i = tid_; i < 3 * 4096; i += 512) { const int idx = i >> 12, b = (i >> 10) & 3, col = i & 1023;
                const float gg = norm_g[(idx == 0 ? 1024 : idx == 1 ? 2048 : 3072) + col];
                const float sc = mods[(size_t)((idx == 0 ? 0 : 5) + b) * 6144 + (idx == 1 ? 1024 : 4096) + col];
                GM[i] = gg * (1.0f + sc); }
        }
        if (!ctx_in_p1) norm_rows(x, ctx, MT, norm_g, mods, 0, 1024, H, gw, NGW, lane);
        else if (c >= 32) norm_rows(x, ctx, ML, norm_g, mods, 0, 1024, H, (c - 32) * 8 + wid, (G - 32) * 8, lane);
        else {
            pg8::SchedOne S1u; const size_t ts = (size_t)256 * 1024 * 2; int tt;
            if (c < 16) { S1u.u.kind = 0; S1u.u.pm = 64 + (c & 3); S1u.u.pn = 4 + (c >> 2); tt = c & 3; S1u.u.a = (const char*)H + (size_t)S1u.u.pm * ts; S1u.u.b = (const char*)WQK + (size_t)S1u.u.pn * ts; }
            else { const int l2 = c - 16; S1u.u.kind = 1; S1u.u.pm = l2 & 3; S1u.u.pn = 64 + (l2 >> 2); tt = l2 >> 2; S1u.u.a = (const char*)WV + (size_t)S1u.u.pm * ts; S1u.u.b = (const char*)H + (size_t)S1u.u.pn * ts; }
            S1u.u.aux = 0;
            norm_rows(x, ctx, ML + tt * 256 + 256, norm_g, mods, 0, 1024, H, ML + tt * 256 + wid, 8, lane);
            asm volatile("s_waitcnt vmcnt(0)" ::: "memory"); __syncthreads();
            pg8::EpiQKV E{QK, VT, gq, gk};
            pg8::gemm_phase<pg8::EpiQKV, pg8::SchedOne, false>(lds, 1024, 1024, 1024, S1u, E);
        }
    }
    SEAM(1);
    DBG16(2, 0, H, (size_t)MT * 1024);
    if (IN(2)) { pg8::SchedQKV S{(const char*)H, (const char*)WQK, (const char*)WV, G, c, ctx_in_p1 ? 768 : 800}; pg8::EpiQKV E{QK, VT, gq, gk};
#ifndef REP_G2
#define REP_G2 1
#endif
        for (int r_ = 0; r_ < REP_G2; ++r_) pg8::gemm_phase<pg8::EpiQKV, pg8::SchedQKV, false>(lds, 1024, 1024, 1024, S, E);
        { PHASE_IDS;
          if (G > 32) { if (c >= 32) bias_items(W1t, CS, mods, BV0, BV1, BVF, (c - 32) * 8 + wid, (G - 32) * 8, lane); }
          else bias_items(W1t, CS, mods, BV0, BV1, BVF, gw, NGW, lane); } }
    SEAM(2);
    DBG16(3, 1, QK, (size_t)ML * 2048); DBG16(3, 2, VT, (size_t)1024 * MT); DBG32(3, 13, mods, (size_t)10 * 6144);
#ifndef REP_ATT
#define REP_ATT 1
#endif
    if (IN(3)) { for (int rep = 0; rep < REP_ATT; ++rep) attn_phase(QK, VT, O, rpb, sbound, lds, G, c); }
    SEAM(3);
    DBG16(4, 3, O, (size_t)ML * 1024);
    if (IN(4)) { pg8::SchedStd S; S.init(O, WO, ML, 1024, 1024, 1024, G, c); pg8::EpiResF E{x, out, mods + 2048, GM, H, SSQ};
        pg8::gemm_phase<pg8::EpiResF, pg8::SchedStd, false>(lds, 1024, 1024, 1024, S, E); }
    SEAM(4);
    DBG32(5, 4, out, (size_t)ML * 1024);
    if (IN(6)) { pg8::SchedStd S; S.init(H, W1t, ML, 4096, 1024, 1024, G, c); pg8::EpiRelu2F E{HMID, 4096, BV0, SSQ};
        pg8::gemm_phase<pg8::EpiRelu2F, pg8::SchedStd, false>(lds, 1024, 1024, 1024, S, E); }
    SEAM(6);
    DBG16(7, 5, HMID, (size_t)ML * 4096);
    if (IN(7)) { pg8::SchedStd S; S.init(HMID, W2t, ML, 1024, 4096, 4096, G, c); pg8::EpiResF E{out, out, mods + 5120, GM + 4096, H, SSQ};
        pg8::gemm_phase<pg8::EpiResF, pg8::SchedStd, false>(lds, 4096, 4096, 4096, S, E); }
    SEAM(7);
    const float* mods1 = mods + 5 * 6144;
    DBG32(8, 6, out, (size_t)ML * 1024);
    if (IN(9)) { pg8::SchedF1 S{(const char*)CS, (const char*)H, G, c}; pg8::EpiZ0F E{Z0, BVF, SSQ};
        pg8::gemm_phase<pg8::EpiZ0F, pg8::SchedF1, true>(lds, 256, 256, 1024, S, E); }
    SEAM(9);
    DBG16(10, 7, Z0, (size_t)262144 * 128);
    if (IN(10)) { PHASE_IDS; for (int r_ = 0; r_ < REP_S12; ++r_) s1_phase(Z0, Dt, Z1, lds, gw, NGW); }
    SEAM(10);
    DBG16(11, 8, Z1, (size_t)262144 * 128);
    if (IN(11)) { PHASE_IDS; for (int r_ = 0; r_ < REP_S12; ++r_) s2_phase(Z1, Et, Fb, gw, NGW, lane); }
    SEAM(11);
    DBG16(12, 9, Fb, (size_t)ML * 1024);
    if (IN(12)) { pg8::SchedStd S; S.init(Fb, FWt, ML, 1024, 1024, 1024, G, c); pg8::EpiResF E{out, out, mods1 + 2048, GM + 8192, H, SSQ};
        pg8::gemm_phase<pg8::EpiResF, pg8::SchedStd, false>(lds, 1024, 1024, 1024, S, E); }
    SEAM(12);
    DBG32(13, 10, out, (size_t)ML * 1024);
    if (IN(14)) { pg8::SchedStd S; S.init(H, W1t + (size_t)4096 * 1024, ML, 4096, 1024, 1024, G, c); pg8::EpiRelu2F E{HMID, 4096, BV1, SSQ};
        pg8::gemm_phase<pg8::EpiRelu2F, pg8::SchedStd, false>(lds, 1024, 1024, 1024, S, E); }
    SEAM(14);
    DBG16(15, 11, HMID, (size_t)ML * 4096);
    if (IN(15)) { pg8::SchedStd S; S.init(HMID, W2t + (size_t)1024 * 4096, ML, 1024, 4096, 4096, G, c); pg8::EpiRes E{out, out, mods1 + 5120};
        pg8::gemm_phase<pg8::EpiRes, pg8::SchedStd, false>(lds, 4096, 4096, 4096, S, E); }
    SEAM(15);
    if (MK_DEBUG && IN(16)) {
        int t_ = threadIdx.x; asm volatile("" : "+v"(t_));
        bool bad = false;
        for (size_t i = (size_t)vcu * 512 + t_; i < (size_t)ML * 1024; i += (size_t)G * 512) { if ((__float_as_uint(out[i]) & 0x7f800000u) == 0x7f800000u) { bad = true; out[i] = 0.f; } }
        if (bad) atomicOr(dflags, 1u << 12);
    }
    SEAM(16);
    if (MK_DEBUG && IN(17)) {
        if (c == 0 && threadIdx.x == 0) { const unsigned f = *dflags; if (f) out[0] = 1.0e6f * (float)(__builtin_ctz(f) + 1) + 1.0e4f * (float)__builtin_popcount(f); }
    }
#undef IN
#undef SEAM
}

constexpr int NPHASE = MK_DEBUG ? 18 : 16;
#ifndef MK_USE_CG
#define MK_USE_CG 0
#endif
#ifndef MK_PER_PHASE
#define MK_PER_PHASE 0
#endif

extern "C" void kernel_launch(void* const* d_in, const int* in_sizes, int n_in, void* d_out, int out_size, void* d_ws, size_t ws_size, hipStream_t stream) {
    static int grid = 0;
    if (grid == 0) {
        if (n_in != 15 || out_size != ML * DM || ws_size < WS_END) { fprintf(stderr, "kernel_launch: unexpected shapes (n_in %d out %d ws %zu)\n", n_in, out_size, ws_size); grid = -1; return; }
        int dev = 0, cus = 0, per_cu = 0;
        hipGetDevice(&dev); hipDeviceGetAttribute(&cus, hipDeviceAttributeMultiprocessorCount, dev);
        hipFuncSetAttribute((const void*)fwd_kernel, hipFuncAttributeMaxDynamicSharedMemorySize, LDS_BYTES);
        if (hipOccupancyMaxActiveBlocksPerMultiprocessor(&per_cu, (const void*)fwd_kernel, 512, LDS_BYTES) != hipSuccess || per_cu < 1) { fprintf(stderr, "kernel_launch: occupancy query failed (%d)\n", per_cu); (void)hipGetLastError(); per_cu = 1; }
        grid = cus * 1;
        if (grid <= 0) grid = 256;
    }
    if (grid < 0) return;
    if (hipMemsetAsync((char*)d_ws + WS_BAR, 0, BAR_BYTES, stream) != hipSuccess) { fprintf(stderr, "kernel_launch: memset failed\n"); return; }
    Args a{};
    for (int i = 0; i < 15; ++i) a.in[i] = (const float*)d_in[i];
    a.out = (float*)d_out; a.ws = (unsigned char*)d_ws;
#if MK_PER_PHASE
    for (int p = 0; p < NPHASE; ++p) { a.ph_lo = p; a.ph_hi = p + 1; hipLaunchKernelGGL(fwd_kernel, dim3(grid), dim3(512), LDS_BYTES, stream, a); }
#else
    a.ph_lo = 0; a.ph_hi = NPHASE; a.use_cg = MK_USE_CG;
    void* kargs[] = {&a};
    hipError_t e = hipLaunchCooperativeKernel((const void*)fwd_kernel, dim3(grid), dim3(512), kargs, LDS_BYTES, stream);
    if (e != hipSuccess) fprintf(stderr, "cooperative launch failed: %s (grid %d)\n", hipGetErrorString(e), grid);
#endif
}
```

```cpp
#include <hip/hip_runtime.h>
#include <hip/hip_cooperative_groups.h>
#include <cstdio>
#include <cstdint>
namespace cg = cooperative_groups;

#define LAS __attribute__((address_space(3)))
typedef unsigned short bf16_t;
typedef short bf16x8 __attribute__((ext_vector_type(8)));
typedef short s16x4 __attribute__((ext_vector_type(4)));
typedef float f32x4 __attribute__((ext_vector_type(4)));
typedef unsigned u32x4 __attribute__((ext_vector_type(4)));
typedef unsigned u32x2 __attribute__((ext_vector_type(2)));

constexpr int DM = 1024, NB = 4, SEQ = 4096, CTXL = 256, FF = 4096;
constexpr int ML = NB * SEQ;
constexpr int MT = ML + NB * CTXL;
constexpr float LOG2E = 1.4426950408889634f;
constexpr float EPS = 1e-6f;

constexpr size_t MiB = 1u << 20;
constexpr size_t WS_MODS = 0;
constexpr size_t WS_SB = 512 * 1024;
constexpr size_t WS_BAR = 1 * MiB;
constexpr size_t BAR_BYTES = 16384;
constexpr size_t WS_CS = 2 * MiB;
constexpr size_t WS_D = 2 * MiB + 512 * 1024;
constexpr size_t WS_E = 3 * MiB;
constexpr size_t WS_WQK = 4 * MiB, WS_WV = 8 * MiB, WS_WO = 10 * MiB, WS_FW = 12 * MiB;
constexpr size_t WS_W1 = 14 * MiB;
constexpr size_t WS_W2 = 30 * MiB;
constexpr size_t WS_SSQ = 46 * MiB;
constexpr size_t WS_BV = 47 * MiB;
constexpr size_t WS_H = 48 * MiB;
constexpr size_t WS_R = 82 * MiB;
constexpr size_t WS_QK = WS_R;
constexpr size_t WS_VT = WS_R + 68 * MiB;
constexpr size_t WS_O = WS_R + 102 * MiB;
constexpr size_t WS_HMID = WS_R;
constexpr size_t WS_Z0 = WS_R;
constexpr size_t WS_Z1 = WS_R + 64 * MiB;
constexpr size_t WS_F = WS_R + 128 * MiB;
constexpr size_t WS_END = 256 * MiB;
static_assert(WS_F + 32 * MiB <= WS_END && WS_HMID + 128 * MiB <= WS_END && WS_O + 32 * MiB <= WS_END, "ws map");

constexpr int LDS_BYTES = 147456;

typedef __bf16 bf16v2_t __attribute__((ext_vector_type(2)));
typedef float f32v2_t __attribute__((ext_vector_type(2)));
__device__ __forceinline__ unsigned cvt_pk_bf16(float lo, float hi) { const f32v2_t v = {lo, hi}; const bf16v2_t r = __builtin_convertvector(v, bf16v2_t); return __builtin_bit_cast(unsigned, r); }
__device__ __forceinline__ f32x4 mfma16(bf16x8 a, bf16x8 b, f32x4 c) { return __builtin_amdgcn_mfma_f32_16x16x32_bf16(a, b, c, 0, 0, 0); }


#ifndef MK_WT
#define MK_WT 0
#endif
__device__ __forceinline__ void st16(void* p, u32x4 v) {
#if MK_WT
    asm volatile("global_store_dwordx4 %0, %1, off sc1\n\ts_nop 1" :: "v"(p), "v"(v) : "memory");
#else
    *(u32x4*)p = v;
#endif
}
__device__ __forceinline__ void st16f(void* p, f32x4 v) {
#if MK_WT
    asm volatile("global_store_dwordx4 %0, %1, off sc1\n\ts_nop 1" :: "v"(p), "v"(v) : "memory");
#else
    *(f32x4*)p = v;
#endif
}
__device__ __forceinline__ void st8(void* p, u32x2 v) {
#if MK_WT
    asm volatile("global_store_dwordx2 %0, %1, off sc1\n\ts_nop 1" :: "v"(p), "v"(v) : "memory");
#else
    *(u32x2*)p = v;
#endif
}
namespace pg8 {
constexpr int BM = 256, BK = 64, HALF = 128, HTB = HALF * BK * 2, STAGE_BYTES = 8 * HTB;
__device__ __forceinline__ int lds_byte(int r, int c) { const int st = (r >> 4) * 2 + (c >> 5), rr = r & 15, cc = c & 31, ob = rr * 64 + cc * 2; return st * 1024 + (ob ^ (((ob >> 9) & 1) << 5)); }
__device__ __forceinline__ void stage_rc(int b, int& R, int& C) { const int st = b / 1024, sb = b % 1024, swz = sb ^ (((sb >> 9) & 1) << 5); R = (st >> 1) * 16 + swz / 64; C = (st & 1) * 32 + (swz % 64) / 2; }
__device__ __forceinline__ int perm32(int rho) { const int n = rho >> 4, i = rho & 15; return 8 * (i >> 2) + 4 * n + (i & 3); }

struct Unit { int pm, pn, kind, aux; const char* a; const char* b; };

template <class Epi, class Sched, bool BMAP>
__device__ __forceinline__ void gemm_phase(LAS unsigned char* lds, const int K, const int lda, const int ldb, const Sched& S, const Epi& E) {
    int tid = threadIdx.x; asm volatile("" : "+v"(tid));
    const int wid = __builtin_amdgcn_readfirstlane(tid >> 6), lane = tid & 63, wr = wid >> 2, wc = wid & 3, fr = lane & 15, fq = lane >> 4;
    int nt = K / BK; asm volatile("" : "+s"(nt));
    unsigned voffA[2], voffB[2];
#pragma unroll
    for (int i = 0; i < 2; ++i) { int R, C; stage_rc(tid * 16 + i * 8192, R, C); const int Rb = (R & ~31) + perm32(R & 31);
        voffA[i] = (unsigned)(R * lda + C) * 2u;
        voffB[i] = BMAP ? (unsigned)((64 * (Rb & 63) + (Rb >> 6)) * ldb + C) * 2u : (unsigned)(Rb * ldb + C) * 2u; }
    const size_t kstep = (size_t)(BK * 2);
    const size_t hstepA = (size_t)HALF * lda * 2;
    const size_t hstepB = BMAP ? (size_t)2 * ldb * 2 : (size_t)HALF * ldb * 2;
    const unsigned ldsw = (unsigned)wid * 1024u;
    const int aoff = lds_byte(wr * 64 + fr, fq * 8), boff = lds_byte(wc * 32 + fr, fq * 8);
#define PG8_SA(b, h) (((b) * 2 + (h)) * HTB)
#define PG8_SB(b, h) ((4 + (b) * 2 + (h)) * HTB)
#define PG8_STAGE(bufoff, gbase, voff) do { _Pragma("unroll") for (int _i = 0; _i < 2; ++_i) \
        __builtin_amdgcn_global_load_lds((const unsigned*)((const char*)(gbase) + (voff)[_i]), (LAS unsigned*)(lds + (bufoff) + ldsw + _i * 8192), 16, 0, 0); } while (0)
#define PG8_LDA(dst, b, h) do { _Pragma("unroll") for (int m = 0; m < 4; ++m) _Pragma("unroll") for (int k = 0; k < 2; ++k) dst[m][k] = *(const LAS bf16x8*)(lds + PG8_SA(b, h) + aoff + m * 2048 + k * 1024); } while (0)
#define PG8_LDB(dst, b, h) do { _Pragma("unroll") for (int n = 0; n < 2; ++n) _Pragma("unroll") for (int k = 0; k < 2; ++k) dst[n][k] = *(const LAS bf16x8*)(lds + PG8_SB(b, h) + boff + n * 2048 + k * 1024); } while (0)
#define PG8_MMA(ai, bj, At, Bt) do { __builtin_amdgcn_s_setprio(1); _Pragma("unroll") for (int m = 0; m < 4; ++m) _Pragma("unroll") for (int n = 0; n < 2; ++n) _Pragma("unroll") for (int k = 0; k < 2; ++k) \
        acc[ai][bj][m][n] = __builtin_amdgcn_mfma_f32_16x16x32_bf16(Bt[n][k], At[m][k], acc[ai][bj][m][n], 0, 0, 0); __builtin_amdgcn_s_setprio(0); } while (0)
#define PG8_WAIT_V(n) asm volatile("s_waitcnt vmcnt(" #n ")" ::: "memory")
#define PG8_WAIT_L(n) asm volatile("s_waitcnt lgkmcnt(" #n ")" ::: "memory")
#define PG8_BAR __builtin_amdgcn_s_barrier()
#define PG8_SCHED __builtin_amdgcn_sched_barrier(0)
    Unit cur, nxt; int ui = 0;
    if (!S.next(0, cur)) return;
    f32x4 acc[2][2][4][2];
#pragma unroll
    for (int a = 0; a < 2; ++a)
#pragma unroll
        for (int b = 0; b < 2; ++b)
#pragma unroll
            for (int m = 0; m < 4; ++m)
#pragma unroll
                for (int n = 0; n < 2; ++n) acc[a][b][m][n] = (f32x4){0.f, 0.f, 0.f, 0.f};
    bf16x8 At[4][2], B0[2][2], B1[2][2];
    const char* cA = cur.a; const char* cB = cur.b;
    if constexpr (Epi::PREP) E.prep(cur, lds, 0, tid);
    PG8_STAGE(PG8_SB(0, 0), cB, voffB); PG8_STAGE(PG8_SB(0, 1), cB + hstepB, voffB); PG8_STAGE(PG8_SA(0, 0), cA, voffA); PG8_STAGE(PG8_SA(0, 1), cA + hstepA, voffA);
    if (wr == 1) PG8_BAR;
    PG8_WAIT_V(2); PG8_BAR;
    PG8_STAGE(PG8_SB(1, 0), cB + kstep, voffB); PG8_STAGE(PG8_SA(1, 0), cA + kstep, voffA); PG8_STAGE(PG8_SB(1, 1), cB + hstepB + kstep, voffB);
    PG8_WAIT_V(6); PG8_BAR;
    for (;;) {
        const bool has_next = S.next(ui + 1, nxt);
        const char* nA = has_next ? nxt.a : cA; const char* nB = has_next ? nxt.b : cB;
        for (int t = 0; t < nt; t += 2) {
            const bool last = (t == nt - 2);
            const char* a1 = cA + (size_t)(t + 1) * kstep;
            const char* a2 = last ? nA : cA + (size_t)(t + 2) * kstep; const char* b2 = last ? nB : cB + (size_t)(t + 2) * kstep;
            const char* a3 = a2 + kstep; const char* b3 = b2 + kstep;
            PG8_LDB(B0, 0, 0); PG8_LDB(B1, 0, 1); PG8_SCHED; PG8_LDA(At, 0, 0); PG8_STAGE(PG8_SA(1, 1), a1 + hstepA, voffA);
            PG8_WAIT_V(8); PG8_WAIT_L(0); PG8_BAR; PG8_MMA(0, 0, At, B0); PG8_MMA(0, 1, At, B1); PG8_BAR; PG8_SCHED;
            PG8_LDA(At, 0, 1); PG8_STAGE(PG8_SB(0, 0), b2, voffB); PG8_STAGE(PG8_SB(0, 1), b2 + hstepB, voffB); PG8_STAGE(PG8_SA(0, 0), a2, voffA);
            PG8_WAIT_V(8); PG8_WAIT_L(0); PG8_BAR; PG8_MMA(1, 0, At, B0); PG8_MMA(1, 1, At, B1); PG8_BAR; PG8_SCHED;
            PG8_LDB(B0, 1, 0); PG8_LDB(B1, 1, 1); PG8_SCHED; PG8_LDA(At, 1, 0); PG8_STAGE(PG8_SA(0, 1), a2 + hstepA, voffA);
            PG8_WAIT_V(8); PG8_WAIT_L(0); PG8_BAR; PG8_MMA(0, 0, At, B0); PG8_MMA(0, 1, At, B1); PG8_BAR; PG8_SCHED;
            PG8_LDA(At, 1, 1); PG8_STAGE(PG8_SB(1, 0), b3, voffB); PG8_STAGE(PG8_SB(1, 1), b3 + hstepB, voffB); PG8_STAGE(PG8_SA(1, 0), a3, voffA);
            PG8_WAIT_V(8); PG8_WAIT_L(0); PG8_BAR; PG8_MMA(1, 0, At, B0); PG8_MMA(1, 1, At, B1); PG8_BAR; PG8_SCHED;
        }
        if (wr == 0) PG8_BAR;
        E(acc, cur, wr, wc, fr, fq, lds, ui & 1);
        if (!has_next) break;
        if constexpr (Epi::PREP) E.prep(nxt, lds, (ui + 1) & 1, tid);
#pragma unroll
        for (int a = 0; a < 2; ++a)
#pragma unroll
            for (int b = 0; b < 2; ++b)
#pragma unroll
                for (int m = 0; m < 4; ++m)
#pragma unroll
                    for (int n = 0; n < 2; ++n) acc[a][b][m][n] = (f32x4){0.f, 0.f, 0.f, 0.f};
        cur = nxt; cA = nA; cB = nB; ++ui;
        if (wr == 1) PG8_BAR;
    }
    PG8_WAIT_V(0);
    PG8_BAR;
#undef PG8_SA
#undef PG8_SB
#undef PG8_STAGE
#undef PG8_LDA
#undef PG8_LDB
#undef PG8_MMA
#undef PG8_WAIT_V
#undef PG8_WAIT_L
#undef PG8_BAR
#undef PG8_SCHED
}

struct SchedStd {
    const char* A; const char* Bt; size_t tsA, tsB; int nM, nN, nwg, G, c;
    __device__ void init(const void* A_, const void* Bt_, int M, int N, int lda, int ldb, int G_, int c_) { A = (const char*)A_; Bt = (const char*)Bt_; tsA = (size_t)BM * lda * 2; tsB = (size_t)BM * ldb * 2; nM = M / BM; nN = N / BM; nwg = nM * nN; G = G_; c = c_; }
    __device__ bool next(int i, Unit& u) const {
        const long L = (long)i * G + c; if (L >= nwg) return false;
        int wgid = (int)L; { const int q = nwg / 8, r = nwg % 8, xcd = wgid % 8, off = wgid / 8; wgid = (xcd < r ? xcd * (q + 1) : r * (q + 1) + (xcd - r) * q) + off; }
        const int nig = 8 * nN, gid = wgid / nig, fm = gid * 8, gsz = (nM - fm) < 8 ? (nM - fm) : 8;
        u.pm = fm + ((wgid % nig) % gsz); u.pn = (wgid % nig) / gsz; u.kind = 0; u.aux = 0;
        u.a = A + (size_t)u.pm * tsA; u.b = Bt + (size_t)u.pn * tsB; return true;
    }
};
struct SchedQKV {
    const char* H; const char* Wqk; const char* Wv; int G, c, nunits;
    __device__ bool next(int i, Unit& u) const {
        const long Ll = (long)i * G + c; if (Ll >= nunits) return false;
        const int L = (int)Ll; const size_t ts = (size_t)BM * 1024 * 2; u.aux = 0;
        if (L < 512) { const int x = L & 7, off = L >> 3; u.kind = 0; u.pm = 8 * x + (off & 7); u.pn = off >> 3; }
        else if (L < 768) { const int l2 = L - 512, x = l2 & 7, off = l2 >> 3; u.kind = 1; u.pm = off & 3; u.pn = 8 * x + (off >> 2); }
        else if (L < 784) { const int l2 = L - 768; u.kind = 0; u.pm = 64 + (l2 & 3); u.pn = 4 + (l2 >> 2); }
        else { const int l2 = L - 784; u.kind = 1; u.pm = l2 & 3; u.pn = 64 + (l2 >> 2); }
        if (u.kind == 0) { u.a = H + (size_t)u.pm * ts; u.b = Wqk + (size_t)u.pn * ts; }
        else { u.a = Wv + (size_t)u.pm * ts; u.b = H + (size_t)u.pn * ts; }
        return true;
    }
};
struct SchedOne { Unit u;
    __device__ __forceinline__ bool next(int i, Unit& o) const { if (i > 0) return false; o = u; return true; }
};
struct SchedF1 {
    const char* CS; const char* H; int G, c;
    __device__ bool next(int i, Unit& u) const {
        const long Ll = (long)i * G + c; if (Ll >= 512) return false;
        const int L = (int)Ll; const int t = L & 15, b = (L >> 4) & 3, g = (L >> 6) & 3, ri = L >> 8;
        u.pm = ri; u.pn = t; u.kind = g; u.aux = b;
        u.a = CS + (size_t)ri * 256 * 256 * 2; u.b = H + ((size_t)(b * 4096 + 4 * t) * 1024 + g * 256) * 2; return true;
    }
};

typedef f32x4 Acc[2][2][4][2];
__device__ __forceinline__ u32x4 pack8(f32x4 v0, f32x4 v1) { u32x4 w; w.x = cvt_pk_bf16(v0[0], v0[1]); w.y = cvt_pk_bf16(v0[2], v0[3]); w.z = cvt_pk_bf16(v1[0], v1[1]); w.w = cvt_pk_bf16(v1[2], v1[3]); return w; }

struct EpiQKV { static constexpr bool PREP = false; bf16_t* QK; bf16_t* VT; const float* gq; const float* gk;
    __device__ __forceinline__ void operator()(const Acc& acc, const Unit& u, int wr, int wc, int fr, int fq, LAS unsigned char*, int) const {
        if (u.kind == 0) {
            const bool isq = u.pn < 4; const float* gp = isq ? gq : gk; const float qs = isq ? 0.125f * LOG2E : 1.0f;
            f32x4 gv[2][2];
#pragma unroll
            for (int bj = 0; bj < 2; ++bj)
#pragma unroll
                for (int n = 0; n < 2; ++n) gv[bj][n] = *(const f32x4*)(gp + 32 * bj + 8 * fq + 4 * n) * qs;
#pragma unroll
            for (int ai = 0; ai < 2; ++ai)
#pragma unroll
                for (int m = 0; m < 4; ++m) {
                    const int row = u.pm * BM + ai * HALF + wr * 64 + m * 16 + fr;
                    float ss = 0.f;
#pragma unroll
                    for (int bj = 0; bj < 2; ++bj)
#pragma unroll
                        for (int n = 0; n < 2; ++n) { const f32x4 x = acc[ai][bj][m][n]; ss += (x[0] * x[0] + x[1] * x[1]) + (x[2] * x[2] + x[3] * x[3]); }
                    ss += __shfl_xor(ss, 16); ss += __shfl_xor(ss, 32);
                    const float rstd = rsqrtf(ss * (1.0f / 64.0f) + EPS);
                    bf16_t* rowp = QK + (size_t)row * 2048 + u.pn * 256 + wc * 64 + 8 * fq;
#pragma unroll
                    for (int bj = 0; bj < 2; ++bj) st16(rowp + 32 * bj, pack8(acc[ai][bj][m][0] * rstd * gv[bj][0], acc[ai][bj][m][1] * rstd * gv[bj][1]));
                }
        } else {
#pragma unroll
            for (int ai = 0; ai < 2; ++ai)
#pragma unroll
                for (int m = 0; m < 4; ++m) {
                    const int row = u.pm * BM + ai * HALF + wr * 64 + m * 16 + fr;
                    bf16_t* rowp = VT + (size_t)row * MT + u.pn * 256 + wc * 32 + 8 * fq;
#pragma unroll
                    for (int bj = 0; bj < 2; ++bj) st16(rowp + bj * HALF, pack8(acc[ai][bj][m][0], acc[ai][bj][m][1]));
                }
        }
    }
};
struct EpiRelu2 { static constexpr bool PREP = false; bf16_t* O; int ldc;
    __device__ __forceinline__ void operator()(const Acc& acc, const Unit& u, int wr, int wc, int fr, int fq, LAS unsigned char*, int) const {
#pragma unroll
        for (int ai = 0; ai < 2; ++ai)
#pragma unroll
            for (int m = 0; m < 4; ++m) {
                const int row = u.pm * BM + ai * HALF + wr * 64 + m * 16 + fr;
                bf16_t* rowp = O + (size_t)row * ldc + u.pn * 256 + wc * 32 + 8 * fq;
#pragma unroll
                for (int bj = 0; bj < 2; ++bj) { f32x4 v0 = acc[ai][bj][m][0], v1 = acc[ai][bj][m][1];
#pragma unroll
                    for (int e = 0; e < 4; ++e) { const float a = fmaxf(v0[e], 0.f), b = fmaxf(v1[e], 0.f); v0[e] = a * a; v1[e] = b * b; }
                    *(u32x4*)(rowp + bj * HALF) = pack8(v0, v1); }
            }
    }
};
struct EpiRes { static constexpr bool PREP = false; const float* base; float* out; const float* gate;
    __device__ __forceinline__ void operator()(const Acc& acc, const Unit& u, int wr, int wc, int fr, int fq, LAS unsigned char*, int) const {
        const int col0 = u.pn * 256 + wc * 32 + 8 * fq;
        const float* gp = gate + (size_t)(u.pm >> 4) * 6144 + col0;
        f32x4 gv[2][2];
#pragma unroll
        for (int bj = 0; bj < 2; ++bj)
#pragma unroll
            for (int n = 0; n < 2; ++n) gv[bj][n] = *(const f32x4*)(gp + bj * HALF + 4 * n);
#pragma unroll
        for (int ai = 0; ai < 2; ++ai)
#pragma unroll
            for (int m = 0; m < 4; ++m) {
                const size_t off = (size_t)(u.pm * BM + ai * HALF + wr * 64 + m * 16 + fr) * 1024 + col0;
#pragma unroll
                for (int bj = 0; bj < 2; ++bj)
#pragma unroll
                    for (int n = 0; n < 2; ++n) { const f32x4 bs = *(const f32x4*)(base + off + bj * HALF + 4 * n);
                        *(f32x4*)(out + off + bj * HALF + 4 * n) = bs + gv[bj][n] * acc[ai][bj][m][n]; }
            }
    }
};
struct EpiZ0 { static constexpr bool PREP = false; bf16_t* Z0;
    __device__ __forceinline__ void operator()(const Acc& acc, const Unit& u, int wr, int wc, int fr, int fq, LAS unsigned char*, int) const {
        const int ri = u.pm, t = u.pn, g = u.kind, b = u.aux;
        bf16_t* p0 = Z0 + ((size_t)(((b * 4 + g) * 256 + wr * 64 + fr) * 64 + 4 * t + (wc >> 1))) * 128 + ri * 64 + 32 * (wc & 1) + 8 * fq;
#pragma unroll
        for (int ai = 0; ai < 2; ++ai)
#pragma unroll
            for (int m = 0; m < 4; ++m) {
#pragma unroll
                for (int bj = 0; bj < 2; ++bj)
                    *(u32x4*)(p0 + (size_t)(ai * HALF + m * 16) * 8192 + bj * 256) = pack8(acc[ai][bj][m][0], acc[ai][bj][m][1]);
                asm volatile("" ::: "memory");
            }
    }
};

constexpr int AUX_OFF = 131072;
struct EpiResF { static constexpr bool PREP = false; const float* base; float* out; const float* gate; const float* gm; bf16_t* XB; float* SSQ;
    __device__ __forceinline__ void operator()(const Acc& acc, const Unit& u, int wr, int wc, int fr, int fq, LAS unsigned char*, int) const {
        const int col0 = u.pn * 256 + wc * 32 + 8 * fq, b = u.pm >> 4;
        f32x4 gv[2][2], mv[2][2];
#pragma unroll
        for (int bj = 0; bj < 2; ++bj)
#pragma unroll
            for (int n = 0; n < 2; ++n) { gv[bj][n] = *(const f32x4*)(gate + (size_t)b * 6144 + col0 + bj * HALF + 4 * n); mv[bj][n] = *(const f32x4*)(gm + b * 1024 + col0 + bj * HALF + 4 * n); }
#pragma unroll
        for (int ai = 0; ai < 2; ++ai)
#pragma unroll
          for (int mh = 0; mh < 2; ++mh) {
            f32x4 pre[2][2][2];
#pragma unroll
            for (int m2 = 0; m2 < 2; ++m2) { const size_t off = (size_t)(u.pm * BM + ai * HALF + wr * 64 + (2 * mh + m2) * 16 + fr) * 1024 + col0;
#pragma unroll
                for (int bj = 0; bj < 2; ++bj)
#pragma unroll
                    for (int n = 0; n < 2; ++n) pre[m2][bj][n] = *(const f32x4*)(base + off + bj * HALF + 4 * n); }
            asm volatile("" ::: "memory");
#pragma unroll
            for (int m2 = 0; m2 < 2; ++m2) {
                const int m = 2 * mh + m2;
                const int row = u.pm * BM + ai * HALF + wr * 64 + m * 16 + fr;
                const size_t off = (size_t)row * 1024 + col0;
                float ss = 0.f;
#pragma unroll
                for (int bj = 0; bj < 2; ++bj) {
                    const f32x4 v0 = pre[m2][bj][0] + gv[bj][0] * acc[ai][bj][m][0];
                    const f32x4 v1 = pre[m2][bj][1] + gv[bj][1] * acc[ai][bj][m][1];
                    st16f(out + off + bj * HALF, v0); st16f(out + off + bj * HALF + 4, v1);
                    ss += ((v0[0] * v0[0] + v0[1] * v0[1]) + (v0[2] * v0[2] + v0[3] * v0[3])) + ((v1[0] * v1[0] + v1[1] * v1[1]) + (v1[2] * v1[2] + v1[3] * v1[3]));
                    st16(XB + off + bj * HALF, pack8(v0 * mv[bj][0], v1 * mv[bj][1]));
                }
                ss += __shfl_xor(ss, 16); ss += __shfl_xor(ss, 32);
                if (fq == 0) SSQ[(size_t)row * 16 + u.pn * 4 + wc] = ss;
            }
            asm volatile("" ::: "memory");
          }
    }
};
__device__ __forceinline__ float ssq_rstd(const float* SSQ, int row, int half) {
    const f32x4 a = *(const f32x4*)(SSQ + (size_t)row * 16 + half * 8), b = *(const f32x4*)(SSQ + (size_t)row * 16 + half * 8 + 4);
    float s = ((a[0] + a[1]) + (a[2] + a[3])) + ((b[0] + b[1]) + (b[2] + b[3]));
    s += __shfl_xor(s, 1);
    return rsqrtf(s * (1.0f / 1024.0f) + EPS);
}
struct EpiRelu2F { static constexpr bool PREP = true; bf16_t* O; int ldc; const float* BV; const float* SSQ;
    __device__ __forceinline__ void prep(const Unit& u, LAS unsigned char* lds, int slot, int tid) const {
        const float r = ssq_rstd(SSQ, u.pm * BM + (tid >> 1), tid & 1);
        if (!(tid & 1)) ((LAS float*)(lds + AUX_OFF))[slot * 256 + (tid >> 1)] = r;
    }
    __device__ __forceinline__ void operator()(const Acc& acc, const Unit& u, int wr, int wc, int fr, int fq, LAS unsigned char* lds, int slot) const {
        const LAS float* rt = (const LAS float*)(lds + AUX_OFF) + slot * 256;
        const int col0 = u.pn * 256 + wc * 32 + 8 * fq, b = u.pm >> 4;
        f32x4 bv[2][2];
#pragma unroll
        for (int bj = 0; bj < 2; ++bj)
#pragma unroll
            for (int n = 0; n < 2; ++n) bv[bj][n] = *(const f32x4*)(BV + (size_t)b * 4096 + col0 + bj * HALF + 4 * n);
#pragma unroll
        for (int ai = 0; ai < 2; ++ai)
#pragma unroll
            for (int m = 0; m < 4; ++m) {
                const int rl = ai * HALF + wr * 64 + m * 16 + fr; const float rs = rt[rl];
                bf16_t* rowp = O + (size_t)(u.pm * BM + rl) * ldc + col0;
#pragma unroll
                for (int bj = 0; bj < 2; ++bj) { f32x4 v0 = acc[ai][bj][m][0] * rs + bv[bj][0], v1 = acc[ai][bj][m][1] * rs + bv[bj][1];
#pragma unroll
                    for (int e = 0; e < 4; ++e) { const float a = fmaxf(v0[e], 0.f), c2 = fmaxf(v1[e], 0.f); v0[e] = a * a; v1[e] = c2 * c2; }
                    st16(rowp + bj * HALF, pack8(v0, v1)); }
            }
    }
};
struct EpiZ0F { static constexpr bool PREP = true; bf16_t* Z0; const float* BVF; const float* SSQ;
    __device__ __forceinline__ void prep(const Unit& u, LAS unsigned char* lds, int slot, int tid) const {
        const int nl = tid >> 1, tok = u.aux * 4096 + 64 * (nl & 63) + 4 * u.pn + (nl >> 6);
        const float r = ssq_rstd(SSQ, tok, tid & 1);
        if (!(tid & 1)) ((LAS float*)(lds + AUX_OFF))[slot * 256 + nl] = r;
    }
    __device__ __forceinline__ void operator()(const Acc& acc, const Unit& u, int wr, int wc, int fr, int fq, LAS unsigned char* lds, int slot) const {
        const LAS float* rt = (const LAS float*)(lds + AUX_OFF) + slot * 256;
        const int ri = u.pm, t = u.pn, g = u.kind, b = u.aux;
        f32x4 rs[2][2];
#pragma unroll
        for (int bj = 0; bj < 2; ++bj)
#pragma unroll
            for (int n = 0; n < 2; ++n) rs[bj][n] = *(const LAS f32x4*)(rt + bj * HALF + wc * 32 + 8 * fq + 4 * n);
        const float* bz = BVF + (size_t)(b * 4 + g) * 512 + ri * 256 + wr * 64 + fr;
        bf16_t* p0 = Z0 + ((size_t)(((b * 4 + g) * 256 + wr * 64 + fr) * 64 + 4 * t + (wc >> 1))) * 128 + ri * 64 + 32 * (wc & 1) + 8 * fq;
#pragma unroll
        for (int ai = 0; ai < 2; ++ai)
#pragma unroll
            for (int m = 0; m < 4; ++m) {
                const float bb = bz[ai * HALF + m * 16];
#pragma unroll
                for (int bj = 0; bj < 2; ++bj)
                    st16(p0 + (size_t)(ai * HALF + m * 16) * 8192 + bj * 256, pack8(acc[ai][bj][m][0] * rs[bj][0] + bb, acc[ai][bj][m][1] * rs[bj][1] + bb));
                asm volatile("" ::: "memory");
            }
    }
};
}


#define XB_TMO      128
#define XB_XCNT(j)  (256  + 64 * (j))
#define XB_XSUB(j)  (1280 + 64 * (j))
#define XB_XGEN(j)  (2304 + 64 * (j))
#define XB_TOP      3328
#define XB_TOPGEN   3392
#define XCD_BAR_WORDS 3456
#define XB_SPIN_CAP (1u << 18)
__device__ __forceinline__ unsigned xb_ld(unsigned* p)              { return __hip_atomic_load(p, __ATOMIC_RELAXED, __HIP_MEMORY_SCOPE_AGENT); }
__device__ __forceinline__ unsigned xb_add(unsigned* p, unsigned v) { return __hip_atomic_fetch_add(p, v, __ATOMIC_RELAXED, __HIP_MEMORY_SCOPE_AGENT); }
__device__ __forceinline__ unsigned xb_xcc_id() { return (unsigned)__builtin_amdgcn_s_getreg((3 << 11) | 20) & 0xFu; }
#define XB_SPIN(cond, bar) do { unsigned _sp = 0; while (cond) { __builtin_amdgcn_s_sleep(1); \
    if ((++_sp & 255u) == 0u) { if (xb_ld(&(bar)[XB_TMO])) break; if (_sp > XB_SPIN_CAP) { atomicAdd(&(bar)[XB_TMO], 1u); break; } } } } while (0)
struct XcdBarrier { unsigned* bar; unsigned x; volatile LAS unsigned* st; };
__device__ __forceinline__ XcdBarrier xcd_barrier_post(unsigned* bar, volatile LAS unsigned* st) {
    XcdBarrier b; b.bar = bar; b.x = xb_xcc_id(); b.st = st;
    if (threadIdx.x == 0) (void)xb_add(&bar[XB_XCNT(b.x)], 1u);
    return b;
}
__device__ __forceinline__ void xcd_barrier_complete(unsigned* bar, unsigned x, unsigned& nloc, unsigned& nx) {
    const unsigned G = gridDim.x * gridDim.y * gridDim.z;
    unsigned sum, cnt, mine, sp = 0u;
    for (;;) {
        sum = 0u; cnt = 0u; mine = 0u;
#pragma unroll
        for (unsigned j = 0; j < 16; ++j) { const unsigned c = xb_ld(&bar[XB_XCNT(j)]); sum += c; cnt += (c > 0u) ? 1u : 0u; mine = (j == x) ? c : mine; }
        if (sum == G) break;
        __builtin_amdgcn_s_sleep(1);
        if ((++sp & 255u) == 0u) { if (xb_ld(&bar[XB_TMO])) break; if (sp > XB_SPIN_CAP) { atomicAdd(&bar[XB_TMO], 1u); break; } }
    }
    nloc = mine > 0u ? mine : 1u; nx = cnt > 0u ? cnt : 1u;
}
__device__ __forceinline__ void xcd_barrier(const XcdBarrier& b) {
    asm volatile("s_waitcnt vmcnt(0)" ::: "memory");
    __syncthreads();
    if (threadIdx.x == 0) {
        unsigned* bar = b.bar;
        __builtin_amdgcn_s_waitcnt(0);
        unsigned nloc = b.st[0], nx = b.st[1];
        if (nloc == 0u) { xcd_barrier_complete(bar, b.x, nloc, nx); b.st[0] = nloc; b.st[1] = nx; }
        const unsigned old = xb_add(&bar[XB_XSUB(b.x)], 1u);
        const unsigned gen = old / nloc;
        if (old + 1u == (gen + 1u) * nloc) {
            __builtin_amdgcn_fence(__ATOMIC_RELEASE, "agent");
            asm volatile("s_waitcnt vmcnt(0)" ::: "memory");
            const unsigned og = xb_add(&bar[XB_TOP], 1u);
            const unsigned tg = og / nx;
            if (og + 1u == (tg + 1u) * nx) xb_add(&bar[XB_TOPGEN], 1u);
            else XB_SPIN(xb_ld(&bar[XB_TOPGEN]) == tg, bar);
            __builtin_amdgcn_fence(__ATOMIC_ACQUIRE, "agent");
            xb_add(&bar[XB_XGEN(b.x)], 1u);
            asm volatile("s_waitcnt vmcnt(0)" ::: "memory");
        } else {
            XB_SPIN(xb_ld(&bar[XB_XGEN(b.x)]) == gen, bar);
            __builtin_amdgcn_fence(__ATOMIC_ACQUIRE, "agent");
            asm volatile("s_waitcnt vmcnt(0)" ::: "memory");
        }
    }
    __syncthreads();
}
__device__ __forceinline__ void p0_mods_unit(const float* c, const float* cctx, const float* ada_w, const float* ada_b, float* mods, LAS unsigned char* lds, int unit) {
    LAS float* s = (LAS float*)lds;
    LAS float* red = s + 5 * 1024;
    int tid = threadIdx.x; asm volatile("" : "+v"(tid));
    for (int i = tid; i < 5 * 1024; i += 512) { const int v = i >> 10, k = i & 1023; const float x = v < 4 ? c[v * 1024 + k] : cctx[k]; s[i] = x / (1.0f + __expf(-x)); }
    __syncthreads();
    const int l = unit / 96, col0 = (unit % 96) * 64, kc = tid >> 6, cl = tid & 63;
    const float* w = ada_w + (size_t)l * 1024 * 6144 + col0 + cl;
    float a0 = 0.f, a1 = 0.f, a2 = 0.f, a3 = 0.f, a4 = 0.f;
    for (int k = kc * 128; k < kc * 128 + 128; k += 32) {
        float wv[32];
#pragma unroll
        for (int j = 0; j < 32; ++j) wv[j] = w[(size_t)(k + j) * 6144];
#pragma unroll
        for (int j = 0; j < 32; ++j) { a0 += s[k + j] * wv[j]; a1 += s[1024 + k + j] * wv[j]; a2 += s[2048 + k + j] * wv[j]; a3 += s[3072 + k + j] * wv[j]; a4 += s[4096 + k + j] * wv[j]; }
    }
    red[(kc * 5 + 0) * 64 + cl] = a0; red[(kc * 5 + 1) * 64 + cl] = a1; red[(kc * 5 + 2) * 64 + cl] = a2; red[(kc * 5 + 3) * 64 + cl] = a3; red[(kc * 5 + 4) * 64 + cl] = a4;
    __syncthreads();
    if (tid < 320) { const int v = tid >> 6, cc = tid & 63; float t = 0.f;
#pragma unroll
        for (int kk = 0; kk < 8; ++kk) t += red[(kk * 5 + v) * 64 + cc];
        mods[(size_t)(l * 5 + v) * 6144 + col0 + cc] = t + ada_b[l * 6144 + col0 + cc]; }
    __syncthreads();
}

__device__ __forceinline__ void p0_transpose_item(const float* W, int K, int N, bf16_t* WT, bf16_t* WT2, int mode, LAS float* scr, int item, int lane) {
    const int nblk = N / 32, kb = item / nblk, nb = item % nblk, k0 = 64 * kb, n0 = 32 * nb;
    float wv_[32];
#pragma unroll
    for (int i = 0; i < 32; ++i) wv_[i] = W[(size_t)(k0 + 2 * i + (lane >> 5)) * N + n0 + (lane & 31)];
#pragma unroll
    for (int i = 0; i < 32; ++i) scr[(2 * i + (lane >> 5)) * 33 + (lane & 31)] = wv_[i];
    asm volatile("s_waitcnt lgkmcnt(0)" ::: "memory");
    const int cch = lane & 7;
#pragma unroll
    for (int j = 0; j < 4; ++j) { const int n = (lane >> 3) + 8 * j; const LAS float* s = scr + (8 * cch) * 33 + n;
        u32x4 o; o.x = cvt_pk_bf16(s[0 * 33], s[1 * 33]); o.y = cvt_pk_bf16(s[2 * 33], s[3 * 33]); o.z = cvt_pk_bf16(s[4 * 33], s[5 * 33]); o.w = cvt_pk_bf16(s[6 * 33], s[7 * 33]);
        const int ng = n0 + n; bf16_t* dst;
        if (mode == 0) dst = WT + (size_t)ng * K;
        else if (ng < 2048) { const int pn = ng >> 8, hh = (ng >> 6) & 3, d = ng & 63; const int tpos = (d >> 5) * 128 + hh * 32 + (d & 31); dst = WT + (size_t)(pn * 256 + tpos) * K; }
        else dst = WT2 + (size_t)(ng - 2048) * K;
        *(u32x4*)(dst + k0 + 8 * cch) = o; }
    asm volatile("s_waitcnt lgkmcnt(0)" ::: "memory");
}

__device__ __forceinline__ float wave_sum(float v) {
#pragma unroll
    for (int o = 1; o < 64; o <<= 1) v += __shfl_xor(v, o);
    return v;
}
__device__ __forceinline__ void norm_rows(const float* xlat, const float* xctx, int nrows, const float* g, const float* modsl, int sh_off, int sc_off, bf16_t* H, int gw, int NGW, int lane) {
    f32x4 gv[4];
#pragma unroll
    for (int j = 0; j < 4; ++j) gv[j] = *(const f32x4*)(g + lane * 4 + 256 * j);
    for (int row = gw; row < nrows; row += NGW) {
        const float* src = row < ML ? xlat + (size_t)row * 1024 : xctx + (size_t)(row - ML) * 1024;
        const int v = row < ML ? (row >> 12) : 4;
        const float* mp = modsl + (size_t)v * 6144;
        f32x4 x[4]; float ss = 0.f;
#pragma unroll
        for (int j = 0; j < 4; ++j) { x[j] = *(const f32x4*)(src + lane * 4 + 256 * j); ss += (x[j][0] * x[j][0] + x[j][1] * x[j][1]) + (x[j][2] * x[j][2] + x[j][3] * x[j][3]); }
        const float rstd = rsqrtf(wave_sum(ss) * (1.0f / 1024.0f) + EPS);
#pragma unroll
        for (int j = 0; j < 4; ++j) {
            const f32x4 sh = *(const f32x4*)(mp + sh_off + lane * 4 + 256 * j), sc = *(const f32x4*)(mp + sc_off + lane * 4 + 256 * j);
            const f32x4 y = (x[j] * rstd * gv[j]) * (sc + 1.0f) + sh;
            u32x2 w; w.x = cvt_pk_bf16(y[0], y[1]); w.y = cvt_pk_bf16(y[2], y[3]);
            *(u32x2*)(H + (size_t)row * 1024 + lane * 4 + 256 * j) = w;
        }
    }
}


__device__ __forceinline__ void bias_items(const bf16_t* W1t, const bf16_t* CS, const float* mods, float* BV0, float* BV1, float* BVF, int w, int NW, int lane) {
    for (int it = w; it < 8192 + 2048; it += NW) {
        float a0 = 0.f, a1 = 0.f, a2 = 0.f, a3 = 0.f; float* dst; int dstride;
        if (it < 8192) {
            const int l = it >> 12, n = it & 4095;
            const bf16_t* wr_ = W1t + (size_t)l * 4096 * 1024 + (size_t)n * 1024 + lane * 16;
            const u32x4 w0 = *(const u32x4*)wr_, w1 = *(const u32x4*)(wr_ + 8);
            const float* sh = mods + (size_t)l * 5 * 6144 + 3072 + lane * 16;
            float wf[16];
#pragma unroll
            for (int e = 0; e < 4; ++e) { wf[2 * e] = __uint_as_float(w0[e] << 16); wf[2 * e + 1] = __uint_as_float(w0[e] & 0xffff0000u); wf[8 + 2 * e] = __uint_as_float(w1[e] << 16); wf[8 + 2 * e + 1] = __uint_as_float(w1[e] & 0xffff0000u); }
#pragma unroll
            for (int q = 0; q < 4; ++q) {
                const f32x4 s0 = *(const f32x4*)(sh + 4 * q), s1 = *(const f32x4*)(sh + 6144 + 4 * q), s2 = *(const f32x4*)(sh + 2 * 6144 + 4 * q), s3 = *(const f32x4*)(sh + 3 * 6144 + 4 * q);
#pragma unroll
                for (int e = 0; e < 4; ++e) { a0 += s0[e] * wf[4 * q + e]; a1 += s1[e] * wf[4 * q + e]; a2 += s2[e] * wf[4 * q + e]; a3 += s3[e] * wf[4 * q + e]; }
            }
            dst = (l == 0 ? BV0 : BV1) + n; dstride = 4096;
        } else {
            const int idx = it - 8192, g = idx >> 9, m = idx & 511;
            const u32x2 w0 = *(const u32x2*)(CS + (size_t)m * 256 + lane * 4);
            const float wf0 = __uint_as_float(w0[0] << 16), wf1 = __uint_as_float(w0[0] & 0xffff0000u), wf2 = __uint_as_float(w0[1] << 16), wf3 = __uint_as_float(w0[1] & 0xffff0000u);
            const float* sh = mods + (size_t)5 * 6144 + g * 256 + lane * 4;
            const f32x4 s0 = *(const f32x4*)(sh), s1 = *(const f32x4*)(sh + 6144), s2 = *(const f32x4*)(sh + 2 * 6144), s3 = *(const f32x4*)(sh + 3 * 6144);
            a0 = s0[0] * wf0 + s0[1] * wf1 + s0[2] * wf2 + s0[3] * wf3; a1 = s1[0] * wf0 + s1[1] * wf1 + s1[2] * wf2 + s1[3] * wf3;
            a2 = s2[0] * wf0 + s2[1] * wf1 + s2[2] * wf2 + s2[3] * wf3; a3 = s3[0] * wf0 + s3[1] * wf1 + s3[2] * wf2 + s3[3] * wf3;
            dst = BVF + g * 512 + m; dstride = 2048;
        }
        a0 = wave_sum(a0); a1 = wave_sum(a1); a2 = wave_sum(a2); a3 = wave_sum(a3);
        if (lane == 0) { dst[0] = a0; dst[dstride] = a1; dst[2 * dstride] = a2; dst[3 * dstride] = a3; }
    }
}
template <bool MASKED>
__device__ __forceinline__ void attn_block(const LAS bf16_t* Ks, const LAS bf16_t* Vs, int kcol0, int fr, int g, const bf16x8 (&Qf)[2], f32x4 (&acc)[4], float& lsum,
                                           const LAS unsigned char* rpb_base  , const int (&dcb)[8], const f32x4& ciX, const f32x4& ciY) {
    bf16x8 KX[2], KY[2];
#pragma unroll
    for (int kk = 0; kk < 2; ++kk) { KX[kk] = *(const LAS bf16x8*)(Ks + (kcol0 + fr) * 72 + kk * 32 + g * 8); KY[kk] = *(const LAS bf16x8*)(Ks + (kcol0 + 16 + fr) * 72 + kk * 32 + g * 8); }
    s16x4 VX[4], VY[4];
#pragma unroll
    for (int db = 0; db < 4; ++db) { VX[db] = *(const LAS s16x4*)(Vs + (16 * db + fr) * 72 + kcol0 + 4 * g); VY[db] = *(const LAS s16x4*)(Vs + (16 * db + fr) * 72 + kcol0 + 16 + 4 * g); }
    f32x4 sX = mfma16(KX[0], Qf[0], ciX); sX = mfma16(KX[1], Qf[1], sX);
    f32x4 sY = mfma16(KY[0], Qf[0], ciY); sY = mfma16(KY[1], Qf[1], sY);
    f32x4 pX, pY;
    if (MASKED) {
#pragma unroll
        for (int ii = 0; ii < 4; ++ii) {
            const float bx = *(const LAS float*)(rpb_base + dcb[ii]), by = *(const LAS float*)(rpb_base + dcb[4 + ii]);
            pX[ii] = __builtin_amdgcn_exp2f(sX[ii] + bx);
            pY[ii] = __builtin_amdgcn_exp2f(sY[ii] + by);
        }
    } else {
#pragma unroll
        for (int ii = 0; ii < 4; ++ii) { pX[ii] = __builtin_amdgcn_exp2f(sX[ii]); pY[ii] = __builtin_amdgcn_exp2f(sY[ii]); }
    }
    lsum += ((pX[0] + pX[1]) + (pX[2] + pX[3])) + ((pY[0] + pY[1]) + (pY[2] + pY[3]));
    const u32x4 pw = pg8::pack8(pX, pY);
    const bf16x8 Pf = __builtin_bit_cast(bf16x8, pw);
#pragma unroll
    for (int db = 0; db < 4; ++db) {
        bf16x8 Vf; Vf[0] = VX[db][0]; Vf[1] = VX[db][1]; Vf[2] = VX[db][2]; Vf[3] = VX[db][3]; Vf[4] = VY[db][0]; Vf[5] = VY[db][1]; Vf[6] = VY[db][2]; Vf[7] = VY[db][3];
        acc[db] = mfma16(Vf, Pf, acc[db]);
    }
}
__device__ __forceinline__ void attn_phase(const bf16_t* QK, const bf16_t* VT, bf16_t* O, const float* rpb, const float* sbound, LAS unsigned char* lds, int G, int c) {
    constexpr int RP_BYTES = 30720, TILE_B = 64 * 72 * 2, SLOT_B = 2 * TILE_B, NSTEP = 13;
    LAS float* rp = (LAS float*)lds;
    int tid = threadIdx.x; asm volatile("" : "+v"(tid));
    const int lane = tid & 63, wid = __builtin_amdgcn_readfirstlane(tid >> 6), fr = lane & 15, g = lane >> 4;
    for (int i = tid; i < 16 * 465; i += 512) rp[i] = rpb[i] * LOG2E;
    const float Mb = *sbound;
    const int nunits = (2048 - c + G - 1) / G;
    const int NT = nunits * NSTEP;
    const int trow = tid >> 3, tch = tid & 7;
    const int ldsoff = (trow * 72 + tch * 8) * 2;
#define ATT_DEC(L_, b_, h_, rp_) do { const int x_ = (L_) & 7, q_ = (L_) >> 3; rp_ = q_ & 31; const int bh_ = 8 * (q_ >> 5) + x_; b_ = bh_ >> 4; h_ = bh_ & 15; } while (0)
#define ATT_GLOAD(T_, pk_, pv_) do { const int u_ = (T_) / NSTEP, t_ = (T_) - u_ * NSTEP; int b_, h_, rp_; ATT_DEC(u_ * G + c, b_, h_, rp_); \
        const int rs0_ = min(max(2 * rp_ - 4, 0), 56); const int tok0_ = t_ < 9 ? b_ * 4096 + min(rs0_ + t_, 63) * 64 : ML + b_ * 256 + 64 * (t_ - 9); \
        pk_ = *(const u32x4*)(QK + (size_t)(tok0_ + trow) * 2048 + 1024 + h_ * 64 + tch * 8); \
        pv_ = *(const u32x4*)(VT + (size_t)(h_ * 64 + trow) * MT + tok0_ + tch * 8); } while (0)
#define ATT_LWRITE(slot_, pk_, pv_) do { *(LAS u32x4*)(lds + RP_BYTES + (slot_) * SLOT_B + ldsoff) = pk_; *(LAS u32x4*)(lds + RP_BYTES + (slot_) * SLOT_B + TILE_B + ldsoff) = pv_; } while (0)
    u32x4 pk0, pv0, pk1, pv1, pk2, pv2;
    ATT_GLOAD(0, pk0, pv0); ATT_LWRITE(0, pk0, pv0);
    if (NT > 1) ATT_GLOAD(1, pk1, pv1);
    if (NT > 2) ATT_GLOAD(2, pk2, pv2);
    if (NT > 3) ATT_GLOAD(3, pk0, pv0);
    __syncthreads();
    int b = 0, h = 0, rpair = 0, r = 0, rs0 = 0, rsr = 0, qrow = 0;
    const int j = wid & 3, w0 = (j == 0) ? 0 : (j == 1) ? 8 : (j == 2) ? 24 : 32;
    int dcb[8]; f32x4 ciX, ciY, ciU;
    {
        const int cq = 16 * j + fr, cs = min(max(cq - 8, 0), 48), eX = w0 + 4 * g - cs, dX = w0 + 4 * g - cq + 15;
#pragma unroll
        for (int ii = 0; ii < 4; ++ii) {
            dcb[ii] = 4 * min(max(dX + ii, 0), 30); dcb[4 + ii] = 4 * min(max(dX + 16 + ii, 0), 30);
            ciX[ii] = ((unsigned)(eX + ii) < 16u) ? -Mb : -1.0e30f; ciY[ii] = ((unsigned)(eX + 16 + ii) < 16u) ? -Mb : -1.0e30f; ciU[ii] = -Mb;
        }
    }
    bf16x8 Qf[2], Qn[2]; f32x4 acc[4]; float lsum = 0.f;
    int t = 0, u = 0, T = 0;
#define ATT_QLOAD(dst, uu) do { int b_, h_, rp_; ATT_DEC((uu) * G + c, b_, h_, rp_); const int qr_ = b_ * 4096 + (2 * rp_ + (wid >> 2)) * 64 + 16 * j + fr; \
        _Pragma("unroll") for (int kk = 0; kk < 2; ++kk) dst[kk] = *(const bf16x8*)(QK + (size_t)qr_ * 2048 + h_ * 64 + 32 * kk + 8 * g); } while (0)
    ATT_QLOAD(Qn, 0);
#define ATT_ITER(PK, PV) do { \
        const int slot = T & 1; \
        if (T + 1 < NT) ATT_LWRITE(slot ^ 1, PK, PV); \
        if (T + 4 < NT) ATT_GLOAD(T + 4, PK, PV); \
        if (t == 0) { \
            ATT_DEC(u * G + c, b, h, rpair); \
            r = 2 * rpair + (wid >> 2); rs0 = min(max(2 * rpair - 4, 0), 56); rsr = min(max(r - 4, 0), 56); \
            qrow = b * 4096 + r * 64 + 16 * j + fr; \
            Qf[0] = Qn[0]; Qf[1] = Qn[1]; \
            _Pragma("unroll") for (int db = 0; db < 4; ++db) acc[db] = (f32x4){0.f, 0.f, 0.f, 0.f}; \
            lsum = 0.f; \
        } \
        if (t == 8 && u + 1 < nunits) ATT_QLOAD(Qn, u + 1); \
        const LAS bf16_t* Ks = (const LAS bf16_t*)(lds + RP_BYTES + slot * SLOT_B); \
        const LAS bf16_t* Vs = (const LAS bf16_t*)(lds + RP_BYTES + slot * SLOT_B + TILE_B); \
        if (t < 9) { \
            const int kr = rs0 + t, i = kr - rsr; \
            if (i >= 0 && i < 8) attn_block<true>(Ks, Vs, w0, fr, g, Qf, acc, lsum, (const LAS unsigned char*)rp + (h * 465 + (kr - r + 7) * 31) * 4, dcb, ciX, ciY); \
        } else { \
            attn_block<false>(Ks, Vs, 0, fr, g, Qf, acc, lsum, (const LAS unsigned char*)rp, dcb, ciU, ciU); \
            attn_block<false>(Ks, Vs, 32, fr, g, Qf, acc, lsum, (const LAS unsigned char*)rp, dcb, ciU, ciU); \
        } \
        if (t == NSTEP - 1) { \
            float ls = lsum; ls += __shfl_xor(ls, 16); ls += __shfl_xor(ls, 32); \
            const float inv = 1.0f / ls; \
            bf16_t* op = O + (size_t)qrow * 1024 + h * 64 + 4 * g; \
            _Pragma("unroll") for (int db = 0; db < 4; ++db) { u32x2 w; w.x = cvt_pk_bf16(acc[db][0] * inv, acc[db][1] * inv); w.y = cvt_pk_bf16(acc[db][2] * inv, acc[db][3] * inv); st8(op + 16 * db, w); } \
            t = 0; ++u; \
        } else ++t; \
        __syncthreads(); \
    } while (0)
    for (;;) {
        ATT_ITER(pk1, pv1); if (++T >= NT) break;
        ATT_ITER(pk2, pv2); if (++T >= NT) break;
        ATT_ITER(pk0, pv0); if (++T >= NT) break;
    }
#undef ATT_ITER
#undef ATT_QLOAD
#undef ATT_DEC
#undef ATT_GLOAD
#undef ATT_LWRITE
}

__device__ __forceinline__ void s1_phase(const bf16_t* Z0, const bf16_t* Dg, bf16_t* Z1, LAS unsigned char* lds, int gw, int NGW) {
    constexpr int DP = 136;
    LAS bf16_t* Dl = (LAS bf16_t*)lds;
    int tid = threadIdx.x; asm volatile("" : "+v"(tid));
    const int lane = tid & 63, fr = lane & 15, g = lane >> 4;
    for (int i = tid; i < 128 * 16; i += 512) { const int row = i >> 4, ch = i & 15; *(LAS u32x4*)(Dl + row * DP + ch * 8) = *(const u32x4*)(Dg + row * 128 + ch * 8); }
    __syncthreads();
    for (int colM = gw; colM < 4096; colM += NGW) {
        bf16x8 A[4][4];
#pragma unroll
        for (int ib = 0; ib < 4; ++ib)
#pragma unroll
            for (int kb = 0; kb < 4; ++kb) A[ib][kb] = *(const bf16x8*)(Z0 + ((size_t)colM * 64 + 16 * ib + fr) * 128 + 32 * kb + 8 * g);
#pragma unroll 2
        for (int jb = 0; jb < 8; ++jb) {
            bf16x8 Bf[4];
#pragma unroll
            for (int kb = 0; kb < 4; ++kb) Bf[kb] = *(const LAS bf16x8*)(Dl + (16 * jb + fr) * DP + 32 * kb + 8 * g);
            const int n = 16 * jb + fr, ka = n >> 1, rip = n & 1;
#pragma unroll
            for (int ib = 0; ib < 4; ++ib) {
                f32x4 a = (f32x4){0.f, 0.f, 0.f, 0.f};
#pragma unroll
                for (int kb = 0; kb < 4; ++kb) a = mfma16(A[ib][kb], Bf[kb], a);
                u32x2 w; w.x = cvt_pk_bf16(a[0], a[1]); w.y = cvt_pk_bf16(a[2], a[3]);
                st8(Z1 + (((size_t)ka * 4096 + colM) * 2 + rip) * 64 + 16 * ib + 4 * g, w);
            }
        }
    }
    __syncthreads();
}
__device__ __forceinline__ void s2_phase(const bf16_t* Z1, const bf16_t* Eg, bf16_t* F, int gw, int NGW, int lane) {
    const int fr = lane & 15, g = lane >> 4;
    for (int it = gw; it < 2048; it += NGW) {
        const int ka = it & 63, chunk = it >> 6;
        bf16x8 Bf[4][4];
#pragma unroll
        for (int jb = 0; jb < 4; ++jb)
#pragma unroll
            for (int kb = 0; kb < 4; ++kb) Bf[jb][kb] = *(const bf16x8*)(Eg + ((size_t)ka * 64 + 16 * jb + fr) * 128 + 32 * kb + 8 * g);
        for (int ib = 0; ib < 8; ++ib) {
            const int colM0 = chunk * 128 + ib * 16;
            bf16x8 A[4];
#pragma unroll
            for (int kb = 0; kb < 4; ++kb) A[kb] = *(const bf16x8*)(Z1 + ((size_t)ka * 4096 + colM0 + fr) * 128 + 32 * kb + 8 * g);
            const int cm = colM0 + 4 * g, b = cm >> 10, ch = cm & 1023;
#pragma unroll
            for (int jb = 0; jb < 4; ++jb) {
                f32x4 a = (f32x4){0.f, 0.f, 0.f, 0.f};
#pragma unroll
                for (int kb = 0; kb < 4; ++kb) a = mfma16(A[kb], Bf[jb][kb], a);
                const int kbk = 16 * jb + fr;
                u32x2 w; w.x = cvt_pk_bf16(a[0], a[1]); w.y = cvt_pk_bf16(a[2], a[3]);
                st8(F + ((size_t)b * 4096 + ka + 64 * kbk) * 1024 + ch, w);
            }
        }
    }
}


#ifndef MK_DEBUG
#define MK_DEBUG 0
#endif
__device__ __forceinline__ void dbg_scan16(const bf16_t* p, size_t n, unsigned* flags, unsigned bit, int gt, int NT) {
    bool bad = false; for (size_t i = gt; i < n; i += NT) bad |= ((p[i] & 0x7f80u) == 0x7f80u);
    if (bad) atomicOr(flags, 1u << bit);
}
__device__ __forceinline__ void dbg_scan32(const float* p, size_t n, unsigned* flags, unsigned bit, int gt, int NT) {
    bool bad = false; for (size_t i = gt; i < n; i += NT) bad |= ((__float_as_uint(p[i]) & 0x7f800000u) == 0x7f800000u);
    if (bad) atomicOr(flags, 1u << bit);
}
struct Args { const float* in[15]; float* out; unsigned char* ws; int ph_lo, ph_hi, use_cg, pad; };
static_assert(sizeof(Args) == 15 * 8 + 8 + 8 + 16, "no padding");

__global__ void __launch_bounds__(512, 2) fwd_kernel(Args args) {
    extern __shared__ __attribute__((aligned(16))) unsigned char lds_raw[];
    LAS unsigned char* lds = (LAS unsigned char*)lds_raw;
    const int G = gridDim.x, c = blockIdx.x;
    const int vcu = (G % 8 == 0) ? (c % 8) * (G / 8) + c / 8 : c;
    const int NGW = G * 8;
#define PHASE_IDS int tid_ = threadIdx.x; asm volatile("" : "+v"(tid_)); const int lane = tid_ & 63, wid = __builtin_amdgcn_readfirstlane(tid_ >> 6); const int gw = vcu * 8 + wid; (void)lane; (void)gw
    unsigned char* ws = args.ws;
    const float* x = args.in[0]; const float* cvec = args.in[1]; const float* ctx = args.in[2]; const float* cctx = args.in[3];
    const float* ada_w = args.in[4]; const float* ada_b = args.in[5]; const float* norm_g = args.in[6];
    const float* wqkv = args.in[7]; const float* wo = args.in[8]; const float* gq = args.in[9]; const float* gk = args.in[10]; const float* rpb = args.in[11];
    const float* fw = args.in[12]; const float* w1 = args.in[13]; const float* w2 = args.in[14];
    float* out = args.out;
    float* mods = (float*)(ws + WS_MODS); float* sbound = (float*)(ws + WS_SB);
    bf16_t* CS = (bf16_t*)(ws + WS_CS); bf16_t* Dt = (bf16_t*)(ws + WS_D); bf16_t* Et = (bf16_t*)(ws + WS_E);
    bf16_t* WQK = (bf16_t*)(ws + WS_WQK); bf16_t* WV = (bf16_t*)(ws + WS_WV); bf16_t* WO = (bf16_t*)(ws + WS_WO); bf16_t* FWt = (bf16_t*)(ws + WS_FW);
    bf16_t* W1t = (bf16_t*)(ws + WS_W1); bf16_t* W2t = (bf16_t*)(ws + WS_W2);
    bf16_t* H = (bf16_t*)(ws + WS_H); bf16_t* QK = (bf16_t*)(ws + WS_QK); bf16_t* VT = (bf16_t*)(ws + WS_VT); bf16_t* O = (bf16_t*)(ws + WS_O);
    bf16_t* HMID = (bf16_t*)(ws + WS_HMID); bf16_t* Z0 = (bf16_t*)(ws + WS_Z0); bf16_t* Z1 = (bf16_t*)(ws + WS_Z1); bf16_t* Fb = (bf16_t*)(ws + WS_F);
    float* SSQ = (float*)(ws + WS_SSQ); float* BV0 = (float*)(ws + WS_BV); float* BV1 = BV0 + 4 * 4096; float* BVF = BV1 + 4 * 4096; float* GM = BVF + 16 * 512;
    const int lo = args.ph_lo, hi = args.ph_hi;
    cg::grid_group grid = cg::this_grid();
#define IN(k) (lo <= (k) && (k) < hi)
#ifndef REP_SYNC
#define REP_SYNC 1
#endif
#ifndef REP_NORM
#define REP_NORM 1
#endif
#ifndef REP_S12
#define REP_S12 1
#endif
#ifndef REP_P0
#define REP_P0 1
#endif
#ifndef USE_XB
#define USE_XB 1
#endif
#define SEAM(k) do { if (IN(k) && IN((k) + 1)) { for (int r_ = 0; r_ < REP_SYNC; ++r_) { if (use_cg) grid.sync(); else xcd_barrier(xbar); } } } while (0)
    { volatile LAS unsigned* st_ = (volatile LAS unsigned*)(lds + LDS_BYTES - 64); if (threadIdx.x < 2) st_[threadIdx.x] = 0u; __syncthreads(); }
    XcdBarrier xbar; xbar.bar = (unsigned*)(ws + WS_BAR); xbar.x = 0; xbar.st = (volatile LAS unsigned*)(lds + LDS_BYTES - 64);
    const bool use_cg = (args.use_cg != 0);
    if (!use_cg && hi - lo > 1) xbar = xcd_barrier_post((unsigned*)(ws + WS_BAR), (volatile LAS unsigned*)(lds + LDS_BYTES - 64));

    unsigned* dflags = (unsigned*)(ws + WS_SB + 256);
#define DBG16(k, bit, p, n) do { if (MK_DEBUG && IN(k)) { int t_ = threadIdx.x; asm volatile("" : "+v"(t_)); dbg_scan16(p, n, dflags, bit, (vcu * 512) + t_, G * 512); } } while (0)
#define DBG32(k, bit, p, n) do { if (MK_DEBUG && IN(k)) { int t_ = threadIdx.x; asm volatile("" : "+v"(t_)); dbg_scan32(p, n, dflags, bit, (vcu * 512) + t_, G * 512); } } while (0)
    if (IN(0)) {
        PHASE_IDS;
        if (MK_DEBUG && c == 0 && tid_ == 0) *dflags = 0u;
        for (int r0_ = 0; r0_ < REP_P0; ++r0_) {
        for (int u = c; u < 192; u += G) p0_mods_unit(cvec, cctx, ada_w, ada_b, mods, lds, u);
        __syncthreads();
        {
            LAS float* scr = (LAS float*)(lds + wid * 16384);
            constexpr int I_QKV = 16 * 96, I_SQ = 16 * 32, I_1 = 16 * 128, I_2 = 64 * 32;
            constexpr int NITEMS = I_QKV + I_SQ + 2 * I_1 + I_2;
            for (int it = NITEMS - 1 - gw; it >= 0; it -= NGW) {
                int r = it;
                if (r < I_QKV) { p0_transpose_item(wqkv, 1024, 3072, WQK, WV, 1, scr, r, lane); continue; } r -= I_QKV;
                if (r < I_SQ) { p0_transpose_item(wo, 1024, 1024, WO, nullptr, 0, scr, r, lane); continue; } r -= I_SQ;
                if (r < 2 * I_1) { const int l = r / I_1; p0_transpose_item(w1 + (size_t)l * 1024 * 4096, 1024, 4096, W1t + (size_t)l * 4096 * 1024, nullptr, 0, scr, r % I_1, lane); continue; } r -= 2 * I_1;
                p0_transpose_item(w2, 4096, 1024, W2t, nullptr, 0, scr, r, lane);
            }
        }
        {
            const int gt = gw * 64 + lane, NT = NGW * 64;
            for (int i = gt; i < 512 * 256; i += NT) { const int m = i >> 8, cc = i & 255, ri = m >> 8, k2 = m & 255; float sn, cs; sincospif(2.0f * (float)((cc * k2) & 255) / 256.0f, &sn, &cs);
                const float v = (ri == 0 ? cs : -sn) * (1.0f / 16.0f); CS[i] = (bf16_t)(cvt_pk_bf16(v, 0.f) & 0xffffu); }
            for (int i = gt; i < 128 * 128; i += NT) { const int n = i >> 7, kp = i & 127, ka = n >> 1, rip = n & 1, ri = kp >> 6, a = kp & 63; float sn, cs; sincospif(2.0f * (float)((a * ka) & 63) / 64.0f, &sn, &cs);
                const float v = (rip == 0 ? (ri == 0 ? cs : sn) : (ri == 0 ? -sn : cs)) * 0.125f; Dt[i] = (bf16_t)(cvt_pk_bf16(v, 0.f) & 0xffffu); }
            for (int i = gt; i < 64 * 64 * 128; i += NT) { const int kp = i & 127, kbk = (i >> 7) & 63, ka = i >> 13, rip = kp >> 6, bp = kp & 63; float sn, cs; sincospif(2.0f * (float)((bp * (ka + 64 * kbk)) & 4095) / 4096.0f, &sn, &cs);
                const float v = (rip == 0 ? cs : sn) * 0.125f; Et[i] = (bf16_t)(cvt_pk_bf16(v, 0.f) & 0xffffu); }
        }
        if (c == G - 1 && wid == 7) {
            float mq = fabsf(gq[lane]), mk = fabsf(gk[lane]), mr = 0.f;
            for (int i = lane; i < 16 * 465; i += 64) mr = fmaxf(mr, fabsf(rpb[i]));
#pragma unroll
            for (int o = 1; o < 64; o <<= 1) { mq = fmaxf(mq, __shfl_xor(mq, o)); mk = fmaxf(mk, __shfl_xor(mk, o)); mr = fmaxf(mr, __shfl_xor(mr, o)); }
            if (lane == 0) *sbound = (8.0f * mq * mk + mr) * LOG2E;
        }
        __syncthreads();
        }
    }
    SEAM(0);
    const bool ctx_in_p1 = false;
    if (IN(1)) { PHASE_IDS;
        if (c == G - 1) {
            for (int i = tid_; i < 3 * 4096; i += 512) { const int idx = i >> 12, b = (i >> 10) & 3, col = i & 1023;
                const float gg = norm_g[(idx == 0 ? 1024 : idx == 1 ? 2048 : 3072) + col];
                const float sc = mods[(size_t)((idx == 0 ? 0 : 5) + b) * 6144 + (idx == 1 ? 1024 : 4096) + col];
                GM[i] = gg * (1.0f + sc); }
        }
        if (!ctx_in_p1) norm_rows(x, ctx, MT, norm_g, mods, 0, 1024, H, gw, NGW, lane);
        else if (c >= 32) norm_rows(x, ctx, ML, norm_g, mods, 0, 1024, H, (c - 32) * 8 + wid, (G - 32) * 8, lane);
        else {
            pg8::SchedOne S1u; const size_t ts = (size_t)256 * 1024 * 2; int tt;
            if (c < 16) { S1u.u.kind = 0; S1u.u.pm = 64 + (c & 3); S1u.u.pn = 4 + (c >> 2); tt = c & 3; S1u.u.a = (const char*)H + (size_t)S1u.u.pm * ts; S1u.u.b = (const char*)WQK + (size_t)S1u.u.pn * ts; }
            else { const int l2 = c - 16; S1u.u.kind = 1; S1u.u.pm = l2 & 3; S1u.u.pn = 64 + (l2 >> 2); tt = l2 >> 2; S1u.u.a = (const char*)WV + (size_t)S1u.u.pm * ts; S1u.u.b = (const char*)H + (size_t)S1u.u.pn * ts; }
            S1u.u.aux = 0;
            norm_rows(x, ctx, ML + tt * 256 + 256, norm_g, mods, 0, 1024, H, ML + tt * 256 + wid, 8, lane);
            asm volatile("s_waitcnt vmcnt(0)" ::: "memory"); __syncthreads();
            pg8::EpiQKV E{QK, VT, gq, gk};
            pg8::gemm_phase<pg8::EpiQKV, pg8::SchedOne, false>(lds, 1024, 1024, 1024, S1u, E);
        }
    }
    SEAM(1);
    DBG16(2, 0, H, (size_t)MT * 1024);
    if (IN(2)) { pg8::SchedQKV S{(const char*)H, (const char*)WQK, (const char*)WV, G, c, ctx_in_p1 ? 768 : 800}; pg8::EpiQKV E{QK, VT, gq, gk};
#ifndef REP_G2
#define REP_G2 1
#endif
        for (int r_ = 0; r_ < REP_G2; ++r_) pg8::gemm_phase<pg8::EpiQKV, pg8::SchedQKV, false>(lds, 1024, 1024, 1024, S, E);
        { PHASE_IDS;
          const bool part = (G > 32); const int w_ = part ? (c - 32) * 8 + wid : gw, nw_ = part ? (G - 32) * 8 : NGW;
          if (!part || c >= 32) {
              bias_items(W1t, CS, mods, BV0, BV1, BVF, w_, nw_, lane);
              LAS float* scr = (LAS float*)(lds + wid * 16384);
              constexpr int I_SQ = 16 * 32, I_2 = 64 * 32;
              for (int it = w_; it < I_SQ + I_2; it += nw_) {
                  if (it < I_SQ) p0_transpose_item(fw, 1024, 1024, FWt, nullptr, 0, scr, it, lane);
                  else p0_transpose_item(w2 + (size_t)4096 * 1024, 4096, 1024, W2t + (size_t)1024 * 4096, nullptr, 0, scr, it - I_SQ, lane);
              }
          } } }
    SEAM(2);
    DBG16(3, 1, QK, (size_t)ML * 2048); DBG16(3, 2, VT, (size_t)1024 * MT); DBG32(3, 13, mods, (size_t)10 * 6144);
#ifndef REP_ATT
#define REP_ATT 1
#endif
    if (IN(3)) { for (int rep = 0; rep < REP_ATT; ++rep) attn_phase(QK, VT, O, rpb, sbound, lds, G, c); }
    SEAM(3);
    DBG16(4, 3, O, (size_t)ML * 1024);
    if (IN(4)) { pg8::SchedStd S; S.init(O, WO, ML, 1024, 1024, 1024, G, c); pg8::EpiResF E{x, out, mods + 2048, GM, H, SSQ};
        pg8::gemm_phase<pg8::EpiResF, pg8::SchedStd, false>(lds, 1024, 1024, 1024, S, E); }
    SEAM(4);
    DBG32(5, 4, out, (size_t)ML * 1024);
    if (IN(6)) { pg8::SchedStd S; S.init(H, W1t, ML, 4096, 1024, 1024, G, c); pg8::EpiRelu2F E{HMID, 4096, BV0, SSQ};
        pg8::gemm_phase<pg8::EpiRelu2F, pg8::SchedStd, false>(lds, 1024, 1024, 1024, S, E); }
    SEAM(6);
    DBG16(7, 5, HMID, (size_t)ML * 4096);
    if (IN(7)) { pg8::SchedStd S; S.init(HMID, W2t, ML, 1024, 4096, 4096, G, c); pg8::EpiResF E{out, out, mods + 5120, GM + 4096, H, SSQ};
        pg8::gemm_phase<pg8::EpiResF, pg8::SchedStd, false>(lds, 4096, 4096, 4096, S, E); }
    SEAM(7);
    const float* mods1 = mods + 5 * 6144;
    DBG32(8, 6, out, (size_t)ML * 1024);
    if (IN(9)) { pg8::SchedF1 S{(const char*)CS, (const char*)H, G, c}; pg8::EpiZ0F E{Z0, BVF, SSQ};
        pg8::gemm_phase<pg8::EpiZ0F, pg8::SchedF1, true>(lds, 256, 256, 1024, S, E); }
    SEAM(9);
    DBG16(10, 7, Z0, (size_t)262144 * 128);
    if (IN(10)) { PHASE_IDS; for (int r_ = 0; r_ < REP_S12; ++r_) s1_phase(Z0, Dt, Z1, lds, gw, NGW); }
    SEAM(10);
    DBG16(11, 8, Z1, (size_t)262144 * 128);
    if (IN(11)) { PHASE_IDS; for (int r_ = 0; r_ < REP_S12; ++r_) s2_phase(Z1, Et, Fb, gw, NGW, lane); }
    SEAM(11);
    DBG16(12, 9, Fb, (size_t)ML * 1024);
    if (IN(12)) { pg8::SchedStd S; S.init(Fb, FWt, ML, 1024, 1024, 1024, G, c); pg8::EpiResF E{out, out, mods1 + 2048, GM + 8192, H, SSQ};
        pg8::gemm_phase<pg8::EpiResF, pg8::SchedStd, false>(lds, 1024, 1024, 1024, S, E); }
    SEAM(12);
    DBG32(13, 10, out, (size_t)ML * 1024);
    if (IN(14)) { pg8::SchedStd S; S.init(H, W1t + (size_t)4096 * 1024, ML, 4096, 1024, 1024, G, c); pg8::EpiRelu2F E{HMID, 4096, BV1, SSQ};
        pg8::gemm_phase<pg8::EpiRelu2F, pg8::SchedStd, false>(lds, 1024, 1024, 1024, S, E); }
    SEAM(14);
    DBG16(15, 11, HMID, (size_t)ML * 4096);
    if (IN(15)) { pg8::SchedStd S; S.init(HMID, W2t + (size_t)1024 * 4096, ML, 1024, 4096, 4096, G, c); pg8::EpiRes E{out, out, mods1 + 5120};
        pg8::gemm_phase<pg8::EpiRes, pg8::SchedStd, false>(lds, 4096, 4096, 4096, S, E); }
    SEAM(15);
    if (MK_DEBUG && IN(16)) {
        int t_ = threadIdx.x; asm volatile("" : "+v"(t_));
        bool bad = false;
        for (size_t i = (size_t)vcu * 512 + t_; i < (size_t)ML * 1024; i += (size_t)G * 512) { if ((__float_as_uint(out[i]) & 0x7f800000u) == 0x7f800000u) { bad = true; out[i] = 0.f; } }
        if (bad) atomicOr(dflags, 1u << 12);
    }
    SEAM(16);
    if (MK_DEBUG && IN(17)) {
        if (c == 0 && threadIdx.x == 0) { const unsigned f = *dflags; if (f) out[0] = 1.0e6f * (float)(__builtin_ctz(f) + 1) + 1.0e4f * (float)__builtin_popcount(f); }
    }
#undef IN
#undef SEAM
}

constexpr int NPHASE = MK_DEBUG ? 18 : 16;
#ifndef MK_USE_CG
#define MK_USE_CG 0
#endif
#ifndef MK_PER_PHASE
#define MK_PER_PHASE 0
#endif

extern "C" void kernel_launch(void* const* d_in, const int* in_sizes, int n_in, void* d_out, int out_size, void* d_ws, size_t ws_size, hipStream_t stream) {
    static int grid = 0;
    if (grid == 0) {
        if (n_in != 15 || out_size != ML * DM || ws_size < WS_END) { fprintf(stderr, "kernel_launch: unexpected shapes (n_in %d out %d ws %zu)\n", n_in, out_size, ws_size); grid = -1; return; }
        int dev = 0, cus = 0, per_cu = 0;
        hipGetDevice(&dev); hipDeviceGetAttribute(&cus, hipDeviceAttributeMultiprocessorCount, dev);
        hipFuncSetAttribute((const void*)fwd_kernel, hipFuncAttributeMaxDynamicSharedMemorySize, LDS_BYTES);
        if (hipOccupancyMaxActiveBlocksPerMultiprocessor(&per_cu, (const void*)fwd_kernel, 512, LDS_BYTES) != hipSuccess || per_cu < 1) { fprintf(stderr, "kernel_launch: occupancy query failed (%d)\n", per_cu); (void)hipGetLastError(); per_cu = 1; }
        grid = cus * 1;
        if (grid <= 0) grid = 256;
    }
    if (grid < 0) return;
    if (hipMemsetAsync((char*)d_ws + WS_BAR, 0, BAR_BYTES, stream) != hipSuccess) { fprintf(stderr, "kernel_launch: memset failed\n"); return; }
    Args a{};
    for (int i = 0; i < 15; ++i) a.in[i] = (const float*)d_in[i];
    a.out = (float*)d_out; a.ws = (unsigned char*)d_ws;
#if MK_PER_PHASE
    for (int p = 0; p < NPHASE; ++p) { a.ph_lo = p; a.ph_hi = p + 1; hipLaunchKernelGGL(fwd_kernel, dim3(grid), dim3(512), LDS_BYTES, stream, a); }
#else
    a.ph_lo = 0; a.ph_hi = NPHASE; a.use_cg = MK_USE_CG;
    void* kargs[] = {&a};
    hipError_t e = hipLaunchCooperativeKernel((const void*)fwd_kernel, dim3(grid), dim3(512), kargs, LDS_BYTES, stream);
    if (e != hipSuccess) fprintf(stderr, "cooperative launch failed: %s (grid %d)\n", hipGetErrorString(e), grid);
#endif
}
```

```cpp
#include <hip/hip_runtime.h>
#include <hip/hip_cooperative_groups.h>
#include <cstdio>
#include <cstdint>
namespace cg = cooperative_groups;

#define LAS __attribute__((address_space(3)))
typedef unsigned short bf16_t;
typedef short bf16x8 __attribute__((ext_vector_type(8)));
typedef short s16x4 __attribute__((ext_vector_type(4)));
typedef float f32x4 __attribute__((ext_vector_type(4)));
typedef unsigned u32x4 __attribute__((ext_vector_type(4)));
typedef unsigned u32x2 __attribute__((ext_vector_type(2)));

constexpr int DM = 1024, NB = 4, SEQ = 4096, CTXL = 256, FF = 4096;
constexpr int ML = NB * SEQ;
constexpr int MT = ML + NB * CTXL;
constexpr float LOG2E = 1.4426950408889634f;
constexpr float EPS = 1e-6f;

constexpr size_t MiB = 1u << 20;
constexpr size_t WS_MODS = 0;
constexpr size_t WS_SB = 512 * 1024;
constexpr size_t WS_BAR = 1 * MiB;
constexpr size_t BAR_BYTES = 16384;
constexpr size_t WS_CS = 2 * MiB;
constexpr size_t WS_D = 2 * MiB + 512 * 1024;
constexpr size_t WS_E = 3 * MiB;
constexpr size_t WS_WQK = 4 * MiB, WS_WV = 8 * MiB, WS_WO = 10 * MiB, WS_FW = 12 * MiB;
constexpr size_t WS_W1 = 14 * MiB;
constexpr size_t WS_W2 = 30 * MiB;
constexpr size_t WS_SSQ = 46 * MiB;
constexpr size_t WS_BV = 47 * MiB;
constexpr size_t WS_H = 48 * MiB;
constexpr size_t WS_R = 82 * MiB;
constexpr size_t WS_QK = WS_R;
constexpr size_t WS_VT = WS_R + 68 * MiB;
constexpr size_t WS_O = WS_R + 102 * MiB;
constexpr size_t WS_HMID = WS_R;
constexpr size_t WS_Z0 = WS_R;
constexpr size_t WS_Z1 = WS_R + 64 * MiB;
constexpr size_t WS_F = WS_R + 128 * MiB;
constexpr size_t WS_END = 256 * MiB;
static_assert(WS_F + 32 * MiB <= WS_END && WS_HMID + 128 * MiB <= WS_END && WS_O + 32 * MiB <= WS_END, "ws map");

constexpr int LDS_BYTES = 147456;

typedef __bf16 bf16v2_t __attribute__((ext_vector_type(2)));
typedef float f32v2_t __attribute__((ext_vector_type(2)));
__device__ __forceinline__ unsigned cvt_pk_bf16(float lo, float hi) { const f32v2_t v = {lo, hi}; const bf16v2_t r = __builtin_convertvector(v, bf16v2_t); return __builtin_bit_cast(unsigned, r); }
__device__ __forceinline__ f32x4 mfma16(bf16x8 a, bf16x8 b, f32x4 c) { return __builtin_amdgcn_mfma_f32_16x16x32_bf16(a, b, c, 0, 0, 0); }


#ifndef MK_WT
#define MK_WT 0
#endif
__device__ __forceinline__ void st16(void* p, u32x4 v) {
#if MK_WT
    asm volatile("global_store_dwordx4 %0, %1, off sc1\n\ts_nop 1" :: "v"(p), "v"(v) : "memory");
#else
    *(u32x4*)p = v;
#endif
}
__device__ __forceinline__ void st16f(void* p, f32x4 v) {
#if MK_WT
    asm volatile("global_store_dwordx4 %0, %1, off sc1\n\ts_nop 1" :: "v"(p), "v"(v) : "memory");
#else
    *(f32x4*)p = v;
#endif
}
__device__ __forceinline__ void st8(void* p, u32x2 v) {
#if MK_WT
    asm volatile("global_store_dwordx2 %0, %1, off sc1\n\ts_nop 1" :: "v"(p), "v"(v) : "memory");
#else
    *(u32x2*)p = v;
#endif
}
namespace pg8 {
constexpr int BM = 256, BK = 64, HALF = 128, HTB = HALF * BK * 2, STAGE_BYTES = 8 * HTB;
__device__ __forceinline__ int lds_byte(int r, int c) { const int st = (r >> 4) * 2 + (c >> 5), rr = r & 15, cc = c & 31, ob = rr * 64 + cc * 2; return st * 1024 + (ob ^ (((ob >> 9) & 1) << 5)); }
__device__ __forceinline__ void stage_rc(int b, int& R, int& C) { const int st = b / 1024, sb = b % 1024, swz = sb ^ (((sb >> 9) & 1) << 5); R = (st >> 1) * 16 + swz / 64; C = (st & 1) * 32 + (swz % 64) / 2; }
__device__ __forceinline__ int perm32(int rho) { const int n = rho >> 4, i = rho & 15; return 8 * (i >> 2) + 4 * n + (i & 3); }

struct Unit { int pm, pn, kind, aux; const char* a; const char* b; };

template <class Epi, class Sched, bool BMAP>
__device__ __forceinline__ void gemm_phase(LAS unsigned char* lds, const int K, const int lda, const int ldb, const Sched& S, const Epi& E, const size_t kstepA = 128, const size_t kstepB = 128) {
    int tid = threadIdx.x; asm volatile("" : "+v"(tid));
    const int wid = __builtin_amdgcn_readfirstlane(tid >> 6), lane = tid & 63, wr = wid >> 2, wc = wid & 3, fr = lane & 15, fq = lane >> 4;
    int nt = K / BK; asm volatile("" : "+s"(nt));
    unsigned voffA[2], voffB[2];
#pragma unroll
    for (int i = 0; i < 2; ++i) { int R, C; stage_rc(tid * 16 + i * 8192, R, C); const int Rb = (R & ~31) + perm32(R & 31);
        voffA[i] = (unsigned)(R * lda + C) * 2u;
        voffB[i] = BMAP ? (unsigned)((64 * (Rb & 63) + (Rb >> 6)) * ldb + C) * 2u : (unsigned)(Rb * ldb + C) * 2u; }
    const size_t hstepA = (size_t)HALF * lda * 2;
    const size_t hstepB = BMAP ? (size_t)2 * ldb * 2 : (size_t)HALF * ldb * 2;
    const unsigned ldsw = (unsigned)wid * 1024u;
    const int aoff = lds_byte(wr * 64 + fr, fq * 8), boff = lds_byte(wc * 32 + fr, fq * 8);
#define PG8_SA(b, h) (((b) * 2 + (h)) * HTB)
#define PG8_SB(b, h) ((4 + (b) * 2 + (h)) * HTB)
#define PG8_STAGE(bufoff, gbase, voff) do { _Pragma("unroll") for (int _i = 0; _i < 2; ++_i) \
        __builtin_amdgcn_global_load_lds((const unsigned*)((const char*)(gbase) + (voff)[_i]), (LAS unsigned*)(lds + (bufoff) + ldsw + _i * 8192), 16, 0, 0); } while (0)
#define PG8_LDA(dst, b, h) do { _Pragma("unroll") for (int m = 0; m < 4; ++m) _Pragma("unroll") for (int k = 0; k < 2; ++k) dst[m][k] = *(const LAS bf16x8*)(lds + PG8_SA(b, h) + aoff + m * 2048 + k * 1024); } while (0)
#define PG8_LDB(dst, b, h) do { _Pragma("unroll") for (int n = 0; n < 2; ++n) _Pragma("unroll") for (int k = 0; k < 2; ++k) dst[n][k] = *(const LAS bf16x8*)(lds + PG8_SB(b, h) + boff + n * 2048 + k * 1024); } while (0)
#define PG8_MMA(ai, bj, At, Bt) do { __builtin_amdgcn_s_setprio(1); _Pragma("unroll") for (int m = 0; m < 4; ++m) _Pragma("unroll") for (int n = 0; n < 2; ++n) _Pragma("unroll") for (int k = 0; k < 2; ++k) \
        acc[ai][bj][m][n] = __builtin_amdgcn_mfma_f32_16x16x32_bf16(Bt[n][k], At[m][k], acc[ai][bj][m][n], 0, 0, 0); __builtin_amdgcn_s_setprio(0); } while (0)
#define PG8_WAIT_V(n) asm volatile("s_waitcnt vmcnt(" #n ")" ::: "memory")
#define PG8_WAIT_L(n) asm volatile("s_waitcnt lgkmcnt(" #n ")" ::: "memory")
#define PG8_BAR __builtin_amdgcn_s_barrier()
#define PG8_SCHED __builtin_amdgcn_sched_barrier(0)
    Unit cur, nxt; int ui = 0;
    if (!S.next(0, cur)) return;
    f32x4 acc[2][2][4][2];
#pragma unroll
    for (int a = 0; a < 2; ++a)
#pragma unroll
        for (int b = 0; b < 2; ++b)
#pragma unroll
            for (int m = 0; m < 4; ++m)
#pragma unroll
                for (int n = 0; n < 2; ++n) acc[a][b][m][n] = (f32x4){0.f, 0.f, 0.f, 0.f};
    bf16x8 At[4][2], B0[2][2], B1[2][2];
    const char* cA = cur.a; const char* cB = cur.b;
    if constexpr (Epi::PREP) E.prep(cur, lds, 0, tid);
    PG8_STAGE(PG8_SB(0, 0), cB, voffB); PG8_STAGE(PG8_SB(0, 1), cB + hstepB, voffB); PG8_STAGE(PG8_SA(0, 0), cA, voffA); PG8_STAGE(PG8_SA(0, 1), cA + hstepA, voffA);
    if (wr == 1) PG8_BAR;
    PG8_WAIT_V(2); PG8_BAR;
    PG8_STAGE(PG8_SB(1, 0), cB + kstepB, voffB); PG8_STAGE(PG8_SA(1, 0), cA + kstepA, voffA); PG8_STAGE(PG8_SB(1, 1), cB + hstepB + kstepB, voffB);
    PG8_WAIT_V(6); PG8_BAR;
    for (;;) {
        const bool has_next = S.next(ui + 1, nxt);
        const char* nA = has_next ? nxt.a : cA; const char* nB = has_next ? nxt.b : cB;
        for (int t = 0; t < nt; t += 2) {
            const bool last = (t == nt - 2);
            const char* a1 = cA + (size_t)(t + 1) * kstepA;
            const char* a2 = last ? nA : cA + (size_t)(t + 2) * kstepA; const char* b2 = last ? nB : cB + (size_t)(t + 2) * kstepB;
            const char* a3 = a2 + kstepA; const char* b3 = b2 + kstepB;
            PG8_LDB(B0, 0, 0); PG8_LDB(B1, 0, 1); PG8_SCHED; PG8_LDA(At, 0, 0); PG8_STAGE(PG8_SA(1, 1), a1 + hstepA, voffA);
            PG8_WAIT_V(8); PG8_WAIT_L(0); PG8_BAR; PG8_MMA(0, 0, At, B0); PG8_MMA(0, 1, At, B1); PG8_BAR; PG8_SCHED;
            PG8_LDA(At, 0, 1); PG8_STAGE(PG8_SB(0, 0), b2, voffB); PG8_STAGE(PG8_SB(0, 1), b2 + hstepB, voffB); PG8_STAGE(PG8_SA(0, 0), a2, voffA);
            PG8_WAIT_V(8); PG8_WAIT_L(0); PG8_BAR; PG8_MMA(1, 0, At, B0); PG8_MMA(1, 1, At, B1); PG8_BAR; PG8_SCHED;
            PG8_LDB(B0, 1, 0); PG8_LDB(B1, 1, 1); PG8_SCHED; PG8_LDA(At, 1, 0); PG8_STAGE(PG8_SA(0, 1), a2 + hstepA, voffA);
            PG8_WAIT_V(8); PG8_WAIT_L(0); PG8_BAR; PG8_MMA(0, 0, At, B0); PG8_MMA(0, 1, At, B1); PG8_BAR; PG8_SCHED;
            PG8_LDA(At, 1, 1); PG8_STAGE(PG8_SB(1, 0), b3, voffB); PG8_STAGE(PG8_SB(1, 1), b3 + hstepB, voffB); PG8_STAGE(PG8_SA(1, 0), a3, voffA);
            PG8_WAIT_V(8); PG8_WAIT_L(0); PG8_BAR; PG8_MMA(1, 0, At, B0); PG8_MMA(1, 1, At, B1); PG8_BAR; PG8_SCHED;
        }
        if (wr == 0) PG8_BAR;
        if constexpr (Epi::PREP) { if (has_next) E.prep(nxt, lds, (ui + 1) & 1, tid); }
        E(acc, cur, wr, wc, fr, fq, lds, ui & 1);
        if (!has_next) break;
#pragma unroll
        for (int a = 0; a < 2; ++a)
#pragma unroll
            for (int b = 0; b < 2; ++b)
#pragma unroll
                for (int m = 0; m < 4; ++m)
#pragma unroll
                    for (int n = 0; n < 2; ++n) acc[a][b][m][n] = (f32x4){0.f, 0.f, 0.f, 0.f};
        cur = nxt; cA = nA; cB = nB; ++ui;
        if (wr == 1) PG8_BAR;
    }
    PG8_WAIT_V(0);
    PG8_BAR;
#undef PG8_SA
#undef PG8_SB
#undef PG8_STAGE
#undef PG8_LDA
#undef PG8_LDB
#undef PG8_MMA
#undef PG8_WAIT_V
#undef PG8_WAIT_L
#undef PG8_BAR
#undef PG8_SCHED
}

struct SchedStd {
    const char* A; const char* Bt; size_t tsA, tsB; int nM, nN, nwg, G, c;
    __device__ void init(const void* A_, const void* Bt_, int M, int N, int lda, int ldb, int G_, int c_, size_t tsA_ = 0) { A = (const char*)A_; Bt = (const char*)Bt_; tsA = tsA_ ? tsA_ : (size_t)BM * lda * 2; tsB = (size_t)BM * ldb * 2; nM = M / BM; nN = N / BM; nwg = nM * nN; G = G_; c = c_; }
    __device__ bool next(int i, Unit& u) const {
        const long L = (long)i * G + c; if (L >= nwg) return false;
        int wgid = (int)L; { const int q = nwg / 8, r = nwg % 8, xcd = wgid % 8, off = wgid / 8; wgid = (xcd < r ? xcd * (q + 1) : r * (q + 1) + (xcd - r) * q) + off; }
        const int nig = 8 * nN, gid = wgid / nig, fm = gid * 8, gsz = (nM - fm) < 8 ? (nM - fm) : 8;
        u.pm = fm + ((wgid % nig) % gsz); u.pn = (wgid % nig) / gsz; u.kind = 0; u.aux = 0;
        u.a = A + (size_t)u.pm * tsA; u.b = Bt + (size_t)u.pn * tsB; return true;
    }
};
struct SchedQKV {
    const char* H; const char* Wqk; const char* Wv; int G, c, nunits;
    __device__ bool next(int i, Unit& u) const {
        const long Ll = (long)i * G + c; if (Ll >= nunits) return false;
        const int L = (int)Ll; const size_t ts = (size_t)BM * 1024 * 2; u.aux = 0;
        if (L < 512) { const int x = L & 7, off = L >> 3; u.kind = 0; u.pm = 8 * x + (off & 7); u.pn = off >> 3; }
        else if (L < 768) { const int l2 = L - 512, x = l2 & 7, off = l2 >> 3; u.kind = 1; u.pm = off & 3; u.pn = 8 * x + (off >> 2); }
        else if (L < 784) { const int l2 = L - 768; u.kind = 0; u.pm = 64 + (l2 & 3); u.pn = 4 + (l2 >> 2); }
        else { const int l2 = L - 784; u.kind = 1; u.pm = l2 & 3; u.pn = 64 + (l2 >> 2); }
        if (u.kind == 0) { u.a = H + (size_t)u.pm * ts; u.b = Wqk + (size_t)u.pn * ts; }
        else { u.a = Wv + (size_t)u.pm * ts; u.b = H + (size_t)u.pn * ts; }
        return true;
    }
};
struct SchedOne { Unit u;
    __device__ __forceinline__ bool next(int i, Unit& o) const { if (i > 0) return false; o = u; return true; }
};
struct SchedF1 {
    const char* CS; const char* H; int G, c;
    __device__ bool next(int i, Unit& u) const {
        const long Ll = (long)i * G + c; if (Ll >= 512) return false;
        const int L = (int)Ll; const int t = L & 15, b = (L >> 4) & 3, g = (L >> 6) & 3, ri = L >> 8;
        u.pm = ri; u.pn = t; u.kind = g; u.aux = b;
        u.a = CS + (size_t)ri * 256 * 256 * 2; u.b = H + ((size_t)(b * 4096 + 4 * t) * 1024 + g * 256) * 2; return true;
    }
};

typedef f32x4 Acc[2][2][4][2];
__device__ __forceinline__ u32x4 pack8(f32x4 v0, f32x4 v1) { u32x4 w; w.x = cvt_pk_bf16(v0[0], v0[1]); w.y = cvt_pk_bf16(v0[2], v0[3]); w.z = cvt_pk_bf16(v1[0], v1[1]); w.w = cvt_pk_bf16(v1[2], v1[3]); return w; }

struct EpiQKV { static constexpr bool PREP = true; bf16_t* QK; bf16_t* VT; const float* gq; const float* gk;
    __device__ __forceinline__ void prep(const Unit& u, LAS unsigned char* lds, int slot, int tid) const {
        if (u.kind == 0 && tid < 64) { const bool isq = u.pn < 4; ((LAS float*)(lds + 131072))[slot * 512 + tid] = isq ? gq[tid] * (0.125f * LOG2E) : gk[tid]; }
    }
    __device__ __forceinline__ void operator()(const Acc& acc, const Unit& u, int wr, int wc, int fr, int fq, LAS unsigned char* lds, int slot) const {
        if (u.kind == 0) {
            const LAS float* gp = (const LAS float*)(lds + 131072) + slot * 512;
            f32x4 gv[2][2];
#pragma unroll
            for (int bj = 0; bj < 2; ++bj)
#pragma unroll
                for (int n = 0; n < 2; ++n) gv[bj][n] = *(const LAS f32x4*)(gp + 32 * bj + 8 * fq + 4 * n);
#pragma unroll
            for (int ai = 0; ai < 2; ++ai)
#pragma unroll
                for (int m = 0; m < 4; ++m) {
                    const int row = u.pm * BM + ai * HALF + wr * 64 + m * 16 + fr;
                    float ss = 0.f;
#pragma unroll
                    for (int bj = 0; bj < 2; ++bj)
#pragma unroll
                        for (int n = 0; n < 2; ++n) { const f32x4 x = acc[ai][bj][m][n]; ss += (x[0] * x[0] + x[1] * x[1]) + (x[2] * x[2] + x[3] * x[3]); }
                    ss += __shfl_xor(ss, 16); ss += __shfl_xor(ss, 32);
                    const float rstd = rsqrtf(ss * (1.0f / 64.0f) + EPS);
                    bf16_t* rowp = QK + (size_t)row * 2048 + u.pn * 256 + wc * 64 + 8 * fq;
#pragma unroll
                    for (int bj = 0; bj < 2; ++bj) st16(rowp + 32 * bj, pack8(acc[ai][bj][m][0] * rstd * gv[bj][0], acc[ai][bj][m][1] * rstd * gv[bj][1]));
                }
        } else {
#pragma unroll
            for (int ai = 0; ai < 2; ++ai)
#pragma unroll
                for (int m = 0; m < 4; ++m) {
                    const int row = u.pm * BM + ai * HALF + wr * 64 + m * 16 + fr;
                    bf16_t* rowp = VT + (size_t)row * MT + u.pn * 256 + wc * 32 + 8 * fq;
#pragma unroll
                    for (int bj = 0; bj < 2; ++bj) st16(rowp + bj * HALF, pack8(acc[ai][bj][m][0], acc[ai][bj][m][1]));
                }
        }
    }
};
struct EpiRelu2 { static constexpr bool PREP = false; bf16_t* O; int ldc;
    __device__ __forceinline__ void operator()(const Acc& acc, const Unit& u, int wr, int wc, int fr, int fq, LAS unsigned char*, int) const {
#pragma unroll
        for (int ai = 0; ai < 2; ++ai)
#pragma unroll
            for (int m = 0; m < 4; ++m) {
                const int row = u.pm * BM + ai * HALF + wr * 64 + m * 16 + fr;
                bf16_t* rowp = O + (size_t)row * ldc + u.pn * 256 + wc * 32 + 8 * fq;
#pragma unroll
                for (int bj = 0; bj < 2; ++bj) { f32x4 v0 = acc[ai][bj][m][0], v1 = acc[ai][bj][m][1];
#pragma unroll
                    for (int e = 0; e < 4; ++e) { const float a = fmaxf(v0[e], 0.f), b = fmaxf(v1[e], 0.f); v0[e] = a * a; v1[e] = b * b; }
                    *(u32x4*)(rowp + bj * HALF) = pack8(v0, v1); }
            }
    }
};
struct EpiRes { static constexpr bool PREP = false; const float* base; float* out; const float* gate;
    __device__ __forceinline__ void operator()(const Acc& acc, const Unit& u, int wr, int wc, int fr, int fq, LAS unsigned char*, int) const {
        const int col0 = u.pn * 256 + wc * 32 + 8 * fq;
        const float* gp = gate + (size_t)(u.pm >> 4) * 6144 + col0;
        f32x4 gv[2][2];
#pragma unroll
        for (int bj = 0; bj < 2; ++bj)
#pragma unroll
            for (int n = 0; n < 2; ++n) gv[bj][n] = *(const f32x4*)(gp + bj * HALF + 4 * n);
#pragma unroll
        for (int ai = 0; ai < 2; ++ai)
#pragma unroll
            for (int m = 0; m < 4; ++m) {
                const size_t off = (size_t)(u.pm * BM + ai * HALF + wr * 64 + m * 16 + fr) * 1024 + col0;
#pragma unroll
                for (int bj = 0; bj < 2; ++bj)
#pragma unroll
                    for (int n = 0; n < 2; ++n) { const f32x4 bs = *(const f32x4*)(base + off + bj * HALF + 4 * n);
                        *(f32x4*)(out + off + bj * HALF + 4 * n) = bs + gv[bj][n] * acc[ai][bj][m][n]; }
            }
    }
};
struct EpiZ0 { static constexpr bool PREP = false; bf16_t* Z0;
    __device__ __forceinline__ void operator()(const Acc& acc, const Unit& u, int wr, int wc, int fr, int fq, LAS unsigned char*, int) const {
        const int ri = u.pm, t = u.pn, g = u.kind, b = u.aux;
        bf16_t* p0 = Z0 + ((size_t)(((b * 4 + g) * 256 + wr * 64 + fr) * 64 + 4 * t + (wc >> 1))) * 128 + ri * 64 + 32 * (wc & 1) + 8 * fq;
#pragma unroll
        for (int ai = 0; ai < 2; ++ai)
#pragma unroll
            for (int m = 0; m < 4; ++m) {
#pragma unroll
                for (int bj = 0; bj < 2; ++bj)
                    *(u32x4*)(p0 + (size_t)(ai * HALF + m * 16) * 8192 + bj * 256) = pack8(acc[ai][bj][m][0], acc[ai][bj][m][1]);
                asm volatile("" ::: "memory");
            }
    }
};

constexpr int AUX_OFF = 131072;
struct EpiResF { static constexpr bool PREP = false; const float* base; float* out; const float* gate; const float* gm; bf16_t* XB; float* SSQ;
    __device__ __forceinline__ void operator()(const Acc& acc, const Unit& u, int wr, int wc, int fr, int fq, LAS unsigned char*, int) const {
        const int col0 = u.pn * 256 + wc * 32 + 8 * fq, b = u.pm >> 4;
        f32x4 gv[2][2], mv[2][2];
#pragma unroll
        for (int bj = 0; bj < 2; ++bj)
#pragma unroll
            for (int n = 0; n < 2; ++n) { gv[bj][n] = *(const f32x4*)(gate + (size_t)b * 6144 + col0 + bj * HALF + 4 * n); mv[bj][n] = *(const f32x4*)(gm + b * 1024 + col0 + bj * HALF + 4 * n); }
#pragma unroll
        for (int ai = 0; ai < 2; ++ai)
#pragma unroll
          for (int mh = 0; mh < 2; ++mh) {
            f32x4 pre[2][2][2];
#pragma unroll
            for (int m2 = 0; m2 < 2; ++m2) { const size_t off = (size_t)(u.pm * BM + ai * HALF + wr * 64 + (2 * mh + m2) * 16 + fr) * 1024 + col0;
#pragma unroll
                for (int bj = 0; bj < 2; ++bj)
#pragma unroll
                    for (int n = 0; n < 2; ++n) pre[m2][bj][n] = *(const f32x4*)(base + off + bj * HALF + 4 * n); }
            asm volatile("" ::: "memory");
#pragma unroll
            for (int m2 = 0; m2 < 2; ++m2) {
                const int m = 2 * mh + m2;
                const int row = u.pm * BM + ai * HALF + wr * 64 + m * 16 + fr;
                const size_t off = (size_t)row * 1024 + col0;
                float ss = 0.f;
#pragma unroll
                for (int bj = 0; bj < 2; ++bj) {
                    const f32x4 v0 = pre[m2][bj][0] + gv[bj][0] * acc[ai][bj][m][0];
                    const f32x4 v1 = pre[m2][bj][1] + gv[bj][1] * acc[ai][bj][m][1];
                    st16f(out + off + bj * HALF, v0); st16f(out + off + bj * HALF + 4, v1);
                    ss += ((v0[0] * v0[0] + v0[1] * v0[1]) + (v0[2] * v0[2] + v0[3] * v0[3])) + ((v1[0] * v1[0] + v1[1] * v1[1]) + (v1[2] * v1[2] + v1[3] * v1[3]));
                    st16(XB + off + bj * HALF, pack8(v0 * mv[bj][0], v1 * mv[bj][1]));
                }
                ss += __shfl_xor(ss, 16); ss += __shfl_xor(ss, 32);
                if (fq == 0) SSQ[(size_t)row * 16 + u.pn * 4 + wc] = ss;
            }
            asm volatile("" ::: "memory");
          }
    }
};
__device__ __forceinline__ float ssq_rstd(const float* SSQ, int row, int half) {
    const f32x4 a = *(const f32x4*)(SSQ + (size_t)row * 16 + half * 8), b = *(const f32x4*)(SSQ + (size_t)row * 16 + half * 8 + 4);
    float s = ((a[0] + a[1]) + (a[2] + a[3])) + ((b[0] + b[1]) + (b[2] + b[3]));
    s += __shfl_xor(s, 1);
    return rsqrtf(s * (1.0f / 1024.0f) + EPS);
}
struct EpiRelu2F { static constexpr bool PREP = true; bf16_t* O; int ldc; const float* BV; const float* SSQ;
    __device__ __forceinline__ void prep(const Unit& u, LAS unsigned char* lds, int slot, int tid) const {
        const float r = ssq_rstd(SSQ, u.pm * BM + (tid >> 1), tid & 1);
        LAS float* aux = (LAS float*)(lds + AUX_OFF) + slot * 512;
        if (!(tid & 1)) aux[tid >> 1] = r;
        if (tid < 256) aux[256 + tid] = BV[(size_t)(u.pm >> 4) * 4096 + u.pn * 256 + tid];
    }
    __device__ __forceinline__ void operator()(const Acc& acc, const Unit& u, int wr, int wc, int fr, int fq, LAS unsigned char* lds, int slot) const {
        const LAS float* rt = (const LAS float*)(lds + AUX_OFF) + slot * 512;
        const int col0 = u.pn * 256 + wc * 32 + 8 * fq;
        f32x4 bv[2][2];
#pragma unroll
        for (int bj = 0; bj < 2; ++bj)
#pragma unroll
            for (int n = 0; n < 2; ++n) bv[bj][n] = *(const LAS f32x4*)(rt + 256 + wc * 32 + 8 * fq + bj * HALF + 4 * n);
#pragma unroll
        for (int ai = 0; ai < 2; ++ai)
#pragma unroll
            for (int m = 0; m < 4; ++m) {
                const int rl = ai * HALF + wr * 64 + m * 16 + fr; const float rs = rt[rl];
                bf16_t* rowp = O + ((size_t)(u.pm * 64 + u.pn * 4 + (wc >> 1)) * 256 + rl) * 64 + (wc & 1) * 32 + 8 * fq;
#pragma unroll
                for (int bj = 0; bj < 2; ++bj) { f32x4 v0 = acc[ai][bj][m][0] * rs + bv[bj][0], v1 = acc[ai][bj][m][1] * rs + bv[bj][1];
#pragma unroll
                    for (int e = 0; e < 4; ++e) { const float a = fmaxf(v0[e], 0.f), c2 = fmaxf(v1[e], 0.f); v0[e] = a * a; v1[e] = c2 * c2; }
                    st16(rowp + bj * 2 * 256 * 64, pack8(v0, v1)); }
            }
    }
};
struct EpiZ0F { static constexpr bool PREP = true; bf16_t* Z0; const float* BVF; const float* SSQ;
    __device__ __forceinline__ void prep(const Unit& u, LAS unsigned char* lds, int slot, int tid) const {
        const int nl = tid >> 1, tok = u.aux * 4096 + 64 * (nl & 63) + 4 * u.pn + (nl >> 6);
        const float r = ssq_rstd(SSQ, tok, tid & 1);
        LAS float* aux = (LAS float*)(lds + AUX_OFF) + slot * 512;
        if (!(tid & 1)) aux[nl] = r;
        if (tid < 256) aux[256 + tid] = BVF[(size_t)(u.aux * 4 + u.kind) * 512 + u.pm * 256 + tid];
    }
    __device__ __forceinline__ void operator()(const Acc& acc, const Unit& u, int wr, int wc, int fr, int fq, LAS unsigned char* lds, int slot) const {
        const LAS float* rt = (const LAS float*)(lds + AUX_OFF) + slot * 512;
        const int ri = u.pm, t = u.pn, g = u.kind, b = u.aux;
        f32x4 rs[2][2];
#pragma unroll
        for (int bj = 0; bj < 2; ++bj)
#pragma unroll
            for (int n = 0; n < 2; ++n) rs[bj][n] = *(const LAS f32x4*)(rt + bj * HALF + wc * 32 + 8 * fq + 4 * n);
        const LAS float* bz = rt + 256 + wr * 64 + fr;
        bf16_t* p0 = Z0 + ((size_t)(((b * 4 + g) * 256 + wr * 64 + fr) * 64 + 4 * t + (wc >> 1))) * 128 + ri * 64 + 32 * (wc & 1) + 8 * fq;
#pragma unroll
        for (int ai = 0; ai < 2; ++ai)
#pragma unroll
            for (int m = 0; m < 4; ++m) {
                const float bb = bz[ai * HALF + m * 16];
#pragma unroll
                for (int bj = 0; bj < 2; ++bj)
                    st16(p0 + (size_t)(ai * HALF + m * 16) * 8192 + bj * 256, pack8(acc[ai][bj][m][0] * rs[bj][0] + bb, acc[ai][bj][m][1] * rs[bj][1] + bb));
                asm volatile("" ::: "memory");
            }
    }
};
}


#define XB_TMO      128
#define XB_XCNT(j)  (256  + 64 * (j))
#define XB_XSUB(j)  (1280 + 64 * (j))
#define XB_XGEN(j)  (2304 + 64 * (j))
#define XB_TOP      3328
#define XB_TOPGEN   3392
#define XCD_BAR_WORDS 3456
#define XB_SPIN_CAP (1u << 18)
__device__ __forceinline__ unsigned xb_ld(unsigned* p)              { return __hip_atomic_load(p, __ATOMIC_RELAXED, __HIP_MEMORY_SCOPE_AGENT); }
__device__ __forceinline__ unsigned xb_add(unsigned* p, unsigned v) { return __hip_atomic_fetch_add(p, v, __ATOMIC_RELAXED, __HIP_MEMORY_SCOPE_AGENT); }
__device__ __forceinline__ unsigned xb_xcc_id() { return (unsigned)__builtin_amdgcn_s_getreg((3 << 11) | 20) & 0xFu; }
#define XB_SPIN(cond, bar) do { unsigned _sp = 0; while (cond) { __builtin_amdgcn_s_sleep(1); \
    if ((++_sp & 255u) == 0u) { if (xb_ld(&(bar)[XB_TMO])) break; if (_sp > XB_SPIN_CAP) { atomicAdd(&(bar)[XB_TMO], 1u); break; } } } } while (0)
struct XcdBarrier { unsigned* bar; unsigned x; volatile LAS unsigned* st; };
__device__ __forceinline__ XcdBarrier xcd_barrier_post(unsigned* bar, volatile LAS unsigned* st) {
    XcdBarrier b; b.bar = bar; b.x = xb_xcc_id(); b.st = st;
    if (threadIdx.x == 0) (void)xb_add(&bar[XB_XCNT(b.x)], 1u);
    return b;
}
__device__ __forceinline__ void xcd_barrier_complete(unsigned* bar, unsigned x, unsigned& nloc, unsigned& nx) {
    const unsigned G = gridDim.x * gridDim.y * gridDim.z;
    unsigned sum, cnt, mine, sp = 0u;
    for (;;) {
        sum = 0u; cnt = 0u; mine = 0u;
#pragma unroll
        for (unsigned j = 0; j < 16; ++j) { const unsigned c = xb_ld(&bar[XB_XCNT(j)]); sum += c; cnt += (c > 0u) ? 1u : 0u; mine = (j == x) ? c : mine; }
        if (sum == G) break;
        __builtin_amdgcn_s_sleep(1);
        if ((++sp & 255u) == 0u) { if (xb_ld(&bar[XB_TMO])) break; if (sp > XB_SPIN_CAP) { atomicAdd(&bar[XB_TMO], 1u); break; } }
    }
    nloc = mine > 0u ? mine : 1u; nx = cnt > 0u ? cnt : 1u;
}
__device__ __forceinline__ void xcd_barrier(const XcdBarrier& b) {
    asm volatile("s_waitcnt vmcnt(0)" ::: "memory");
    __syncthreads();
    if (threadIdx.x == 0) {
        unsigned* bar = b.bar;
        __builtin_amdgcn_s_waitcnt(0);
        unsigned nloc = b.st[0], nx = b.st[1];
        if (nloc == 0u) { xcd_barrier_complete(bar, b.x, nloc, nx); b.st[0] = nloc; b.st[1] = nx; }
        const unsigned old = xb_add(&bar[XB_XSUB(b.x)], 1u);
        const unsigned gen = old / nloc;
        if (old + 1u == (gen + 1u) * nloc) {
            __builtin_amdgcn_fence(__ATOMIC_RELEASE, "agent");
            asm volatile("s_waitcnt vmcnt(0)" ::: "memory");
            const unsigned og = xb_add(&bar[XB_TOP], 1u);
            const unsigned tg = og / nx;
            if (og + 1u == (tg + 1u) * nx) xb_add(&bar[XB_TOPGEN], 1u);
            else XB_SPIN(xb_ld(&bar[XB_TOPGEN]) == tg, bar);
            __builtin_amdgcn_fence(__ATOMIC_ACQUIRE, "agent");
            xb_add(&bar[XB_XGEN(b.x)], 1u);
            asm volatile("s_waitcnt vmcnt(0)" ::: "memory");
        } else {
            XB_SPIN(xb_ld(&bar[XB_XGEN(b.x)]) == gen, bar);
            __builtin_amdgcn_fence(__ATOMIC_ACQUIRE, "agent");
            asm volatile("s_waitcnt vmcnt(0)" ::: "memory");
        }
    }
    __syncthreads();
}
__device__ __forceinline__ void p0_mods_unit(const float* c, const float* cctx, const float* ada_w, const float* ada_b, float* mods, LAS unsigned char* lds, int unit) {
    LAS float* s = (LAS float*)lds;
    LAS float* red = s + 5 * 1024;
    int tid = threadIdx.x; asm volatile("" : "+v"(tid));
    for (int i = tid; i < 5 * 1024; i += 512) { const int v = i >> 10, k = i & 1023; const float x = v < 4 ? c[v * 1024 + k] : cctx[k]; s[i] = x / (1.0f + __expf(-x)); }
    __syncthreads();
    const int l = unit / 96, col0 = (unit % 96) * 64, kc = tid >> 6, cl = tid & 63;
    const float* w = ada_w + (size_t)l * 1024 * 6144 + col0 + cl;
    float a0 = 0.f, a1 = 0.f, a2 = 0.f, a3 = 0.f, a4 = 0.f;
    for (int k = kc * 128; k < kc * 128 + 128; k += 32) {
        float wv[32];
#pragma unroll
        for (int j = 0; j < 32; ++j) wv[j] = w[(size_t)(k + j) * 6144];
#pragma unroll
        for (int j = 0; j < 32; ++j) { a0 += s[k + j] * wv[j]; a1 += s[1024 + k + j] * wv[j]; a2 += s[2048 + k + j] * wv[j]; a3 += s[3072 + k + j] * wv[j]; a4 += s[4096 + k + j] * wv[j]; }
    }
    red[(kc * 5 + 0) * 64 + cl] = a0; red[(kc * 5 + 1) * 64 + cl] = a1; red[(kc * 5 + 2) * 64 + cl] = a2; red[(kc * 5 + 3) * 64 + cl] = a3; red[(kc * 5 + 4) * 64 + cl] = a4;
    __syncthreads();
    if (tid < 320) { const int v = tid >> 6, cc = tid & 63; float t = 0.f;
#pragma unroll
        for (int kk = 0; kk < 8; ++kk) t += red[(kk * 5 + v) * 64 + cc];
        mods[(size_t)(l * 5 + v) * 6144 + col0 + cc] = t + ada_b[l * 6144 + col0 + cc]; }
    __syncthreads();
}

__device__ __forceinline__ void p0_transpose_item(const float* W, int K, int N, bf16_t* WT, bf16_t* WT2, int mode, LAS float* scr, int item, int lane) {
    const int nblk = N / 32, kb = item / nblk, nb = item % nblk, k0 = 64 * kb, n0 = 32 * nb;
    float wv_[32];
#pragma unroll
    for (int i = 0; i < 32; ++i) wv_[i] = W[(size_t)(k0 + 2 * i + (lane >> 5)) * N + n0 + (lane & 31)];
#pragma unroll
    for (int i = 0; i < 32; ++i) scr[(2 * i + (lane >> 5)) * 33 + (lane & 31)] = wv_[i];
    asm volatile("s_waitcnt lgkmcnt(0)" ::: "memory");
    const int cch = lane & 7;
#pragma unroll
    for (int j = 0; j < 4; ++j) { const int n = (lane >> 3) + 8 * j; const LAS float* s = scr + (8 * cch) * 33 + n;
        u32x4 o; o.x = cvt_pk_bf16(s[0 * 33], s[1 * 33]); o.y = cvt_pk_bf16(s[2 * 33], s[3 * 33]); o.z = cvt_pk_bf16(s[4 * 33], s[5 * 33]); o.w = cvt_pk_bf16(s[6 * 33], s[7 * 33]);
        const int ng = n0 + n; bf16_t* dst;
        if (mode == 0) dst = WT + (size_t)ng * K;
        else if (ng < 2048) { const int pn = ng >> 8, hh = (ng >> 6) & 3, d = ng & 63; const int tpos = (d >> 5) * 128 + hh * 32 + (d & 31); dst = WT + (size_t)(pn * 256 + tpos) * K; }
        else dst = WT2 + (size_t)(ng - 2048) * K;
        *(u32x4*)(dst + k0 + 8 * cch) = o; }
    asm volatile("s_waitcnt lgkmcnt(0)" ::: "memory");
}

__device__ __forceinline__ float wave_sum(float v) {
#pragma unroll
    for (int o = 1; o < 64; o <<= 1) v += __shfl_xor(v, o);
    return v;
}
__device__ __forceinline__ void norm_rows(const float* xlat, const float* xctx, int nrows, const float* g, const float* modsl, int sh_off, int sc_off, bf16_t* H, int gw, int NGW, int lane) {
    f32x4 gv[4];
#pragma unroll
    for (int j = 0; j < 4; ++j) gv[j] = *(const f32x4*)(g + lane * 4 + 256 * j);
    for (int row = gw; row < nrows; row += NGW) {
        const float* src = row < ML ? xlat + (size_t)row * 1024 : xctx + (size_t)(row - ML) * 1024;
        const int v = row < ML ? (row >> 12) : 4;
        const float* mp = modsl + (size_t)v * 6144;
        f32x4 x[4]; float ss = 0.f;
#pragma unroll
        for (int j = 0; j < 4; ++j) { x[j] = *(const f32x4*)(src + lane * 4 + 256 * j); ss += (x[j][0] * x[j][0] + x[j][1] * x[j][1]) + (x[j][2] * x[j][2] + x[j][3] * x[j][3]); }
        const float rstd = rsqrtf(wave_sum(ss) * (1.0f / 1024.0f) + EPS);
#pragma unroll
        for (int j = 0; j < 4; ++j) {
            const f32x4 sh = *(const f32x4*)(mp + sh_off + lane * 4 + 256 * j), sc = *(const f32x4*)(mp + sc_off + lane * 4 + 256 * j);
            const f32x4 y = (x[j] * rstd * gv[j]) * (sc + 1.0f) + sh;
            u32x2 w; w.x = cvt_pk_bf16(y[0], y[1]); w.y = cvt_pk_bf16(y[2], y[3]);
            *(u32x2*)(H + (size_t)row * 1024 + lane * 4 + 256 * j) = w;
        }
    }
}


__device__ __forceinline__ void bias_items(const bf16_t* W1t, const bf16_t* CS, const float* mods, float* BV0, float* BV1, float* BVF, int w, int NW, int lane) {
    for (int it = w; it < 8192 + 2048; it += NW) {
        float a0 = 0.f, a1 = 0.f, a2 = 0.f, a3 = 0.f; float* dst; int dstride;
        if (it < 8192) {
            const int l = it >> 12, n = it & 4095;
            const bf16_t* wr_ = W1t + (size_t)l * 4096 * 1024 + (size_t)n * 1024 + lane * 16;
            const u32x4 w0 = *(const u32x4*)wr_, w1 = *(const u32x4*)(wr_ + 8);
            const float* sh = mods + (size_t)l * 5 * 6144 + 3072 + lane * 16;
            float wf[16];
#pragma unroll
            for (int e = 0; e < 4; ++e) { wf[2 * e] = __uint_as_float(w0[e] << 16); wf[2 * e + 1] = __uint_as_float(w0[e] & 0xffff0000u); wf[8 + 2 * e] = __uint_as_float(w1[e] << 16); wf[8 + 2 * e + 1] = __uint_as_float(w1[e] & 0xffff0000u); }
#pragma unroll
            for (int q = 0; q < 4; ++q) {
                const f32x4 s0 = *(const f32x4*)(sh + 4 * q), s1 = *(const f32x4*)(sh + 6144 + 4 * q), s2 = *(const f32x4*)(sh + 2 * 6144 + 4 * q), s3 = *(const f32x4*)(sh + 3 * 6144 + 4 * q);
#pragma unroll
                for (int e = 0; e < 4; ++e) { a0 += s0[e] * wf[4 * q + e]; a1 += s1[e] * wf[4 * q + e]; a2 += s2[e] * wf[4 * q + e]; a3 += s3[e] * wf[4 * q + e]; }
            }
            dst = (l == 0 ? BV0 : BV1) + n; dstride = 4096;
        } else {
            const int idx = it - 8192, g = idx >> 9, m = idx & 511;
            const u32x2 w0 = *(const u32x2*)(CS + (size_t)m * 256 + lane * 4);
            const float wf0 = __uint_as_float(w0[0] << 16), wf1 = __uint_as_float(w0[0] & 0xffff0000u), wf2 = __uint_as_float(w0[1] << 16), wf3 = __uint_as_float(w0[1] & 0xffff0000u);
            const float* sh = mods + (size_t)5 * 6144 + g * 256 + lane * 4;
            const f32x4 s0 = *(const f32x4*)(sh), s1 = *(const f32x4*)(sh + 6144), s2 = *(const f32x4*)(sh + 2 * 6144), s3 = *(const f32x4*)(sh + 3 * 6144);
            a0 = s0[0] * wf0 + s0[1] * wf1 + s0[2] * wf2 + s0[3] * wf3; a1 = s1[0] * wf0 + s1[1] * wf1 + s1[2] * wf2 + s1[3] * wf3;
            a2 = s2[0] * wf0 + s2[1] * wf1 + s2[2] * wf2 + s2[3] * wf3; a3 = s3[0] * wf0 + s3[1] * wf1 + s3[2] * wf2 + s3[3] * wf3;
            dst = BVF + g * 512 + m; dstride = 2048;
        }
        a0 = wave_sum(a0); a1 = wave_sum(a1); a2 = wave_sum(a2); a3 = wave_sum(a3);
        if (lane == 0) { dst[0] = a0; dst[dstride] = a1; dst[2 * dstride] = a2; dst[3 * dstride] = a3; }
    }
}
template <bool MASKED>
__device__ __forceinline__ void attn_block(const LAS bf16_t* Ks, const LAS bf16_t* Vs, int kcol0, int fr, int g, const bf16x8 (&Qf)[2], f32x4 (&acc)[4], float& lsum,
                                           const LAS unsigned char* rpb_base  , const int (&dcb)[8], const f32x4& ciX, const f32x4& ciY) {
    bf16x8 KX[2], KY[2];
#pragma unroll
    for (int kk = 0; kk < 2; ++kk) { KX[kk] = *(const LAS bf16x8*)(Ks + (kcol0 + fr) * 72 + kk * 32 + g * 8); KY[kk] = *(const LAS bf16x8*)(Ks + (kcol0 + 16 + fr) * 72 + kk * 32 + g * 8); }
    s16x4 VX[4], VY[4];
#pragma unroll
    for (int db = 0; db < 4; ++db) { VX[db] = *(const LAS s16x4*)(Vs + (16 * db + fr) * 72 + kcol0 + 4 * g); VY[db] = *(const LAS s16x4*)(Vs + (16 * db + fr) * 72 + kcol0 + 16 + 4 * g); }
    f32x4 sX = mfma16(KX[0], Qf[0], ciX); sX = mfma16(KX[1], Qf[1], sX);
    f32x4 sY = mfma16(KY[0], Qf[0], ciY); sY = mfma16(KY[1], Qf[1], sY);
    f32x4 pX, pY;
    if (MASKED) {
#pragma unroll
        for (int ii = 0; ii < 4; ++ii) {
            const float bx = *(const LAS float*)(rpb_base + dcb[ii]), by = *(const LAS float*)(rpb_base + dcb[4 + ii]);
            pX[ii] = __builtin_amdgcn_exp2f(sX[ii] + bx);
            pY[ii] = __builtin_amdgcn_exp2f(sY[ii] + by);
        }
    } else {
#pragma unroll
        for (int ii = 0; ii < 4; ++ii) { pX[ii] = __builtin_amdgcn_exp2f(sX[ii]); pY[ii] = __builtin_amdgcn_exp2f(sY[ii]); }
    }
    lsum += ((pX[0] + pX[1]) + (pX[2] + pX[3])) + ((pY[0] + pY[1]) + (pY[2] + pY[3]));
    const u32x4 pw = pg8::pack8(pX, pY);
    const bf16x8 Pf = __builtin_bit_cast(bf16x8, pw);
#pragma unroll
    for (int db = 0; db < 4; ++db) {
        bf16x8 Vf; Vf[0] = VX[db][0]; Vf[1] = VX[db][1]; Vf[2] = VX[db][2]; Vf[3] = VX[db][3]; Vf[4] = VY[db][0]; Vf[5] = VY[db][1]; Vf[6] = VY[db][2]; Vf[7] = VY[db][3];
        acc[db] = mfma16(Vf, Pf, acc[db]);
    }
}
__device__ __forceinline__ void attn_phase(const bf16_t* QK, const bf16_t* VT, bf16_t* O, const float* rpb, const float* sbound, LAS unsigned char* lds, int G, int c) {
    constexpr int RP_BYTES = 30720, TILE_B = 64 * 72 * 2, SLOT_B = 2 * TILE_B, NSTEP = 13;
    LAS float* rp = (LAS float*)lds;
    int tid = threadIdx.x; asm volatile("" : "+v"(tid));
    const int lane = tid & 63, wid = __builtin_amdgcn_readfirstlane(tid >> 6), fr = lane & 15, g = lane >> 4;
    for (int i = tid; i < 16 * 465; i += 512) rp[i] = rpb[i] * LOG2E;
    const float Mb = *sbound;
    const int nunits = (2048 - c + G - 1) / G;
    const int NT = nunits * NSTEP;
    const int trow = tid >> 3, tch = tid & 7;
    const int ldsoff = (trow * 72 + tch * 8) * 2;
#define ATT_DEC(L_, b_, h_, rp_) do { const int x_ = (L_) & 7, q_ = (L_) >> 3; rp_ = q_ & 31; const int bh_ = 8 * (q_ >> 5) + x_; b_ = bh_ >> 4; h_ = bh_ & 15; } while (0)
#define ATT_GLOAD(T_, pk_, pv_) do { const int u_ = (T_) / NSTEP, t_ = (T_) - u_ * NSTEP; int b_, h_, rp_; ATT_DEC(u_ * G + c, b_, h_, rp_); \
        const int rs0_ = min(max(2 * rp_ - 4, 0), 56); const int tok0_ = t_ < 9 ? b_ * 4096 + min(rs0_ + t_, 63) * 64 : ML + b_ * 256 + 64 * (t_ - 9); \
        pk_ = *(const u32x4*)(QK + (size_t)(tok0_ + trow) * 2048 + 1024 + h_ * 64 + tch * 8); \
        pv_ = *(const u32x4*)(VT + (size_t)(h_ * 64 + trow) * MT + tok0_ + tch * 8); } while (0)
#define ATT_LWRITE(slot_, pk_, pv_) do { *(LAS u32x4*)(lds + RP_BYTES + (slot_) * SLOT_B + ldsoff) = pk_; *(LAS u32x4*)(lds + RP_BYTES + (slot_) * SLOT_B + TILE_B + ldsoff) = pv_; } while (0)
    u32x4 pk0, pv0, pk1, pv1, pk2, pv2;
    ATT_GLOAD(0, pk0, pv0); ATT_LWRITE(0, pk0, pv0);
    if (NT > 1) ATT_GLOAD(1, pk1, pv1);
    if (NT > 2) ATT_GLOAD(2, pk2, pv2);
    if (NT > 3) ATT_GLOAD(3, pk0, pv0);
    __syncthreads();
    int b = 0, h = 0, rpair = 0, r = 0, rs0 = 0, rsr = 0, qrow = 0;
    const int j = wid & 3, w0 = (j == 0) ? 0 : (j == 1) ? 8 : (j == 2) ? 24 : 32;
    int dcb[8]; f32x4 ciX, ciY, ciU;
    {
        const int cq = 16 * j + fr, cs = min(max(cq - 8, 0), 48), eX = w0 + 4 * g - cs, dX = w0 + 4 * g - cq + 15;
#pragma unroll
        for (int ii = 0; ii < 4; ++ii) {
            dcb[ii] = 4 * min(max(dX + ii, 0), 30); dcb[4 + ii] = 4 * min(max(dX + 16 + ii, 0), 30);
            ciX[ii] = ((unsigned)(eX + ii) < 16u) ? -Mb : -1.0e30f; ciY[ii] = ((unsigned)(eX + 16 + ii) < 16u) ? -Mb : -1.0e30f; ciU[ii] = -Mb;
        }
    }
    bf16x8 Qf[2], Qn[2]; f32x4 acc[4]; float lsum = 0.f;
    int t = 0, u = 0, T = 0;
#define ATT_QLOAD(dst, uu) do { int b_, h_, rp_; ATT_DEC((uu) * G + c, b_, h_, rp_); const int qr_ = b_ * 4096 + (2 * rp_ + (wid >> 2)) * 64 + 16 * j + fr; \
        _Pragma("unroll") for (int kk = 0; kk < 2; ++kk) dst[kk] = *(const bf16x8*)(QK + (size_t)qr_ * 2048 + h_ * 64 + 32 * kk + 8 * g); } while (0)
    ATT_QLOAD(Qn, 0);
#define ATT_ITER(PK, PV) do { \
        const int slot = T & 1; \
        if (T + 1 < NT) ATT_LWRITE(slot ^ 1, PK, PV); \
        if (T + 4 < NT) ATT_GLOAD(T + 4, PK, PV); \
        if (t == 0) { \
            ATT_DEC(u * G + c, b, h, rpair); \
            r = 2 * rpair + (wid >> 2); rs0 = min(max(2 * rpair - 4, 0), 56); rsr = min(max(r - 4, 0), 56); \
            qrow = b * 4096 + r * 64 + 16 * j + fr; \
            Qf[0] = Qn[0]; Qf[1] = Qn[1]; \
            _Pragma("unroll") for (int db = 0; db < 4; ++db) acc[db] = (f32x4){0.f, 0.f, 0.f, 0.f}; \
            lsum = 0.f; \
        } \
        if (t == 8 && u + 1 < nunits) ATT_QLOAD(Qn, u + 1); \
        const LAS bf16_t* Ks = (const LAS bf16_t*)(lds + RP_BYTES + slot * SLOT_B); \
        const LAS bf16_t* Vs = (const LAS bf16_t*)(lds + RP_BYTES + slot * SLOT_B + TILE_B); \
        if (t < 9) { \
            const int kr = rs0 + t, i = kr - rsr; \
            if (i >= 0 && i < 8) attn_block<true>(Ks, Vs, w0, fr, g, Qf, acc, lsum, (const LAS unsigned char*)rp + (h * 465 + (kr - r + 7) * 31) * 4, dcb, ciX, ciY); \
        } else { \
            attn_block<false>(Ks, Vs, 0, fr, g, Qf, acc, lsum, (const LAS unsigned char*)rp, dcb, ciU, ciU); \
            attn_block<false>(Ks, Vs, 32, fr, g, Qf, acc, lsum, (const LAS unsigned char*)rp, dcb, ciU, ciU); \
        } \
        if (t == NSTEP - 1) { \
            float ls = lsum; ls += __shfl_xor(ls, 16); ls += __shfl_xor(ls, 32); \
            const float inv = 1.0f / ls; \
            bf16_t* op = O + (size_t)qrow * 1024 + h * 64 + 4 * g; \
            _Pragma("unroll") for (int db = 0; db < 4; ++db) { u32x2 w; w.x = cvt_pk_bf16(acc[db][0] * inv, acc[db][1] * inv); w.y = cvt_pk_bf16(acc[db][2] * inv, acc[db][3] * inv); st8(op + 16 * db, w); } \
            t = 0; ++u; \
        } else ++t; \
        __syncthreads(); \
    } while (0)
    for (;;) {
        ATT_ITER(pk1, pv1); if (++T >= NT) break;
        ATT_ITER(pk2, pv2); if (++T >= NT) break;
        ATT_ITER(pk0, pv0); if (++T >= NT) break;
    }
#undef ATT_ITER
#undef ATT_QLOAD
#undef ATT_DEC
#undef ATT_GLOAD
#undef ATT_LWRITE
}

__device__ __forceinline__ void s1_phase(const bf16_t* Z0, const bf16_t* Dg, bf16_t* Z1, LAS unsigned char* lds, int gw, int NGW) {
    constexpr int DP = 136;
    LAS bf16_t* Dl = (LAS bf16_t*)lds;
    int tid = threadIdx.x; asm volatile("" : "+v"(tid));
    const int lane = tid & 63, fr = lane & 15, g = lane >> 4;
    for (int i = tid; i < 128 * 16; i += 512) { const int row = i >> 4, ch = i & 15; *(LAS u32x4*)(Dl + row * DP + ch * 8) = *(const u32x4*)(Dg + row * 128 + ch * 8); }
    __syncthreads();
    for (int colM = gw; colM < 4096; colM += NGW) {
        bf16x8 A[4][4];
#pragma unroll
        for (int ib = 0; ib < 4; ++ib)
#pragma unroll
            for (int kb = 0; kb < 4; ++kb) A[ib][kb] = *(const bf16x8*)(Z0 + ((size_t)colM * 64 + 16 * ib + fr) * 128 + 32 * kb + 8 * g);
#pragma unroll 2
        for (int jb = 0; jb < 8; ++jb) {
            bf16x8 Bf[4];
#pragma unroll
            for (int kb = 0; kb < 4; ++kb) Bf[kb] = *(const LAS bf16x8*)(Dl + (16 * jb + fr) * DP + 32 * kb + 8 * g);
            const int n = 16 * jb + fr, ka = n >> 1, rip = n & 1;
#pragma unroll
            for (int ib = 0; ib < 4; ++ib) {
                f32x4 a = (f32x4){0.f, 0.f, 0.f, 0.f};
#pragma unroll
                for (int kb = 0; kb < 4; ++kb) a = mfma16(A[ib][kb], Bf[kb], a);
                u32x2 w; w.x = cvt_pk_bf16(a[0], a[1]); w.y = cvt_pk_bf16(a[2], a[3]);
                st8(Z1 + (((size_t)ka * 4096 + colM) * 2 + rip) * 64 + 16 * ib + 4 * g, w);
            }
        }
    }
    __syncthreads();
}
__device__ __forceinline__ void s2_phase(const bf16_t* Z1, const bf16_t* Eg, bf16_t* F, int gw, int NGW, int lane) {
    const int fr = lane & 15, g = lane >> 4;
    for (int it = gw; it < 2048; it += NGW) {
        const int ka = it & 63, chunk = it >> 6;
        bf16x8 Bf[4][4];
#pragma unroll
        for (int jb = 0; jb < 4; ++jb)
#pragma unroll
            for (int kb = 0; kb < 4; ++kb) Bf[jb][kb] = *(const bf16x8*)(Eg + ((size_t)ka * 64 + 16 * jb + fr) * 128 + 32 * kb + 8 * g);
        for (int ib = 0; ib < 8; ++ib) {
            const int colM0 = chunk * 128 + ib * 16;
            bf16x8 A[4];
#pragma unroll
            for (int kb = 0; kb < 4; ++kb) A[kb] = *(const bf16x8*)(Z1 + ((size_t)ka * 4096 + colM0 + fr) * 128 + 32 * kb + 8 * g);
            const int cm = colM0 + 4 * g, b = cm >> 10, ch = cm & 1023;
#pragma unroll
            for (int jb = 0; jb < 4; ++jb) {
                f32x4 a = (f32x4){0.f, 0.f, 0.f, 0.f};
#pragma unroll
                for (int kb = 0; kb < 4; ++kb) a = mfma16(A[kb], Bf[jb][kb], a);
                const int kbk = 16 * jb + fr;
                u32x2 w; w.x = cvt_pk_bf16(a[0], a[1]); w.y = cvt_pk_bf16(a[2], a[3]);
                st8(F + ((size_t)b * 4096 + ka + 64 * kbk) * 1024 + ch, w);
            }
        }
    }
}


#ifndef MK_DEBUG
#define MK_DEBUG 0
#endif
__device__ __forceinline__ void dbg_scan16(const bf16_t* p, size_t n, unsigned* flags, unsigned bit, int gt, int NT) {
    bool bad = false; for (size_t i = gt; i < n; i += NT) bad |= ((p[i] & 0x7f80u) == 0x7f80u);
    if (bad) atomicOr(flags, 1u << bit);
}
__device__ __forceinline__ void dbg_scan32(const float* p, size_t n, unsigned* flags, unsigned bit, int gt, int NT) {
    bool bad = false; for (size_t i = gt; i < n; i += NT) bad |= ((__float_as_uint(p[i]) & 0x7f800000u) == 0x7f800000u);
    if (bad) atomicOr(flags, 1u << bit);
}
struct Args { const float* in[15]; float* out; unsigned char* ws; int ph_lo, ph_hi, use_cg, pad; };
static_assert(sizeof(Args) == 15 * 8 + 8 + 8 + 16, "no padding");

__global__ void __launch_bounds__(512, 2) fwd_kernel(Args args) {
    extern __shared__ __attribute__((aligned(16))) unsigned char lds_raw[];
    LAS unsigned char* lds = (LAS unsigned char*)lds_raw;
    const int G = gridDim.x, c = blockIdx.x;
    const int vcu = (G % 8 == 0) ? (c % 8) * (G / 8) + c / 8 : c;
    const int NGW = G * 8;
#define PHASE_IDS int tid_ = threadIdx.x; asm volatile("" : "+v"(tid_)); const int lane = tid_ & 63, wid = __builtin_amdgcn_readfirstlane(tid_ >> 6); const int gw = vcu * 8 + wid; (void)lane; (void)gw
    unsigned char* ws = args.ws;
    const float* x = args.in[0]; const float* cvec = args.in[1]; const float* ctx = args.in[2]; const float* cctx = args.in[3];
    const float* ada_w = args.in[4]; const float* ada_b = args.in[5]; const float* norm_g = args.in[6];
    const float* wqkv = args.in[7]; const float* wo = args.in[8]; const float* gq = args.in[9]; const float* gk = args.in[10]; const float* rpb = args.in[11];
    const float* fw = args.in[12]; const float* w1 = args.in[13]; const float* w2 = args.in[14];
    float* out = args.out;
    float* mods = (float*)(ws + WS_MODS); float* sbound = (float*)(ws + WS_SB);
    bf16_t* CS = (bf16_t*)(ws + WS_CS); bf16_t* Dt = (bf16_t*)(ws + WS_D); bf16_t* Et = (bf16_t*)(ws + WS_E);
    bf16_t* WQK = (bf16_t*)(ws + WS_WQK); bf16_t* WV = (bf16_t*)(ws + WS_WV); bf16_t* WO = (bf16_t*)(ws + WS_WO); bf16_t* FWt = (bf16_t*)(ws + WS_FW);
    bf16_t* W1t = (bf16_t*)(ws + WS_W1); bf16_t* W2t = (bf16_t*)(ws + WS_W2);
    bf16_t* H = (bf16_t*)(ws + WS_H); bf16_t* QK = (bf16_t*)(ws + WS_QK); bf16_t* VT = (bf16_t*)(ws + WS_VT); bf16_t* O = (bf16_t*)(ws + WS_O);
    bf16_t* HMID = (bf16_t*)(ws + WS_HMID); bf16_t* Z0 = (bf16_t*)(ws + WS_Z0); bf16_t* Z1 = (bf16_t*)(ws + WS_Z1); bf16_t* Fb = (bf16_t*)(ws + WS_F);
    float* SSQ = (float*)(ws + WS_SSQ); float* BV0 = (float*)(ws + WS_BV); float* BV1 = BV0 + 4 * 4096; float* BVF = BV1 + 4 * 4096; float* GM = BVF + 16 * 512;
    const int lo = args.ph_lo, hi = args.ph_hi;
    cg::grid_group grid = cg::this_grid();
#define IN(k) (lo <= (k) && (k) < hi)
#ifndef REP_SYNC
#define REP_SYNC 1
#endif
#ifndef REP_NORM
#define REP_NORM 1
#endif
#ifndef REP_S12
#define REP_S12 1
#endif
#ifndef REP_P0
#define REP_P0 1
#endif
#ifndef USE_XB
#define USE_XB 1
#endif
#define SEAM(k) do { if (IN(k) && IN((k) + 1)) { for (int r_ = 0; r_ < REP_SYNC; ++r_) { if (use_cg) grid.sync(); else xcd_barrier(xbar); } } } while (0)
    { volatile LAS unsigned* st_ = (volatile LAS unsigned*)(lds + LDS_BYTES - 64); if (threadIdx.x < 2) st_[threadIdx.x] = 0u; __syncthreads(); }
    XcdBarrier xbar; xbar.bar = (unsigned*)(ws + WS_BAR); xbar.x = 0; xbar.st = (volatile LAS unsigned*)(lds + LDS_BYTES - 64);
    const bool use_cg = (args.use_cg != 0);
    if (!use_cg && hi - lo > 1) xbar = xcd_barrier_post((unsigned*)(ws + WS_BAR), (volatile LAS unsigned*)(lds + LDS_BYTES - 64));

    unsigned* dflags = (unsigned*)(ws + WS_SB + 256);
#define DBG16(k, bit, p, n) do { if (MK_DEBUG && IN(k)) { int t_ = threadIdx.x; asm volatile("" : "+v"(t_)); dbg_scan16(p, n, dflags, bit, (vcu * 512) + t_, G * 512); } } while (0)
#define DBG32(k, bit, p, n) do { if (MK_DEBUG && IN(k)) { int t_ = threadIdx.x; asm volatile("" : "+v"(t_)); dbg_scan32(p, n, dflags, bit, (vcu * 512) + t_, G * 512); } } while (0)
    if (IN(0)) {
        PHASE_IDS;
        if (MK_DEBUG && c == 0 && tid_ == 0) *dflags = 0u;
        for (int r0_ = 0; r0_ < REP_P0; ++r0_) {
        for (int u = c; u < 192; u += G) p0_mods_unit(cvec, cctx, ada_w, ada_b, mods, lds, u);
        __syncthreads();
        {
            LAS float* scr = (LAS float*)(lds + wid * 16384);
            constexpr int I_QKV = 16 * 96, I_SQ = 16 * 32, I_1 = 16 * 128, I_2 = 64 * 32;
            constexpr int NITEMS = I_QKV + I_SQ + 2 * I_1 + I_2;
            for (int it = NITEMS - 1 - gw; it >= 0; it -= NGW) {
                int r = it;
                if (r < I_QKV) { p0_transpose_item(wqkv, 1024, 3072, WQK, WV, 1, scr, r, lane); continue; } r -= I_QKV;
                if (r < I_SQ) { p0_transpose_item(wo, 1024, 1024, WO, nullptr, 0, scr, r, lane); continue; } r -= I_SQ;
                if (r < 2 * I_1) { const int l = r / I_1; p0_transpose_item(w1 + (size_t)l * 1024 * 4096, 1024, 4096, W1t + (size_t)l * 4096 * 1024, nullptr, 0, scr, r % I_1, lane); continue; } r -= 2 * I_1;
                p0_transpose_item(w2, 4096, 1024, W2t, nullptr, 0, scr, r, lane);
            }
        }
        {
            const int gt = gw * 64 + lane, NT = NGW * 64;
            for (int i = gt; i < 512 * 256; i += NT) { const int m = i >> 8, cc = i & 255, ri = m >> 8, k2 = m & 255; float sn, cs; sincospif(2.0f * (float)((cc * k2) & 255) / 256.0f, &sn, &cs);
                const float v = (ri == 0 ? cs : -sn) * (1.0f / 16.0f); CS[i] = (bf16_t)(cvt_pk_bf16(v, 0.f) & 0xffffu); }
            for (int i = gt; i < 128 * 128; i += NT) { const int n = i >> 7, kp = i & 127, ka = n >> 1, rip = n & 1, ri = kp >> 6, a = kp & 63; float sn, cs; sincospif(2.0f * (float)((a * ka) & 63) / 64.0f, &sn, &cs);
                const float v = (rip == 0 ? (ri == 0 ? cs : sn) : (ri == 0 ? -sn : cs)) * 0.125f; Dt[i] = (bf16_t)(cvt_pk_bf16(v, 0.f) & 0xffffu); }
            for (int i = gt; i < 64 * 64 * 128; i += NT) { const int kp = i & 127, kbk = (i >> 7) & 63, ka = i >> 13, rip = kp >> 6, bp = kp & 63; float sn, cs; sincospif(2.0f * (float)((bp * (ka + 64 * kbk)) & 4095) / 4096.0f, &sn, &cs);
                const float v = (rip == 0 ? cs : sn) * 0.125f; Et[i] = (bf16_t)(cvt_pk_bf16(v, 0.f) & 0xffffu); }
        }
        if (c == G - 1 && wid == 7) {
            float mq = fabsf(gq[lane]), mk = fabsf(gk[lane]), mr = 0.f;
            for (int i = lane; i < 16 * 465; i += 64) mr = fmaxf(mr, fabsf(rpb[i]));
#pragma unroll
            for (int o = 1; o < 64; o <<= 1) { mq = fmaxf(mq, __shfl_xor(mq, o)); mk = fmaxf(mk, __shfl_xor(mk, o)); mr = fmaxf(mr, __shfl_xor(mr, o)); }
            if (lane == 0) *sbound = (8.0f * mq * mk + mr) * LOG2E;
        }
        __syncthreads();
        }
    }
    SEAM(0);
    const bool ctx_in_p1 = false;
    if (IN(1)) { PHASE_IDS;
        if (c == G - 1) {
            for (int i = tid_; i < 3 * 4096; i += 512) { const int idx = i >> 12, b = (i >> 10) & 3, col = i & 1023;
                const float gg = norm_g[(idx == 0 ? 1024 : idx == 1 ? 2048 : 3072) + col];
                const float sc = mods[(size_t)((idx == 0 ? 0 : 5) + b) * 6144 + (idx == 1 ? 1024 : 4096) + col];
                GM[i] = gg * (1.0f + sc); }
        }
        if (!ctx_in_p1) norm_rows(x, ctx, MT, norm_g, mods, 0, 1024, H, gw, NGW, lane);
        else if (c >= 32) norm_rows(x, ctx, ML, norm_g, mods, 0, 1024, H, (c - 32) * 8 + wid, (G - 32) * 8, lane);
        else {
            pg8::SchedOne S1u; const size_t ts = (size_t)256 * 1024 * 2; int tt;
            if (c < 16) { S1u.u.kind = 0; S1u.u.pm = 64 + (c & 3); S1u.u.pn = 4 + (c >> 2); tt = c & 3; S1u.u.a = (const char*)H + (size_t)S1u.u.pm * ts; S1u.u.b = (const char*)WQK + (size_t)S1u.u.pn * ts; }
            else { const int l2 = c - 16; S1u.u.kind = 1; S1u.u.pm = l2 & 3; S1u.u.pn = 64 + (l2 >> 2); tt = l2 >> 2; S1u.u.a = (const char*)WV + (size_t)S1u.u.pm * ts; S1u.u.b = (const char*)H + (size_t)S1u.u.pn * ts; }
            S1u.u.aux = 0;
            norm_rows(x, ctx, ML + tt * 256 + 256, norm_g, mods, 0, 1024, H, ML + tt * 256 + wid, 8, lane);
            asm volatile("s_waitcnt vmcnt(0)" ::: "memory"); __syncthreads();
            pg8::EpiQKV E{QK, VT, gq, gk};
            pg8::gemm_phase<pg8::EpiQKV, pg8::SchedOne, false>(lds, 1024, 1024, 1024, S1u, E);
        }
    }
    SEAM(1);
    DBG16(2, 0, H, (size_t)MT * 1024);
    if (IN(2)) { pg8::SchedQKV S{(const char*)H, (const char*)WQK, (const char*)WV, G, c, ctx_in_p1 ? 768 : 800}; pg8::EpiQKV E{QK, VT, gq, gk};
#ifndef REP_G2
#define REP_G2 1
#endif
        for (int r_ = 0; r_ < REP_G2; ++r_) pg8::gemm_phase<pg8::EpiQKV, pg8::SchedQKV, false>(lds, 1024, 1024, 1024, S, E);
        { PHASE_IDS;
          const bool part = (G > 32); const int w_ = part ? (c - 32) * 8 + wid : gw, nw_ = part ? (G - 32) * 8 : NGW;
          if (!part || c >= 32) {
              bias_items(W1t, CS, mods, BV0, BV1, BVF, w_, nw_, lane);
              LAS float* scr = (LAS float*)(lds + wid * 16384);
              constexpr int I_SQ = 16 * 32, I_2 = 64 * 32;
              for (int it = w_; it < I_SQ + I_2; it += nw_) {
                  if (it < I_SQ) p0_transpose_item(fw, 1024, 1024, FWt, nullptr, 0, scr, it, lane);
                  else p0_transpose_item(w2 + (size_t)4096 * 1024, 4096, 1024, W2t + (size_t)1024 * 4096, nullptr, 0, scr, it - I_SQ, lane);
              }
          } } }
    SEAM(2);
    DBG16(3, 1, QK, (size_t)ML * 2048); DBG16(3, 2, VT, (size_t)1024 * MT); DBG32(3, 13, mods, (size_t)10 * 6144);
#ifndef REP_ATT
#define REP_ATT 1
#endif
    if (IN(3)) { for (int rep = 0; rep < REP_ATT; ++rep) attn_phase(QK, VT, O, rpb, sbound, lds, G, c); }
    SEAM(3);
    DBG16(4, 3, O, (size_t)ML * 1024);
    if (IN(4)) { pg8::SchedStd S; S.init(O, WO, ML, 1024, 1024, 1024, G, c); pg8::EpiResF E{x, out, mods + 2048, GM, H, SSQ};
        pg8::gemm_phase<pg8::EpiResF, pg8::SchedStd, false>(lds, 1024, 1024, 1024, S, E); }
    SEAM(4);
    DBG32(5, 4, out, (size_t)ML * 1024);
    if (IN(6)) { pg8::SchedStd S; S.init(H, W1t, ML, 4096, 1024, 1024, G, c); pg8::EpiRelu2F E{HMID, 4096, BV0, SSQ};
        pg8::gemm_phase<pg8::EpiRelu2F, pg8::SchedStd, false>(lds, 1024, 1024, 1024, S, E); }
    SEAM(6);
    DBG16(7, 5, HMID, (size_t)ML * 4096);
    if (IN(7)) { pg8::SchedStd S; S.init(HMID, W2t, ML, 1024, 64, 4096, G, c, (size_t)64 * 32768); pg8::EpiResF E{out, out, mods + 5120, GM + 4096, H, SSQ};
        pg8::gemm_phase<pg8::EpiResF, pg8::SchedStd, false>(lds, 4096, 64, 4096, S, E, 32768, 128); }
    SEAM(7);
    const float* mods1 = mods + 5 * 6144;
    DBG32(8, 6, out, (size_t)ML * 1024);
    if (IN(9)) { pg8::SchedF1 S{(const char*)CS, (const char*)H, G, c}; pg8::EpiZ0F E{Z0, BVF, SSQ};
        pg8::gemm_phase<pg8::EpiZ0F, pg8::SchedF1, true>(lds, 256, 256, 1024, S, E); }
    SEAM(9);
    DBG16(10, 7, Z0, (size_t)262144 * 128);
    if (IN(10)) { PHASE_IDS; for (int r_ = 0; r_ < REP_S12; ++r_) s1_phase(Z0, Dt, Z1, lds, gw, NGW); }
    SEAM(10);
    DBG16(11, 8, Z1, (size_t)262144 * 128);
    if (IN(11)) { PHASE_IDS; for (int r_ = 0; r_ < REP_S12; ++r_) s2_phase(Z1, Et, Fb, gw, NGW, lane); }
    SEAM(11);
    DBG16(12, 9, Fb, (size_t)ML * 1024);
    if (IN(12)) { pg8::SchedStd S; S.init(Fb, FWt, ML, 1024, 1024, 1024, G, c); pg8::EpiResF E{out, out, mods1 + 2048, GM + 8192, H, SSQ};
        pg8::gemm_phase<pg8::EpiResF, pg8::SchedStd, false>(lds, 1024, 1024, 1024, S, E); }
    SEAM(12);
    DBG32(13, 10, out, (size_t)ML * 1024);
    if (IN(14)) { pg8::SchedStd S; S.init(H, W1t + (size_t)4096 * 1024, ML, 4096, 1024, 1024, G, c); pg8::EpiRelu2F E{HMID, 4096, BV1, SSQ};
        pg8::gemm_phase<pg8::EpiRelu2F, pg8::SchedStd, false>(lds, 1024, 1024, 1024, S, E); }
    SEAM(14);
    DBG16(15, 11, HMID, (size_t)ML * 4096);
    if (IN(15)) { pg8::SchedStd S; S.init(HMID, W2t + (size_t)1024 * 4096, ML, 1024, 64, 4096, G, c, (size_t)64 * 32768); pg8::EpiRes E{out, out, mods1 + 5120};
        pg8::gemm_phase<pg8::EpiRes, pg8::SchedStd, false>(lds, 4096, 64, 4096, S, E, 32768, 128); }
    SEAM(15);
    if (MK_DEBUG && IN(16)) {
        int t_ = threadIdx.x; asm volatile("" : "+v"(t_));
        bool bad = false;
        for (size_t i = (size_t)vcu * 512 + t_; i < (size_t)ML * 1024; i += (size_t)G * 512) { if ((__float_as_uint(out[i]) & 0x7f800000u) == 0x7f800000u) { bad = true; out[i] = 0.f; } }
        if (bad) atomicOr(dflags, 1u << 12);
    }
    SEAM(16);
    if (MK_DEBUG && IN(17)) {
        if (c == 0 && threadIdx.x == 0) { const unsigned f = *dflags; if (f) out[0] = 1.0e6f * (float)(__builtin_ctz(f) + 1) + 1.0e4f * (float)__builtin_popcount(f); }
    }
#undef IN
#undef SEAM
}

constexpr int NPHASE = MK_DEBUG ? 18 : 16;
#ifndef MK_USE_CG
#define MK_USE_CG 0
#endif
#ifndef MK_PER_PHASE
#define MK_PER_PHASE 0
#endif

extern "C" void kernel_launch(void* const* d_in, const int* in_sizes, int n_in, void* d_out, int out_size, void* d_ws, size_t ws_size, hipStream_t stream) {
    static int grid = 0;
    if (grid == 0) {
        if (n_in != 15 || out_size != ML * DM || ws_size < WS_END) { fprintf(stderr, "kernel_launch: unexpected shapes (n_in %d out %d ws %zu)\n", n_in, out_size, ws_size); grid = -1; return; }
        int dev = 0, cus = 0, per_cu = 0;
        hipGetDevice(&dev); hipDeviceGetAttribute(&cus, hipDeviceAttributeMultiprocessorCount, dev);
        hipFuncSetAttribute((const void*)fwd_kernel, hipFuncAttributeMaxDynamicSharedMemorySize, LDS_BYTES);
        if (hipOccupancyMaxActiveBlocksPerMultiprocessor(&per_cu, (const void*)fwd_kernel, 512, LDS_BYTES) != hipSuccess || per_cu < 1) { fprintf(stderr, "kernel_launch: occupancy query failed (%d)\n", per_cu); (void)hipGetLastError(); per_cu = 1; }
        grid = cus * 1;
        if (grid <= 0) grid = 256;
    }
    if (grid < 0) return;
    if (hipMemsetAsync((char*)d_ws + WS_BAR, 0, BAR_BYTES, stream) != hipSuccess) { fprintf(stderr, "kernel_launch: memset failed\n"); return; }
    Args a{};
    for (int i = 0; i < 15; ++i) a.in[i] = (const float*)d_in[i];
    a.out = (float*)d_out; a.ws = (unsigned char*)d_ws;
#if MK_PER_PHASE
    for (int p = 0; p < NPHASE; ++p) { a.ph_lo = p; a.ph_hi = p + 1; hipLaunchKernelGGL(fwd_kernel, dim3(grid), dim3(512), LDS_BYTES, stream, a); }
#else
    a.ph_lo = 0; a.ph_hi = NPHASE; a.use_cg = MK_USE_CG;
    void* kargs[] = {&a};
    hipError_t e = hipLaunchCooperativeKernel((const void*)fwd_kernel, dim3(grid), dim3(512), kargs, LDS_BYTES, stream);
    if (e != hipSuccess) fprintf(stderr, "cooperative launch failed: %s (grid %d)\n", hipGetErrorString(e), grid);
#endif
}
```

```cpp
#include <hip/hip_runtime.h>
#include <hip/hip_cooperative_groups.h>
#include <cstdio>
#include <cstdint>
namespace cg = cooperative_groups;

#define LAS __attribute__((address_space(3)))
typedef unsigned short bf16_t;
typedef short bf16x8 __attribute__((ext_vector_type(8)));
typedef short s16x4 __attribute__((ext_vector_type(4)));
typedef float f32x4 __attribute__((ext_vector_type(4)));
typedef unsigned u32x4 __attribute__((ext_vector_type(4)));
typedef unsigned u32x2 __attribute__((ext_vector_type(2)));

constexpr int DM = 1024, NB = 4, SEQ = 4096, CTXL = 256, FF = 4096;
constexpr int ML = NB * SEQ;
constexpr int MT = ML + NB * CTXL;
constexpr float LOG2E = 1.4426950408889634f;
constexpr float EPS = 1e-6f;

constexpr size_t MiB = 1u << 20;
constexpr size_t WS_MODS = 0;
constexpr size_t WS_SB = 512 * 1024;
constexpr size_t WS_BAR = 1 * MiB;
constexpr size_t BAR_BYTES = 16384;
constexpr size_t WS_CS = 2 * MiB;
constexpr size_t WS_D = 2 * MiB + 512 * 1024;
constexpr size_t WS_E = 3 * MiB;
constexpr size_t WS_WQK = 4 * MiB, WS_WV = 8 * MiB, WS_WO = 10 * MiB, WS_FW = 12 * MiB;
constexpr size_t WS_W1 = 14 * MiB;
constexpr size_t WS_W2 = 30 * MiB;
constexpr size_t WS_SSQ = 46 * MiB;
constexpr size_t WS_BV = 47 * MiB;
constexpr size_t WS_H = 48 * MiB;
constexpr size_t WS_R = 82 * MiB;
constexpr size_t WS_QK = WS_R;
constexpr size_t WS_VT = WS_R + 68 * MiB;
constexpr size_t WS_O = WS_R + 102 * MiB;
constexpr size_t WS_HMID = WS_R;
constexpr size_t WS_Z0 = WS_R;
constexpr size_t WS_Z1 = WS_R + 64 * MiB;
constexpr size_t WS_F = WS_R;
constexpr size_t WS_XS = WS_R + 134 * MiB;
constexpr size_t WS_END = 256 * MiB;
static_assert(WS_XS + 32 * MiB <= WS_END && WS_O + 32 * MiB <= WS_XS && WS_F + 32 * MiB <= WS_END && WS_HMID + 128 * MiB <= WS_END && WS_O + 32 * MiB <= WS_END, "ws map");

constexpr int LDS_BYTES = 147456;

typedef __bf16 bf16v2_t __attribute__((ext_vector_type(2)));
typedef float f32v2_t __attribute__((ext_vector_type(2)));
__device__ __forceinline__ unsigned cvt_pk_bf16(float lo, float hi) { const f32v2_t v = {lo, hi}; const bf16v2_t r = __builtin_convertvector(v, bf16v2_t); return __builtin_bit_cast(unsigned, r); }
__device__ __forceinline__ f32x4 mfma16(bf16x8 a, bf16x8 b, f32x4 c) { return __builtin_amdgcn_mfma_f32_16x16x32_bf16(a, b, c, 0, 0, 0); }


#ifndef MK_WT
#define MK_WT 0
#endif
__device__ __forceinline__ void st16(void* p, u32x4 v) {
#if MK_WT
    asm volatile("global_store_dwordx4 %0, %1, off sc1\n\ts_nop 1" :: "v"(p), "v"(v) : "memory");
#else
    *(u32x4*)p = v;
#endif
}
__device__ __forceinline__ void st16f(void* p, f32x4 v) {
#if MK_WT
    asm volatile("global_store_dwordx4 %0, %1, off sc1\n\ts_nop 1" :: "v"(p), "v"(v) : "memory");
#else
    *(f32x4*)p = v;
#endif
}
__device__ __forceinline__ void st8(void* p, u32x2 v) {
#if MK_WT
    asm volatile("global_store_dwordx2 %0, %1, off sc1\n\ts_nop 1" :: "v"(p), "v"(v) : "memory");
#else
    *(u32x2*)p = v;
#endif
}
namespace pg8 {
constexpr int BM = 256, BK = 64, HALF = 128, HTB = HALF * BK * 2, STAGE_BYTES = 8 * HTB;
__device__ __forceinline__ int lds_byte(int r, int c) { const int st = (r >> 4) * 2 + (c >> 5), rr = r & 15, cc = c & 31, ob = rr * 64 + cc * 2; return st * 1024 + (ob ^ (((ob >> 9) & 1) << 5)); }
__device__ __forceinline__ void stage_rc(int b, int& R, int& C) { const int st = b / 1024, sb = b % 1024, swz = sb ^ (((sb >> 9) & 1) << 5); R = (st >> 1) * 16 + swz / 64; C = (st & 1) * 32 + (swz % 64) / 2; }
__device__ __forceinline__ int perm32(int rho) { const int n = rho >> 4, i = rho & 15; return 8 * (i >> 2) + 4 * n + (i & 3); }

struct Unit { int pm, pn, kind, aux; const char* a; const char* b; };

template <class Epi, class Sched, bool BMAP>
__device__ __forceinline__ void gemm_phase(LAS unsigned char* lds, const int K, const int lda, const int ldb, const Sched& S, const Epi& E, const size_t kstepA = 128, const size_t kstepB = 128) {
    int tid = threadIdx.x; asm volatile("" : "+v"(tid));
    const int wid = __builtin_amdgcn_readfirstlane(tid >> 6), lane = tid & 63, wr = wid >> 2, wc = wid & 3, fr = lane & 15, fq = lane >> 4;
    int nt = K / BK; asm volatile("" : "+s"(nt));
    unsigned voffA[2], voffB[2];
#pragma unroll
    for (int i = 0; i < 2; ++i) { int R, C; stage_rc(tid * 16 + i * 8192, R, C); const int Rb = (R & ~31) + perm32(R & 31);
        voffA[i] = (unsigned)(R * lda + C) * 2u;
        voffB[i] = BMAP ? (unsigned)((64 * (Rb & 63) + (Rb >> 6)) * ldb + C) * 2u : (unsigned)(Rb * ldb + C) * 2u; }
    const size_t hstepA = (size_t)HALF * lda * 2;
    const size_t hstepB = BMAP ? (size_t)2 * ldb * 2 : (size_t)HALF * ldb * 2;
    const unsigned ldsw = (unsigned)wid * 1024u;
    const int aoff = lds_byte(wr * 64 + fr, fq * 8), boff = lds_byte(wc * 32 + fr, fq * 8);
#define PG8_SA(b, h) (((b) * 2 + (h)) * HTB)
#define PG8_SB(b, h) ((4 + (b) * 2 + (h)) * HTB)
#define PG8_STAGE(bufoff, gbase, voff) do { _Pragma("unroll") for (int _i = 0; _i < 2; ++_i) \
        __builtin_amdgcn_global_load_lds((const unsigned*)((const char*)(gbase) + (voff)[_i]), (LAS unsigned*)(lds + (bufoff) + ldsw + _i * 8192), 16, 0, 0); } while (0)
#define PG8_LDA(dst, b, h) do { _Pragma("unroll") for (int m = 0; m < 4; ++m) _Pragma("unroll") for (int k = 0; k < 2; ++k) dst[m][k] = *(const LAS bf16x8*)(lds + PG8_SA(b, h) + aoff + m * 2048 + k * 1024); } while (0)
#define PG8_LDB(dst, b, h) do { _Pragma("unroll") for (int n = 0; n < 2; ++n) _Pragma("unroll") for (int k = 0; k < 2; ++k) dst[n][k] = *(const LAS bf16x8*)(lds + PG8_SB(b, h) + boff + n * 2048 + k * 1024); } while (0)
#define PG8_MMA(ai, bj, At, Bt) do { __builtin_amdgcn_s_setprio(1); _Pragma("unroll") for (int m = 0; m < 4; ++m) _Pragma("unroll") for (int n = 0; n < 2; ++n) _Pragma("unroll") for (int k = 0; k < 2; ++k) \
        acc[ai][bj][m][n] = __builtin_amdgcn_mfma_f32_16x16x32_bf16(Bt[n][k], At[m][k], acc[ai][bj][m][n], 0, 0, 0); __builtin_amdgcn_s_setprio(0); } while (0)
#define PG8_WAIT_V(n) asm volatile("s_waitcnt vmcnt(" #n ")" ::: "memory")
#define PG8_WAIT_L(n) asm volatile("s_waitcnt lgkmcnt(" #n ")" ::: "memory")
#define PG8_BAR __builtin_amdgcn_s_barrier()
#define PG8_SCHED __builtin_amdgcn_sched_barrier(0)
    Unit cur, nxt; int ui = 0;
    if (!S.next(0, cur)) return;
    f32x4 acc[2][2][4][2];
#pragma unroll
    for (int a = 0; a < 2; ++a)
#pragma unroll
        for (int b = 0; b < 2; ++b)
#pragma unroll
            for (int m = 0; m < 4; ++m)
#pragma unroll
                for (int n = 0; n < 2; ++n) acc[a][b][m][n] = (f32x4){0.f, 0.f, 0.f, 0.f};
    bf16x8 At[4][2], B0[2][2], B1[2][2];
    const char* cA = cur.a; const char* cB = cur.b;
    if constexpr (Epi::PREP) E.prep(cur, lds, 0, tid);
    PG8_STAGE(PG8_SB(0, 0), cB, voffB); PG8_STAGE(PG8_SB(0, 1), cB + hstepB, voffB); PG8_STAGE(PG8_SA(0, 0), cA, voffA); PG8_STAGE(PG8_SA(0, 1), cA + hstepA, voffA);
    if (wr == 1) PG8_BAR;
    PG8_WAIT_V(2); PG8_BAR;
    PG8_STAGE(PG8_SB(1, 0), cB + kstepB, voffB); PG8_STAGE(PG8_SA(1, 0), cA + kstepA, voffA); PG8_STAGE(PG8_SB(1, 1), cB + hstepB + kstepB, voffB);
    PG8_WAIT_V(6); PG8_BAR;
    for (;;) {
        const bool has_next = S.next(ui + 1, nxt);
        const char* nA = has_next ? nxt.a : cA; const char* nB = has_next ? nxt.b : cB;
        for (int t = 0; t < nt; t += 2) {
            const bool last = (t == nt - 2);
            const char* a1 = cA + (size_t)(t + 1) * kstepA;
            const char* a2 = last ? nA : cA + (size_t)(t + 2) * kstepA; const char* b2 = last ? nB : cB + (size_t)(t + 2) * kstepB;
            const char* a3 = a2 + kstepA; const char* b3 = b2 + kstepB;
            PG8_LDB(B0, 0, 0); PG8_LDB(B1, 0, 1); PG8_SCHED; PG8_LDA(At, 0, 0); PG8_STAGE(PG8_SA(1, 1), a1 + hstepA, voffA);
            PG8_WAIT_V(8); PG8_WAIT_L(0); PG8_BAR; PG8_MMA(0, 0, At, B0); PG8_MMA(0, 1, At, B1); PG8_BAR; PG8_SCHED;
            PG8_LDA(At, 0, 1); PG8_STAGE(PG8_SB(0, 0), b2, voffB); PG8_STAGE(PG8_SB(0, 1), b2 + hstepB, voffB); PG8_STAGE(PG8_SA(0, 0), a2, voffA);
            PG8_WAIT_V(8); PG8_WAIT_L(0); PG8_BAR; PG8_MMA(1, 0, At, B0); PG8_MMA(1, 1, At, B1); PG8_BAR; PG8_SCHED;
            PG8_LDB(B0, 1, 0); PG8_LDB(B1, 1, 1); PG8_SCHED; PG8_LDA(At, 1, 0); PG8_STAGE(PG8_SA(0, 1), a2 + hstepA, voffA);
            PG8_WAIT_V(8); PG8_WAIT_L(0); PG8_BAR; PG8_MMA(0, 0, At, B0); PG8_MMA(0, 1, At, B1); PG8_BAR; PG8_SCHED;
            PG8_LDA(At, 1, 1); PG8_STAGE(PG8_SB(1, 0), b3, voffB); PG8_STAGE(PG8_SB(1, 1), b3 + hstepB, voffB); PG8_STAGE(PG8_SA(1, 0), a3, voffA);
            PG8_WAIT_V(8); PG8_WAIT_L(0); PG8_BAR; PG8_MMA(1, 0, At, B0); PG8_MMA(1, 1, At, B1); PG8_BAR; PG8_SCHED;
        }
        if (wr == 0) PG8_BAR;
        if constexpr (Epi::PREP) { if (has_next) E.prep(nxt, lds, (ui + 1) & 1, tid); }
        E(acc, cur, wr, wc, fr, fq, lds, ui & 1);
        if (!has_next) break;
#pragma unroll
        for (int a = 0; a < 2; ++a)
#pragma unroll
            for (int b = 0; b < 2; ++b)
#pragma unroll
                for (int m = 0; m < 4; ++m)
#pragma unroll
                    for (int n = 0; n < 2; ++n) acc[a][b][m][n] = (f32x4){0.f, 0.f, 0.f, 0.f};
        cur = nxt; cA = nA; cB = nB; ++ui;
        if (wr == 1) PG8_BAR;
    }
    PG8_WAIT_V(0);
    PG8_BAR;
#undef PG8_SA
#undef PG8_SB
#undef PG8_STAGE
#undef PG8_LDA
#undef PG8_LDB
#undef PG8_MMA
#undef PG8_WAIT_V
#undef PG8_WAIT_L
#undef PG8_BAR
#undef PG8_SCHED
}

struct SchedStd {
    const char* A; const char* Bt; size_t tsA, tsB; int nM, nN, nwg, G, c;
    __device__ void init(const void* A_, const void* Bt_, int M, int N, int lda, int ldb, int G_, int c_, size_t tsA_ = 0) { A = (const char*)A_; Bt = (const char*)Bt_; tsA = tsA_ ? tsA_ : (size_t)BM * lda * 2; tsB = (size_t)BM * ldb * 2; nM = M / BM; nN = N / BM; nwg = nM * nN; G = G_; c = c_; }
    __device__ bool next(int i, Unit& u) const {
        const long L = (long)i * G + c; if (L >= nwg) return false;
        int wgid = (int)L; { const int q = nwg / 8, r = nwg % 8, xcd = wgid % 8, off = wgid / 8; wgid = (xcd < r ? xcd * (q + 1) : r * (q + 1) + (xcd - r) * q) + off; }
        const int nig = 8 * nN, gid = wgid / nig, fm = gid * 8, gsz = (nM - fm) < 8 ? (nM - fm) : 8;
        u.pm = fm + ((wgid % nig) % gsz); u.pn = (wgid % nig) / gsz; u.kind = 0; u.aux = 0;
        u.a = A + (size_t)u.pm * tsA; u.b = Bt + (size_t)u.pn * tsB; return true;
    }
};
struct SchedQKV {
    const char* H; const char* Wqk; const char* Wv; int G, c, nunits;
    __device__ bool next(int i, Unit& u) const {
        const long Ll = (long)i * G + c; if (Ll >= nunits) return false;
        const int L = (int)Ll; const size_t ts = (size_t)BM * 1024 * 2; u.aux = 0;
        if (L < 512) { const int x = L & 7, off = L >> 3; u.kind = 0; u.pm = 8 * x + (off & 7); u.pn = off >> 3; }
        else if (L < 768) { const int l2 = L - 512, x = l2 & 7, off = l2 >> 3; u.kind = 1; u.pm = off & 3; u.pn = 8 * x + (off >> 2); }
        else if (L < 784) { const int l2 = L - 768; u.kind = 0; u.pm = 64 + (l2 & 3); u.pn = 4 + (l2 >> 2); }
        else { const int l2 = L - 784; u.kind = 1; u.pm = l2 & 3; u.pn = 64 + (l2 >> 2); }
        if (u.kind == 0) { u.a = H + (size_t)u.pm * ts; u.b = Wqk + (size_t)u.pn * ts; }
        else { u.a = Wv + (size_t)u.pm * ts; u.b = H + (size_t)u.pn * ts; }
        return true;
    }
};
struct SchedOne { Unit u;
    __device__ __forceinline__ bool next(int i, Unit& o) const { if (i > 0) return false; o = u; return true; }
};
struct SchedF1 {
    const char* CS; const char* H; int G, c;
    __device__ bool next(int i, Unit& u) const {
        const long Ll = (long)i * G + c; if (Ll >= 512) return false;
        const int L = (int)Ll; const int t = L & 15, b = (L >> 4) & 3, g = (L >> 6) & 3, ri = L >> 8;
        u.pm = ri; u.pn = t; u.kind = g; u.aux = b;
        u.a = CS + (size_t)ri * 256 * 256 * 2; u.b = H + ((size_t)(b * 4096 + 4 * t) * 1024 + g * 256) * 2; return true;
    }
};

typedef f32x4 Acc[2][2][4][2];
__device__ __forceinline__ u32x4 pack8(f32x4 v0, f32x4 v1) { u32x4 w; w.x = cvt_pk_bf16(v0[0], v0[1]); w.y = cvt_pk_bf16(v0[2], v0[3]); w.z = cvt_pk_bf16(v1[0], v1[1]); w.w = cvt_pk_bf16(v1[2], v1[3]); return w; }

__device__ __forceinline__ void unpack8(u32x4 w, f32x4& v0, f32x4& v1) {
    v0[0] = __uint_as_float(w.x << 16); v0[1] = __uint_as_float(w.x & 0xffff0000u); v0[2] = __uint_as_float(w.y << 16); v0[3] = __uint_as_float(w.y & 0xffff0000u);
    v1[0] = __uint_as_float(w.z << 16); v1[1] = __uint_as_float(w.z & 0xffff0000u); v1[2] = __uint_as_float(w.w << 16); v1[3] = __uint_as_float(w.w & 0xffff0000u);
}
struct EpiQKV { static constexpr bool PREP = true; bf16_t* QK; bf16_t* VT; const float* gq; const float* gk;
    __device__ __forceinline__ void prep(const Unit& u, LAS unsigned char* lds, int slot, int tid) const {
        if (u.kind == 0 && tid < 64) { const bool isq = u.pn < 4; ((LAS float*)(lds + 131072))[slot * 512 + tid] = isq ? gq[tid] * (0.125f * LOG2E) : gk[tid]; }
    }
    __device__ __forceinline__ void operator()(const Acc& acc, const Unit& u, int wr, int wc, int fr, int fq, LAS unsigned char* lds, int slot) const {
        if (u.kind == 0) {
            const LAS float* gp = (const LAS float*)(lds + 131072) + slot * 512;
            f32x4 gv[2][2];
#pragma unroll
            for (int bj = 0; bj < 2; ++bj)
#pragma unroll
                for (int n = 0; n < 2; ++n) gv[bj][n] = *(const LAS f32x4*)(gp + 32 * bj + 8 * fq + 4 * n);
#pragma unroll
            for (int ai = 0; ai < 2; ++ai)
#pragma unroll
                for (int m = 0; m < 4; ++m) {
                    const int row = u.pm * BM + ai * HALF + wr * 64 + m * 16 + fr;
                    float ss = 0.f;
#pragma unroll
                    for (int bj = 0; bj < 2; ++bj)
#pragma unroll
                        for (int n = 0; n < 2; ++n) { const f32x4 x = acc[ai][bj][m][n]; ss += (x[0] * x[0] + x[1] * x[1]) + (x[2] * x[2] + x[3] * x[3]); }
                    ss += __shfl_xor(ss, 16); ss += __shfl_xor(ss, 32);
                    const float rstd = rsqrtf(ss * (1.0f / 64.0f) + EPS);
                    bf16_t* rowp = QK + (size_t)row * 2048 + u.pn * 256 + wc * 64 + 8 * fq;
#pragma unroll
                    for (int bj = 0; bj < 2; ++bj) st16(rowp + 32 * bj, pack8(acc[ai][bj][m][0] * rstd * gv[bj][0], acc[ai][bj][m][1] * rstd * gv[bj][1]));
                }
        } else {
#pragma unroll
            for (int ai = 0; ai < 2; ++ai)
#pragma unroll
                for (int m = 0; m < 4; ++m) {
                    const int row = u.pm * BM + ai * HALF + wr * 64 + m * 16 + fr;
                    bf16_t* rowp = VT + (size_t)row * MT + u.pn * 256 + wc * 32 + 8 * fq;
#pragma unroll
                    for (int bj = 0; bj < 2; ++bj) st16(rowp + bj * HALF, pack8(acc[ai][bj][m][0], acc[ai][bj][m][1]));
                }
        }
    }
};
struct EpiRelu2 { static constexpr bool PREP = false; bf16_t* O; int ldc;
    __device__ __forceinline__ void operator()(const Acc& acc, const Unit& u, int wr, int wc, int fr, int fq, LAS unsigned char*, int) const {
#pragma unroll
        for (int ai = 0; ai < 2; ++ai)
#pragma unroll
            for (int m = 0; m < 4; ++m) {
                const int row = u.pm * BM + ai * HALF + wr * 64 + m * 16 + fr;
                bf16_t* rowp = O + (size_t)row * ldc + u.pn * 256 + wc * 32 + 8 * fq;
#pragma unroll
                for (int bj = 0; bj < 2; ++bj) { f32x4 v0 = acc[ai][bj][m][0], v1 = acc[ai][bj][m][1];
#pragma unroll
                    for (int e = 0; e < 4; ++e) { const float a = fmaxf(v0[e], 0.f), b = fmaxf(v1[e], 0.f); v0[e] = a * a; v1[e] = b * b; }
                    *(u32x4*)(rowp + bj * HALF) = pack8(v0, v1); }
            }
    }
};
struct EpiRes { static constexpr bool PREP = false; const bf16_t* base; float* out; const float* gate;
    __device__ __forceinline__ void operator()(const Acc& acc, const Unit& u, int wr, int wc, int fr, int fq, LAS unsigned char*, int) const {
        const int col0 = u.pn * 256 + wc * 32 + 8 * fq;
        const float* gp = gate + (size_t)(u.pm >> 4) * 6144 + col0;
        f32x4 gv[2][2];
#pragma unroll
        for (int bj = 0; bj < 2; ++bj)
#pragma unroll
            for (int n = 0; n < 2; ++n) gv[bj][n] = *(const f32x4*)(gp + bj * HALF + 4 * n);
#pragma unroll
        for (int ai = 0; ai < 2; ++ai)
#pragma unroll
          for (int mh = 0; mh < 2; ++mh) {
            u32x4 pre[2][2];
#pragma unroll
            for (int m2 = 0; m2 < 2; ++m2)
#pragma unroll
                for (int bj = 0; bj < 2; ++bj) pre[m2][bj] = *(const u32x4*)(base + (size_t)(u.pm * BM + ai * HALF + wr * 64 + (2 * mh + m2) * 16 + fr) * 1024 + col0 + bj * HALF);
            asm volatile("" ::: "memory");
#pragma unroll
            for (int m2 = 0; m2 < 2; ++m2) { const int m = 2 * mh + m2;
                const size_t off = (size_t)(u.pm * BM + ai * HALF + wr * 64 + m * 16 + fr) * 1024 + col0;
#pragma unroll
                for (int bj = 0; bj < 2; ++bj) { f32x4 b0, b1; unpack8(pre[m2][bj], b0, b1);
                    *(f32x4*)(out + off + bj * HALF) = b0 + gv[bj][0] * acc[ai][bj][m][0]; *(f32x4*)(out + off + bj * HALF + 4) = b1 + gv[bj][1] * acc[ai][bj][m][1]; }
            }
            asm volatile("" ::: "memory");
          }
    }
};
struct EpiZ0 { static constexpr bool PREP = false; bf16_t* Z0;
    __device__ __forceinline__ void operator()(const Acc& acc, const Unit& u, int wr, int wc, int fr, int fq, LAS unsigned char*, int) const {
        const int ri = u.pm, t = u.pn, g = u.kind, b = u.aux;
        bf16_t* p0 = Z0 + ((size_t)(((b * 4 + g) * 256 + wr * 64 + fr) * 64 + 4 * t + (wc >> 1))) * 128 + ri * 64 + 32 * (wc & 1) + 8 * fq;
#pragma unroll
        for (int ai = 0; ai < 2; ++ai)
#pragma unroll
            for (int m = 0; m < 4; ++m) {
#pragma unroll
                for (int bj = 0; bj < 2; ++bj)
                    *(u32x4*)(p0 + (size_t)(ai * HALF + m * 16) * 8192 + bj * 256) = pack8(acc[ai][bj][m][0], acc[ai][bj][m][1]);
                asm volatile("" ::: "memory");
            }
    }
};

constexpr int AUX_OFF = 131072;
template <bool BASE16>
struct EpiResF { static constexpr bool PREP = false; const void* base; bf16_t* XS; const float* gate; const float* gm; bf16_t* XB; float* SSQ;
    __device__ __forceinline__ void operator()(const Acc& acc, const Unit& u, int wr, int wc, int fr, int fq, LAS unsigned char*, int) const {
        const int col0 = u.pn * 256 + wc * 32 + 8 * fq, b = u.pm >> 4;
        f32x4 gv[2][2], mv[2][2];
#pragma unroll
        for (int bj = 0; bj < 2; ++bj)
#pragma unroll
            for (int n = 0; n < 2; ++n) { gv[bj][n] = *(const f32x4*)(gate + (size_t)b * 6144 + col0 + bj * HALF + 4 * n); mv[bj][n] = *(const f32x4*)(gm + b * 1024 + col0 + bj * HALF + 4 * n); }
#pragma unroll
        for (int ai = 0; ai < 2; ++ai)
#pragma unroll
          for (int mh = 0; mh < 2; ++mh) {
            f32x4 pre[2][2][2];
#pragma unroll
            for (int m2 = 0; m2 < 2; ++m2) { const size_t off = (size_t)(u.pm * BM + ai * HALF + wr * 64 + (2 * mh + m2) * 16 + fr) * 1024 + col0;
#pragma unroll
                for (int bj = 0; bj < 2; ++bj) {
                    if (BASE16) { const u32x4 w = *(const u32x4*)((const bf16_t*)base + off + bj * HALF); unpack8(w, pre[m2][bj][0], pre[m2][bj][1]); }
                    else { pre[m2][bj][0] = *(const f32x4*)((const float*)base + off + bj * HALF); pre[m2][bj][1] = *(const f32x4*)((const float*)base + off + bj * HALF + 4); }
                } }
            asm volatile("" ::: "memory");
#pragma unroll
            for (int m2 = 0; m2 < 2; ++m2) {
                const int m = 2 * mh + m2;
                const int row = u.pm * BM + ai * HALF + wr * 64 + m * 16 + fr;
                const size_t off = (size_t)row * 1024 + col0;
                float ss = 0.f;
#pragma unroll
                for (int bj = 0; bj < 2; ++bj) {
                    const f32x4 v0 = pre[m2][bj][0] + gv[bj][0] * acc[ai][bj][m][0];
                    const f32x4 v1 = pre[m2][bj][1] + gv[bj][1] * acc[ai][bj][m][1];
                    st16(XS + off + bj * HALF, pack8(v0, v1));
                    ss += ((v0[0] * v0[0] + v0[1] * v0[1]) + (v0[2] * v0[2] + v0[3] * v0[3])) + ((v1[0] * v1[0] + v1[1] * v1[1]) + (v1[2] * v1[2] + v1[3] * v1[3]));
                    st16(XB + off + bj * HALF, pack8(v0 * mv[bj][0], v1 * mv[bj][1]));
                }
                ss += __shfl_xor(ss, 16); ss += __shfl_xor(ss, 32);
                if (fq == 0) SSQ[(size_t)row * 16 + u.pn * 4 + wc] = ss;
            }
            asm volatile("" ::: "memory");
          }
    }
};
__device__ __forceinline__ float ssq_rstd(const float* SSQ, int row, int half) {
    const f32x4 a = *(const f32x4*)(SSQ + (size_t)row * 16 + half * 8), b = *(const f32x4*)(SSQ + (size_t)row * 16 + half * 8 + 4);
    float s = ((a[0] + a[1]) + (a[2] + a[3])) + ((b[0] + b[1]) + (b[2] + b[3]));
    s += __shfl_xor(s, 1);
    return rsqrtf(s * (1.0f / 1024.0f) + EPS);
}
struct EpiRelu2F { static constexpr bool PREP = true; bf16_t* O; int ldc; const float* BV; const float* SSQ;
    __device__ __forceinline__ void prep(const Unit& u, LAS unsigned char* lds, int slot, int tid) const {
        const float r = ssq_rstd(SSQ, u.pm * BM + (tid >> 1), tid & 1);
        LAS float* aux = (LAS float*)(lds + AUX_OFF) + slot * 512;
        if (!(tid & 1)) aux[tid >> 1] = r;
        if (tid < 256) aux[256 + tid] = BV[(size_t)(u.pm >> 4) * 4096 + u.pn * 256 + tid];
    }
    __device__ __forceinline__ void operator()(const Acc& acc, const Unit& u, int wr, int wc, int fr, int fq, LAS unsigned char* lds, int slot) const {
        const LAS float* rt = (const LAS float*)(lds + AUX_OFF) + slot * 512;
        const int col0 = u.pn * 256 + wc * 32 + 8 * fq;
        f32x4 bv[2][2];
#pragma unroll
        for (int bj = 0; bj < 2; ++bj)
#pragma unroll
            for (int n = 0; n < 2; ++n) bv[bj][n] = *(const LAS f32x4*)(rt + 256 + wc * 32 + 8 * fq + bj * HALF + 4 * n);
#pragma unroll
        for (int ai = 0; ai < 2; ++ai)
#pragma unroll
            for (int m = 0; m < 4; ++m) {
                const int rl = ai * HALF + wr * 64 + m * 16 + fr; const float rs = rt[rl];
                bf16_t* rowp = O + ((size_t)(u.pm * 64 + u.pn * 4 + (wc >> 1)) * 256 + rl) * 64 + (wc & 1) * 32 + 8 * fq;
#pragma unroll
                for (int bj = 0; bj < 2; ++bj) { f32x4 v0 = acc[ai][bj][m][0] * rs + bv[bj][0], v1 = acc[ai][bj][m][1] * rs + bv[bj][1];
#pragma unroll
                    for (int e = 0; e < 4; ++e) { const float a = fmaxf(v0[e], 0.f), c2 = fmaxf(v1[e], 0.f); v0[e] = a * a; v1[e] = c2 * c2; }
                    st16(rowp + bj * 2 * 256 * 64, pack8(v0, v1)); }
            }
    }
};
struct EpiZ0F { static constexpr bool PREP = true; bf16_t* Z0; const float* BVF; const float* SSQ;
    __device__ __forceinline__ void prep(const Unit& u, LAS unsigned char* lds, int slot, int tid) const {
        const int nl = tid >> 1, tok = u.aux * 4096 + 64 * (nl & 63) + 4 * u.pn + (nl >> 6);
        const float r = ssq_rstd(SSQ, tok, tid & 1);
        LAS float* aux = (LAS float*)(lds + AUX_OFF) + slot * 512;
        if (!(tid & 1)) aux[nl] = r;
        if (tid < 256) aux[256 + tid] = BVF[(size_t)(u.aux * 4 + u.kind) * 512 + u.pm * 256 + tid];
    }
    __device__ __forceinline__ void operator()(const Acc& acc, const Unit& u, int wr, int wc, int fr, int fq, LAS unsigned char* lds, int slot) const {
        const LAS float* rt = (const LAS float*)(lds + AUX_OFF) + slot * 512;
        const int ri = u.pm, t = u.pn, g = u.kind, b = u.aux;
        f32x4 rs[2][2];
#pragma unroll
        for (int bj = 0; bj < 2; ++bj)
#pragma unroll
            for (int n = 0; n < 2; ++n) rs[bj][n] = *(const LAS f32x4*)(rt + bj * HALF + wc * 32 + 8 * fq + 4 * n);
        const LAS float* bz = rt + 256 + wr * 64 + fr;
        bf16_t* p0 = Z0 + ((size_t)(((b * 4 + g) * 256 + wr * 64 + fr) * 64 + 4 * t + (wc >> 1))) * 128 + ri * 64 + 32 * (wc & 1) + 8 * fq;
#pragma unroll
        for (int ai = 0; ai < 2; ++ai)
#pragma unroll
            for (int m = 0; m < 4; ++m) {
                const float bb = bz[ai * HALF + m * 16];
#pragma unroll
                for (int bj = 0; bj < 2; ++bj)
                    st16(p0 + (size_t)(ai * HALF + m * 16) * 8192 + bj * 256, pack8(acc[ai][bj][m][0] * rs[bj][0] + bb, acc[ai][bj][m][1] * rs[bj][1] + bb));
                asm volatile("" ::: "memory");
            }
    }
};
}


#define XB_TMO      128
#define XB_XCNT(j)  (256  + 64 * (j))
#define XB_XSUB(j)  (1280 + 64 * (j))
#define XB_XGEN(j)  (2304 + 64 * (j))
#define XB_TOP      3328
#define XB_TOPGEN   3392
#define XCD_BAR_WORDS 3456
#define XB_SPIN_CAP (1u << 18)
__device__ __forceinline__ unsigned xb_ld(unsigned* p)              { return __hip_atomic_load(p, __ATOMIC_RELAXED, __HIP_MEMORY_SCOPE_AGENT); }
__device__ __forceinline__ unsigned xb_add(unsigned* p, unsigned v) { return __hip_atomic_fetch_add(p, v, __ATOMIC_RELAXED, __HIP_MEMORY_SCOPE_AGENT); }
__device__ __forceinline__ unsigned xb_xcc_id() { return (unsigned)__builtin_amdgcn_s_getreg((3 << 11) | 20) & 0xFu; }
#define XB_SPIN(cond, bar) do { unsigned _sp = 0; while (cond) { __builtin_amdgcn_s_sleep(1); \
    if ((++_sp & 255u) == 0u) { if (xb_ld(&(bar)[XB_TMO])) break; if (_sp > XB_SPIN_CAP) { atomicAdd(&(bar)[XB_TMO], 1u); break; } } } } while (0)
struct XcdBarrier { unsigned* bar; unsigned x; volatile LAS unsigned* st; };
__device__ __forceinline__ XcdBarrier xcd_barrier_post(unsigned* bar, volatile LAS unsigned* st) {
    XcdBarrier b; b.bar = bar; b.x = xb_xcc_id(); b.st = st;
    if (threadIdx.x == 0) (void)xb_add(&bar[XB_XCNT(b.x)], 1u);
    return b;
}
__device__ __forceinline__ void xcd_barrier_complete(unsigned* bar, unsigned x, unsigned& nloc, unsigned& nx) {
    const unsigned G = gridDim.x * gridDim.y * gridDim.z;
    unsigned sum, cnt, mine, sp = 0u;
    for (;;) {
        sum = 0u; cnt = 0u; mine = 0u;
#pragma unroll
        for (unsigned j = 0; j < 16; ++j) { const unsigned c = xb_ld(&bar[XB_XCNT(j)]); sum += c; cnt += (c > 0u) ? 1u : 0u; mine = (j == x) ? c : mine; }
        if (sum == G) break;
        __builtin_amdgcn_s_sleep(1);
        if ((++sp & 255u) == 0u) { if (xb_ld(&bar[XB_TMO])) break; if (sp > XB_SPIN_CAP) { atomicAdd(&bar[XB_TMO], 1u); break; } }
    }
    nloc = mine > 0u ? mine : 1u; nx = cnt > 0u ? cnt : 1u;
}
__device__ __forceinline__ void xcd_barrier(const XcdBarrier& b) {
    asm volatile("s_waitcnt vmcnt(0)" ::: "memory");
    __syncthreads();
    if (threadIdx.x == 0) {
        unsigned* bar = b.bar;
        __builtin_amdgcn_s_waitcnt(0);
        unsigned nloc = b.st[0], nx = b.st[1];
        if (nloc == 0u) { xcd_barrier_complete(bar, b.x, nloc, nx); b.st[0] = nloc; b.st[1] = nx; }
        const unsigned old = xb_add(&bar[XB_XSUB(b.x)], 1u);
        const unsigned gen = old / nloc;
        if (old + 1u == (gen + 1u) * nloc) {
            __builtin_amdgcn_fence(__ATOMIC_RELEASE, "agent");
            asm volatile("s_waitcnt vmcnt(0)" ::: "memory");
            const unsigned og = xb_add(&bar[XB_TOP], 1u);
            const unsigned tg = og / nx;
            if (og + 1u == (tg + 1u) * nx) xb_add(&bar[XB_TOPGEN], 1u);
            else XB_SPIN(xb_ld(&bar[XB_TOPGEN]) == tg, bar);
            __builtin_amdgcn_fence(__ATOMIC_ACQUIRE, "agent");
            xb_add(&bar[XB_XGEN(b.x)], 1u);
            asm volatile("s_waitcnt vmcnt(0)" ::: "memory");
        } else {
            XB_SPIN(xb_ld(&bar[XB_XGEN(b.x)]) == gen, bar);
            __builtin_amdgcn_fence(__ATOMIC_ACQUIRE, "agent");
            asm volatile("s_waitcnt vmcnt(0)" ::: "memory");
        }
    }
    __syncthreads();
}
__device__ __forceinline__ void p0_mods_unit(const float* c, const float* cctx, const float* ada_w, const float* ada_b, float* mods, LAS unsigned char* lds, int unit) {
    LAS float* s = (LAS float*)lds;
    LAS float* red = s + 5 * 1024;
    int tid = threadIdx.x; asm volatile("" : "+v"(tid));
    for (int i = tid; i < 5 * 1024; i += 512) { const int v = i >> 10, k = i & 1023; const float x = v < 4 ? c[v * 1024 + k] : cctx[k]; s[i] = x / (1.0f + __expf(-x)); }
    __syncthreads();
    const int l = unit / 96, col0 = (unit % 96) * 64, kc = tid >> 6, cl = tid & 63;
    const float* w = ada_w + (size_t)l * 1024 * 6144 + col0 + cl;
    float a0 = 0.f, a1 = 0.f, a2 = 0.f, a3 = 0.f, a4 = 0.f;
    for (int k = kc * 128; k < kc * 128 + 128; k += 32) {
        float wv[32];
#pragma unroll
        for (int j = 0; j < 32; ++j) wv[j] = w[(size_t)(k + j) * 6144];
#pragma unroll
        for (int j = 0; j < 32; ++j) { a0 += s[k + j] * wv[j]; a1 += s[1024 + k + j] * wv[j]; a2 += s[2048 + k + j] * wv[j]; a3 += s[3072 + k + j] * wv[j]; a4 += s[4096 + k + j] * wv[j]; }
    }
    red[(kc * 5 + 0) * 64 + cl] = a0; red[(kc * 5 + 1) * 64 + cl] = a1; red[(kc * 5 + 2) * 64 + cl] = a2; red[(kc * 5 + 3) * 64 + cl] = a3; red[(kc * 5 + 4) * 64 + cl] = a4;
    __syncthreads();
    if (tid < 320) { const int v = tid >> 6, cc = tid & 63; float t = 0.f;
#pragma unroll
        for (int kk = 0; kk < 8; ++kk) t += red[(kk * 5 + v) * 64 + cc];
        mods[(size_t)(l * 5 + v) * 6144 + col0 + cc] = t + ada_b[l * 6144 + col0 + cc]; }
    __syncthreads();
}

__device__ __forceinline__ void p0_transpose_item(const float* W, int K, int N, bf16_t* WT, bf16_t* WT2, int mode, LAS float* scr, int item, int lane) {
    const int nblk = N / 32, kb = item / nblk, nb = item % nblk, k0 = 64 * kb, n0 = 32 * nb;
    float wv_[32];
#pragma unroll
    for (int i = 0; i < 32; ++i) wv_[i] = W[(size_t)(k0 + 2 * i + (lane >> 5)) * N + n0 + (lane & 31)];
#pragma unroll
    for (int i = 0; i < 32; ++i) scr[(2 * i + (lane >> 5)) * 33 + (lane & 31)] = wv_[i];
    asm volatile("s_waitcnt lgkmcnt(0)" ::: "memory");
    const int cch = lane & 7;
#pragma unroll
    for (int j = 0; j < 4; ++j) { const int n = (lane >> 3) + 8 * j; const LAS float* s = scr + (8 * cch) * 33 + n;
        u32x4 o; o.x = cvt_pk_bf16(s[0 * 33], s[1 * 33]); o.y = cvt_pk_bf16(s[2 * 33], s[3 * 33]); o.z = cvt_pk_bf16(s[4 * 33], s[5 * 33]); o.w = cvt_pk_bf16(s[6 * 33], s[7 * 33]);
        const int ng = n0 + n; bf16_t* dst;
        if (mode == 0) dst = WT + (size_t)ng * K;
        else if (ng < 2048) { const int pn = ng >> 8, hh = (ng >> 6) & 3, d = ng & 63; const int tpos = (d >> 5) * 128 + hh * 32 + (d & 31); dst = WT + (size_t)(pn * 256 + tpos) * K; }
        else dst = WT2 + (size_t)(ng - 2048) * K;
        *(u32x4*)(dst + k0 + 8 * cch) = o; }
    asm volatile("s_waitcnt lgkmcnt(0)" ::: "memory");
}

__device__ __forceinline__ float wave_sum(float v) {
#pragma unroll
    for (int o = 1; o < 64; o <<= 1) v += __shfl_xor(v, o);
    return v;
}
__device__ __forceinline__ void norm_rows(const float* xlat, const float* xctx, int nrows, const float* g, const float* modsl, int sh_off, int sc_off, bf16_t* H, int gw, int NGW, int lane) {
    f32x4 gv[4];
#pragma unroll
    for (int j = 0; j < 4; ++j) gv[j] = *(const f32x4*)(g + lane * 4 + 256 * j);
    for (int row = gw; row < nrows; row += NGW) {
        const float* src = row < ML ? xlat + (size_t)row * 1024 : xctx + (size_t)(row - ML) * 1024;
        const int v = row < ML ? (row >> 12) : 4;
        const float* mp = modsl + (size_t)v * 6144;
        f32x4 x[4]; float ss = 0.f;
#pragma unroll
        for (int j = 0; j < 4; ++j) { x[j] = *(const f32x4*)(src + lane * 4 + 256 * j); ss += (x[j][0] * x[j][0] + x[j][1] * x[j][1]) + (x[j][2] * x[j][2] + x[j][3] * x[j][3]); }
        const float rstd = rsqrtf(wave_sum(ss) * (1.0f / 1024.0f) + EPS);
#pragma unroll
        for (int j = 0; j < 4; ++j) {
            const f32x4 sh = *(const f32x4*)(mp + sh_off + lane * 4 + 256 * j), sc = *(const f32x4*)(mp + sc_off + lane * 4 + 256 * j);
            const f32x4 y = (x[j] * rstd * gv[j]) * (sc + 1.0f) + sh;
            u32x2 w; w.x = cvt_pk_bf16(y[0], y[1]); w.y = cvt_pk_bf16(y[2], y[3]);
            *(u32x2*)(H + (size_t)row * 1024 + lane * 4 + 256 * j) = w;
        }
    }
}


__device__ __forceinline__ void bias_items(const bf16_t* W1t, const bf16_t* CS, const float* mods, float* BV0, float* BV1, float* BVF, int w, int NW, int lane) {
    for (int it = w; it < 8192 + 2048; it += NW) {
        float a0 = 0.f, a1 = 0.f, a2 = 0.f, a3 = 0.f; float* dst; int dstride;
        if (it < 8192) {
            const int l = it >> 12, n = it & 4095;
            const bf16_t* wr_ = W1t + (size_t)l * 4096 * 1024 + (size_t)n * 1024 + lane * 16;
            const u32x4 w0 = *(const u32x4*)wr_, w1 = *(const u32x4*)(wr_ + 8);
            const float* sh = mods + (size_t)l * 5 * 6144 + 3072 + lane * 16;
            float wf[16];
#pragma unroll
            for (int e = 0; e < 4; ++e) { wf[2 * e] = __uint_as_float(w0[e] << 16); wf[2 * e + 1] = __uint_as_float(w0[e] & 0xffff0000u); wf[8 + 2 * e] = __uint_as_float(w1[e] << 16); wf[8 + 2 * e + 1] = __uint_as_float(w1[e] & 0xffff0000u); }
#pragma unroll
            for (int q = 0; q < 4; ++q) {
                const f32x4 s0 = *(const f32x4*)(sh + 4 * q), s1 = *(const f32x4*)(sh + 6144 + 4 * q), s2 = *(const f32x4*)(sh + 2 * 6144 + 4 * q), s3 = *(const f32x4*)(sh + 3 * 6144 + 4 * q);
#pragma unroll
                for (int e = 0; e < 4; ++e) { a0 += s0[e] * wf[4 * q + e]; a1 += s1[e] * wf[4 * q + e]; a2 += s2[e] * wf[4 * q + e]; a3 += s3[e] * wf[4 * q + e]; }
            }
            dst = (l == 0 ? BV0 : BV1) + n; dstride = 4096;
        } else {
            const int idx = it - 8192, g = idx >> 9, m = idx & 511;
            const u32x2 w0 = *(const u32x2*)(CS + (size_t)m * 256 + lane * 4);
            const float wf0 = __uint_as_float(w0[0] << 16), wf1 = __uint_as_float(w0[0] & 0xffff0000u), wf2 = __uint_as_float(w0[1] << 16), wf3 = __uint_as_float(w0[1] & 0xffff0000u);
            const float* sh = mods + (size_t)5 * 6144 + g * 256 + lane * 4;
            const f32x4 s0 = *(const f32x4*)(sh), s1 = *(const f32x4*)(sh + 6144), s2 = *(const f32x4*)(sh + 2 * 6144), s3 = *(const f32x4*)(sh + 3 * 6144);
            a0 = s0[0] * wf0 + s0[1] * wf1 + s0[2] * wf2 + s0[3] * wf3; a1 = s1[0] * wf0 + s1[1] * wf1 + s1[2] * wf2 + s1[3] * wf3;
            a2 = s2[0] * wf0 + s2[1] * wf1 + s2[2] * wf2 + s2[3] * wf3; a3 = s3[0] * wf0 + s3[1] * wf1 + s3[2] * wf2 + s3[3] * wf3;
            dst = BVF + g * 512 + m; dstride = 2048;
        }
        a0 = wave_sum(a0); a1 = wave_sum(a1); a2 = wave_sum(a2); a3 = wave_sum(a3);
        if (lane == 0) { dst[0] = a0; dst[dstride] = a1; dst[2 * dstride] = a2; dst[3 * dstride] = a3; }
    }
}
template <bool MASKED>
__device__ __forceinline__ void attn_block(const LAS bf16_t* Ks, const LAS bf16_t* Vs, int kcol0, int fr, int g, const bf16x8 (&Qf)[2], f32x4 (&acc)[4], float& lsum,
                                           const LAS unsigned char* rpb_base  , const int (&dcb)[8], const f32x4& ciX, const f32x4& ciY) {
    bf16x8 KX[2], KY[2];
#pragma unroll
    for (int kk = 0; kk < 2; ++kk) { KX[kk] = *(const LAS bf16x8*)(Ks + (kcol0 + fr) * 72 + kk * 32 + g * 8); KY[kk] = *(const LAS bf16x8*)(Ks + (kcol0 + 16 + fr) * 72 + kk * 32 + g * 8); }
    s16x4 VX[4], VY[4];
#pragma unroll
    for (int db = 0; db < 4; ++db) { VX[db] = *(const LAS s16x4*)(Vs + (16 * db + fr) * 72 + kcol0 + 4 * g); VY[db] = *(const LAS s16x4*)(Vs + (16 * db + fr) * 72 + kcol0 + 16 + 4 * g); }
    f32x4 sX = mfma16(KX[0], Qf[0], ciX); sX = mfma16(KX[1], Qf[1], sX);
    f32x4 sY = mfma16(KY[0], Qf[0], ciY); sY = mfma16(KY[1], Qf[1], sY);
    f32x4 pX, pY;
    if (MASKED) {
#pragma unroll
        for (int ii = 0; ii < 4; ++ii) {
            const float bx = *(const LAS float*)(rpb_base + dcb[ii]), by = *(const LAS float*)(rpb_base + dcb[4 + ii]);
            pX[ii] = __builtin_amdgcn_exp2f(sX[ii] + bx);
            pY[ii] = __builtin_amdgcn_exp2f(sY[ii] + by);
        }
    } else {
#pragma unroll
        for (int ii = 0; ii < 4; ++ii) { pX[ii] = __builtin_amdgcn_exp2f(sX[ii]); pY[ii] = __builtin_amdgcn_exp2f(sY[ii]); }
    }
    lsum += ((pX[0] + pX[1]) + (pX[2] + pX[3])) + ((pY[0] + pY[1]) + (pY[2] + pY[3]));
    const u32x4 pw = pg8::pack8(pX, pY);
    const bf16x8 Pf = __builtin_bit_cast(bf16x8, pw);
#pragma unroll
    for (int db = 0; db < 4; ++db) {
        bf16x8 Vf; Vf[0] = VX[db][0]; Vf[1] = VX[db][1]; Vf[2] = VX[db][2]; Vf[3] = VX[db][3]; Vf[4] = VY[db][0]; Vf[5] = VY[db][1]; Vf[6] = VY[db][2]; Vf[7] = VY[db][3];
        acc[db] = mfma16(Vf, Pf, acc[db]);
    }
}
__device__ __forceinline__ void attn_phase(const bf16_t* QK, const bf16_t* VT, bf16_t* O, const float* rpb, const float* sbound, LAS unsigned char* lds, int G, int c) {
    constexpr int RP_BYTES = 30720, TILE_B = 64 * 72 * 2, SLOT_B = 2 * TILE_B, NSTEP = 13;
    LAS float* rp = (LAS float*)lds;
    int tid = threadIdx.x; asm volatile("" : "+v"(tid));
    const int lane = tid & 63, wid = __builtin_amdgcn_readfirstlane(tid >> 6), fr = lane & 15, g = lane >> 4;
    for (int i = tid; i < 16 * 465; i += 512) rp[i] = rpb[i] * LOG2E;
    const float Mb = *sbound;
    const int nunits = (2048 - c + G - 1) / G;
    const int NT = nunits * NSTEP;
    const int trow = tid >> 3, tch = tid & 7;
    const int ldsoff = (trow * 72 + tch * 8) * 2;
#define ATT_DEC(L_, b_, h_, rp_) do { const int x_ = (L_) & 7, q_ = (L_) >> 3; rp_ = q_ & 31; const int bh_ = 8 * (q_ >> 5) + x_; b_ = bh_ >> 4; h_ = bh_ & 15; } while (0)
#define ATT_GLOAD(T_, pk_, pv_) do { const int u_ = (T_) / NSTEP, t_ = (T_) - u_ * NSTEP; int b_, h_, rp_; ATT_DEC(u_ * G + c, b_, h_, rp_); \
        const int rs0_ = min(max(2 * rp_ - 4, 0), 56); const int tok0_ = t_ < 9 ? b_ * 4096 + min(rs0_ + t_, 63) * 64 : ML + b_ * 256 + 64 * (t_ - 9); \
        pk_ = *(const u32x4*)(QK + (size_t)(tok0_ + trow) * 2048 + 1024 + h_ * 64 + tch * 8); \
        pv_ = *(const u32x4*)(VT + (size_t)(h_ * 64 + trow) * MT + tok0_ + tch * 8); } while (0)
#define ATT_LWRITE(slot_, pk_, pv_) do { *(LAS u32x4*)(lds + RP_BYTES + (slot_) * SLOT_B + ldsoff) = pk_; *(LAS u32x4*)(lds + RP_BYTES + (slot_) * SLOT_B + TILE_B + ldsoff) = pv_; } while (0)
    u32x4 pk0, pv0, pk1, pv1, pk2, pv2;
    ATT_GLOAD(0, pk0, pv0); ATT_LWRITE(0, pk0, pv0);
    if (NT > 1) ATT_GLOAD(1, pk1, pv1);
    if (NT > 2) ATT_GLOAD(2, pk2, pv2);
    if (NT > 3) ATT_GLOAD(3, pk0, pv0);
    __syncthreads();
    int b = 0, h = 0, rpair = 0, r = 0, rs0 = 0, rsr = 0, qrow = 0;
    const int j = wid & 3, w0 = (j == 0) ? 0 : (j == 1) ? 8 : (j == 2) ? 24 : 32;
    int dcb[8]; f32x4 ciX, ciY, ciU;
    {
        const int cq = 16 * j + fr, cs = min(max(cq - 8, 0), 48), eX = w0 + 4 * g - cs, dX = w0 + 4 * g - cq + 15;
#pragma unroll
        for (int ii = 0; ii < 4; ++ii) {
            dcb[ii] = 4 * min(max(dX + ii, 0), 30); dcb[4 + ii] = 4 * min(max(dX + 16 + ii, 0), 30);
            ciX[ii] = ((unsigned)(eX + ii) < 16u) ? -Mb : -1.0e30f; ciY[ii] = ((unsigned)(eX + 16 + ii) < 16u) ? -Mb : -1.0e30f; ciU[ii] = -Mb;
        }
    }
    bf16x8 Qf[2], Qn[2]; f32x4 acc[4]; float lsum = 0.f;
    int t = 0, u = 0, T = 0;
#define ATT_QLOAD(dst, uu) do { int b_, h_, rp_; ATT_DEC((uu) * G + c, b_, h_, rp_); const int qr_ = b_ * 4096 + (2 * rp_ + (wid >> 2)) * 64 + 16 * j + fr; \
        _Pragma("unroll") for (int kk = 0; kk < 2; ++kk) dst[kk] = *(const bf16x8*)(QK + (size_t)qr_ * 2048 + h_ * 64 + 32 * kk + 8 * g); } while (0)
    ATT_QLOAD(Qn, 0);
#define ATT_ITER(PK, PV) do { \
        const int slot = T & 1; \
        if (T + 1 < NT) ATT_LWRITE(slot ^ 1, PK, PV); \
        if (T + 4 < NT) ATT_GLOAD(T + 4, PK, PV); \
        if (t == 0) { \
            ATT_DEC(u * G + c, b, h, rpair); \
            r = 2 * rpair + (wid >> 2); rs0 = min(max(2 * rpair - 4, 0), 56); rsr = min(max(r - 4, 0), 56); \
            qrow = b * 4096 + r * 64 + 16 * j + fr; \
            Qf[0] = Qn[0]; Qf[1] = Qn[1]; \
            _Pragma("unroll") for (int db = 0; db < 4; ++db) acc[db] = (f32x4){0.f, 0.f, 0.f, 0.f}; \
            lsum = 0.f; \
        } \
        if (t == 8 && u + 1 < nunits) ATT_QLOAD(Qn, u + 1); \
        const LAS bf16_t* Ks = (const LAS bf16_t*)(lds + RP_BYTES + slot * SLOT_B); \
        const LAS bf16_t* Vs = (const LAS bf16_t*)(lds + RP_BYTES + slot * SLOT_B + TILE_B); \
        if (t < 9) { \
            const int kr = rs0 + t, i = kr - rsr; \
            if (i >= 0 && i < 8) attn_block<true>(Ks, Vs, w0, fr, g, Qf, acc, lsum, (const LAS unsigned char*)rp + (h * 465 + (kr - r + 7) * 31) * 4, dcb, ciX, ciY); \
        } else { \
            attn_block<false>(Ks, Vs, 0, fr, g, Qf, acc, lsum, (const LAS unsigned char*)rp, dcb, ciU, ciU); \
            attn_block<false>(Ks, Vs, 32, fr, g, Qf, acc, lsum, (const LAS unsigned char*)rp, dcb, ciU, ciU); \
        } \
        if (t == NSTEP - 1) { \
            float ls = lsum; ls += __shfl_xor(ls, 16); ls += __shfl_xor(ls, 32); \
            const float inv = 1.0f / ls; \
            bf16_t* op = O + (size_t)qrow * 1024 + h * 64 + 4 * g; \
            _Pragma("unroll") for (int db = 0; db < 4; ++db) { u32x2 w; w.x = cvt_pk_bf16(acc[db][0] * inv, acc[db][1] * inv); w.y = cvt_pk_bf16(acc[db][2] * inv, acc[db][3] * inv); st8(op + 16 * db, w); } \
            t = 0; ++u; \
        } else ++t; \
        __syncthreads(); \
    } while (0)
    for (;;) {
        ATT_ITER(pk1, pv1); if (++T >= NT) break;
        ATT_ITER(pk2, pv2); if (++T >= NT) break;
        ATT_ITER(pk0, pv0); if (++T >= NT) break;
    }
#undef ATT_ITER
#undef ATT_QLOAD
#undef ATT_DEC
#undef ATT_GLOAD
#undef ATT_LWRITE
}

__device__ __forceinline__ void s1_phase(const bf16_t* Z0, const bf16_t* Dg, bf16_t* Z1, LAS unsigned char* lds, int gw, int NGW) {
    constexpr int DP = 136;
    LAS bf16_t* Dl = (LAS bf16_t*)lds;
    int tid = threadIdx.x; asm volatile("" : "+v"(tid));
    const int lane = tid & 63, fr = lane & 15, g = lane >> 4;
    for (int i = tid; i < 128 * 16; i += 512) { const int row = i >> 4, ch = i & 15; *(LAS u32x4*)(Dl + row * DP + ch * 8) = *(const u32x4*)(Dg + row * 128 + ch * 8); }
    __syncthreads();
    for (int colM = gw; colM < 4096; colM += NGW) {
        bf16x8 A[4][4];
#pragma unroll
        for (int ib = 0; ib < 4; ++ib)
#pragma unroll
            for (int kb = 0; kb < 4; ++kb) A[ib][kb] = *(const bf16x8*)(Z0 + ((size_t)colM * 64 + 16 * ib + fr) * 128 + 32 * kb + 8 * g);
#pragma unroll 2
        for (int jb = 0; jb < 8; ++jb) {
            bf16x8 Bf[4];
#pragma unroll
            for (int kb = 0; kb < 4; ++kb) Bf[kb] = *(const LAS bf16x8*)(Dl + (16 * jb + fr) * DP + 32 * kb + 8 * g);
            const int n = 16 * jb + fr, ka = n >> 1, rip = n & 1;
#pragma unroll
            for (int ib = 0; ib < 4; ++ib) {
                f32x4 a = (f32x4){0.f, 0.f, 0.f, 0.f};
#pragma unroll
                for (int kb = 0; kb < 4; ++kb) a = mfma16(A[ib][kb], Bf[kb], a);
                u32x2 w; w.x = cvt_pk_bf16(a[0], a[1]); w.y = cvt_pk_bf16(a[2], a[3]);
                st8(Z1 + (((size_t)ka * 4096 + colM) * 2 + rip) * 64 + 16 * ib + 4 * g, w);
            }
        }
    }
    __syncthreads();
}
__device__ __forceinline__ void s2_phase(const bf16_t* Z1, const bf16_t* Eg, bf16_t* F, int gw, int NGW, int lane) {
    const int fr = lane & 15, g = lane >> 4;
    for (int it = gw; it < 2048; it += NGW) {
        const int ka = it & 63, chunk = it >> 6;
        bf16x8 Bf[4][4];
#pragma unroll
        for (int jb = 0; jb < 4; ++jb)
#pragma unroll
            for (int kb = 0; kb < 4; ++kb) Bf[jb][kb] = *(const bf16x8*)(Eg + ((size_t)ka * 64 + 16 * jb + fr) * 128 + 32 * kb + 8 * g);
        for (int ib = 0; ib < 8; ++ib) {
            const int colM0 = chunk * 128 + ib * 16;
            bf16x8 A[4];
#pragma unroll
            for (int kb = 0; kb < 4; ++kb) A[kb] = *(const bf16x8*)(Z1 + ((size_t)ka * 4096 + colM0 + fr) * 128 + 32 * kb + 8 * g);
            const int cm = colM0 + 4 * g, b = cm >> 10, ch = cm & 1023;
#pragma unroll
            for (int jb = 0; jb < 4; ++jb) {
                f32x4 a = (f32x4){0.f, 0.f, 0.f, 0.f};
#pragma unroll
                for (int kb = 0; kb < 4; ++kb) a = mfma16(A[kb], Bf[jb][kb], a);
                const int kbk = 16 * jb + fr;
                u32x2 w; w.x = cvt_pk_bf16(a[0], a[1]); w.y = cvt_pk_bf16(a[2], a[3]);
                st8(F + ((size_t)b * 4096 + ka + 64 * kbk) * 1024 + ch, w);
            }
        }
    }
}


#ifndef MK_DEBUG
#define MK_DEBUG 0
#endif
__device__ __forceinline__ void dbg_scan16(const bf16_t* p, size_t n, unsigned* flags, unsigned bit, int gt, int NT) {
    bool bad = false; for (size_t i = gt; i < n; i += NT) bad |= ((p[i] & 0x7f80u) == 0x7f80u);
    if (bad) atomicOr(flags, 1u << bit);
}
__device__ __forceinline__ void dbg_scan32(const float* p, size_t n, unsigned* flags, unsigned bit, int gt, int NT) {
    bool bad = false; for (size_t i = gt; i < n; i += NT) bad |= ((__float_as_uint(p[i]) & 0x7f800000u) == 0x7f800000u);
    if (bad) atomicOr(flags, 1u << bit);
}
struct Args { const float* in[15]; float* out; unsigned char* ws; int ph_lo, ph_hi, use_cg, pad; };
static_assert(sizeof(Args) == 15 * 8 + 8 + 8 + 16, "no padding");

__global__ void __launch_bounds__(512, 2) fwd_kernel(Args args) {
    extern __shared__ __attribute__((aligned(16))) unsigned char lds_raw[];
    LAS unsigned char* lds = (LAS unsigned char*)lds_raw;
    const int G = gridDim.x, c = blockIdx.x;
    const int vcu = (G % 8 == 0) ? (c % 8) * (G / 8) + c / 8 : c;
    const int NGW = G * 8;
#define PHASE_IDS int tid_ = threadIdx.x; asm volatile("" : "+v"(tid_)); const int lane = tid_ & 63, wid = __builtin_amdgcn_readfirstlane(tid_ >> 6); const int gw = vcu * 8 + wid; (void)lane; (void)gw
    unsigned char* ws = args.ws;
    const float* x = args.in[0]; const float* cvec = args.in[1]; const float* ctx = args.in[2]; const float* cctx = args.in[3];
    const float* ada_w = args.in[4]; const float* ada_b = args.in[5]; const float* norm_g = args.in[6];
    const float* wqkv = args.in[7]; const float* wo = args.in[8]; const float* gq = args.in[9]; const float* gk = args.in[10]; const float* rpb = args.in[11];
    const float* fw = args.in[12]; const float* w1 = args.in[13]; const float* w2 = args.in[14];
    float* out = args.out;
    float* mods = (float*)(ws + WS_MODS); float* sbound = (float*)(ws + WS_SB);
    bf16_t* CS = (bf16_t*)(ws + WS_CS); bf16_t* Dt = (bf16_t*)(ws + WS_D); bf16_t* Et = (bf16_t*)(ws + WS_E);
    bf16_t* WQK = (bf16_t*)(ws + WS_WQK); bf16_t* WV = (bf16_t*)(ws + WS_WV); bf16_t* WO = (bf16_t*)(ws + WS_WO); bf16_t* FWt = (bf16_t*)(ws + WS_FW);
    bf16_t* W1t = (bf16_t*)(ws + WS_W1); bf16_t* W2t = (bf16_t*)(ws + WS_W2);
    bf16_t* H = (bf16_t*)(ws + WS_H); bf16_t* QK = (bf16_t*)(ws + WS_QK); bf16_t* VT = (bf16_t*)(ws + WS_VT); bf16_t* O = (bf16_t*)(ws + WS_O);
    bf16_t* XS = (bf16_t*)(ws + WS_XS); bf16_t* HMID = (bf16_t*)(ws + WS_HMID); bf16_t* Z0 = (bf16_t*)(ws + WS_Z0); bf16_t* Z1 = (bf16_t*)(ws + WS_Z1); bf16_t* Fb = (bf16_t*)(ws + WS_F);
    float* SSQ = (float*)(ws + WS_SSQ); float* BV0 = (float*)(ws + WS_BV); float* BV1 = BV0 + 4 * 4096; float* BVF = BV1 + 4 * 4096; float* GM = BVF + 16 * 512;
    const int lo = args.ph_lo, hi = args.ph_hi;
    cg::grid_group grid = cg::this_grid();
#define IN(k) (lo <= (k) && (k) < hi)
#ifndef REP_SYNC
#define REP_SYNC 1
#endif
#ifndef REP_NORM
#define REP_NORM 1
#endif
#ifndef REP_S12
#define REP_S12 1
#endif
#ifndef REP_P0
#define REP_P0 1
#endif
#ifndef USE_XB
#define USE_XB 1
#endif
#define SEAM(k) do { if (IN(k) && IN((k) + 1)) { for (int r_ = 0; r_ < REP_SYNC; ++r_) { if (use_cg) grid.sync(); else xcd_barrier(xbar); } } } while (0)
    { volatile LAS unsigned* st_ = (volatile LAS unsigned*)(lds + LDS_BYTES - 64); if (threadIdx.x < 2) st_[threadIdx.x] = 0u; __syncthreads(); }
    XcdBarrier xbar; xbar.bar = (unsigned*)(ws + WS_BAR); xbar.x = 0; xbar.st = (volatile LAS unsigned*)(lds + LDS_BYTES - 64);
    const bool use_cg = (args.use_cg != 0);
    if (!use_cg && hi - lo > 1) xbar = xcd_barrier_post((unsigned*)(ws + WS_BAR), (volatile LAS unsigned*)(lds + LDS_BYTES - 64));

    unsigned* dflags = (unsigned*)(ws + WS_SB + 256);
#define DBG16(k, bit, p, n) do { if (MK_DEBUG && IN(k)) { int t_ = threadIdx.x; asm volatile("" : "+v"(t_)); dbg_scan16(p, n, dflags, bit, (vcu * 512) + t_, G * 512); } } while (0)
#define DBG32(k, bit, p, n) do { if (MK_DEBUG && IN(k)) { int t_ = threadIdx.x; asm volatile("" : "+v"(t_)); dbg_scan32(p, n, dflags, bit, (vcu * 512) + t_, G * 512); } } while (0)
    if (IN(0)) {
        PHASE_IDS;
        if (MK_DEBUG && c == 0 && tid_ == 0) *dflags = 0u;
        for (int r0_ = 0; r0_ < REP_P0; ++r0_) {
        for (int u = c; u < 192; u += G) p0_mods_unit(cvec, cctx, ada_w, ada_b, mods, lds, u);
        __syncthreads();
        {
            LAS float* scr = (LAS float*)(lds + wid * 16384);
            constexpr int I_QKV = 16 * 96, I_SQ = 16 * 32, I_1 = 16 * 128, I_2 = 64 * 32;
            constexpr int NITEMS = I_QKV + I_SQ + 2 * I_1 + I_2;
            for (int it = NITEMS - 1 - gw; it >= 0; it -= NGW) {
                int r = it;
                if (r < I_QKV) { p0_transpose_item(wqkv, 1024, 3072, WQK, WV, 1, scr, r, lane); continue; } r -= I_QKV;
                if (r < I_SQ) { p0_transpose_item(wo, 1024, 1024, WO, nullptr, 0, scr, r, lane); continue; } r -= I_SQ;
                if (r < 2 * I_1) { const int l = r / I_1; p0_transpose_item(w1 + (size_t)l * 1024 * 4096, 1024, 4096, W1t + (size_t)l * 4096 * 1024, nullptr, 0, scr, r % I_1, lane); continue; } r -= 2 * I_1;
                p0_transpose_item(w2, 4096, 1024, W2t, nullptr, 0, scr, r, lane);
            }
        }
        {
            const int gt = gw * 64 + lane, NT = NGW * 64;
            for (int i = gt; i < 512 * 256; i += NT) { const int m = i >> 8, cc = i & 255, ri = m >> 8, k2 = m & 255; float sn, cs; sincospif(2.0f * (float)((cc * k2) & 255) / 256.0f, &sn, &cs);
                const float v = (ri == 0 ? cs : -sn) * (1.0f / 16.0f); CS[i] = (bf16_t)(cvt_pk_bf16(v, 0.f) & 0xffffu); }
            for (int i = gt; i < 128 * 128; i += NT) { const int n = i >> 7, kp = i & 127, ka = n >> 1, rip = n & 1, ri = kp >> 6, a = kp & 63; float sn, cs; sincospif(2.0f * (float)((a * ka) & 63) / 64.0f, &sn, &cs);
                const float v = (rip == 0 ? (ri == 0 ? cs : sn) : (ri == 0 ? -sn : cs)) * 0.125f; Dt[i] = (bf16_t)(cvt_pk_bf16(v, 0.f) & 0xffffu); }
            for (int i = gt; i < 64 * 64 * 128; i += NT) { const int kp = i & 127, kbk = (i >> 7) & 63, ka = i >> 13, rip = kp >> 6, bp = kp & 63; float sn, cs; sincospif(2.0f * (float)((bp * (ka + 64 * kbk)) & 4095) / 4096.0f, &sn, &cs);
                const float v = (rip == 0 ? cs : sn) * 0.125f; Et[i] = (bf16_t)(cvt_pk_bf16(v, 0.f) & 0xffffu); }
        }
        if (c == G - 1 && wid == 7) {
            float mq = fabsf(gq[lane]), mk = fabsf(gk[lane]), mr = 0.f;
            for (int i = lane; i < 16 * 465; i += 64) mr = fmaxf(mr, fabsf(rpb[i]));
#pragma unroll
            for (int o = 1; o < 64; o <<= 1) { mq = fmaxf(mq, __shfl_xor(mq, o)); mk = fmaxf(mk, __shfl_xor(mk, o)); mr = fmaxf(mr, __shfl_xor(mr, o)); }
            if (lane == 0) *sbound = (8.0f * mq * mk + mr) * LOG2E;
        }
        __syncthreads();
        }
    }
    SEAM(0);
    const bool ctx_in_p1 = false;
    if (IN(1)) { PHASE_IDS;
        if (c == G - 1) {
            for (int i = tid_; i < 3 * 4096; i += 512) { const int idx = i >> 12, b = (i >> 10) & 3, col = i & 1023;
                const float gg = norm_g[(idx == 0 ? 1024 : idx == 1 ? 2048 : 3072) + col];
                const float sc = mods[(size_t)((idx == 0 ? 0 : 5) + b) * 6144 + (idx == 1 ? 1024 : 4096) + col];
                GM[i] = gg * (1.0f + sc); }
        }
        if (!ctx_in_p1) norm_rows(x, ctx, MT, norm_g, mods, 0, 1024, H, gw, NGW, lane);
        else if (c >= 32) norm_rows(x, ctx, ML, norm_g, mods, 0, 1024, H, (c - 32) * 8 + wid, (G - 32) * 8, lane);
        else {
            pg8::SchedOne S1u; const size_t ts = (size_t)256 * 1024 * 2; int tt;
            if (c < 16) { S1u.u.kind = 0; S1u.u.pm = 64 + (c & 3); S1u.u.pn = 4 + (c >> 2); tt = c & 3; S1u.u.a = (const char*)H + (size_t)S1u.u.pm * ts; S1u.u.b = (const char*)WQK + (size_t)S1u.u.pn * ts; }
            else { const int l2 = c - 16; S1u.u.kind = 1; S1u.u.pm = l2 & 3; S1u.u.pn = 64 + (l2 >> 2); tt = l2 >> 2; S1u.u.a = (const char*)WV + (size_t)S1u.u.pm * ts; S1u.u.b = (const char*)H + (size_t)S1u.u.pn * ts; }
            S1u.u.aux = 0;
            norm_rows(x, ctx, ML + tt * 256 + 256, norm_g, mods, 0, 1024, H, ML + tt * 256 + wid, 8, lane);
            asm volatile("s_waitcnt vmcnt(0)" ::: "memory"); __syncthreads();
            pg8::EpiQKV E{QK, VT, gq, gk};
            pg8::gemm_phase<pg8::EpiQKV, pg8::SchedOne, false>(lds, 1024, 1024, 1024, S1u, E);
        }
    }
    SEAM(1);
    DBG16(2, 0, H, (size_t)MT * 1024);
    if (IN(2)) { pg8::SchedQKV S{(const char*)H, (const char*)WQK, (const char*)WV, G, c, ctx_in_p1 ? 768 : 800}; pg8::EpiQKV E{QK, VT, gq, gk};
#ifndef REP_G2
#define REP_G2 1
#endif
        for (int r_ = 0; r_ < REP_G2; ++r_) pg8::gemm_phase<pg8::EpiQKV, pg8::SchedQKV, false>(lds, 1024, 1024, 1024, S, E);
        { PHASE_IDS;
          const bool part = (G > 32); const int w_ = part ? (c - 32) * 8 + wid : gw, nw_ = part ? (G - 32) * 8 : NGW;
          if (!part || c >= 32) {
              bias_items(W1t, CS, mods, BV0, BV1, BVF, w_, nw_, lane);
              LAS float* scr = (LAS float*)(lds + wid * 16384);
              constexpr int I_SQ = 16 * 32, I_2 = 64 * 32;
              for (int it = w_; it < I_SQ + I_2; it += nw_) {
                  if (it < I_SQ) p0_transpose_item(fw, 1024, 1024, FWt, nullptr, 0, scr, it, lane);
                  else p0_transpose_item(w2 + (size_t)4096 * 1024, 4096, 1024, W2t + (size_t)1024 * 4096, nullptr, 0, scr, it - I_SQ, lane);
              }
          } } }
    SEAM(2);
    DBG16(3, 1, QK, (size_t)ML * 2048); DBG16(3, 2, VT, (size_t)1024 * MT); DBG32(3, 13, mods, (size_t)10 * 6144);
#ifndef REP_ATT
#define REP_ATT 1
#endif
    if (IN(3)) { for (int rep = 0; rep < REP_ATT; ++rep) attn_phase(QK, VT, O, rpb, sbound, lds, G, c); }
    SEAM(3);
    DBG16(4, 3, O, (size_t)ML * 1024);
    if (IN(4)) { pg8::SchedStd S; S.init(O, WO, ML, 1024, 1024, 1024, G, c); pg8::EpiResF<false> E{x, XS, mods + 2048, GM, H, SSQ};
        pg8::gemm_phase<pg8::EpiResF<false>, pg8::SchedStd, false>(lds, 1024, 1024, 1024, S, E); }
    SEAM(4);
    DBG32(5, 4, out, (size_t)ML * 1024);
    if (IN(6)) { pg8::SchedStd S; S.init(H, W1t, ML, 4096, 1024, 1024, G, c); pg8::EpiRelu2F E{HMID, 4096, BV0, SSQ};
        pg8::gemm_phase<pg8::EpiRelu2F, pg8::SchedStd, false>(lds, 1024, 1024, 1024, S, E); }
    SEAM(6);
    DBG16(7, 5, HMID, (size_t)ML * 4096);
    if (IN(7)) { pg8::SchedStd S; S.init(HMID, W2t, ML, 1024, 64, 4096, G, c, (size_t)64 * 32768); pg8::EpiResF<true> E{XS, XS, mods + 5120, GM + 4096, H, SSQ};
        pg8::gemm_phase<pg8::EpiResF<true>, pg8::SchedStd, false>(lds, 4096, 64, 4096, S, E, 32768, 128); }
    SEAM(7);
    const float* mods1 = mods + 5 * 6144;
    DBG32(8, 6, out, (size_t)ML * 1024);
    if (IN(9)) { pg8::SchedF1 S{(const char*)CS, (const char*)H, G, c}; pg8::EpiZ0F E{Z0, BVF, SSQ};
        pg8::gemm_phase<pg8::EpiZ0F, pg8::SchedF1, true>(lds, 256, 256, 1024, S, E); }
    SEAM(9);
    DBG16(10, 7, Z0, (size_t)262144 * 128);
    if (IN(10)) { PHASE_IDS; for (int r_ = 0; r_ < REP_S12; ++r_) s1_phase(Z0, Dt, Z1, lds, gw, NGW); }
    SEAM(10);
    DBG16(11, 8, Z1, (size_t)262144 * 128);
    if (IN(11)) { PHASE_IDS; for (int r_ = 0; r_ < REP_S12; ++r_) s2_phase(Z1, Et, Fb, gw, NGW, lane); }
    SEAM(11);
    DBG16(12, 9, Fb, (size_t)ML * 1024);
    if (IN(12)) { pg8::SchedStd S; S.init(Fb, FWt, ML, 1024, 1024, 1024, G, c); pg8::EpiResF<true> E{XS, XS, mods1 + 2048, GM + 8192, H, SSQ};
        pg8::gemm_phase<pg8::EpiResF<true>, pg8::SchedStd, false>(lds, 1024, 1024, 1024, S, E); }
    SEAM(12);
    DBG32(13, 10, out, (size_t)ML * 1024);
    if (IN(14)) { pg8::SchedStd S; S.init(H, W1t + (size_t)4096 * 1024, ML, 4096, 1024, 1024, G, c); pg8::EpiRelu2F E{HMID, 4096, BV1, SSQ};
        pg8::gemm_phase<pg8::EpiRelu2F, pg8::SchedStd, false>(lds, 1024, 1024, 1024, S, E); }
    SEAM(14);
    DBG16(15, 11, HMID, (size_t)ML * 4096);
    if (IN(15)) { pg8::SchedStd S; S.init(HMID, W2t + (size_t)1024 * 4096, ML, 1024, 64, 4096, G, c, (size_t)64 * 32768); pg8::EpiRes E{XS, out, mods1 + 5120};
        pg8::gemm_phase<pg8::EpiRes, pg8::SchedStd, false>(lds, 4096, 64, 4096, S, E, 32768, 128); }
    SEAM(15);
    if (MK_DEBUG && IN(16)) {
        int t_ = threadIdx.x; asm volatile("" : "+v"(t_));
        bool bad = false;
        for (size_t i = (size_t)vcu * 512 + t_; i < (size_t)ML * 1024; i += (size_t)G * 512) { if ((__float_as_uint(out[i]) & 0x7f800000u) == 0x7f800000u) { bad = true; out[i] = 0.f; } }
        if (bad) atomicOr(dflags, 1u << 12);
    }
    SEAM(16);
    if (MK_DEBUG && IN(17)) {
        if (c == 0 && threadIdx.x == 0) { const unsigned f = *dflags; if (f) out[0] = 1.0e6f * (float)(__builtin_ctz(f) + 1) + 1.0e4f * (float)__builtin_popcount(f); }
    }
#undef IN
#undef SEAM
}

constexpr int NPHASE = MK_DEBUG ? 18 : 16;
#ifndef MK_USE_CG
#define MK_USE_CG 0
#endif
#ifndef MK_PER_PHASE
#define MK_PER_PHASE 0
#endif

extern "C" void kernel_launch(void* const* d_in, const int* in_sizes, int n_in, void* d_out, int out_size, void* d_ws, size_t ws_size, hipStream_t stream) {
    static int grid = 0;
    if (grid == 0) {
        if (n_in != 15 || out_size != ML * DM || ws_size < WS_END) { fprintf(stderr, "kernel_launch: unexpected shapes (n_in %d out %d ws %zu)\n", n_in, out_size, ws_size); grid = -1; return; }
        int dev = 0, cus = 0, per_cu = 0;
        hipGetDevice(&dev); hipDeviceGetAttribute(&cus, hipDeviceAttributeMultiprocessorCount, dev);
        hipFuncSetAttribute((const void*)fwd_kernel, hipFuncAttributeMaxDynamicSharedMemorySize, LDS_BYTES);
        if (hipOccupancyMaxActiveBlocksPerMultiprocessor(&per_cu, (const void*)fwd_kernel, 512, LDS_BYTES) != hipSuccess || per_cu < 1) { fprintf(stderr, "kernel_launch: occupancy query failed (%d)\n", per_cu); (void)hipGetLastError(); per_cu = 1; }
        grid = cus * 1;
        if (grid <= 0) grid = 256;
    }
    if (grid < 0) return;
    if (hipMemsetAsync((char*)d_ws + WS_BAR, 0, BAR_BYTES, stream) != hipSuccess) { fprintf(stderr, "kernel_launch: memset failed\n"); return; }
    Args a{};
    for (int i = 0; i < 15; ++i) a.in[i] = (const float*)d_in[i];
    a.out = (float*)d_out; a.ws = (unsigned char*)d_ws;
#if MK_PER_PHASE
    for (int p = 0; p < NPHASE; ++p) { a.ph_lo = p; a.ph_hi = p + 1; hipLaunchKernelGGL(fwd_kernel, dim3(grid), dim3(512), LDS_BYTES, stream, a); }
#else
    a.ph_lo = 0; a.ph_hi = NPHASE; a.use_cg = MK_USE_CG;
    void* kargs[] = {&a};
    hipError_t e = hipLaunchCooperativeKernel((const void*)fwd_kernel, dim3(grid), dim3(512), kargs, LDS_BYTES, stream);
    if (e != hipSuccess) fprintf(stderr, "cooperative launch failed: %s (grid %d)\n", hipGetErrorString(e), grid);
#endif
}
```

```cpp
#include <hip/hip_runtime.h>
#include <hip/hip_cooperative_groups.h>
#include <cstdio>
#include <cstdint>
namespace cg = cooperative_groups;

#define LAS __attribute__((address_space(3)))
typedef unsigned short bf16_t;
typedef short bf16x8 __attribute__((ext_vector_type(8)));
typedef short s16x4 __attribute__((ext_vector_type(4)));
typedef float f32x4 __attribute__((ext_vector_type(4)));
typedef unsigned u32x4 __attribute__((ext_vector_type(4)));
typedef unsigned u32x2 __attribute__((ext_vector_type(2)));

constexpr int DM = 1024, NB = 4, SEQ = 4096, CTXL = 256, FF = 4096;
constexpr int ML = NB * SEQ;
constexpr int MT = ML + NB * CTXL;
constexpr float LOG2E = 1.4426950408889634f;
constexpr float EPS = 1e-6f;

constexpr size_t MiB = 1u << 20;
constexpr size_t WS_MODS = 0;
constexpr size_t WS_SB = 512 * 1024;
constexpr size_t WS_BAR = 1 * MiB;
constexpr size_t BAR_BYTES = 16384;
constexpr size_t WS_CS = 2 * MiB;
constexpr size_t WS_D = 2 * MiB + 512 * 1024;
constexpr size_t WS_E = 3 * MiB;
constexpr size_t WS_WQK = 4 * MiB, WS_WV = 8 * MiB, WS_WO = 10 * MiB, WS_FW = 12 * MiB;
constexpr size_t WS_W1 = 14 * MiB;
constexpr size_t WS_W2 = 30 * MiB;
constexpr size_t WS_SSQ = 46 * MiB;
constexpr size_t WS_BV = 47 * MiB;
constexpr size_t WS_H = 48 * MiB;
constexpr size_t WS_R = 82 * MiB;
constexpr size_t WS_QK = WS_R;
constexpr size_t WS_VT = WS_R + 68 * MiB;
constexpr size_t WS_O = WS_R + 102 * MiB;
constexpr size_t WS_HMID = WS_R;
constexpr size_t WS_Z0 = WS_R;
constexpr size_t WS_Z1 = WS_R + 64 * MiB;
constexpr size_t WS_F = WS_R;
constexpr size_t WS_XS = WS_R + 134 * MiB;
constexpr size_t WS_END = 256 * MiB;
static_assert(WS_XS + 32 * MiB <= WS_END && WS_O + 32 * MiB <= WS_XS && WS_F + 32 * MiB <= WS_END && WS_HMID + 128 * MiB <= WS_END && WS_O + 32 * MiB <= WS_END, "ws map");

constexpr int LDS_BYTES = 147456;

typedef __bf16 bf16v2_t __attribute__((ext_vector_type(2)));
typedef float f32v2_t __attribute__((ext_vector_type(2)));
__device__ __forceinline__ unsigned cvt_pk_bf16(float lo, float hi) { const f32v2_t v = {lo, hi}; const bf16v2_t r = __builtin_convertvector(v, bf16v2_t); return __builtin_bit_cast(unsigned, r); }
__device__ __forceinline__ f32x4 mfma16(bf16x8 a, bf16x8 b, f32x4 c) { return __builtin_amdgcn_mfma_f32_16x16x32_bf16(a, b, c, 0, 0, 0); }


#ifndef MK_WT
#define MK_WT 0
#endif
__device__ __forceinline__ void st16(void* p, u32x4 v) {
#if MK_WT
    asm volatile("global_store_dwordx4 %0, %1, off sc1\n\ts_nop 1" :: "v"(p), "v"(v) : "memory");
#else
    *(u32x4*)p = v;
#endif
}
__device__ __forceinline__ void st16f(void* p, f32x4 v) {
#if MK_WT
    asm volatile("global_store_dwordx4 %0, %1, off sc1\n\ts_nop 1" :: "v"(p), "v"(v) : "memory");
#else
    *(f32x4*)p = v;
#endif
}
__device__ __forceinline__ void st8(void* p, u32x2 v) {
#if MK_WT
    asm volatile("global_store_dwordx2 %0, %1, off sc1\n\ts_nop 1" :: "v"(p), "v"(v) : "memory");
#else
    *(u32x2*)p = v;
#endif
}
namespace pg8 {
constexpr int BM = 256, BK = 64, HALF = 128, HTB = HALF * BK * 2, STAGE_BYTES = 8 * HTB;
__device__ __forceinline__ int lds_byte(int r, int c) { const int st = (r >> 4) * 2 + (c >> 5), rr = r & 15, cc = c & 31, ob = rr * 64 + cc * 2; return st * 1024 + (ob ^ (((ob >> 9) & 1) << 5)); }
__device__ __forceinline__ void stage_rc(int b, int& R, int& C) { const int st = b / 1024, sb = b % 1024, swz = sb ^ (((sb >> 9) & 1) << 5); R = (st >> 1) * 16 + swz / 64; C = (st & 1) * 32 + (swz % 64) / 2; }
__device__ __forceinline__ int perm32(int rho) { const int n = rho >> 4, i = rho & 15; return 8 * (i >> 2) + 4 * n + (i & 3); }

struct Unit { int pm, pn, kind, aux; const char* a; const char* b; };

template <class Epi, class Sched, bool BMAP>
__device__ __forceinline__ void gemm_phase(LAS unsigned char* lds, const int K, const int lda, const int ldb, const Sched& S, const Epi& E, const size_t kstepA = 128, const size_t kstepB = 128) {
    int tid = threadIdx.x; asm volatile("" : "+v"(tid));
    const int wid = __builtin_amdgcn_readfirstlane(tid >> 6), lane = tid & 63, wr = wid >> 2, wc = wid & 3, fr = lane & 15, fq = lane >> 4;
    int nt = K / BK; asm volatile("" : "+s"(nt));
    unsigned voffA[2], voffB[2];
#pragma unroll
    for (int i = 0; i < 2; ++i) { int R, C; stage_rc(tid * 16 + i * 8192, R, C); const int Rb = (R & ~31) + perm32(R & 31);
        voffA[i] = (unsigned)(R * lda + C) * 2u;
        voffB[i] = BMAP ? (unsigned)((64 * (Rb & 63) + (Rb >> 6)) * ldb + C) * 2u : (unsigned)(Rb * ldb + C) * 2u; }
    const size_t hstepA = (size_t)HALF * lda * 2;
    const size_t hstepB = BMAP ? (size_t)2 * ldb * 2 : (size_t)HALF * ldb * 2;
    const unsigned ldsw = (unsigned)wid * 1024u;
    const int aoff = lds_byte(wr * 64 + fr, fq * 8), boff = lds_byte(wc * 32 + fr, fq * 8);
#define PG8_SA(b, h) (((b) * 2 + (h)) * HTB)
#define PG8_SB(b, h) ((4 + (b) * 2 + (h)) * HTB)
#define PG8_STAGE(bufoff, gbase, voff) do { _Pragma("unroll") for (int _i = 0; _i < 2; ++_i) \
        __builtin_amdgcn_global_load_lds((const unsigned*)((const char*)(gbase) + (voff)[_i]), (LAS unsigned*)(lds + (bufoff) + ldsw + _i * 8192), 16, 0, 0); } while (0)
#define PG8_LDA(dst, b, h) do { _Pragma("unroll") for (int m = 0; m < 4; ++m) _Pragma("unroll") for (int k = 0; k < 2; ++k) dst[m][k] = *(const LAS bf16x8*)(lds + PG8_SA(b, h) + aoff + m * 2048 + k * 1024); } while (0)
#define PG8_LDB(dst, b, h) do { _Pragma("unroll") for (int n = 0; n < 2; ++n) _Pragma("unroll") for (int k = 0; k < 2; ++k) dst[n][k] = *(const LAS bf16x8*)(lds + PG8_SB(b, h) + boff + n * 2048 + k * 1024); } while (0)
#define PG8_MMA(ai, bj, At, Bt) do { __builtin_amdgcn_s_setprio(1); _Pragma("unroll") for (int m = 0; m < 4; ++m) _Pragma("unroll") for (int n = 0; n < 2; ++n) _Pragma("unroll") for (int k = 0; k < 2; ++k) \
        acc[ai][bj][m][n] = __builtin_amdgcn_mfma_f32_16x16x32_bf16(Bt[n][k], At[m][k], acc[ai][bj][m][n], 0, 0, 0); __builtin_amdgcn_s_setprio(0); } while (0)
#define PG8_WAIT_V(n) asm volatile("s_waitcnt vmcnt(" #n ")" ::: "memory")
#define PG8_WAIT_L(n) asm volatile("s_waitcnt lgkmcnt(" #n ")" ::: "memory")
#define PG8_BAR __builtin_amdgcn_s_barrier()
#define PG8_SCHED __builtin_amdgcn_sched_barrier(0)
    Unit cur, nxt; int ui = 0;
    if (!S.next(0, cur)) return;
    f32x4 acc[2][2][4][2];
#pragma unroll
    for (int a = 0; a < 2; ++a)
#pragma unroll
        for (int b = 0; b < 2; ++b)
#pragma unroll
            for (int m = 0; m < 4; ++m)
#pragma unroll
                for (int n = 0; n < 2; ++n) acc[a][b][m][n] = (f32x4){0.f, 0.f, 0.f, 0.f};
    bf16x8 At[4][2], B0[2][2], B1[2][2];
    const char* cA = cur.a; const char* cB = cur.b;
    if constexpr (Epi::PREP) E.prep(cur, lds, 0, tid);
    PG8_STAGE(PG8_SB(0, 0), cB, voffB); PG8_STAGE(PG8_SB(0, 1), cB + hstepB, voffB); PG8_STAGE(PG8_SA(0, 0), cA, voffA); PG8_STAGE(PG8_SA(0, 1), cA + hstepA, voffA);
    if (wr == 1) PG8_BAR;
    PG8_WAIT_V(2); PG8_BAR;
    PG8_STAGE(PG8_SB(1, 0), cB + kstepB, voffB); PG8_STAGE(PG8_SA(1, 0), cA + kstepA, voffA); PG8_STAGE(PG8_SB(1, 1), cB + hstepB + kstepB, voffB);
    PG8_WAIT_V(6); PG8_BAR;
    for (;;) {
        const bool has_next = S.next(ui + 1, nxt);
        const char* nA = has_next ? nxt.a : cA; const char* nB = has_next ? nxt.b : cB;
        for (int t = 0; t < nt; t += 2) {
            const bool last = (t == nt - 2);
            const char* a1 = cA + (size_t)(t + 1) * kstepA;
            const char* a2 = last ? nA : cA + (size_t)(t + 2) * kstepA; const char* b2 = last ? nB : cB + (size_t)(t + 2) * kstepB;
            const char* a3 = a2 + kstepA; const char* b3 = b2 + kstepB;
            PG8_LDB(B0, 0, 0); PG8_LDB(B1, 0, 1); PG8_SCHED; PG8_LDA(At, 0, 0); PG8_STAGE(PG8_SA(1, 1), a1 + hstepA, voffA);
            PG8_WAIT_V(8); PG8_WAIT_L(0); PG8_BAR; PG8_MMA(0, 0, At, B0); PG8_MMA(0, 1, At, B1); PG8_BAR; PG8_SCHED;
            PG8_LDA(At, 0, 1); PG8_STAGE(PG8_SB(0, 0), b2, voffB); PG8_STAGE(PG8_SB(0, 1), b2 + hstepB, voffB); PG8_STAGE(PG8_SA(0, 0), a2, voffA);
            PG8_WAIT_V(8); PG8_WAIT_L(0); PG8_BAR; PG8_MMA(1, 0, At, B0); PG8_MMA(1, 1, At, B1); PG8_BAR; PG8_SCHED;
            PG8_LDB(B0, 1, 0); PG8_LDB(B1, 1, 1); PG8_SCHED; PG8_LDA(At, 1, 0); PG8_STAGE(PG8_SA(0, 1), a2 + hstepA, voffA);
            PG8_WAIT_V(8); PG8_WAIT_L(0); PG8_BAR; PG8_MMA(0, 0, At, B0); PG8_MMA(0, 1, At, B1); PG8_BAR; PG8_SCHED;
            PG8_LDA(At, 1, 1); PG8_STAGE(PG8_SB(1, 0), b3, voffB); PG8_STAGE(PG8_SB(1, 1), b3 + hstepB, voffB); PG8_STAGE(PG8_SA(1, 0), a3, voffA);
            PG8_WAIT_V(8); PG8_WAIT_L(0); PG8_BAR; PG8_MMA(1, 0, At, B0); PG8_MMA(1, 1, At, B1); PG8_BAR; PG8_SCHED;
        }
        if (wr == 0) PG8_BAR;
        if constexpr (Epi::PREP) { if (has_next) E.prep(nxt, lds, (ui + 1) & 1, tid); }
        E(acc, cur, wr, wc, fr, fq, lds, ui & 1);
        if (!has_next) break;
#pragma unroll
        for (int a = 0; a < 2; ++a)
#pragma unroll
            for (int b = 0; b < 2; ++b)
#pragma unroll
                for (int m = 0; m < 4; ++m)
#pragma unroll
                    for (int n = 0; n < 2; ++n) acc[a][b][m][n] = (f32x4){0.f, 0.f, 0.f, 0.f};
        cur = nxt; cA = nA; cB = nB; ++ui;
        if (wr == 1) PG8_BAR;
    }
    PG8_WAIT_V(0);
    PG8_BAR;
#undef PG8_SA
#undef PG8_SB
#undef PG8_STAGE
#undef PG8_LDA
#undef PG8_LDB
#undef PG8_MMA
#undef PG8_WAIT_V
#undef PG8_WAIT_L
#undef PG8_BAR
#undef PG8_SCHED
}

struct SchedStd {
    const char* A; const char* Bt; size_t tsA, tsB; int nM, nN, nwg, G, c;
    __device__ void init(const void* A_, const void* Bt_, int M, int N, int lda, int ldb, int G_, int c_, size_t tsA_ = 0) { A = (const char*)A_; Bt = (const char*)Bt_; tsA = tsA_ ? tsA_ : (size_t)BM * lda * 2; tsB = (size_t)BM * ldb * 2; nM = M / BM; nN = N / BM; nwg = nM * nN; G = G_; c = c_; }
    __device__ bool next(int i, Unit& u) const {
        const long L = (long)i * G + c; if (L >= nwg) return false;
        int wgid = (int)L; { const int q = nwg / 8, r = nwg % 8, xcd = wgid % 8, off = wgid / 8; wgid = (xcd < r ? xcd * (q + 1) : r * (q + 1) + (xcd - r) * q) + off; }
        const int nig = 8 * nN, gid = wgid / nig, fm = gid * 8, gsz = (nM - fm) < 8 ? (nM - fm) : 8;
        u.pm = fm + ((wgid % nig) % gsz); u.pn = (wgid % nig) / gsz; u.kind = 0; u.aux = 0;
        u.a = A + (size_t)u.pm * tsA; u.b = Bt + (size_t)u.pn * tsB; return true;
    }
};
struct SchedQKV {
    const char* H; const char* Wqk; const char* Wv; int G, c, nunits;
    __device__ bool next(int i, Unit& u) const {
        const long Ll = (long)i * G + c; if (Ll >= nunits) return false;
        const int L = (int)Ll; const size_t ts = (size_t)BM * 1024 * 2; u.aux = 0;
        if (L < 512) { const int x = L & 7, off = L >> 3; u.kind = 0; u.pm = 8 * x + (off & 7); u.pn = off >> 3; }
        else if (L < 768) { const int l2 = L - 512, x = l2 & 7, off = l2 >> 3; u.kind = 1; u.pm = off & 3; u.pn = 8 * x + (off >> 2); }
        else if (L < 784) { const int l2 = L - 768; u.kind = 0; u.pm = 64 + (l2 & 3); u.pn = 4 + (l2 >> 2); }
        else { const int l2 = L - 784; u.kind = 1; u.pm = l2 & 3; u.pn = 64 + (l2 >> 2); }
        if (u.kind == 0) { u.a = H + (size_t)u.pm * ts; u.b = Wqk + (size_t)u.pn * ts; }
        else { u.a = Wv + (size_t)u.pm * ts; u.b = H + (size_t)u.pn * ts; }
        return true;
    }
};
struct SchedOne { Unit u;
    __device__ __forceinline__ bool next(int i, Unit& o) const { if (i > 0) return false; o = u; return true; }
};
struct SchedF1 {
    const char* CS; const char* H; int G, c;
    __device__ bool next(int i, Unit& u) const {
        const long Ll = (long)i * G + c; if (Ll >= 512) return false;
        const int L = (int)Ll; const int t = L & 15, b = (L >> 4) & 3, g = (L >> 6) & 3, ri = L >> 8;
        u.pm = ri; u.pn = t; u.kind = g; u.aux = b;
        u.a = CS + (size_t)ri * 256 * 256 * 2; u.b = H + ((size_t)(b * 4096 + 4 * t) * 1024 + g * 256) * 2; return true;
    }
};

typedef f32x4 Acc[2][2][4][2];
__device__ __forceinline__ u32x4 pack8(f32x4 v0, f32x4 v1) { u32x4 w; w.x = cvt_pk_bf16(v0[0], v0[1]); w.y = cvt_pk_bf16(v0[2], v0[3]); w.z = cvt_pk_bf16(v1[0], v1[1]); w.w = cvt_pk_bf16(v1[2], v1[3]); return w; }

__device__ __forceinline__ void unpack8(u32x4 w, f32x4& v0, f32x4& v1) {
    v0[0] = __uint_as_float(w.x << 16); v0[1] = __uint_as_float(w.x & 0xffff0000u); v0[2] = __uint_as_float(w.y << 16); v0[3] = __uint_as_float(w.y & 0xffff0000u);
    v1[0] = __uint_as_float(w.z << 16); v1[1] = __uint_as_float(w.z & 0xffff0000u); v1[2] = __uint_as_float(w.w << 16); v1[3] = __uint_as_float(w.w & 0xffff0000u);
}
struct EpiQKV { static constexpr bool PREP = true; bf16_t* QK; bf16_t* VT; const float* gq; const float* gk;
    __device__ __forceinline__ void prep(const Unit& u, LAS unsigned char* lds, int slot, int tid) const {
        if (u.kind == 0 && tid < 64) { const bool isq = u.pn < 4; ((LAS float*)(lds + 131072))[slot * 512 + tid] = isq ? gq[tid] * (0.125f * LOG2E) : gk[tid]; }
    }
    __device__ __forceinline__ void operator()(const Acc& acc, const Unit& u, int wr, int wc, int fr, int fq, LAS unsigned char* lds, int slot) const {
        if (u.kind == 0) {
            const LAS float* gp = (const LAS float*)(lds + 131072) + slot * 512;
            f32x4 gv[2][2];
#pragma unroll
            for (int bj = 0; bj < 2; ++bj)
#pragma unroll
                for (int n = 0; n < 2; ++n) gv[bj][n] = *(const LAS f32x4*)(gp + 32 * bj + 8 * fq + 4 * n);
#pragma unroll
            for (int ai = 0; ai < 2; ++ai)
#pragma unroll
                for (int m = 0; m < 4; ++m) {
                    const int row = u.pm * BM + ai * HALF + wr * 64 + m * 16 + fr;
                    float ss = 0.f;
#pragma unroll
                    for (int bj = 0; bj < 2; ++bj)
#pragma unroll
                        for (int n = 0; n < 2; ++n) { const f32x4 x = acc[ai][bj][m][n]; ss += (x[0] * x[0] + x[1] * x[1]) + (x[2] * x[2] + x[3] * x[3]); }
                    ss += __shfl_xor(ss, 16); ss += __shfl_xor(ss, 32);
                    const float rstd = rsqrtf(ss * (1.0f / 64.0f) + EPS);
                    bf16_t* rowp = QK + (size_t)row * 2048 + u.pn * 256 + wc * 64 + 8 * fq;
#pragma unroll
                    for (int bj = 0; bj < 2; ++bj) st16(rowp + 32 * bj, pack8(acc[ai][bj][m][0] * rstd * gv[bj][0], acc[ai][bj][m][1] * rstd * gv[bj][1]));
                }
        } else {
#pragma unroll
            for (int ai = 0; ai < 2; ++ai)
#pragma unroll
                for (int m = 0; m < 4; ++m) {
                    const int row = u.pm * BM + ai * HALF + wr * 64 + m * 16 + fr;
                    bf16_t* rowp = VT + (size_t)row * MT + u.pn * 256 + wc * 32 + 8 * fq;
#pragma unroll
                    for (int bj = 0; bj < 2; ++bj) st16(rowp + bj * HALF, pack8(acc[ai][bj][m][0], acc[ai][bj][m][1]));
                }
        }
    }
};
struct EpiRelu2 { static constexpr bool PREP = false; bf16_t* O; int ldc;
    __device__ __forceinline__ void operator()(const Acc& acc, const Unit& u, int wr, int wc, int fr, int fq, LAS unsigned char*, int) const {
#pragma unroll
        for (int ai = 0; ai < 2; ++ai)
#pragma unroll
            for (int m = 0; m < 4; ++m) {
                const int row = u.pm * BM + ai * HALF + wr * 64 + m * 16 + fr;
                bf16_t* rowp = O + (size_t)row * ldc + u.pn * 256 + wc * 32 + 8 * fq;
#pragma unroll
                for (int bj = 0; bj < 2; ++bj) { f32x4 v0 = acc[ai][bj][m][0], v1 = acc[ai][bj][m][1];
#pragma unroll
                    for (int e = 0; e < 4; ++e) { const float a = fmaxf(v0[e], 0.f), b = fmaxf(v1[e], 0.f); v0[e] = a * a; v1[e] = b * b; }
                    *(u32x4*)(rowp + bj * HALF) = pack8(v0, v1); }
            }
    }
};
struct EpiRes { static constexpr bool PREP = false; const bf16_t* base; float* out; const float* gate;
    __device__ __forceinline__ void operator()(const Acc& acc, const Unit& u, int wr, int wc, int fr, int fq, LAS unsigned char*, int) const {
        const int col0 = u.pn * 256 + wc * 32 + 8 * fq;
        const float* gp = gate + (size_t)(u.pm >> 4) * 6144 + col0;
        f32x4 gv[2][2];
#pragma unroll
        for (int bj = 0; bj < 2; ++bj)
#pragma unroll
            for (int n = 0; n < 2; ++n) gv[bj][n] = *(const f32x4*)(gp + bj * HALF + 4 * n);
#pragma unroll
        for (int ai = 0; ai < 2; ++ai)
#pragma unroll
          for (int mh = 0; mh < 2; ++mh) {
            u32x4 pre[2][2];
#pragma unroll
            for (int m2 = 0; m2 < 2; ++m2)
#pragma unroll
                for (int bj = 0; bj < 2; ++bj) pre[m2][bj] = *(const u32x4*)(base + (size_t)(u.pm * BM + ai * HALF + wr * 64 + (2 * mh + m2) * 16 + fr) * 1024 + col0 + bj * HALF);
            asm volatile("" ::: "memory");
#pragma unroll
            for (int m2 = 0; m2 < 2; ++m2) { const int m = 2 * mh + m2;
                const size_t off = (size_t)(u.pm * BM + ai * HALF + wr * 64 + m * 16 + fr) * 1024 + col0;
#pragma unroll
                for (int bj = 0; bj < 2; ++bj) { f32x4 b0, b1; unpack8(pre[m2][bj], b0, b1);
                    *(f32x4*)(out + off + bj * HALF) = b0 + gv[bj][0] * acc[ai][bj][m][0]; *(f32x4*)(out + off + bj * HALF + 4) = b1 + gv[bj][1] * acc[ai][bj][m][1]; }
            }
            asm volatile("" ::: "memory");
          }
    }
};
struct EpiZ0 { static constexpr bool PREP = false; bf16_t* Z0;
    __device__ __forceinline__ void operator()(const Acc& acc, const Unit& u, int wr, int wc, int fr, int fq, LAS unsigned char*, int) const {
        const int ri = u.pm, t = u.pn, g = u.kind, b = u.aux;
        bf16_t* p0 = Z0 + ((size_t)(((b * 4 + g) * 256 + wr * 64 + fr) * 64 + 4 * t + (wc >> 1))) * 128 + ri * 64 + 32 * (wc & 1) + 8 * fq;
#pragma unroll
        for (int ai = 0; ai < 2; ++ai)
#pragma unroll
            for (int m = 0; m < 4; ++m) {
#pragma unroll
                for (int bj = 0; bj < 2; ++bj)
                    *(u32x4*)(p0 + (size_t)(ai * HALF + m * 16) * 8192 + bj * 256) = pack8(acc[ai][bj][m][0], acc[ai][bj][m][1]);
                asm volatile("" ::: "memory");
            }
    }
};

constexpr int AUX_OFF = 131072;
template <bool BASE16>
struct EpiResF { static constexpr bool PREP = false; const void* base; bf16_t* XS; const float* gate; const float* gm; bf16_t* XB; float* SSQ;
    __device__ __forceinline__ void operator()(const Acc& acc, const Unit& u, int wr, int wc, int fr, int fq, LAS unsigned char*, int) const {
        const int col0 = u.pn * 256 + wc * 32 + 8 * fq, b = u.pm >> 4;
        f32x4 gv[2][2], mv[2][2];
#pragma unroll
        for (int bj = 0; bj < 2; ++bj)
#pragma unroll
            for (int n = 0; n < 2; ++n) { gv[bj][n] = *(const f32x4*)(gate + (size_t)b * 6144 + col0 + bj * HALF + 4 * n); mv[bj][n] = *(const f32x4*)(gm + b * 1024 + col0 + bj * HALF + 4 * n); }
#pragma unroll
        for (int ai = 0; ai < 2; ++ai)
#pragma unroll
          for (int mh = 0; mh < 2; ++mh) {
            f32x4 pre[2][2][2];
#pragma unroll
            for (int m2 = 0; m2 < 2; ++m2) { const size_t off = (size_t)(u.pm * BM + ai * HALF + wr * 64 + (2 * mh + m2) * 16 + fr) * 1024 + col0;
#pragma unroll
                for (int bj = 0; bj < 2; ++bj) {
                    if (BASE16) { const u32x4 w = *(const u32x4*)((const bf16_t*)base + off + bj * HALF); unpack8(w, pre[m2][bj][0], pre[m2][bj][1]); }
                    else { pre[m2][bj][0] = *(const f32x4*)((const float*)base + off + bj * HALF); pre[m2][bj][1] = *(const f32x4*)((const float*)base + off + bj * HALF + 4); }
                } }
            asm volatile("" ::: "memory");
#pragma unroll
            for (int m2 = 0; m2 < 2; ++m2) {
                const int m = 2 * mh + m2;
                const int row = u.pm * BM + ai * HALF + wr * 64 + m * 16 + fr;
                const size_t off = (size_t)row * 1024 + col0;
                float ss = 0.f;
#pragma unroll
                for (int bj = 0; bj < 2; ++bj) {
                    const f32x4 v0 = pre[m2][bj][0] + gv[bj][0] * acc[ai][bj][m][0];
                    const f32x4 v1 = pre[m2][bj][1] + gv[bj][1] * acc[ai][bj][m][1];
                    st16(XS + off + bj * HALF, pack8(v0, v1));
                    ss += ((v0[0] * v0[0] + v0[1] * v0[1]) + (v0[2] * v0[2] + v0[3] * v0[3])) + ((v1[0] * v1[0] + v1[1] * v1[1]) + (v1[2] * v1[2] + v1[3] * v1[3]));
                    st16(XB + off + bj * HALF, pack8(v0 * mv[bj][0], v1 * mv[bj][1]));
                }
                ss += __shfl_xor(ss, 16); ss += __shfl_xor(ss, 32);
                if (fq == 0) SSQ[(size_t)row * 16 + u.pn * 4 + wc] = ss;
            }
            asm volatile("" ::: "memory");
          }
    }
};
__device__ __forceinline__ float ssq_rstd(const float* SSQ, int row, int half) {
    const f32x4 a = *(const f32x4*)(SSQ + (size_t)row * 16 + half * 8), b = *(const f32x4*)(SSQ + (size_t)row * 16 + half * 8 + 4);
    float s = ((a[0] + a[1]) + (a[2] + a[3])) + ((b[0] + b[1]) + (b[2] + b[3]));
    s += __shfl_xor(s, 1);
    return rsqrtf(s * (1.0f / 1024.0f) + EPS);
}
struct EpiRelu2F { static constexpr bool PREP = true; bf16_t* O; int ldc; const float* BV; const float* SSQ;
    __device__ __forceinline__ void prep(const Unit& u, LAS unsigned char* lds, int slot, int tid) const {
        const float r = ssq_rstd(SSQ, u.pm * BM + (tid >> 1), tid & 1);
        LAS float* aux = (LAS float*)(lds + AUX_OFF) + slot * 512;
        if (!(tid & 1)) aux[tid >> 1] = r;
        if (tid < 256) aux[256 + tid] = BV[(size_t)(u.pm >> 4) * 4096 + u.pn * 256 + tid];
    }
    __device__ __forceinline__ void operator()(const Acc& acc, const Unit& u, int wr, int wc, int fr, int fq, LAS unsigned char* lds, int slot) const {
        const LAS float* rt = (const LAS float*)(lds + AUX_OFF) + slot * 512;
        const int col0 = u.pn * 256 + wc * 32 + 8 * fq;
        f32x4 bv[2][2];
#pragma unroll
        for (int bj = 0; bj < 2; ++bj)
#pragma unroll
            for (int n = 0; n < 2; ++n) bv[bj][n] = *(const LAS f32x4*)(rt + 256 + wc * 32 + 8 * fq + bj * HALF + 4 * n);
#pragma unroll
        for (int ai = 0; ai < 2; ++ai)
#pragma unroll
            for (int m = 0; m < 4; ++m) {
                const int rl = ai * HALF + wr * 64 + m * 16 + fr; const float rs = rt[rl];
                bf16_t* rowp = O + ((size_t)(u.pm * 64 + u.pn * 4 + (wc >> 1)) * 256 + rl) * 64 + (wc & 1) * 32 + 8 * fq;
#pragma unroll
                for (int bj = 0; bj < 2; ++bj) { f32x4 v0 = acc[ai][bj][m][0] * rs + bv[bj][0], v1 = acc[ai][bj][m][1] * rs + bv[bj][1];
#pragma unroll
                    for (int e = 0; e < 4; ++e) { const float a = fmaxf(v0[e], 0.f), c2 = fmaxf(v1[e], 0.f); v0[e] = a * a; v1[e] = c2 * c2; }
                    st16(rowp + bj * 2 * 256 * 64, pack8(v0, v1)); }
            }
    }
};
struct EpiZ0F { static constexpr bool PREP = true; bf16_t* Z0; const float* BVF; const float* SSQ;
    __device__ __forceinline__ void prep(const Unit& u, LAS unsigned char* lds, int slot, int tid) const {
        const int nl = tid >> 1, tok = u.aux * 4096 + 64 * (nl & 63) + 4 * u.pn + (nl >> 6);
        const float r = ssq_rstd(SSQ, tok, tid & 1);
        LAS float* aux = (LAS float*)(lds + AUX_OFF) + slot * 512;
        if (!(tid & 1)) aux[nl] = r;
        if (tid < 256) aux[256 + tid] = BVF[(size_t)(u.aux * 4 + u.kind) * 512 + u.pm * 256 + tid];
    }
    __device__ __forceinline__ void operator()(const Acc& acc, const Unit& u, int wr, int wc, int fr, int fq, LAS unsigned char* lds, int slot) const {
        const LAS float* rt = (const LAS float*)(lds + AUX_OFF) + slot * 512;
        const int ri = u.pm, t = u.pn, g = u.kind, b = u.aux;
        f32x4 rs[2][2];
#pragma unroll
        for (int bj = 0; bj < 2; ++bj)
#pragma unroll
            for (int n = 0; n < 2; ++n) rs[bj][n] = *(const LAS f32x4*)(rt + bj * HALF + wc * 32 + 8 * fq + 4 * n);
        const LAS float* bz = rt + 256 + wr * 64 + fr;
        bf16_t* p0 = Z0 + ((size_t)(((b * 4 + g) * 256 + wr * 64 + fr) * 64 + 4 * t + (wc >> 1))) * 128 + ri * 64 + 32 * (wc & 1) + 8 * fq;
#pragma unroll
        for (int ai = 0; ai < 2; ++ai)
#pragma unroll
            for (int m = 0; m < 4; ++m) {
                const float bb = bz[ai * HALF + m * 16];
#pragma unroll
                for (int bj = 0; bj < 2; ++bj)
                    st16(p0 + (size_t)(ai * HALF + m * 16) * 8192 + bj * 256, pack8(acc[ai][bj][m][0] * rs[bj][0] + bb, acc[ai][bj][m][1] * rs[bj][1] + bb));
                asm volatile("" ::: "memory");
            }
    }
};
}


#define XB_TMO      128
#define XB_XCNT(j)  (256  + 64 * (j))
#define XB_XSUB(j)  (1280 + 64 * (j))
#define XB_XGEN(j)  (2304 + 64 * (j))
#define XB_TOP      3328
#define XB_TOPGEN   3392
#define XCD_BAR_WORDS 3456
#define XB_SPIN_CAP (1u << 18)
__device__ __forceinline__ unsigned xb_ld(unsigned* p)              { return __hip_atomic_load(p, __ATOMIC_RELAXED, __HIP_MEMORY_SCOPE_AGENT); }
__device__ __forceinline__ unsigned xb_add(unsigned* p, unsigned v) { return __hip_atomic_fetch_add(p, v, __ATOMIC_RELAXED, __HIP_MEMORY_SCOPE_AGENT); }
__device__ __forceinline__ unsigned xb_xcc_id() { return (unsigned)__builtin_amdgcn_s_getreg((3 << 11) | 20) & 0xFu; }
#define XB_SPIN(cond, bar) do { unsigned _sp = 0; while (cond) { __builtin_amdgcn_s_sleep(1); \
    if ((++_sp & 255u) == 0u) { if (xb_ld(&(bar)[XB_TMO])) break; if (_sp > XB_SPIN_CAP) { atomicAdd(&(bar)[XB_TMO], 1u); break; } } } } while (0)
struct XcdBarrier { unsigned* bar; unsigned x; volatile LAS unsigned* st; };
__device__ __forceinline__ XcdBarrier xcd_barrier_post(unsigned* bar, volatile LAS unsigned* st) {
    XcdBarrier b; b.bar = bar; b.x = xb_xcc_id(); b.st = st;
    if (threadIdx.x == 0) (void)xb_add(&bar[XB_XCNT(b.x)], 1u);
    return b;
}
__device__ __forceinline__ void xcd_barrier_complete(unsigned* bar, unsigned x, unsigned& nloc, unsigned& nx) {
    const unsigned G = gridDim.x * gridDim.y * gridDim.z;
    unsigned sum, cnt, mine, sp = 0u;
    for (;;) {
        sum = 0u; cnt = 0u; mine = 0u;
#pragma unroll
        for (unsigned j = 0; j < 16; ++j) { const unsigned c = xb_ld(&bar[XB_XCNT(j)]); sum += c; cnt += (c > 0u) ? 1u : 0u; mine = (j == x) ? c : mine; }
        if (sum == G) break;
        __builtin_amdgcn_s_sleep(1);
        if ((++sp & 255u) == 0u) { if (xb_ld(&bar[XB_TMO])) break; if (sp > XB_SPIN_CAP) { atomicAdd(&bar[XB_TMO], 1u); break; } }
    }
    nloc = mine > 0u ? mine : 1u; nx = cnt > 0u ? cnt : 1u;
}
__device__ __forceinline__ void xcd_barrier(const XcdBarrier& b) {
    asm volatile("s_waitcnt vmcnt(0)" ::: "memory");
    __syncthreads();
    if (threadIdx.x == 0) {
        unsigned* bar = b.bar;
        __builtin_amdgcn_s_waitcnt(0);
        unsigned nloc = b.st[0], nx = b.st[1];
        if (nloc == 0u) { xcd_barrier_complete(bar, b.x, nloc, nx); b.st[0] = nloc; b.st[1] = nx; }
        const unsigned old = xb_add(&bar[XB_XSUB(b.x)], 1u);
        const unsigned gen = old / nloc;
        if (old + 1u == (gen + 1u) * nloc) {
            __builtin_amdgcn_fence(__ATOMIC_RELEASE, "agent");
            asm volatile("s_waitcnt vmcnt(0)" ::: "memory");
            const unsigned og = xb_add(&bar[XB_TOP], 1u);
            const unsigned tg = og / nx;
            if (og + 1u == (tg + 1u) * nx) xb_add(&bar[XB_TOPGEN], 1u);
            else XB_SPIN(xb_ld(&bar[XB_TOPGEN]) == tg, bar);
            __builtin_amdgcn_fence(__ATOMIC_ACQUIRE, "agent");
            xb_add(&bar[XB_XGEN(b.x)], 1u);
            asm volatile("s_waitcnt vmcnt(0)" ::: "memory");
        } else {
            XB_SPIN(xb_ld(&bar[XB_XGEN(b.x)]) == gen, bar);
            __builtin_amdgcn_fence(__ATOMIC_ACQUIRE, "agent");
            asm volatile("s_waitcnt vmcnt(0)" ::: "memory");
        }
    }
    __syncthreads();
}
__device__ __forceinline__ void p0_mods_unit(const float* c, const float* cctx, const float* ada_w, const float* ada_b, float* mods, LAS unsigned char* lds, int unit) {
    LAS float* s = (LAS float*)lds;
    LAS float* red = s + 5 * 1024;
    int tid = threadIdx.x; asm volatile("" : "+v"(tid));
    for (int i = tid; i < 5 * 1024; i += 512) { const int v = i >> 10, k = i & 1023; const float x = v < 4 ? c[v * 1024 + k] : cctx[k]; s[i] = x / (1.0f + __expf(-x)); }
    __syncthreads();
    const int l = unit / 96, col0 = (unit % 96) * 64, kc = tid >> 6, cl = tid & 63;
    const float* w = ada_w + (size_t)l * 1024 * 6144 + col0 + cl;
    float a0 = 0.f, a1 = 0.f, a2 = 0.f, a3 = 0.f, a4 = 0.f;
    for (int k = kc * 128; k < kc * 128 + 128; k += 32) {
        float wv[32];
#pragma unroll
        for (int j = 0; j < 32; ++j) wv[j] = w[(size_t)(k + j) * 6144];
#pragma unroll
        for (int j = 0; j < 32; ++j) { a0 += s[k + j] * wv[j]; a1 += s[1024 + k + j] * wv[j]; a2 += s[2048 + k + j] * wv[j]; a3 += s[3072 + k + j] * wv[j]; a4 += s[4096 + k + j] * wv[j]; }
    }
    red[(kc * 5 + 0) * 64 + cl] = a0; red[(kc * 5 + 1) * 64 + cl] = a1; red[(kc * 5 + 2) * 64 + cl] = a2; red[(kc * 5 + 3) * 64 + cl] = a3; red[(kc * 5 + 4) * 64 + cl] = a4;
    __syncthreads();
    if (tid < 320) { const int v = tid >> 6, cc = tid & 63; float t = 0.f;
#pragma unroll
        for (int kk = 0; kk < 8; ++kk) t += red[(kk * 5 + v) * 64 + cc];
        mods[(size_t)(l * 5 + v) * 6144 + col0 + cc] = t + ada_b[l * 6144 + col0 + cc]; }
    __syncthreads();
}

__device__ __forceinline__ void p0_transpose_item(const float* W, int K, int N, bf16_t* WT, bf16_t* WT2, int mode, LAS float* scr, int item, int lane) {
    const int nblk = N / 32, kb = item / nblk, nb = item % nblk, k0 = 64 * kb, n0 = 32 * nb;
    float wv_[32];
#pragma unroll
    for (int i = 0; i < 32; ++i) wv_[i] = W[(size_t)(k0 + 2 * i + (lane >> 5)) * N + n0 + (lane & 31)];
#pragma unroll
    for (int i = 0; i < 32; ++i) scr[(2 * i + (lane >> 5)) * 33 + (lane & 31)] = wv_[i];
    asm volatile("s_waitcnt lgkmcnt(0)" ::: "memory");
    const int cch = lane & 7;
#pragma unroll
    for (int j = 0; j < 4; ++j) { const int n = (lane >> 3) + 8 * j; const LAS float* s = scr + (8 * cch) * 33 + n;
        u32x4 o; o.x = cvt_pk_bf16(s[0 * 33], s[1 * 33]); o.y = cvt_pk_bf16(s[2 * 33], s[3 * 33]); o.z = cvt_pk_bf16(s[4 * 33], s[5 * 33]); o.w = cvt_pk_bf16(s[6 * 33], s[7 * 33]);
        const int ng = n0 + n; bf16_t* dst;
        if (mode == 0) dst = WT + (size_t)ng * K;
        else if (ng < 2048) { const int pn = ng >> 8, hh = (ng >> 6) & 3, d = ng & 63; const int tpos = (d >> 5) * 128 + hh * 32 + (d & 31); dst = WT + (size_t)(pn * 256 + tpos) * K; }
        else dst = WT2 + (size_t)(ng - 2048) * K;
        *(u32x4*)(dst + k0 + 8 * cch) = o; }
    asm volatile("s_waitcnt lgkmcnt(0)" ::: "memory");
}

__device__ __forceinline__ float wave_sum(float v) {
#pragma unroll
    for (int o = 1; o < 64; o <<= 1) v += __shfl_xor(v, o);
    return v;
}
__device__ __forceinline__ void norm_rows(const float* xlat, const float* xctx, int nrows, const float* g, const float* modsl, int sh_off, int sc_off, bf16_t* H, int gw, int NGW, int lane) {
    f32x4 gv[4];
#pragma unroll
    for (int j = 0; j < 4; ++j) gv[j] = *(const f32x4*)(g + lane * 4 + 256 * j);
    for (int row = gw; row < nrows; row += NGW) {
        const float* src = row < ML ? xlat + (size_t)row * 1024 : xctx + (size_t)(row - ML) * 1024;
        const int v = row < ML ? (row >> 12) : 4;
        const float* mp = modsl + (size_t)v * 6144;
        f32x4 x[4]; float ss = 0.f;
#pragma unroll
        for (int j = 0; j < 4; ++j) { x[j] = *(const f32x4*)(src + lane * 4 + 256 * j); ss += (x[j][0] * x[j][0] + x[j][1] * x[j][1]) + (x[j][2] * x[j][2] + x[j][3] * x[j][3]); }
        const float rstd = rsqrtf(wave_sum(ss) * (1.0f / 1024.0f) + EPS);
#pragma unroll
        for (int j = 0; j < 4; ++j) {
            const f32x4 sh = *(const f32x4*)(mp + sh_off + lane * 4 + 256 * j), sc = *(const f32x4*)(mp + sc_off + lane * 4 + 256 * j);
            const f32x4 y = (x[j] * rstd * gv[j]) * (sc + 1.0f) + sh;
            u32x2 w; w.x = cvt_pk_bf16(y[0], y[1]); w.y = cvt_pk_bf16(y[2], y[3]);
            *(u32x2*)(H + (size_t)row * 1024 + lane * 4 + 256 * j) = w;
        }
    }
}


__device__ __forceinline__ void bias_items(const bf16_t* W1t, const bf16_t* CS, const float* mods, float* BV0, float* BV1, float* BVF, int w, int NW, int lane) {
    for (int it = w; it < 8192 + 2048; it += NW) {
        float a0 = 0.f, a1 = 0.f, a2 = 0.f, a3 = 0.f; float* dst; int dstride;
        if (it < 8192) {
            const int l = it >> 12, n = it & 4095;
            const bf16_t* wr_ = W1t + (size_t)l * 4096 * 1024 + (size_t)n * 1024 + lane * 16;
            const u32x4 w0 = *(const u32x4*)wr_, w1 = *(const u32x4*)(wr_ + 8);
            const float* sh = mods + (size_t)l * 5 * 6144 + 3072 + lane * 16;
            float wf[16];
#pragma unroll
            for (int e = 0; e < 4; ++e) { wf[2 * e] = __uint_as_float(w0[e] << 16); wf[2 * e + 1] = __uint_as_float(w0[e] & 0xffff0000u); wf[8 + 2 * e] = __uint_as_float(w1[e] << 16); wf[8 + 2 * e + 1] = __uint_as_float(w1[e] & 0xffff0000u); }
#pragma unroll
            for (int q = 0; q < 4; ++q) {
                const f32x4 s0 = *(const f32x4*)(sh + 4 * q), s1 = *(const f32x4*)(sh + 6144 + 4 * q), s2 = *(const f32x4*)(sh + 2 * 6144 + 4 * q), s3 = *(const f32x4*)(sh + 3 * 6144 + 4 * q);
#pragma unroll
                for (int e = 0; e < 4; ++e) { a0 += s0[e] * wf[4 * q + e]; a1 += s1[e] * wf[4 * q + e]; a2 += s2[e] * wf[4 * q + e]; a3 += s3[e] * wf[4 * q + e]; }
            }
            dst = (l == 0 ? BV0 : BV1) + n; dstride = 4096;
        } else {
            const int idx = it - 8192, g = idx >> 9, m = idx & 511;
            const u32x2 w0 = *(const u32x2*)(CS + (size_t)m * 256 + lane * 4);
            const float wf0 = __uint_as_float(w0[0] << 16), wf1 = __uint_as_float(w0[0] & 0xffff0000u), wf2 = __uint_as_float(w0[1] << 16), wf3 = __uint_as_float(w0[1] & 0xffff0000u);
            const float* sh = mods + (size_t)5 * 6144 + g * 256 + lane * 4;
            const f32x4 s0 = *(const f32x4*)(sh), s1 = *(const f32x4*)(sh + 6144), s2 = *(const f32x4*)(sh + 2 * 6144), s3 = *(const f32x4*)(sh + 3 * 6144);
            a0 = s0[0] * wf0 + s0[1] * wf1 + s0[2] * wf2 + s0[3] * wf3; a1 = s1[0] * wf0 + s1[1] * wf1 + s1[2] * wf2 + s1[3] * wf3;
            a2 = s2[0] * wf0 + s2[1] * wf1 + s2[2] * wf2 + s2[3] * wf3; a3 = s3[0] * wf0 + s3[1] * wf1 + s3[2] * wf2 + s3[3] * wf3;
            dst = BVF + g * 512 + m; dstride = 2048;
        }
        a0 = wave_sum(a0); a1 = wave_sum(a1); a2 = wave_sum(a2); a3 = wave_sum(a3);
        if (lane == 0) { dst[0] = a0; dst[dstride] = a1; dst[2 * dstride] = a2; dst[3 * dstride] = a3; }
    }
}
template <bool MASKED>
__device__ __forceinline__ void attn_block(const LAS bf16_t* Ks, const LAS bf16_t* Vs, int kcol0, int fr, int g, const bf16x8 (&Qf)[2], f32x4 (&acc)[4], float& lsum,
                                           const LAS unsigned char* rpb_base  , const int (&dcb)[8], const f32x4& ciX, const f32x4& ciY) {
    bf16x8 KX[2], KY[2];
#pragma unroll
    for (int kk = 0; kk < 2; ++kk) { KX[kk] = *(const LAS bf16x8*)(Ks + (kcol0 + fr) * 72 + kk * 32 + g * 8); KY[kk] = *(const LAS bf16x8*)(Ks + (kcol0 + 16 + fr) * 72 + kk * 32 + g * 8); }
    s16x4 VX[4], VY[4];
#pragma unroll
    for (int db = 0; db < 4; ++db) { VX[db] = *(const LAS s16x4*)(Vs + (16 * db + fr) * 72 + kcol0 + 4 * g); VY[db] = *(const LAS s16x4*)(Vs + (16 * db + fr) * 72 + kcol0 + 16 + 4 * g); }
    f32x4 sX = mfma16(KX[0], Qf[0], ciX); sX = mfma16(KX[1], Qf[1], sX);
    f32x4 sY = mfma16(KY[0], Qf[0], ciY); sY = mfma16(KY[1], Qf[1], sY);
    f32x4 pX, pY;
    if (MASKED) {
#pragma unroll
        for (int ii = 0; ii < 4; ++ii) {
            const float bx = *(const LAS float*)(rpb_base + dcb[ii]), by = *(const LAS float*)(rpb_base + dcb[4 + ii]);
            pX[ii] = __builtin_amdgcn_exp2f(sX[ii] + bx);
            pY[ii] = __builtin_amdgcn_exp2f(sY[ii] + by);
        }
    } else {
#pragma unroll
        for (int ii = 0; ii < 4; ++ii) { pX[ii] = __builtin_amdgcn_exp2f(sX[ii]); pY[ii] = __builtin_amdgcn_exp2f(sY[ii]); }
    }
    lsum += ((pX[0] + pX[1]) + (pX[2] + pX[3])) + ((pY[0] + pY[1]) + (pY[2] + pY[3]));
    const u32x4 pw = pg8::pack8(pX, pY);
    const bf16x8 Pf = __builtin_bit_cast(bf16x8, pw);
#pragma unroll
    for (int db = 0; db < 4; ++db) {
        bf16x8 Vf; Vf[0] = VX[db][0]; Vf[1] = VX[db][1]; Vf[2] = VX[db][2]; Vf[3] = VX[db][3]; Vf[4] = VY[db][0]; Vf[5] = VY[db][1]; Vf[6] = VY[db][2]; Vf[7] = VY[db][3];
        acc[db] = mfma16(Vf, Pf, acc[db]);
    }
}
__device__ __forceinline__ void attn_phase(const bf16_t* QK, const bf16_t* VT, bf16_t* O, const float* rpb, const float* sbound, LAS unsigned char* lds, int G, int c) {
    constexpr int RP_BYTES = 30720, TILE_B = 64 * 72 * 2, PAIR_B = 4 * TILE_B, NPAIR = 7;
    LAS float* rp = (LAS float*)lds;
    int tid = threadIdx.x; asm volatile("" : "+v"(tid));
    const int lane = tid & 63, wid = __builtin_amdgcn_readfirstlane(tid >> 6), fr = lane & 15, g = lane >> 4;
    for (int i = tid; i < 16 * 465; i += 512) rp[i] = rpb[i] * LOG2E;
    const float Mb = *sbound;
    const int nunits = (2048 - c + G - 1) / G;
    const int ND = nunits * NPAIR;
    const int trow = tid >> 3, tch = tid & 7;
    const int ldsoff = (trow * 72 + tch * 8) * 2;
#define ATT_DEC(L_, b_, h_, rp_) do { const int x_ = (L_) & 7, q_ = (L_) >> 3; rp_ = q_ & 31; const int bh_ = 8 * (q_ >> 5) + x_; b_ = bh_ >> 4; h_ = bh_ & 15; } while (0)
#define ATT_TOK(b_, rs0_, t_) ((t_) < 9 ? (b_) * 4096 + min((rs0_) + (t_), 63) * 64 : ML + (b_) * 256 + 64 * (min((t_), 12) - 9))
#define ATT_GLOAD(D_, R) do { const int u_ = (D_) / NPAIR, p_ = (D_) - u_ * NPAIR; int b_, h_, rp_; ATT_DEC(u_ * G + c, b_, h_, rp_); \
        const int rs0_ = min(max(2 * rp_ - 4, 0), 56); const int tk0_ = ATT_TOK(b_, rs0_, 2 * p_), tk1_ = ATT_TOK(b_, rs0_, 2 * p_ + 1); \
        const bf16_t* kb_ = QK + (size_t)trow * 2048 + 1024 + h_ * 64 + tch * 8; const bf16_t* vb_ = VT + (size_t)(h_ * 64 + trow) * MT + tch * 8; \
        R[0] = *(const u32x4*)(kb_ + (size_t)tk0_ * 2048); R[1] = *(const u32x4*)(vb_ + tk0_); R[2] = *(const u32x4*)(kb_ + (size_t)tk1_ * 2048); R[3] = *(const u32x4*)(vb_ + tk1_); } while (0)
#define ATT_LWRITE(slot_, R) do { _Pragma("unroll") for (int q_ = 0; q_ < 4; ++q_) *(LAS u32x4*)(lds + RP_BYTES + (slot_) * PAIR_B + q_ * TILE_B + ldsoff) = R[q_]; } while (0)
    u32x4 R0[4], R1[4];
    ATT_GLOAD(0, R0); ATT_LWRITE(0, R0);
    if (ND > 1) ATT_GLOAD(1, R1);
    if (ND > 2) ATT_GLOAD(2, R0);
    __syncthreads();
    int b = 0, h = 0, rpair = 0, r = 0, rs0 = 0, rsr = 0, qrow = 0;
    const int j = wid & 3, w0 = (j == 0) ? 0 : (j == 1) ? 8 : (j == 2) ? 24 : 32;
    int dcb[8]; f32x4 ciX, ciY, ciU;
    {
        const int cq = 16 * j + fr, cs = min(max(cq - 8, 0), 48), eX = w0 + 4 * g - cs, dX = w0 + 4 * g - cq + 15;
#pragma unroll
        for (int ii = 0; ii < 4; ++ii) {
            dcb[ii] = 4 * min(max(dX + ii, 0), 30); dcb[4 + ii] = 4 * min(max(dX + 16 + ii, 0), 30);
            ciX[ii] = ((unsigned)(eX + ii) < 16u) ? -Mb : -1.0e30f; ciY[ii] = ((unsigned)(eX + 16 + ii) < 16u) ? -Mb : -1.0e30f; ciU[ii] = -Mb;
        }
    }
    bf16x8 Qf[2], Qn[2]; f32x4 acc[4]; float lsum = 0.f;
    int p = 0, u = 0, D = 0;
#define ATT_QLOAD(dst, uu) do { int b_, h_, rp_; ATT_DEC((uu) * G + c, b_, h_, rp_); const int qr_ = b_ * 4096 + (2 * rp_ + (wid >> 2)) * 64 + 16 * j + fr; \
        _Pragma("unroll") for (int kk = 0; kk < 2; ++kk) dst[kk] = *(const bf16x8*)(QK + (size_t)qr_ * 2048 + h_ * 64 + 32 * kk + 8 * g); } while (0)
#define ATT_TILE(t_, toff_) do { \
        const LAS bf16_t* Ks = (const LAS bf16_t*)(lds + RP_BYTES + slot * PAIR_B + (toff_)); \
        const LAS bf16_t* Vs = (const LAS bf16_t*)(lds + RP_BYTES + slot * PAIR_B + (toff_) + TILE_B); \
        if ((t_) < 9) { \
            const int kr = rs0 + (t_), i = kr - rsr; \
            if (i >= 0 && i < 8) attn_block<true>(Ks, Vs, w0, fr, g, Qf, acc, lsum, (const LAS unsigned char*)rp + (h * 465 + (kr - r + 7) * 31) * 4, dcb, ciX, ciY); \
        } else if ((t_) < 13) { \
            attn_block<false>(Ks, Vs, 0, fr, g, Qf, acc, lsum, (const LAS unsigned char*)rp, dcb, ciU, ciU); \
            attn_block<false>(Ks, Vs, 32, fr, g, Qf, acc, lsum, (const LAS unsigned char*)rp, dcb, ciU, ciU); \
        } } while (0)
    ATT_QLOAD(Qn, 0);
#define ATT_ITER(R) do { \
        const int slot = D & 1; \
        if (D + 1 < ND) ATT_LWRITE(slot ^ 1, R); \
        if (D + 3 < ND) ATT_GLOAD(D + 3, R); \
        if (p == 0) { \
            ATT_DEC(u * G + c, b, h, rpair); \
            r = 2 * rpair + (wid >> 2); rs0 = min(max(2 * rpair - 4, 0), 56); rsr = min(max(r - 4, 0), 56); \
            qrow = b * 4096 + r * 64 + 16 * j + fr; \
            Qf[0] = Qn[0]; Qf[1] = Qn[1]; \
            _Pragma("unroll") for (int db = 0; db < 4; ++db) acc[db] = (f32x4){0.f, 0.f, 0.f, 0.f}; \
            lsum = 0.f; \
        } \
        if (p == 4 && u + 1 < nunits) ATT_QLOAD(Qn, u + 1); \
        ATT_TILE(2 * p, 0); \
        ATT_TILE(2 * p + 1, 2 * TILE_B); \
        if (p == NPAIR - 1) { \
            float ls = lsum; ls += __shfl_xor(ls, 16); ls += __shfl_xor(ls, 32); \
            const float inv = 1.0f / ls; \
            bf16_t* op = O + (size_t)qrow * 1024 + h * 64 + 4 * g; \
            _Pragma("unroll") for (int db = 0; db < 4; ++db) { u32x2 w; w.x = cvt_pk_bf16(acc[db][0] * inv, acc[db][1] * inv); w.y = cvt_pk_bf16(acc[db][2] * inv, acc[db][3] * inv); st8(op + 16 * db, w); } \
            p = 0; ++u; \
        } else ++p; \
        __syncthreads(); \
    } while (0)
    for (;;) {
        ATT_ITER(R1); if (++D >= ND) break;
        ATT_ITER(R0); if (++D >= ND) break;
    }
#undef ATT_ITER
#undef ATT_TILE
#undef ATT_QLOAD
#undef ATT_DEC
#undef ATT_TOK
#undef ATT_GLOAD
#undef ATT_LWRITE
}

__device__ __forceinline__ void s1_phase(const bf16_t* Z0, const bf16_t* Dg, bf16_t* Z1, LAS unsigned char* lds, int gw, int NGW) {
    constexpr int DP = 136;
    LAS bf16_t* Dl = (LAS bf16_t*)lds;
    int tid = threadIdx.x; asm volatile("" : "+v"(tid));
    const int lane = tid & 63, fr = lane & 15, g = lane >> 4;
    for (int i = tid; i < 128 * 16; i += 512) { const int row = i >> 4, ch = i & 15; *(LAS u32x4*)(Dl + row * DP + ch * 8) = *(const u32x4*)(Dg + row * 128 + ch * 8); }
    __syncthreads();
    for (int colM = gw; colM < 4096; colM += NGW) {
        bf16x8 A[4][4];
#pragma unroll
        for (int ib = 0; ib < 4; ++ib)
#pragma unroll
            for (int kb = 0; kb < 4; ++kb) A[ib][kb] = *(const bf16x8*)(Z0 + ((size_t)colM * 64 + 16 * ib + fr) * 128 + 32 * kb + 8 * g);
#pragma unroll 2
        for (int jb = 0; jb < 8; ++jb) {
            bf16x8 Bf[4];
#pragma unroll
            for (int kb = 0; kb < 4; ++kb) Bf[kb] = *(const LAS bf16x8*)(Dl + (16 * jb + fr) * DP + 32 * kb + 8 * g);
            const int n = 16 * jb + fr, ka = n >> 1, rip = n & 1;
#pragma unroll
            for (int ib = 0; ib < 4; ++ib) {
                f32x4 a = (f32x4){0.f, 0.f, 0.f, 0.f};
#pragma unroll
                for (int kb = 0; kb < 4; ++kb) a = mfma16(A[ib][kb], Bf[kb], a);
                u32x2 w; w.x = cvt_pk_bf16(a[0], a[1]); w.y = cvt_pk_bf16(a[2], a[3]);
                st8(Z1 + (((size_t)ka * 4096 + colM) * 2 + rip) * 64 + 16 * ib + 4 * g, w);
            }
        }
    }
    __syncthreads();
}
__device__ __forceinline__ void s2_phase(const bf16_t* Z1, const bf16_t* Eg, bf16_t* F, int gw, int NGW, int lane) {
    const int fr = lane & 15, g = lane >> 4;
    for (int it = gw; it < 2048; it += NGW) {
        const int ka = it & 63, chunk = it >> 6;
        bf16x8 Bf[4][4];
#pragma unroll
        for (int jb = 0; jb < 4; ++jb)
#pragma unroll
            for (int kb = 0; kb < 4; ++kb) Bf[jb][kb] = *(const bf16x8*)(Eg + ((size_t)ka * 64 + 16 * jb + fr) * 128 + 32 * kb + 8 * g);
        for (int ib = 0; ib < 8; ++ib) {
            const int colM0 = chunk * 128 + ib * 16;
            bf16x8 A[4];
#pragma unroll
            for (int kb = 0; kb < 4; ++kb) A[kb] = *(const bf16x8*)(Z1 + ((size_t)ka * 4096 + colM0 + fr) * 128 + 32 * kb + 8 * g);
            const int cm = colM0 + 4 * g, b = cm >> 10, ch = cm & 1023;
#pragma unroll
            for (int jb = 0; jb < 4; ++jb) {
                f32x4 a = (f32x4){0.f, 0.f, 0.f, 0.f};
#pragma unroll
                for (int kb = 0; kb < 4; ++kb) a = mfma16(A[kb], Bf[jb][kb], a);
                const int kbk = 16 * jb + fr;
                u32x2 w; w.x = cvt_pk_bf16(a[0], a[1]); w.y = cvt_pk_bf16(a[2], a[3]);
                st8(F + ((size_t)b * 4096 + ka + 64 * kbk) * 1024 + ch, w);
            }
        }
    }
}


#ifndef MK_DEBUG
#define MK_DEBUG 0
#endif
__device__ __forceinline__ void dbg_scan16(const bf16_t* p, size_t n, unsigned* flags, unsigned bit, int gt, int NT) {
    bool bad = false; for (size_t i = gt; i < n; i += NT) bad |= ((p[i] & 0x7f80u) == 0x7f80u);
    if (bad) atomicOr(flags, 1u << bit);
}
__device__ __forceinline__ void dbg_scan32(const float* p, size_t n, unsigned* flags, unsigned bit, int gt, int NT) {
    bool bad = false; for (size_t i = gt; i < n; i += NT) bad |= ((__float_as_uint(p[i]) & 0x7f800000u) == 0x7f800000u);
    if (bad) atomicOr(flags, 1u << bit);
}
struct Args { const float* in[15]; float* out; unsigned char* ws; int ph_lo, ph_hi, use_cg, pad; };
static_assert(sizeof(Args) == 15 * 8 + 8 + 8 + 16, "no padding");

__global__ void __launch_bounds__(512, 2) fwd_kernel(Args args) {
    extern __shared__ __attribute__((aligned(16))) unsigned char lds_raw[];
    LAS unsigned char* lds = (LAS unsigned char*)lds_raw;
    const int G = gridDim.x, c = blockIdx.x;
    const int vcu = (G % 8 == 0) ? (c % 8) * (G / 8) + c / 8 : c;
    const int NGW = G * 8;
#define PHASE_IDS int tid_ = threadIdx.x; asm volatile("" : "+v"(tid_)); const int lane = tid_ & 63, wid = __builtin_amdgcn_readfirstlane(tid_ >> 6); const int gw = vcu * 8 + wid; (void)lane; (void)gw
    unsigned char* ws = args.ws;
    const float* x = args.in[0]; const float* cvec = args.in[1]; const float* ctx = args.in[2]; const float* cctx = args.in[3];
    const float* ada_w = args.in[4]; const float* ada_b = args.in[5]; const float* norm_g = args.in[6];
    const float* wqkv = args.in[7]; const float* wo = args.in[8]; const float* gq = args.in[9]; const float* gk = args.in[10]; const float* rpb = args.in[11];
    const float* fw = args.in[12]; const float* w1 = args.in[13]; const float* w2 = args.in[14];
    float* out = args.out;
    float* mods = (float*)(ws + WS_MODS); float* sbound = (float*)(ws + WS_SB);
    bf16_t* CS = (bf16_t*)(ws + WS_CS); bf16_t* Dt = (bf16_t*)(ws + WS_D); bf16_t* Et = (bf16_t*)(ws + WS_E);
    bf16_t* WQK = (bf16_t*)(ws + WS_WQK); bf16_t* WV = (bf16_t*)(ws + WS_WV); bf16_t* WO = (bf16_t*)(ws + WS_WO); bf16_t* FWt = (bf16_t*)(ws + WS_FW);
    bf16_t* W1t = (bf16_t*)(ws + WS_W1); bf16_t* W2t = (bf16_t*)(ws + WS_W2);
    bf16_t* H = (bf16_t*)(ws + WS_H); bf16_t* QK = (bf16_t*)(ws + WS_QK); bf16_t* VT = (bf16_t*)(ws + WS_VT); bf16_t* O = (bf16_t*)(ws + WS_O);
    bf16_t* XS = (bf16_t*)(ws + WS_XS); bf16_t* HMID = (bf16_t*)(ws + WS_HMID); bf16_t* Z0 = (bf16_t*)(ws + WS_Z0); bf16_t* Z1 = (bf16_t*)(ws + WS_Z1); bf16_t* Fb = (bf16_t*)(ws + WS_F);
    float* SSQ = (float*)(ws + WS_SSQ); float* BV0 = (float*)(ws + WS_BV); float* BV1 = BV0 + 4 * 4096; float* BVF = BV1 + 4 * 4096; float* GM = BVF + 16 * 512;
    const int lo = args.ph_lo, hi = args.ph_hi;
    cg::grid_group grid = cg::this_grid();
#define IN(k) (lo <= (k) && (k) < hi)
#ifndef REP_SYNC
#define REP_SYNC 1
#endif
#ifndef REP_NORM
#define REP_NORM 1
#endif
#ifndef REP_S12
#define REP_S12 1
#endif
#ifndef REP_P0
#define REP_P0 1
#endif
#ifndef USE_XB
#define USE_XB 1
#endif
#define SEAM(k) do { if (IN(k) && IN((k) + 1)) { for (int r_ = 0; r_ < REP_SYNC; ++r_) { if (use_cg) grid.sync(); else xcd_barrier(xbar); } } } while (0)
    { volatile LAS unsigned* st_ = (volatile LAS unsigned*)(lds + LDS_BYTES - 64); if (threadIdx.x < 2) st_[threadIdx.x] = 0u; __syncthreads(); }
    XcdBarrier xbar; xbar.bar = (unsigned*)(ws + WS_BAR); xbar.x = 0; xbar.st = (volatile LAS unsigned*)(lds + LDS_BYTES - 64);
    const bool use_cg = (args.use_cg != 0);
    if (!use_cg && hi - lo > 1) xbar = xcd_barrier_post((unsigned*)(ws + WS_BAR), (volatile LAS unsigned*)(lds + LDS_BYTES - 64));

    unsigned* dflags = (unsigned*)(ws + WS_SB + 256);
#define DBG16(k, bit, p, n) do { if (MK_DEBUG && IN(k)) { int t_ = threadIdx.x; asm volatile("" : "+v"(t_)); dbg_scan16(p, n, dflags, bit, (vcu * 512) + t_, G * 512); } } while (0)
#define DBG32(k, bit, p, n) do { if (MK_DEBUG && IN(k)) { int t_ = threadIdx.x; asm volatile("" : "+v"(t_)); dbg_scan32(p, n, dflags, bit, (vcu * 512) + t_, G * 512); } } while (0)
    if (IN(0)) {
        PHASE_IDS;
        if (MK_DEBUG && c == 0 && tid_ == 0) *dflags = 0u;
        for (int r0_ = 0; r0_ < REP_P0; ++r0_) {
        for (int u = c; u < 192; u += G) p0_mods_unit(cvec, cctx, ada_w, ada_b, mods, lds, u);
        __syncthreads();
        {
            LAS float* scr = (LAS float*)(lds + wid * 16384);
            constexpr int I_QKV = 16 * 96, I_SQ = 16 * 32, I_1 = 16 * 128, I_2 = 64 * 32;
            constexpr int NITEMS = I_QKV + I_SQ + 2 * I_1 + I_2;
            for (int it = NITEMS - 1 - gw; it >= 0; it -= NGW) {
                int r = it;
                if (r < I_QKV) { p0_transpose_item(wqkv, 1024, 3072, WQK, WV, 1, scr, r, lane); continue; } r -= I_QKV;
                if (r < I_SQ) { p0_transpose_item(wo, 1024, 1024, WO, nullptr, 0, scr, r, lane); continue; } r -= I_SQ;
                if (r < 2 * I_1) { const int l = r / I_1; p0_transpose_item(w1 + (size_t)l * 1024 * 4096, 1024, 4096, W1t + (size_t)l * 4096 * 1024, nullptr, 0, scr, r % I_1, lane); continue; } r -= 2 * I_1;
                p0_transpose_item(w2, 4096, 1024, W2t, nullptr, 0, scr, r, lane);
            }
        }
        {
            const int gt = gw * 64 + lane, NT = NGW * 64;
            for (int i = gt; i < 512 * 256; i += NT) { const int m = i >> 8, cc = i & 255, ri = m >> 8, k2 = m & 255; float sn, cs; sincospif(2.0f * (float)((cc * k2) & 255) / 256.0f, &sn, &cs);
                const float v = (ri == 0 ? cs : -sn) * (1.0f / 16.0f); CS[i] = (bf16_t)(cvt_pk_bf16(v, 0.f) & 0xffffu); }
            for (int i = gt; i < 128 * 128; i += NT) { const int n = i >> 7, kp = i & 127, ka = n >> 1, rip = n & 1, ri = kp >> 6, a = kp & 63; float sn, cs; sincospif(2.0f * (float)((a * ka) & 63) / 64.0f, &sn, &cs);
                const float v = (rip == 0 ? (ri == 0 ? cs : sn) : (ri == 0 ? -sn : cs)) * 0.125f; Dt[i] = (bf16_t)(cvt_pk_bf16(v, 0.f) & 0xffffu); }
            for (int i = gt; i < 64 * 64 * 128; i += NT) { const int kp = i & 127, kbk = (i >> 7) & 63, ka = i >> 13, rip = kp >> 6, bp = kp & 63; float sn, cs; sincospif(2.0f * (float)((bp * (ka + 64 * kbk)) & 4095) / 4096.0f, &sn, &cs);
                const float v = (rip == 0 ? cs : sn) * 0.125f; Et[i] = (bf16_t)(cvt_pk_bf16(v, 0.f) & 0xffffu); }
        }
        if (c == G - 1 && wid == 7) {
            float mq = fabsf(gq[lane]), mk = fabsf(gk[lane]), mr = 0.f;
            for (int i = lane; i < 16 * 465; i += 64) mr = fmaxf(mr, fabsf(rpb[i]));
#pragma unroll
            for (int o = 1; o < 64; o <<= 1) { mq = fmaxf(mq, __shfl_xor(mq, o)); mk = fmaxf(mk, __shfl_xor(mk, o)); mr = fmaxf(mr, __shfl_xor(mr, o)); }
            if (lane == 0) *sbound = (8.0f * mq * mk + mr) * LOG2E;
        }
        __syncthreads();
        }
    }
    SEAM(0);
    const bool ctx_in_p1 = false;
    if (IN(1)) { PHASE_IDS;
        if (c == G - 1) {
            for (int i = tid_; i < 3 * 4096; i += 512) { const int idx = i >> 12, b = (i >> 10) & 3, col = i & 1023;
                const float gg = norm_g[(idx == 0 ? 1024 : idx == 1 ? 2048 : 3072) + col];
                const float sc = mods[(size_t)((idx == 0 ? 0 : 5) + b) * 6144 + (idx == 1 ? 1024 : 4096) + col];
                GM[i] = gg * (1.0f + sc); }
        }
        if (!ctx_in_p1) norm_rows(x, ctx, MT, norm_g, mods, 0, 1024, H, gw, NGW, lane);
        else if (c >= 32) norm_rows(x, ctx, ML, norm_g, mods, 0, 1024, H, (c - 32) * 8 + wid, (G - 32) * 8, lane);
        else {
            pg8::SchedOne S1u; const size_t ts = (size_t)256 * 1024 * 2; int tt;
            if (c < 16) { S1u.u.kind = 0; S1u.u.pm = 64 + (c & 3); S1u.u.pn = 4 + (c >> 2); tt = c & 3; S1u.u.a = (const char*)H + (size_t)S1u.u.pm * ts; S1u.u.b = (const char*)WQK + (size_t)S1u.u.pn * ts; }
            else { const int l2 = c - 16; S1u.u.kind = 1; S1u.u.pm = l2 & 3; S1u.u.pn = 64 + (l2 >> 2); tt = l2 >> 2; S1u.u.a = (const char*)WV + (size_t)S1u.u.pm * ts; S1u.u.b = (const char*)H + (size_t)S1u.u.pn * ts; }
            S1u.u.aux = 0;
            norm_rows(x, ctx, ML + tt * 256 + 256, norm_g, mods, 0, 1024, H, ML + tt * 256 + wid, 8, lane);
            asm volatile("s_waitcnt vmcnt(0)" ::: "memory"); __syncthreads();
            pg8::EpiQKV E{QK, VT, gq, gk};
            pg8::gemm_phase<pg8::EpiQKV, pg8::SchedOne, false>(lds, 1024, 1024, 1024, S1u, E);
        }
    }
    SEAM(1);
    DBG16(2, 0, H, (size_t)MT * 1024);
    if (IN(2)) { pg8::SchedQKV S{(const char*)H, (const char*)WQK, (const char*)WV, G, c, ctx_in_p1 ? 768 : 800}; pg8::EpiQKV E{QK, VT, gq, gk};
#ifndef REP_G2
#define REP_G2 1
#endif
        for (int r_ = 0; r_ < REP_G2; ++r_) pg8::gemm_phase<pg8::EpiQKV, pg8::SchedQKV, false>(lds, 1024, 1024, 1024, S, E);
        { PHASE_IDS;
          const bool part = (G > 32); const int w_ = part ? (c - 32) * 8 + wid : gw, nw_ = part ? (G - 32) * 8 : NGW;
          if (!part || c >= 32) {
              bias_items(W1t, CS, mods, BV0, BV1, BVF, w_, nw_, lane);
              LAS float* scr = (LAS float*)(lds + wid * 16384);
              constexpr int I_SQ = 16 * 32, I_2 = 64 * 32;
              for (int it = w_; it < I_SQ + I_2; it += nw_) {
                  if (it < I_SQ) p0_transpose_item(fw, 1024, 1024, FWt, nullptr, 0, scr, it, lane);
                  else p0_transpose_item(w2 + (size_t)4096 * 1024, 4096, 1024, W2t + (size_t)1024 * 4096, nullptr, 0, scr, it - I_SQ, lane);
              }
          } } }
    SEAM(2);
    DBG16(3, 1, QK, (size_t)ML * 2048); DBG16(3, 2, VT, (size_t)1024 * MT); DBG32(3, 13, mods, (size_t)10 * 6144);
#ifndef REP_ATT
#define REP_ATT 1
#endif
    if (IN(3)) { for (int rep = 0; rep < REP_ATT; ++rep) attn_phase(QK, VT, O, rpb, sbound, lds, G, c); }
    SEAM(3);
    DBG16(4, 3, O, (size_t)ML * 1024);
    if (IN(4)) { pg8::SchedStd S; S.init(O, WO, ML, 1024, 1024, 1024, G, c); pg8::EpiResF<false> E{x, XS, mods + 2048, GM, H, SSQ};
        pg8::gemm_phase<pg8::EpiResF<false>, pg8::SchedStd, false>(lds, 1024, 1024, 1024, S, E); }
    SEAM(4);
    DBG32(5, 4, out, (size_t)ML * 1024);
    if (IN(6)) { pg8::SchedStd S; S.init(H, W1t, ML, 4096, 1024, 1024, G, c); pg8::EpiRelu2F E{HMID, 4096, BV0, SSQ};
        pg8::gemm_phase<pg8::EpiRelu2F, pg8::SchedStd, false>(lds, 1024, 1024, 1024, S, E); }
    SEAM(6);
    DBG16(7, 5, HMID, (size_t)ML * 4096);
    if (IN(7)) { pg8::SchedStd S; S.init(HMID, W2t, ML, 1024, 64, 4096, G, c, (size_t)64 * 32768); pg8::EpiResF<true> E{XS, XS, mods + 5120, GM + 4096, H, SSQ};
        pg8::gemm_phase<pg8::EpiResF<true>, pg8::SchedStd, false>(lds, 4096, 64, 4096, S, E, 32768, 128); }
    SEAM(7);
    const float* mods1 = mods + 5 * 6144;
    DBG32(8, 6, out, (size_t)ML * 1024);
    if (IN(9)) { pg8::SchedF1 S{(const char*)CS, (const char*)H, G, c}; pg8::EpiZ0F E{Z0, BVF, SSQ};
        pg8::gemm_phase<pg8::EpiZ0F, pg8::SchedF1, true>(lds, 256, 256, 1024, S, E); }
    SEAM(9);
    DBG16(10, 7, Z0, (size_t)262144 * 128);
    if (IN(10)) { PHASE_IDS; for (int r_ = 0; r_ < REP_S12; ++r_) s1_phase(Z0, Dt, Z1, lds, gw, NGW); }
    SEAM(10);
    DBG16(11, 8, Z1, (size_t)262144 * 128);
    if (IN(11)) { PHASE_IDS; for (int r_ = 0; r_ < REP_S12; ++r_) s2_phase(Z1, Et, Fb, gw, NGW, lane); }
    SEAM(11);
    DBG16(12, 9, Fb, (size_t)ML * 1024);
    if (IN(12)) { pg8::SchedStd S; S.init(Fb, FWt, ML, 1024, 1024, 1024, G, c); pg8::EpiResF<true> E{XS, XS, mods1 + 2048, GM + 8192, H, SSQ};
        pg8::gemm_phase<pg8::EpiResF<true>, pg8::SchedStd, false>(lds, 1024, 1024, 1024, S, E); }
    SEAM(12);
    DBG32(13, 10, out, (size_t)ML * 1024);
    if (IN(14)) { pg8::SchedStd S; S.init(H, W1t + (size_t)4096 * 1024, ML, 4096, 1024, 1024, G, c); pg8::EpiRelu2F E{HMID, 4096, BV1, SSQ};
        pg8::gemm_phase<pg8::EpiRelu2F, pg8::SchedStd, false>(lds, 1024, 1024, 1024, S, E); }
    SEAM(14);
    DBG16(15, 11, HMID, (size_t)ML * 4096);
    if (IN(15)) { pg8::SchedStd S; S.init(HMID, W2t + (size_t)1024 * 4096, ML, 1024, 64, 4096, G, c, (size_t)64 * 32768); pg8::EpiRes E{XS, out, mods1 + 5120};
        pg8::gemm_phase<pg8::EpiRes, pg8::SchedStd, false>(lds, 4096, 64, 4096, S, E, 32768, 128); }
    SEAM(15);
    if (MK_DEBUG && IN(16)) {
        int t_ = threadIdx.x; asm volatile("" : "+v"(t_));
        bool bad = false;
        for (size_t i = (size_t)vcu * 512 + t_; i < (size_t)ML * 1024; i += (size_t)G * 512) { if ((__float_as_uint(out[i]) & 0x7f800000u) == 0x7f800000u) { bad = true; out[i] = 0.f; } }
        if (bad) atomicOr(dflags, 1u << 12);
    }
    SEAM(16);
    if (MK_DEBUG && IN(17)) {
        if (c == 0 && threadIdx.x == 0) { const unsigned f = *dflags; if (f) out[0] = 1.0e6f * (float)(__builtin_ctz(f) + 1) + 1.0e4f * (float)__builtin_popcount(f); }
    }
#undef IN
#undef SEAM
}

constexpr int NPHASE = MK_DEBUG ? 18 : 16;
#ifndef MK_USE_CG
#define MK_USE_CG 0
#endif
#ifndef MK_PER_PHASE
#define MK_PER_PHASE 0
#endif

extern "C" void kernel_launch(void* const* d_in, const int* in_sizes, int n_in, void* d_out, int out_size, void* d_ws, size_t ws_size, hipStream_t stream) {
    static int grid = 0;
    if (grid == 0) {
        if (n_in != 15 || out_size != ML * DM || ws_size < WS_END) { fprintf(stderr, "kernel_launch: unexpected shapes (n_in %d out %d ws %zu)\n", n_in, out_size, ws_size); grid = -1; return; }
        int dev = 0, cus = 0, per_cu = 0;
        hipGetDevice(&dev); hipDeviceGetAttribute(&cus, hipDeviceAttributeMultiprocessorCount, dev);
        hipFuncSetAttribute((const void*)fwd_kernel, hipFuncAttributeMaxDynamicSharedMemorySize, LDS_BYTES);
        if (hipOccupancyMaxActiveBlocksPerMultiprocessor(&per_cu, (const void*)fwd_kernel, 512, LDS_BYTES) != hipSuccess || per_cu < 1) { fprintf(stderr, "kernel_launch: occupancy query failed (%d)\n", per_cu); (void)hipGetLastError(); per_cu = 1; }
        grid = cus * 1;
        if (grid <= 0) grid = 256;
    }
    if (grid < 0) return;
    if (hipMemsetAsync((char*)d_ws + WS_BAR, 0, BAR_BYTES, stream) != hipSuccess) { fprintf(stderr, "kernel_launch: memset failed\n"); return; }
    Args a{};
    for (int i = 0; i < 15; ++i) a.in[i] = (const float*)d_in[i];
    a.out = (float*)d_out; a.ws = (unsigned char*)d_ws;
#if MK_PER_PHASE
    for (int p = 0; p < NPHASE; ++p) { a.ph_lo = p; a.ph_hi = p + 1; hipLaunchKernelGGL(fwd_kernel, dim3(grid), dim3(512), LDS_BYTES, stream, a); }
#else
    a.ph_lo = 0; a.ph_hi = NPHASE; a.use_cg = MK_USE_CG;
    void* kargs[] = {&a};
    hipError_t e = hipLaunchCooperativeKernel((const void*)fwd_kernel, dim3(grid), dim3(512), kargs, LDS_BYTES, stream);
    if (e != hipSuccess) fprintf(stderr, "cooperative launch failed: %s (grid %d)\n", hipGetErrorString(e), grid);
#endif
}
```

```cpp
#include <hip/hip_runtime.h>
#include <hip/hip_cooperative_groups.h>
#include <cstdio>
#include <cstdint>
namespace cg = cooperative_groups;

#define LAS __attribute__((address_space(3)))
typedef unsigned short bf16_t;
typedef short bf16x8 __attribute__((ext_vector_type(8)));
typedef short s16x4 __attribute__((ext_vector_type(4)));
typedef float f32x4 __attribute__((ext_vector_type(4)));
typedef unsigned u32x4 __attribute__((ext_vector_type(4)));
typedef unsigned u32x2 __attribute__((ext_vector_type(2)));

constexpr int DM = 1024, NB = 4, SEQ = 4096, CTXL = 256, FF = 4096;
constexpr int ML = NB * SEQ;
constexpr int MT = ML + NB * CTXL;
constexpr float LOG2E = 1.4426950408889634f;
constexpr float EPS = 1e-6f;

constexpr size_t MiB = 1u << 20;
constexpr size_t WS_MODS = 0;
constexpr size_t WS_SB = 512 * 1024;
constexpr size_t WS_BAR = 1 * MiB;
constexpr size_t BAR_BYTES = 16384;
constexpr size_t WS_CS = 2 * MiB;
constexpr size_t WS_D = 2 * MiB + 512 * 1024;
constexpr size_t WS_E = 3 * MiB;
constexpr size_t WS_WQK = 4 * MiB, WS_WV = 8 * MiB, WS_WO = 10 * MiB, WS_FW = 12 * MiB;
constexpr size_t WS_W1 = 14 * MiB;
constexpr size_t WS_W2 = 30 * MiB;
constexpr size_t WS_SSQ = 46 * MiB;
constexpr size_t WS_BV = 47 * MiB;
constexpr size_t WS_H = 48 * MiB;
constexpr size_t WS_R = 82 * MiB;
constexpr size_t WS_QK = WS_R;
constexpr size_t WS_VT = WS_R + 68 * MiB;
constexpr size_t WS_O = WS_R + 102 * MiB;
constexpr size_t WS_HMID = WS_R;
constexpr size_t WS_Z0 = WS_R;
constexpr size_t WS_Z1 = WS_R + 64 * MiB;
constexpr size_t WS_F = WS_R;
constexpr size_t WS_XS = WS_R + 134 * MiB;
constexpr size_t WS_END = 256 * MiB;
static_assert(WS_XS + 32 * MiB <= WS_END && WS_O + 32 * MiB <= WS_XS && WS_F + 32 * MiB <= WS_END && WS_HMID + 128 * MiB <= WS_END && WS_O + 32 * MiB <= WS_END, "ws map");

constexpr int LDS_BYTES = 147456;

typedef __bf16 bf16v2_t __attribute__((ext_vector_type(2)));
typedef float f32v2_t __attribute__((ext_vector_type(2)));
__device__ __forceinline__ unsigned cvt_pk_bf16(float lo, float hi) { const f32v2_t v = {lo, hi}; const bf16v2_t r = __builtin_convertvector(v, bf16v2_t); return __builtin_bit_cast(unsigned, r); }
__device__ __forceinline__ f32x4 mfma16(bf16x8 a, bf16x8 b, f32x4 c) { return __builtin_amdgcn_mfma_f32_16x16x32_bf16(a, b, c, 0, 0, 0); }


#ifndef MK_WT
#define MK_WT 0
#endif
__device__ __forceinline__ void st16(void* p, u32x4 v) {
#if MK_WT
    asm volatile("global_store_dwordx4 %0, %1, off sc1\n\ts_nop 1" :: "v"(p), "v"(v) : "memory");
#else
    *(u32x4*)p = v;
#endif
}
__device__ __forceinline__ void st16f(void* p, f32x4 v) {
#if MK_WT
    asm volatile("global_store_dwordx4 %0, %1, off sc1\n\ts_nop 1" :: "v"(p), "v"(v) : "memory");
#else
    *(f32x4*)p = v;
#endif
}
__device__ __forceinline__ void st8(void* p, u32x2 v) {
#if MK_WT
    asm volatile("global_store_dwordx2 %0, %1, off sc1\n\ts_nop 1" :: "v"(p), "v"(v) : "memory");
#else
    *(u32x2*)p = v;
#endif
}
namespace pg8 {
constexpr int BM = 256, BK = 64, HALF = 128, HTB = HALF * BK * 2, STAGE_BYTES = 8 * HTB;
__device__ __forceinline__ int lds_byte(int r, int c) { const int st = (r >> 4) * 2 + (c >> 5), rr = r & 15, cc = c & 31, ob = rr * 64 + cc * 2; return st * 1024 + (ob ^ (((ob >> 9) & 1) << 5)); }
__device__ __forceinline__ void stage_rc(int b, int& R, int& C) { const int st = b / 1024, sb = b % 1024, swz = sb ^ (((sb >> 9) & 1) << 5); R = (st >> 1) * 16 + swz / 64; C = (st & 1) * 32 + (swz % 64) / 2; }
__device__ __forceinline__ int perm32(int rho) { const int n = rho >> 4, i = rho & 15; return 8 * (i >> 2) + 4 * n + (i & 3); }

struct Unit { int pm, pn, kind, aux; const char* a; const char* b; };

template <class Epi, class Sched, bool BMAP>
__device__ __forceinline__ void gemm_phase(LAS unsigned char* lds, const int K, const int lda, const int ldb, const Sched& S, const Epi& E, const size_t kstepA = 128, const size_t kstepB = 128) {
    int tid = threadIdx.x; asm volatile("" : "+v"(tid));
    const int wid = __builtin_amdgcn_readfirstlane(tid >> 6), lane = tid & 63, wr = wid >> 2, wc = wid & 3, fr = lane & 15, fq = lane >> 4;
    int nt = K / BK; asm volatile("" : "+s"(nt));
    unsigned voffA[2], voffB[2];
#pragma unroll
    for (int i = 0; i < 2; ++i) { int R, C; stage_rc(tid * 16 + i * 8192, R, C); const int Rb = (R & ~31) + perm32(R & 31);
        voffA[i] = (unsigned)(R * lda + C) * 2u;
        voffB[i] = BMAP ? (unsigned)((64 * (Rb & 63) + (Rb >> 6)) * ldb + C) * 2u : (unsigned)(Rb * ldb + C) * 2u; }
    const size_t hstepA = (size_t)HALF * lda * 2;
    const size_t hstepB = BMAP ? (size_t)2 * ldb * 2 : (size_t)HALF * ldb * 2;
    const unsigned ldsw = (unsigned)wid * 1024u;
    const int aoff = lds_byte(wr * 64 + fr, fq * 8), boff = lds_byte(wc * 32 + fr, fq * 8);
#define PG8_SA(b, h) (((b) * 2 + (h)) * HTB)
#define PG8_SB(b, h) ((4 + (b) * 2 + (h)) * HTB)
#define PG8_STAGE(bufoff, gbase, voff) do { _Pragma("unroll") for (int _i = 0; _i < 2; ++_i) \
        __builtin_amdgcn_global_load_lds((const unsigned*)((const char*)(gbase) + (voff)[_i]), (LAS unsigned*)(lds + (bufoff) + ldsw + _i * 8192), 16, 0, 0); } while (0)
#define PG8_LDA(dst, b, h) do { _Pragma("unroll") for (int m = 0; m < 4; ++m) _Pragma("unroll") for (int k = 0; k < 2; ++k) dst[m][k] = *(const LAS bf16x8*)(lds + PG8_SA(b, h) + aoff + m * 2048 + k * 1024); } while (0)
#define PG8_LDB(dst, b, h) do { _Pragma("unroll") for (int n = 0; n < 2; ++n) _Pragma("unroll") for (int k = 0; k < 2; ++k) dst[n][k] = *(const LAS bf16x8*)(lds + PG8_SB(b, h) + boff + n * 2048 + k * 1024); } while (0)
#define PG8_MMA(ai, bj, At, Bt) do { __builtin_amdgcn_s_setprio(1); _Pragma("unroll") for (int m = 0; m < 4; ++m) _Pragma("unroll") for (int n = 0; n < 2; ++n) _Pragma("unroll") for (int k = 0; k < 2; ++k) \
        acc[ai][bj][m][n] = __builtin_amdgcn_mfma_f32_16x16x32_bf16(Bt[n][k], At[m][k], acc[ai][bj][m][n], 0, 0, 0); __builtin_amdgcn_s_setprio(0); } while (0)
#define PG8_WAIT_V(n) asm volatile("s_waitcnt vmcnt(" #n ")" ::: "memory")
#define PG8_WAIT_L(n) asm volatile("s_waitcnt lgkmcnt(" #n ")" ::: "memory")
#define PG8_BAR __builtin_amdgcn_s_barrier()
#define PG8_SCHED __builtin_amdgcn_sched_barrier(0)
    Unit cur, nxt; int ui = 0;
    if (!S.next(0, cur)) return;
    f32x4 acc[2][2][4][2];
#pragma unroll
    for (int a = 0; a < 2; ++a)
#pragma unroll
        for (int b = 0; b < 2; ++b)
#pragma unroll
            for (int m = 0; m < 4; ++m)
#pragma unroll
                for (int n = 0; n < 2; ++n) acc[a][b][m][n] = (f32x4){0.f, 0.f, 0.f, 0.f};
    bf16x8 At[4][2], B0[2][2], B1[2][2];
    const char* cA = cur.a; const char* cB = cur.b;
    if constexpr (Epi::PREP) E.prep(cur, lds, 0, tid);
    PG8_STAGE(PG8_SB(0, 0), cB, voffB); PG8_STAGE(PG8_SB(0, 1), cB + hstepB, voffB); PG8_STAGE(PG8_SA(0, 0), cA, voffA); PG8_STAGE(PG8_SA(0, 1), cA + hstepA, voffA);
    if (wr == 1) PG8_BAR;
    PG8_WAIT_V(2); PG8_BAR;
    PG8_STAGE(PG8_SB(1, 0), cB + kstepB, voffB); PG8_STAGE(PG8_SA(1, 0), cA + kstepA, voffA); PG8_STAGE(PG8_SB(1, 1), cB + hstepB + kstepB, voffB);
    PG8_WAIT_V(6); PG8_BAR;
    for (;;) {
        const bool has_next = S.next(ui + 1, nxt);
        const char* nA = has_next ? nxt.a : cA; const char* nB = has_next ? nxt.b : cB;
        for (int t = 0; t < nt; t += 2) {
            const bool last = (t == nt - 2);
            const char* a1 = cA + (size_t)(t + 1) * kstepA;
            const char* a2 = last ? nA : cA + (size_t)(t + 2) * kstepA; const char* b2 = last ? nB : cB + (size_t)(t + 2) * kstepB;
            const char* a3 = a2 + kstepA; const char* b3 = b2 + kstepB;
            PG8_LDB(B0, 0, 0); PG8_LDB(B1, 0, 1); PG8_SCHED; PG8_LDA(At, 0, 0); PG8_STAGE(PG8_SA(1, 1), a1 + hstepA, voffA);
            PG8_WAIT_V(8); PG8_WAIT_L(0); PG8_BAR; PG8_MMA(0, 0, At, B0); PG8_MMA(0, 1, At, B1); PG8_BAR; PG8_SCHED;
            PG8_LDA(At, 0, 1); PG8_STAGE(PG8_SB(0, 0), b2, voffB); PG8_STAGE(PG8_SB(0, 1), b2 + hstepB, voffB); PG8_STAGE(PG8_SA(0, 0), a2, voffA);
            PG8_WAIT_V(8); PG8_WAIT_L(0); PG8_BAR; PG8_MMA(1, 0, At, B0); PG8_MMA(1, 1, At, B1); PG8_BAR; PG8_SCHED;
            PG8_LDB(B0, 1, 0); PG8_LDB(B1, 1, 1); PG8_SCHED; PG8_LDA(At, 1, 0); PG8_STAGE(PG8_SA(0, 1), a2 + hstepA, voffA);
            PG8_WAIT_V(8); PG8_WAIT_L(0); PG8_BAR; PG8_MMA(0, 0, At, B0); PG8_MMA(0, 1, At, B1); PG8_BAR; PG8_SCHED;
            PG8_LDA(At, 1, 1); PG8_STAGE(PG8_SB(1, 0), b3, voffB); PG8_STAGE(PG8_SB(1, 1), b3 + hstepB, voffB); PG8_STAGE(PG8_SA(1, 0), a3, voffA);
            PG8_WAIT_V(8); PG8_WAIT_L(0); PG8_BAR; PG8_MMA(1, 0, At, B0); PG8_MMA(1, 1, At, B1); PG8_BAR; PG8_SCHED;
        }
        if (wr == 0) PG8_BAR;
        if constexpr (Epi::PREP) { if (has_next) E.prep(nxt, lds, (ui + 1) & 1, tid); }
        E(acc, cur, wr, wc, fr, fq, lds, ui & 1);
        if (!has_next) break;
#pragma unroll
        for (int a = 0; a < 2; ++a)
#pragma unroll
            for (int b = 0; b < 2; ++b)
#pragma unroll
                for (int m = 0; m < 4; ++m)
#pragma unroll
                    for (int n = 0; n < 2; ++n) acc[a][b][m][n] = (f32x4){0.f, 0.f, 0.f, 0.f};
        cur = nxt; cA = nA; cB = nB; ++ui;
        if (wr == 1) PG8_BAR;
    }
    PG8_WAIT_V(0);
    PG8_BAR;
#undef PG8_SA
#undef PG8_SB
#undef PG8_STAGE
#undef PG8_LDA
#undef PG8_LDB
#undef PG8_MMA
#undef PG8_WAIT_V
#undef PG8_WAIT_L
#undef PG8_BAR
#undef PG8_SCHED
}

struct SchedStd {
    const char* A; const char* Bt; size_t tsA, tsB; int nM, nN, nwg, G, c;
    __device__ void init(const void* A_, const void* Bt_, int M, int N, int lda, int ldb, int G_, int c_, size_t tsA_ = 0) { A = (const char*)A_; Bt = (const char*)Bt_; tsA = tsA_ ? tsA_ : (size_t)BM * lda * 2; tsB = (size_t)BM * ldb * 2; nM = M / BM; nN = N / BM; nwg = nM * nN; G = G_; c = c_; }
    __device__ bool next(int i, Unit& u) const {
        const long L = (long)i * G + c; if (L >= nwg) return false;
        int wgid = (int)L; { const int q = nwg / 8, r = nwg % 8, xcd = wgid % 8, off = wgid / 8; wgid = (xcd < r ? xcd * (q + 1) : r * (q + 1) + (xcd - r) * q) + off; }
        const int nig = 8 * nN, gid = wgid / nig, fm = gid * 8, gsz = (nM - fm) < 8 ? (nM - fm) : 8;
        u.pm = fm + ((wgid % nig) % gsz); u.pn = (wgid % nig) / gsz; u.kind = 0; u.aux = 0;
        u.a = A + (size_t)u.pm * tsA; u.b = Bt + (size_t)u.pn * tsB; return true;
    }
};
struct SchedQKV {
    const char* H; const char* Wqk; const char* Wv; int G, c, nunits;
    __device__ bool next(int i, Unit& u) const {
        const long Ll = (long)i * G + c; if (Ll >= nunits) return false;
        const int L = (int)Ll; const size_t ts = (size_t)BM * 1024 * 2; u.aux = 0;
        if (L < 512) { const int x = L & 7, off = L >> 3; u.kind = 0; u.pm = 8 * x + (off & 7); u.pn = off >> 3; }
        else if (L < 768) { const int l2 = L - 512, x = l2 & 7, off = l2 >> 3; u.kind = 1; u.pm = off & 3; u.pn = 8 * x + (off >> 2); }
        else if (L < 784) { const int l2 = L - 768; u.kind = 0; u.pm = 64 + (l2 & 3); u.pn = 4 + (l2 >> 2); }
        else { const int l2 = L - 784; u.kind = 1; u.pm = l2 & 3; u.pn = 64 + (l2 >> 2); }
        if (u.kind == 0) { u.a = H + (size_t)u.pm * ts; u.b = Wqk + (size_t)u.pn * ts; }
        else { u.a = Wv + (size_t)u.pm * ts; u.b = H + (size_t)u.pn * ts; }
        return true;
    }
};
struct SchedOne { Unit u;
    __device__ __forceinline__ bool next(int i, Unit& o) const { if (i > 0) return false; o = u; return true; }
};
struct SchedF1 {
    const char* CS; const char* H; int G, c;
    __device__ bool next(int i, Unit& u) const {
        const long Ll = (long)i * G + c; if (Ll >= 512) return false;
        const int L = (int)Ll; const int t = L & 15, b = (L >> 4) & 3, g = (L >> 6) & 3, ri = L >> 8;
        u.pm = ri; u.pn = t; u.kind = g; u.aux = b;
        u.a = CS + (size_t)ri * 256 * 256 * 2; u.b = H + ((size_t)(b * 4096 + 4 * t) * 1024 + g * 256) * 2; return true;
    }
};

typedef f32x4 Acc[2][2][4][2];
__device__ __forceinline__ u32x4 pack8(f32x4 v0, f32x4 v1) { u32x4 w; w.x = cvt_pk_bf16(v0[0], v0[1]); w.y = cvt_pk_bf16(v0[2], v0[3]); w.z = cvt_pk_bf16(v1[0], v1[1]); w.w = cvt_pk_bf16(v1[2], v1[3]); return w; }

__device__ __forceinline__ void unpack8(u32x4 w, f32x4& v0, f32x4& v1) {
    v0[0] = __uint_as_float(w.x << 16); v0[1] = __uint_as_float(w.x & 0xffff0000u); v0[2] = __uint_as_float(w.y << 16); v0[3] = __uint_as_float(w.y & 0xffff0000u);
    v1[0] = __uint_as_float(w.z << 16); v1[1] = __uint_as_float(w.z & 0xffff0000u); v1[2] = __uint_as_float(w.w << 16); v1[3] = __uint_as_float(w.w & 0xffff0000u);
}
struct EpiQKV { static constexpr bool PREP = true; bf16_t* QK; bf16_t* VT; const float* gq; const float* gk;
    __device__ __forceinline__ void prep(const Unit& u, LAS unsigned char* lds, int slot, int tid) const {
        if (u.kind == 0 && tid < 64) { const bool isq = u.pn < 4; ((LAS float*)(lds + 131072))[slot * 512 + tid] = isq ? gq[tid] * (0.125f * LOG2E) : gk[tid]; }
    }
    __device__ __forceinline__ void operator()(const Acc& acc, const Unit& u, int wr, int wc, int fr, int fq, LAS unsigned char* lds, int slot) const {
        if (u.kind == 0) {
            const LAS float* gp = (const LAS float*)(lds + 131072) + slot * 512;
            f32x4 gv[2][2];
#pragma unroll
            for (int bj = 0; bj < 2; ++bj)
#pragma unroll
                for (int n = 0; n < 2; ++n) gv[bj][n] = *(const LAS f32x4*)(gp + 32 * bj + 8 * fq + 4 * n);
#pragma unroll
            for (int ai = 0; ai < 2; ++ai)
#pragma unroll
                for (int m = 0; m < 4; ++m) {
                    const int row = u.pm * BM + ai * HALF + wr * 64 + m * 16 + fr;
                    float ss = 0.f;
#pragma unroll
                    for (int bj = 0; bj < 2; ++bj)
#pragma unroll
                        for (int n = 0; n < 2; ++n) { const f32x4 x = acc[ai][bj][m][n]; ss += (x[0] * x[0] + x[1] * x[1]) + (x[2] * x[2] + x[3] * x[3]); }
                    ss += __shfl_xor(ss, 16); ss += __shfl_xor(ss, 32);
                    const float rstd = rsqrtf(ss * (1.0f / 64.0f) + EPS);
                    bf16_t* rowp = QK + (size_t)row * 2048 + u.pn * 256 + wc * 64 + 8 * fq;
#pragma unroll
                    for (int bj = 0; bj < 2; ++bj) st16(rowp + 32 * bj, pack8(acc[ai][bj][m][0] * rstd * gv[bj][0], acc[ai][bj][m][1] * rstd * gv[bj][1]));
                }
        } else {
#pragma unroll
            for (int ai = 0; ai < 2; ++ai)
#pragma unroll
                for (int m = 0; m < 4; ++m) {
                    const int row = u.pm * BM + ai * HALF + wr * 64 + m * 16 + fr;
                    bf16_t* rowp = VT + (size_t)row * MT + u.pn * 256 + wc * 32 + 8 * fq;
#pragma unroll
                    for (int bj = 0; bj < 2; ++bj) st16(rowp + bj * HALF, pack8(acc[ai][bj][m][0], acc[ai][bj][m][1]));
                }
        }
    }
};
struct EpiRelu2 { static constexpr bool PREP = false; bf16_t* O; int ldc;
    __device__ __forceinline__ void operator()(const Acc& acc, const Unit& u, int wr, int wc, int fr, int fq, LAS unsigned char*, int) const {
#pragma unroll
        for (int ai = 0; ai < 2; ++ai)
#pragma unroll
            for (int m = 0; m < 4; ++m) {
                const int row = u.pm * BM + ai * HALF + wr * 64 + m * 16 + fr;
                bf16_t* rowp = O + (size_t)row * ldc + u.pn * 256 + wc * 32 + 8 * fq;
#pragma unroll
                for (int bj = 0; bj < 2; ++bj) { f32x4 v0 = acc[ai][bj][m][0], v1 = acc[ai][bj][m][1];
#pragma unroll
                    for (int e = 0; e < 4; ++e) { const float a = fmaxf(v0[e], 0.f), b = fmaxf(v1[e], 0.f); v0[e] = a * a; v1[e] = b * b; }
                    *(u32x4*)(rowp + bj * HALF) = pack8(v0, v1); }
            }
    }
};
struct EpiRes { static constexpr bool PREP = false; const bf16_t* base; float* out; const float* gate;
    __device__ __forceinline__ void operator()(const Acc& acc, const Unit& u, int wr, int wc, int fr, int fq, LAS unsigned char*, int) const {
        const int col0 = u.pn * 256 + wc * 32 + 8 * fq;
        const float* gp = gate + (size_t)(u.pm >> 4) * 6144 + col0;
        f32x4 gv[2][2];
#pragma unroll
        for (int bj = 0; bj < 2; ++bj)
#pragma unroll
            for (int n = 0; n < 2; ++n) gv[bj][n] = *(const f32x4*)(gp + bj * HALF + 4 * n);
#pragma unroll
        for (int ai = 0; ai < 2; ++ai)
#pragma unroll
          for (int mh = 0; mh < 2; ++mh) {
            u32x4 pre[2][2];
#pragma unroll
            for (int m2 = 0; m2 < 2; ++m2)
#pragma unroll
                for (int bj = 0; bj < 2; ++bj) pre[m2][bj] = *(const u32x4*)(base + (size_t)(u.pm * BM + ai * HALF + wr * 64 + (2 * mh + m2) * 16 + fr) * 1024 + col0 + bj * HALF);
            asm volatile("" ::: "memory");
#pragma unroll
            for (int m2 = 0; m2 < 2; ++m2) { const int m = 2 * mh + m2;
                const size_t off = (size_t)(u.pm * BM + ai * HALF + wr * 64 + m * 16 + fr) * 1024 + col0;
#pragma unroll
                for (int bj = 0; bj < 2; ++bj) { f32x4 b0, b1; unpack8(pre[m2][bj], b0, b1);
                    *(f32x4*)(out + off + bj * HALF) = b0 + gv[bj][0] * acc[ai][bj][m][0]; *(f32x4*)(out + off + bj * HALF + 4) = b1 + gv[bj][1] * acc[ai][bj][m][1]; }
            }
            asm volatile("" ::: "memory");
          }
    }
};
struct EpiZ0 { static constexpr bool PREP = false; bf16_t* Z0;
    __device__ __forceinline__ void operator()(const Acc& acc, const Unit& u, int wr, int wc, int fr, int fq, LAS unsigned char*, int) const {
        const int ri = u.pm, t = u.pn, g = u.kind, b = u.aux;
        bf16_t* p0 = Z0 + ((size_t)(((b * 4 + g) * 256 + wr * 64 + fr) * 64 + 4 * t + (wc >> 1))) * 128 + ri * 64 + 32 * (wc & 1) + 8 * fq;
#pragma unroll
        for (int ai = 0; ai < 2; ++ai)
#pragma unroll
            for (int m = 0; m < 4; ++m) {
#pragma unroll
                for (int bj = 0; bj < 2; ++bj)
                    *(u32x4*)(p0 + (size_t)(ai * HALF + m * 16) * 8192 + bj * 256) = pack8(acc[ai][bj][m][0], acc[ai][bj][m][1]);
                asm volatile("" ::: "memory");
            }
    }
};

constexpr int AUX_OFF = 131072;
template <bool BASE16>
struct EpiResF { static constexpr bool PREP = false; const void* base; bf16_t* XS; const float* gate; const float* gm; bf16_t* XB; float* SSQ;
    __device__ __forceinline__ void operator()(const Acc& acc, const Unit& u, int wr, int wc, int fr, int fq, LAS unsigned char*, int) const {
        const int col0 = u.pn * 256 + wc * 32 + 8 * fq, b = u.pm >> 4;
        f32x4 gv[2][2], mv[2][2];
#pragma unroll
        for (int bj = 0; bj < 2; ++bj)
#pragma unroll
            for (int n = 0; n < 2; ++n) { gv[bj][n] = *(const f32x4*)(gate + (size_t)b * 6144 + col0 + bj * HALF + 4 * n); mv[bj][n] = *(const f32x4*)(gm + b * 1024 + col0 + bj * HALF + 4 * n); }
#pragma unroll
        for (int ai = 0; ai < 2; ++ai)
#pragma unroll
          for (int mh = 0; mh < 2; ++mh) {
            f32x4 pre[2][2][2];
#pragma unroll
            for (int m2 = 0; m2 < 2; ++m2) { const size_t off = (size_t)(u.pm * BM + ai * HALF + wr * 64 + (2 * mh + m2) * 16 + fr) * 1024 + col0;
#pragma unroll
                for (int bj = 0; bj < 2; ++bj) {
                    if (BASE16) { const u32x4 w = *(const u32x4*)((const bf16_t*)base + off + bj * HALF); unpack8(w, pre[m2][bj][0], pre[m2][bj][1]); }
                    else { pre[m2][bj][0] = *(const f32x4*)((const float*)base + off + bj * HALF); pre[m2][bj][1] = *(const f32x4*)((const float*)base + off + bj * HALF + 4); }
                } }
            asm volatile("" ::: "memory");
#pragma unroll
            for (int m2 = 0; m2 < 2; ++m2) {
                const int m = 2 * mh + m2;
                const int row = u.pm * BM + ai * HALF + wr * 64 + m * 16 + fr;
                const size_t off = (size_t)row * 1024 + col0;
                float ss = 0.f;
#pragma unroll
                for (int bj = 0; bj < 2; ++bj) {
                    const f32x4 v0 = pre[m2][bj][0] + gv[bj][0] * acc[ai][bj][m][0];
                    const f32x4 v1 = pre[m2][bj][1] + gv[bj][1] * acc[ai][bj][m][1];
                    st16(XS + off + bj * HALF, pack8(v0, v1));
                    ss += ((v0[0] * v0[0] + v0[1] * v0[1]) + (v0[2] * v0[2] + v0[3] * v0[3])) + ((v1[0] * v1[0] + v1[1] * v1[1]) + (v1[2] * v1[2] + v1[3] * v1[3]));
                    st16(XB + off + bj * HALF, pack8(v0 * mv[bj][0], v1 * mv[bj][1]));
                }
                ss += __shfl_xor(ss, 16); ss += __shfl_xor(ss, 32);
                if (fq == 0) SSQ[(size_t)row * 16 + u.pn * 4 + wc] = ss;
            }
            asm volatile("" ::: "memory");
          }
    }
};
__device__ __forceinline__ float ssq_rstd(const float* SSQ, int row, int half) {
    const f32x4 a = *(const f32x4*)(SSQ + (size_t)row * 16 + half * 8), b = *(const f32x4*)(SSQ + (size_t)row * 16 + half * 8 + 4);
    float s = ((a[0] + a[1]) + (a[2] + a[3])) + ((b[0] + b[1]) + (b[2] + b[3]));
    s += __shfl_xor(s, 1);
    return rsqrtf(s * (1.0f / 1024.0f) + EPS);
}
struct EpiRelu2F { static constexpr bool PREP = true; bf16_t* O; int ldc; const float* BV; const float* SSQ;
    __device__ __forceinline__ void prep(const Unit& u, LAS unsigned char* lds, int slot, int tid) const {
        const float r = ssq_rstd(SSQ, u.pm * BM + (tid >> 1), tid & 1);
        LAS float* aux = (LAS float*)(lds + AUX_OFF) + slot * 512;
        if (!(tid & 1)) aux[tid >> 1] = r;
        if (tid < 256) aux[256 + tid] = BV[(size_t)(u.pm >> 4) * 4096 + u.pn * 256 + tid];
    }
    __device__ __forceinline__ void operator()(const Acc& acc, const Unit& u, int wr, int wc, int fr, int fq, LAS unsigned char* lds, int slot) const {
        const LAS float* rt = (const LAS float*)(lds + AUX_OFF) + slot * 512;
        const int col0 = u.pn * 256 + wc * 32 + 8 * fq;
        f32x4 bv[2][2];
#pragma unroll
        for (int bj = 0; bj < 2; ++bj)
#pragma unroll
            for (int n = 0; n < 2; ++n) bv[bj][n] = *(const LAS f32x4*)(rt + 256 + wc * 32 + 8 * fq + bj * HALF + 4 * n);
#pragma unroll
        for (int ai = 0; ai < 2; ++ai)
#pragma unroll
            for (int m = 0; m < 4; ++m) {
                const int rl = ai * HALF + wr * 64 + m * 16 + fr; const float rs = rt[rl];
                bf16_t* rowp = O + ((size_t)(u.pm * 64 + u.pn * 4 + (wc >> 1)) * 256 + rl) * 64 + (wc & 1) * 32 + 8 * fq;
#pragma unroll
                for (int bj = 0; bj < 2; ++bj) { f32x4 v0 = acc[ai][bj][m][0] * rs + bv[bj][0], v1 = acc[ai][bj][m][1] * rs + bv[bj][1];
#pragma unroll
                    for (int e = 0; e < 4; ++e) { const float a = fmaxf(v0[e], 0.f), c2 = fmaxf(v1[e], 0.f); v0[e] = a * a; v1[e] = c2 * c2; }
                    st16(rowp + bj * 2 * 256 * 64, pack8(v0, v1)); }
            }
    }
};
struct EpiZ0F { static constexpr bool PREP = true; bf16_t* Z0; const float* BVF; const float* SSQ;
    __device__ __forceinline__ void prep(const Unit& u, LAS unsigned char* lds, int slot, int tid) const {
        const int nl = tid >> 1, tok = u.aux * 4096 + 64 * (nl & 63) + 4 * u.pn + (nl >> 6);
        const float r = ssq_rstd(SSQ, tok, tid & 1);
        LAS float* aux = (LAS float*)(lds + AUX_OFF) + slot * 512;
        if (!(tid & 1)) aux[nl] = r;
        if (tid < 256) aux[256 + tid] = BVF[(size_t)(u.aux * 4 + u.kind) * 512 + u.pm * 256 + tid];
    }
    __device__ __forceinline__ void operator()(const Acc& acc, const Unit& u, int wr, int wc, int fr, int fq, LAS unsigned char* lds, int slot) const {
        const LAS float* rt = (const LAS float*)(lds + AUX_OFF) + slot * 512;
        const int ri = u.pm, t = u.pn, g = u.kind, b = u.aux;
        f32x4 rs[2][2];
#pragma unroll
        for (int bj = 0; bj < 2; ++bj)
#pragma unroll
            for (int n = 0; n < 2; ++n) rs[bj][n] = *(const LAS f32x4*)(rt + bj * HALF + wc * 32 + 8 * fq + 4 * n);
        const LAS float* bz = rt + 256 + wr * 64 + fr;
        bf16_t* p0 = Z0 + ((size_t)(((b * 4 + g) * 256 + wr * 64 + fr) * 64 + 4 * t + (wc >> 1))) * 128 + ri * 64 + 32 * (wc & 1) + 8 * fq;
#pragma unroll
        for (int ai = 0; ai < 2; ++ai)
#pragma unroll
            for (int m = 0; m < 4; ++m) {
                const float bb = bz[ai * HALF + m * 16];
#pragma unroll
                for (int bj = 0; bj < 2; ++bj)
                    st16(p0 + (size_t)(ai * HALF + m * 16) * 8192 + bj * 256, pack8(acc[ai][bj][m][0] * rs[bj][0] + bb, acc[ai][bj][m][1] * rs[bj][1] + bb));
                asm volatile("" ::: "memory");
            }
    }
};
}


#define XB_TMO      128
#define XB_XCNT(j)  (256  + 64 * (j))
#define XB_XSUB(j)  (1280 + 64 * (j))
#define XB_XGEN(j)  (2304 + 64 * (j))
#define XB_TOP      3328
#define XB_TOPGEN   3392
#define XCD_BAR_WORDS 3456
#define XB_SPIN_CAP (1u << 18)
__device__ __forceinline__ unsigned xb_ld(unsigned* p)              { return __hip_atomic_load(p, __ATOMIC_RELAXED, __HIP_MEMORY_SCOPE_AGENT); }
__device__ __forceinline__ unsigned xb_add(unsigned* p, unsigned v) { return __hip_atomic_fetch_add(p, v, __ATOMIC_RELAXED, __HIP_MEMORY_SCOPE_AGENT); }
__device__ __forceinline__ unsigned xb_xcc_id() { return (unsigned)__builtin_amdgcn_s_getreg((3 << 11) | 20) & 0xFu; }
#define XB_SPIN(cond, bar) do { unsigned _sp = 0; while (cond) { __builtin_amdgcn_s_sleep(1); \
    if ((++_sp & 255u) == 0u) { if (xb_ld(&(bar)[XB_TMO])) break; if (_sp > XB_SPIN_CAP) { atomicAdd(&(bar)[XB_TMO], 1u); break; } } } } while (0)
struct XcdBarrier { unsigned* bar; unsigned x; volatile LAS unsigned* st; };
__device__ __forceinline__ XcdBarrier xcd_barrier_post(unsigned* bar, volatile LAS unsigned* st) {
    XcdBarrier b; b.bar = bar; b.x = xb_xcc_id(); b.st = st;
    if (threadIdx.x == 0) (void)xb_add(&bar[XB_XCNT(b.x)], 1u);
    return b;
}
__device__ __forceinline__ void xcd_barrier_complete(unsigned* bar, unsigned x, unsigned& nloc, unsigned& nx) {
    const unsigned G = gridDim.x * gridDim.y * gridDim.z;
    unsigned sum, cnt, mine, sp = 0u;
    for (;;) {
        sum = 0u; cnt = 0u; mine = 0u;
#pragma unroll
        for (unsigned j = 0; j < 16; ++j) { const unsigned c = xb_ld(&bar[XB_XCNT(j)]); sum += c; cnt += (c > 0u) ? 1u : 0u; mine = (j == x) ? c : mine; }
        if (sum == G) break;
        __builtin_amdgcn_s_sleep(1);
        if ((++sp & 255u) == 0u) { if (xb_ld(&bar[XB_TMO])) break; if (sp > XB_SPIN_CAP) { atomicAdd(&bar[XB_TMO], 1u); break; } }
    }
    nloc = mine > 0u ? mine : 1u; nx = cnt > 0u ? cnt : 1u;
}
__device__ __forceinline__ void xcd_barrier(const XcdBarrier& b) {
    asm volatile("s_waitcnt vmcnt(0)" ::: "memory");
    __syncthreads();
    if (threadIdx.x == 0) {
        unsigned* bar = b.bar;
        __builtin_amdgcn_s_waitcnt(0);
        unsigned nloc = b.st[0], nx = b.st[1];
        if (nloc == 0u) { xcd_barrier_complete(bar, b.x, nloc, nx); b.st[0] = nloc; b.st[1] = nx; }
        const unsigned old = xb_add(&bar[XB_XSUB(b.x)], 1u);
        const unsigned gen = old / nloc;
        if (old + 1u == (gen + 1u) * nloc) {
            __builtin_amdgcn_fence(__ATOMIC_RELEASE, "agent");
            asm volatile("s_waitcnt vmcnt(0)" ::: "memory");
            const unsigned og = xb_add(&bar[XB_TOP], 1u);
            const unsigned tg = og / nx;
            if (og + 1u == (tg + 1u) * nx) xb_add(&bar[XB_TOPGEN], 1u);
            else XB_SPIN(xb_ld(&bar[XB_TOPGEN]) == tg, bar);
            __builtin_amdgcn_fence(__ATOMIC_ACQUIRE, "agent");
            xb_add(&bar[XB_XGEN(b.x)], 1u);
            asm volatile("s_waitcnt vmcnt(0)" ::: "memory");
        } else {
            XB_SPIN(xb_ld(&bar[XB_XGEN(b.x)]) == gen, bar);
            __builtin_amdgcn_fence(__ATOMIC_ACQUIRE, "agent");
            asm volatile("s_waitcnt vmcnt(0)" ::: "memory");
        }
    }
    __syncthreads();
}
__device__ __forceinline__ void p0_mods_unit(const float* c, const float* cctx, const float* ada_w, const float* ada_b, float* mods, LAS unsigned char* lds, int unit) {
    LAS float* s = (LAS float*)lds;
    LAS float* red = s + 5 * 1024;
    int tid = threadIdx.x; asm volatile("" : "+v"(tid));
    for (int i = tid; i < 5 * 1024; i += 512) { const int v = i >> 10, k = i & 1023; const float x = v < 4 ? c[v * 1024 + k] : cctx[k]; s[i] = x / (1.0f + __expf(-x)); }
    __syncthreads();
    const int l = unit / 96, col0 = (unit % 96) * 64, kc = tid >> 6, cl = tid & 63;
    const float* w = ada_w + (size_t)l * 1024 * 6144 + col0 + cl;
    float a0 = 0.f, a1 = 0.f, a2 = 0.f, a3 = 0.f, a4 = 0.f;
    for (int k = kc * 128; k < kc * 128 + 128; k += 32) {
        float wv[32];
#pragma unroll
        for (int j = 0; j < 32; ++j) wv[j] = w[(size_t)(k + j) * 6144];
#pragma unroll
        for (int j = 0; j < 32; ++j) { a0 += s[k + j] * wv[j]; a1 += s[1024 + k + j] * wv[j]; a2 += s[2048 + k + j] * wv[j]; a3 += s[3072 + k + j] * wv[j]; a4 += s[4096 + k + j] * wv[j]; }
    }
    red[(kc * 5 + 0) * 64 + cl] = a0; red[(kc * 5 + 1) * 64 + cl] = a1; red[(kc * 5 + 2) * 64 + cl] = a2; red[(kc * 5 + 3) * 64 + cl] = a3; red[(kc * 5 + 4) * 64 + cl] = a4;
    __syncthreads();
    if (tid < 320) { const int v = tid >> 6, cc = tid & 63; float t = 0.f;
#pragma unroll
        for (int kk = 0; kk < 8; ++kk) t += red[(kk * 5 + v) * 64 + cc];
        mods[(size_t)(l * 5 + v) * 6144 + col0 + cc] = t + ada_b[l * 6144 + col0 + cc]; }
    __syncthreads();
}

__device__ __forceinline__ void p0_transpose_item(const float* W, int K, int N, bf16_t* WT, bf16_t* WT2, int mode, LAS float* scr, int item, int lane) {
    const int nblk = N / 32, kb = item / nblk, nb = item % nblk, k0 = 64 * kb, n0 = 32 * nb;
    float wv_[32];
#pragma unroll
    for (int i = 0; i < 32; ++i) wv_[i] = W[(size_t)(k0 + 2 * i + (lane >> 5)) * N + n0 + (lane & 31)];
#pragma unroll
    for (int i = 0; i < 32; ++i) scr[(2 * i + (lane >> 5)) * 33 + (lane & 31)] = wv_[i];
    asm volatile("s_waitcnt lgkmcnt(0)" ::: "memory");
    const int cch = lane & 7;
#pragma unroll
    for (int j = 0; j < 4; ++j) { const int n = (lane >> 3) + 8 * j; const LAS float* s = scr + (8 * cch) * 33 + n;
        u32x4 o; o.x = cvt_pk_bf16(s[0 * 33], s[1 * 33]); o.y = cvt_pk_bf16(s[2 * 33], s[3 * 33]); o.z = cvt_pk_bf16(s[4 * 33], s[5 * 33]); o.w = cvt_pk_bf16(s[6 * 33], s[7 * 33]);
        const int ng = n0 + n; bf16_t* dst;
        if (mode == 0) dst = WT + (size_t)ng * K;
        else if (ng < 2048) { const int pn = ng >> 8, hh = (ng >> 6) & 3, d = ng & 63; const int tpos = (d >> 5) * 128 + hh * 32 + (d & 31); dst = WT + (size_t)(pn * 256 + tpos) * K; }
        else dst = WT2 + (size_t)(ng - 2048) * K;
        *(u32x4*)(dst + k0 + 8 * cch) = o; }
    asm volatile("s_waitcnt lgkmcnt(0)" ::: "memory");
}

__device__ __forceinline__ float wave_sum(float v) {
#pragma unroll
    for (int o = 1; o < 64; o <<= 1) v += __shfl_xor(v, o);
    return v;
}
__device__ __forceinline__ void norm_rows(const float* xlat, const float* xctx, int nrows, const float* g, const float* modsl, int sh_off, int sc_off, bf16_t* H, int gw, int NGW, int lane) {
    f32x4 gv[4];
#pragma unroll
    for (int j = 0; j < 4; ++j) gv[j] = *(const f32x4*)(g + lane * 4 + 256 * j);
    for (int row = gw; row < nrows; row += NGW) {
        const float* src = row < ML ? xlat + (size_t)row * 1024 : xctx + (size_t)(row - ML) * 1024;
        const int v = row < ML ? (row >> 12) : 4;
        const float* mp = modsl + (size_t)v * 6144;
        f32x4 x[4]; float ss = 0.f;
#pragma unroll
        for (int j = 0; j < 4; ++j) { x[j] = *(const f32x4*)(src + lane * 4 + 256 * j); ss += (x[j][0] * x[j][0] + x[j][1] * x[j][1]) + (x[j][2] * x[j][2] + x[j][3] * x[j][3]); }
        const float rstd = rsqrtf(wave_sum(ss) * (1.0f / 1024.0f) + EPS);
#pragma unroll
        for (int j = 0; j < 4; ++j) {
            const f32x4 sh = *(const f32x4*)(mp + sh_off + lane * 4 + 256 * j), sc = *(const f32x4*)(mp + sc_off + lane * 4 + 256 * j);
            const f32x4 y = (x[j] * rstd * gv[j]) * (sc + 1.0f) + sh;
            u32x2 w; w.x = cvt_pk_bf16(y[0], y[1]); w.y = cvt_pk_bf16(y[2], y[3]);
            *(u32x2*)(H + (size_t)row * 1024 + lane * 4 + 256 * j) = w;
        }
    }
}


__device__ __forceinline__ void bias_items(const bf16_t* W1t, const bf16_t* CS, const float* mods, float* BV0, float* BV1, float* BVF, int w, int NW, int lane) {
    for (int it = w; it < 8192 + 2048; it += NW) {
        float a0 = 0.f, a1 = 0.f, a2 = 0.f, a3 = 0.f; float* dst; int dstride;
        if (it < 8192) {
            const int l = it >> 12, n = it & 4095;
            const bf16_t* wr_ = W1t + (size_t)l * 4096 * 1024 + (size_t)n * 1024 + lane * 16;
            const u32x4 w0 = *(const u32x4*)wr_, w1 = *(const u32x4*)(wr_ + 8);
            const float* sh = mods + (size_t)l * 5 * 6144 + 3072 + lane * 16;
            float wf[16];
#pragma unroll
            for (int e = 0; e < 4; ++e) { wf[2 * e] = __uint_as_float(w0[e] << 16); wf[2 * e + 1] = __uint_as_float(w0[e] & 0xffff0000u); wf[8 + 2 * e] = __uint_as_float(w1[e] << 16); wf[8 + 2 * e + 1] = __uint_as_float(w1[e] & 0xffff0000u); }
#pragma unroll
            for (int q = 0; q < 4; ++q) {
                const f32x4 s0 = *(const f32x4*)(sh + 4 * q), s1 = *(const f32x4*)(sh + 6144 + 4 * q), s2 = *(const f32x4*)(sh + 2 * 6144 + 4 * q), s3 = *(const f32x4*)(sh + 3 * 6144 + 4 * q);
#pragma unroll
                for (int e = 0; e < 4; ++e) { a0 += s0[e] * wf[4 * q + e]; a1 += s1[e] * wf[4 * q + e]; a2 += s2[e] * wf[4 * q + e]; a3 += s3[e] * wf[4 * q + e]; }
            }
            dst = (l == 0 ? BV0 : BV1) + n; dstride = 4096;
        } else {
            const int idx = it - 8192, g = idx >> 9, m = idx & 511;
            const u32x2 w0 = *(const u32x2*)(CS + (size_t)m * 256 + lane * 4);
            const float wf0 = __uint_as_float(w0[0] << 16), wf1 = __uint_as_float(w0[0] & 0xffff0000u), wf2 = __uint_as_float(w0[1] << 16), wf3 = __uint_as_float(w0[1] & 0xffff0000u);
            const float* sh = mods + (size_t)5 * 6144 + g * 256 + lane * 4;
            const f32x4 s0 = *(const f32x4*)(sh), s1 = *(const f32x4*)(sh + 6144), s2 = *(const f32x4*)(sh + 2 * 6144), s3 = *(const f32x4*)(sh + 3 * 6144);
            a0 = s0[0] * wf0 + s0[1] * wf1 + s0[2] * wf2 + s0[3] * wf3; a1 = s1[0] * wf0 + s1[1] * wf1 + s1[2] * wf2 + s1[3] * wf3;
            a2 = s2[0] * wf0 + s2[1] * wf1 + s2[2] * wf2 + s2[3] * wf3; a3 = s3[0] * wf0 + s3[1] * wf1 + s3[2] * wf2 + s3[3] * wf3;
            dst = BVF + g * 512 + m; dstride = 2048;
        }
        a0 = wave_sum(a0); a1 = wave_sum(a1); a2 = wave_sum(a2); a3 = wave_sum(a3);
        if (lane == 0) { dst[0] = a0; dst[dstride] = a1; dst[2 * dstride] = a2; dst[3 * dstride] = a3; }
    }
}
template <bool MASKED>
__device__ __forceinline__ void attn_block(const LAS bf16_t* Ks, const LAS bf16_t* Vs, int kcol0, int fr, int g, const bf16x8 (&Qf)[2], f32x4 (&acc)[4], float& lsum,
                                           const LAS unsigned char* rpb_base  , const int (&dcb)[8], const f32x4& ciX, const f32x4& ciY) {
    bf16x8 KX[2], KY[2];
#pragma unroll
    for (int kk = 0; kk < 2; ++kk) { KX[kk] = *(const LAS bf16x8*)(Ks + (kcol0 + fr) * 72 + kk * 32 + g * 8); KY[kk] = *(const LAS bf16x8*)(Ks + (kcol0 + 16 + fr) * 72 + kk * 32 + g * 8); }
    s16x4 VX[4], VY[4];
#pragma unroll
    for (int db = 0; db < 4; ++db) { VX[db] = *(const LAS s16x4*)(Vs + (16 * db + fr) * 72 + kcol0 + 4 * g); VY[db] = *(const LAS s16x4*)(Vs + (16 * db + fr) * 72 + kcol0 + 16 + 4 * g); }
    f32x4 sX = mfma16(KX[0], Qf[0], ciX); sX = mfma16(KX[1], Qf[1], sX);
    f32x4 sY = mfma16(KY[0], Qf[0], ciY); sY = mfma16(KY[1], Qf[1], sY);
    f32x4 pX, pY;
    if (MASKED) {
#pragma unroll
        for (int ii = 0; ii < 4; ++ii) {
            const float bx = *(const LAS float*)(rpb_base + dcb[ii]), by = *(const LAS float*)(rpb_base + dcb[4 + ii]);
            pX[ii] = __builtin_amdgcn_exp2f(sX[ii] + bx);
            pY[ii] = __builtin_amdgcn_exp2f(sY[ii] + by);
        }
    } else {
#pragma unroll
        for (int ii = 0; ii < 4; ++ii) { pX[ii] = __builtin_amdgcn_exp2f(sX[ii]); pY[ii] = __builtin_amdgcn_exp2f(sY[ii]); }
    }
    lsum += ((pX[0] + pX[1]) + (pX[2] + pX[3])) + ((pY[0] + pY[1]) + (pY[2] + pY[3]));
    const u32x4 pw = pg8::pack8(pX, pY);
    const bf16x8 Pf = __builtin_bit_cast(bf16x8, pw);
#pragma unroll
    for (int db = 0; db < 4; ++db) {
        bf16x8 Vf; Vf[0] = VX[db][0]; Vf[1] = VX[db][1]; Vf[2] = VX[db][2]; Vf[3] = VX[db][3]; Vf[4] = VY[db][0]; Vf[5] = VY[db][1]; Vf[6] = VY[db][2]; Vf[7] = VY[db][3];
        acc[db] = mfma16(Vf, Pf, acc[db]);
    }
}
__device__ __forceinline__ void attn_phase(const bf16_t* QK, const bf16_t* VT, bf16_t* O, const float* rpb, const float* sbound, LAS unsigned char* lds, int G, int c) {
    constexpr int RP_BYTES = 30720, TILE_B = 64 * 72 * 2, PAIR_B = 4 * TILE_B, NPAIR = 7;
    LAS float* rp = (LAS float*)lds;
    int tid = threadIdx.x; asm volatile("" : "+v"(tid));
    const int lane = tid & 63, wid = __builtin_amdgcn_readfirstlane(tid >> 6), fr = lane & 15, g = lane >> 4;
    for (int i = tid; i < 16 * 465; i += 512) rp[i] = rpb[i] * LOG2E;
    const float Mb = *sbound;
    const int nunits = (2048 - c + G - 1) / G;
    const int ND = nunits * NPAIR;
    const int trow = tid >> 3, tch = tid & 7;
    const int ldsoff = (trow * 72 + tch * 8) * 2;
#define ATT_DEC(L_, b_, h_, rp_) do { const int x_ = (L_) & 7, q_ = (L_) >> 3; rp_ = q_ & 31; const int bh_ = 8 * (q_ >> 5) + x_; b_ = bh_ >> 4; h_ = bh_ & 15; } while (0)
#define ATT_TOK(b_, rs0_, t_) ((t_) < 9 ? (b_) * 4096 + min((rs0_) + (t_), 63) * 64 : ML + (b_) * 256 + 64 * (min((t_), 12) - 9))
#define ATT_GLOAD(D_, R) do { const int u_ = (D_) / NPAIR, p_ = (D_) - u_ * NPAIR; int b_, h_, rp_; ATT_DEC(u_ * G + c, b_, h_, rp_); \
        const int rs0_ = min(max(2 * rp_ - 4, 0), 56); const int tk0_ = ATT_TOK(b_, rs0_, 2 * p_), tk1_ = ATT_TOK(b_, rs0_, 2 * p_ + 1); \
        const bf16_t* kb_ = QK + (size_t)trow * 2048 + 1024 + h_ * 64 + tch * 8; const bf16_t* vb_ = VT + (size_t)(h_ * 64 + trow) * MT + tch * 8; \
        R[0] = *(const u32x4*)(kb_ + (size_t)tk0_ * 2048); R[1] = *(const u32x4*)(vb_ + tk0_); R[2] = *(const u32x4*)(kb_ + (size_t)tk1_ * 2048); R[3] = *(const u32x4*)(vb_ + tk1_); } while (0)
#define ATT_LWRITE(slot_, R) do { _Pragma("unroll") for (int q_ = 0; q_ < 4; ++q_) *(LAS u32x4*)(lds + RP_BYTES + (slot_) * PAIR_B + q_ * TILE_B + ldsoff) = R[q_]; } while (0)
    u32x4 R0[4], R1[4];
    ATT_GLOAD(0, R0); ATT_LWRITE(0, R0);
    if (ND > 1) ATT_GLOAD(1, R1);
    if (ND > 2) ATT_GLOAD(2, R0);
    __syncthreads();
    int b = 0, h = 0, rpair = 0, r = 0, rs0 = 0, rsr = 0, qrow = 0;
    const int j = wid & 3, w0 = (j == 0) ? 0 : (j == 1) ? 8 : (j == 2) ? 24 : 32;
    int dcb[8]; f32x4 ciX, ciY, ciU;
    {
        const int cq = 16 * j + fr, cs = min(max(cq - 8, 0), 48), eX = w0 + 4 * g - cs, dX = w0 + 4 * g - cq + 15;
#pragma unroll
        for (int ii = 0; ii < 4; ++ii) {
            dcb[ii] = 4 * min(max(dX + ii, 0), 30); dcb[4 + ii] = 4 * min(max(dX + 16 + ii, 0), 30);
            ciX[ii] = ((unsigned)(eX + ii) < 16u) ? -Mb : -1.0e30f; ciY[ii] = ((unsigned)(eX + 16 + ii) < 16u) ? -Mb : -1.0e30f; ciU[ii] = -Mb;
        }
    }
    bf16x8 Qf[2], Qn[2]; f32x4 acc[4]; float lsum = 0.f;
    int p = 0, u = 0, D = 0;
#define ATT_QLOAD(dst, uu) do { int b_, h_, rp_; ATT_DEC((uu) * G + c, b_, h_, rp_); const int qr_ = b_ * 4096 + (2 * rp_ + (wid >> 2)) * 64 + 16 * j + fr; \
        _Pragma("unroll") for (int kk = 0; kk < 2; ++kk) dst[kk] = *(const bf16x8*)(QK + (size_t)qr_ * 2048 + h_ * 64 + 32 * kk + 8 * g); } while (0)
#define ATT_TILE(t_, toff_) do { \
        const LAS bf16_t* Ks = (const LAS bf16_t*)(lds + RP_BYTES + slot * PAIR_B + (toff_)); \
        const LAS bf16_t* Vs = (const LAS bf16_t*)(lds + RP_BYTES + slot * PAIR_B + (toff_) + TILE_B); \
        if ((t_) < 9) { \
            const int kr = rs0 + (t_), i = kr - rsr; \
            if (i >= 0 && i < 8) attn_block<true>(Ks, Vs, w0, fr, g, Qf, acc, lsum, (const LAS unsigned char*)rp + (h * 465 + (kr - r + 7) * 31) * 4, dcb, ciX, ciY); \
        } else if ((t_) < 13) { \
            attn_block<false>(Ks, Vs, 0, fr, g, Qf, acc, lsum, (const LAS unsigned char*)rp, dcb, ciU, ciU); \
            attn_block<false>(Ks, Vs, 32, fr, g, Qf, acc, lsum, (const LAS unsigned char*)rp, dcb, ciU, ciU); \
        } } while (0)
    ATT_QLOAD(Qn, 0);
#define ATT_ITER(R) do { \
        const int slot = D & 1; \
        if (D + 1 < ND) ATT_LWRITE(slot ^ 1, R); \
        if (D + 3 < ND) ATT_GLOAD(D + 3, R); \
        if (p == 0) { \
            ATT_DEC(u * G + c, b, h, rpair); \
            r = 2 * rpair + (wid >> 2); rs0 = min(max(2 * rpair - 4, 0), 56); rsr = min(max(r - 4, 0), 56); \
            qrow = b * 4096 + r * 64 + 16 * j + fr; \
            Qf[0] = Qn[0]; Qf[1] = Qn[1]; \
            _Pragma("unroll") for (int db = 0; db < 4; ++db) acc[db] = (f32x4){0.f, 0.f, 0.f, 0.f}; \
            lsum = 0.f; \
        } \
        if (p == 4 && u + 1 < nunits) ATT_QLOAD(Qn, u + 1); \
        { const int i0_ = rs0 + 2 * p - rsr, i1_ = i0_ + 1; \
          if (2 * p + 1 < 9 && i0_ >= 0 && i1_ < 8) {        \
            const LAS bf16_t* Ka = (const LAS bf16_t*)(lds + RP_BYTES + slot * PAIR_B); const LAS bf16_t* Va = (const LAS bf16_t*)(lds + RP_BYTES + slot * PAIR_B + TILE_B); \
            const LAS bf16_t* Kb = (const LAS bf16_t*)(lds + RP_BYTES + slot * PAIR_B + 2 * TILE_B); const LAS bf16_t* Vb = (const LAS bf16_t*)(lds + RP_BYTES + slot * PAIR_B + 3 * TILE_B); \
            const LAS unsigned char* rb_ = (const LAS unsigned char*)rp + (h * 465 + (rs0 + 2 * p - r + 7) * 31) * 4; \
            attn_block<true>(Ka, Va, w0, fr, g, Qf, acc, lsum, rb_, dcb, ciX, ciY); \
            attn_block<true>(Kb, Vb, w0, fr, g, Qf, acc, lsum, rb_ + 124, dcb, ciX, ciY); \
          } else { ATT_TILE(2 * p, 0); ATT_TILE(2 * p + 1, 2 * TILE_B); } } \
        if (p == NPAIR - 1) { \
            float ls = lsum; ls += __shfl_xor(ls, 16); ls += __shfl_xor(ls, 32); \
            const float inv = 1.0f / ls; \
            bf16_t* op = O + (size_t)qrow * 1024 + h * 64 + 4 * g; \
            _Pragma("unroll") for (int db = 0; db < 4; ++db) { u32x2 w; w.x = cvt_pk_bf16(acc[db][0] * inv, acc[db][1] * inv); w.y = cvt_pk_bf16(acc[db][2] * inv, acc[db][3] * inv); st8(op + 16 * db, w); } \
            p = 0; ++u; \
        } else ++p; \
        __syncthreads(); \
    } while (0)
    for (;;) {
        ATT_ITER(R1); if (++D >= ND) break;
        ATT_ITER(R0); if (++D >= ND) break;
    }
#undef ATT_ITER
#undef ATT_TILE
#undef ATT_QLOAD
#undef ATT_DEC
#undef ATT_TOK
#undef ATT_GLOAD
#undef ATT_LWRITE
}

__device__ __forceinline__ void s1_phase(const bf16_t* Z0, const bf16_t* Dg, bf16_t* Z1, LAS unsigned char* lds, int gw, int NGW) {
    constexpr int DP = 136;
    LAS bf16_t* Dl = (LAS bf16_t*)lds;
    int tid = threadIdx.x; asm volatile("" : "+v"(tid));
    const int lane = tid & 63, fr = lane & 15, g = lane >> 4;
    for (int i = tid; i < 128 * 16; i += 512) { const int row = i >> 4, ch = i & 15; *(LAS u32x4*)(Dl + row * DP + ch * 8) = *(const u32x4*)(Dg + row * 128 + ch * 8); }
    __syncthreads();
    for (int colM = gw; colM < 4096; colM += NGW) {
        bf16x8 A[4][4];
#pragma unroll
        for (int ib = 0; ib < 4; ++ib)
#pragma unroll
            for (int kb = 0; kb < 4; ++kb) A[ib][kb] = *(const bf16x8*)(Z0 + ((size_t)colM * 64 + 16 * ib + fr) * 128 + 32 * kb + 8 * g);
#pragma unroll 2
        for (int jb = 0; jb < 8; ++jb) {
            bf16x8 Bf[4];
#pragma unroll
            for (int kb = 0; kb < 4; ++kb) Bf[kb] = *(const LAS bf16x8*)(Dl + (16 * jb + fr) * DP + 32 * kb + 8 * g);
            const int n = 16 * jb + fr, ka = n >> 1, rip = n & 1;
#pragma unroll
            for (int ib = 0; ib < 4; ++ib) {
                f32x4 a = (f32x4){0.f, 0.f, 0.f, 0.f};
#pragma unroll
                for (int kb = 0; kb < 4; ++kb) a = mfma16(A[ib][kb], Bf[kb], a);
                u32x2 w; w.x = cvt_pk_bf16(a[0], a[1]); w.y = cvt_pk_bf16(a[2], a[3]);
                st8(Z1 + (((size_t)ka * 4096 + colM) * 2 + rip) * 64 + 16 * ib + 4 * g, w);
            }
        }
    }
    __syncthreads();
}
__device__ __forceinline__ void s2_phase(const bf16_t* Z1, const bf16_t* Eg, bf16_t* F, int gw, int NGW, int lane) {
    const int fr = lane & 15, g = lane >> 4;
    for (int it = gw; it < 2048; it += NGW) {
        const int ka = it & 63, chunk = it >> 6;
        bf16x8 Bf[4][4];
#pragma unroll
        for (int jb = 0; jb < 4; ++jb)
#pragma unroll
            for (int kb = 0; kb < 4; ++kb) Bf[jb][kb] = *(const bf16x8*)(Eg + ((size_t)ka * 64 + 16 * jb + fr) * 128 + 32 * kb + 8 * g);
        for (int ib = 0; ib < 8; ++ib) {
            const int colM0 = chunk * 128 + ib * 16;
            bf16x8 A[4];
#pragma unroll
            for (int kb = 0; kb < 4; ++kb) A[kb] = *(const bf16x8*)(Z1 + ((size_t)ka * 4096 + colM0 + fr) * 128 + 32 * kb + 8 * g);
            const int cm = colM0 + 4 * g, b = cm >> 10, ch = cm & 1023;
#pragma unroll
            for (int jb = 0; jb < 4; ++jb) {
                f32x4 a = (f32x4){0.f, 0.f, 0.f, 0.f};
#pragma unroll
                for (int kb = 0; kb < 4; ++kb) a = mfma16(A[kb], Bf[jb][kb], a);
                const int kbk = 16 * jb + fr;
                u32x2 w; w.x = cvt_pk_bf16(a[0], a[1]); w.y = cvt_pk_bf16(a[2], a[3]);
                st8(F + ((size_t)b * 4096 + ka + 64 * kbk) * 1024 + ch, w);
            }
        }
    }
}


#ifndef MK_DEBUG
#define MK_DEBUG 0
#endif
__device__ __forceinline__ void dbg_scan16(const bf16_t* p, size_t n, unsigned* flags, unsigned bit, int gt, int NT) {
    bool bad = false; for (size_t i = gt; i < n; i += NT) bad |= ((p[i] & 0x7f80u) == 0x7f80u);
    if (bad) atomicOr(flags, 1u << bit);
}
__device__ __forceinline__ void dbg_scan32(const float* p, size_t n, unsigned* flags, unsigned bit, int gt, int NT) {
    bool bad = false; for (size_t i = gt; i < n; i += NT) bad |= ((__float_as_uint(p[i]) & 0x7f800000u) == 0x7f800000u);
    if (bad) atomicOr(flags, 1u << bit);
}
struct Args { const float* in[15]; float* out; unsigned char* ws; int ph_lo, ph_hi, use_cg, pad; };
static_assert(sizeof(Args) == 15 * 8 + 8 + 8 + 16, "no padding");

__global__ void __launch_bounds__(512, 2) fwd_kernel(Args args) {
    extern __shared__ __attribute__((aligned(16))) unsigned char lds_raw[];
    LAS unsigned char* lds = (LAS unsigned char*)lds_raw;
    const int G = gridDim.x, c = blockIdx.x;
    const int vcu = (G % 8 == 0) ? (c % 8) * (G / 8) + c / 8 : c;
    const int NGW = G * 8;
#define PHASE_IDS int tid_ = threadIdx.x; asm volatile("" : "+v"(tid_)); const int lane = tid_ & 63, wid = __builtin_amdgcn_readfirstlane(tid_ >> 6); const int gw = vcu * 8 + wid; (void)lane; (void)gw
    unsigned char* ws = args.ws;
    const float* x = args.in[0]; const float* cvec = args.in[1]; const float* ctx = args.in[2]; const float* cctx = args.in[3];
    const float* ada_w = args.in[4]; const float* ada_b = args.in[5]; const float* norm_g = args.in[6];
    const float* wqkv = args.in[7]; const float* wo = args.in[8]; const float* gq = args.in[9]; const float* gk = args.in[10]; const float* rpb = args.in[11];
    const float* fw = args.in[12]; const float* w1 = args.in[13]; const float* w2 = args.in[14];
    float* out = args.out;
    float* mods = (float*)(ws + WS_MODS); float* sbound = (float*)(ws + WS_SB);
    bf16_t* CS = (bf16_t*)(ws + WS_CS); bf16_t* Dt = (bf16_t*)(ws + WS_D); bf16_t* Et = (bf16_t*)(ws + WS_E);
    bf16_t* WQK = (bf16_t*)(ws + WS_WQK); bf16_t* WV = (bf16_t*)(ws + WS_WV); bf16_t* WO = (bf16_t*)(ws + WS_WO); bf16_t* FWt = (bf16_t*)(ws + WS_FW);
    bf16_t* W1t = (bf16_t*)(ws + WS_W1); bf16_t* W2t = (bf16_t*)(ws + WS_W2);
    bf16_t* H = (bf16_t*)(ws + WS_H); bf16_t* QK = (bf16_t*)(ws + WS_QK); bf16_t* VT = (bf16_t*)(ws + WS_VT); bf16_t* O = (bf16_t*)(ws + WS_O);
    bf16_t* XS = (bf16_t*)(ws + WS_XS); bf16_t* HMID = (bf16_t*)(ws + WS_HMID); bf16_t* Z0 = (bf16_t*)(ws + WS_Z0); bf16_t* Z1 = (bf16_t*)(ws + WS_Z1); bf16_t* Fb = (bf16_t*)(ws + WS_F);
    float* SSQ = (float*)(ws + WS_SSQ); float* BV0 = (float*)(ws + WS_BV); float* BV1 = BV0 + 4 * 4096; float* BVF = BV1 + 4 * 4096; float* GM = BVF + 16 * 512;
    const int lo = args.ph_lo, hi = args.ph_hi;
    cg::grid_group grid = cg::this_grid();
#define IN(k) (lo <= (k) && (k) < hi)
#ifndef REP_SYNC
#define REP_SYNC 1
#endif
#ifndef REP_NORM
#define REP_NORM 1
#endif
#ifndef REP_S12
#define REP_S12 1
#endif
#ifndef REP_P0
#define REP_P0 1
#endif
#ifndef USE_XB
#define USE_XB 1
#endif
#define SEAM(k) do { if (IN(k) && IN((k) + 1)) { for (int r_ = 0; r_ < REP_SYNC; ++r_) { if (use_cg) grid.sync(); else xcd_barrier(xbar); } } } while (0)
    { volatile LAS unsigned* st_ = (volatile LAS unsigned*)(lds + LDS_BYTES - 64); if (threadIdx.x < 2) st_[threadIdx.x] = 0u; __syncthreads(); }
    XcdBarrier xbar; xbar.bar = (unsigned*)(ws + WS_BAR); xbar.x = 0; xbar.st = (volatile LAS unsigned*)(lds + LDS_BYTES - 64);
    const bool use_cg = (args.use_cg != 0);
    if (!use_cg && hi - lo > 1) xbar = xcd_barrier_post((unsigned*)(ws + WS_BAR), (volatile LAS unsigned*)(lds + LDS_BYTES - 64));

    unsigned* dflags = (unsigned*)(ws + WS_SB + 256);
#define DBG16(k, bit, p, n) do { if (MK_DEBUG && IN(k)) { int t_ = threadIdx.x; asm volatile("" : "+v"(t_)); dbg_scan16(p, n, dflags, bit, (vcu * 512) + t_, G * 512); } } while (0)
#define DBG32(k, bit, p, n) do { if (MK_DEBUG && IN(k)) { int t_ = threadIdx.x; asm volatile("" : "+v"(t_)); dbg_scan32(p, n, dflags, bit, (vcu * 512) + t_, G * 512); } } while (0)
    if (IN(0)) {
        PHASE_IDS;
        if (MK_DEBUG && c == 0 && tid_ == 0) *dflags = 0u;
        for (int r0_ = 0; r0_ < REP_P0; ++r0_) {
        for (int u = c; u < 192; u += G) p0_mods_unit(cvec, cctx, ada_w, ada_b, mods, lds, u);
        __syncthreads();
        {
            LAS float* scr = (LAS float*)(lds + wid * 16384);
            constexpr int I_QKV = 16 * 96, I_SQ = 16 * 32, I_1 = 16 * 128, I_2 = 64 * 32;
            constexpr int NITEMS = I_QKV + I_SQ + 2 * I_1 + I_2;
            for (int it = NITEMS - 1 - gw; it >= 0; it -= NGW) {
                int r = it;
                if (r < I_QKV) { p0_transpose_item(wqkv, 1024, 3072, WQK, WV, 1, scr, r, lane); continue; } r -= I_QKV;
                if (r < I_SQ) { p0_transpose_item(wo, 1024, 1024, WO, nullptr, 0, scr, r, lane); continue; } r -= I_SQ;
                if (r < 2 * I_1) { const int l = r / I_1; p0_transpose_item(w1 + (size_t)l * 1024 * 4096, 1024, 4096, W1t + (size_t)l * 4096 * 1024, nullptr, 0, scr, r % I_1, lane); continue; } r -= 2 * I_1;
                p0_transpose_item(w2, 4096, 1024, W2t, nullptr, 0, scr, r, lane);
            }
        }
        {
            const int gt = gw * 64 + lane, NT = NGW * 64;
            for (int i = gt; i < 512 * 256; i += NT) { const int m = i >> 8, cc = i & 255, ri = m >> 8, k2 = m & 255; float sn, cs; sincospif(2.0f * (float)((cc * k2) & 255) / 256.0f, &sn, &cs);
                const float v = (ri == 0 ? cs : -sn) * (1.0f / 16.0f); CS[i] = (bf16_t)(cvt_pk_bf16(v, 0.f) & 0xffffu); }
            for (int i = gt; i < 128 * 128; i += NT) { const int n = i >> 7, kp = i & 127, ka = n >> 1, rip = n & 1, ri = kp >> 6, a = kp & 63; float sn, cs; sincospif(2.0f * (float)((a * ka) & 63) / 64.0f, &sn, &cs);
                const float v = (rip == 0 ? (ri == 0 ? cs : sn) : (ri == 0 ? -sn : cs)) * 0.125f; Dt[i] = (bf16_t)(cvt_pk_bf16(v, 0.f) & 0xffffu); }
            for (int i = gt; i < 64 * 64 * 128; i += NT) { const int kp = i & 127, kbk = (i >> 7) & 63, ka = i >> 13, rip = kp >> 6, bp = kp & 63; float sn, cs; sincospif(2.0f * (float)((bp * (ka + 64 * kbk)) & 4095) / 4096.0f, &sn, &cs);
                const float v = (rip == 0 ? cs : sn) * 0.125f; Et[i] = (bf16_t)(cvt_pk_bf16(v, 0.f) & 0xffffu); }
        }
        if (c == G - 1 && wid == 7) {
            float mq = fabsf(gq[lane]), mk = fabsf(gk[lane]), mr = 0.f;
            for (int i = lane; i < 16 * 465; i += 64) mr = fmaxf(mr, fabsf(rpb[i]));
#pragma unroll
            for (int o = 1; o < 64; o <<= 1) { mq = fmaxf(mq, __shfl_xor(mq, o)); mk = fmaxf(mk, __shfl_xor(mk, o)); mr = fmaxf(mr, __shfl_xor(mr, o)); }
            if (lane == 0) *sbound = (8.0f * mq * mk + mr) * LOG2E;
        }
        __syncthreads();
        }
    }
    SEAM(0);
    const bool ctx_in_p1 = false;
    if (IN(1)) { PHASE_IDS;
        if (c == G - 1) {
            for (int i = tid_; i < 3 * 4096; i += 512) { const int idx = i >> 12, b = (i >> 10) & 3, col = i & 1023;
                const float gg = norm_g[(idx == 0 ? 1024 : idx == 1 ? 2048 : 3072) + col];
                const float sc = mods[(size_t)((idx == 0 ? 0 : 5) + b) * 6144 + (idx == 1 ? 1024 : 4096) + col];
                GM[i] = gg * (1.0f + sc); }
        }
        if (!ctx_in_p1) norm_rows(x, ctx, MT, norm_g, mods, 0, 1024, H, gw, NGW, lane);
        else if (c >= 32) norm_rows(x, ctx, ML, norm_g, mods, 0, 1024, H, (c - 32) * 8 + wid, (G - 32) * 8, lane);
        else {
            pg8::SchedOne S1u; const size_t ts = (size_t)256 * 1024 * 2; int tt;
            if (c < 16) { S1u.u.kind = 0; S1u.u.pm = 64 + (c & 3); S1u.u.pn = 4 + (c >> 2); tt = c & 3; S1u.u.a = (const char*)H + (size_t)S1u.u.pm * ts; S1u.u.b = (const char*)WQK + (size_t)S1u.u.pn * ts; }
            else { const int l2 = c - 16; S1u.u.kind = 1; S1u.u.pm = l2 & 3; S1u.u.pn = 64 + (l2 >> 2); tt = l2 >> 2; S1u.u.a = (const char*)WV + (size_t)S1u.u.pm * ts; S1u.u.b = (const char*)H + (size_t)S1u.u.pn * ts; }
            S1u.u.aux = 0;
            norm_rows(x, ctx, ML + tt * 256 + 256, norm_g, mods, 0, 1024, H, ML + tt * 256 + wid, 8, lane);
            asm volatile("s_waitcnt vmcnt(0)" ::: "memory"); __syncthreads();
            pg8::EpiQKV E{QK, VT, gq, gk};
            pg8::gemm_phase<pg8::EpiQKV, pg8::SchedOne, false>(lds, 1024, 1024, 1024, S1u, E);
        }
    }
    SEAM(1);
    DBG16(2, 0, H, (size_t)MT * 1024);
    if (IN(2)) { pg8::SchedQKV S{(const char*)H, (const char*)WQK, (const char*)WV, G, c, ctx_in_p1 ? 768 : 800}; pg8::EpiQKV E{QK, VT, gq, gk};
#ifndef REP_G2
#define REP_G2 1
#endif
        for (int r_ = 0; r_ < REP_G2; ++r_) pg8::gemm_phase<pg8::EpiQKV, pg8::SchedQKV, false>(lds, 1024, 1024, 1024, S, E);
        { PHASE_IDS;
          const bool part = (G > 32); const int w_ = part ? (c - 32) * 8 + wid : gw, nw_ = part ? (G - 32) * 8 : NGW;
          if (!part || c >= 32) {
              bias_items(W1t, CS, mods, BV0, BV1, BVF, w_, nw_, lane);
              LAS float* scr = (LAS float*)(lds + wid * 16384);
              constexpr int I_SQ = 16 * 32, I_2 = 64 * 32;
              for (int it = w_; it < I_SQ + I_2; it += nw_) {
                  if (it < I_SQ) p0_transpose_item(fw, 1024, 1024, FWt, nullptr, 0, scr, it, lane);
                  else p0_transpose_item(w2 + (size_t)4096 * 1024, 4096, 1024, W2t + (size_t)1024 * 4096, nullptr, 0, scr, it - I_SQ, lane);
              }
          } } }
    SEAM(2);
    DBG16(3, 1, QK, (size_t)ML * 2048); DBG16(3, 2, VT, (size_t)1024 * MT); DBG32(3, 13, mods, (size_t)10 * 6144);
#ifndef REP_ATT
#define REP_ATT 1
#endif
    if (IN(3)) { for (int rep = 0; rep < REP_ATT; ++rep) attn_phase(QK, VT, O, rpb, sbound, lds, G, c); }
    SEAM(3);
    DBG16(4, 3, O, (size_t)ML * 1024);
    if (IN(4)) { pg8::SchedStd S; S.init(O, WO, ML, 1024, 1024, 1024, G, c); pg8::EpiResF<false> E{x, XS, mods + 2048, GM, H, SSQ};
        pg8::gemm_phase<pg8::EpiResF<false>, pg8::SchedStd, false>(lds, 1024, 1024, 1024, S, E); }
    SEAM(4);
    DBG32(5, 4, out, (size_t)ML * 1024);
    if (IN(6)) { pg8::SchedStd S; S.init(H, W1t, ML, 4096, 1024, 1024, G, c); pg8::EpiRelu2F E{HMID, 4096, BV0, SSQ};
        pg8::gemm_phase<pg8::EpiRelu2F, pg8::SchedStd, false>(lds, 1024, 1024, 1024, S, E); }
    SEAM(6);
    DBG16(7, 5, HMID, (size_t)ML * 4096);
    if (IN(7)) { pg8::SchedStd S; S.init(HMID, W2t, ML, 1024, 64, 4096, G, c, (size_t)64 * 32768); pg8::EpiResF<true> E{XS, XS, mods + 5120, GM + 4096, H, SSQ};
        pg8::gemm_phase<pg8::EpiResF<true>, pg8::SchedStd, false>(lds, 4096, 64, 4096, S, E, 32768, 128); }
    SEAM(7);
    const float* mods1 = mods + 5 * 6144;
    DBG32(8, 6, out, (size_t)ML * 1024);
    if (IN(9)) { pg8::SchedF1 S{(const char*)CS, (const char*)H, G, c}; pg8::EpiZ0F E{Z0, BVF, SSQ};
        pg8::gemm_phase<pg8::EpiZ0F, pg8::SchedF1, true>(lds, 256, 256, 1024, S, E); }
    SEAM(9);
    DBG16(10, 7, Z0, (size_t)262144 * 128);
    if (IN(10)) { PHASE_IDS; for (int r_ = 0; r_ < REP_S12; ++r_) s1_phase(Z0, Dt, Z1, lds, gw, NGW); }
    SEAM(10);
    DBG16(11, 8, Z1, (size_t)262144 * 128);
    if (IN(11)) { PHASE_IDS; for (int r_ = 0; r_ < REP_S12; ++r_) s2_phase(Z1, Et, Fb, gw, NGW, lane); }
    SEAM(11);
    DBG16(12, 9, Fb, (size_t)ML * 1024);
    if (IN(12)) { pg8::SchedStd S; S.init(Fb, FWt, ML, 1024, 1024, 1024, G, c); pg8::EpiResF<true> E{XS, XS, mods1 + 2048, GM + 8192, H, SSQ};
        pg8::gemm_phase<pg8::EpiResF<true>, pg8::SchedStd, false>(lds, 1024, 1024, 1024, S, E); }
    SEAM(12);
    DBG32(13, 10, out, (size_t)ML * 1024);
    if (IN(14)) { pg8::SchedStd S; S.init(H, W1t + (size_t)4096 * 1024, ML, 4096, 1024, 1024, G, c); pg8::EpiRelu2F E{HMID, 4096, BV1, SSQ};
        pg8::gemm_phase<pg8::EpiRelu2F, pg8::SchedStd, false>(lds, 1024, 1024, 1024, S, E); }
    SEAM(14);
    DBG16(15, 11, HMID, (size_t)ML * 4096);
    if (IN(15)) { pg8::SchedStd S; S.init(HMID, W2t + (size_t)1024 * 4096, ML, 1024, 64, 4096, G, c, (size_t)64 * 32768); pg8::EpiRes E{XS, out, mods1 + 5120};
        pg8::gemm_phase<pg8::EpiRes, pg8::SchedStd, false>(lds, 4096, 64, 4096, S, E, 32768, 128); }
    SEAM(15);
    if (MK_DEBUG && IN(16)) {
        int t_ = threadIdx.x; asm volatile("" : "+v"(t_));
        bool bad = false;
        for (size_t i = (size_t)vcu * 512 + t_; i < (size_t)ML * 1024; i += (size_t)G * 512) { if ((__float_as_uint(out[i]) & 0x7f800000u) == 0x7f800000u) { bad = true; out[i] = 0.f; } }
        if (bad) atomicOr(dflags, 1u << 12);
    }
    SEAM(16);
    if (MK_DEBUG && IN(17)) {
        if (c == 0 && threadIdx.x == 0) { const unsigned f = *dflags; if (f) out[0] = 1.0e6f * (float)(__builtin_ctz(f) + 1) + 1.0e4f * (float)__builtin_popcount(f); }
    }
#undef IN
#undef SEAM
}

constexpr int NPHASE = MK_DEBUG ? 18 : 16;
#ifndef MK_USE_CG
#define MK_USE_CG 0
#endif
#ifndef MK_PER_PHASE
#define MK_PER_PHASE 0
#endif

extern "C" void kernel_launch(void* const* d_in, const int* in_sizes, int n_in, void* d_out, int out_size, void* d_ws, size_t ws_size, hipStream_t stream) {
    static int grid = 0;
    if (grid == 0) {
        if (n_in != 15 || out_size != ML * DM || ws_size < WS_END) { fprintf(stderr, "kernel_launch: unexpected shapes (n_in %d out %d ws %zu)\n", n_in, out_size, ws_size); grid = -1; return; }
        int dev = 0, cus = 0, per_cu = 0;
        hipGetDevice(&dev); hipDeviceGetAttribute(&cus, hipDeviceAttributeMultiprocessorCount, dev);
        hipFuncSetAttribute((const void*)fwd_kernel, hipFuncAttributeMaxDynamicSharedMemorySize, LDS_BYTES);
        if (hipOccupancyMaxActiveBlocksPerMultiprocessor(&per_cu, (const void*)fwd_kernel, 512, LDS_BYTES) != hipSuccess || per_cu < 1) { fprintf(stderr, "kernel_launch: occupancy query failed (%d)\n", per_cu); (void)hipGetLastError(); per_cu = 1; }
        grid = cus * 1;
        if (grid <= 0) grid = 256;
    }
    if (grid < 0) return;
    if (hipMemsetAsync((char*)d_ws + WS_BAR, 0, BAR_BYTES, stream) != hipSuccess) { fprintf(stderr, "kernel_launch: memset failed\n"); return; }
    Args a{};
    for (int i = 0; i < 15; ++i) a.in[i] = (const float*)d_in[i];
    a.out = (float*)d_out; a.ws = (unsigned char*)d_ws;
#if MK_PER_PHASE
    for (int p = 0; p < NPHASE; ++p) { a.ph_lo = p; a.ph_hi = p + 1; hipLaunchKernelGGL(fwd_kernel, dim3(grid), dim3(512), LDS_BYTES, stream, a); }
#else
    a.ph_lo = 0; a.ph_hi = NPHASE; a.use_cg = MK_USE_CG;
    void* kargs[] = {&a};
    hipError_t e = hipLaunchCooperativeKernel((const void*)fwd_kernel, dim3(grid), dim3(512), kargs, LDS_BYTES, stream);
    if (e != hipSuccess) fprintf(stderr, "cooperative launch failed: %s (grid %d)\n", hipGetErrorString(e), grid);
#endif
}
```

```cpp
#include <hip/hip_runtime.h>
#include <hip/hip_cooperative_groups.h>
#include <cstdio>
#include <cstdint>
namespace cg = cooperative_groups;

#define LAS __attribute__((address_space(3)))
typedef unsigned short bf16_t;
typedef short bf16x8 __attribute__((ext_vector_type(8)));
typedef short s16x4 __attribute__((ext_vector_type(4)));
typedef float f32x4 __attribute__((ext_vector_type(4)));
typedef unsigned u32x4 __attribute__((ext_vector_type(4)));
typedef unsigned u32x2 __attribute__((ext_vector_type(2)));

constexpr int DM = 1024, NB = 4, SEQ = 4096, CTXL = 256, FF = 4096;
constexpr int ML = NB * SEQ;
constexpr int MT = ML + NB * CTXL;
constexpr float LOG2E = 1.4426950408889634f;
constexpr float EPS = 1e-6f;

constexpr size_t MiB = 1u << 20;
constexpr size_t WS_MODS = 0;
constexpr size_t WS_SB = 512 * 1024;
constexpr size_t WS_BAR = 1 * MiB;
constexpr size_t BAR_BYTES = 16384;
constexpr size_t WS_CS = 2 * MiB;
constexpr size_t WS_D = 2 * MiB + 512 * 1024;
constexpr size_t WS_E = 3 * MiB;
constexpr size_t WS_WQK = 4 * MiB, WS_WV = 8 * MiB, WS_WO = 10 * MiB, WS_FW = 12 * MiB;
constexpr size_t WS_W1 = 14 * MiB;
constexpr size_t WS_W2 = 30 * MiB;
constexpr size_t WS_SSQ = 46 * MiB;
constexpr size_t WS_BV = 47 * MiB;
constexpr size_t WS_H = 48 * MiB;
constexpr size_t WS_R = 82 * MiB;
constexpr size_t WS_QK = WS_R;
constexpr size_t WS_VT = WS_R + 68 * MiB;
constexpr size_t WS_O = WS_R + 102 * MiB;
constexpr size_t WS_HMID = WS_R;
constexpr size_t WS_Z0 = WS_R;
constexpr size_t WS_Z1 = WS_R + 64 * MiB;
constexpr size_t WS_F = WS_R;
constexpr size_t WS_XS = WS_R + 134 * MiB;
constexpr size_t WS_END = 256 * MiB;
static_assert(WS_XS + 32 * MiB <= WS_END && WS_O + 32 * MiB <= WS_XS && WS_F + 32 * MiB <= WS_END && WS_HMID + 128 * MiB <= WS_END && WS_O + 32 * MiB <= WS_END, "ws map");

constexpr int LDS_BYTES = 147456;

typedef __bf16 bf16v2_t __attribute__((ext_vector_type(2)));
typedef float f32v2_t __attribute__((ext_vector_type(2)));
__device__ __forceinline__ unsigned cvt_pk_bf16(float lo, float hi) { const f32v2_t v = {lo, hi}; const bf16v2_t r = __builtin_convertvector(v, bf16v2_t); return __builtin_bit_cast(unsigned, r); }
__device__ __forceinline__ f32x4 mfma16(bf16x8 a, bf16x8 b, f32x4 c) { return __builtin_amdgcn_mfma_f32_16x16x32_bf16(a, b, c, 0, 0, 0); }


#ifndef MK_WT
#define MK_WT 0
#endif
__device__ __forceinline__ void st16(void* p, u32x4 v) {
#if MK_WT
    asm volatile("global_store_dwordx4 %0, %1, off sc1\n\ts_nop 1" :: "v"(p), "v"(v) : "memory");
#else
    *(u32x4*)p = v;
#endif
}
__device__ __forceinline__ void st16f(void* p, f32x4 v) {
#if MK_WT
    asm volatile("global_store_dwordx4 %0, %1, off sc1\n\ts_nop 1" :: "v"(p), "v"(v) : "memory");
#else
    *(f32x4*)p = v;
#endif
}
__device__ __forceinline__ void st8(void* p, u32x2 v) {
#if MK_WT
    asm volatile("global_store_dwordx2 %0, %1, off sc1\n\ts_nop 1" :: "v"(p), "v"(v) : "memory");
#else
    *(u32x2*)p = v;
#endif
}
namespace pg8 {
constexpr int BM = 256, BK = 64, HALF = 128, HTB = HALF * BK * 2, STAGE_BYTES = 8 * HTB;
__device__ __forceinline__ int lds_byte(int r, int c) { const int st = (r >> 4) * 2 + (c >> 5), rr = r & 15, cc = c & 31, ob = rr * 64 + cc * 2; return st * 1024 + (ob ^ (((ob >> 9) & 1) << 5)); }
__device__ __forceinline__ void stage_rc(int b, int& R, int& C) { const int st = b / 1024, sb = b % 1024, swz = sb ^ (((sb >> 9) & 1) << 5); R = (st >> 1) * 16 + swz / 64; C = (st & 1) * 32 + (swz % 64) / 2; }
__device__ __forceinline__ int perm32(int rho) { const int n = rho >> 4, i = rho & 15; return 8 * (i >> 2) + 4 * n + (i & 3); }

struct Unit { int pm, pn, kind, aux; const char* a; const char* b; };

template <class Epi, class Sched, bool BMAP>
__device__ __forceinline__ void gemm_phase(LAS unsigned char* lds, const int K, const int lda, const int ldb, const Sched& S, const Epi& E, const size_t kstepA = 128, const size_t kstepB = 128) {
    int tid = threadIdx.x; asm volatile("" : "+v"(tid));
    const int wid = __builtin_amdgcn_readfirstlane(tid >> 6), lane = tid & 63, wr = wid >> 2, wc = wid & 3, fr = lane & 15, fq = lane >> 4;
    int nt = K / BK; asm volatile("" : "+s"(nt));
    unsigned voffA[2], voffB[2];
#pragma unroll
    for (int i = 0; i < 2; ++i) { int R, C; stage_rc(tid * 16 + i * 8192, R, C); const int Rb = (R & ~31) + perm32(R & 31);
        voffA[i] = (unsigned)(R * lda + C) * 2u;
        voffB[i] = BMAP ? (unsigned)((64 * (Rb & 63) + (Rb >> 6)) * ldb + C) * 2u : (unsigned)(Rb * ldb + C) * 2u; }
    const size_t hstepA = (size_t)HALF * lda * 2;
    const size_t hstepB = BMAP ? (size_t)2 * ldb * 2 : (size_t)HALF * ldb * 2;
    const unsigned ldsw = (unsigned)wid * 1024u;
    const int aoff = lds_byte(wr * 64 + fr, fq * 8), boff = lds_byte(wc * 32 + fr, fq * 8);
#define PG8_SA(b, h) (((b) * 2 + (h)) * HTB)
#define PG8_SB(b, h) ((4 + (b) * 2 + (h)) * HTB)
#define PG8_STAGE(bufoff, gbase, voff) do { _Pragma("unroll") for (int _i = 0; _i < 2; ++_i) \
        __builtin_amdgcn_global_load_lds((const unsigned*)((const char*)(gbase) + (voff)[_i]), (LAS unsigned*)(lds + (bufoff) + ldsw + _i * 8192), 16, 0, 0); } while (0)
#define PG8_LDA(dst, b, h) do { _Pragma("unroll") for (int m = 0; m < 4; ++m) _Pragma("unroll") for (int k = 0; k < 2; ++k) dst[m][k] = *(const LAS bf16x8*)(lds + PG8_SA(b, h) + aoff + m * 2048 + k * 1024); } while (0)
#define PG8_LDB(dst, b, h) do { _Pragma("unroll") for (int n = 0; n < 2; ++n) _Pragma("unroll") for (int k = 0; k < 2; ++k) dst[n][k] = *(const LAS bf16x8*)(lds + PG8_SB(b, h) + boff + n * 2048 + k * 1024); } while (0)
#define PG8_MMA(ai, bj, At, Bt) do { __builtin_amdgcn_s_setprio(1); _Pragma("unroll") for (int m = 0; m < 4; ++m) _Pragma("unroll") for (int n = 0; n < 2; ++n) _Pragma("unroll") for (int k = 0; k < 2; ++k) \
        acc[ai][bj][m][n] = __builtin_amdgcn_mfma_f32_16x16x32_bf16(Bt[n][k], At[m][k], acc[ai][bj][m][n], 0, 0, 0); __builtin_amdgcn_s_setprio(0); } while (0)
#define PG8_WAIT_V(n) asm volatile("s_waitcnt vmcnt(" #n ")" ::: "memory")
#define PG8_WAIT_L(n) asm volatile("s_waitcnt lgkmcnt(" #n ")" ::: "memory")
#define PG8_BAR __builtin_amdgcn_s_barrier()
#define PG8_SCHED __builtin_amdgcn_sched_barrier(0)
    Unit cur, nxt; int ui = 0;
    if (!S.next(0, cur)) return;
    f32x4 acc[2][2][4][2];
#pragma unroll
    for (int a = 0; a < 2; ++a)
#pragma unroll
        for (int b = 0; b < 2; ++b)
#pragma unroll
            for (int m = 0; m < 4; ++m)
#pragma unroll
                for (int n = 0; n < 2; ++n) acc[a][b][m][n] = (f32x4){0.f, 0.f, 0.f, 0.f};
    bf16x8 At[4][2], B0[2][2], B1[2][2];
    const char* cA = cur.a; const char* cB = cur.b;
    if constexpr (Epi::PREP) E.prep(cur, lds, 0, tid);
    PG8_STAGE(PG8_SB(0, 0), cB, voffB); PG8_STAGE(PG8_SB(0, 1), cB + hstepB, voffB); PG8_STAGE(PG8_SA(0, 0), cA, voffA); PG8_STAGE(PG8_SA(0, 1), cA + hstepA, voffA);
    if (wr == 1) PG8_BAR;
    PG8_WAIT_V(2); PG8_BAR;
    PG8_STAGE(PG8_SB(1, 0), cB + kstepB, voffB); PG8_STAGE(PG8_SA(1, 0), cA + kstepA, voffA); PG8_STAGE(PG8_SB(1, 1), cB + hstepB + kstepB, voffB);
    PG8_WAIT_V(6); PG8_BAR;
    for (;;) {
        const bool has_next = S.next(ui + 1, nxt);
        const char* nA = has_next ? nxt.a : cA; const char* nB = has_next ? nxt.b : cB;
        for (int t = 0; t < nt; t += 2) {
            const bool last = (t == nt - 2);
            const char* a1 = cA + (size_t)(t + 1) * kstepA;
            const char* a2 = last ? nA : cA + (size_t)(t + 2) * kstepA; const char* b2 = last ? nB : cB + (size_t)(t + 2) * kstepB;
            const char* a3 = a2 + kstepA; const char* b3 = b2 + kstepB;
            PG8_LDB(B0, 0, 0); PG8_LDB(B1, 0, 1); PG8_SCHED; PG8_LDA(At, 0, 0); PG8_STAGE(PG8_SA(1, 1), a1 + hstepA, voffA);
            PG8_WAIT_V(8); PG8_WAIT_L(0); PG8_BAR; PG8_MMA(0, 0, At, B0); PG8_MMA(0, 1, At, B1); PG8_BAR; PG8_SCHED;
            PG8_LDA(At, 0, 1); PG8_STAGE(PG8_SB(0, 0), b2, voffB); PG8_STAGE(PG8_SB(0, 1), b2 + hstepB, voffB); PG8_STAGE(PG8_SA(0, 0), a2, voffA);
            PG8_WAIT_V(8); PG8_WAIT_L(0); PG8_BAR; PG8_MMA(1, 0, At, B0); PG8_MMA(1, 1, At, B1); PG8_BAR; PG8_SCHED;
            PG8_LDB(B0, 1, 0); PG8_LDB(B1, 1, 1); PG8_SCHED; PG8_LDA(At, 1, 0); PG8_STAGE(PG8_SA(0, 1), a2 + hstepA, voffA);
            PG8_WAIT_V(8); PG8_WAIT_L(0); PG8_BAR; PG8_MMA(0, 0, At, B0); PG8_MMA(0, 1, At, B1); PG8_BAR; PG8_SCHED;
            PG8_LDA(At, 1, 1); PG8_STAGE(PG8_SB(1, 0), b3, voffB); PG8_STAGE(PG8_SB(1, 1), b3 + hstepB, voffB); PG8_STAGE(PG8_SA(1, 0), a3, voffA);
            PG8_WAIT_V(8); PG8_WAIT_L(0); PG8_BAR; PG8_MMA(1, 0, At, B0); PG8_MMA(1, 1, At, B1); PG8_BAR; PG8_SCHED;
        }
        if (wr == 0) PG8_BAR;
        if constexpr (Epi::PREP) { if (has_next) E.prep(nxt, lds, (ui + 1) & 1, tid); }
        E(acc, cur, wr, wc, fr, fq, lds, ui & 1);
        if (!has_next) break;
#pragma unroll
        for (int a = 0; a < 2; ++a)
#pragma unroll
            for (int b = 0; b < 2; ++b)
#pragma unroll
                for (int m = 0; m < 4; ++m)
#pragma unroll
                    for (int n = 0; n < 2; ++n) acc[a][b][m][n] = (f32x4){0.f, 0.f, 0.f, 0.f};
        cur = nxt; cA = nA; cB = nB; ++ui;
        if (wr == 1) PG8_BAR;
    }
    PG8_WAIT_V(0);
    PG8_BAR;
#undef PG8_SA
#undef PG8_SB
#undef PG8_STAGE
#undef PG8_LDA
#undef PG8_LDB
#undef PG8_MMA
#undef PG8_WAIT_V
#undef PG8_WAIT_L
#undef PG8_BAR
#undef PG8_SCHED
}

struct SchedStd {
    const char* A; const char* Bt; size_t tsA, tsB; int nM, nN, nwg, G, c;
    __device__ void init(const void* A_, const void* Bt_, int M, int N, int lda, int ldb, int G_, int c_, size_t tsA_ = 0) { A = (const char*)A_; Bt = (const char*)Bt_; tsA = tsA_ ? tsA_ : (size_t)BM * lda * 2; tsB = (size_t)BM * ldb * 2; nM = M / BM; nN = N / BM; nwg = nM * nN; G = G_; c = c_; }
    __device__ bool next(int i, Unit& u) const {
        const long L = (long)i * G + c; if (L >= nwg) return false;
        int wgid = (int)L; { const int q = nwg / 8, r = nwg % 8, xcd = wgid % 8, off = wgid / 8; wgid = (xcd < r ? xcd * (q + 1) : r * (q + 1) + (xcd - r) * q) + off; }
        const int nig = 8 * nN, gid = wgid / nig, fm = gid * 8, gsz = (nM - fm) < 8 ? (nM - fm) : 8;
        u.pm = fm + ((wgid % nig) % gsz); u.pn = (wgid % nig) / gsz; u.kind = 0; u.aux = 0;
        u.a = A + (size_t)u.pm * tsA; u.b = Bt + (size_t)u.pn * tsB; return true;
    }
};
struct SchedQKV {
    const char* H; const char* Wqk; const char* Wv; int G, c, nunits;
    __device__ bool next(int i, Unit& u) const {
        const long Ll = (long)i * G + c; if (Ll >= nunits) return false;
        const int L = (int)Ll; const size_t ts = (size_t)BM * 1024 * 2; u.aux = 0;
        if (L < 512) { const int x = L & 7, off = L >> 3; u.kind = 0; u.pm = 8 * x + (off & 7); u.pn = off >> 3; }
        else if (L < 768) { const int l2 = L - 512, x = l2 & 7, off = l2 >> 3; u.kind = 1; u.pm = off & 3; u.pn = 8 * x + (off >> 2); }
        else if (L < 784) { const int l2 = L - 768; u.kind = 0; u.pm = 64 + (l2 & 3); u.pn = 4 + (l2 >> 2); }
        else { const int l2 = L - 784; u.kind = 1; u.pm = l2 & 3; u.pn = 64 + (l2 >> 2); }
        if (u.kind == 0) { u.a = H + (size_t)u.pm * ts; u.b = Wqk + (size_t)u.pn * ts; }
        else { u.a = Wv + (size_t)u.pm * ts; u.b = H + (size_t)u.pn * ts; }
        return true;
    }
};
struct SchedOne { Unit u;
    __device__ __forceinline__ bool next(int i, Unit& o) const { if (i > 0) return false; o = u; return true; }
};
struct SchedF1 {
    const char* CS; const char* H; int G, c;
    __device__ bool next(int i, Unit& u) const {
        const long Ll = (long)i * G + c; if (Ll >= 256) return false;
        const int L = (int)Ll; const int t = L & 15, b = (L >> 4) & 3, g = (L >> 6) & 3;
        u.pm = 0; u.pn = t; u.kind = g; u.aux = b;
        u.a = CS; u.b = H + ((size_t)(b * 4096 + 4 * t) * 1024 + g * 256) * 2; return true;
    }
};

typedef f32x4 Acc[2][2][4][2];
__device__ __forceinline__ u32x4 pack8(f32x4 v0, f32x4 v1) { u32x4 w; w.x = cvt_pk_bf16(v0[0], v0[1]); w.y = cvt_pk_bf16(v0[2], v0[3]); w.z = cvt_pk_bf16(v1[0], v1[1]); w.w = cvt_pk_bf16(v1[2], v1[3]); return w; }

__device__ __forceinline__ void unpack8(u32x4 w, f32x4& v0, f32x4& v1) {
    v0[0] = __uint_as_float(w.x << 16); v0[1] = __uint_as_float(w.x & 0xffff0000u); v0[2] = __uint_as_float(w.y << 16); v0[3] = __uint_as_float(w.y & 0xffff0000u);
    v1[0] = __uint_as_float(w.z << 16); v1[1] = __uint_as_float(w.z & 0xffff0000u); v1[2] = __uint_as_float(w.w << 16); v1[3] = __uint_as_float(w.w & 0xffff0000u);
}
struct EpiQKV { static constexpr bool PREP = true; bf16_t* QK; bf16_t* VT; const float* gq; const float* gk;
    __device__ __forceinline__ void prep(const Unit& u, LAS unsigned char* lds, int slot, int tid) const {
        if (u.kind == 0 && tid < 64) { const bool isq = u.pn < 4; ((LAS float*)(lds + 131072))[slot * 512 + tid] = isq ? gq[tid] * (0.125f * LOG2E) : gk[tid]; }
    }
    __device__ __forceinline__ void operator()(const Acc& acc, const Unit& u, int wr, int wc, int fr, int fq, LAS unsigned char* lds, int slot) const {
        if (u.kind == 0) {
            const LAS float* gp = (const LAS float*)(lds + 131072) + slot * 512;
            f32x4 gv[2][2];
#pragma unroll
            for (int bj = 0; bj < 2; ++bj)
#pragma unroll
                for (int n = 0; n < 2; ++n) gv[bj][n] = *(const LAS f32x4*)(gp + 32 * bj + 8 * fq + 4 * n);
#pragma unroll
            for (int ai = 0; ai < 2; ++ai)
#pragma unroll
                for (int m = 0; m < 4; ++m) {
                    const int row = u.pm * BM + ai * HALF + wr * 64 + m * 16 + fr;
                    float ss = 0.f;
#pragma unroll
                    for (int bj = 0; bj < 2; ++bj)
#pragma unroll
                        for (int n = 0; n < 2; ++n) { const f32x4 x = acc[ai][bj][m][n]; ss += (x[0] * x[0] + x[1] * x[1]) + (x[2] * x[2] + x[3] * x[3]); }
                    ss += __shfl_xor(ss, 16); ss += __shfl_xor(ss, 32);
                    const float rstd = rsqrtf(ss * (1.0f / 64.0f) + EPS);
                    bf16_t* rowp = QK + (size_t)row * 2048 + u.pn * 256 + wc * 64 + 8 * fq;
#pragma unroll
                    for (int bj = 0; bj < 2; ++bj) st16(rowp + 32 * bj, pack8(acc[ai][bj][m][0] * rstd * gv[bj][0], acc[ai][bj][m][1] * rstd * gv[bj][1]));
                }
        } else {
#pragma unroll
            for (int ai = 0; ai < 2; ++ai)
#pragma unroll
                for (int m = 0; m < 4; ++m) {
                    const int row = u.pm * BM + ai * HALF + wr * 64 + m * 16 + fr;
                    bf16_t* rowp = VT + (size_t)row * MT + u.pn * 256 + wc * 32 + 8 * fq;
#pragma unroll
                    for (int bj = 0; bj < 2; ++bj) st16(rowp + bj * HALF, pack8(acc[ai][bj][m][0], acc[ai][bj][m][1]));
                }
        }
    }
};
struct EpiRelu2 { static constexpr bool PREP = false; bf16_t* O; int ldc;
    __device__ __forceinline__ void operator()(const Acc& acc, const Unit& u, int wr, int wc, int fr, int fq, LAS unsigned char*, int) const {
#pragma unroll
        for (int ai = 0; ai < 2; ++ai)
#pragma unroll
            for (int m = 0; m < 4; ++m) {
                const int row = u.pm * BM + ai * HALF + wr * 64 + m * 16 + fr;
                bf16_t* rowp = O + (size_t)row * ldc + u.pn * 256 + wc * 32 + 8 * fq;
#pragma unroll
                for (int bj = 0; bj < 2; ++bj) { f32x4 v0 = acc[ai][bj][m][0], v1 = acc[ai][bj][m][1];
#pragma unroll
                    for (int e = 0; e < 4; ++e) { const float a = fmaxf(v0[e], 0.f), b = fmaxf(v1[e], 0.f); v0[e] = a * a; v1[e] = b * b; }
                    *(u32x4*)(rowp + bj * HALF) = pack8(v0, v1); }
            }
    }
};
struct EpiRes { static constexpr bool PREP = false; const bf16_t* base; float* out; const float* gate;
    __device__ __forceinline__ void operator()(const Acc& acc, const Unit& u, int wr, int wc, int fr, int fq, LAS unsigned char*, int) const {
        const int col0 = u.pn * 256 + wc * 32 + 8 * fq;
        const float* gp = gate + (size_t)(u.pm >> 4) * 6144 + col0;
        f32x4 gv[2][2];
#pragma unroll
        for (int bj = 0; bj < 2; ++bj)
#pragma unroll
            for (int n = 0; n < 2; ++n) gv[bj][n] = *(const f32x4*)(gp + bj * HALF + 4 * n);
#pragma unroll
        for (int ai = 0; ai < 2; ++ai)
#pragma unroll
          for (int mh = 0; mh < 2; ++mh) {
            u32x4 pre[2][2];
#pragma unroll
            for (int m2 = 0; m2 < 2; ++m2)
#pragma unroll
                for (int bj = 0; bj < 2; ++bj) pre[m2][bj] = *(const u32x4*)(base + (size_t)(u.pm * BM + ai * HALF + wr * 64 + (2 * mh + m2) * 16 + fr) * 1024 + col0 + bj * HALF);
            asm volatile("" ::: "memory");
#pragma unroll
            for (int m2 = 0; m2 < 2; ++m2) { const int m = 2 * mh + m2;
                const size_t off = (size_t)(u.pm * BM + ai * HALF + wr * 64 + m * 16 + fr) * 1024 + col0;
#pragma unroll
                for (int bj = 0; bj < 2; ++bj) { f32x4 b0, b1; unpack8(pre[m2][bj], b0, b1);
                    *(f32x4*)(out + off + bj * HALF) = b0 + gv[bj][0] * acc[ai][bj][m][0]; *(f32x4*)(out + off + bj * HALF + 4) = b1 + gv[bj][1] * acc[ai][bj][m][1]; }
            }
            asm volatile("" ::: "memory");
          }
    }
};
struct EpiZ0 { static constexpr bool PREP = false; bf16_t* Z0;
    __device__ __forceinline__ void operator()(const Acc& acc, const Unit& u, int wr, int wc, int fr, int fq, LAS unsigned char*, int) const {
        const int ri = u.pm, t = u.pn, g = u.kind, b = u.aux;
        bf16_t* p0 = Z0 + ((size_t)(((b * 4 + g) * 256 + wr * 64 + fr) * 64 + 4 * t + (wc >> 1))) * 128 + ri * 64 + 32 * (wc & 1) + 8 * fq;
#pragma unroll
        for (int ai = 0; ai < 2; ++ai)
#pragma unroll
            for (int m = 0; m < 4; ++m) {
#pragma unroll
                for (int bj = 0; bj < 2; ++bj)
                    *(u32x4*)(p0 + (size_t)(ai * HALF + m * 16) * 8192 + bj * 256) = pack8(acc[ai][bj][m][0], acc[ai][bj][m][1]);
                asm volatile("" ::: "memory");
            }
    }
};

constexpr int AUX_OFF = 131072;
template <bool BASE16>
struct EpiResF { static constexpr bool PREP = false; const void* base; bf16_t* XS; const float* gate; const float* gm; bf16_t* XB; float* SSQ;
    __device__ __forceinline__ void operator()(const Acc& acc, const Unit& u, int wr, int wc, int fr, int fq, LAS unsigned char*, int) const {
        const int col0 = u.pn * 256 + wc * 32 + 8 * fq, b = u.pm >> 4;
        f32x4 gv[2][2], mv[2][2];
#pragma unroll
        for (int bj = 0; bj < 2; ++bj)
#pragma unroll
            for (int n = 0; n < 2; ++n) { gv[bj][n] = *(const f32x4*)(gate + (size_t)b * 6144 + col0 + bj * HALF + 4 * n); mv[bj][n] = *(const f32x4*)(gm + b * 1024 + col0 + bj * HALF + 4 * n); }
#pragma unroll
        for (int ai = 0; ai < 2; ++ai)
#pragma unroll
          for (int mh = 0; mh < 2; ++mh) {
            f32x4 pre[2][2][2];
#pragma unroll
            for (int m2 = 0; m2 < 2; ++m2) { const size_t off = (size_t)(u.pm * BM + ai * HALF + wr * 64 + (2 * mh + m2) * 16 + fr) * 1024 + col0;
#pragma unroll
                for (int bj = 0; bj < 2; ++bj) {
                    if (BASE16) { const u32x4 w = *(const u32x4*)((const bf16_t*)base + off + bj * HALF); unpack8(w, pre[m2][bj][0], pre[m2][bj][1]); }
                    else { pre[m2][bj][0] = *(const f32x4*)((const float*)base + off + bj * HALF); pre[m2][bj][1] = *(const f32x4*)((const float*)base + off + bj * HALF + 4); }
                } }
            asm volatile("" ::: "memory");
#pragma unroll
            for (int m2 = 0; m2 < 2; ++m2) {
                const int m = 2 * mh + m2;
                const int row = u.pm * BM + ai * HALF + wr * 64 + m * 16 + fr;
                const size_t off = (size_t)row * 1024 + col0;
                float ss = 0.f;
#pragma unroll
                for (int bj = 0; bj < 2; ++bj) {
                    const f32x4 v0 = pre[m2][bj][0] + gv[bj][0] * acc[ai][bj][m][0];
                    const f32x4 v1 = pre[m2][bj][1] + gv[bj][1] * acc[ai][bj][m][1];
                    st16(XS + off + bj * HALF, pack8(v0, v1));
                    ss += ((v0[0] * v0[0] + v0[1] * v0[1]) + (v0[2] * v0[2] + v0[3] * v0[3])) + ((v1[0] * v1[0] + v1[1] * v1[1]) + (v1[2] * v1[2] + v1[3] * v1[3]));
                    st16(XB + off + bj * HALF, pack8(v0 * mv[bj][0], v1 * mv[bj][1]));
                }
                ss += __shfl_xor(ss, 16); ss += __shfl_xor(ss, 32);
                if (fq == 0) SSQ[(size_t)row * 16 + u.pn * 4 + wc] = ss;
            }
            asm volatile("" ::: "memory");
          }
    }
};
__device__ __forceinline__ float ssq_rstd(const float* SSQ, int row, int half) {
    const f32x4 a = *(const f32x4*)(SSQ + (size_t)row * 16 + half * 8), b = *(const f32x4*)(SSQ + (size_t)row * 16 + half * 8 + 4);
    float s = ((a[0] + a[1]) + (a[2] + a[3])) + ((b[0] + b[1]) + (b[2] + b[3]));
    s += __shfl_xor(s, 1);
    return rsqrtf(s * (1.0f / 1024.0f) + EPS);
}
struct EpiRelu2F { static constexpr bool PREP = true; bf16_t* O; int ldc; const float* BV; const float* SSQ;
    __device__ __forceinline__ void prep(const Unit& u, LAS unsigned char* lds, int slot, int tid) const {
        const float r = ssq_rstd(SSQ, u.pm * BM + (tid >> 1), tid & 1);
        LAS float* aux = (LAS float*)(lds + AUX_OFF) + slot * 512;
        if (!(tid & 1)) aux[tid >> 1] = r;
        if (tid < 256) aux[256 + tid] = BV[(size_t)(u.pm >> 4) * 4096 + u.pn * 256 + tid];
    }
    __device__ __forceinline__ void operator()(const Acc& acc, const Unit& u, int wr, int wc, int fr, int fq, LAS unsigned char* lds, int slot) const {
        const LAS float* rt = (const LAS float*)(lds + AUX_OFF) + slot * 512;
        const int col0 = u.pn * 256 + wc * 32 + 8 * fq;
        f32x4 bv[2][2];
#pragma unroll
        for (int bj = 0; bj < 2; ++bj)
#pragma unroll
            for (int n = 0; n < 2; ++n) bv[bj][n] = *(const LAS f32x4*)(rt + 256 + wc * 32 + 8 * fq + bj * HALF + 4 * n);
#pragma unroll
        for (int ai = 0; ai < 2; ++ai)
#pragma unroll
            for (int m = 0; m < 4; ++m) {
                const int rl = ai * HALF + wr * 64 + m * 16 + fr; const float rs = rt[rl];
                bf16_t* rowp = O + ((size_t)(u.pm * 64 + u.pn * 4 + (wc >> 1)) * 256 + rl) * 64 + (wc & 1) * 32 + 8 * fq;
#pragma unroll
                for (int bj = 0; bj < 2; ++bj) { f32x4 v0 = acc[ai][bj][m][0] * rs + bv[bj][0], v1 = acc[ai][bj][m][1] * rs + bv[bj][1];
#pragma unroll
                    for (int e = 0; e < 4; ++e) { const float a = fmaxf(v0[e], 0.f), c2 = fmaxf(v1[e], 0.f); v0[e] = a * a; v1[e] = c2 * c2; }
                    st16(rowp + bj * 2 * 256 * 64, pack8(v0, v1)); }
            }
    }
};
constexpr int NCOL = 2064;
struct EpiZ0F { static constexpr bool PREP = true; bf16_t* Z0; const float* BVF; const float* SSQ;
    __device__ __forceinline__ void prep(const Unit& u, LAS unsigned char* lds, int slot, int tid) const {
        const int nl = tid >> 1, tok = u.aux * 4096 + 64 * (nl & 63) + 4 * u.pn + (nl >> 6);
        const float r = ssq_rstd(SSQ, tok, tid & 1);
        LAS float* aux = (LAS float*)(lds + AUX_OFF) + slot * 512;
        if (!(tid & 1)) aux[nl] = r;
        if (tid < 256) aux[256 + tid] = BVF[(size_t)(u.aux * 4 + u.kind) * 256 + tid];
    }
    __device__ __forceinline__ void operator()(const Acc& acc, const Unit& u, int wr, int wc, int fr, int fq, LAS unsigned char* lds, int slot) const {
        const LAS float* rt = (const LAS float*)(lds + AUX_OFF) + slot * 512;
        const int t = u.pn, g = u.kind, b = u.aux;
        f32x4 rs[2][2];
#pragma unroll
        for (int bj = 0; bj < 2; ++bj)
#pragma unroll
            for (int n = 0; n < 2; ++n) rs[bj][n] = *(const LAS f32x4*)(rt + bj * HALF + wc * 32 + 8 * fq + 4 * n);
        const LAS float* bz = rt + 256 + wr * 64 + fr;
        bf16_t* p0 = Z0 + ((size_t)(((b * 4 + g) * 128 + wr * 64 + fr) * 64 + 4 * t + (wc >> 1))) * 128 + 32 * (wc & 1) + 8 * fq;
        bf16_t* ps = Z0 + ((size_t)((2048 + b * 4 + g) * 64 + 4 * t + (wc >> 1))) * 128 + 32 * (wc & 1) + 8 * fq;
#pragma unroll
        for (int ai = 0; ai < 2; ++ai)
#pragma unroll
            for (int m = 0; m < 4; ++m) {
                const float bb = bz[ai * HALF + m * 16];
                const bool nyq = (ai == 1 && m == 0) && (wr == 0) && (fr == 0);
#pragma unroll
                for (int bj = 0; bj < 2; ++bj) {
                    const u32x4 v = pack8(acc[ai][bj][m][0] * rs[bj][0] + bb, acc[ai][bj][m][1] * rs[bj][1] + bb);
                    const u32x4 z = {0u, 0u, 0u, 0u};
                    st16(p0 + (size_t)(m * 16) * 8192 + ai * 64 + bj * 256, nyq ? z : v);
                    if (ai == 1 && m == 0) { if (nyq) { st16(ps + bj * 256, v); st16(ps + bj * 256 + 64, z); } }
                }
                asm volatile("" ::: "memory");
            }
    }
};
}


#define XB_TMO      128
#define XB_XCNT(j)  (256  + 64 * (j))
#define XB_XSUB(j)  (1280 + 64 * (j))
#define XB_XGEN(j)  (2304 + 64 * (j))
#define XB_TOP      3328
#define XB_TOPGEN   3392
#define XCD_BAR_WORDS 3456
#define XB_SPIN_CAP (1u << 18)
__device__ __forceinline__ unsigned xb_ld(unsigned* p)              { return __hip_atomic_load(p, __ATOMIC_RELAXED, __HIP_MEMORY_SCOPE_AGENT); }
__device__ __forceinline__ unsigned xb_add(unsigned* p, unsigned v) { return __hip_atomic_fetch_add(p, v, __ATOMIC_RELAXED, __HIP_MEMORY_SCOPE_AGENT); }
__device__ __forceinline__ unsigned xb_xcc_id() { return (unsigned)__builtin_amdgcn_s_getreg((3 << 11) | 20) & 0xFu; }
#define XB_SPIN(cond, bar) do { unsigned _sp = 0; while (cond) { __builtin_amdgcn_s_sleep(1); \
    if ((++_sp & 255u) == 0u) { if (xb_ld(&(bar)[XB_TMO])) break; if (_sp > XB_SPIN_CAP) { atomicAdd(&(bar)[XB_TMO], 1u); break; } } } } while (0)
struct XcdBarrier { unsigned* bar; unsigned x; volatile LAS unsigned* st; };
__device__ __forceinline__ XcdBarrier xcd_barrier_post(unsigned* bar, volatile LAS unsigned* st) {
    XcdBarrier b; b.bar = bar; b.x = xb_xcc_id(); b.st = st;
    if (threadIdx.x == 0) (void)xb_add(&bar[XB_XCNT(b.x)], 1u);
    return b;
}
__device__ __forceinline__ void xcd_barrier_complete(unsigned* bar, unsigned x, unsigned& nloc, unsigned& nx) {
    const unsigned G = gridDim.x * gridDim.y * gridDim.z;
    unsigned sum, cnt, mine, sp = 0u;
    for (;;) {
        sum = 0u; cnt = 0u; mine = 0u;
#pragma unroll
        for (unsigned j = 0; j < 16; ++j) { const unsigned c = xb_ld(&bar[XB_XCNT(j)]); sum += c; cnt += (c > 0u) ? 1u : 0u; mine = (j == x) ? c : mine; }
        if (sum == G) break;
        __builtin_amdgcn_s_sleep(1);
        if ((++sp & 255u) == 0u) { if (xb_ld(&bar[XB_TMO])) break; if (sp > XB_SPIN_CAP) { atomicAdd(&bar[XB_TMO], 1u); break; } }
    }
    nloc = mine > 0u ? mine : 1u; nx = cnt > 0u ? cnt : 1u;
}
__device__ __forceinline__ void xcd_barrier(const XcdBarrier& b) {
    asm volatile("s_waitcnt vmcnt(0)" ::: "memory");
    __syncthreads();
    if (threadIdx.x == 0) {
        unsigned* bar = b.bar;
        __builtin_amdgcn_s_waitcnt(0);
        unsigned nloc = b.st[0], nx = b.st[1];
        if (nloc == 0u) { xcd_barrier_complete(bar, b.x, nloc, nx); b.st[0] = nloc; b.st[1] = nx; }
        const unsigned old = xb_add(&bar[XB_XSUB(b.x)], 1u);
        const unsigned gen = old / nloc;
        if (old + 1u == (gen + 1u) * nloc) {
            __builtin_amdgcn_fence(__ATOMIC_RELEASE, "agent");
            asm volatile("s_waitcnt vmcnt(0)" ::: "memory");
            const unsigned og = xb_add(&bar[XB_TOP], 1u);
            const unsigned tg = og / nx;
            if (og + 1u == (tg + 1u) * nx) xb_add(&bar[XB_TOPGEN], 1u);
            else XB_SPIN(xb_ld(&bar[XB_TOPGEN]) == tg, bar);
            __builtin_amdgcn_fence(__ATOMIC_ACQUIRE, "agent");
            xb_add(&bar[XB_XGEN(b.x)], 1u);
            asm volatile("s_waitcnt vmcnt(0)" ::: "memory");
        } else {
            XB_SPIN(xb_ld(&bar[XB_XGEN(b.x)]) == gen, bar);
            __builtin_amdgcn_fence(__ATOMIC_ACQUIRE, "agent");
            asm volatile("s_waitcnt vmcnt(0)" ::: "memory");
        }
    }
    __syncthreads();
}
__device__ __forceinline__ void p0_mods_unit(const float* c, const float* cctx, const float* ada_w, const float* ada_b, float* mods, LAS unsigned char* lds, int unit) {
    LAS float* s = (LAS float*)lds;
    LAS float* red = s + 5 * 1024;
    int tid = threadIdx.x; asm volatile("" : "+v"(tid));
    for (int i = tid; i < 5 * 1024; i += 512) { const int v = i >> 10, k = i & 1023; const float x = v < 4 ? c[v * 1024 + k] : cctx[k]; s[i] = x / (1.0f + __expf(-x)); }
    __syncthreads();
    const int l = unit / 96, col0 = (unit % 96) * 64, kc = tid >> 6, cl = tid & 63;
    const float* w = ada_w + (size_t)l * 1024 * 6144 + col0 + cl;
    float a0 = 0.f, a1 = 0.f, a2 = 0.f, a3 = 0.f, a4 = 0.f;
    for (int k = kc * 128; k < kc * 128 + 128; k += 32) {
        float wv[32];
#pragma unroll
        for (int j = 0; j < 32; ++j) wv[j] = w[(size_t)(k + j) * 6144];
#pragma unroll
        for (int j = 0; j < 32; ++j) { a0 += s[k + j] * wv[j]; a1 += s[1024 + k + j] * wv[j]; a2 += s[2048 + k + j] * wv[j]; a3 += s[3072 + k + j] * wv[j]; a4 += s[4096 + k + j] * wv[j]; }
    }
    red[(kc * 5 + 0) * 64 + cl] = a0; red[(kc * 5 + 1) * 64 + cl] = a1; red[(kc * 5 + 2) * 64 + cl] = a2; red[(kc * 5 + 3) * 64 + cl] = a3; red[(kc * 5 + 4) * 64 + cl] = a4;
    __syncthreads();
    if (tid < 320) { const int v = tid >> 6, cc = tid & 63; float t = 0.f;
#pragma unroll
        for (int kk = 0; kk < 8; ++kk) t += red[(kk * 5 + v) * 64 + cc];
        mods[(size_t)(l * 5 + v) * 6144 + col0 + cc] = t + ada_b[l * 6144 + col0 + cc]; }
    __syncthreads();
}

__device__ __forceinline__ void p0_transpose_item(const float* W, int K, int N, bf16_t* WT, bf16_t* WT2, int mode, LAS float* scr, int item, int lane) {
    const int nblk = N / 32, kb = item / nblk, nb = item % nblk, k0 = 64 * kb, n0 = 32 * nb;
    float wv_[32];
#pragma unroll
    for (int i = 0; i < 32; ++i) { int srow = k0 + 2 * i + (lane >> 5);
        if (mode == 2) { const int j = srow & 255; if (j > 128) srow = (srow & ~255) + 256 - (j - 128); }
        wv_[i] = W[(size_t)srow * N + n0 + (lane & 31)]; }
#pragma unroll
    for (int i = 0; i < 32; ++i) scr[(2 * i + (lane >> 5)) * 33 + (lane & 31)] = wv_[i];
    asm volatile("s_waitcnt lgkmcnt(0)" ::: "memory");
    const int cch = lane & 7;
#pragma unroll
    for (int j = 0; j < 4; ++j) { const int n = (lane >> 3) + 8 * j; const LAS float* s = scr + (8 * cch) * 33 + n;
        u32x4 o; o.x = cvt_pk_bf16(s[0 * 33], s[1 * 33]); o.y = cvt_pk_bf16(s[2 * 33], s[3 * 33]); o.z = cvt_pk_bf16(s[4 * 33], s[5 * 33]); o.w = cvt_pk_bf16(s[6 * 33], s[7 * 33]);
        const int ng = n0 + n; bf16_t* dst;
        if (mode != 1) dst = WT + (size_t)ng * K;
        else if (ng < 2048) { const int pn = ng >> 8, hh = (ng >> 6) & 3, d = ng & 63; const int tpos = (d >> 5) * 128 + hh * 32 + (d & 31); dst = WT + (size_t)(pn * 256 + tpos) * K; }
        else dst = WT2 + (size_t)(ng - 2048) * K;
        *(u32x4*)(dst + k0 + 8 * cch) = o; }
    asm volatile("s_waitcnt lgkmcnt(0)" ::: "memory");
}

__device__ __forceinline__ float wave_sum(float v) {
#pragma unroll
    for (int o = 1; o < 64; o <<= 1) v += __shfl_xor(v, o);
    return v;
}
__device__ __forceinline__ void norm_rows(const float* xlat, const float* xctx, int nrows, const float* g, const float* modsl, int sh_off, int sc_off, bf16_t* H, int gw, int NGW, int lane) {
    f32x4 gv[4];
#pragma unroll
    for (int j = 0; j < 4; ++j) gv[j] = *(const f32x4*)(g + lane * 4 + 256 * j);
    for (int row = gw; row < nrows; row += NGW) {
        const float* src = row < ML ? xlat + (size_t)row * 1024 : xctx + (size_t)(row - ML) * 1024;
        const int v = row < ML ? (row >> 12) : 4;
        const float* mp = modsl + (size_t)v * 6144;
        f32x4 x[4]; float ss = 0.f;
#pragma unroll
        for (int j = 0; j < 4; ++j) { x[j] = *(const f32x4*)(src + lane * 4 + 256 * j); ss += (x[j][0] * x[j][0] + x[j][1] * x[j][1]) + (x[j][2] * x[j][2] + x[j][3] * x[j][3]); }
        const float rstd = rsqrtf(wave_sum(ss) * (1.0f / 1024.0f) + EPS);
#pragma unroll
        for (int j = 0; j < 4; ++j) {
            const f32x4 sh = *(const f32x4*)(mp + sh_off + lane * 4 + 256 * j), sc = *(const f32x4*)(mp + sc_off + lane * 4 + 256 * j);
            const f32x4 y = (x[j] * rstd * gv[j]) * (sc + 1.0f) + sh;
            u32x2 w; w.x = cvt_pk_bf16(y[0], y[1]); w.y = cvt_pk_bf16(y[2], y[3]);
            *(u32x2*)(H + (size_t)row * 1024 + lane * 4 + 256 * j) = w;
        }
    }
}


__device__ __forceinline__ void bias_items(const bf16_t* W1t, const bf16_t* CS, const float* mods, float* BV0, float* BV1, float* BVF, int w, int NW, int lane) {
    for (int it = w; it < 8192 + 1024; it += NW) {
        float a0 = 0.f, a1 = 0.f, a2 = 0.f, a3 = 0.f; float* dst; int dstride;
        if (it < 8192) {
            const int l = it >> 12, n = it & 4095;
            const bf16_t* wr_ = W1t + (size_t)l * 4096 * 1024 + (size_t)n * 1024 + lane * 16;
            const u32x4 w0 = *(const u32x4*)wr_, w1 = *(const u32x4*)(wr_ + 8);
            const float* sh = mods + (size_t)l * 5 * 6144 + 3072 + lane * 16;
            float wf[16];
#pragma unroll
            for (int e = 0; e < 4; ++e) { wf[2 * e] = __uint_as_float(w0[e] << 16); wf[2 * e + 1] = __uint_as_float(w0[e] & 0xffff0000u); wf[8 + 2 * e] = __uint_as_float(w1[e] << 16); wf[8 + 2 * e + 1] = __uint_as_float(w1[e] & 0xffff0000u); }
#pragma unroll
            for (int q = 0; q < 4; ++q) {
                const f32x4 s0 = *(const f32x4*)(sh + 4 * q), s1 = *(const f32x4*)(sh + 6144 + 4 * q), s2 = *(const f32x4*)(sh + 2 * 6144 + 4 * q), s3 = *(const f32x4*)(sh + 3 * 6144 + 4 * q);
#pragma unroll
                for (int e = 0; e < 4; ++e) { a0 += s0[e] * wf[4 * q + e]; a1 += s1[e] * wf[4 * q + e]; a2 += s2[e] * wf[4 * q + e]; a3 += s3[e] * wf[4 * q + e]; }
            }
            dst = (l == 0 ? BV0 : BV1) + n; dstride = 4096;
        } else {
            const int idx = it - 8192, g = idx >> 8, m = idx & 255;
            const u32x2 w0 = *(const u32x2*)(CS + (size_t)m * 256 + lane * 4);
            const float wf0 = __uint_as_float(w0[0] << 16), wf1 = __uint_as_float(w0[0] & 0xffff0000u), wf2 = __uint_as_float(w0[1] << 16), wf3 = __uint_as_float(w0[1] & 0xffff0000u);
            const float* sh = mods + (size_t)5 * 6144 + g * 256 + lane * 4;
            const f32x4 s0 = *(const f32x4*)(sh), s1 = *(const f32x4*)(sh + 6144), s2 = *(const f32x4*)(sh + 2 * 6144), s3 = *(const f32x4*)(sh + 3 * 6144);
            a0 = s0[0] * wf0 + s0[1] * wf1 + s0[2] * wf2 + s0[3] * wf3; a1 = s1[0] * wf0 + s1[1] * wf1 + s1[2] * wf2 + s1[3] * wf3;
            a2 = s2[0] * wf0 + s2[1] * wf1 + s2[2] * wf2 + s2[3] * wf3; a3 = s3[0] * wf0 + s3[1] * wf1 + s3[2] * wf2 + s3[3] * wf3;
            dst = BVF + g * 256 + m; dstride = 1024;
        }
        a0 = wave_sum(a0); a1 = wave_sum(a1); a2 = wave_sum(a2); a3 = wave_sum(a3);
        if (lane == 0) { dst[0] = a0; dst[dstride] = a1; dst[2 * dstride] = a2; dst[3 * dstride] = a3; }
    }
}
template <bool MASKED>
__device__ __forceinline__ void attn_block(const LAS bf16_t* Ks, const LAS bf16_t* Vs, int kcol0, int fr, int g, const bf16x8 (&Qf)[2], f32x4 (&acc)[4], float& lsum,
                                           const LAS unsigned char* rpb_base  , const int (&dcb)[8], const f32x4& ciX, const f32x4& ciY) {
    bf16x8 KX[2], KY[2];
#pragma unroll
    for (int kk = 0; kk < 2; ++kk) { KX[kk] = *(const LAS bf16x8*)(Ks + (kcol0 + fr) * 72 + kk * 32 + g * 8); KY[kk] = *(const LAS bf16x8*)(Ks + (kcol0 + 16 + fr) * 72 + kk * 32 + g * 8); }
    s16x4 VX[4], VY[4];
#pragma unroll
    for (int db = 0; db < 4; ++db) { VX[db] = *(const LAS s16x4*)(Vs + (16 * db + fr) * 72 + kcol0 + 4 * g); VY[db] = *(const LAS s16x4*)(Vs + (16 * db + fr) * 72 + kcol0 + 16 + 4 * g); }
    f32x4 sX = mfma16(KX[0], Qf[0], ciX); sX = mfma16(KX[1], Qf[1], sX);
    f32x4 sY = mfma16(KY[0], Qf[0], ciY); sY = mfma16(KY[1], Qf[1], sY);
    f32x4 pX, pY;
    if (MASKED) {
#pragma unroll
        for (int ii = 0; ii < 4; ++ii) {
            const float bx = *(const LAS float*)(rpb_base + dcb[ii]), by = *(const LAS float*)(rpb_base + dcb[4 + ii]);
            pX[ii] = __builtin_amdgcn_exp2f(sX[ii] + bx);
            pY[ii] = __builtin_amdgcn_exp2f(sY[ii] + by);
        }
    } else {
#pragma unroll
        for (int ii = 0; ii < 4; ++ii) { pX[ii] = __builtin_amdgcn_exp2f(sX[ii]); pY[ii] = __builtin_amdgcn_exp2f(sY[ii]); }
    }
    lsum += ((pX[0] + pX[1]) + (pX[2] + pX[3])) + ((pY[0] + pY[1]) + (pY[2] + pY[3]));
    const u32x4 pw = pg8::pack8(pX, pY);
    const bf16x8 Pf = __builtin_bit_cast(bf16x8, pw);
#pragma unroll
    for (int db = 0; db < 4; ++db) {
        bf16x8 Vf; Vf[0] = VX[db][0]; Vf[1] = VX[db][1]; Vf[2] = VX[db][2]; Vf[3] = VX[db][3]; Vf[4] = VY[db][0]; Vf[5] = VY[db][1]; Vf[6] = VY[db][2]; Vf[7] = VY[db][3];
        acc[db] = mfma16(Vf, Pf, acc[db]);
    }
}
__device__ __forceinline__ void attn_phase(const bf16_t* QK, const bf16_t* VT, bf16_t* O, const float* rpb, const float* sbound, LAS unsigned char* lds, int G, int c) {
    constexpr int RP_BYTES = 30720, TILE_B = 64 * 72 * 2, PAIR_B = 4 * TILE_B, NPAIR = 7;
    LAS float* rp = (LAS float*)lds;
    int tid = threadIdx.x; asm volatile("" : "+v"(tid));
    const int lane = tid & 63, wid = __builtin_amdgcn_readfirstlane(tid >> 6), fr = lane & 15, g = lane >> 4;
    for (int i = tid; i < 16 * 465; i += 512) rp[i] = rpb[i] * LOG2E;
    const float Mb = *sbound;
    const int nunits = (2048 - c + G - 1) / G;
    const int ND = nunits * NPAIR;
    const int trow = tid >> 3, tch = tid & 7;
    const int ldsoff = (trow * 72 + tch * 8) * 2;
#define ATT_DEC(L_, b_, h_, rp_) do { const int x_ = (L_) & 7, q_ = (L_) >> 3; rp_ = q_ & 31; const int bh_ = 8 * (q_ >> 5) + x_; b_ = bh_ >> 4; h_ = bh_ & 15; } while (0)
#define ATT_TOK(b_, rs0_, t_) ((t_) < 9 ? (b_) * 4096 + min((rs0_) + (t_), 63) * 64 : ML + (b_) * 256 + 64 * (min((t_), 12) - 9))
#define ATT_GLOAD(D_, R) do { const int u_ = (D_) / NPAIR, p_ = (D_) - u_ * NPAIR; int b_, h_, rp_; ATT_DEC(u_ * G + c, b_, h_, rp_); \
        const int rs0_ = min(max(2 * rp_ - 4, 0), 56); const int tk0_ = ATT_TOK(b_, rs0_, 2 * p_), tk1_ = ATT_TOK(b_, rs0_, 2 * p_ + 1); \
        const bf16_t* kb_ = QK + (size_t)trow * 2048 + 1024 + h_ * 64 + tch * 8; const bf16_t* vb_ = VT + (size_t)(h_ * 64 + trow) * MT + tch * 8; \
        R[0] = *(const u32x4*)(kb_ + (size_t)tk0_ * 2048); R[1] = *(const u32x4*)(vb_ + tk0_); R[2] = *(const u32x4*)(kb_ + (size_t)tk1_ * 2048); R[3] = *(const u32x4*)(vb_ + tk1_); } while (0)
#define ATT_LWRITE(slot_, R) do { _Pragma("unroll") for (int q_ = 0; q_ < 4; ++q_) *(LAS u32x4*)(lds + RP_BYTES + (slot_) * PAIR_B + q_ * TILE_B + ldsoff) = R[q_]; } while (0)
    u32x4 R0[4], R1[4];
    ATT_GLOAD(0, R0); ATT_LWRITE(0, R0);
    if (ND > 1) ATT_GLOAD(1, R1);
    if (ND > 2) ATT_GLOAD(2, R0);
    __syncthreads();
    int b = 0, h = 0, rpair = 0, r = 0, rs0 = 0, rsr = 0, qrow = 0;
    const int j = wid & 3, w0 = (j == 0) ? 0 : (j == 1) ? 8 : (j == 2) ? 24 : 32;
    int dcb[8]; f32x4 ciX, ciY, ciU;
    {
        const int cq = 16 * j + fr, cs = min(max(cq - 8, 0), 48), eX = w0 + 4 * g - cs, dX = w0 + 4 * g - cq + 15;
#pragma unroll
        for (int ii = 0; ii < 4; ++ii) {
            dcb[ii] = 4 * min(max(dX + ii, 0), 30); dcb[4 + ii] = 4 * min(max(dX + 16 + ii, 0), 30);
            ciX[ii] = ((unsigned)(eX + ii) < 16u) ? -Mb : -1.0e30f; ciY[ii] = ((unsigned)(eX + 16 + ii) < 16u) ? -Mb : -1.0e30f; ciU[ii] = -Mb;
        }
    }
    bf16x8 Qf[2], Qn[2]; f32x4 acc[4]; float lsum = 0.f;
    int p = 0, u = 0, D = 0;
#define ATT_QLOAD(dst, uu) do { int b_, h_, rp_; ATT_DEC((uu) * G + c, b_, h_, rp_); const int qr_ = b_ * 4096 + (2 * rp_ + (wid >> 2)) * 64 + 16 * j + fr; \
        _Pragma("unroll") for (int kk = 0; kk < 2; ++kk) dst[kk] = *(const bf16x8*)(QK + (size_t)qr_ * 2048 + h_ * 64 + 32 * kk + 8 * g); } while (0)
#define ATT_TILE(t_, toff_) do { \
        const LAS bf16_t* Ks = (const LAS bf16_t*)(lds + RP_BYTES + slot * PAIR_B + (toff_)); \
        const LAS bf16_t* Vs = (const LAS bf16_t*)(lds + RP_BYTES + slot * PAIR_B + (toff_) + TILE_B); \
        if ((t_) < 9) { \
            const int kr = rs0 + (t_), i = kr - rsr; \
            if (i >= 0 && i < 8) attn_block<true>(Ks, Vs, w0, fr, g, Qf, acc, lsum, (const LAS unsigned char*)rp + (h * 465 + (kr - r + 7) * 31) * 4, dcb, ciX, ciY); \
        } else if ((t_) < 13) { \
            attn_block<false>(Ks, Vs, 0, fr, g, Qf, acc, lsum, (const LAS unsigned char*)rp, dcb, ciU, ciU); \
            attn_block<false>(Ks, Vs, 32, fr, g, Qf, acc, lsum, (const LAS unsigned char*)rp, dcb, ciU, ciU); \
        } } while (0)
    ATT_QLOAD(Qn, 0);
#define ATT_ITER(R) do { \
        const int slot = D & 1; \
        if (D + 1 < ND) ATT_LWRITE(slot ^ 1, R); \
        if (D + 3 < ND) ATT_GLOAD(D + 3, R); \
        if (p == 0) { \
            ATT_DEC(u * G + c, b, h, rpair); \
            r = 2 * rpair + (wid >> 2); rs0 = min(max(2 * rpair - 4, 0), 56); rsr = min(max(r - 4, 0), 56); \
            qrow = b * 4096 + r * 64 + 16 * j + fr; \
            Qf[0] = Qn[0]; Qf[1] = Qn[1]; \
            _Pragma("unroll") for (int db = 0; db < 4; ++db) acc[db] = (f32x4){0.f, 0.f, 0.f, 0.f}; \
            lsum = 0.f; \
        } \
        if (p == 4 && u + 1 < nunits) ATT_QLOAD(Qn, u + 1); \
        { const int i0_ = rs0 + 2 * p - rsr, i1_ = i0_ + 1; \
          if (2 * p + 1 < 9 && i0_ >= 0 && i1_ < 8) {        \
            const LAS bf16_t* Ka = (const LAS bf16_t*)(lds + RP_BYTES + slot * PAIR_B); const LAS bf16_t* Va = (const LAS bf16_t*)(lds + RP_BYTES + slot * PAIR_B + TILE_B); \
            const LAS bf16_t* Kb = (const LAS bf16_t*)(lds + RP_BYTES + slot * PAIR_B + 2 * TILE_B); const LAS bf16_t* Vb = (const LAS bf16_t*)(lds + RP_BYTES + slot * PAIR_B + 3 * TILE_B); \
            const LAS unsigned char* rb_ = (const LAS unsigned char*)rp + (h * 465 + (rs0 + 2 * p - r + 7) * 31) * 4; \
            attn_block<true>(Ka, Va, w0, fr, g, Qf, acc, lsum, rb_, dcb, ciX, ciY); \
            attn_block<true>(Kb, Vb, w0, fr, g, Qf, acc, lsum, rb_ + 124, dcb, ciX, ciY); \
          } else { ATT_TILE(2 * p, 0); ATT_TILE(2 * p + 1, 2 * TILE_B); } } \
        if (p == NPAIR - 1) { \
            float ls = lsum; ls += __shfl_xor(ls, 16); ls += __shfl_xor(ls, 32); \
            const float inv = 1.0f / ls; \
            bf16_t* op = O + (size_t)qrow * 1024 + h * 64 + 4 * g; \
            _Pragma("unroll") for (int db = 0; db < 4; ++db) { u32x2 w; w.x = cvt_pk_bf16(acc[db][0] * inv, acc[db][1] * inv); w.y = cvt_pk_bf16(acc[db][2] * inv, acc[db][3] * inv); st8(op + 16 * db, w); } \
            p = 0; ++u; \
        } else ++p; \
        __syncthreads(); \
    } while (0)
    for (;;) {
        ATT_ITER(R1); if (++D >= ND) break;
        ATT_ITER(R0); if (++D >= ND) break;
    }
#undef ATT_ITER
#undef ATT_TILE
#undef ATT_QLOAD
#undef ATT_DEC
#undef ATT_TOK
#undef ATT_GLOAD
#undef ATT_LWRITE
}

__device__ __forceinline__ void s1_phase(const bf16_t* Z0, const bf16_t* Dg, bf16_t* Z1, LAS unsigned char* lds, int gw, int NGW) {
    constexpr int DP = 136;
    LAS bf16_t* Dl = (LAS bf16_t*)lds;
    int tid = threadIdx.x; asm volatile("" : "+v"(tid));
    const int lane = tid & 63, fr = lane & 15, g = lane >> 4;
    for (int i = tid; i < 128 * 16; i += 512) { const int row = i >> 4, ch = i & 15; *(LAS u32x4*)(Dl + row * DP + ch * 8) = *(const u32x4*)(Dg + row * 128 + ch * 8); }
    __syncthreads();
    for (int colM = gw; colM < pg8::NCOL; colM += NGW) {
        bf16x8 A[4][4];
#pragma unroll
        for (int ib = 0; ib < 4; ++ib)
#pragma unroll
            for (int kb = 0; kb < 4; ++kb) A[ib][kb] = *(const bf16x8*)(Z0 + ((size_t)colM * 64 + 16 * ib + fr) * 128 + 32 * kb + 8 * g);
#pragma unroll 2
        for (int jb = 0; jb < 8; ++jb) {
            bf16x8 Bf[4];
#pragma unroll
            for (int kb = 0; kb < 4; ++kb) Bf[kb] = *(const LAS bf16x8*)(Dl + (16 * jb + fr) * DP + 32 * kb + 8 * g);
            const int n = 16 * jb + fr, ka = n >> 1, rip = n & 1;
#pragma unroll
            for (int ib = 0; ib < 4; ++ib) {
                f32x4 a = (f32x4){0.f, 0.f, 0.f, 0.f};
#pragma unroll
                for (int kb = 0; kb < 4; ++kb) a = mfma16(A[ib][kb], Bf[kb], a);
                u32x2 w; w.x = cvt_pk_bf16(a[0], a[1]); w.y = cvt_pk_bf16(a[2], a[3]);
                st8(Z1 + (((size_t)ka * pg8::NCOL + colM) * 2 + rip) * 64 + 16 * ib + 4 * g, w);
            }
        }
    }
    __syncthreads();
}
__device__ __forceinline__ void s2_phase(const bf16_t* Z1, const bf16_t* Eg, bf16_t* F, int gw, int NGW, int lane) {
    const int fr = lane & 15, g = lane >> 4;
    for (int it = gw; it < 2048 + 64; it += NGW) {
        const bool special = it >= 2048;
        const int ka = special ? it - 2048 : (it & 63), q = it >> 6, bg = q >> 1, ib0 = special ? 0 : 4 * (q & 1), nib = special ? 1 : 4;
        bf16x8 Bf[4][4];
#pragma unroll
        for (int jb = 0; jb < 4; ++jb)
#pragma unroll
            for (int kb = 0; kb < 4; ++kb) Bf[jb][kb] = *(const bf16x8*)(Eg + ((size_t)ka * 64 + 16 * jb + fr) * 128 + 32 * kb + 8 * g);
        for (int ibb = 0; ibb < nib; ++ibb) {
            const int ib = ib0 + ibb;
            const int colM0 = special ? 2048 : bg * 128 + ib * 16;
            bf16x8 A[4];
#pragma unroll
            for (int kb = 0; kb < 4; ++kb) A[kb] = *(const bf16x8*)(Z1 + ((size_t)ka * pg8::NCOL + colM0 + fr) * 128 + 32 * kb + 8 * g);
            const int k2 = ib * 16 + 4 * g, b = bg >> 2, gg = bg & 3;
#pragma unroll
            for (int jb = 0; jb < 4; ++jb) {
                f32x4 a = (f32x4){0.f, 0.f, 0.f, 0.f};
#pragma unroll
                for (int kb = 0; kb < 4; ++kb) a = mfma16(A[kb], Bf[jb][kb], a);
                const int k = ka + 64 * (16 * jb + fr), km = (4096 - k) & 4095;
                u32x2 w; w.x = cvt_pk_bf16(a[0], a[1]); w.y = cvt_pk_bf16(a[2], a[3]);
                if (!special) {
                    st8(F + ((size_t)b * 4096 + k) * 1024 + gg * 256 + k2, w);
                    bf16_t* pm_ = F + ((size_t)b * 4096 + km) * 1024 + gg * 256 + 128 + k2;
                    if (k2 != 0) st8(pm_, w);
                    else { pm_[1] = (bf16_t)(w.x >> 16); *(unsigned*)(pm_ + 2) = w.y; }
                } else {
                    bf16_t* ps_ = F + ((size_t)g * 4096 + k) * 1024 + 128;
                    ps_[0] = (bf16_t)(w.x & 0xffffu); ps_[256] = (bf16_t)(w.x >> 16); ps_[512] = (bf16_t)(w.y & 0xffffu); ps_[768] = (bf16_t)(w.y >> 16);
                }
            }
        }
    }
}


#ifndef MK_DEBUG
#define MK_DEBUG 0
#endif
__device__ __forceinline__ void dbg_scan16(const bf16_t* p, size_t n, unsigned* flags, unsigned bit, int gt, int NT) {
    bool bad = false; for (size_t i = gt; i < n; i += NT) bad |= ((p[i] & 0x7f80u) == 0x7f80u);
    if (bad) atomicOr(flags, 1u << bit);
}
__device__ __forceinline__ void dbg_scan32(const float* p, size_t n, unsigned* flags, unsigned bit, int gt, int NT) {
    bool bad = false; for (size_t i = gt; i < n; i += NT) bad |= ((__float_as_uint(p[i]) & 0x7f800000u) == 0x7f800000u);
    if (bad) atomicOr(flags, 1u << bit);
}
struct Args { const float* in[15]; float* out; unsigned char* ws; int ph_lo, ph_hi, use_cg, pad; };
static_assert(sizeof(Args) == 15 * 8 + 8 + 8 + 16, "no padding");

__global__ void __launch_bounds__(512, 2) fwd_kernel(Args args) {
    extern __shared__ __attribute__((aligned(16))) unsigned char lds_raw[];
    LAS unsigned char* lds = (LAS unsigned char*)lds_raw;
    const int G = gridDim.x, c = blockIdx.x;
    const int vcu = (G % 8 == 0) ? (c % 8) * (G / 8) + c / 8 : c;
    const int NGW = G * 8;
#define PHASE_IDS int tid_ = threadIdx.x; asm volatile("" : "+v"(tid_)); const int lane = tid_ & 63, wid = __builtin_amdgcn_readfirstlane(tid_ >> 6); const int gw = vcu * 8 + wid; (void)lane; (void)gw
    unsigned char* ws = args.ws;
    const float* x = args.in[0]; const float* cvec = args.in[1]; const float* ctx = args.in[2]; const float* cctx = args.in[3];
    const float* ada_w = args.in[4]; const float* ada_b = args.in[5]; const float* norm_g = args.in[6];
    const float* wqkv = args.in[7]; const float* wo = args.in[8]; const float* gq = args.in[9]; const float* gk = args.in[10]; const float* rpb = args.in[11];
    const float* fw = args.in[12]; const float* w1 = args.in[13]; const float* w2 = args.in[14];
    float* out = args.out;
    float* mods = (float*)(ws + WS_MODS); float* sbound = (float*)(ws + WS_SB);
    bf16_t* CS = (bf16_t*)(ws + WS_CS); bf16_t* Dt = (bf16_t*)(ws + WS_D); bf16_t* Et = (bf16_t*)(ws + WS_E);
    bf16_t* WQK = (bf16_t*)(ws + WS_WQK); bf16_t* WV = (bf16_t*)(ws + WS_WV); bf16_t* WO = (bf16_t*)(ws + WS_WO); bf16_t* FWt = (bf16_t*)(ws + WS_FW);
    bf16_t* W1t = (bf16_t*)(ws + WS_W1); bf16_t* W2t = (bf16_t*)(ws + WS_W2);
    bf16_t* H = (bf16_t*)(ws + WS_H); bf16_t* QK = (bf16_t*)(ws + WS_QK); bf16_t* VT = (bf16_t*)(ws + WS_VT); bf16_t* O = (bf16_t*)(ws + WS_O);
    bf16_t* XS = (bf16_t*)(ws + WS_XS); bf16_t* HMID = (bf16_t*)(ws + WS_HMID); bf16_t* Z0 = (bf16_t*)(ws + WS_Z0); bf16_t* Z1 = (bf16_t*)(ws + WS_Z1); bf16_t* Fb = (bf16_t*)(ws + WS_F);
    float* SSQ = (float*)(ws + WS_SSQ); float* BV0 = (float*)(ws + WS_BV); float* BV1 = BV0 + 4 * 4096; float* BVF = BV1 + 4 * 4096; float* GM = BVF + 16 * 512;
    const int lo = args.ph_lo, hi = args.ph_hi;
    cg::grid_group grid = cg::this_grid();
#define IN(k) (lo <= (k) && (k) < hi)
#ifndef REP_SYNC
#define REP_SYNC 1
#endif
#ifndef REP_NORM
#define REP_NORM 1
#endif
#ifndef REP_S12
#define REP_S12 1
#endif
#ifndef REP_P0
#define REP_P0 1
#endif
#ifndef USE_XB
#define USE_XB 1
#endif
#define SEAM(k) do { if (IN(k) && IN((k) + 1)) { for (int r_ = 0; r_ < REP_SYNC; ++r_) { if (use_cg) grid.sync(); else xcd_barrier(xbar); } } } while (0)
    { volatile LAS unsigned* st_ = (volatile LAS unsigned*)(lds + LDS_BYTES - 64); if (threadIdx.x < 2) st_[threadIdx.x] = 0u; __syncthreads(); }
    XcdBarrier xbar; xbar.bar = (unsigned*)(ws + WS_BAR); xbar.x = 0; xbar.st = (volatile LAS unsigned*)(lds + LDS_BYTES - 64);
    const bool use_cg = (args.use_cg != 0);
    if (!use_cg && hi - lo > 1) xbar = xcd_barrier_post((unsigned*)(ws + WS_BAR), (volatile LAS unsigned*)(lds + LDS_BYTES - 64));

    unsigned* dflags = (unsigned*)(ws + WS_SB + 256);
#define DBG16(k, bit, p, n) do { if (MK_DEBUG && IN(k)) { int t_ = threadIdx.x; asm volatile("" : "+v"(t_)); dbg_scan16(p, n, dflags, bit, (vcu * 512) + t_, G * 512); } } while (0)
#define DBG32(k, bit, p, n) do { if (MK_DEBUG && IN(k)) { int t_ = threadIdx.x; asm volatile("" : "+v"(t_)); dbg_scan32(p, n, dflags, bit, (vcu * 512) + t_, G * 512); } } while (0)
    if (IN(0)) {
        PHASE_IDS;
        if (MK_DEBUG && c == 0 && tid_ == 0) *dflags = 0u;
        for (int r0_ = 0; r0_ < REP_P0; ++r0_) {
        for (int u = c; u < 192; u += G) p0_mods_unit(cvec, cctx, ada_w, ada_b, mods, lds, u);
        __syncthreads();
        {
            LAS float* scr = (LAS float*)(lds + wid * 16384);
            constexpr int I_QKV = 16 * 96, I_SQ = 16 * 32, I_1 = 16 * 128, I_2 = 64 * 32;
            constexpr int NITEMS = I_QKV + I_SQ + 2 * I_1 + I_2;
            for (int it = NITEMS - 1 - gw; it >= 0; it -= NGW) {
                int r = it;
                if (r < I_QKV) { p0_transpose_item(wqkv, 1024, 3072, WQK, WV, 1, scr, r, lane); continue; } r -= I_QKV;
                if (r < I_SQ) { p0_transpose_item(wo, 1024, 1024, WO, nullptr, 0, scr, r, lane); continue; } r -= I_SQ;
                if (r < 2 * I_1) { const int l = r / I_1; p0_transpose_item(w1 + (size_t)l * 1024 * 4096, 1024, 4096, W1t + (size_t)l * 4096 * 1024, nullptr, 0, scr, r % I_1, lane); continue; } r -= 2 * I_1;
                p0_transpose_item(w2, 4096, 1024, W2t, nullptr, 0, scr, r, lane);
            }
        }
        {
            const int gt = gw * 64 + lane, NT = NGW * 64;
            for (int i = gt; i < 256 * 256; i += NT) { const int m = i >> 8, cc = i & 255, ri = m >> 7, k2 = m & 127; float sn, cs; sincospif(2.0f * (float)((cc * k2) & 255) / 256.0f, &sn, &cs);
                float v = (ri == 0 ? cs : -sn) * (1.0f / 16.0f); if (m == 128) v = (cc & 1) ? -(1.0f / 16.0f) : (1.0f / 16.0f);
                CS[i] = (bf16_t)(cvt_pk_bf16(v, 0.f) & 0xffffu); }
            for (int i = gt; i < 128 * 128; i += NT) { const int n = i >> 7, kp = i & 127, ka = n >> 1, rip = n & 1, ri = kp >> 6, a = kp & 63; float sn, cs; sincospif(2.0f * (float)((a * ka) & 63) / 64.0f, &sn, &cs);
                const float v = (rip == 0 ? (ri == 0 ? cs : sn) : (ri == 0 ? -sn : cs)) * 0.125f; Dt[i] = (bf16_t)(cvt_pk_bf16(v, 0.f) & 0xffffu); }
            for (int i = gt; i < 64 * 64 * 128; i += NT) { const int kp = i & 127, kbk = (i >> 7) & 63, ka = i >> 13, rip = kp >> 6, bp = kp & 63; float sn, cs; sincospif(2.0f * (float)((bp * (ka + 64 * kbk)) & 4095) / 4096.0f, &sn, &cs);
                const float v = (rip == 0 ? cs : sn) * 0.125f; Et[i] = (bf16_t)(cvt_pk_bf16(v, 0.f) & 0xffffu); }
        }
        if (c == G - 1 && wid == 7) {
            float mq = fabsf(gq[lane]), mk = fabsf(gk[lane]), mr = 0.f;
            for (int i = lane; i < 16 * 465; i += 64) mr = fmaxf(mr, fabsf(rpb[i]));
#pragma unroll
            for (int o = 1; o < 64; o <<= 1) { mq = fmaxf(mq, __shfl_xor(mq, o)); mk = fmaxf(mk, __shfl_xor(mk, o)); mr = fmaxf(mr, __shfl_xor(mr, o)); }
            if (lane == 0) *sbound = (8.0f * mq * mk + mr) * LOG2E;
        }
        __syncthreads();
        }
    }
    SEAM(0);
    const bool ctx_in_p1 = false;
    if (IN(1)) { PHASE_IDS;
        if (c == G - 1) {
            for (int i = tid_; i < 3 * 4096; i += 512) { const int idx = i >> 12, b = (i >> 10) & 3, col = i & 1023;
                const float gg = norm_g[(idx == 0 ? 1024 : idx == 1 ? 2048 : 3072) + col];
                const float sc = mods[(size_t)((idx == 0 ? 0 : 5) + b) * 6144 + (idx == 1 ? 1024 : 4096) + col];
                GM[i] = gg * (1.0f + sc); }
        }
        if (!ctx_in_p1) norm_rows(x, ctx, MT, norm_g, mods, 0, 1024, H, gw, NGW, lane);
        else if (c >= 32) norm_rows(x, ctx, ML, norm_g, mods, 0, 1024, H, (c - 32) * 8 + wid, (G - 32) * 8, lane);
        else {
            pg8::SchedOne S1u; const size_t ts = (size_t)256 * 1024 * 2; int tt;
            if (c < 16) { S1u.u.kind = 0; S1u.u.pm = 64 + (c & 3); S1u.u.pn = 4 + (c >> 2); tt = c & 3; S1u.u.a = (const char*)H + (size_t)S1u.u.pm * ts; S1u.u.b = (const char*)WQK + (size_t)S1u.u.pn * ts; }
            else { const int l2 = c - 16; S1u.u.kind = 1; S1u.u.pm = l2 & 3; S1u.u.pn = 64 + (l2 >> 2); tt = l2 >> 2; S1u.u.a = (const char*)WV + (size_t)S1u.u.pm * ts; S1u.u.b = (const char*)H + (size_t)S1u.u.pn * ts; }
            S1u.u.aux = 0;
            norm_rows(x, ctx, ML + tt * 256 + 256, norm_g, mods, 0, 1024, H, ML + tt * 256 + wid, 8, lane);
            asm volatile("s_waitcnt vmcnt(0)" ::: "memory"); __syncthreads();
            pg8::EpiQKV E{QK, VT, gq, gk};
            pg8::gemm_phase<pg8::EpiQKV, pg8::SchedOne, false>(lds, 1024, 1024, 1024, S1u, E);
        }
    }
    SEAM(1);
    DBG16(2, 0, H, (size_t)MT * 1024);
    if (IN(2)) { pg8::SchedQKV S{(const char*)H, (const char*)WQK, (const char*)WV, G, c, ctx_in_p1 ? 768 : 800}; pg8::EpiQKV E{QK, VT, gq, gk};
#ifndef REP_G2
#define REP_G2 1
#endif
        for (int r_ = 0; r_ < REP_G2; ++r_) pg8::gemm_phase<pg8::EpiQKV, pg8::SchedQKV, false>(lds, 1024, 1024, 1024, S, E);
        { PHASE_IDS;
          const bool part = (G > 32); const int w_ = part ? (c - 32) * 8 + wid : gw, nw_ = part ? (G - 32) * 8 : NGW;
          if (!part || c >= 32) {
              bias_items(W1t, CS, mods, BV0, BV1, BVF, w_, nw_, lane);
              LAS float* scr = (LAS float*)(lds + wid * 16384);
              constexpr int I_SQ = 16 * 32, I_2 = 64 * 32;
              for (int it = w_; it < I_SQ + I_2; it += nw_) {
                  if (it < I_SQ) p0_transpose_item(fw, 1024, 1024, FWt, nullptr, 2, scr, it, lane);
                  else p0_transpose_item(w2 + (size_t)4096 * 1024, 4096, 1024, W2t + (size_t)1024 * 4096, nullptr, 0, scr, it - I_SQ, lane);
              }
          } } }
    SEAM(2);
    DBG16(3, 1, QK, (size_t)ML * 2048); DBG16(3, 2, VT, (size_t)1024 * MT); DBG32(3, 13, mods, (size_t)10 * 6144);
#ifndef REP_ATT
#define REP_ATT 1
#endif
    if (IN(3)) { for (int rep = 0; rep < REP_ATT; ++rep) attn_phase(QK, VT, O, rpb, sbound, lds, G, c); }
    SEAM(3);
    DBG16(4, 3, O, (size_t)ML * 1024);
    if (IN(4)) { pg8::SchedStd S; S.init(O, WO, ML, 1024, 1024, 1024, G, c); pg8::EpiResF<false> E{x, XS, mods + 2048, GM, H, SSQ};
        pg8::gemm_phase<pg8::EpiResF<false>, pg8::SchedStd, false>(lds, 1024, 1024, 1024, S, E); }
    SEAM(4);
    DBG32(5, 4, out, (size_t)ML * 1024);
    if (IN(6)) { pg8::SchedStd S; S.init(H, W1t, ML, 4096, 1024, 1024, G, c); pg8::EpiRelu2F E{HMID, 4096, BV0, SSQ};
        pg8::gemm_phase<pg8::EpiRelu2F, pg8::SchedStd, false>(lds, 1024, 1024, 1024, S, E); }
    SEAM(6);
    DBG16(7, 5, HMID, (size_t)ML * 4096);
    if (IN(7)) { pg8::SchedStd S; S.init(HMID, W2t, ML, 1024, 64, 4096, G, c, (size_t)64 * 32768); pg8::EpiResF<true> E{XS, XS, mods + 5120, GM + 4096, H, SSQ};
        pg8::gemm_phase<pg8::EpiResF<true>, pg8::SchedStd, false>(lds, 4096, 64, 4096, S, E, 32768, 128); }
    SEAM(7);
    const float* mods1 = mods + 5 * 6144;
    DBG32(8, 6, out, (size_t)ML * 1024);
    if (IN(9)) { pg8::SchedF1 S{(const char*)CS, (const char*)H, G, c}; pg8::EpiZ0F E{Z0, BVF, SSQ};
        pg8::gemm_phase<pg8::EpiZ0F, pg8::SchedF1, true>(lds, 256, 256, 1024, S, E); }
    SEAM(9);
    DBG16(10, 7, Z0, (size_t)262144 * 128);
    if (IN(10)) { PHASE_IDS; for (int r_ = 0; r_ < REP_S12; ++r_) s1_phase(Z0, Dt, Z1, lds, gw, NGW); }
    SEAM(10);
    DBG16(11, 8, Z1, (size_t)262144 * 128);
    if (IN(11)) { PHASE_IDS; for (int r_ = 0; r_ < REP_S12; ++r_) s2_phase(Z1, Et, Fb, gw, NGW, lane); }
    SEAM(11);
    DBG16(12, 9, Fb, (size_t)ML * 1024);
    if (IN(12)) { pg8::SchedStd S; S.init(Fb, FWt, ML, 1024, 1024, 1024, G, c); pg8::EpiResF<true> E{XS, XS, mods1 + 2048, GM + 8192, H, SSQ};
        pg8::gemm_phase<pg8::EpiResF<true>, pg8::SchedStd, false>(lds, 1024, 1024, 1024, S, E); }
    SEAM(12);
    DBG32(13, 10, out, (size_t)ML * 1024);
    if (IN(14)) { pg8::SchedStd S; S.init(H, W1t + (size_t)4096 * 1024, ML, 4096, 1024, 1024, G, c); pg8::EpiRelu2F E{HMID, 4096, BV1, SSQ};
        pg8::gemm_phase<pg8::EpiRelu2F, pg8::SchedStd, false>(lds, 1024, 1024, 1024, S, E); }
    SEAM(14);
    DBG16(15, 11, HMID, (size_t)ML * 4096);
    if (IN(15)) { pg8::SchedStd S; S.init(HMID, W2t + (size_t)1024 * 4096, ML, 1024, 64, 4096, G, c, (size_t)64 * 32768); pg8::EpiRes E{XS, out, mods1 + 5120};
        pg8::gemm_phase<pg8::EpiRes, pg8::SchedStd, false>(lds, 4096, 64, 4096, S, E, 32768, 128); }
    SEAM(15);
    if (MK_DEBUG && IN(16)) {
        int t_ = threadIdx.x; asm volatile("" : "+v"(t_));
        bool bad = false;
        for (size_t i = (size_t)vcu * 512 + t_; i < (size_t)ML * 1024; i += (size_t)G * 512) { if ((__float_as_uint(out[i]) & 0x7f800000u) == 0x7f800000u) { bad = true; out[i] = 0.f; } }
        if (bad) atomicOr(dflags, 1u << 12);
    }
    SEAM(16);
    if (MK_DEBUG && IN(17)) {
        if (c == 0 && threadIdx.x == 0) { const unsigned f = *dflags; if (f) out[0] = 1.0e6f * (float)(__builtin_ctz(f) + 1) + 1.0e4f * (float)__builtin_popcount(f); }
    }
#undef IN
#undef SEAM
}

constexpr int NPHASE = MK_DEBUG ? 18 : 16;
#ifndef MK_USE_CG
#define MK_USE_CG 0
#endif
#ifndef MK_PER_PHASE
#define MK_PER_PHASE 0
#endif

extern "C" void kernel_launch(void* const* d_in, const int* in_sizes, int n_in, void* d_out, int out_size, void* d_ws, size_t ws_size, hipStream_t stream) {
    static int grid = 0;
    if (grid == 0) {
        if (n_in != 15 || out_size != ML * DM || ws_size < WS_END) { fprintf(stderr, "kernel_launch: unexpected shapes (n_in %d out %d ws %zu)\n", n_in, out_size, ws_size); grid = -1; return; }
        int dev = 0, cus = 0, per_cu = 0;
        hipGetDevice(&dev); hipDeviceGetAttribute(&cus, hipDeviceAttributeMultiprocessorCount, dev);
        hipFuncSetAttribute((const void*)fwd_kernel, hipFuncAttributeMaxDynamicSharedMemorySize, LDS_BYTES);
        if (hipOccupancyMaxActiveBlocksPerMultiprocessor(&per_cu, (const void*)fwd_kernel, 512, LDS_BYTES) != hipSuccess || per_cu < 1) { fprintf(stderr, "kernel_launch: occupancy query failed (%d)\n", per_cu); (void)hipGetLastError(); per_cu = 1; }
        grid = cus * 1;
        if (grid <= 0) grid = 256;
    }
    if (grid < 0) return;
    if (hipMemsetAsync((char*)d_ws + WS_BAR, 0, BAR_BYTES, stream) != hipSuccess) { fprintf(stderr, "kernel_launch: memset failed\n"); return; }
    Args a{};
    for (int i = 0; i < 15; ++i) a.in[i] = (const float*)d_in[i];
    a.out = (float*)d_out; a.ws = (unsigned char*)d_ws;
#if MK_PER_PHASE
    for (int p = 0; p < NPHASE; ++p) { a.ph_lo = p; a.ph_hi = p + 1; hipLaunchKernelGGL(fwd_kernel, dim3(grid), dim3(512), LDS_BYTES, stream, a); }
#else
    a.ph_lo = 0; a.ph_hi = NPHASE; a.use_cg = MK_USE_CG;
    void* kargs[] = {&a};
    hipError_t e = hipLaunchCooperativeKernel((const void*)fwd_kernel, dim3(grid), dim3(512), kargs, LDS_BYTES, stream);
    if (e != hipSuccess) fprintf(stderr, "cooperative launch failed: %s (grid %d)\n", hipGetErrorString(e), grid);
#endif
}
```

```cpp
#include <hip/hip_runtime.h>
#include <hip/hip_cooperative_groups.h>
#include <cstdio>
#include <cstdint>
namespace cg = cooperative_groups;

#define LAS __attribute__((address_space(3)))
typedef unsigned short bf16_t;
typedef short bf16x8 __attribute__((ext_vector_type(8)));
typedef short s16x4 __attribute__((ext_vector_type(4)));
typedef float f32x4 __attribute__((ext_vector_type(4)));
typedef unsigned u32x4 __attribute__((ext_vector_type(4)));
typedef unsigned u32x2 __attribute__((ext_vector_type(2)));

constexpr int DM = 1024, NB = 4, SEQ = 4096, CTXL = 256, FF = 4096;
constexpr int ML = NB * SEQ;
constexpr int MT = ML + NB * CTXL;
constexpr float LOG2E = 1.4426950408889634f;
constexpr float EPS = 1e-6f;

constexpr size_t MiB = 1u << 20;
constexpr size_t WS_MODS = 0;
constexpr size_t WS_SB = 512 * 1024;
constexpr size_t WS_BAR = 1 * MiB;
constexpr size_t BAR_BYTES = 16384;
constexpr size_t WS_CS = 2 * MiB;
constexpr size_t WS_D = 2 * MiB + 512 * 1024;
constexpr size_t WS_E = 3 * MiB;
constexpr size_t WS_WQK = 4 * MiB, WS_WV = 8 * MiB, WS_WO = 10 * MiB, WS_FW = 12 * MiB;
constexpr size_t WS_W1 = 14 * MiB;
constexpr size_t WS_W2 = 30 * MiB;
constexpr size_t WS_SSQ = 46 * MiB;
constexpr size_t WS_BV = 47 * MiB;
constexpr size_t WS_H = 48 * MiB;
constexpr size_t WS_R = 82 * MiB;
constexpr size_t WS_QK = WS_R;
constexpr size_t WS_VT = WS_R + 68 * MiB;
constexpr size_t WS_O = WS_R + 102 * MiB;
constexpr size_t WS_HMID = WS_R;
constexpr size_t WS_Z0 = WS_R;
constexpr size_t WS_Z1 = WS_R + 64 * MiB;
constexpr size_t WS_F = WS_R;
constexpr size_t WS_XS = WS_R + 134 * MiB;
constexpr size_t WS_END = 256 * MiB;
static_assert(WS_XS + 32 * MiB <= WS_END && WS_O + 32 * MiB <= WS_XS && WS_F + 32 * MiB <= WS_END && WS_HMID + 128 * MiB <= WS_END && WS_O + 32 * MiB <= WS_END, "ws map");

constexpr int LDS_BYTES = 147456;

typedef __bf16 bf16v2_t __attribute__((ext_vector_type(2)));
typedef float f32v2_t __attribute__((ext_vector_type(2)));
__device__ __forceinline__ unsigned cvt_pk_bf16(float lo, float hi) { const f32v2_t v = {lo, hi}; const bf16v2_t r = __builtin_convertvector(v, bf16v2_t); return __builtin_bit_cast(unsigned, r); }
__device__ __forceinline__ f32x4 mfma16(bf16x8 a, bf16x8 b, f32x4 c) { return __builtin_amdgcn_mfma_f32_16x16x32_bf16(a, b, c, 0, 0, 0); }


#ifndef MK_WT
#define MK_WT 0
#endif
__device__ __forceinline__ void st16(void* p, u32x4 v) {
#if MK_WT
    asm volatile("global_store_dwordx4 %0, %1, off sc1\n\ts_nop 1" :: "v"(p), "v"(v) : "memory");
#else
    *(u32x4*)p = v;
#endif
}
__device__ __forceinline__ void st16f(void* p, f32x4 v) {
#if MK_WT
    asm volatile("global_store_dwordx4 %0, %1, off sc1\n\ts_nop 1" :: "v"(p), "v"(v) : "memory");
#else
    *(f32x4*)p = v;
#endif
}
__device__ __forceinline__ void st8(void* p, u32x2 v) {
#if MK_WT
    asm volatile("global_store_dwordx2 %0, %1, off sc1\n\ts_nop 1" :: "v"(p), "v"(v) : "memory");
#else
    *(u32x2*)p = v;
#endif
}
namespace pg8 {
constexpr int BM = 256, BK = 64, HALF = 128, HTB = HALF * BK * 2, STAGE_BYTES = 8 * HTB;
__device__ __forceinline__ int lds_byte(int r, int c) { const int st = (r >> 4) * 2 + (c >> 5), rr = r & 15, cc = c & 31, ob = rr * 64 + cc * 2; return st * 1024 + (ob ^ (((ob >> 9) & 1) << 5)); }
__device__ __forceinline__ void stage_rc(int b, int& R, int& C) { const int st = b / 1024, sb = b % 1024, swz = sb ^ (((sb >> 9) & 1) << 5); R = (st >> 1) * 16 + swz / 64; C = (st & 1) * 32 + (swz % 64) / 2; }
__device__ __forceinline__ int perm32(int rho) { const int n = rho >> 4, i = rho & 15; return 8 * (i >> 2) + 4 * n + (i & 3); }

struct Unit { int pm, pn, kind, aux; const char* a; const char* b; };

template <class Epi, class Sched, bool BMAP>
__device__ __forceinline__ void gemm_phase(LAS unsigned char* lds, const int K, const int lda, const int ldb, const Sched& S, const Epi& E, const size_t kstepA = 128, const size_t kstepB = 128) {
    int tid = threadIdx.x; asm volatile("" : "+v"(tid));
    const int wid = __builtin_amdgcn_readfirstlane(tid >> 6), lane = tid & 63, wr = wid >> 2, wc = wid & 3, fr = lane & 15, fq = lane >> 4;
    int nt = K / BK; asm volatile("" : "+s"(nt));
    unsigned voffA[2], voffB[2];
#pragma unroll
    for (int i = 0; i < 2; ++i) { int R, C; stage_rc(tid * 16 + i * 8192, R, C); const int Rb = (R & ~31) + perm32(R & 31);
        voffA[i] = (unsigned)(R * lda + C) * 2u;
        voffB[i] = BMAP ? (unsigned)((64 * (Rb & 63) + (Rb >> 6)) * ldb + C) * 2u : (unsigned)(Rb * ldb + C) * 2u; }
    const size_t hstepA = (size_t)HALF * lda * 2;
    const size_t hstepB = BMAP ? (size_t)2 * ldb * 2 : (size_t)HALF * ldb * 2;
    const unsigned ldsw = (unsigned)wid * 1024u;
    const int aoff = lds_byte(wr * 64 + fr, fq * 8), boff = lds_byte(wc * 32 + fr, fq * 8);
#define PG8_SA(b, h) (((b) * 2 + (h)) * HTB)
#define PG8_SB(b, h) ((4 + (b) * 2 + (h)) * HTB)
#define PG8_STAGE(bufoff, gbase, voff) do { _Pragma("unroll") for (int _i = 0; _i < 2; ++_i) \
        __builtin_amdgcn_global_load_lds((const unsigned*)((const char*)(gbase) + (voff)[_i]), (LAS unsigned*)(lds + (bufoff) + ldsw + _i * 8192), 16, 0, 0); } while (0)
#define PG8_LDA(dst, b, h) do { _Pragma("unroll") for (int m = 0; m < 4; ++m) _Pragma("unroll") for (int k = 0; k < 2; ++k) dst[m][k] = *(const LAS bf16x8*)(lds + PG8_SA(b, h) + aoff + m * 2048 + k * 1024); } while (0)
#define PG8_LDB(dst, b, h) do { _Pragma("unroll") for (int n = 0; n < 2; ++n) _Pragma("unroll") for (int k = 0; k < 2; ++k) dst[n][k] = *(const LAS bf16x8*)(lds + PG8_SB(b, h) + boff + n * 2048 + k * 1024); } while (0)
#define PG8_MMA(ai, bj, At, Bt) do { __builtin_amdgcn_s_setprio(1); _Pragma("unroll") for (int m = 0; m < 4; ++m) _Pragma("unroll") for (int n = 0; n < 2; ++n) _Pragma("unroll") for (int k = 0; k < 2; ++k) \
        acc[ai][bj][m][n] = __builtin_amdgcn_mfma_f32_16x16x32_bf16(Bt[n][k], At[m][k], acc[ai][bj][m][n], 0, 0, 0); __builtin_amdgcn_s_setprio(0); } while (0)
#define PG8_WAIT_V(n) asm volatile("s_waitcnt vmcnt(" #n ")" ::: "memory")
#define PG8_WAIT_L(n) asm volatile("s_waitcnt lgkmcnt(" #n ")" ::: "memory")
#define PG8_BAR __builtin_amdgcn_s_barrier()
#define PG8_SCHED __builtin_amdgcn_sched_barrier(0)
    Unit cur, nxt; int ui = 0;
    if (!S.next(0, cur)) return;
    f32x4 acc[2][2][4][2];
#pragma unroll
    for (int a = 0; a < 2; ++a)
#pragma unroll
        for (int b = 0; b < 2; ++b)
#pragma unroll
            for (int m = 0; m < 4; ++m)
#pragma unroll
                for (int n = 0; n < 2; ++n) acc[a][b][m][n] = (f32x4){0.f, 0.f, 0.f, 0.f};
    bf16x8 At[4][2], B0[2][2], B1[2][2];
    const char* cA = cur.a; const char* cB = cur.b;
    if constexpr (Epi::PREP) E.prep(cur, lds, 0, tid);
    PG8_STAGE(PG8_SB(0, 0), cB, voffB); PG8_STAGE(PG8_SB(0, 1), cB + hstepB, voffB); PG8_STAGE(PG8_SA(0, 0), cA, voffA); PG8_STAGE(PG8_SA(0, 1), cA + hstepA, voffA);
    if (wr == 1) PG8_BAR;
    PG8_WAIT_V(2); PG8_BAR;
    PG8_STAGE(PG8_SB(1, 0), cB + kstepB, voffB); PG8_STAGE(PG8_SA(1, 0), cA + kstepA, voffA); PG8_STAGE(PG8_SB(1, 1), cB + hstepB + kstepB, voffB);
    PG8_WAIT_V(6); PG8_BAR;
    for (;;) {
        const bool has_next = S.next(ui + 1, nxt);
        const char* nA = has_next ? nxt.a : cA; const char* nB = has_next ? nxt.b : cB;
        for (int t = 0; t < nt; t += 2) {
            const bool last = (t == nt - 2);
            const char* a1 = cA + (size_t)(t + 1) * kstepA;
            const char* a2 = last ? nA : cA + (size_t)(t + 2) * kstepA; const char* b2 = last ? nB : cB + (size_t)(t + 2) * kstepB;
            const char* a3 = a2 + kstepA; const char* b3 = b2 + kstepB;
            PG8_LDB(B0, 0, 0); PG8_LDB(B1, 0, 1); PG8_SCHED; PG8_LDA(At, 0, 0); PG8_STAGE(PG8_SA(1, 1), a1 + hstepA, voffA);
            PG8_WAIT_V(8); PG8_WAIT_L(0); PG8_BAR; PG8_MMA(0, 0, At, B0); PG8_MMA(0, 1, At, B1); PG8_BAR; PG8_SCHED;
            PG8_LDA(At, 0, 1); PG8_STAGE(PG8_SB(0, 0), b2, voffB); PG8_STAGE(PG8_SB(0, 1), b2 + hstepB, voffB); PG8_STAGE(PG8_SA(0, 0), a2, voffA);
            PG8_WAIT_V(8); PG8_WAIT_L(0); PG8_BAR; PG8_MMA(1, 0, At, B0); PG8_MMA(1, 1, At, B1); PG8_BAR; PG8_SCHED;
            PG8_LDB(B0, 1, 0); PG8_LDB(B1, 1, 1); PG8_SCHED; PG8_LDA(At, 1, 0); PG8_STAGE(PG8_SA(0, 1), a2 + hstepA, voffA);
            PG8_WAIT_V(8); PG8_WAIT_L(0); PG8_BAR; PG8_MMA(0, 0, At, B0); PG8_MMA(0, 1, At, B1); PG8_BAR; PG8_SCHED;
            PG8_LDA(At, 1, 1); PG8_STAGE(PG8_SB(1, 0), b3, voffB); PG8_STAGE(PG8_SB(1, 1), b3 + hstepB, voffB); PG8_STAGE(PG8_SA(1, 0), a3, voffA);
            PG8_WAIT_V(8); PG8_WAIT_L(0); PG8_BAR; PG8_MMA(1, 0, At, B0); PG8_MMA(1, 1, At, B1); PG8_BAR; PG8_SCHED;
        }
        if (wr == 0) PG8_BAR;
        if constexpr (Epi::PREP) { if (has_next) E.prep(nxt, lds, (ui + 1) & 1, tid); }
        E(acc, cur, wr, wc, fr, fq, lds, ui & 1);
        if (!has_next) break;
#pragma unroll
        for (int a = 0; a < 2; ++a)
#pragma unroll
            for (int b = 0; b < 2; ++b)
#pragma unroll
                for (int m = 0; m < 4; ++m)
#pragma unroll
                    for (int n = 0; n < 2; ++n) acc[a][b][m][n] = (f32x4){0.f, 0.f, 0.f, 0.f};
        cur = nxt; cA = nA; cB = nB; ++ui;
        if (wr == 1) PG8_BAR;
    }
    PG8_WAIT_V(0);
    PG8_BAR;
#undef PG8_SA
#undef PG8_SB
#undef PG8_STAGE
#undef PG8_LDA
#undef PG8_LDB
#undef PG8_MMA
#undef PG8_WAIT_V
#undef PG8_WAIT_L
#undef PG8_BAR
#undef PG8_SCHED
}

struct SchedStd {
    const char* A; const char* Bt; size_t tsA, tsB; int nM, nN, nwg, G, c;
    __device__ void init(const void* A_, const void* Bt_, int M, int N, int lda, int ldb, int G_, int c_, size_t tsA_ = 0) { A = (const char*)A_; Bt = (const char*)Bt_; tsA = tsA_ ? tsA_ : (size_t)BM * lda * 2; tsB = (size_t)BM * ldb * 2; nM = M / BM; nN = N / BM; nwg = nM * nN; G = G_; c = c_; }
    __device__ bool next(int i, Unit& u) const {
        const long L = (long)i * G + c; if (L >= nwg) return false;
        int wgid = (int)L; { const int q = nwg / 8, r = nwg % 8, xcd = wgid % 8, off = wgid / 8; wgid = (xcd < r ? xcd * (q + 1) : r * (q + 1) + (xcd - r) * q) + off; }
        const int nig = 8 * nN, gid = wgid / nig, fm = gid * 8, gsz = (nM - fm) < 8 ? (nM - fm) : 8;
        u.pm = fm + ((wgid % nig) % gsz); u.pn = (wgid % nig) / gsz; u.kind = 0; u.aux = 0;
        u.a = A + (size_t)u.pm * tsA; u.b = Bt + (size_t)u.pn * tsB; return true;
    }
};
struct SchedQKV {
    const char* H; const char* Wqk; const char* Wv; int G, c, nunits;
    __device__ bool next(int i, Unit& u) const {
        const long Ll = (long)i * G + c; if (Ll >= nunits) return false;
        const int L = (int)Ll; const size_t ts = (size_t)BM * 1024 * 2; u.aux = 0;
        if (L < 512) { const int x = L & 7, off = L >> 3; u.kind = 0; u.pm = 8 * x + (off & 7); u.pn = off >> 3; }
        else if (L < 768) { const int l2 = L - 512, x = l2 & 7, off = l2 >> 3; u.kind = 1; u.pm = off & 3; u.pn = 8 * x + (off >> 2); }
        else if (L < 784) { const int l2 = L - 768; u.kind = 0; u.pm = 64 + (l2 & 3); u.pn = 4 + (l2 >> 2); }
        else { const int l2 = L - 784; u.kind = 1; u.pm = l2 & 3; u.pn = 64 + (l2 >> 2); }
        if (u.kind == 0) { u.a = H + (size_t)u.pm * ts; u.b = Wqk + (size_t)u.pn * ts; }
        else { u.a = Wv + (size_t)u.pm * ts; u.b = H + (size_t)u.pn * ts; }
        return true;
    }
};
struct SchedOne { Unit u;
    __device__ __forceinline__ bool next(int i, Unit& o) const { if (i > 0) return false; o = u; return true; }
};
struct SchedF1 {
    const char* CS; const char* H; int G, c;
    __device__ bool next(int i, Unit& u) const {
        const long Ll = (long)i * G + c; if (Ll >= 256) return false;
        const int L = (int)Ll; const int t = L & 15, b = (L >> 4) & 3, g = (L >> 6) & 3;
        u.pm = 0; u.pn = t; u.kind = g; u.aux = b;
        u.a = CS; u.b = H + ((size_t)(b * 4096 + 4 * t) * 1024 + g * 256) * 2; return true;
    }
};

typedef f32x4 Acc[2][2][4][2];
__device__ __forceinline__ u32x4 pack8(f32x4 v0, f32x4 v1) { u32x4 w; w.x = cvt_pk_bf16(v0[0], v0[1]); w.y = cvt_pk_bf16(v0[2], v0[3]); w.z = cvt_pk_bf16(v1[0], v1[1]); w.w = cvt_pk_bf16(v1[2], v1[3]); return w; }

__device__ __forceinline__ void unpack8(u32x4 w, f32x4& v0, f32x4& v1) {
    v0[0] = __uint_as_float(w.x << 16); v0[1] = __uint_as_float(w.x & 0xffff0000u); v0[2] = __uint_as_float(w.y << 16); v0[3] = __uint_as_float(w.y & 0xffff0000u);
    v1[0] = __uint_as_float(w.z << 16); v1[1] = __uint_as_float(w.z & 0xffff0000u); v1[2] = __uint_as_float(w.w << 16); v1[3] = __uint_as_float(w.w & 0xffff0000u);
}
struct EpiQKV { static constexpr bool PREP = true; bf16_t* QK; bf16_t* VT; const float* gq; const float* gk;
    __device__ __forceinline__ void prep(const Unit& u, LAS unsigned char* lds, int slot, int tid) const {
        if (u.kind == 0 && tid < 64) { const bool isq = u.pn < 4; ((LAS float*)(lds + 131072))[slot * 512 + tid] = isq ? gq[tid] * (0.125f * LOG2E) : gk[tid]; }
    }
    __device__ __forceinline__ void operator()(const Acc& acc, const Unit& u, int wr, int wc, int fr, int fq, LAS unsigned char* lds, int slot) const {
        if (u.kind == 0) {
            const LAS float* gp = (const LAS float*)(lds + 131072) + slot * 512;
            f32x4 gv[2][2];
#pragma unroll
            for (int bj = 0; bj < 2; ++bj)
#pragma unroll
                for (int n = 0; n < 2; ++n) gv[bj][n] = *(const LAS f32x4*)(gp + 32 * bj + 8 * fq + 4 * n);
#pragma unroll
            for (int ai = 0; ai < 2; ++ai)
#pragma unroll
                for (int m = 0; m < 4; ++m) {
                    const int row = u.pm * BM + ai * HALF + wr * 64 + m * 16 + fr;
                    float ss = 0.f;
#pragma unroll
                    for (int bj = 0; bj < 2; ++bj)
#pragma unroll
                        for (int n = 0; n < 2; ++n) { const f32x4 x = acc[ai][bj][m][n]; ss += (x[0] * x[0] + x[1] * x[1]) + (x[2] * x[2] + x[3] * x[3]); }
                    ss += __shfl_xor(ss, 16); ss += __shfl_xor(ss, 32);
                    const float rstd = rsqrtf(ss * (1.0f / 64.0f) + EPS);
                    bf16_t* rowp = QK + (size_t)row * 2048 + u.pn * 256 + wc * 64 + 8 * fq;
#pragma unroll
                    for (int bj = 0; bj < 2; ++bj) st16(rowp + 32 * bj, pack8(acc[ai][bj][m][0] * rstd * gv[bj][0], acc[ai][bj][m][1] * rstd * gv[bj][1]));
                }
        } else {
#pragma unroll
            for (int ai = 0; ai < 2; ++ai)
#pragma unroll
                for (int m = 0; m < 4; ++m) {
                    const int row = u.pm * BM + ai * HALF + wr * 64 + m * 16 + fr;
                    bf16_t* rowp = VT + (size_t)row * MT + u.pn * 256 + wc * 32 + 8 * fq;
#pragma unroll
                    for (int bj = 0; bj < 2; ++bj) st16(rowp + bj * HALF, pack8(acc[ai][bj][m][0], acc[ai][bj][m][1]));
                }
        }
    }
};
struct EpiRelu2 { static constexpr bool PREP = false; bf16_t* O; int ldc;
    __device__ __forceinline__ void operator()(const Acc& acc, const Unit& u, int wr, int wc, int fr, int fq, LAS unsigned char*, int) const {
#pragma unroll
        for (int ai = 0; ai < 2; ++ai)
#pragma unroll
            for (int m = 0; m < 4; ++m) {
                const int row = u.pm * BM + ai * HALF + wr * 64 + m * 16 + fr;
                bf16_t* rowp = O + (size_t)row * ldc + u.pn * 256 + wc * 32 + 8 * fq;
#pragma unroll
                for (int bj = 0; bj < 2; ++bj) { f32x4 v0 = acc[ai][bj][m][0], v1 = acc[ai][bj][m][1];
#pragma unroll
                    for (int e = 0; e < 4; ++e) { const float a = fmaxf(v0[e], 0.f), b = fmaxf(v1[e], 0.f); v0[e] = a * a; v1[e] = b * b; }
                    *(u32x4*)(rowp + bj * HALF) = pack8(v0, v1); }
            }
    }
};
struct EpiRes { static constexpr bool PREP = false; const bf16_t* base; float* out; const float* gate;
    __device__ __forceinline__ void operator()(const Acc& acc, const Unit& u, int wr, int wc, int fr, int fq, LAS unsigned char*, int) const {
        const int col0 = u.pn * 256 + wc * 32 + 8 * fq;
        const float* gp = gate + (size_t)(u.pm >> 4) * 6144 + col0;
        f32x4 gv[2][2];
#pragma unroll
        for (int bj = 0; bj < 2; ++bj)
#pragma unroll
            for (int n = 0; n < 2; ++n) gv[bj][n] = *(const f32x4*)(gp + bj * HALF + 4 * n);
#pragma unroll
        for (int ai = 0; ai < 2; ++ai)
#pragma unroll
          for (int mh = 0; mh < 2; ++mh) {
            u32x4 pre[2][2];
#pragma unroll
            for (int m2 = 0; m2 < 2; ++m2)
#pragma unroll
                for (int bj = 0; bj < 2; ++bj) pre[m2][bj] = *(const u32x4*)(base + (size_t)(u.pm * BM + ai * HALF + wr * 64 + (2 * mh + m2) * 16 + fr) * 1024 + col0 + bj * HALF);
            asm volatile("" ::: "memory");
#pragma unroll
            for (int m2 = 0; m2 < 2; ++m2) { const int m = 2 * mh + m2;
                const size_t off = (size_t)(u.pm * BM + ai * HALF + wr * 64 + m * 16 + fr) * 1024 + col0;
#pragma unroll
                for (int bj = 0; bj < 2; ++bj) { f32x4 b0, b1; unpack8(pre[m2][bj], b0, b1);
                    *(f32x4*)(out + off + bj * HALF) = b0 + gv[bj][0] * acc[ai][bj][m][0]; *(f32x4*)(out + off + bj * HALF + 4) = b1 + gv[bj][1] * acc[ai][bj][m][1]; }
            }
            asm volatile("" ::: "memory");
          }
    }
};
struct EpiZ0 { static constexpr bool PREP = false; bf16_t* Z0;
    __device__ __forceinline__ void operator()(const Acc& acc, const Unit& u, int wr, int wc, int fr, int fq, LAS unsigned char*, int) const {
        const int ri = u.pm, t = u.pn, g = u.kind, b = u.aux;
        bf16_t* p0 = Z0 + ((size_t)(((b * 4 + g) * 256 + wr * 64 + fr) * 64 + 4 * t + (wc >> 1))) * 128 + ri * 64 + 32 * (wc & 1) + 8 * fq;
#pragma unroll
        for (int ai = 0; ai < 2; ++ai)
#pragma unroll
            for (int m = 0; m < 4; ++m) {
#pragma unroll
                for (int bj = 0; bj < 2; ++bj)
                    *(u32x4*)(p0 + (size_t)(ai * HALF + m * 16) * 8192 + bj * 256) = pack8(acc[ai][bj][m][0], acc[ai][bj][m][1]);
                asm volatile("" ::: "memory");
            }
    }
};

constexpr int AUX_OFF = 131072;
template <bool BASE16>
struct EpiResF { static constexpr bool PREP = false; const void* base; bf16_t* XS; const float* gate; const float* gm; bf16_t* XB; float* SSQ;
    __device__ __forceinline__ void operator()(const Acc& acc, const Unit& u, int wr, int wc, int fr, int fq, LAS unsigned char*, int) const {
        const int col0 = u.pn * 256 + wc * 32 + 8 * fq, b = u.pm >> 4;
        f32x4 gv[2][2], mv[2][2];
#pragma unroll
        for (int bj = 0; bj < 2; ++bj)
#pragma unroll
            for (int n = 0; n < 2; ++n) { gv[bj][n] = *(const f32x4*)(gate + (size_t)b * 6144 + col0 + bj * HALF + 4 * n); mv[bj][n] = *(const f32x4*)(gm + b * 1024 + col0 + bj * HALF + 4 * n); }
#pragma unroll
        for (int ai = 0; ai < 2; ++ai)
#pragma unroll
          for (int mh = 0; mh < 2; ++mh) {
            f32x4 pre[2][2][2];
#pragma unroll
            for (int m2 = 0; m2 < 2; ++m2) { const size_t off = (size_t)(u.pm * BM + ai * HALF + wr * 64 + (2 * mh + m2) * 16 + fr) * 1024 + col0;
#pragma unroll
                for (int bj = 0; bj < 2; ++bj) {
                    if (BASE16) { const u32x4 w = *(const u32x4*)((const bf16_t*)base + off + bj * HALF); unpack8(w, pre[m2][bj][0], pre[m2][bj][1]); }
                    else { pre[m2][bj][0] = *(const f32x4*)((const float*)base + off + bj * HALF); pre[m2][bj][1] = *(const f32x4*)((const float*)base + off + bj * HALF + 4); }
                } }
            asm volatile("" ::: "memory");
#pragma unroll
            for (int m2 = 0; m2 < 2; ++m2) {
                const int m = 2 * mh + m2;
                const int row = u.pm * BM + ai * HALF + wr * 64 + m * 16 + fr;
                const size_t off = (size_t)row * 1024 + col0;
                float ss = 0.f;
#pragma unroll
                for (int bj = 0; bj < 2; ++bj) {
                    const f32x4 v0 = pre[m2][bj][0] + gv[bj][0] * acc[ai][bj][m][0];
                    const f32x4 v1 = pre[m2][bj][1] + gv[bj][1] * acc[ai][bj][m][1];
                    st16(XS + off + bj * HALF, pack8(v0, v1));
                    ss += ((v0[0] * v0[0] + v0[1] * v0[1]) + (v0[2] * v0[2] + v0[3] * v0[3])) + ((v1[0] * v1[0] + v1[1] * v1[1]) + (v1[2] * v1[2] + v1[3] * v1[3]));
                    st16(XB + off + bj * HALF, pack8(v0 * mv[bj][0], v1 * mv[bj][1]));
                }
                ss += __shfl_xor(ss, 16); ss += __shfl_xor(ss, 32);
                if (fq == 0) SSQ[(size_t)row * 16 + u.pn * 4 + wc] = ss;
            }
            asm volatile("" ::: "memory");
          }
    }
};
__device__ __forceinline__ float ssq_rstd(const float* SSQ, int row, int half) {
    const f32x4 a = *(const f32x4*)(SSQ + (size_t)row * 16 + half * 8), b = *(const f32x4*)(SSQ + (size_t)row * 16 + half * 8 + 4);
    float s = ((a[0] + a[1]) + (a[2] + a[3])) + ((b[0] + b[1]) + (b[2] + b[3]));
    s += __shfl_xor(s, 1);
    return rsqrtf(s * (1.0f / 1024.0f) + EPS);
}
struct EpiRelu2F { static constexpr bool PREP = true; bf16_t* O; int ldc; const float* BV; const float* SSQ;
    __device__ __forceinline__ void prep(const Unit& u, LAS unsigned char* lds, int slot, int tid) const {
        const float r = ssq_rstd(SSQ, u.pm * BM + (tid >> 1), tid & 1);
        LAS float* aux = (LAS float*)(lds + AUX_OFF) + slot * 512;
        if (!(tid & 1)) aux[tid >> 1] = r;
        if (tid < 256) aux[256 + tid] = BV[(size_t)(u.pm >> 4) * 4096 + u.pn * 256 + tid];
    }
    __device__ __forceinline__ void operator()(const Acc& acc, const Unit& u, int wr, int wc, int fr, int fq, LAS unsigned char* lds, int slot) const {
        const LAS float* rt = (const LAS float*)(lds + AUX_OFF) + slot * 512;
        const int col0 = u.pn * 256 + wc * 32 + 8 * fq;
        f32x4 bv[2][2];
#pragma unroll
        for (int bj = 0; bj < 2; ++bj)
#pragma unroll
            for (int n = 0; n < 2; ++n) bv[bj][n] = *(const LAS f32x4*)(rt + 256 + wc * 32 + 8 * fq + bj * HALF + 4 * n);
#pragma unroll
        for (int ai = 0; ai < 2; ++ai)
#pragma unroll
            for (int m = 0; m < 4; ++m) {
                const int rl = ai * HALF + wr * 64 + m * 16 + fr; const float rs = rt[rl];
                bf16_t* rowp = O + ((size_t)(u.pm * 64 + u.pn * 4 + (wc >> 1)) * 256 + rl) * 64 + (wc & 1) * 32 + 8 * fq;
#pragma unroll
                for (int bj = 0; bj < 2; ++bj) { f32x4 v0 = acc[ai][bj][m][0] * rs + bv[bj][0], v1 = acc[ai][bj][m][1] * rs + bv[bj][1];
#pragma unroll
                    for (int e = 0; e < 4; ++e) { const float a = fmaxf(v0[e], 0.f), c2 = fmaxf(v1[e], 0.f); v0[e] = a * a; v1[e] = c2 * c2; }
                    st16(rowp + bj * 2 * 256 * 64, pack8(v0, v1)); }
            }
    }
};
constexpr int NCOL = 2064;
struct EpiZ0F { static constexpr bool PREP = true; bf16_t* Z0; const float* BVF; const float* SSQ;
    __device__ __forceinline__ void prep(const Unit& u, LAS unsigned char* lds, int slot, int tid) const {
        const int nl = tid >> 1, tok = u.aux * 4096 + 64 * (nl & 63) + 4 * u.pn + (nl >> 6);
        const float r = ssq_rstd(SSQ, tok, tid & 1);
        LAS float* aux = (LAS float*)(lds + AUX_OFF) + slot * 512;
        if (!(tid & 1)) aux[nl] = r;
        if (tid < 256) aux[256 + tid] = BVF[(size_t)(u.aux * 4 + u.kind) * 256 + tid];
    }
    __device__ __forceinline__ void operator()(const Acc& acc, const Unit& u, int wr, int wc, int fr, int fq, LAS unsigned char* lds, int slot) const {
        const LAS float* rt = (const LAS float*)(lds + AUX_OFF) + slot * 512;
        const int t = u.pn, g = u.kind, b = u.aux;
        f32x4 rs[2][2];
#pragma unroll
        for (int bj = 0; bj < 2; ++bj)
#pragma unroll
            for (int n = 0; n < 2; ++n) rs[bj][n] = *(const LAS f32x4*)(rt + bj * HALF + wc * 32 + 8 * fq + 4 * n);
        const LAS float* bz = rt + 256 + wr * 64 + fr;
        bf16_t* p0 = Z0 + ((size_t)(((b * 4 + g) * 128 + wr * 64 + fr) * 64 + 4 * t + (wc >> 1))) * 128 + 32 * (wc & 1) + 8 * fq;
        bf16_t* ps = Z0 + ((size_t)((2048 + b * 4 + g) * 64 + 4 * t + (wc >> 1))) * 128 + 32 * (wc & 1) + 8 * fq;
#pragma unroll
        for (int ai = 0; ai < 2; ++ai)
#pragma unroll
            for (int m = 0; m < 4; ++m) {
                const float bb = bz[ai * HALF + m * 16];
                const bool nyq = (ai == 1 && m == 0) && (wr == 0) && (fr == 0);
#pragma unroll
                for (int bj = 0; bj < 2; ++bj) {
                    const u32x4 v = pack8(acc[ai][bj][m][0] * rs[bj][0] + bb, acc[ai][bj][m][1] * rs[bj][1] + bb);
                    const u32x4 z = {0u, 0u, 0u, 0u};
                    st16(p0 + (size_t)(m * 16) * 8192 + ai * 64 + bj * 256, nyq ? z : v);
                    if (ai == 1 && m == 0) { if (nyq) { st16(ps + bj * 256, v); st16(ps + bj * 256 + 64, z); } }
                }
                asm volatile("" ::: "memory");
            }
    }
};
}


#define XB_TMO      128
#define XB_XCNT(j)  (256  + 64 * (j))
#define XB_XSUB(j)  (1280 + 64 * (j))
#define XB_XGEN(j)  (2304 + 64 * (j))
#define XB_TOP      3328
#define XB_TOPGEN   3392
#define XCD_BAR_WORDS 3456
#define XB_SPIN_CAP (1u << 18)
__device__ __forceinline__ unsigned xb_ld(unsigned* p)              { return __hip_atomic_load(p, __ATOMIC_RELAXED, __HIP_MEMORY_SCOPE_AGENT); }
__device__ __forceinline__ unsigned xb_add(unsigned* p, unsigned v) { return __hip_atomic_fetch_add(p, v, __ATOMIC_RELAXED, __HIP_MEMORY_SCOPE_AGENT); }
__device__ __forceinline__ unsigned xb_xcc_id() { return (unsigned)__builtin_amdgcn_s_getreg((3 << 11) | 20) & 0xFu; }
#define XB_SPIN(cond, bar) do { unsigned _sp = 0; while (cond) { __builtin_amdgcn_s_sleep(1); \
    if ((++_sp & 255u) == 0u) { if (xb_ld(&(bar)[XB_TMO])) break; if (_sp > XB_SPIN_CAP) { atomicAdd(&(bar)[XB_TMO], 1u); break; } } } } while (0)
struct XcdBarrier { unsigned* bar; unsigned x; volatile LAS unsigned* st; };
__device__ __forceinline__ XcdBarrier xcd_barrier_post(unsigned* bar, volatile LAS unsigned* st) {
    XcdBarrier b; b.bar = bar; b.x = xb_xcc_id(); b.st = st;
    if (threadIdx.x == 0) (void)xb_add(&bar[XB_XCNT(b.x)], 1u);
    return b;
}
__device__ __forceinline__ void xcd_barrier_complete(unsigned* bar, unsigned x, unsigned& nloc, unsigned& nx) {
    const unsigned G = gridDim.x * gridDim.y * gridDim.z;
    unsigned sum, cnt, mine, sp = 0u;
    for (;;) {
        sum = 0u; cnt = 0u; mine = 0u;
#pragma unroll
        for (unsigned j = 0; j < 16; ++j) { const unsigned c = xb_ld(&bar[XB_XCNT(j)]); sum += c; cnt += (c > 0u) ? 1u : 0u; mine = (j == x) ? c : mine; }
        if (sum == G) break;
        __builtin_amdgcn_s_sleep(1);
        if ((++sp & 255u) == 0u) { if (xb_ld(&bar[XB_TMO])) break; if (sp > XB_SPIN_CAP) { atomicAdd(&bar[XB_TMO], 1u); break; } }
    }
    nloc = mine > 0u ? mine : 1u; nx = cnt > 0u ? cnt : 1u;
}
__device__ __forceinline__ void xcd_barrier(const XcdBarrier& b) {
    asm volatile("s_waitcnt vmcnt(0)" ::: "memory");
    __syncthreads();
    if (threadIdx.x == 0) {
        unsigned* bar = b.bar;
        __builtin_amdgcn_s_waitcnt(0);
        unsigned nloc = b.st[0], nx = b.st[1];
        if (nloc == 0u) { xcd_barrier_complete(bar, b.x, nloc, nx); b.st[0] = nloc; b.st[1] = nx; }
        const unsigned old = xb_add(&bar[XB_XSUB(b.x)], 1u);
        const unsigned gen = old / nloc;
        if (old + 1u == (gen + 1u) * nloc) {
            __builtin_amdgcn_fence(__ATOMIC_RELEASE, "agent");
            asm volatile("s_waitcnt vmcnt(0)" ::: "memory");
            const unsigned og = xb_add(&bar[XB_TOP], 1u);
            const unsigned tg = og / nx;
            if (og + 1u == (tg + 1u) * nx) xb_add(&bar[XB_TOPGEN], 1u);
            else XB_SPIN(xb_ld(&bar[XB_TOPGEN]) == tg, bar);
            __builtin_amdgcn_fence(__ATOMIC_ACQUIRE, "agent");
            xb_add(&bar[XB_XGEN(b.x)], 1u);
            asm volatile("s_waitcnt vmcnt(0)" ::: "memory");
        } else {
            XB_SPIN(xb_ld(&bar[XB_XGEN(b.x)]) == gen, bar);
            __builtin_amdgcn_fence(__ATOMIC_ACQUIRE, "agent");
            asm volatile("s_waitcnt vmcnt(0)" ::: "memory");
        }
    }
    __syncthreads();
}
__device__ __forceinline__ void p0_mods_unit(const float* c, const float* cctx, const float* ada_w, const float* ada_b, float* mods, LAS unsigned char* lds, int unit) {
    LAS float* s = (LAS float*)lds;
    LAS float* red = s + 5 * 1024;
    int tid = threadIdx.x; asm volatile("" : "+v"(tid));
    for (int i = tid; i < 5 * 1024; i += 512) { const int v = i >> 10, k = i & 1023; const float x = v < 4 ? c[v * 1024 + k] : cctx[k]; s[i] = x / (1.0f + __expf(-x)); }
    __syncthreads();
    const int l = unit / 96, col0 = (unit % 96) * 64, kc = tid >> 6, cl = tid & 63;
    const float* w = ada_w + (size_t)l * 1024 * 6144 + col0 + cl;
    float a0 = 0.f, a1 = 0.f, a2 = 0.f, a3 = 0.f, a4 = 0.f;
    for (int k = kc * 128; k < kc * 128 + 128; k += 32) {
        float wv[32];
#pragma unroll
        for (int j = 0; j < 32; ++j) wv[j] = __builtin_nontemporal_load(w + (size_t)(k + j) * 6144);
#pragma unroll
        for (int j = 0; j < 32; ++j) { a0 += s[k + j] * wv[j]; a1 += s[1024 + k + j] * wv[j]; a2 += s[2048 + k + j] * wv[j]; a3 += s[3072 + k + j] * wv[j]; a4 += s[4096 + k + j] * wv[j]; }
    }
    red[(kc * 5 + 0) * 64 + cl] = a0; red[(kc * 5 + 1) * 64 + cl] = a1; red[(kc * 5 + 2) * 64 + cl] = a2; red[(kc * 5 + 3) * 64 + cl] = a3; red[(kc * 5 + 4) * 64 + cl] = a4;
    __syncthreads();
    if (tid < 320) { const int v = tid >> 6, cc = tid & 63; float t = 0.f;
#pragma unroll
        for (int kk = 0; kk < 8; ++kk) t += red[(kk * 5 + v) * 64 + cc];
        mods[(size_t)(l * 5 + v) * 6144 + col0 + cc] = t + ada_b[l * 6144 + col0 + cc]; }
    __syncthreads();
}

__device__ __forceinline__ void p0_transpose_item(const float* W, int K, int N, bf16_t* WT, bf16_t* WT2, int mode, LAS float* scr, int item, int lane) {
    const int nblk = N / 32, kb = item / nblk, nb = item % nblk, k0 = 64 * kb, n0 = 32 * nb;
    float wv_[32];
#pragma unroll
    for (int i = 0; i < 32; ++i) { int srow = k0 + 2 * i + (lane >> 5);
        if (mode == 2) { const int j = srow & 255; if (j > 128) srow = (srow & ~255) + 256 - (j - 128); }
        wv_[i] = __builtin_nontemporal_load(W + (size_t)srow * N + n0 + (lane & 31)); }
#pragma unroll
    for (int i = 0; i < 32; ++i) scr[(2 * i + (lane >> 5)) * 33 + (lane & 31)] = wv_[i];
    asm volatile("s_waitcnt lgkmcnt(0)" ::: "memory");
    const int cch = lane & 7;
#pragma unroll
    for (int j = 0; j < 4; ++j) { const int n = (lane >> 3) + 8 * j; const LAS float* s = scr + (8 * cch) * 33 + n;
        u32x4 o; o.x = cvt_pk_bf16(s[0 * 33], s[1 * 33]); o.y = cvt_pk_bf16(s[2 * 33], s[3 * 33]); o.z = cvt_pk_bf16(s[4 * 33], s[5 * 33]); o.w = cvt_pk_bf16(s[6 * 33], s[7 * 33]);
        const int ng = n0 + n; bf16_t* dst;
        if (mode != 1) dst = WT + (size_t)ng * K;
        else if (ng < 2048) { const int pn = ng >> 8, hh = (ng >> 6) & 3, d = ng & 63; const int tpos = (d >> 5) * 128 + hh * 32 + (d & 31); dst = WT + (size_t)(pn * 256 + tpos) * K; }
        else dst = WT2 + (size_t)(ng - 2048) * K;
        *(u32x4*)(dst + k0 + 8 * cch) = o; }
    asm volatile("s_waitcnt lgkmcnt(0)" ::: "memory");
}

__device__ __forceinline__ float wave_sum(float v) {
#pragma unroll
    for (int o = 1; o < 64; o <<= 1) v += __shfl_xor(v, o);
    return v;
}
__device__ __forceinline__ void norm_rows(const float* xlat, const float* xctx, int nrows, const float* g, const float* modsl, int sh_off, int sc_off, bf16_t* H, int gw, int NGW, int lane) {
    f32x4 gv[4];
#pragma unroll
    for (int j = 0; j < 4; ++j) gv[j] = *(const f32x4*)(g + lane * 4 + 256 * j);
    for (int row = gw; row < nrows; row += NGW) {
        const float* src = row < ML ? xlat + (size_t)row * 1024 : xctx + (size_t)(row - ML) * 1024;
        const int v = row < ML ? (row >> 12) : 4;
        const float* mp = modsl + (size_t)v * 6144;
        f32x4 x[4]; float ss = 0.f;
#pragma unroll
        for (int j = 0; j < 4; ++j) { x[j] = *(const f32x4*)(src + lane * 4 + 256 * j); ss += (x[j][0] * x[j][0] + x[j][1] * x[j][1]) + (x[j][2] * x[j][2] + x[j][3] * x[j][3]); }
        const float rstd = rsqrtf(wave_sum(ss) * (1.0f / 1024.0f) + EPS);
#pragma unroll
        for (int j = 0; j < 4; ++j) {
            const f32x4 sh = *(const f32x4*)(mp + sh_off + lane * 4 + 256 * j), sc = *(const f32x4*)(mp + sc_off + lane * 4 + 256 * j);
            const f32x4 y = (x[j] * rstd * gv[j]) * (sc + 1.0f) + sh;
            u32x2 w; w.x = cvt_pk_bf16(y[0], y[1]); w.y = cvt_pk_bf16(y[2], y[3]);
            *(u32x2*)(H + (size_t)row * 1024 + lane * 4 + 256 * j) = w;
        }
    }
}


__device__ __forceinline__ void bias_items(const bf16_t* W1t, const bf16_t* CS, const float* mods, float* BV0, float* BV1, float* BVF, int w, int NW, int lane) {
    for (int it = w; it < 8192 + 1024; it += NW) {
        float a0 = 0.f, a1 = 0.f, a2 = 0.f, a3 = 0.f; float* dst; int dstride;
        if (it < 8192) {
            const int l = it >> 12, n = it & 4095;
            const bf16_t* wr_ = W1t + (size_t)l * 4096 * 1024 + (size_t)n * 1024 + lane * 16;
            const u32x4 w0 = *(const u32x4*)wr_, w1 = *(const u32x4*)(wr_ + 8);
            const float* sh = mods + (size_t)l * 5 * 6144 + 3072 + lane * 16;
            float wf[16];
#pragma unroll
            for (int e = 0; e < 4; ++e) { wf[2 * e] = __uint_as_float(w0[e] << 16); wf[2 * e + 1] = __uint_as_float(w0[e] & 0xffff0000u); wf[8 + 2 * e] = __uint_as_float(w1[e] << 16); wf[8 + 2 * e + 1] = __uint_as_float(w1[e] & 0xffff0000u); }
#pragma unroll
            for (int q = 0; q < 4; ++q) {
                const f32x4 s0 = *(const f32x4*)(sh + 4 * q), s1 = *(const f32x4*)(sh + 6144 + 4 * q), s2 = *(const f32x4*)(sh + 2 * 6144 + 4 * q), s3 = *(const f32x4*)(sh + 3 * 6144 + 4 * q);
#pragma unroll
                for (int e = 0; e < 4; ++e) { a0 += s0[e] * wf[4 * q + e]; a1 += s1[e] * wf[4 * q + e]; a2 += s2[e] * wf[4 * q + e]; a3 += s3[e] * wf[4 * q + e]; }
            }
            dst = (l == 0 ? BV0 : BV1) + n; dstride = 4096;
        } else {
            const int idx = it - 8192, g = idx >> 8, m = idx & 255;
            const u32x2 w0 = *(const u32x2*)(CS + (size_t)m * 256 + lane * 4);
            const float wf0 = __uint_as_float(w0[0] << 16), wf1 = __uint_as_float(w0[0] & 0xffff0000u), wf2 = __uint_as_float(w0[1] << 16), wf3 = __uint_as_float(w0[1] & 0xffff0000u);
            const float* sh = mods + (size_t)5 * 6144 + g * 256 + lane * 4;
            const f32x4 s0 = *(const f32x4*)(sh), s1 = *(const f32x4*)(sh + 6144), s2 = *(const f32x4*)(sh + 2 * 6144), s3 = *(const f32x4*)(sh + 3 * 6144);
            a0 = s0[0] * wf0 + s0[1] * wf1 + s0[2] * wf2 + s0[3] * wf3; a1 = s1[0] * wf0 + s1[1] * wf1 + s1[2] * wf2 + s1[3] * wf3;
            a2 = s2[0] * wf0 + s2[1] * wf1 + s2[2] * wf2 + s2[3] * wf3; a3 = s3[0] * wf0 + s3[1] * wf1 + s3[2] * wf2 + s3[3] * wf3;
            dst = BVF + g * 256 + m; dstride = 1024;
        }
        a0 = wave_sum(a0); a1 = wave_sum(a1); a2 = wave_sum(a2); a3 = wave_sum(a3);
        if (lane == 0) { dst[0] = a0; dst[dstride] = a1; dst[2 * dstride] = a2; dst[3 * dstride] = a3; }
    }
}
template <bool MASKED>
__device__ __forceinline__ void attn_block(const LAS bf16_t* Ks, const LAS bf16_t* Vs, int kcol0, int fr, int g, const bf16x8 (&Qf)[2], f32x4 (&acc)[4], float& lsum,
                                           const LAS unsigned char* rpb_base  , const int (&dcb)[8], const f32x4& ciX, const f32x4& ciY) {
    bf16x8 KX[2], KY[2];
#pragma unroll
    for (int kk = 0; kk < 2; ++kk) { KX[kk] = *(const LAS bf16x8*)(Ks + (kcol0 + fr) * 72 + kk * 32 + g * 8); KY[kk] = *(const LAS bf16x8*)(Ks + (kcol0 + 16 + fr) * 72 + kk * 32 + g * 8); }
    s16x4 VX[4], VY[4];
#pragma unroll
    for (int db = 0; db < 4; ++db) { VX[db] = *(const LAS s16x4*)(Vs + (16 * db + fr) * 72 + kcol0 + 4 * g); VY[db] = *(const LAS s16x4*)(Vs + (16 * db + fr) * 72 + kcol0 + 16 + 4 * g); }
    f32x4 sX = mfma16(KX[0], Qf[0], ciX); sX = mfma16(KX[1], Qf[1], sX);
    f32x4 sY = mfma16(KY[0], Qf[0], ciY); sY = mfma16(KY[1], Qf[1], sY);
    f32x4 pX, pY;
    if (MASKED) {
#pragma unroll
        for (int ii = 0; ii < 4; ++ii) {
            const float bx = *(const LAS float*)(rpb_base + dcb[ii]), by = *(const LAS float*)(rpb_base + dcb[4 + ii]);
            pX[ii] = __builtin_amdgcn_exp2f(sX[ii] + bx);
            pY[ii] = __builtin_amdgcn_exp2f(sY[ii] + by);
        }
    } else {
#pragma unroll
        for (int ii = 0; ii < 4; ++ii) { pX[ii] = __builtin_amdgcn_exp2f(sX[ii]); pY[ii] = __builtin_amdgcn_exp2f(sY[ii]); }
    }
    lsum += ((pX[0] + pX[1]) + (pX[2] + pX[3])) + ((pY[0] + pY[1]) + (pY[2] + pY[3]));
    const u32x4 pw = pg8::pack8(pX, pY);
    const bf16x8 Pf = __builtin_bit_cast(bf16x8, pw);
#pragma unroll
    for (int db = 0; db < 4; ++db) {
        bf16x8 Vf; Vf[0] = VX[db][0]; Vf[1] = VX[db][1]; Vf[2] = VX[db][2]; Vf[3] = VX[db][3]; Vf[4] = VY[db][0]; Vf[5] = VY[db][1]; Vf[6] = VY[db][2]; Vf[7] = VY[db][3];
        acc[db] = mfma16(Vf, Pf, acc[db]);
    }
}
__device__ __forceinline__ void attn_phase(const bf16_t* QK, const bf16_t* VT, bf16_t* O, const float* rpb, const float* sbound, LAS unsigned char* lds, int G, int c) {
    constexpr int RP_BYTES = 30720, TILE_B = 64 * 72 * 2, PAIR_B = 4 * TILE_B, NPAIR = 7;
    LAS float* rp = (LAS float*)lds;
    int tid = threadIdx.x; asm volatile("" : "+v"(tid));
    const int lane = tid & 63, wid = __builtin_amdgcn_readfirstlane(tid >> 6), fr = lane & 15, g = lane >> 4;
    for (int i = tid; i < 16 * 465; i += 512) rp[i] = rpb[i] * LOG2E;
    const float Mb = *sbound;
    const int nunits = (2048 - c + G - 1) / G;
    const int ND = nunits * NPAIR;
    const int trow = tid >> 3, tch = tid & 7;
    const int ldsoff = (trow * 72 + tch * 8) * 2;
#define ATT_DEC(L_, b_, h_, rp_) do { const int x_ = (L_) & 7, q_ = (L_) >> 3; rp_ = q_ & 31; const int bh_ = 8 * (q_ >> 5) + x_; b_ = bh_ >> 4; h_ = bh_ & 15; } while (0)
#define ATT_TOK(b_, rs0_, t_) ((t_) < 9 ? (b_) * 4096 + min((rs0_) + (t_), 63) * 64 : ML + (b_) * 256 + 64 * (min((t_), 12) - 9))
#define ATT_GLOAD(D_, R) do { const int u_ = (D_) / NPAIR, p_ = (D_) - u_ * NPAIR; int b_, h_, rp_; ATT_DEC(u_ * G + c, b_, h_, rp_); \
        const int rs0_ = min(max(2 * rp_ - 4, 0), 56); const int tk0_ = ATT_TOK(b_, rs0_, 2 * p_), tk1_ = ATT_TOK(b_, rs0_, 2 * p_ + 1); \
        const bf16_t* kb_ = QK + (size_t)trow * 2048 + 1024 + h_ * 64 + tch * 8; const bf16_t* vb_ = VT + (size_t)(h_ * 64 + trow) * MT + tch * 8; \
        R[0] = *(const u32x4*)(kb_ + (size_t)tk0_ * 2048); R[1] = *(const u32x4*)(vb_ + tk0_); R[2] = *(const u32x4*)(kb_ + (size_t)tk1_ * 2048); R[3] = *(const u32x4*)(vb_ + tk1_); } while (0)
#define ATT_LWRITE(slot_, R) do { _Pragma("unroll") for (int q_ = 0; q_ < 4; ++q_) *(LAS u32x4*)(lds + RP_BYTES + (slot_) * PAIR_B + q_ * TILE_B + ldsoff) = R[q_]; } while (0)
    u32x4 R0[4], R1[4];
    ATT_GLOAD(0, R0); ATT_LWRITE(0, R0);
    if (ND > 1) ATT_GLOAD(1, R1);
    if (ND > 2) ATT_GLOAD(2, R0);
    __syncthreads();
    int b = 0, h = 0, rpair = 0, r = 0, rs0 = 0, rsr = 0, qrow = 0;
    const int j = wid & 3, w0 = (j == 0) ? 0 : (j == 1) ? 8 : (j == 2) ? 24 : 32;
    int dcb[8]; f32x4 ciX, ciY, ciU;
    {
        const int cq = 16 * j + fr, cs = min(max(cq - 8, 0), 48), eX = w0 + 4 * g - cs, dX = w0 + 4 * g - cq + 15;
#pragma unroll
        for (int ii = 0; ii < 4; ++ii) {
            dcb[ii] = 4 * min(max(dX + ii, 0), 30); dcb[4 + ii] = 4 * min(max(dX + 16 + ii, 0), 30);
            ciX[ii] = ((unsigned)(eX + ii) < 16u) ? -Mb : -1.0e30f; ciY[ii] = ((unsigned)(eX + 16 + ii) < 16u) ? -Mb : -1.0e30f; ciU[ii] = -Mb;
        }
    }
    bf16x8 Qf[2], Qn[2]; f32x4 acc[4]; float lsum = 0.f;
    int p = 0, u = 0, D = 0;
#define ATT_QLOAD(dst, uu) do { int b_, h_, rp_; ATT_DEC((uu) * G + c, b_, h_, rp_); const int qr_ = b_ * 4096 + (2 * rp_ + (wid >> 2)) * 64 + 16 * j + fr; \
        _Pragma("unroll") for (int kk = 0; kk < 2; ++kk) dst[kk] = *(const bf16x8*)(QK + (size_t)qr_ * 2048 + h_ * 64 + 32 * kk + 8 * g); } while (0)
#define ATT_TILE(t_, toff_) do { \
        const LAS bf16_t* Ks = (const LAS bf16_t*)(lds + RP_BYTES + slot * PAIR_B + (toff_)); \
        const LAS bf16_t* Vs = (const LAS bf16_t*)(lds + RP_BYTES + slot * PAIR_B + (toff_) + TILE_B); \
        if ((t_) < 9) { \
            const int kr = rs0 + (t_), i = kr - rsr; \
            if (i >= 0 && i < 8) attn_block<true>(Ks, Vs, w0, fr, g, Qf, acc, lsum, (const LAS unsigned char*)rp + (h * 465 + (kr - r + 7) * 31) * 4, dcb, ciX, ciY); \
        } else if ((t_) < 13) { \
            attn_block<false>(Ks, Vs, 0, fr, g, Qf, acc, lsum, (const LAS unsigned char*)rp, dcb, ciU, ciU); \
            attn_block<false>(Ks, Vs, 32, fr, g, Qf, acc, lsum, (const LAS unsigned char*)rp, dcb, ciU, ciU); \
        } } while (0)
    ATT_QLOAD(Qn, 0);
#define ATT_ITER(R) do { \
        const int slot = D & 1; \
        if (D + 1 < ND) ATT_LWRITE(slot ^ 1, R); \
        if (D + 3 < ND) ATT_GLOAD(D + 3, R); \
        if (p == 0) { \
            ATT_DEC(u * G + c, b, h, rpair); \
            r = 2 * rpair + (wid >> 2); rs0 = min(max(2 * rpair - 4, 0), 56); rsr = min(max(r - 4, 0), 56); \
            qrow = b * 4096 + r * 64 + 16 * j + fr; \
            Qf[0] = Qn[0]; Qf[1] = Qn[1]; \
            _Pragma("unroll") for (int db = 0; db < 4; ++db) acc[db] = (f32x4){0.f, 0.f, 0.f, 0.f}; \
            lsum = 0.f; \
        } \
        if (p == 4 && u + 1 < nunits) ATT_QLOAD(Qn, u + 1); \
        { const int i0_ = rs0 + 2 * p - rsr, i1_ = i0_ + 1; \
          if (2 * p + 1 < 9 && i0_ >= 0 && i1_ < 8) {        \
            const LAS bf16_t* Ka = (const LAS bf16_t*)(lds + RP_BYTES + slot * PAIR_B); const LAS bf16_t* Va = (const LAS bf16_t*)(lds + RP_BYTES + slot * PAIR_B + TILE_B); \
            const LAS bf16_t* Kb = (const LAS bf16_t*)(lds + RP_BYTES + slot * PAIR_B + 2 * TILE_B); const LAS bf16_t* Vb = (const LAS bf16_t*)(lds + RP_BYTES + slot * PAIR_B + 3 * TILE_B); \
            const LAS unsigned char* rb_ = (const LAS unsigned char*)rp + (h * 465 + (rs0 + 2 * p - r + 7) * 31) * 4; \
            attn_block<true>(Ka, Va, w0, fr, g, Qf, acc, lsum, rb_, dcb, ciX, ciY); \
            attn_block<true>(Kb, Vb, w0, fr, g, Qf, acc, lsum, rb_ + 124, dcb, ciX, ciY); \
          } else { ATT_TILE(2 * p, 0); ATT_TILE(2 * p + 1, 2 * TILE_B); } } \
        if (p == NPAIR - 1) { \
            float ls = lsum; ls += __shfl_xor(ls, 16); ls += __shfl_xor(ls, 32); \
            const float inv = 1.0f / ls; \
            bf16_t* op = O + (size_t)qrow * 1024 + h * 64 + 4 * g; \
            _Pragma("unroll") for (int db = 0; db < 4; ++db) { u32x2 w; w.x = cvt_pk_bf16(acc[db][0] * inv, acc[db][1] * inv); w.y = cvt_pk_bf16(acc[db][2] * inv, acc[db][3] * inv); st8(op + 16 * db, w); } \
            p = 0; ++u; \
        } else ++p; \
        __syncthreads(); \
    } while (0)
    for (;;) {
        ATT_ITER(R1); if (++D >= ND) break;
        ATT_ITER(R0); if (++D >= ND) break;
    }
#undef ATT_ITER
#undef ATT_TILE
#undef ATT_QLOAD
#undef ATT_DEC
#undef ATT_TOK
#undef ATT_GLOAD
#undef ATT_LWRITE
}

__device__ __forceinline__ void s1_phase(const bf16_t* Z0, const bf16_t* Dg, bf16_t* Z1, LAS unsigned char* lds, int gw, int NGW) {
    constexpr int DP = 136;
    LAS bf16_t* Dl = (LAS bf16_t*)lds;
    int tid = threadIdx.x; asm volatile("" : "+v"(tid));
    const int lane = tid & 63, fr = lane & 15, g = lane >> 4;
    for (int i = tid; i < 128 * 16; i += 512) { const int row = i >> 4, ch = i & 15; *(LAS u32x4*)(Dl + row * DP + ch * 8) = *(const u32x4*)(Dg + row * 128 + ch * 8); }
    __syncthreads();
    for (int colM = gw; colM < pg8::NCOL; colM += NGW) {
        bf16x8 A[4][4];
#pragma unroll
        for (int ib = 0; ib < 4; ++ib)
#pragma unroll
            for (int kb = 0; kb < 4; ++kb) A[ib][kb] = *(const bf16x8*)(Z0 + ((size_t)colM * 64 + 16 * ib + fr) * 128 + 32 * kb + 8 * g);
#pragma unroll 2
        for (int jb = 0; jb < 8; ++jb) {
            bf16x8 Bf[4];
#pragma unroll
            for (int kb = 0; kb < 4; ++kb) Bf[kb] = *(const LAS bf16x8*)(Dl + (16 * jb + fr) * DP + 32 * kb + 8 * g);
            const int n = 16 * jb + fr, ka = n >> 1, rip = n & 1;
#pragma unroll
            for (int ib = 0; ib < 4; ++ib) {
                f32x4 a = (f32x4){0.f, 0.f, 0.f, 0.f};
#pragma unroll
                for (int kb = 0; kb < 4; ++kb) a = mfma16(A[ib][kb], Bf[kb], a);
                u32x2 w; w.x = cvt_pk_bf16(a[0], a[1]); w.y = cvt_pk_bf16(a[2], a[3]);
                st8(Z1 + (((size_t)ka * pg8::NCOL + colM) * 2 + rip) * 64 + 16 * ib + 4 * g, w);
            }
        }
    }
    __syncthreads();
}
__device__ __forceinline__ void s2_phase(const bf16_t* Z1, const bf16_t* Eg, bf16_t* F, int gw, int NGW, int lane) {
    const int fr = lane & 15, g = lane >> 4;
    for (int it = gw; it < 2048 + 64; it += NGW) {
        const bool special = it >= 2048;
        const int ka = special ? it - 2048 : (it & 63), q = it >> 6, bg = q >> 1, ib0 = special ? 0 : 4 * (q & 1), nib = special ? 1 : 4;
        bf16x8 Bf[4][4];
#pragma unroll
        for (int jb = 0; jb < 4; ++jb)
#pragma unroll
            for (int kb = 0; kb < 4; ++kb) Bf[jb][kb] = *(const bf16x8*)(Eg + ((size_t)ka * 64 + 16 * jb + fr) * 128 + 32 * kb + 8 * g);
        for (int ibb = 0; ibb < nib; ++ibb) {
            const int ib = ib0 + ibb;
            const int colM0 = special ? 2048 : bg * 128 + ib * 16;
            bf16x8 A[4];
#pragma unroll
            for (int kb = 0; kb < 4; ++kb) A[kb] = *(const bf16x8*)(Z1 + ((size_t)ka * pg8::NCOL + colM0 + fr) * 128 + 32 * kb + 8 * g);
            const int k2 = ib * 16 + 4 * g, b = bg >> 2, gg = bg & 3;
#pragma unroll
            for (int jb = 0; jb < 4; ++jb) {
                f32x4 a = (f32x4){0.f, 0.f, 0.f, 0.f};
#pragma unroll
                for (int kb = 0; kb < 4; ++kb) a = mfma16(A[kb], Bf[jb][kb], a);
                const int k = ka + 64 * (16 * jb + fr), km = (4096 - k) & 4095;
                u32x2 w; w.x = cvt_pk_bf16(a[0], a[1]); w.y = cvt_pk_bf16(a[2], a[3]);
                if (!special) {
                    st8(F + ((size_t)b * 4096 + k) * 1024 + gg * 256 + k2, w);
                    bf16_t* pm_ = F + ((size_t)b * 4096 + km) * 1024 + gg * 256 + 128 + k2;
                    if (k2 != 0) st8(pm_, w);
                    else { pm_[1] = (bf16_t)(w.x >> 16); *(unsigned*)(pm_ + 2) = w.y; }
                } else {
                    bf16_t* ps_ = F + ((size_t)g * 4096 + k) * 1024 + 128;
                    ps_[0] = (bf16_t)(w.x & 0xffffu); ps_[256] = (bf16_t)(w.x >> 16); ps_[512] = (bf16_t)(w.y & 0xffffu); ps_[768] = (bf16_t)(w.y >> 16);
                }
            }
        }
    }
}


#ifndef MK_DEBUG
#define MK_DEBUG 0
#endif
__device__ __forceinline__ void dbg_scan16(const bf16_t* p, size_t n, unsigned* flags, unsigned bit, int gt, int NT) {
    bool bad = false; for (size_t i = gt; i < n; i += NT) bad |= ((p[i] & 0x7f80u) == 0x7f80u);
    if (bad) atomicOr(flags, 1u << bit);
}
__device__ __forceinline__ void dbg_scan32(const float* p, size_t n, unsigned* flags, unsigned bit, int gt, int NT) {
    bool bad = false; for (size_t i = gt; i < n; i += NT) bad |= ((__float_as_uint(p[i]) & 0x7f800000u) == 0x7f800000u);
    if (bad) atomicOr(flags, 1u << bit);
}
struct Args { const float* in[15]; float* out; unsigned char* ws; int ph_lo, ph_hi, use_cg, pad; };
static_assert(sizeof(Args) == 15 * 8 + 8 + 8 + 16, "no padding");

__global__ void __launch_bounds__(512, 2) fwd_kernel(Args args) {
    extern __shared__ __attribute__((aligned(16))) unsigned char lds_raw[];
    LAS unsigned char* lds = (LAS unsigned char*)lds_raw;
    const int G = gridDim.x, c = blockIdx.x;
    const int vcu = (G % 8 == 0) ? (c % 8) * (G / 8) + c / 8 : c;
    const int NGW = G * 8;
#define PHASE_IDS int tid_ = threadIdx.x; asm volatile("" : "+v"(tid_)); const int lane = tid_ & 63, wid = __builtin_amdgcn_readfirstlane(tid_ >> 6); const int gw = vcu * 8 + wid; (void)lane; (void)gw
    unsigned char* ws = args.ws;
    const float* x = args.in[0]; const float* cvec = args.in[1]; const float* ctx = args.in[2]; const float* cctx = args.in[3];
    const float* ada_w = args.in[4]; const float* ada_b = args.in[5]; const float* norm_g = args.in[6];
    const float* wqkv = args.in[7]; const float* wo = args.in[8]; const float* gq = args.in[9]; const float* gk = args.in[10]; const float* rpb = args.in[11];
    const float* fw = args.in[12]; const float* w1 = args.in[13]; const float* w2 = args.in[14];
    float* out = args.out;
    float* mods = (float*)(ws + WS_MODS); float* sbound = (float*)(ws + WS_SB);
    bf16_t* CS = (bf16_t*)(ws + WS_CS); bf16_t* Dt = (bf16_t*)(ws + WS_D); bf16_t* Et = (bf16_t*)(ws + WS_E);
    bf16_t* WQK = (bf16_t*)(ws + WS_WQK); bf16_t* WV = (bf16_t*)(ws + WS_WV); bf16_t* WO = (bf16_t*)(ws + WS_WO); bf16_t* FWt = (bf16_t*)(ws + WS_FW);
    bf16_t* W1t = (bf16_t*)(ws + WS_W1); bf16_t* W2t = (bf16_t*)(ws + WS_W2);
    bf16_t* H = (bf16_t*)(ws + WS_H); bf16_t* QK = (bf16_t*)(ws + WS_QK); bf16_t* VT = (bf16_t*)(ws + WS_VT); bf16_t* O = (bf16_t*)(ws + WS_O);
    bf16_t* XS = (bf16_t*)(ws + WS_XS); bf16_t* HMID = (bf16_t*)(ws + WS_HMID); bf16_t* Z0 = (bf16_t*)(ws + WS_Z0); bf16_t* Z1 = (bf16_t*)(ws + WS_Z1); bf16_t* Fb = (bf16_t*)(ws + WS_F);
    float* SSQ = (float*)(ws + WS_SSQ); float* BV0 = (float*)(ws + WS_BV); float* BV1 = BV0 + 4 * 4096; float* BVF = BV1 + 4 * 4096; float* GM = BVF + 16 * 512;
    const int lo = args.ph_lo, hi = args.ph_hi;
    cg::grid_group grid = cg::this_grid();
#define IN(k) (lo <= (k) && (k) < hi)
#ifndef REP_SYNC
#define REP_SYNC 1
#endif
#ifndef REP_NORM
#define REP_NORM 1
#endif
#ifndef REP_S12
#define REP_S12 1
#endif
#ifndef REP_P0
#define REP_P0 1
#endif
#ifndef USE_XB
#define USE_XB 1
#endif
#define SEAM(k) do { if (IN(k) && IN((k) + 1)) { for (int r_ = 0; r_ < REP_SYNC; ++r_) { if (use_cg) grid.sync(); else xcd_barrier(xbar); } } } while (0)
    { volatile LAS unsigned* st_ = (volatile LAS unsigned*)(lds + LDS_BYTES - 64); if (threadIdx.x < 2) st_[threadIdx.x] = 0u; __syncthreads(); }
    XcdBarrier xbar; xbar.bar = (unsigned*)(ws + WS_BAR); xbar.x = 0; xbar.st = (volatile LAS unsigned*)(lds + LDS_BYTES - 64);
    const bool use_cg = (args.use_cg != 0);
    if (!use_cg && hi - lo > 1) xbar = xcd_barrier_post((unsigned*)(ws + WS_BAR), (volatile LAS unsigned*)(lds + LDS_BYTES - 64));

    unsigned* dflags = (unsigned*)(ws + WS_SB + 256);
#define DBG16(k, bit, p, n) do { if (MK_DEBUG && IN(k)) { int t_ = threadIdx.x; asm volatile("" : "+v"(t_)); dbg_scan16(p, n, dflags, bit, (vcu * 512) + t_, G * 512); } } while (0)
#define DBG32(k, bit, p, n) do { if (MK_DEBUG && IN(k)) { int t_ = threadIdx.x; asm volatile("" : "+v"(t_)); dbg_scan32(p, n, dflags, bit, (vcu * 512) + t_, G * 512); } } while (0)
    if (IN(0)) {
        PHASE_IDS;
        if (MK_DEBUG && c == 0 && tid_ == 0) *dflags = 0u;
        for (int r0_ = 0; r0_ < REP_P0; ++r0_) {
        for (int u = c; u < 192; u += G) p0_mods_unit(cvec, cctx, ada_w, ada_b, mods, lds, u);
        __syncthreads();
        {
            LAS float* scr = (LAS float*)(lds + wid * 16384);
            constexpr int I_QKV = 16 * 96, I_SQ = 16 * 32, I_1 = 16 * 128, I_2 = 64 * 32;
            constexpr int NITEMS = I_QKV + I_SQ + 2 * I_1 + I_2;
            for (int it = NITEMS - 1 - gw; it >= 0; it -= NGW) {
                int r = it;
                if (r < I_QKV) { p0_transpose_item(wqkv, 1024, 3072, WQK, WV, 1, scr, r, lane); continue; } r -= I_QKV;
                if (r < I_SQ) { p0_transpose_item(wo, 1024, 1024, WO, nullptr, 0, scr, r, lane); continue; } r -= I_SQ;
                if (r < 2 * I_1) { const int l = r / I_1; p0_transpose_item(w1 + (size_t)l * 1024 * 4096, 1024, 4096, W1t + (size_t)l * 4096 * 1024, nullptr, 0, scr, r % I_1, lane); continue; } r -= 2 * I_1;
                p0_transpose_item(w2, 4096, 1024, W2t, nullptr, 0, scr, r, lane);
            }
        }
        {
            const int gt = gw * 64 + lane, NT = NGW * 64;
            for (int i = gt; i < 256 * 256; i += NT) { const int m = i >> 8, cc = i & 255, ri = m >> 7, k2 = m & 127; float sn, cs; sincospif(2.0f * (float)((cc * k2) & 255) / 256.0f, &sn, &cs);
                float v = (ri == 0 ? cs : -sn) * (1.0f / 16.0f); if (m == 128) v = (cc & 1) ? -(1.0f / 16.0f) : (1.0f / 16.0f);
                CS[i] = (bf16_t)(cvt_pk_bf16(v, 0.f) & 0xffffu); }
            for (int i = gt; i < 128 * 128; i += NT) { const int n = i >> 7, kp = i & 127, ka = n >> 1, rip = n & 1, ri = kp >> 6, a = kp & 63; float sn, cs; sincospif(2.0f * (float)((a * ka) & 63) / 64.0f, &sn, &cs);
                const float v = (rip == 0 ? (ri == 0 ? cs : sn) : (ri == 0 ? -sn : cs)) * 0.125f; Dt[i] = (bf16_t)(cvt_pk_bf16(v, 0.f) & 0xffffu); }
            for (int i = gt; i < 64 * 64 * 128; i += NT) { const int kp = i & 127, kbk = (i >> 7) & 63, ka = i >> 13, rip = kp >> 6, bp = kp & 63; float sn, cs; sincospif(2.0f * (float)((bp * (ka + 64 * kbk)) & 4095) / 4096.0f, &sn, &cs);
                const float v = (rip == 0 ? cs : sn) * 0.125f; Et[i] = (bf16_t)(cvt_pk_bf16(v, 0.f) & 0xffffu); }
        }
        if (c == G - 1 && wid == 7) {
            float mq = fabsf(gq[lane]), mk = fabsf(gk[lane]), mr = 0.f;
            for (int i = lane; i < 16 * 465; i += 64) mr = fmaxf(mr, fabsf(rpb[i]));
#pragma unroll
            for (int o = 1; o < 64; o <<= 1) { mq = fmaxf(mq, __shfl_xor(mq, o)); mk = fmaxf(mk, __shfl_xor(mk, o)); mr = fmaxf(mr, __shfl_xor(mr, o)); }
            if (lane == 0) *sbound = (8.0f * mq * mk + mr) * LOG2E;
        }
        __syncthreads();
        }
    }
    SEAM(0);
    const bool ctx_in_p1 = false;
    if (IN(1)) { PHASE_IDS;
        if (c == G - 1) {
            for (int i = tid_; i < 3 * 4096; i += 512) { const int idx = i >> 12, b = (i >> 10) & 3, col = i & 1023;
                const float gg = norm_g[(idx == 0 ? 1024 : idx == 1 ? 2048 : 3072) + col];
                const float sc = mods[(size_t)((idx == 0 ? 0 : 5) + b) * 6144 + (idx == 1 ? 1024 : 4096) + col];
                GM[i] = gg * (1.0f + sc); }
        }
        if (!ctx_in_p1) norm_rows(x, ctx, MT, norm_g, mods, 0, 1024, H, gw, NGW, lane);
        else if (c >= 32) norm_rows(x, ctx, ML, norm_g, mods, 0, 1024, H, (c - 32) * 8 + wid, (G - 32) * 8, lane);
        else {
            pg8::SchedOne S1u; const size_t ts = (size_t)256 * 1024 * 2; int tt;
            if (c < 16) { S1u.u.kind = 0; S1u.u.pm = 64 + (c & 3); S1u.u.pn = 4 + (c >> 2); tt = c & 3; S1u.u.a = (const char*)H + (size_t)S1u.u.pm * ts; S1u.u.b = (const char*)WQK + (size_t)S1u.u.pn * ts; }
            else { const int l2 = c - 16; S1u.u.kind = 1; S1u.u.pm = l2 & 3; S1u.u.pn = 64 + (l2 >> 2); tt = l2 >> 2; S1u.u.a = (const char*)WV + (size_t)S1u.u.pm * ts; S1u.u.b = (const char*)H + (size_t)S1u.u.pn * ts; }
            S1u.u.aux = 0;
            norm_rows(x, ctx, ML + tt * 256 + 256, norm_g, mods, 0, 1024, H, ML + tt * 256 + wid, 8, lane);
            asm volatile("s_waitcnt vmcnt(0)" ::: "memory"); __syncthreads();
            pg8::EpiQKV E{QK, VT, gq, gk};
            pg8::gemm_phase<pg8::EpiQKV, pg8::SchedOne, false>(lds, 1024, 1024, 1024, S1u, E);
        }
    }
    SEAM(1);
    DBG16(2, 0, H, (size_t)MT * 1024);
    if (IN(2)) { pg8::SchedQKV S{(const char*)H, (const char*)WQK, (const char*)WV, G, c, ctx_in_p1 ? 768 : 800}; pg8::EpiQKV E{QK, VT, gq, gk};
#ifndef REP_G2
#define REP_G2 1
#endif
        for (int r_ = 0; r_ < REP_G2; ++r_) pg8::gemm_phase<pg8::EpiQKV, pg8::SchedQKV, false>(lds, 1024, 1024, 1024, S, E);
        { PHASE_IDS;
          const bool part = (G > 32); const int w_ = part ? (c - 32) * 8 + wid : gw, nw_ = part ? (G - 32) * 8 : NGW;
          if (!part || c >= 32) {
              bias_items(W1t, CS, mods, BV0, BV1, BVF, w_, nw_, lane);
              LAS float* scr = (LAS float*)(lds + wid * 16384);
              constexpr int I_SQ = 16 * 32, I_2 = 64 * 32;
              for (int it = w_; it < I_SQ + I_2; it += nw_) {
                  if (it < I_SQ) p0_transpose_item(fw, 1024, 1024, FWt, nullptr, 2, scr, it, lane);
                  else p0_transpose_item(w2 + (size_t)4096 * 1024, 4096, 1024, W2t + (size_t)1024 * 4096, nullptr, 0, scr, it - I_SQ, lane);
              }
          } } }
    SEAM(2);
    DBG16(3, 1, QK, (size_t)ML * 2048); DBG16(3, 2, VT, (size_t)1024 * MT); DBG32(3, 13, mods, (size_t)10 * 6144);
#ifndef REP_ATT
#define REP_ATT 1
#endif
    if (IN(3)) { for (int rep = 0; rep < REP_ATT; ++rep) attn_phase(QK, VT, O, rpb, sbound, lds, G, c); }
    SEAM(3);
    DBG16(4, 3, O, (size_t)ML * 1024);
    if (IN(4)) { pg8::SchedStd S; S.init(O, WO, ML, 1024, 1024, 1024, G, c); pg8::EpiResF<false> E{x, XS, mods + 2048, GM, H, SSQ};
        pg8::gemm_phase<pg8::EpiResF<false>, pg8::SchedStd, false>(lds, 1024, 1024, 1024, S, E); }
    SEAM(4);
    DBG32(5, 4, out, (size_t)ML * 1024);
    if (IN(6)) { pg8::SchedStd S; S.init(H, W1t, ML, 4096, 1024, 1024, G, c); pg8::EpiRelu2F E{HMID, 4096, BV0, SSQ};
        pg8::gemm_phase<pg8::EpiRelu2F, pg8::SchedStd, false>(lds, 1024, 1024, 1024, S, E); }
    SEAM(6);
    DBG16(7, 5, HMID, (size_t)ML * 4096);
    if (IN(7)) { pg8::SchedStd S; S.init(HMID, W2t, ML, 1024, 64, 4096, G, c, (size_t)64 * 32768); pg8::EpiResF<true> E{XS, XS, mods + 5120, GM + 4096, H, SSQ};
        pg8::gemm_phase<pg8::EpiResF<true>, pg8::SchedStd, false>(lds, 4096, 64, 4096, S, E, 32768, 128); }
    SEAM(7);
    const float* mods1 = mods + 5 * 6144;
    DBG32(8, 6, out, (size_t)ML * 1024);
    if (IN(9)) { pg8::SchedF1 S{(const char*)CS, (const char*)H, G, c}; pg8::EpiZ0F E{Z0, BVF, SSQ};
        pg8::gemm_phase<pg8::EpiZ0F, pg8::SchedF1, true>(lds, 256, 256, 1024, S, E); }
    SEAM(9);
    DBG16(10, 7, Z0, (size_t)262144 * 128);
    if (IN(10)) { PHASE_IDS; for (int r_ = 0; r_ < REP_S12; ++r_) s1_phase(Z0, Dt, Z1, lds, gw, NGW); }
    SEAM(10);
    DBG16(11, 8, Z1, (size_t)262144 * 128);
    if (IN(11)) { PHASE_IDS; for (int r_ = 0; r_ < REP_S12; ++r_) s2_phase(Z1, Et, Fb, gw, NGW, lane); }
    SEAM(11);
    DBG16(12, 9, Fb, (size_t)ML * 1024);
    if (IN(12)) { pg8::SchedStd S; S.init(Fb, FWt, ML, 1024, 1024, 1024, G, c); pg8::EpiResF<true> E{XS, XS, mods1 + 2048, GM + 8192, H, SSQ};
        pg8::gemm_phase<pg8::EpiResF<true>, pg8::SchedStd, false>(lds, 1024, 1024, 1024, S, E); }
    SEAM(12);
    DBG32(13, 10, out, (size_t)ML * 1024);
    if (IN(14)) { pg8::SchedStd S; S.init(H, W1t + (size_t)4096 * 1024, ML, 4096, 1024, 1024, G, c); pg8::EpiRelu2F E{HMID, 4096, BV1, SSQ};
        pg8::gemm_phase<pg8::EpiRelu2F, pg8::SchedStd, false>(lds, 1024, 1024, 1024, S, E); }
    SEAM(14);
    DBG16(15, 11, HMID, (size_t)ML * 4096);
    if (IN(15)) { pg8::SchedStd S; S.init(HMID, W2t + (size_t)1024 * 4096, ML, 1024, 64, 4096, G, c, (size_t)64 * 32768); pg8::EpiRes E{XS, out, mods1 + 5120};
        pg8::gemm_phase<pg8::EpiRes, pg8::SchedStd, false>(lds, 4096, 64, 4096, S, E, 32768, 128); }
    SEAM(15);
    if (MK_DEBUG && IN(16)) {
        int t_ = threadIdx.x; asm volatile("" : "+v"(t_));
        bool bad = false;
        for (size_t i = (size_t)vcu * 512 + t_; i < (size_t)ML * 1024; i += (size_t)G * 512) { if ((__float_as_uint(out[i]) & 0x7f800000u) == 0x7f800000u) { bad = true; out[i] = 0.f; } }
        if (bad) atomicOr(dflags, 1u << 12);
    }
    SEAM(16);
    if (MK_DEBUG && IN(17)) {
        if (c == 0 && threadIdx.x == 0) { const unsigned f = *dflags; if (f) out[0] = 1.0e6f * (float)(__builtin_ctz(f) + 1) + 1.0e4f * (float)__builtin_popcount(f); }
    }
#undef IN
#undef SEAM
}

constexpr int NPHASE = MK_DEBUG ? 18 : 16;
#ifndef MK_USE_CG
#define MK_USE_CG 0
#endif
#ifndef MK_PER_PHASE
#define MK_PER_PHASE 0
#endif

extern "C" void kernel_launch(void* const* d_in, const int* in_sizes, int n_in, void* d_out, int out_size, void* d_ws, size_t ws_size, hipStream_t stream) {
    static int grid = 0;
    if (grid == 0) {
        if (n_in != 15 || out_size != ML * DM || ws_size < WS_END) { fprintf(stderr, "kernel_launch: unexpected shapes (n_in %d out %d ws %zu)\n", n_in, out_size, ws_size); grid = -1; return; }
        int dev = 0, cus = 0, per_cu = 0;
        hipGetDevice(&dev); hipDeviceGetAttribute(&cus, hipDeviceAttributeMultiprocessorCount, dev);
        hipFuncSetAttribute((const void*)fwd_kernel, hipFuncAttributeMaxDynamicSharedMemorySize, LDS_BYTES);
        if (hipOccupancyMaxActiveBlocksPerMultiprocessor(&per_cu, (const void*)fwd_kernel, 512, LDS_BYTES) != hipSuccess || per_cu < 1) { fprintf(stderr, "kernel_launch: occupancy query failed (%d)\n", per_cu); (void)hipGetLastError(); per_cu = 1; }
        grid = cus * 1;
        if (grid <= 0) grid = 256;
    }
    if (grid < 0) return;
    if (hipMemsetAsync((char*)d_ws + WS_BAR, 0, BAR_BYTES, stream) != hipSuccess) { fprintf(stderr, "kernel_launch: memset failed\n"); return; }
    Args a{};
    for (int i = 0; i < 15; ++i) a.in[i] = (const float*)d_in[i];
    a.out = (float*)d_out; a.ws = (unsigned char*)d_ws;
#if MK_PER_PHASE
    for (int p = 0; p < NPHASE; ++p) { a.ph_lo = p; a.ph_hi = p + 1; hipLaunchKernelGGL(fwd_kernel, dim3(grid), dim3(512), LDS_BYTES, stream, a); }
#else
    a.ph_lo = 0; a.ph_hi = NPHASE; a.use_cg = MK_USE_CG;
    void* kargs[] = {&a};
    hipError_t e = hipLaunchCooperativeKernel((const void*)fwd_kernel, dim3(grid), dim3(512), kargs, LDS_BYTES, stream);
    if (e != hipSuccess) fprintf(stderr, "cooperative launch failed: %s (grid %d)\n", hipGetErrorString(e), grid);
#endif
}
```

```cpp
#include <hip/hip_runtime.h>
#include <hip/hip_cooperative_groups.h>
#include <cstdio>
#include <cstdint>
namespace cg = cooperative_groups;

#define LAS __attribute__((address_space(3)))
typedef unsigned short bf16_t;
typedef short bf16x8 __attribute__((ext_vector_type(8)));
typedef short s16x4 __attribute__((ext_vector_type(4)));
typedef float f32x4 __attribute__((ext_vector_type(4)));
typedef unsigned u32x4 __attribute__((ext_vector_type(4)));
typedef unsigned u32x2 __attribute__((ext_vector_type(2)));

constexpr int DM = 1024, NB = 4, SEQ = 4096, CTXL = 256, FF = 4096;
constexpr int ML = NB * SEQ;
constexpr int MT = ML + NB * CTXL;
constexpr float LOG2E = 1.4426950408889634f;
constexpr float EPS = 1e-6f;

constexpr size_t MiB = 1u << 20;
constexpr size_t WS_MODS = 0;
constexpr size_t WS_SB = 512 * 1024;
constexpr size_t WS_BAR = 1 * MiB;
constexpr size_t BAR_BYTES = 16384;
constexpr size_t WS_CS = 2 * MiB;
constexpr size_t WS_D = 2 * MiB + 512 * 1024;
constexpr size_t WS_E = 3 * MiB;
constexpr size_t WS_WQK = 4 * MiB, WS_WV = 8 * MiB, WS_WO = 10 * MiB, WS_FW = 12 * MiB;
constexpr size_t WS_W1 = 14 * MiB;
constexpr size_t WS_W2 = 30 * MiB;
constexpr size_t WS_SSQ = 46 * MiB;
constexpr size_t WS_BV = 47 * MiB;
constexpr size_t WS_H = 48 * MiB;
constexpr size_t WS_R = 82 * MiB;
constexpr size_t WS_QK = WS_R;
constexpr size_t WS_VT = WS_R + 68 * MiB;
constexpr size_t WS_O = WS_R + 102 * MiB;
constexpr size_t WS_HMID = WS_R;
constexpr size_t WS_Z0 = WS_R;
constexpr size_t WS_Z1 = WS_R + 64 * MiB;
constexpr size_t WS_F = WS_R;
constexpr size_t WS_XS = WS_R + 134 * MiB;
constexpr size_t WS_END = 256 * MiB;
static_assert(WS_XS + 32 * MiB <= WS_END && WS_O + 32 * MiB <= WS_XS && WS_F + 32 * MiB <= WS_END && WS_HMID + 128 * MiB <= WS_END && WS_O + 32 * MiB <= WS_END, "ws map");

constexpr int LDS_BYTES = 147456;

typedef __bf16 bf16v2_t __attribute__((ext_vector_type(2)));
typedef float f32v2_t __attribute__((ext_vector_type(2)));
__device__ __forceinline__ unsigned cvt_pk_bf16(float lo, float hi) { const f32v2_t v = {lo, hi}; const bf16v2_t r = __builtin_convertvector(v, bf16v2_t); return __builtin_bit_cast(unsigned, r); }
__device__ __forceinline__ f32x4 mfma16(bf16x8 a, bf16x8 b, f32x4 c) { return __builtin_amdgcn_mfma_f32_16x16x32_bf16(a, b, c, 0, 0, 0); }


#ifndef MK_WT
#define MK_WT 0
#endif
__device__ __forceinline__ void st16(void* p, u32x4 v) {
#if MK_WT
    asm volatile("global_store_dwordx4 %0, %1, off sc1\n\ts_nop 1" :: "v"(p), "v"(v) : "memory");
#else
    *(u32x4*)p = v;
#endif
}
__device__ __forceinline__ void st16f(void* p, f32x4 v) {
#if MK_WT
    asm volatile("global_store_dwordx4 %0, %1, off sc1\n\ts_nop 1" :: "v"(p), "v"(v) : "memory");
#else
    *(f32x4*)p = v;
#endif
}
__device__ __forceinline__ void st8(void* p, u32x2 v) {
#if MK_WT
    asm volatile("global_store_dwordx2 %0, %1, off sc1\n\ts_nop 1" :: "v"(p), "v"(v) : "memory");
#else
    *(u32x2*)p = v;
#endif
}
namespace pg8 {
constexpr int BM = 256, BK = 64, HALF = 128, HTB = HALF * BK * 2, STAGE_BYTES = 8 * HTB;
__device__ __forceinline__ int lds_byte(int r, int c) { const int st = (r >> 4) * 2 + (c >> 5), rr = r & 15, cc = c & 31, ob = rr * 64 + cc * 2; return st * 1024 + (ob ^ (((ob >> 9) & 1) << 5)); }
__device__ __forceinline__ void stage_rc(int b, int& R, int& C) { const int st = b / 1024, sb = b % 1024, swz = sb ^ (((sb >> 9) & 1) << 5); R = (st >> 1) * 16 + swz / 64; C = (st & 1) * 32 + (swz % 64) / 2; }
__device__ __forceinline__ int perm32(int rho) { const int n = rho >> 4, i = rho & 15; return 8 * (i >> 2) + 4 * n + (i & 3); }

struct Unit { int pm, pn, kind, aux; const char* a; const char* b; };

template <class Epi, class Sched, bool BMAP>
__device__ __forceinline__ void gemm_phase(LAS unsigned char* lds, const int K, const int lda, const int ldb, const Sched& S, const Epi& E, const size_t kstepA = 128, const size_t kstepB = 128) {
    int tid = threadIdx.x; asm volatile("" : "+v"(tid));
    const int wid = __builtin_amdgcn_readfirstlane(tid >> 6), lane = tid & 63, wr = wid >> 2, wc = wid & 3, fr = lane & 15, fq = lane >> 4;
    int nt = K / BK; asm volatile("" : "+s"(nt));
    unsigned voffA[2], voffB[2];
#pragma unroll
    for (int i = 0; i < 2; ++i) { int R, C; stage_rc(tid * 16 + i * 8192, R, C); const int Rb = (R & ~31) + perm32(R & 31);
        voffA[i] = (unsigned)(R * lda + C) * 2u;
        voffB[i] = BMAP ? (unsigned)((64 * (Rb & 63) + (Rb >> 6)) * ldb + C) * 2u : (unsigned)(Rb * ldb + C) * 2u; }
    const size_t hstepA = (size_t)HALF * lda * 2;
    const size_t hstepB = BMAP ? (size_t)2 * ldb * 2 : (size_t)HALF * ldb * 2;
    const unsigned ldsw = (unsigned)wid * 1024u;
    const int aoff = lds_byte(wr * 64 + fr, fq * 8), boff = lds_byte(wc * 32 + fr, fq * 8);
#define PG8_SA(b, h) (((b) * 2 + (h)) * HTB)
#define PG8_SB(b, h) ((4 + (b) * 2 + (h)) * HTB)
#define PG8_STAGE(bufoff, gbase, voff) do { _Pragma("unroll") for (int _i = 0; _i < 2; ++_i) \
        __builtin_amdgcn_global_load_lds((const unsigned*)((const char*)(gbase) + (voff)[_i]), (LAS unsigned*)(lds + (bufoff) + ldsw + _i * 8192), 16, 0, 0); } while (0)
#define PG8_LDA(dst, b, h) do { _Pragma("unroll") for (int m = 0; m < 4; ++m) _Pragma("unroll") for (int k = 0; k < 2; ++k) dst[m][k] = *(const LAS bf16x8*)(lds + PG8_SA(b, h) + aoff + m * 2048 + k * 1024); } while (0)
#define PG8_LDB(dst, b, h) do { _Pragma("unroll") for (int n = 0; n < 2; ++n) _Pragma("unroll") for (int k = 0; k < 2; ++k) dst[n][k] = *(const LAS bf16x8*)(lds + PG8_SB(b, h) + boff + n * 2048 + k * 1024); } while (0)
#define PG8_MMA(ai, bj, At, Bt) do { __builtin_amdgcn_s_setprio(1); _Pragma("unroll") for (int m = 0; m < 4; ++m) _Pragma("unroll") for (int n = 0; n < 2; ++n) _Pragma("unroll") for (int k = 0; k < 2; ++k) \
        acc[ai][bj][m][n] = __builtin_amdgcn_mfma_f32_16x16x32_bf16(Bt[n][k], At[m][k], acc[ai][bj][m][n], 0, 0, 0); __builtin_amdgcn_s_setprio(0); } while (0)
#define PG8_WAIT_V(n) asm volatile("s_waitcnt vmcnt(" #n ")" ::: "memory")
#define PG8_WAIT_L(n) asm volatile("s_waitcnt lgkmcnt(" #n ")" ::: "memory")
#define PG8_BAR __builtin_amdgcn_s_barrier()
#define PG8_SCHED __builtin_amdgcn_sched_barrier(0)
    Unit cur, nxt; int ui = 0;
    if (!S.next(0, cur)) return;
    f32x4 acc[2][2][4][2];
#pragma unroll
    for (int a = 0; a < 2; ++a)
#pragma unroll
        for (int b = 0; b < 2; ++b)
#pragma unroll
            for (int m = 0; m < 4; ++m)
#pragma unroll
                for (int n = 0; n < 2; ++n) acc[a][b][m][n] = (f32x4){0.f, 0.f, 0.f, 0.f};
    bf16x8 At[4][2], B0[2][2], B1[2][2];
    const char* cA = cur.a; const char* cB = cur.b;
    if constexpr (Epi::PREP) E.prep(cur, lds, 0, tid);
    PG8_STAGE(PG8_SB(0, 0), cB, voffB); PG8_STAGE(PG8_SB(0, 1), cB + hstepB, voffB); PG8_STAGE(PG8_SA(0, 0), cA, voffA); PG8_STAGE(PG8_SA(0, 1), cA + hstepA, voffA);
    if (wr == 1) PG8_BAR;
    PG8_WAIT_V(2); PG8_BAR;
    PG8_STAGE(PG8_SB(1, 0), cB + kstepB, voffB); PG8_STAGE(PG8_SA(1, 0), cA + kstepA, voffA); PG8_STAGE(PG8_SB(1, 1), cB + hstepB + kstepB, voffB);
    PG8_WAIT_V(6); PG8_BAR;
    for (;;) {
        const bool has_next = S.next(ui + 1, nxt);
        const char* nA = has_next ? nxt.a : cA; const char* nB = has_next ? nxt.b : cB;
        for (int t = 0; t < nt; t += 2) {
            const bool last = (t == nt - 2);
            const char* a1 = cA + (size_t)(t + 1) * kstepA;
            const char* a2 = last ? nA : cA + (size_t)(t + 2) * kstepA; const char* b2 = last ? nB : cB + (size_t)(t + 2) * kstepB;
            const char* a3 = a2 + kstepA; const char* b3 = b2 + kstepB;
            PG8_LDB(B0, 0, 0); PG8_LDB(B1, 0, 1); PG8_SCHED; PG8_LDA(At, 0, 0); PG8_STAGE(PG8_SA(1, 1), a1 + hstepA, voffA);
            PG8_WAIT_V(8); PG8_WAIT_L(0); PG8_BAR; PG8_MMA(0, 0, At, B0); PG8_MMA(0, 1, At, B1); PG8_BAR; PG8_SCHED;
            PG8_LDA(At, 0, 1); PG8_STAGE(PG8_SB(0, 0), b2, voffB); PG8_STAGE(PG8_SB(0, 1), b2 + hstepB, voffB); PG8_STAGE(PG8_SA(0, 0), a2, voffA);
            PG8_WAIT_V(8); PG8_WAIT_L(0); PG8_BAR; PG8_MMA(1, 0, At, B0); PG8_MMA(1, 1, At, B1); PG8_BAR; PG8_SCHED;
            PG8_LDB(B0, 1, 0); PG8_LDB(B1, 1, 1); PG8_SCHED; PG8_LDA(At, 1, 0); PG8_STAGE(PG8_SA(0, 1), a2 + hstepA, voffA);
            PG8_WAIT_V(8); PG8_WAIT_L(0); PG8_BAR; PG8_MMA(0, 0, At, B0); PG8_MMA(0, 1, At, B1); PG8_BAR; PG8_SCHED;
            PG8_LDA(At, 1, 1); PG8_STAGE(PG8_SB(1, 0), b3, voffB); PG8_STAGE(PG8_SB(1, 1), b3 + hstepB, voffB); PG8_STAGE(PG8_SA(1, 0), a3, voffA);
            PG8_WAIT_V(8); PG8_WAIT_L(0); PG8_BAR; PG8_MMA(1, 0, At, B0); PG8_MMA(1, 1, At, B1); PG8_BAR; PG8_SCHED;
        }
        if (wr == 0) PG8_BAR;
        if constexpr (Epi::PREP) { if (has_next) E.prep(nxt, lds, (ui + 1) & 1, tid); }
        E(acc, cur, wr, wc, fr, fq, lds, ui & 1);
        if (!has_next) break;
#pragma unroll
        for (int a = 0; a < 2; ++a)
#pragma unroll
            for (int b = 0; b < 2; ++b)
#pragma unroll
                for (int m = 0; m < 4; ++m)
#pragma unroll
                    for (int n = 0; n < 2; ++n) acc[a][b][m][n] = (f32x4){0.f, 0.f, 0.f, 0.f};
        cur = nxt; cA = nA; cB = nB; ++ui;
        if (wr == 1) PG8_BAR;
    }
    PG8_WAIT_V(0);
    PG8_BAR;
#undef PG8_SA
#undef PG8_SB
#undef PG8_STAGE
#undef PG8_LDA
#undef PG8_LDB
#undef PG8_MMA
#undef PG8_WAIT_V
#undef PG8_WAIT_L
#undef PG8_BAR
#undef PG8_SCHED
}

struct SchedStd {
    const char* A; const char* Bt; size_t tsA, tsB; int nM, nN, nwg, G, c;
    __device__ void init(const void* A_, const void* Bt_, int M, int N, int lda, int ldb, int G_, int c_, size_t tsA_ = 0) { A = (const char*)A_; Bt = (const char*)Bt_; tsA = tsA_ ? tsA_ : (size_t)BM * lda * 2; tsB = (size_t)BM * ldb * 2; nM = M / BM; nN = N / BM; nwg = nM * nN; G = G_; c = c_; }
    __device__ bool next(int i, Unit& u) const {
        const long L = (long)i * G + c; if (L >= nwg) return false;
        int wgid = (int)L; { const int q = nwg / 8, r = nwg % 8, xcd = wgid % 8, off = wgid / 8; wgid = (xcd < r ? xcd * (q + 1) : r * (q + 1) + (xcd - r) * q) + off; }
        const int nig = 8 * nN, gid = wgid / nig, fm = gid * 8, gsz = (nM - fm) < 8 ? (nM - fm) : 8;
        u.pm = fm + ((wgid % nig) % gsz); u.pn = (wgid % nig) / gsz; u.kind = 0; u.aux = 0;
        u.a = A + (size_t)u.pm * tsA; u.b = Bt + (size_t)u.pn * tsB; return true;
    }
};
struct SchedQKV {
    const char* H; const char* Wqk; const char* Wv; int G, c, nunits;
    __device__ bool next(int i, Unit& u) const {
        const long Ll = (long)i * G + c; if (Ll >= nunits) return false;
        const int L = (int)Ll; const size_t ts = (size_t)BM * 1024 * 2; u.aux = 0;
        if (L < 512) { const int x = L & 7, off = L >> 3; u.kind = 0; u.pm = 8 * x + (off & 7); u.pn = off >> 3; }
        else if (L < 768) { const int l2 = L - 512, x = l2 & 7, off = l2 >> 3; u.kind = 1; u.pm = off & 3; u.pn = 8 * x + (off >> 2); }
        else if (L < 784) { const int l2 = L - 768; u.kind = 0; u.pm = 64 + (l2 & 3); u.pn = 4 + (l2 >> 2); }
        else { const int l2 = L - 784; u.kind = 1; u.pm = l2 & 3; u.pn = 64 + (l2 >> 2); }
        if (u.kind == 0) { u.a = H + (size_t)u.pm * ts; u.b = Wqk + (size_t)u.pn * ts; }
        else { u.a = Wv + (size_t)u.pm * ts; u.b = H + (size_t)u.pn * ts; }
        return true;
    }
};
struct SchedOne { Unit u;
    __device__ __forceinline__ bool next(int i, Unit& o) const { if (i > 0) return false; o = u; return true; }
};
struct SchedF1 {
    const char* CS; const char* H; int G, c;
    __device__ bool next(int i, Unit& u) const {
        const long Ll = (long)i * G + c; if (Ll >= 256) return false;
        const int L = (int)Ll; const int t = L & 15, b = (L >> 4) & 3, g = (L >> 6) & 3;
        u.pm = 0; u.pn = t; u.kind = g; u.aux = b;
        u.a = CS; u.b = H + ((size_t)(b * 4096 + 4 * t) * 1024 + g * 256) * 2; return true;
    }
};

typedef f32x4 Acc[2][2][4][2];
__device__ __forceinline__ u32x4 pack8(f32x4 v0, f32x4 v1) { u32x4 w; w.x = cvt_pk_bf16(v0[0], v0[1]); w.y = cvt_pk_bf16(v0[2], v0[3]); w.z = cvt_pk_bf16(v1[0], v1[1]); w.w = cvt_pk_bf16(v1[2], v1[3]); return w; }

__device__ __forceinline__ void unpack8(u32x4 w, f32x4& v0, f32x4& v1) {
    v0[0] = __uint_as_float(w.x << 16); v0[1] = __uint_as_float(w.x & 0xffff0000u); v0[2] = __uint_as_float(w.y << 16); v0[3] = __uint_as_float(w.y & 0xffff0000u);
    v1[0] = __uint_as_float(w.z << 16); v1[1] = __uint_as_float(w.z & 0xffff0000u); v1[2] = __uint_as_float(w.w << 16); v1[3] = __uint_as_float(w.w & 0xffff0000u);
}
struct EpiQKV { static constexpr bool PREP = true; bf16_t* QK; bf16_t* VT; const float* gq; const float* gk;
    __device__ __forceinline__ void prep(const Unit& u, LAS unsigned char* lds, int slot, int tid) const {
        if (u.kind == 0 && tid < 64) { const bool isq = u.pn < 4; ((LAS float*)(lds + 131072))[slot * 512 + tid] = isq ? gq[tid] * (0.125f * LOG2E) : gk[tid]; }
    }
    __device__ __forceinline__ void operator()(const Acc& acc, const Unit& u, int wr, int wc, int fr, int fq, LAS unsigned char* lds, int slot) const {
        if (u.kind == 0) {
            const LAS float* gp = (const LAS float*)(lds + 131072) + slot * 512;
            f32x4 gv[2][2];
#pragma unroll
            for (int bj = 0; bj < 2; ++bj)
#pragma unroll
                for (int n = 0; n < 2; ++n) gv[bj][n] = *(const LAS f32x4*)(gp + 32 * bj + 8 * fq + 4 * n);
#pragma unroll
            for (int ai = 0; ai < 2; ++ai)
#pragma unroll
                for (int m = 0; m < 4; ++m) {
                    const int row = u.pm * BM + ai * HALF + wr * 64 + m * 16 + fr;
                    float ss = 0.f;
#pragma unroll
                    for (int bj = 0; bj < 2; ++bj)
#pragma unroll
                        for (int n = 0; n < 2; ++n) { const f32x4 x = acc[ai][bj][m][n]; ss += (x[0] * x[0] + x[1] * x[1]) + (x[2] * x[2] + x[3] * x[3]); }
                    ss += __shfl_xor(ss, 16); ss += __shfl_xor(ss, 32);
                    const float rstd = rsqrtf(ss * (1.0f / 64.0f) + EPS);
                    bf16_t* rowp = QK + (size_t)row * 2048 + u.pn * 256 + wc * 64 + 8 * fq;
#pragma unroll
                    for (int bj = 0; bj < 2; ++bj) st16(rowp + 32 * bj, pack8(acc[ai][bj][m][0] * rstd * gv[bj][0], acc[ai][bj][m][1] * rstd * gv[bj][1]));
                }
        } else {
#pragma unroll
            for (int ai = 0; ai < 2; ++ai)
#pragma unroll
                for (int m = 0; m < 4; ++m) {
                    const int row = u.pm * BM + ai * HALF + wr * 64 + m * 16 + fr;
                    bf16_t* rowp = VT + (size_t)row * MT + u.pn * 256 + wc * 32 + 8 * fq;
#pragma unroll
                    for (int bj = 0; bj < 2; ++bj) st16(rowp + bj * HALF, pack8(acc[ai][bj][m][0], acc[ai][bj][m][1]));
                }
        }
    }
};
struct EpiRelu2 { static constexpr bool PREP = false; bf16_t* O; int ldc;
    __device__ __forceinline__ void operator()(const Acc& acc, const Unit& u, int wr, int wc, int fr, int fq, LAS unsigned char*, int) const {
#pragma unroll
        for (int ai = 0; ai < 2; ++ai)
#pragma unroll
            for (int m = 0; m < 4; ++m) {
                const int row = u.pm * BM + ai * HALF + wr * 64 + m * 16 + fr;
                bf16_t* rowp = O + (size_t)row * ldc + u.pn * 256 + wc * 32 + 8 * fq;
#pragma unroll
                for (int bj = 0; bj < 2; ++bj) { f32x4 v0 = acc[ai][bj][m][0], v1 = acc[ai][bj][m][1];
#pragma unroll
                    for (int e = 0; e < 4; ++e) { const float a = fmaxf(v0[e], 0.f), b = fmaxf(v1[e], 0.f); v0[e] = a * a; v1[e] = b * b; }
                    *(u32x4*)(rowp + bj * HALF) = pack8(v0, v1); }
            }
    }
};
struct EpiRes { static constexpr bool PREP = false; const bf16_t* base; float* out; const float* gate;
    __device__ __forceinline__ void operator()(const Acc& acc, const Unit& u, int wr, int wc, int fr, int fq, LAS unsigned char*, int) const {
        const int col0 = u.pn * 256 + wc * 32 + 8 * fq;
        const float* gp = gate + (size_t)(u.pm >> 4) * 6144 + col0;
        f32x4 gv[2][2];
#pragma unroll
        for (int bj = 0; bj < 2; ++bj)
#pragma unroll
            for (int n = 0; n < 2; ++n) gv[bj][n] = *(const f32x4*)(gp + bj * HALF + 4 * n);
#pragma unroll
        for (int ai = 0; ai < 2; ++ai)
#pragma unroll
          for (int mh = 0; mh < 2; ++mh) {
            u32x4 pre[2][2];
#pragma unroll
            for (int m2 = 0; m2 < 2; ++m2)
#pragma unroll
                for (int bj = 0; bj < 2; ++bj) pre[m2][bj] = __builtin_nontemporal_load((const u32x4*)(base + (size_t)(u.pm * BM + ai * HALF + wr * 64 + (2 * mh + m2) * 16 + fr) * 1024 + col0 + bj * HALF));
            asm volatile("" ::: "memory");
#pragma unroll
            for (int m2 = 0; m2 < 2; ++m2) { const int m = 2 * mh + m2;
                const size_t off = (size_t)(u.pm * BM + ai * HALF + wr * 64 + m * 16 + fr) * 1024 + col0;
#pragma unroll
                for (int bj = 0; bj < 2; ++bj) { f32x4 b0, b1; unpack8(pre[m2][bj], b0, b1);
                    *(f32x4*)(out + off + bj * HALF) = b0 + gv[bj][0] * acc[ai][bj][m][0]; *(f32x4*)(out + off + bj * HALF + 4) = b1 + gv[bj][1] * acc[ai][bj][m][1]; }
            }
            asm volatile("" ::: "memory");
          }
    }
};
struct EpiZ0 { static constexpr bool PREP = false; bf16_t* Z0;
    __device__ __forceinline__ void operator()(const Acc& acc, const Unit& u, int wr, int wc, int fr, int fq, LAS unsigned char*, int) const {
        const int ri = u.pm, t = u.pn, g = u.kind, b = u.aux;
        bf16_t* p0 = Z0 + ((size_t)(((b * 4 + g) * 256 + wr * 64 + fr) * 64 + 4 * t + (wc >> 1))) * 128 + ri * 64 + 32 * (wc & 1) + 8 * fq;
#pragma unroll
        for (int ai = 0; ai < 2; ++ai)
#pragma unroll
            for (int m = 0; m < 4; ++m) {
#pragma unroll
                for (int bj = 0; bj < 2; ++bj)
                    *(u32x4*)(p0 + (size_t)(ai * HALF + m * 16) * 8192 + bj * 256) = pack8(acc[ai][bj][m][0], acc[ai][bj][m][1]);
                asm volatile("" ::: "memory");
            }
    }
};

constexpr int AUX_OFF = 131072;
template <bool BASE16>
struct EpiResF { static constexpr bool PREP = false; const void* base; bf16_t* XS; const float* gate; const float* gm; bf16_t* XB; float* SSQ;
    __device__ __forceinline__ void operator()(const Acc& acc, const Unit& u, int wr, int wc, int fr, int fq, LAS unsigned char*, int) const {
        const int col0 = u.pn * 256 + wc * 32 + 8 * fq, b = u.pm >> 4;
        f32x4 gv[2][2], mv[2][2];
#pragma unroll
        for (int bj = 0; bj < 2; ++bj)
#pragma unroll
            for (int n = 0; n < 2; ++n) { gv[bj][n] = *(const f32x4*)(gate + (size_t)b * 6144 + col0 + bj * HALF + 4 * n); mv[bj][n] = *(const f32x4*)(gm + b * 1024 + col0 + bj * HALF + 4 * n); }
#pragma unroll
        for (int ai = 0; ai < 2; ++ai)
#pragma unroll
          for (int mh = 0; mh < 2; ++mh) {
            f32x4 pre[2][2][2];
#pragma unroll
            for (int m2 = 0; m2 < 2; ++m2) { const size_t off = (size_t)(u.pm * BM + ai * HALF + wr * 64 + (2 * mh + m2) * 16 + fr) * 1024 + col0;
#pragma unroll
                for (int bj = 0; bj < 2; ++bj) {
                    if (BASE16) { const u32x4 w = __builtin_nontemporal_load((const u32x4*)((const bf16_t*)base + off + bj * HALF)); unpack8(w, pre[m2][bj][0], pre[m2][bj][1]); }
                    else { pre[m2][bj][0] = __builtin_nontemporal_load((const f32x4*)((const float*)base + off + bj * HALF)); pre[m2][bj][1] = __builtin_nontemporal_load((const f32x4*)((const float*)base + off + bj * HALF + 4)); }
                } }
            asm volatile("" ::: "memory");
#pragma unroll
            for (int m2 = 0; m2 < 2; ++m2) {
                const int m = 2 * mh + m2;
                const int row = u.pm * BM + ai * HALF + wr * 64 + m * 16 + fr;
                const size_t off = (size_t)row * 1024 + col0;
                float ss = 0.f;
#pragma unroll
                for (int bj = 0; bj < 2; ++bj) {
                    const f32x4 v0 = pre[m2][bj][0] + gv[bj][0] * acc[ai][bj][m][0];
                    const f32x4 v1 = pre[m2][bj][1] + gv[bj][1] * acc[ai][bj][m][1];
                    st16(XS + off + bj * HALF, pack8(v0, v1));
                    ss += ((v0[0] * v0[0] + v0[1] * v0[1]) + (v0[2] * v0[2] + v0[3] * v0[3])) + ((v1[0] * v1[0] + v1[1] * v1[1]) + (v1[2] * v1[2] + v1[3] * v1[3]));
                    st16(XB + off + bj * HALF, pack8(v0 * mv[bj][0], v1 * mv[bj][1]));
                }
                ss += __shfl_xor(ss, 16); ss += __shfl_xor(ss, 32);
                if (fq == 0) SSQ[(size_t)row * 16 + u.pn * 4 + wc] = ss;
            }
            asm volatile("" ::: "memory");
          }
    }
};
__device__ __forceinline__ float ssq_rstd(const float* SSQ, int row, int half) {
    const f32x4 a = *(const f32x4*)(SSQ + (size_t)row * 16 + half * 8), b = *(const f32x4*)(SSQ + (size_t)row * 16 + half * 8 + 4);
    float s = ((a[0] + a[1]) + (a[2] + a[3])) + ((b[0] + b[1]) + (b[2] + b[3]));
    s += __shfl_xor(s, 1);
    return rsqrtf(s * (1.0f / 1024.0f) + EPS);
}
struct EpiRelu2F { static constexpr bool PREP = true; bf16_t* O; int ldc; const float* BV; const float* SSQ;
    __device__ __forceinline__ void prep(const Unit& u, LAS unsigned char* lds, int slot, int tid) const {
        const float r = ssq_rstd(SSQ, u.pm * BM + (tid >> 1), tid & 1);
        LAS float* aux = (LAS float*)(lds + AUX_OFF) + slot * 512;
        if (!(tid & 1)) aux[tid >> 1] = r;
        if (tid < 256) aux[256 + tid] = BV[(size_t)(u.pm >> 4) * 4096 + u.pn * 256 + tid];
    }
    __device__ __forceinline__ void operator()(const Acc& acc, const Unit& u, int wr, int wc, int fr, int fq, LAS unsigned char* lds, int slot) const {
        const LAS float* rt = (const LAS float*)(lds + AUX_OFF) + slot * 512;
        const int col0 = u.pn * 256 + wc * 32 + 8 * fq;
        f32x4 bv[2][2];
#pragma unroll
        for (int bj = 0; bj < 2; ++bj)
#pragma unroll
            for (int n = 0; n < 2; ++n) bv[bj][n] = *(const LAS f32x4*)(rt + 256 + wc * 32 + 8 * fq + bj * HALF + 4 * n);
#pragma unroll
        for (int ai = 0; ai < 2; ++ai)
#pragma unroll
            for (int m = 0; m < 4; ++m) {
                const int rl = ai * HALF + wr * 64 + m * 16 + fr; const float rs = rt[rl];
                bf16_t* rowp = O + ((size_t)(u.pm * 64 + u.pn * 4 + (wc >> 1)) * 256 + rl) * 64 + (wc & 1) * 32 + 8 * fq;
#pragma unroll
                for (int bj = 0; bj < 2; ++bj) { f32x4 v0 = acc[ai][bj][m][0] * rs + bv[bj][0], v1 = acc[ai][bj][m][1] * rs + bv[bj][1];
#pragma unroll
                    for (int e = 0; e < 4; ++e) { const float a = fmaxf(v0[e], 0.f), c2 = fmaxf(v1[e], 0.f); v0[e] = a * a; v1[e] = c2 * c2; }
                    st16(rowp + bj * 2 * 256 * 64, pack8(v0, v1)); }
            }
    }
};
constexpr int NCOL = 2064;
struct EpiZ0F { static constexpr bool PREP = true; bf16_t* Z0; const float* BVF; const float* SSQ;
    __device__ __forceinline__ void prep(const Unit& u, LAS unsigned char* lds, int slot, int tid) const {
        const int nl = tid >> 1, tok = u.aux * 4096 + 64 * (nl & 63) + 4 * u.pn + (nl >> 6);
        const float r = ssq_rstd(SSQ, tok, tid & 1);
        LAS float* aux = (LAS float*)(lds + AUX_OFF) + slot * 512;
        if (!(tid & 1)) aux[nl] = r;
        if (tid < 256) aux[256 + tid] = BVF[(size_t)(u.aux * 4 + u.kind) * 256 + tid];
    }
    __device__ __forceinline__ void operator()(const Acc& acc, const Unit& u, int wr, int wc, int fr, int fq, LAS unsigned char* lds, int slot) const {
        const LAS float* rt = (const LAS float*)(lds + AUX_OFF) + slot * 512;
        const int t = u.pn, g = u.kind, b = u.aux;
        f32x4 rs[2][2];
#pragma unroll
        for (int bj = 0; bj < 2; ++bj)
#pragma unroll
            for (int n = 0; n < 2; ++n) rs[bj][n] = *(const LAS f32x4*)(rt + bj * HALF + wc * 32 + 8 * fq + 4 * n);
        const LAS float* bz = rt + 256 + wr * 64 + fr;
        bf16_t* p0 = Z0 + ((size_t)(((b * 4 + g) * 128 + wr * 64 + fr) * 64 + 4 * t + (wc >> 1))) * 128 + 32 * (wc & 1) + 8 * fq;
        bf16_t* ps = Z0 + ((size_t)((2048 + b * 4 + g) * 64 + 4 * t + (wc >> 1))) * 128 + 32 * (wc & 1) + 8 * fq;
#pragma unroll
        for (int ai = 0; ai < 2; ++ai)
#pragma unroll
            for (int m = 0; m < 4; ++m) {
                const float bb = bz[ai * HALF + m * 16];
                const bool nyq = (ai == 1 && m == 0) && (wr == 0) && (fr == 0);
#pragma unroll
                for (int bj = 0; bj < 2; ++bj) {
                    const u32x4 v = pack8(acc[ai][bj][m][0] * rs[bj][0] + bb, acc[ai][bj][m][1] * rs[bj][1] + bb);
                    const u32x4 z = {0u, 0u, 0u, 0u};
                    st16(p0 + (size_t)(m * 16) * 8192 + ai * 64 + bj * 256, nyq ? z : v);
                    if (ai == 1 && m == 0) { if (nyq) { st16(ps + bj * 256, v); st16(ps + bj * 256 + 64, z); } }
                }
                asm volatile("" ::: "memory");
            }
    }
};
}


#define XB_TMO      128
#define XB_XCNT(j)  (256  + 64 * (j))
#define XB_XSUB(j)  (1280 + 64 * (j))
#define XB_XGEN(j)  (2304 + 64 * (j))
#define XB_TOP      3328
#define XB_TOPGEN   3392
#define XCD_BAR_WORDS 3456
#define XB_SPIN_CAP (1u << 18)
__device__ __forceinline__ unsigned xb_ld(unsigned* p)              { return __hip_atomic_load(p, __ATOMIC_RELAXED, __HIP_MEMORY_SCOPE_AGENT); }
__device__ __forceinline__ unsigned xb_add(unsigned* p, unsigned v) { return __hip_atomic_fetch_add(p, v, __ATOMIC_RELAXED, __HIP_MEMORY_SCOPE_AGENT); }
__device__ __forceinline__ unsigned xb_xcc_id() { return (unsigned)__builtin_amdgcn_s_getreg((3 << 11) | 20) & 0xFu; }
#define XB_SPIN(cond, bar) do { unsigned _sp = 0; while (cond) { __builtin_amdgcn_s_sleep(1); \
    if ((++_sp & 255u) == 0u) { if (xb_ld(&(bar)[XB_TMO])) break; if (_sp > XB_SPIN_CAP) { atomicAdd(&(bar)[XB_TMO], 1u); break; } } } } while (0)
struct XcdBarrier { unsigned* bar; unsigned x; volatile LAS unsigned* st; };
__device__ __forceinline__ XcdBarrier xcd_barrier_post(unsigned* bar, volatile LAS unsigned* st) {
    XcdBarrier b; b.bar = bar; b.x = xb_xcc_id(); b.st = st;
    if (threadIdx.x == 0) (void)xb_add(&bar[XB_XCNT(b.x)], 1u);
    return b;
}
__device__ __forceinline__ void xcd_barrier_complete(unsigned* bar, unsigned x, unsigned& nloc, unsigned& nx) {
    const unsigned G = gridDim.x * gridDim.y * gridDim.z;
    unsigned sum, cnt, mine, sp = 0u;
    for (;;) {
        sum = 0u; cnt = 0u; mine = 0u;
#pragma unroll
        for (unsigned j = 0; j < 16; ++j) { const unsigned c = xb_ld(&bar[XB_XCNT(j)]); sum += c; cnt += (c > 0u) ? 1u : 0u; mine = (j == x) ? c : mine; }
        if (sum == G) break;
        __builtin_amdgcn_s_sleep(1);
        if ((++sp & 255u) == 0u) { if (xb_ld(&bar[XB_TMO])) break; if (sp > XB_SPIN_CAP) { atomicAdd(&bar[XB_TMO], 1u); break; } }
    }
    nloc = mine > 0u ? mine : 1u; nx = cnt > 0u ? cnt : 1u;
}
__device__ __forceinline__ void xcd_barrier(const XcdBarrier& b) {
    asm volatile("s_waitcnt vmcnt(0)" ::: "memory");
    __syncthreads();
    if (threadIdx.x == 0) {
        unsigned* bar = b.bar;
        __builtin_amdgcn_s_waitcnt(0);
        unsigned nloc = b.st[0], nx = b.st[1];
        if (nloc == 0u) { xcd_barrier_complete(bar, b.x, nloc, nx); b.st[0] = nloc; b.st[1] = nx; }
        const unsigned old = xb_add(&bar[XB_XSUB(b.x)], 1u);
        const unsigned gen = old / nloc;
        if (old + 1u == (gen + 1u) * nloc) {
            __builtin_amdgcn_fence(__ATOMIC_RELEASE, "agent");
            asm volatile("s_waitcnt vmcnt(0)" ::: "memory");
            const unsigned og = xb_add(&bar[XB_TOP], 1u);
            const unsigned tg = og / nx;
            if (og + 1u == (tg + 1u) * nx) xb_add(&bar[XB_TOPGEN], 1u);
            else XB_SPIN(xb_ld(&bar[XB_TOPGEN]) == tg, bar);
            __builtin_amdgcn_fence(__ATOMIC_ACQUIRE, "agent");
            xb_add(&bar[XB_XGEN(b.x)], 1u);
            asm volatile("s_waitcnt vmcnt(0)" ::: "memory");
        } else {
            XB_SPIN(xb_ld(&bar[XB_XGEN(b.x)]) == gen, bar);
            __builtin_amdgcn_fence(__ATOMIC_ACQUIRE, "agent");
            asm volatile("s_waitcnt vmcnt(0)" ::: "memory");
        }
    }
    __syncthreads();
}
__device__ __forceinline__ void p0_mods_unit(const float* c, const float* cctx, const float* ada_w, const float* ada_b, float* mods, LAS unsigned char* lds, int unit) {
    LAS float* s = (LAS float*)lds;
    LAS float* red = s + 5 * 1024;
    int tid = threadIdx.x; asm volatile("" : "+v"(tid));
    for (int i = tid; i < 5 * 1024; i += 512) { const int v = i >> 10, k = i & 1023; const float x = v < 4 ? c[v * 1024 + k] : cctx[k]; s[i] = x / (1.0f + __expf(-x)); }
    __syncthreads();
    const int l = unit / 96, col0 = (unit % 96) * 64, kc = tid >> 6, cl = tid & 63;
    const float* w = ada_w + (size_t)l * 1024 * 6144 + col0 + cl;
    float a0 = 0.f, a1 = 0.f, a2 = 0.f, a3 = 0.f, a4 = 0.f;
    for (int k = kc * 128; k < kc * 128 + 128; k += 32) {
        float wv[32];
#pragma unroll
        for (int j = 0; j < 32; ++j) wv[j] = __builtin_nontemporal_load(w + (size_t)(k + j) * 6144);
#pragma unroll
        for (int j = 0; j < 32; ++j) { a0 += s[k + j] * wv[j]; a1 += s[1024 + k + j] * wv[j]; a2 += s[2048 + k + j] * wv[j]; a3 += s[3072 + k + j] * wv[j]; a4 += s[4096 + k + j] * wv[j]; }
    }
    red[(kc * 5 + 0) * 64 + cl] = a0; red[(kc * 5 + 1) * 64 + cl] = a1; red[(kc * 5 + 2) * 64 + cl] = a2; red[(kc * 5 + 3) * 64 + cl] = a3; red[(kc * 5 + 4) * 64 + cl] = a4;
    __syncthreads();
    if (tid < 320) { const int v = tid >> 6, cc = tid & 63; float t = 0.f;
#pragma unroll
        for (int kk = 0; kk < 8; ++kk) t += red[(kk * 5 + v) * 64 + cc];
        mods[(size_t)(l * 5 + v) * 6144 + col0 + cc] = t + ada_b[l * 6144 + col0 + cc]; }
    __syncthreads();
}

__device__ __forceinline__ void p0_transpose_item(const float* W, int K, int N, bf16_t* WT, bf16_t* WT2, int mode, LAS float* scr, int item, int lane) {
    const int nblk = N / 32, kb = item / nblk, nb = item % nblk, k0 = 64 * kb, n0 = 32 * nb;
    float wv_[32];
#pragma unroll
    for (int i = 0; i < 32; ++i) { int srow = k0 + 2 * i + (lane >> 5);
        if (mode == 2) { const int j = srow & 255; if (j > 128) srow = (srow & ~255) + 256 - (j - 128); }
        wv_[i] = __builtin_nontemporal_load(W + (size_t)srow * N + n0 + (lane & 31)); }
#pragma unroll
    for (int i = 0; i < 32; ++i) scr[(2 * i + (lane >> 5)) * 33 + (lane & 31)] = wv_[i];
    asm volatile("s_waitcnt lgkmcnt(0)" ::: "memory");
    const int cch = lane & 7;
#pragma unroll
    for (int j = 0; j < 4; ++j) { const int n = (lane >> 3) + 8 * j; const LAS float* s = scr + (8 * cch) * 33 + n;
        u32x4 o; o.x = cvt_pk_bf16(s[0 * 33], s[1 * 33]); o.y = cvt_pk_bf16(s[2 * 33], s[3 * 33]); o.z = cvt_pk_bf16(s[4 * 33], s[5 * 33]); o.w = cvt_pk_bf16(s[6 * 33], s[7 * 33]);
        const int ng = n0 + n; bf16_t* dst;
        if (mode != 1) dst = WT + (size_t)ng * K;
        else if (ng < 2048) { const int pn = ng >> 8, hh = (ng >> 6) & 3, d = ng & 63; const int tpos = (d >> 5) * 128 + hh * 32 + (d & 31); dst = WT + (size_t)(pn * 256 + tpos) * K; }
        else dst = WT2 + (size_t)(ng - 2048) * K;
        *(u32x4*)(dst + k0 + 8 * cch) = o; }
    asm volatile("s_waitcnt lgkmcnt(0)" ::: "memory");
}

__device__ __forceinline__ float wave_sum(float v) {
#pragma unroll
    for (int o = 1; o < 64; o <<= 1) v += __shfl_xor(v, o);
    return v;
}
__device__ __forceinline__ void norm_rows(const float* xlat, const float* xctx, int nrows, const float* g, const float* modsl, int sh_off, int sc_off, bf16_t* H, int gw, int NGW, int lane) {
    f32x4 gv[4];
#pragma unroll
    for (int j = 0; j < 4; ++j) gv[j] = *(const f32x4*)(g + lane * 4 + 256 * j);
    for (int row = gw; row < nrows; row += NGW) {
        const float* src = row < ML ? xlat + (size_t)row * 1024 : xctx + (size_t)(row - ML) * 1024;
        const int v = row < ML ? (row >> 12) : 4;
        const float* mp = modsl + (size_t)v * 6144;
        f32x4 x[4]; float ss = 0.f;
#pragma unroll
        for (int j = 0; j < 4; ++j) { x[j] = __builtin_nontemporal_load((const f32x4*)(src + lane * 4 + 256 * j)); ss += (x[j][0] * x[j][0] + x[j][1] * x[j][1]) + (x[j][2] * x[j][2] + x[j][3] * x[j][3]); }
        const float rstd = rsqrtf(wave_sum(ss) * (1.0f / 1024.0f) + EPS);
#pragma unroll
        for (int j = 0; j < 4; ++j) {
            const f32x4 sh = *(const f32x4*)(mp + sh_off + lane * 4 + 256 * j), sc = *(const f32x4*)(mp + sc_off + lane * 4 + 256 * j);
            const f32x4 y = (x[j] * rstd * gv[j]) * (sc + 1.0f) + sh;
            u32x2 w; w.x = cvt_pk_bf16(y[0], y[1]); w.y = cvt_pk_bf16(y[2], y[3]);
            *(u32x2*)(H + (size_t)row * 1024 + lane * 4 + 256 * j) = w;
        }
    }
}


__device__ __forceinline__ void bias_items(const bf16_t* W1t, const bf16_t* CS, const float* mods, float* BV0, float* BV1, float* BVF, int w, int NW, int lane) {
    for (int it = w; it < 8192 + 1024; it += NW) {
        float a0 = 0.f, a1 = 0.f, a2 = 0.f, a3 = 0.f; float* dst; int dstride;
        if (it < 8192) {
            const int l = it >> 12, n = it & 4095;
            const bf16_t* wr_ = W1t + (size_t)l * 4096 * 1024 + (size_t)n * 1024 + lane * 16;
            const u32x4 w0 = *(const u32x4*)wr_, w1 = *(const u32x4*)(wr_ + 8);
            const float* sh = mods + (size_t)l * 5 * 6144 + 3072 + lane * 16;
            float wf[16];
#pragma unroll
            for (int e = 0; e < 4; ++e) { wf[2 * e] = __uint_as_float(w0[e] << 16); wf[2 * e + 1] = __uint_as_float(w0[e] & 0xffff0000u); wf[8 + 2 * e] = __uint_as_float(w1[e] << 16); wf[8 + 2 * e + 1] = __uint_as_float(w1[e] & 0xffff0000u); }
#pragma unroll
            for (int q = 0; q < 4; ++q) {
                const f32x4 s0 = *(const f32x4*)(sh + 4 * q), s1 = *(const f32x4*)(sh + 6144 + 4 * q), s2 = *(const f32x4*)(sh + 2 * 6144 + 4 * q), s3 = *(const f32x4*)(sh + 3 * 6144 + 4 * q);
#pragma unroll
                for (int e = 0; e < 4; ++e) { a0 += s0[e] * wf[4 * q + e]; a1 += s1[e] * wf[4 * q + e]; a2 += s2[e] * wf[4 * q + e]; a3 += s3[e] * wf[4 * q + e]; }
            }
            dst = (l == 0 ? BV0 : BV1) + n; dstride = 4096;
        } else {
            const int idx = it - 8192, g = idx >> 8, m = idx & 255;
            const u32x2 w0 = *(const u32x2*)(CS + (size_t)m * 256 + lane * 4);
            const float wf0 = __uint_as_float(w0[0] << 16), wf1 = __uint_as_float(w0[0] & 0xffff0000u), wf2 = __uint_as_float(w0[1] << 16), wf3 = __uint_as_float(w0[1] & 0xffff0000u);
            const float* sh = mods + (size_t)5 * 6144 + g * 256 + lane * 4;
            const f32x4 s0 = *(const f32x4*)(sh), s1 = *(const f32x4*)(sh + 6144), s2 = *(const f32x4*)(sh + 2 * 6144), s3 = *(const f32x4*)(sh + 3 * 6144);
            a0 = s0[0] * wf0 + s0[1] * wf1 + s0[2] * wf2 + s0[3] * wf3; a1 = s1[0] * wf0 + s1[1] * wf1 + s1[2] * wf2 + s1[3] * wf3;
            a2 = s2[0] * wf0 + s2[1] * wf1 + s2[2] * wf2 + s2[3] * wf3; a3 = s3[0] * wf0 + s3[1] * wf1 + s3[2] * wf2 + s3[3] * wf3;
            dst = BVF + g * 256 + m; dstride = 1024;
        }
        a0 = wave_sum(a0); a1 = wave_sum(a1); a2 = wave_sum(a2); a3 = wave_sum(a3);
        if (lane == 0) { dst[0] = a0; dst[dstride] = a1; dst[2 * dstride] = a2; dst[3 * dstride] = a3; }
    }
}
template <bool MASKED>
__device__ __forceinline__ void attn_block(const LAS bf16_t* Ks, const LAS bf16_t* Vs, int kcol0, int fr, int g, const bf16x8 (&Qf)[2], f32x4 (&acc)[4], float& lsum,
                                           const LAS unsigned char* rpb_base  , const int (&dcb)[8], const f32x4& ciX, const f32x4& ciY) {
    bf16x8 KX[2], KY[2];
#pragma unroll
    for (int kk = 0; kk < 2; ++kk) { KX[kk] = *(const LAS bf16x8*)(Ks + (kcol0 + fr) * 72 + kk * 32 + g * 8); KY[kk] = *(const LAS bf16x8*)(Ks + (kcol0 + 16 + fr) * 72 + kk * 32 + g * 8); }
    s16x4 VX[4], VY[4];
#pragma unroll
    for (int db = 0; db < 4; ++db) { VX[db] = *(const LAS s16x4*)(Vs + (16 * db + fr) * 72 + kcol0 + 4 * g); VY[db] = *(const LAS s16x4*)(Vs + (16 * db + fr) * 72 + kcol0 + 16 + 4 * g); }
    f32x4 sX = mfma16(KX[0], Qf[0], ciX); sX = mfma16(KX[1], Qf[1], sX);
    f32x4 sY = mfma16(KY[0], Qf[0], ciY); sY = mfma16(KY[1], Qf[1], sY);
    f32x4 pX, pY;
    if (MASKED) {
#pragma unroll
        for (int ii = 0; ii < 4; ++ii) {
            const float bx = *(const LAS float*)(rpb_base + dcb[ii]), by = *(const LAS float*)(rpb_base + dcb[4 + ii]);
            pX[ii] = __builtin_amdgcn_exp2f(sX[ii] + bx);
            pY[ii] = __builtin_amdgcn_exp2f(sY[ii] + by);
        }
    } else {
#pragma unroll
        for (int ii = 0; ii < 4; ++ii) { pX[ii] = __builtin_amdgcn_exp2f(sX[ii]); pY[ii] = __builtin_amdgcn_exp2f(sY[ii]); }
    }
    lsum += ((pX[0] + pX[1]) + (pX[2] + pX[3])) + ((pY[0] + pY[1]) + (pY[2] + pY[3]));
    const u32x4 pw = pg8::pack8(pX, pY);
    const bf16x8 Pf = __builtin_bit_cast(bf16x8, pw);
#pragma unroll
    for (int db = 0; db < 4; ++db) {
        bf16x8 Vf; Vf[0] = VX[db][0]; Vf[1] = VX[db][1]; Vf[2] = VX[db][2]; Vf[3] = VX[db][3]; Vf[4] = VY[db][0]; Vf[5] = VY[db][1]; Vf[6] = VY[db][2]; Vf[7] = VY[db][3];
        acc[db] = mfma16(Vf, Pf, acc[db]);
    }
}
__device__ __forceinline__ void attn_phase(const bf16_t* QK, const bf16_t* VT, bf16_t* O, const float* rpb, const float* sbound, LAS unsigned char* lds, int G, int c) {
    constexpr int RP_BYTES = 30720, TILE_B = 64 * 72 * 2, PAIR_B = 4 * TILE_B, NPAIR = 7;
    LAS float* rp = (LAS float*)lds;
    int tid = threadIdx.x; asm volatile("" : "+v"(tid));
    const int lane = tid & 63, wid = __builtin_amdgcn_readfirstlane(tid >> 6), fr = lane & 15, g = lane >> 4;
    for (int i = tid; i < 16 * 465; i += 512) rp[i] = rpb[i] * LOG2E;
    const float Mb = *sbound;
    const int nunits = (2048 - c + G - 1) / G;
    const int ND = nunits * NPAIR;
    const int trow = tid >> 3, tch = tid & 7;
    const int ldsoff = (trow * 72 + tch * 8) * 2;
#define ATT_DEC(L_, b_, h_, rp_) do { const int x_ = (L_) & 7, q_ = (L_) >> 3; rp_ = q_ & 31; const int bh_ = 8 * (q_ >> 5) + x_; b_ = bh_ >> 4; h_ = bh_ & 15; } while (0)
#define ATT_TOK(b_, rs0_, t_) ((t_) < 9 ? (b_) * 4096 + min((rs0_) + (t_), 63) * 64 : ML + (b_) * 256 + 64 * (min((t_), 12) - 9))
#define ATT_GLOAD(D_, R) do { const int u_ = (D_) / NPAIR, p_ = (D_) - u_ * NPAIR; int b_, h_, rp_; ATT_DEC(u_ * G + c, b_, h_, rp_); \
        const int rs0_ = min(max(2 * rp_ - 4, 0), 56); const int tk0_ = ATT_TOK(b_, rs0_, 2 * p_), tk1_ = ATT_TOK(b_, rs0_, 2 * p_ + 1); \
        const bf16_t* kb_ = QK + (size_t)trow * 2048 + 1024 + h_ * 64 + tch * 8; const bf16_t* vb_ = VT + (size_t)(h_ * 64 + trow) * MT + tch * 8; \
        R[0] = *(const u32x4*)(kb_ + (size_t)tk0_ * 2048); R[1] = *(const u32x4*)(vb_ + tk0_); R[2] = *(const u32x4*)(kb_ + (size_t)tk1_ * 2048); R[3] = *(const u32x4*)(vb_ + tk1_); } while (0)
#define ATT_LWRITE(slot_, R) do { _Pragma("unroll") for (int q_ = 0; q_ < 4; ++q_) *(LAS u32x4*)(lds + RP_BYTES + (slot_) * PAIR_B + q_ * TILE_B + ldsoff) = R[q_]; } while (0)
    u32x4 R0[4], R1[4];
    ATT_GLOAD(0, R0); ATT_LWRITE(0, R0);
    if (ND > 1) ATT_GLOAD(1, R1);
    if (ND > 2) ATT_GLOAD(2, R0);
    __syncthreads();
    int b = 0, h = 0, rpair = 0, r = 0, rs0 = 0, rsr = 0, qrow = 0;
    const int j = wid & 3, w0 = (j == 0) ? 0 : (j == 1) ? 8 : (j == 2) ? 24 : 32;
    int dcb[8]; f32x4 ciX, ciY, ciU;
    {
        const int cq = 16 * j + fr, cs = min(max(cq - 8, 0), 48), eX = w0 + 4 * g - cs, dX = w0 + 4 * g - cq + 15;
#pragma unroll
        for (int ii = 0; ii < 4; ++ii) {
            dcb[ii] = 4 * min(max(dX + ii, 0), 30); dcb[4 + ii] = 4 * min(max(dX + 16 + ii, 0), 30);
            ciX[ii] = ((unsigned)(eX + ii) < 16u) ? -Mb : -1.0e30f; ciY[ii] = ((unsigned)(eX + 16 + ii) < 16u) ? -Mb : -1.0e30f; ciU[ii] = -Mb;
        }
    }
    bf16x8 Qf[2], Qn[2]; f32x4 acc[4]; float lsum = 0.f;
    int p = 0, u = 0, D = 0;
#define ATT_QLOAD(dst, uu) do { int b_, h_, rp_; ATT_DEC((uu) * G + c, b_, h_, rp_); const int qr_ = b_ * 4096 + (2 * rp_ + (wid >> 2)) * 64 + 16 * j + fr; \
        _Pragma("unroll") for (int kk = 0; kk < 2; ++kk) dst[kk] = *(const bf16x8*)(QK + (size_t)qr_ * 2048 + h_ * 64 + 32 * kk + 8 * g); } while (0)
#define ATT_TILE(t_, toff_) do { \
        const LAS bf16_t* Ks = (const LAS bf16_t*)(lds + RP_BYTES + slot * PAIR_B + (toff_)); \
        const LAS bf16_t* Vs = (const LAS bf16_t*)(lds + RP_BYTES + slot * PAIR_B + (toff_) + TILE_B); \
        if ((t_) < 9) { \
            const int kr = rs0 + (t_), i = kr - rsr; \
            if (i >= 0 && i < 8) attn_block<true>(Ks, Vs, w0, fr, g, Qf, acc, lsum, (const LAS unsigned char*)rp + (h * 465 + (kr - r + 7) * 31) * 4, dcb, ciX, ciY); \
        } else if ((t_) < 13) { \
            attn_block<false>(Ks, Vs, 0, fr, g, Qf, acc, lsum, (const LAS unsigned char*)rp, dcb, ciU, ciU); \
            attn_block<false>(Ks, Vs, 32, fr, g, Qf, acc, lsum, (const LAS unsigned char*)rp, dcb, ciU, ciU); \
        } } while (0)
    ATT_QLOAD(Qn, 0);
#define ATT_ITER(R) do { \
        const int slot = D & 1; \
        if (D + 1 < ND) ATT_LWRITE(slot ^ 1, R); \
        if (D + 3 < ND) ATT_GLOAD(D + 3, R); \
        if (p == 0) { \
            ATT_DEC(u * G + c, b, h, rpair); \
            r = 2 * rpair + (wid >> 2); rs0 = min(max(2 * rpair - 4, 0), 56); rsr = min(max(r - 4, 0), 56); \
            qrow = b * 4096 + r * 64 + 16 * j + fr; \
            Qf[0] = Qn[0]; Qf[1] = Qn[1]; \
            _Pragma("unroll") for (int db = 0; db < 4; ++db) acc[db] = (f32x4){0.f, 0.f, 0.f, 0.f}; \
            lsum = 0.f; \
        } \
        if (p == 4 && u + 1 < nunits) ATT_QLOAD(Qn, u + 1); \
        { const int i0_ = rs0 + 2 * p - rsr, i1_ = i0_ + 1; \
          if (2 * p + 1 < 9 && i0_ >= 0 && i1_ < 8) {        \
            const LAS bf16_t* Ka = (const LAS bf16_t*)(lds + RP_BYTES + slot * PAIR_B); const LAS bf16_t* Va = (const LAS bf16_t*)(lds + RP_BYTES + slot * PAIR_B + TILE_B); \
            const LAS bf16_t* Kb = (const LAS bf16_t*)(lds + RP_BYTES + slot * PAIR_B + 2 * TILE_B); const LAS bf16_t* Vb = (const LAS bf16_t*)(lds + RP_BYTES + slot * PAIR_B + 3 * TILE_B); \
            const LAS unsigned char* rb_ = (const LAS unsigned char*)rp + (h * 465 + (rs0 + 2 * p - r + 7) * 31) * 4; \
            attn_block<true>(Ka, Va, w0, fr, g, Qf, acc, lsum, rb_, dcb, ciX, ciY); \
            attn_block<true>(Kb, Vb, w0, fr, g, Qf, acc, lsum, rb_ + 124, dcb, ciX, ciY); \
          } else { ATT_TILE(2 * p, 0); ATT_TILE(2 * p + 1, 2 * TILE_B); } } \
        if (p == NPAIR - 1) { \
            float ls = lsum; ls += __shfl_xor(ls, 16); ls += __shfl_xor(ls, 32); \
            const float inv = 1.0f / ls; \
            bf16_t* op = O + (size_t)qrow * 1024 + h * 64 + 4 * g; \
            _Pragma("unroll") for (int db = 0; db < 4; ++db) { u32x2 w; w.x = cvt_pk_bf16(acc[db][0] * inv, acc[db][1] * inv); w.y = cvt_pk_bf16(acc[db][2] * inv, acc[db][3] * inv); st8(op + 16 * db, w); } \
            p = 0; ++u; \
        } else ++p; \
        __syncthreads(); \
    } while (0)
    for (;;) {
        ATT_ITER(R1); if (++D >= ND) break;
        ATT_ITER(R0); if (++D >= ND) break;
    }
#undef ATT_ITER
#undef ATT_TILE
#undef ATT_QLOAD
#undef ATT_DEC
#undef ATT_TOK
#undef ATT_GLOAD
#undef ATT_LWRITE
}

__device__ __forceinline__ void s1_phase(const bf16_t* Z0, const bf16_t* Dg, bf16_t* Z1, LAS unsigned char* lds, int gw, int NGW) {
    constexpr int DP = 136;
    LAS bf16_t* Dl = (LAS bf16_t*)lds;
    int tid = threadIdx.x; asm volatile("" : "+v"(tid));
    const int lane = tid & 63, fr = lane & 15, g = lane >> 4;
    for (int i = tid; i < 128 * 16; i += 512) { const int row = i >> 4, ch = i & 15; *(LAS u32x4*)(Dl + row * DP + ch * 8) = *(const u32x4*)(Dg + row * 128 + ch * 8); }
    __syncthreads();
    for (int colM = gw; colM < pg8::NCOL; colM += NGW) {
        bf16x8 A[4][4];
#pragma unroll
        for (int ib = 0; ib < 4; ++ib)
#pragma unroll
            for (int kb = 0; kb < 4; ++kb) A[ib][kb] = *(const bf16x8*)(Z0 + ((size_t)colM * 64 + 16 * ib + fr) * 128 + 32 * kb + 8 * g);
#pragma unroll 2
        for (int jb = 0; jb < 8; ++jb) {
            bf16x8 Bf[4];
#pragma unroll
            for (int kb = 0; kb < 4; ++kb) Bf[kb] = *(const LAS bf16x8*)(Dl + (16 * jb + fr) * DP + 32 * kb + 8 * g);
            const int n = 16 * jb + fr, ka = n >> 1, rip = n & 1;
#pragma unroll
            for (int ib = 0; ib < 4; ++ib) {
                f32x4 a = (f32x4){0.f, 0.f, 0.f, 0.f};
#pragma unroll
                for (int kb = 0; kb < 4; ++kb) a = mfma16(A[ib][kb], Bf[kb], a);
                u32x2 w; w.x = cvt_pk_bf16(a[0], a[1]); w.y = cvt_pk_bf16(a[2], a[3]);
                st8(Z1 + (((size_t)ka * pg8::NCOL + colM) * 2 + rip) * 64 + 16 * ib + 4 * g, w);
            }
        }
    }
    __syncthreads();
}
__device__ __forceinline__ void s2_phase(const bf16_t* Z1, const bf16_t* Eg, bf16_t* F, int gw, int NGW, int lane) {
    const int fr = lane & 15, g = lane >> 4;
    for (int it = gw; it < 2048 + 64; it += NGW) {
        const bool special = it >= 2048;
        const int ka = special ? it - 2048 : (it & 63), q = it >> 6, bg = q >> 1, ib0 = special ? 0 : 4 * (q & 1), nib = special ? 1 : 4;
        bf16x8 Bf[4][4];
#pragma unroll
        for (int jb = 0; jb < 4; ++jb)
#pragma unroll
            for (int kb = 0; kb < 4; ++kb) Bf[jb][kb] = *(const bf16x8*)(Eg + ((size_t)ka * 64 + 16 * jb + fr) * 128 + 32 * kb + 8 * g);
        for (int ibb = 0; ibb < nib; ++ibb) {
            const int ib = ib0 + ibb;
            const int colM0 = special ? 2048 : bg * 128 + ib * 16;
            bf16x8 A[4];
#pragma unroll
            for (int kb = 0; kb < 4; ++kb) A[kb] = *(const bf16x8*)(Z1 + ((size_t)ka * pg8::NCOL + colM0 + fr) * 128 + 32 * kb + 8 * g);
            const int k2 = ib * 16 + 4 * g, b = bg >> 2, gg = bg & 3;
#pragma unroll
            for (int jb = 0; jb < 4; ++jb) {
                f32x4 a = (f32x4){0.f, 0.f, 0.f, 0.f};
#pragma unroll
                for (int kb = 0; kb < 4; ++kb) a = mfma16(A[kb], Bf[jb][kb], a);
                const int k = ka + 64 * (16 * jb + fr), km = (4096 - k) & 4095;
                u32x2 w; w.x = cvt_pk_bf16(a[0], a[1]); w.y = cvt_pk_bf16(a[2], a[3]);
                if (!special) {
                    st8(F + ((size_t)b * 4096 + k) * 1024 + gg * 256 + k2, w);
                    bf16_t* pm_ = F + ((size_t)b * 4096 + km) * 1024 + gg * 256 + 128 + k2;
                    if (k2 != 0) st8(pm_, w);
                    else { pm_[1] = (bf16_t)(w.x >> 16); *(unsigned*)(pm_ + 2) = w.y; }
                } else {
                    bf16_t* ps_ = F + ((size_t)g * 4096 + k) * 1024 + 128;
                    ps_[0] = (bf16_t)(w.x & 0xffffu); ps_[256] = (bf16_t)(w.x >> 16); ps_[512] = (bf16_t)(w.y & 0xffffu); ps_[768] = (bf16_t)(w.y >> 16);
                }
            }
        }
    }
}


#ifndef MK_DEBUG
#define MK_DEBUG 0
#endif
__device__ __forceinline__ void dbg_scan16(const bf16_t* p, size_t n, unsigned* flags, unsigned bit, int gt, int NT) {
    bool bad = false; for (size_t i = gt; i < n; i += NT) bad |= ((p[i] & 0x7f80u) == 0x7f80u);
    if (bad) atomicOr(flags, 1u << bit);
}
__device__ __forceinline__ void dbg_scan32(const float* p, size_t n, unsigned* flags, unsigned bit, int gt, int NT) {
    bool bad = false; for (size_t i = gt; i < n; i += NT) bad |= ((__float_as_uint(p[i]) & 0x7f800000u) == 0x7f800000u);
    if (bad) atomicOr(flags, 1u << bit);
}
struct Args { const float* in[15]; float* out; unsigned char* ws; int ph_lo, ph_hi, use_cg, pad; };
static_assert(sizeof(Args) == 15 * 8 + 8 + 8 + 16, "no padding");

__global__ void __launch_bounds__(512, 2) fwd_kernel(Args args) {
    extern __shared__ __attribute__((aligned(16))) unsigned char lds_raw[];
    LAS unsigned char* lds = (LAS unsigned char*)lds_raw;
    const int G = gridDim.x, c = blockIdx.x;
    const int vcu = (G % 8 == 0) ? (c % 8) * (G / 8) + c / 8 : c;
    const int NGW = G * 8;
#define PHASE_IDS int tid_ = threadIdx.x; asm volatile("" : "+v"(tid_)); const int lane = tid_ & 63, wid = __builtin_amdgcn_readfirstlane(tid_ >> 6); const int gw = vcu * 8 + wid; (void)lane; (void)gw
    unsigned char* ws = args.ws;
    const float* x = args.in[0]; const float* cvec = args.in[1]; const float* ctx = args.in[2]; const float* cctx = args.in[3];
    const float* ada_w = args.in[4]; const float* ada_b = args.in[5]; const float* norm_g = args.in[6];
    const float* wqkv = args.in[7]; const float* wo = args.in[8]; const float* gq = args.in[9]; const float* gk = args.in[10]; const float* rpb = args.in[11];
    const float* fw = args.in[12]; const float* w1 = args.in[13]; const float* w2 = args.in[14];
    float* out = args.out;
    float* mods = (float*)(ws + WS_MODS); float* sbound = (float*)(ws + WS_SB);
    bf16_t* CS = (bf16_t*)(ws + WS_CS); bf16_t* Dt = (bf16_t*)(ws + WS_D); bf16_t* Et = (bf16_t*)(ws + WS_E);
    bf16_t* WQK = (bf16_t*)(ws + WS_WQK); bf16_t* WV = (bf16_t*)(ws + WS_WV); bf16_t* WO = (bf16_t*)(ws + WS_WO); bf16_t* FWt = (bf16_t*)(ws + WS_FW);
    bf16_t* W1t = (bf16_t*)(ws + WS_W1); bf16_t* W2t = (bf16_t*)(ws + WS_W2);
    bf16_t* H = (bf16_t*)(ws + WS_H); bf16_t* QK = (bf16_t*)(ws + WS_QK); bf16_t* VT = (bf16_t*)(ws + WS_VT); bf16_t* O = (bf16_t*)(ws + WS_O);
    bf16_t* XS = (bf16_t*)(ws + WS_XS); bf16_t* HMID = (bf16_t*)(ws + WS_HMID); bf16_t* Z0 = (bf16_t*)(ws + WS_Z0); bf16_t* Z1 = (bf16_t*)(ws + WS_Z1); bf16_t* Fb = (bf16_t*)(ws + WS_F);
    float* SSQ = (float*)(ws + WS_SSQ); float* BV0 = (float*)(ws + WS_BV); float* BV1 = BV0 + 4 * 4096; float* BVF = BV1 + 4 * 4096; float* GM = BVF + 16 * 512;
    const int lo = args.ph_lo, hi = args.ph_hi;
    cg::grid_group grid = cg::this_grid();
#define IN(k) (lo <= (k) && (k) < hi)
#ifndef REP_SYNC
#define REP_SYNC 1
#endif
#ifndef REP_NORM
#define REP_NORM 1
#endif
#ifndef REP_S12
#define REP_S12 1
#endif
#ifndef REP_P0
#define REP_P0 1
#endif
#ifndef USE_XB
#define USE_XB 1
#endif
#define SEAM(k) do { if (IN(k) && IN((k) + 1)) { for (int r_ = 0; r_ < REP_SYNC; ++r_) { if (use_cg) grid.sync(); else xcd_barrier(xbar); } } } while (0)
    { volatile LAS unsigned* st_ = (volatile LAS unsigned*)(lds + LDS_BYTES - 64); if (threadIdx.x < 2) st_[threadIdx.x] = 0u; __syncthreads(); }
    XcdBarrier xbar; xbar.bar = (unsigned*)(ws + WS_BAR); xbar.x = 0; xbar.st = (volatile LAS unsigned*)(lds + LDS_BYTES - 64);
    const bool use_cg = (args.use_cg != 0);
    if (!use_cg && hi - lo > 1) xbar = xcd_barrier_post((unsigned*)(ws + WS_BAR), (volatile LAS unsigned*)(lds + LDS_BYTES - 64));

    unsigned* dflags = (unsigned*)(ws + WS_SB + 256);
#define DBG16(k, bit, p, n) do { if (MK_DEBUG && IN(k)) { int t_ = threadIdx.x; asm volatile("" : "+v"(t_)); dbg_scan16(p, n, dflags, bit, (vcu * 512) + t_, G * 512); } } while (0)
#define DBG32(k, bit, p, n) do { if (MK_DEBUG && IN(k)) { int t_ = threadIdx.x; asm volatile("" : "+v"(t_)); dbg_scan32(p, n, dflags, bit, (vcu * 512) + t_, G * 512); } } while (0)
    if (IN(0)) {
        PHASE_IDS;
        if (MK_DEBUG && c == 0 && tid_ == 0) *dflags = 0u;
        for (int r0_ = 0; r0_ < REP_P0; ++r0_) {
        for (int u = c; u < 192; u += G) p0_mods_unit(cvec, cctx, ada_w, ada_b, mods, lds, u);
        __syncthreads();
        {
            LAS float* scr = (LAS float*)(lds + wid * 16384);
            constexpr int I_QKV = 16 * 96, I_SQ = 16 * 32, I_1 = 16 * 128, I_2 = 64 * 32;
            constexpr int NITEMS = I_QKV + I_SQ + 2 * I_1 + I_2;
            for (int it = NITEMS - 1 - gw; it >= 0; it -= NGW) {
                int r = it;
                if (r < I_QKV) { p0_transpose_item(wqkv, 1024, 3072, WQK, WV, 1, scr, r, lane); continue; } r -= I_QKV;
                if (r < I_SQ) { p0_transpose_item(wo, 1024, 1024, WO, nullptr, 0, scr, r, lane); continue; } r -= I_SQ;
                if (r < 2 * I_1) { const int l = r / I_1; p0_transpose_item(w1 + (size_t)l * 1024 * 4096, 1024, 4096, W1t + (size_t)l * 4096 * 1024, nullptr, 0, scr, r % I_1, lane); continue; } r -= 2 * I_1;
                p0_transpose_item(w2, 4096, 1024, W2t, nullptr, 0, scr, r, lane);
            }
        }
        {
            const int gt = gw * 64 + lane, NT = NGW * 64;
            for (int i = gt; i < 256 * 256; i += NT) { const int m = i >> 8, cc = i & 255, ri = m >> 7, k2 = m & 127; float sn, cs; sincospif(2.0f * (float)((cc * k2) & 255) / 256.0f, &sn, &cs);
                float v = (ri == 0 ? cs : -sn) * (1.0f / 16.0f); if (m == 128) v = (cc & 1) ? -(1.0f / 16.0f) : (1.0f / 16.0f);
                CS[i] = (bf16_t)(cvt_pk_bf16(v, 0.f) & 0xffffu); }
            for (int i = gt; i < 128 * 128; i += NT) { const int n = i >> 7, kp = i & 127, ka = n >> 1, rip = n & 1, ri = kp >> 6, a = kp & 63; float sn, cs; sincospif(2.0f * (float)((a * ka) & 63) / 64.0f, &sn, &cs);
                const float v = (rip == 0 ? (ri == 0 ? cs : sn) : (ri == 0 ? -sn : cs)) * 0.125f; Dt[i] = (bf16_t)(cvt_pk_bf16(v, 0.f) & 0xffffu); }
            for (int i = gt; i < 64 * 64 * 128; i += NT) { const int kp = i & 127, kbk = (i >> 7) & 63, ka = i >> 13, rip = kp >> 6, bp = kp & 63; float sn, cs; sincospif(2.0f * (float)((bp * (ka + 64 * kbk)) & 4095) / 4096.0f, &sn, &cs);
                const float v = (rip == 0 ? cs : sn) * 0.125f; Et[i] = (bf16_t)(cvt_pk_bf16(v, 0.f) & 0xffffu); }
        }
        if (c == G - 1 && wid == 7) {
            float mq = fabsf(gq[lane]), mk = fabsf(gk[lane]), mr = 0.f;
            for (int i = lane; i < 16 * 465; i += 64) mr = fmaxf(mr, fabsf(rpb[i]));
#pragma unroll
            for (int o = 1; o < 64; o <<= 1) { mq = fmaxf(mq, __shfl_xor(mq, o)); mk = fmaxf(mk, __shfl_xor(mk, o)); mr = fmaxf(mr, __shfl_xor(mr, o)); }
            if (lane == 0) *sbound = (8.0f * mq * mk + mr) * LOG2E;
        }
        __syncthreads();
        }
    }
    SEAM(0);
    const bool ctx_in_p1 = false;
    if (IN(1)) { PHASE_IDS;
        if (c == G - 1) {
            for (int i = tid_; i < 3 * 4096; i += 512) { const int idx = i >> 12, b = (i >> 10) & 3, col = i & 1023;
                const float gg = norm_g[(idx == 0 ? 1024 : idx == 1 ? 2048 : 3072) + col];
                const float sc = mods[(size_t)((idx == 0 ? 0 : 5) + b) * 6144 + (idx == 1 ? 1024 : 4096) + col];
                GM[i] = gg * (1.0f + sc); }
        }
        if (!ctx_in_p1) norm_rows(x, ctx, MT, norm_g, mods, 0, 1024, H, gw, NGW, lane);
        else if (c >= 32) norm_rows(x, ctx, ML, norm_g, mods, 0, 1024, H, (c - 32) * 8 + wid, (G - 32) * 8, lane);
        else {
            pg8::SchedOne S1u; const size_t ts = (size_t)256 * 1024 * 2; int tt;
            if (c < 16) { S1u.u.kind = 0; S1u.u.pm = 64 + (c & 3); S1u.u.pn = 4 + (c >> 2); tt = c & 3; S1u.u.a = (const char*)H + (size_t)S1u.u.pm * ts; S1u.u.b = (const char*)WQK + (size_t)S1u.u.pn * ts; }
            else { const int l2 = c - 16; S1u.u.kind = 1; S1u.u.pm = l2 & 3; S1u.u.pn = 64 + (l2 >> 2); tt = l2 >> 2; S1u.u.a = (const char*)WV + (size_t)S1u.u.pm * ts; S1u.u.b = (const char*)H + (size_t)S1u.u.pn * ts; }
            S1u.u.aux = 0;
            norm_rows(x, ctx, ML + tt * 256 + 256, norm_g, mods, 0, 1024, H, ML + tt * 256 + wid, 8, lane);
            asm volatile("s_waitcnt vmcnt(0)" ::: "memory"); __syncthreads();
            pg8::EpiQKV E{QK, VT, gq, gk};
            pg8::gemm_phase<pg8::EpiQKV, pg8::SchedOne, false>(lds, 1024, 1024, 1024, S1u, E);
        }
    }
    SEAM(1);
    DBG16(2, 0, H, (size_t)MT * 1024);
    if (IN(2)) { pg8::SchedQKV S{(const char*)H, (const char*)WQK, (const char*)WV, G, c, ctx_in_p1 ? 768 : 800}; pg8::EpiQKV E{QK, VT, gq, gk};
#ifndef REP_G2
#define REP_G2 1
#endif
        for (int r_ = 0; r_ < REP_G2; ++r_) pg8::gemm_phase<pg8::EpiQKV, pg8::SchedQKV, false>(lds, 1024, 1024, 1024, S, E);
        { PHASE_IDS;
          const bool part = (G > 32); const int w_ = part ? (c - 32) * 8 + wid : gw, nw_ = part ? (G - 32) * 8 : NGW;
          if (!part || c >= 32) {
              bias_items(W1t, CS, mods, BV0, BV1, BVF, w_, nw_, lane);
              LAS float* scr = (LAS float*)(lds + wid * 16384);
              constexpr int I_SQ = 16 * 32, I_2 = 64 * 32;
              for (int it = w_; it < I_SQ + I_2; it += nw_) {
                  if (it < I_SQ) p0_transpose_item(fw, 1024, 1024, FWt, nullptr, 2, scr, it, lane);
                  else p0_transpose_item(w2 + (size_t)4096 * 1024, 4096, 1024, W2t + (size_t)1024 * 4096, nullptr, 0, scr, it - I_SQ, lane);
              }
          } } }
    SEAM(2);
    DBG16(3, 1, QK, (size_t)ML * 2048); DBG16(3, 2, VT, (size_t)1024 * MT); DBG32(3, 13, mods, (size_t)10 * 6144);
#ifndef REP_ATT
#define REP_ATT 1
#endif
    if (IN(3)) { for (int rep = 0; rep < REP_ATT; ++rep) attn_phase(QK, VT, O, rpb, sbound, lds, G, c); }
    SEAM(3);
    DBG16(4, 3, O, (size_t)ML * 1024);
    if (IN(4)) { pg8::SchedStd S; S.init(O, WO, ML, 1024, 1024, 1024, G, c); pg8::EpiResF<false> E{x, XS, mods + 2048, GM, H, SSQ};
        pg8::gemm_phase<pg8::EpiResF<false>, pg8::SchedStd, false>(lds, 1024, 1024, 1024, S, E); }
    SEAM(4);
    DBG32(5, 4, out, (size_t)ML * 1024);
    if (IN(6)) { pg8::SchedStd S; S.init(H, W1t, ML, 4096, 1024, 1024, G, c); pg8::EpiRelu2F E{HMID, 4096, BV0, SSQ};
        pg8::gemm_phase<pg8::EpiRelu2F, pg8::SchedStd, false>(lds, 1024, 1024, 1024, S, E); }
    SEAM(6);
    DBG16(7, 5, HMID, (size_t)ML * 4096);
    if (IN(7)) { pg8::SchedStd S; S.init(HMID, W2t, ML, 1024, 64, 4096, G, c, (size_t)64 * 32768); pg8::EpiResF<true> E{XS, XS, mods + 5120, GM + 4096, H, SSQ};
        pg8::gemm_phase<pg8::EpiResF<true>, pg8::SchedStd, false>(lds, 4096, 64, 4096, S, E, 32768, 128); }
    SEAM(7);
    const float* mods1 = mods + 5 * 6144;
    DBG32(8, 6, out, (size_t)ML * 1024);
    if (IN(9)) { pg8::SchedF1 S{(const char*)CS, (const char*)H, G, c}; pg8::EpiZ0F E{Z0, BVF, SSQ};
        pg8::gemm_phase<pg8::EpiZ0F, pg8::SchedF1, true>(lds, 256, 256, 1024, S, E); }
    SEAM(9);
    DBG16(10, 7, Z0, (size_t)262144 * 128);
    if (IN(10)) { PHASE_IDS; for (int r_ = 0; r_ < REP_S12; ++r_) s1_phase(Z0, Dt, Z1, lds, gw, NGW); }
    SEAM(10);
    DBG16(11, 8, Z1, (size_t)262144 * 128);
    if (IN(11)) { PHASE_IDS; for (int r_ = 0; r_ < REP_S12; ++r_) s2_phase(Z1, Et, Fb, gw, NGW, lane); }
    SEAM(11);
    DBG16(12, 9, Fb, (size_t)ML * 1024);
    if (IN(12)) { pg8::SchedStd S; S.init(Fb, FWt, ML, 1024, 1024, 1024, G, c); pg8::EpiResF<true> E{XS, XS, mods1 + 2048, GM + 8192, H, SSQ};
        pg8::gemm_phase<pg8::EpiResF<true>, pg8::SchedStd, false>(lds, 1024, 1024, 1024, S, E); }
    SEAM(12);
    DBG32(13, 10, out, (size_t)ML * 1024);
    if (IN(14)) { pg8::SchedStd S; S.init(H, W1t + (size_t)4096 * 1024, ML, 4096, 1024, 1024, G, c); pg8::EpiRelu2F E{HMID, 4096, BV1, SSQ};
        pg8::gemm_phase<pg8::EpiRelu2F, pg8::SchedStd, false>(lds, 1024, 1024, 1024, S, E); }
    SEAM(14);
    DBG16(15, 11, HMID, (size_t)ML * 4096);
    if (IN(15)) { pg8::SchedStd S; S.init(HMID, W2t + (size_t)1024 * 4096, ML, 1024, 64, 4096, G, c, (size_t)64 * 32768); pg8::EpiRes E{XS, out, mods1 + 5120};
        pg8::gemm_phase<pg8::EpiRes, pg8::SchedStd, false>(lds, 4096, 64, 4096, S, E, 32768, 128); }
    SEAM(15);
    if (MK_DEBUG && IN(16)) {
        int t_ = threadIdx.x; asm volatile("" : "+v"(t_));
        bool bad = false;
        for (size_t i = (size_t)vcu * 512 + t_; i < (size_t)ML * 1024; i += (size_t)G * 512) { if ((__float_as_uint(out[i]) & 0x7f800000u) == 0x7f800000u) { bad = true; out[i] = 0.f; } }
        if (bad) atomicOr(dflags, 1u << 12);
    }
    SEAM(16);
    if (MK_DEBUG && IN(17)) {
        if (c == 0 && threadIdx.x == 0) { const unsigned f = *dflags; if (f) out[0] = 1.0e6f * (float)(__builtin_ctz(f) + 1) + 1.0e4f * (float)__builtin_popcount(f); }
    }
#undef IN
#undef SEAM
}

constexpr int NPHASE = MK_DEBUG ? 18 : 16;
#ifndef MK_USE_CG
#define MK_USE_CG 0
#endif
#ifndef MK_PER_PHASE
#define MK_PER_PHASE 0
#endif

extern "C" void kernel_launch(void* const* d_in, const int* in_sizes, int n_in, void* d_out, int out_size, void* d_ws, size_t ws_size, hipStream_t stream) {
    static int grid = 0;
    if (grid == 0) {
        if (n_in != 15 || out_size != ML * DM || ws_size < WS_END) { fprintf(stderr, "kernel_launch: unexpected shapes (n_in %d out %d ws %zu)\n", n_in, out_size, ws_size); grid = -1; return; }
        int dev = 0, cus = 0, per_cu = 0;
        hipGetDevice(&dev); hipDeviceGetAttribute(&cus, hipDeviceAttributeMultiprocessorCount, dev);
        hipFuncSetAttribute((const void*)fwd_kernel, hipFuncAttributeMaxDynamicSharedMemorySize, LDS_BYTES);
        if (hipOccupancyMaxActiveBlocksPerMultiprocessor(&per_cu, (const void*)fwd_kernel, 512, LDS_BYTES) != hipSuccess || per_cu < 1) { fprintf(stderr, "kernel_launch: occupancy query failed (%d)\n", per_cu); (void)hipGetLastError(); per_cu = 1; }
        grid = cus * 1;
        if (grid <= 0) grid = 256;
    }
    if (grid < 0) return;
    if (hipMemsetAsync((char*)d_ws + WS_BAR, 0, BAR_BYTES, stream) != hipSuccess) { fprintf(stderr, "kernel_launch: memset failed\n"); return; }
    Args a{};
    for (int i = 0; i < 15; ++i) a.in[i] = (const float*)d_in[i];
    a.out = (float*)d_out; a.ws = (unsigned char*)d_ws;
#if MK_PER_PHASE
    for (int p = 0; p < NPHASE; ++p) { a.ph_lo = p; a.ph_hi = p + 1; hipLaunchKernelGGL(fwd_kernel, dim3(grid), dim3(512), LDS_BYTES, stream, a); }
#else
    a.ph_lo = 0; a.ph_hi = NPHASE; a.use_cg = MK_USE_CG;
    void* kargs[] = {&a};
    hipError_t e = hipLaunchCooperativeKernel((const void*)fwd_kernel, dim3(grid), dim3(512), kargs, LDS_BYTES, stream);
    if (e != hipSuccess) fprintf(stderr, "cooperative launch failed: %s (grid %d)\n", hipGetErrorString(e), grid);
#endif
}
```

```cpp
#include <hip/hip_runtime.h>
#include <hip/hip_cooperative_groups.h>
#include <cstdio>
#include <cstdint>
namespace cg = cooperative_groups;

#define LAS __attribute__((address_space(3)))
typedef unsigned short bf16_t;
typedef short bf16x8 __attribute__((ext_vector_type(8)));
typedef short s16x4 __attribute__((ext_vector_type(4)));
typedef float f32x4 __attribute__((ext_vector_type(4)));
typedef unsigned u32x4 __attribute__((ext_vector_type(4)));
typedef unsigned u32x2 __attribute__((ext_vector_type(2)));

constexpr int DM = 1024, NB = 4, SEQ = 4096, CTXL = 256, FF = 4096;
constexpr int ML = NB * SEQ;
constexpr int MT = ML + NB * CTXL;
constexpr float LOG2E = 1.4426950408889634f;
constexpr float EPS = 1e-6f;

constexpr size_t MiB = 1u << 20;
constexpr size_t WS_MODS = 0;
constexpr size_t WS_SB = 512 * 1024;
constexpr size_t WS_BAR = 1 * MiB;
constexpr size_t BAR_BYTES = 16384;
constexpr size_t WS_CS = 2 * MiB;
constexpr size_t WS_D = 2 * MiB + 512 * 1024;
constexpr size_t WS_E = 3 * MiB;
constexpr size_t WS_WQK = 4 * MiB, WS_WV = 8 * MiB, WS_WO = 10 * MiB, WS_FW = 12 * MiB;
constexpr size_t WS_W1 = 14 * MiB;
constexpr size_t WS_W2 = 30 * MiB;
constexpr size_t WS_SSQ = 46 * MiB;
constexpr size_t WS_BV = 47 * MiB;
constexpr size_t WS_H = 48 * MiB;
constexpr size_t WS_R = 82 * MiB;
constexpr size_t WS_QK = WS_R;
constexpr size_t WS_VT = WS_R + 68 * MiB;
constexpr size_t WS_O = WS_R + 102 * MiB;
constexpr size_t WS_HMID = WS_R;
constexpr size_t WS_Z0 = WS_R;
constexpr size_t WS_Z1 = WS_R + 64 * MiB;
constexpr size_t WS_F = WS_R;
constexpr size_t WS_XS = WS_R + 134 * MiB;
constexpr size_t WS_END = 256 * MiB;
static_assert(WS_XS + 32 * MiB <= WS_END && WS_O + 32 * MiB <= WS_XS && WS_F + 32 * MiB <= WS_END && WS_HMID + 128 * MiB <= WS_END && WS_O + 32 * MiB <= WS_END, "ws map");

constexpr int LDS_BYTES = 147456;

typedef __bf16 bf16v2_t __attribute__((ext_vector_type(2)));
typedef float f32v2_t __attribute__((ext_vector_type(2)));
__device__ __forceinline__ unsigned cvt_pk_bf16(float lo, float hi) { const f32v2_t v = {lo, hi}; const bf16v2_t r = __builtin_convertvector(v, bf16v2_t); return __builtin_bit_cast(unsigned, r); }
__device__ __forceinline__ f32x4 mfma16(bf16x8 a, bf16x8 b, f32x4 c) { return __builtin_amdgcn_mfma_f32_16x16x32_bf16(a, b, c, 0, 0, 0); }


#ifndef MK_WT
#define MK_WT 0
#endif
__device__ __forceinline__ void st16(void* p, u32x4 v) {
#if MK_WT
    asm volatile("global_store_dwordx4 %0, %1, off sc1\n\ts_nop 1" :: "v"(p), "v"(v) : "memory");
#else
    *(u32x4*)p = v;
#endif
}
__device__ __forceinline__ void st16f(void* p, f32x4 v) {
#if MK_WT
    asm volatile("global_store_dwordx4 %0, %1, off sc1\n\ts_nop 1" :: "v"(p), "v"(v) : "memory");
#else
    *(f32x4*)p = v;
#endif
}
__device__ __forceinline__ void st8(void* p, u32x2 v) {
#if MK_WT
    asm volatile("global_store_dwordx2 %0, %1, off sc1\n\ts_nop 1" :: "v"(p), "v"(v) : "memory");
#else
    *(u32x2*)p = v;
#endif
}
namespace pg8 {
constexpr int BM = 256, BK = 64, HALF = 128, HTB = HALF * BK * 2, STAGE_BYTES = 8 * HTB;
__device__ __forceinline__ int lds_byte(int r, int c) { const int st = (r >> 4) * 2 + (c >> 5), rr = r & 15, cc = c & 31, ob = rr * 64 + cc * 2; return st * 1024 + (ob ^ (((ob >> 9) & 1) << 5)); }
__device__ __forceinline__ void stage_rc(int b, int& R, int& C) { const int st = b / 1024, sb = b % 1024, swz = sb ^ (((sb >> 9) & 1) << 5); R = (st >> 1) * 16 + swz / 64; C = (st & 1) * 32 + (swz % 64) / 2; }
__device__ __forceinline__ int perm32(int rho) { const int n = rho >> 4, i = rho & 15; return 8 * (i >> 2) + 4 * n + (i & 3); }

struct Unit { int pm, pn, kind, aux; const char* a; const char* b; };

template <class Epi, class Sched, bool BMAP>
__device__ __forceinline__ void gemm_phase(LAS unsigned char* lds, const int K, const int lda, const int ldb, const Sched& S, const Epi& E, const size_t kstepA = 128, const size_t kstepB = 128) {
    int tid = threadIdx.x; asm volatile("" : "+v"(tid));
    const int wid = __builtin_amdgcn_readfirstlane(tid >> 6), lane = tid & 63, wr = wid >> 2, wc = wid & 3, fr = lane & 15, fq = lane >> 4;
    int nt = K / BK; asm volatile("" : "+s"(nt));
    unsigned voffA[2], voffB[2];
#pragma unroll
    for (int i = 0; i < 2; ++i) { int R, C; stage_rc(tid * 16 + i * 8192, R, C); const int Rb = (R & ~31) + perm32(R & 31);
        voffA[i] = (unsigned)(R * lda + C) * 2u;
        voffB[i] = BMAP ? (unsigned)((64 * (Rb & 63) + (Rb >> 6)) * ldb + C) * 2u : (unsigned)(Rb * ldb + C) * 2u; }
    const size_t hstepA = (size_t)HALF * lda * 2;
    const size_t hstepB = BMAP ? (size_t)2 * ldb * 2 : (size_t)HALF * ldb * 2;
    const unsigned ldsw = (unsigned)wid * 1024u;
    const int aoff = lds_byte(wr * 64 + fr, fq * 8), boff = lds_byte(wc * 32 + fr, fq * 8);
#define PG8_SA(b, h) (((b) * 2 + (h)) * HTB)
#define PG8_SB(b, h) ((4 + (b) * 2 + (h)) * HTB)
#define PG8_STAGE(bufoff, gbase, voff) do { _Pragma("unroll") for (int _i = 0; _i < 2; ++_i) \
        __builtin_amdgcn_global_load_lds((const unsigned*)((const char*)(gbase) + (voff)[_i]), (LAS unsigned*)(lds + (bufoff) + ldsw + _i * 8192), 16, 0, 0); } while (0)
#define PG8_LDA(dst, b, h) do { _Pragma("unroll") for (int m = 0; m < 4; ++m) _Pragma("unroll") for (int k = 0; k < 2; ++k) dst[m][k] = *(const LAS bf16x8*)(lds + PG8_SA(b, h) + aoff + m * 2048 + k * 1024); } while (0)
#define PG8_LDB(dst, b, h) do { _Pragma("unroll") for (int n = 0; n < 2; ++n) _Pragma("unroll") for (int k = 0; k < 2; ++k) dst[n][k] = *(const LAS bf16x8*)(lds + PG8_SB(b, h) + boff + n * 2048 + k * 1024); } while (0)
#define PG8_MMA(ai, bj, At, Bt) do { __builtin_amdgcn_s_setprio(1); _Pragma("unroll") for (int m = 0; m < 4; ++m) _Pragma("unroll") for (int n = 0; n < 2; ++n) _Pragma("unroll") for (int k = 0; k < 2; ++k) \
        acc[ai][bj][m][n] = __builtin_amdgcn_mfma_f32_16x16x32_bf16(Bt[n][k], At[m][k], acc[ai][bj][m][n], 0, 0, 0); __builtin_amdgcn_s_setprio(0); } while (0)
#define PG8_WAIT_V(n) asm volatile("s_waitcnt vmcnt(" #n ")" ::: "memory")
#define PG8_WAIT_L(n) asm volatile("s_waitcnt lgkmcnt(" #n ")" ::: "memory")
#define PG8_BAR __builtin_amdgcn_s_barrier()
#define PG8_SCHED __builtin_amdgcn_sched_barrier(0)
    Unit cur, nxt; int ui = 0;
    if (!S.next(0, cur)) return;
    f32x4 acc[2][2][4][2];
#pragma unroll
    for (int a = 0; a < 2; ++a)
#pragma unroll
        for (int b = 0; b < 2; ++b)
#pragma unroll
            for (int m = 0; m < 4; ++m)
#pragma unroll
                for (int n = 0; n < 2; ++n) acc[a][b][m][n] = (f32x4){0.f, 0.f, 0.f, 0.f};
    bf16x8 At[4][2], B0[2][2], B1[2][2];
    const char* cA = cur.a; const char* cB = cur.b;
    if constexpr (Epi::PREP) E.prep(cur, lds, 0, tid);
    PG8_STAGE(PG8_SB(0, 0), cB, voffB); PG8_STAGE(PG8_SB(0, 1), cB + hstepB, voffB); PG8_STAGE(PG8_SA(0, 0), cA, voffA); PG8_STAGE(PG8_SA(0, 1), cA + hstepA, voffA);
    if (wr == 1) PG8_BAR;
    PG8_WAIT_V(2); PG8_BAR;
    PG8_STAGE(PG8_SB(1, 0), cB + kstepB, voffB); PG8_STAGE(PG8_SA(1, 0), cA + kstepA, voffA); PG8_STAGE(PG8_SB(1, 1), cB + hstepB + kstepB, voffB);
    PG8_WAIT_V(6); PG8_BAR;
    for (;;) {
        const bool has_next = S.next(ui + 1, nxt);
        const char* nA = has_next ? nxt.a : cA; const char* nB = has_next ? nxt.b : cB;
        for (int t = 0; t < nt; t += 2) {
            const bool last = (t == nt - 2);
            const char* a1 = cA + (size_t)(t + 1) * kstepA;
            const char* a2 = last ? nA : cA + (size_t)(t + 2) * kstepA; const char* b2 = last ? nB : cB + (size_t)(t + 2) * kstepB;
            const char* a3 = a2 + kstepA; const char* b3 = b2 + kstepB;
            PG8_LDB(B0, 0, 0); PG8_LDB(B1, 0, 1); PG8_SCHED; PG8_LDA(At, 0, 0); PG8_STAGE(PG8_SA(1, 1), a1 + hstepA, voffA);
            PG8_WAIT_V(8); PG8_WAIT_L(0); PG8_BAR; PG8_MMA(0, 0, At, B0); PG8_MMA(0, 1, At, B1); PG8_BAR; PG8_SCHED;
            PG8_LDA(At, 0, 1); PG8_STAGE(PG8_SB(0, 0), b2, voffB); PG8_STAGE(PG8_SB(0, 1), b2 + hstepB, voffB); PG8_STAGE(PG8_SA(0, 0), a2, voffA);
            PG8_WAIT_V(8); PG8_WAIT_L(0); PG8_BAR; PG8_MMA(1, 0, At, B0); PG8_MMA(1, 1, At, B1); PG8_BAR; PG8_SCHED;
            PG8_LDB(B0, 1, 0); PG8_LDB(B1, 1, 1); PG8_SCHED; PG8_LDA(At, 1, 0); PG8_STAGE(PG8_SA(0, 1), a2 + hstepA, voffA);
            PG8_WAIT_V(8); PG8_WAIT_L(0); PG8_BAR; PG8_MMA(0, 0, At, B0); PG8_MMA(0, 1, At, B1); PG8_BAR; PG8_SCHED;
            PG8_LDA(At, 1, 1); PG8_STAGE(PG8_SB(1, 0), b3, voffB); PG8_STAGE(PG8_SB(1, 1), b3 + hstepB, voffB); PG8_STAGE(PG8_SA(1, 0), a3, voffA);
            PG8_WAIT_V(8); PG8_WAIT_L(0); PG8_BAR; PG8_MMA(1, 0, At, B0); PG8_MMA(1, 1, At, B1); PG8_BAR; PG8_SCHED;
        }
        if (wr == 0) PG8_BAR;
        if constexpr (Epi::PREP) { if (has_next) E.prep(nxt, lds, (ui + 1) & 1, tid); }
        E(acc, cur, wr, wc, fr, fq, lds, ui & 1);
        if (!has_next) break;
#pragma unroll
        for (int a = 0; a < 2; ++a)
#pragma unroll
            for (int b = 0; b < 2; ++b)
#pragma unroll
                for (int m = 0; m < 4; ++m)
#pragma unroll
                    for (int n = 0; n < 2; ++n) acc[a][b][m][n] = (f32x4){0.f, 0.f, 0.f, 0.f};
        cur = nxt; cA = nA; cB = nB; ++ui;
        if (wr == 1) PG8_BAR;
    }
    PG8_WAIT_V(0);
    PG8_BAR;
#undef PG8_SA
#undef PG8_SB
#undef PG8_STAGE
#undef PG8_LDA
#undef PG8_LDB
#undef PG8_MMA
#undef PG8_WAIT_V
#undef PG8_WAIT_L
#undef PG8_BAR
#undef PG8_SCHED
}

struct SchedStd {
    const char* A; const char* Bt; size_t tsA, tsB; int nM, nN, nwg, G, c;
    __device__ void init(const void* A_, const void* Bt_, int M, int N, int lda, int ldb, int G_, int c_, size_t tsA_ = 0) { A = (const char*)A_; Bt = (const char*)Bt_; tsA = tsA_ ? tsA_ : (size_t)BM * lda * 2; tsB = (size_t)BM * ldb * 2; nM = M / BM; nN = N / BM; nwg = nM * nN; G = G_; c = c_; }
    __device__ bool next(int i, Unit& u) const {
        const long L = (long)i * G + c; if (L >= nwg) return false;
        int wgid = (int)L; { const int q = nwg / 8, r = nwg % 8, xcd = wgid % 8, off = wgid / 8; wgid = (xcd < r ? xcd * (q + 1) : r * (q + 1) + (xcd - r) * q) + off; }
        const int nig = 8 * nN, gid = wgid / nig, fm = gid * 8, gsz = (nM - fm) < 8 ? (nM - fm) : 8;
        u.pm = fm + ((wgid % nig) % gsz); u.pn = (wgid % nig) / gsz; u.kind = 0; u.aux = 0;
        u.a = A + (size_t)u.pm * tsA; u.b = Bt + (size_t)u.pn * tsB; return true;
    }
};
struct SchedQKV {
    const char* H; const char* Wqk; const char* Wv; int G, c, nunits;
    __device__ bool next(int i, Unit& u) const {
        const long Ll = (long)i * G + c; if (Ll >= nunits) return false;
        const int L = (int)Ll; const size_t ts = (size_t)BM * 1024 * 2; u.aux = 0;
        if (L < 512) { const int x = L & 7, off = L >> 3; u.kind = 0; u.pm = 8 * x + (off & 7); u.pn = off >> 3; }
        else if (L < 768) { const int l2 = L - 512, x = l2 & 7, off = l2 >> 3; u.kind = 1; u.pm = off & 3; u.pn = 8 * x + (off >> 2); }
        else if (L < 784) { const int l2 = L - 768; u.kind = 0; u.pm = 64 + (l2 & 3); u.pn = 4 + (l2 >> 2); }
        else { const int l2 = L - 784; u.kind = 1; u.pm = l2 & 3; u.pn = 64 + (l2 >> 2); }
        if (u.kind == 0) { u.a = H + (size_t)u.pm * ts; u.b = Wqk + (size_t)u.pn * ts; }
        else { u.a = Wv + (size_t)u.pm * ts; u.b = H + (size_t)u.pn * ts; }
        return true;
    }
};
struct SchedOne { Unit u;
    __device__ __forceinline__ bool next(int i, Unit& o) const { if (i > 0) return false; o = u; return true; }
};
struct SchedF1 {
    const char* CS; const char* H; int G, c;
    __device__ bool next(int i, Unit& u) const {
        const long Ll = (long)i * G + c; if (Ll >= 256) return false;
        const int L = (int)Ll; const int t = L & 15, b = (L >> 4) & 3, g = (L >> 6) & 3;
        u.pm = 0; u.pn = t; u.kind = g; u.aux = b;
        u.a = CS; u.b = H + ((size_t)(b * 4096 + 4 * t) * 1024 + g * 256) * 2; return true;
    }
};

typedef f32x4 Acc[2][2][4][2];
__device__ __forceinline__ u32x4 pack8(f32x4 v0, f32x4 v1) { u32x4 w; w.x = cvt_pk_bf16(v0[0], v0[1]); w.y = cvt_pk_bf16(v0[2], v0[3]); w.z = cvt_pk_bf16(v1[0], v1[1]); w.w = cvt_pk_bf16(v1[2], v1[3]); return w; }

__device__ __forceinline__ void unpack8(u32x4 w, f32x4& v0, f32x4& v1) {
    v0[0] = __uint_as_float(w.x << 16); v0[1] = __uint_as_float(w.x & 0xffff0000u); v0[2] = __uint_as_float(w.y << 16); v0[3] = __uint_as_float(w.y & 0xffff0000u);
    v1[0] = __uint_as_float(w.z << 16); v1[1] = __uint_as_float(w.z & 0xffff0000u); v1[2] = __uint_as_float(w.w << 16); v1[3] = __uint_as_float(w.w & 0xffff0000u);
}
struct EpiQKV { static constexpr bool PREP = true; bf16_t* QK; bf16_t* VT; const float* gq; const float* gk;
    __device__ __forceinline__ void prep(const Unit& u, LAS unsigned char* lds, int slot, int tid) const {
        if (u.kind == 0 && tid < 64) { const bool isq = u.pn < 4; ((LAS float*)(lds + 131072))[slot * 512 + tid] = isq ? gq[tid] * (0.125f * LOG2E) : gk[tid]; }
    }
    __device__ __forceinline__ void operator()(const Acc& acc, const Unit& u, int wr, int wc, int fr, int fq, LAS unsigned char* lds, int slot) const {
        if (u.kind == 0) {
            const LAS float* gp = (const LAS float*)(lds + 131072) + slot * 512;
            f32x4 gv[2][2];
#pragma unroll
            for (int bj = 0; bj < 2; ++bj)
#pragma unroll
                for (int n = 0; n < 2; ++n) gv[bj][n] = *(const LAS f32x4*)(gp + 32 * bj + 8 * fq + 4 * n);
#pragma unroll
            for (int ai = 0; ai < 2; ++ai)
#pragma unroll
                for (int m = 0; m < 4; ++m) {
                    const int row = u.pm * BM + ai * HALF + wr * 64 + m * 16 + fr;
                    float ss = 0.f;
#pragma unroll
                    for (int bj = 0; bj < 2; ++bj)
#pragma unroll
                        for (int n = 0; n < 2; ++n) { const f32x4 x = acc[ai][bj][m][n]; ss += (x[0] * x[0] + x[1] * x[1]) + (x[2] * x[2] + x[3] * x[3]); }
                    ss += __shfl_xor(ss, 16); ss += __shfl_xor(ss, 32);
                    const float rstd = rsqrtf(ss * (1.0f / 64.0f) + EPS);
                    bf16_t* rowp = QK + (size_t)row * 2048 + u.pn * 256 + wc * 64 + 8 * fq;
#pragma unroll
                    for (int bj = 0; bj < 2; ++bj) st16(rowp + 32 * bj, pack8(acc[ai][bj][m][0] * rstd * gv[bj][0], acc[ai][bj][m][1] * rstd * gv[bj][1]));
                }
        } else {
#pragma unroll
            for (int ai = 0; ai < 2; ++ai)
#pragma unroll
                for (int m = 0; m < 4; ++m) {
                    const int row = u.pm * BM + ai * HALF + wr * 64 + m * 16 + fr;
                    bf16_t* rowp = VT + (size_t)row * MT + u.pn * 256 + wc * 32 + 8 * fq;
#pragma unroll
                    for (int bj = 0; bj < 2; ++bj) st16(rowp + bj * HALF, pack8(acc[ai][bj][m][0], acc[ai][bj][m][1]));
                }
        }
    }
};
struct EpiRelu2 { static constexpr bool PREP = false; bf16_t* O; int ldc;
    __device__ __forceinline__ void operator()(const Acc& acc, const Unit& u, int wr, int wc, int fr, int fq, LAS unsigned char*, int) const {
#pragma unroll
        for (int ai = 0; ai < 2; ++ai)
#pragma unroll
            for (int m = 0; m < 4; ++m) {
                const int row = u.pm * BM + ai * HALF + wr * 64 + m * 16 + fr;
                bf16_t* rowp = O + (size_t)row * ldc + u.pn * 256 + wc * 32 + 8 * fq;
#pragma unroll
                for (int bj = 0; bj < 2; ++bj) { f32x4 v0 = acc[ai][bj][m][0], v1 = acc[ai][bj][m][1];
#pragma unroll
                    for (int e = 0; e < 4; ++e) { const float a = fmaxf(v0[e], 0.f), b = fmaxf(v1[e], 0.f); v0[e] = a * a; v1[e] = b * b; }
                    *(u32x4*)(rowp + bj * HALF) = pack8(v0, v1); }
            }
    }
};
struct EpiRes { static constexpr bool PREP = false; const bf16_t* base; float* out; const float* gate;
    __device__ __forceinline__ void operator()(const Acc& acc, const Unit& u, int wr, int wc, int fr, int fq, LAS unsigned char*, int) const {
        const int col0 = u.pn * 256 + wc * 32 + 8 * fq;
        const float* gp = gate + (size_t)(u.pm >> 4) * 6144 + col0;
        f32x4 gv[2][2];
#pragma unroll
        for (int bj = 0; bj < 2; ++bj)
#pragma unroll
            for (int n = 0; n < 2; ++n) gv[bj][n] = *(const f32x4*)(gp + bj * HALF + 4 * n);
#pragma unroll
        for (int ai = 0; ai < 2; ++ai)
#pragma unroll
          for (int mh = 0; mh < 2; ++mh) {
            u32x4 pre[2][2];
#pragma unroll
            for (int m2 = 0; m2 < 2; ++m2)
#pragma unroll
                for (int bj = 0; bj < 2; ++bj) pre[m2][bj] = __builtin_nontemporal_load((const u32x4*)(base + (size_t)(u.pm * BM + ai * HALF + wr * 64 + (2 * mh + m2) * 16 + fr) * 1024 + col0 + bj * HALF));
            asm volatile("" ::: "memory");
#pragma unroll
            for (int m2 = 0; m2 < 2; ++m2) { const int m = 2 * mh + m2;
                const size_t off = (size_t)(u.pm * BM + ai * HALF + wr * 64 + m * 16 + fr) * 1024 + col0;
#pragma unroll
                for (int bj = 0; bj < 2; ++bj) { f32x4 b0, b1; unpack8(pre[m2][bj], b0, b1);
                    *(f32x4*)(out + off + bj * HALF) = b0 + gv[bj][0] * acc[ai][bj][m][0]; *(f32x4*)(out + off + bj * HALF + 4) = b1 + gv[bj][1] * acc[ai][bj][m][1]; }
            }
            asm volatile("" ::: "memory");
          }
    }
};
struct EpiZ0 { static constexpr bool PREP = false; bf16_t* Z0;
    __device__ __forceinline__ void operator()(const Acc& acc, const Unit& u, int wr, int wc, int fr, int fq, LAS unsigned char*, int) const {
        const int ri = u.pm, t = u.pn, g = u.kind, b = u.aux;
        bf16_t* p0 = Z0 + ((size_t)(((b * 4 + g) * 256 + wr * 64 + fr) * 64 + 4 * t + (wc >> 1))) * 128 + ri * 64 + 32 * (wc & 1) + 8 * fq;
#pragma unroll
        for (int ai = 0; ai < 2; ++ai)
#pragma unroll
            for (int m = 0; m < 4; ++m) {
#pragma unroll
                for (int bj = 0; bj < 2; ++bj)
                    *(u32x4*)(p0 + (size_t)(ai * HALF + m * 16) * 8192 + bj * 256) = pack8(acc[ai][bj][m][0], acc[ai][bj][m][1]);
                asm volatile("" ::: "memory");
            }
    }
};

constexpr int AUX_OFF = 131072;
template <bool BASE16>
struct EpiResF { static constexpr bool PREP = false; const void* base; bf16_t* XS; const float* gate; const float* gm; bf16_t* XB; float* SSQ;
    __device__ __forceinline__ void operator()(const Acc& acc, const Unit& u, int wr, int wc, int fr, int fq, LAS unsigned char*, int) const {
        const int col0 = u.pn * 256 + wc * 32 + 8 * fq, b = u.pm >> 4;
        f32x4 gv[2][2], mv[2][2];
#pragma unroll
        for (int bj = 0; bj < 2; ++bj)
#pragma unroll
            for (int n = 0; n < 2; ++n) { gv[bj][n] = *(const f32x4*)(gate + (size_t)b * 6144 + col0 + bj * HALF + 4 * n); mv[bj][n] = *(const f32x4*)(gm + b * 1024 + col0 + bj * HALF + 4 * n); }
#pragma unroll
        for (int ai = 0; ai < 2; ++ai)
#pragma unroll
          for (int mh = 0; mh < 2; ++mh) {
            f32x4 pre[2][2][2];
#pragma unroll
            for (int m2 = 0; m2 < 2; ++m2) { const size_t off = (size_t)(u.pm * BM + ai * HALF + wr * 64 + (2 * mh + m2) * 16 + fr) * 1024 + col0;
#pragma unroll
                for (int bj = 0; bj < 2; ++bj) {
                    if (BASE16) { const u32x4 w = __builtin_nontemporal_load((const u32x4*)((const bf16_t*)base + off + bj * HALF)); unpack8(w, pre[m2][bj][0], pre[m2][bj][1]); }
                    else { pre[m2][bj][0] = __builtin_nontemporal_load((const f32x4*)((const float*)base + off + bj * HALF)); pre[m2][bj][1] = __builtin_nontemporal_load((const f32x4*)((const float*)base + off + bj * HALF + 4)); }
                } }
            asm volatile("" ::: "memory");
#pragma unroll
            for (int m2 = 0; m2 < 2; ++m2) {
                const int m = 2 * mh + m2;
                const int row = u.pm * BM + ai * HALF + wr * 64 + m * 16 + fr;
                const size_t off = (size_t)row * 1024 + col0;
                float ss = 0.f;
#pragma unroll
                for (int bj = 0; bj < 2; ++bj) {
                    const f32x4 v0 = pre[m2][bj][0] + gv[bj][0] * acc[ai][bj][m][0];
                    const f32x4 v1 = pre[m2][bj][1] + gv[bj][1] * acc[ai][bj][m][1];
                    st16(XS + off + bj * HALF, pack8(v0, v1));
                    ss += ((v0[0] * v0[0] + v0[1] * v0[1]) + (v0[2] * v0[2] + v0[3] * v0[3])) + ((v1[0] * v1[0] + v1[1] * v1[1]) + (v1[2] * v1[2] + v1[3] * v1[3]));
                    st16(XB + off + bj * HALF, pack8(v0 * mv[bj][0], v1 * mv[bj][1]));
                }
                ss += __shfl_xor(ss, 16); ss += __shfl_xor(ss, 32);
                if (fq == 0) SSQ[(size_t)row * 16 + u.pn * 4 + wc] = ss;
            }
            asm volatile("" ::: "memory");
          }
    }
};
__device__ __forceinline__ float ssq_rstd(const float* SSQ, int row, int half) {
    const f32x4 a = *(const f32x4*)(SSQ + (size_t)row * 16 + half * 8), b = *(const f32x4*)(SSQ + (size_t)row * 16 + half * 8 + 4);
    float s = ((a[0] + a[1]) + (a[2] + a[3])) + ((b[0] + b[1]) + (b[2] + b[3]));
    s += __shfl_xor(s, 1);
    return rsqrtf(s * (1.0f / 1024.0f) + EPS);
}
struct EpiRelu2F { static constexpr bool PREP = true; bf16_t* O; int ldc; const float* BV; const float* SSQ;
    __device__ __forceinline__ void prep(const Unit& u, LAS unsigned char* lds, int slot, int tid) const {
        const float r = ssq_rstd(SSQ, u.pm * BM + (tid >> 1), tid & 1);
        LAS float* aux = (LAS float*)(lds + AUX_OFF) + slot * 512;
        if (!(tid & 1)) aux[tid >> 1] = r;
        if (tid < 256) aux[256 + tid] = BV[(size_t)(u.pm >> 4) * 4096 + u.pn * 256 + tid];
    }
    __device__ __forceinline__ void operator()(const Acc& acc, const Unit& u, int wr, int wc, int fr, int fq, LAS unsigned char* lds, int slot) const {
        const LAS float* rt = (const LAS float*)(lds + AUX_OFF) + slot * 512;
        const int col0 = u.pn * 256 + wc * 32 + 8 * fq;
        f32x4 bv[2][2];
#pragma unroll
        for (int bj = 0; bj < 2; ++bj)
#pragma unroll
            for (int n = 0; n < 2; ++n) bv[bj][n] = *(const LAS f32x4*)(rt + 256 + wc * 32 + 8 * fq + bj * HALF + 4 * n);
#pragma unroll
        for (int ai = 0; ai < 2; ++ai)
#pragma unroll
            for (int m = 0; m < 4; ++m) {
                const int rl = ai * HALF + wr * 64 + m * 16 + fr; const float rs = rt[rl];
                bf16_t* rowp = O + ((size_t)(u.pm * 64 + u.pn * 4 + (wc >> 1)) * 256 + rl) * 64 + (wc & 1) * 32 + 8 * fq;
#pragma unroll
                for (int bj = 0; bj < 2; ++bj) { f32x4 v0 = acc[ai][bj][m][0] * rs + bv[bj][0], v1 = acc[ai][bj][m][1] * rs + bv[bj][1];
#pragma unroll
                    for (int e = 0; e < 4; ++e) { const float a = fmaxf(v0[e], 0.f), c2 = fmaxf(v1[e], 0.f); v0[e] = a * a; v1[e] = c2 * c2; }
                    st16(rowp + bj * 2 * 256 * 64, pack8(v0, v1)); }
            }
    }
};
constexpr int NCOL = 2064;
struct EpiZ0F { static constexpr bool PREP = true; bf16_t* Z0; const float* BVF; const float* SSQ;
    __device__ __forceinline__ void prep(const Unit& u, LAS unsigned char* lds, int slot, int tid) const {
        const int nl = tid >> 1, tok = u.aux * 4096 + 64 * (nl & 63) + 4 * u.pn + (nl >> 6);
        const float r = ssq_rstd(SSQ, tok, tid & 1);
        LAS float* aux = (LAS float*)(lds + AUX_OFF) + slot * 512;
        if (!(tid & 1)) aux[nl] = r;
        if (tid < 256) aux[256 + tid] = BVF[(size_t)(u.aux * 4 + u.kind) * 256 + tid];
    }
    __device__ __forceinline__ void operator()(const Acc& acc, const Unit& u, int wr, int wc, int fr, int fq, LAS unsigned char* lds, int slot) const {
        const LAS float* rt = (const LAS float*)(lds + AUX_OFF) + slot * 512;
        const int t = u.pn, g = u.kind, b = u.aux;
        f32x4 rs[2][2];
#pragma unroll
        for (int bj = 0; bj < 2; ++bj)
#pragma unroll
            for (int n = 0; n < 2; ++n) rs[bj][n] = *(const LAS f32x4*)(rt + bj * HALF + wc * 32 + 8 * fq + 4 * n);
        const LAS float* bz = rt + 256 + wr * 64 + fr;
        bf16_t* p0 = Z0 + ((size_t)(((b * 4 + g) * 128 + wr * 64 + fr) * 64 + 4 * t + (wc >> 1))) * 128 + 32 * (wc & 1) + 8 * fq;
        bf16_t* ps = Z0 + ((size_t)((2048 + b * 4 + g) * 64 + 4 * t + (wc >> 1))) * 128 + 32 * (wc & 1) + 8 * fq;
#pragma unroll
        for (int ai = 0; ai < 2; ++ai)
#pragma unroll
            for (int m = 0; m < 4; ++m) {
                const float bb = bz[ai * HALF + m * 16];
                const bool nyq = (ai == 1 && m == 0) && (wr == 0) && (fr == 0);
#pragma unroll
                for (int bj = 0; bj < 2; ++bj) {
                    const u32x4 v = pack8(acc[ai][bj][m][0] * rs[bj][0] + bb, acc[ai][bj][m][1] * rs[bj][1] + bb);
                    const u32x4 z = {0u, 0u, 0u, 0u};
                    st16(p0 + (size_t)(m * 16) * 8192 + ai * 64 + bj * 256, nyq ? z : v);
                    if (ai == 1 && m == 0) { if (nyq) { st16(ps + bj * 256, v); st16(ps + bj * 256 + 64, z); } }
                }
                asm volatile("" ::: "memory");
            }
    }
};
}


#define XB_TMO      128
#define XB_XCNT(j)  (256  + 64 * (j))
#define XB_XSUB(j)  (1280 + 64 * (j))
#define XB_XGEN(j)  (2304 + 64 * (j))
#define XB_TOP      3328
#define XB_TOPGEN   3392
#define XCD_BAR_WORDS 3456
#define XB_SPIN_CAP (1u << 18)
__device__ __forceinline__ unsigned xb_ld(unsigned* p)              { return __hip_atomic_load(p, __ATOMIC_RELAXED, __HIP_MEMORY_SCOPE_AGENT); }
__device__ __forceinline__ unsigned xb_add(unsigned* p, unsigned v) { return __hip_atomic_fetch_add(p, v, __ATOMIC_RELAXED, __HIP_MEMORY_SCOPE_AGENT); }
__device__ __forceinline__ unsigned xb_xcc_id() { return (unsigned)__builtin_amdgcn_s_getreg((3 << 11) | 20) & 0xFu; }
#define XB_SPIN(cond, bar) do { unsigned _sp = 0; while (cond) { __builtin_amdgcn_s_sleep(1); \
    if ((++_sp & 255u) == 0u) { if (xb_ld(&(bar)[XB_TMO])) break; if (_sp > XB_SPIN_CAP) { atomicAdd(&(bar)[XB_TMO], 1u); break; } } } } while (0)
struct XcdBarrier { unsigned* bar; unsigned x; volatile LAS unsigned* st; };
__device__ __forceinline__ XcdBarrier xcd_barrier_post(unsigned* bar, volatile LAS unsigned* st) {
    XcdBarrier b; b.bar = bar; b.x = xb_xcc_id(); b.st = st;
    if (threadIdx.x == 0) (void)xb_add(&bar[XB_XCNT(b.x)], 1u);
    return b;
}
__device__ __forceinline__ void xcd_barrier_complete(unsigned* bar, unsigned x, unsigned& nloc, unsigned& nx) {
    const unsigned G = gridDim.x * gridDim.y * gridDim.z;
    unsigned sum, cnt, mine, sp = 0u;
    for (;;) {
        sum = 0u; cnt = 0u; mine = 0u;
#pragma unroll
        for (unsigned j = 0; j < 16; ++j) { const unsigned c = xb_ld(&bar[XB_XCNT(j)]); sum += c; cnt += (c > 0u) ? 1u : 0u; mine = (j == x) ? c : mine; }
        if (sum == G) break;
        __builtin_amdgcn_s_sleep(1);
        if ((++sp & 255u) == 0u) { if (xb_ld(&bar[XB_TMO])) break; if (sp > XB_SPIN_CAP) { atomicAdd(&bar[XB_TMO], 1u); break; } }
    }
    nloc = mine > 0u ? mine : 1u; nx = cnt > 0u ? cnt : 1u;
}
__device__ __forceinline__ void xcd_barrier(const XcdBarrier& b) {
    asm volatile("s_waitcnt vmcnt(0)" ::: "memory");
    __syncthreads();
    if (threadIdx.x == 0) {
        unsigned* bar = b.bar;
        __builtin_amdgcn_s_waitcnt(0);
        unsigned nloc = b.st[0], nx = b.st[1];
        if (nloc == 0u) { xcd_barrier_complete(bar, b.x, nloc, nx); b.st[0] = nloc; b.st[1] = nx; }
        const unsigned old = xb_add(&bar[XB_XSUB(b.x)], 1u);
        const unsigned gen = old / nloc;
        if (old + 1u == (gen + 1u) * nloc) {
            __builtin_amdgcn_fence(__ATOMIC_RELEASE, "agent");
            asm volatile("s_waitcnt vmcnt(0)" ::: "memory");
            const unsigned og = xb_add(&bar[XB_TOP], 1u);
            const unsigned tg = og / nx;
            if (og + 1u == (tg + 1u) * nx) xb_add(&bar[XB_TOPGEN], 1u);
            else XB_SPIN(xb_ld(&bar[XB_TOPGEN]) == tg, bar);
            __builtin_amdgcn_fence(__ATOMIC_ACQUIRE, "agent");
            xb_add(&bar[XB_XGEN(b.x)], 1u);
            asm volatile("s_waitcnt vmcnt(0)" ::: "memory");
        } else {
            XB_SPIN(xb_ld(&bar[XB_XGEN(b.x)]) == gen, bar);
            __builtin_amdgcn_fence(__ATOMIC_ACQUIRE, "agent");
            asm volatile("s_waitcnt vmcnt(0)" ::: "memory");
        }
    }
    __syncthreads();
}
__device__ __forceinline__ void p0_mods_unit(const float* c, const float* cctx, const float* ada_w, const float* ada_b, float* mods, LAS unsigned char* lds, int unit) {
    LAS float* s = (LAS float*)lds;
    LAS float* red = s + 5 * 1024;
    int tid = threadIdx.x; asm volatile("" : "+v"(tid));
    for (int i = tid; i < 5 * 1024; i += 512) { const int v = i >> 10, k = i & 1023; const float x = v < 4 ? c[v * 1024 + k] : cctx[k]; s[i] = x / (1.0f + __expf(-x)); }
    __syncthreads();
    const int l = unit / 96, col0 = (unit % 96) * 64, kc = tid >> 6, cl = tid & 63;
    const float* w = ada_w + (size_t)l * 1024 * 6144 + col0 + cl;
    float a0 = 0.f, a1 = 0.f, a2 = 0.f, a3 = 0.f, a4 = 0.f;
    for (int k = kc * 128; k < kc * 128 + 128; k += 32) {
        float wv[32];
#pragma unroll
        for (int j = 0; j < 32; ++j) wv[j] = __builtin_nontemporal_load(w + (size_t)(k + j) * 6144);
#pragma unroll
        for (int j = 0; j < 32; ++j) { a0 += s[k + j] * wv[j]; a1 += s[1024 + k + j] * wv[j]; a2 += s[2048 + k + j] * wv[j]; a3 += s[3072 + k + j] * wv[j]; a4 += s[4096 + k + j] * wv[j]; }
    }
    red[(kc * 5 + 0) * 64 + cl] = a0; red[(kc * 5 + 1) * 64 + cl] = a1; red[(kc * 5 + 2) * 64 + cl] = a2; red[(kc * 5 + 3) * 64 + cl] = a3; red[(kc * 5 + 4) * 64 + cl] = a4;
    __syncthreads();
    if (tid < 320) { const int v = tid >> 6, cc = tid & 63; float t = 0.f;
#pragma unroll
        for (int kk = 0; kk < 8; ++kk) t += red[(kk * 5 + v) * 64 + cc];
        mods[(size_t)(l * 5 + v) * 6144 + col0 + cc] = t + ada_b[l * 6144 + col0 + cc]; }
    __syncthreads();
}

__device__ __forceinline__ void p0_transpose_item(const float* W, int K, int N, bf16_t* WT, bf16_t* WT2, int mode, LAS float* scr, int item, int lane) {
    const int nblk = N / 32, kb = item / nblk, nb = item % nblk, k0 = 64 * kb, n0 = 32 * nb;
    float wv_[32];
#pragma unroll
    for (int i = 0; i < 32; ++i) { int srow = k0 + 2 * i + (lane >> 5);
        if (mode == 2) { const int j = srow & 255; if (j > 128) srow = (srow & ~255) + 256 - (j - 128); }
        wv_[i] = __builtin_nontemporal_load(W + (size_t)srow * N + n0 + (lane & 31)); }
#pragma unroll
    for (int i = 0; i < 32; ++i) scr[(2 * i + (lane >> 5)) * 33 + (lane & 31)] = wv_[i];
    asm volatile("s_waitcnt lgkmcnt(0)" ::: "memory");
    const int cch = lane & 7;
#pragma unroll
    for (int j = 0; j < 4; ++j) { const int n = (lane >> 3) + 8 * j; const LAS float* s = scr + (8 * cch) * 33 + n;
        u32x4 o; o.x = cvt_pk_bf16(s[0 * 33], s[1 * 33]); o.y = cvt_pk_bf16(s[2 * 33], s[3 * 33]); o.z = cvt_pk_bf16(s[4 * 33], s[5 * 33]); o.w = cvt_pk_bf16(s[6 * 33], s[7 * 33]);
        const int ng = n0 + n; bf16_t* dst;
        if (mode != 1) dst = WT + (size_t)ng * K;
        else if (ng < 2048) { const int pn = ng >> 8, hh = (ng >> 6) & 3, d = ng & 63; const int tpos = (d >> 5) * 128 + hh * 32 + (d & 31); dst = WT + (size_t)(pn * 256 + tpos) * K; }
        else dst = WT2 + (size_t)(ng - 2048) * K;
        *(u32x4*)(dst + k0 + 8 * cch) = o; }
    asm volatile("s_waitcnt lgkmcnt(0)" ::: "memory");
}

__device__ __forceinline__ float wave_sum(float v) {
#pragma unroll
    for (int o = 1; o < 64; o <<= 1) v += __shfl_xor(v, o);
    return v;
}
__device__ __forceinline__ void norm_rows(const float* xlat, const float* xctx, int nrows, const float* g, const float* modsl, int sh_off, int sc_off, bf16_t* H, int gw, int NGW, int lane) {
    f32x4 gv[4];
#pragma unroll
    for (int j = 0; j < 4; ++j) gv[j] = *(const f32x4*)(g + lane * 4 + 256 * j);
    for (int row = gw; row < nrows; row += NGW) {
        const float* src = row < ML ? xlat + (size_t)row * 1024 : xctx + (size_t)(row - ML) * 1024;
        const int v = row < ML ? (row >> 12) : 4;
        const float* mp = modsl + (size_t)v * 6144;
        f32x4 x[4]; float ss = 0.f;
#pragma unroll
        for (int j = 0; j < 4; ++j) { x[j] = __builtin_nontemporal_load((const f32x4*)(src + lane * 4 + 256 * j)); ss += (x[j][0] * x[j][0] + x[j][1] * x[j][1]) + (x[j][2] * x[j][2] + x[j][3] * x[j][3]); }
        const float rstd = rsqrtf(wave_sum(ss) * (1.0f / 1024.0f) + EPS);
#pragma unroll
        for (int j = 0; j < 4; ++j) {
            const f32x4 sh = *(const f32x4*)(mp + sh_off + lane * 4 + 256 * j), sc = *(const f32x4*)(mp + sc_off + lane * 4 + 256 * j);
            const f32x4 y = (x[j] * rstd * gv[j]) * (sc + 1.0f) + sh;
            u32x2 w; w.x = cvt_pk_bf16(y[0], y[1]); w.y = cvt_pk_bf16(y[2], y[3]);
            *(u32x2*)(H + (size_t)row * 1024 + lane * 4 + 256 * j) = w;
        }
    }
}


__device__ __forceinline__ void bias_items(const bf16_t* W1t, const bf16_t* CS, const float* mods, float* BV0, float* BV1, float* BVF, int w, int NW, int lane) {
    for (int it = w; it < 8192 + 1024; it += NW) {
        float a0 = 0.f, a1 = 0.f, a2 = 0.f, a3 = 0.f; float* dst; int dstride;
        if (it < 8192) {
            const int l = it >> 12, n = it & 4095;
            const bf16_t* wr_ = W1t + (size_t)l * 4096 * 1024 + (size_t)n * 1024 + lane * 16;
            const u32x4 w0 = *(const u32x4*)wr_, w1 = *(const u32x4*)(wr_ + 8);
            const float* sh = mods + (size_t)l * 5 * 6144 + 3072 + lane * 16;
            float wf[16];
#pragma unroll
            for (int e = 0; e < 4; ++e) { wf[2 * e] = __uint_as_float(w0[e] << 16); wf[2 * e + 1] = __uint_as_float(w0[e] & 0xffff0000u); wf[8 + 2 * e] = __uint_as_float(w1[e] << 16); wf[8 + 2 * e + 1] = __uint_as_float(w1[e] & 0xffff0000u); }
#pragma unroll
            for (int q = 0; q < 4; ++q) {
                const f32x4 s0 = *(const f32x4*)(sh + 4 * q), s1 = *(const f32x4*)(sh + 6144 + 4 * q), s2 = *(const f32x4*)(sh + 2 * 6144 + 4 * q), s3 = *(const f32x4*)(sh + 3 * 6144 + 4 * q);
#pragma unroll
                for (int e = 0; e < 4; ++e) { a0 += s0[e] * wf[4 * q + e]; a1 += s1[e] * wf[4 * q + e]; a2 += s2[e] * wf[4 * q + e]; a3 += s3[e] * wf[4 * q + e]; }
            }
            dst = (l == 0 ? BV0 : BV1) + n; dstride = 4096;
        } else {
            const int idx = it - 8192, g = idx >> 8, m = idx & 255;
            const u32x2 w0 = *(const u32x2*)(CS + (size_t)m * 256 + lane * 4);
            const float wf0 = __uint_as_float(w0[0] << 16), wf1 = __uint_as_float(w0[0] & 0xffff0000u), wf2 = __uint_as_float(w0[1] << 16), wf3 = __uint_as_float(w0[1] & 0xffff0000u);
            const float* sh = mods + (size_t)5 * 6144 + g * 256 + lane * 4;
            const f32x4 s0 = *(const f32x4*)(sh), s1 = *(const f32x4*)(sh + 6144), s2 = *(const f32x4*)(sh + 2 * 6144), s3 = *(const f32x4*)(sh + 3 * 6144);
            a0 = s0[0] * wf0 + s0[1] * wf1 + s0[2] * wf2 + s0[3] * wf3; a1 = s1[0] * wf0 + s1[1] * wf1 + s1[2] * wf2 + s1[3] * wf3;
            a2 = s2[0] * wf0 + s2[1] * wf1 + s2[2] * wf2 + s2[3] * wf3; a3 = s3[0] * wf0 + s3[1] * wf1 + s3[2] * wf2 + s3[3] * wf3;
            dst = BVF + g * 256 + m; dstride = 1024;
        }
        a0 = wave_sum(a0); a1 = wave_sum(a1); a2 = wave_sum(a2); a3 = wave_sum(a3);
        if (lane == 0) { dst[0] = a0; dst[dstride] = a1; dst[2 * dstride] = a2; dst[3 * dstride] = a3; }
    }
}
template <bool MASKED>
__device__ __forceinline__ void attn_block(const LAS bf16_t* Ks, const LAS bf16_t* Vs, int kcol0, int fr, int g, const bf16x8 (&Qf)[2], f32x4 (&acc)[4], float& lsum,
                                           const LAS unsigned char* rpb_base  , const int (&dcb)[8], const f32x4& ciX, const f32x4& ciY) {
    bf16x8 KX[2], KY[2];
#pragma unroll
    for (int kk = 0; kk < 2; ++kk) { KX[kk] = *(const LAS bf16x8*)(Ks + (kcol0 + fr) * 72 + kk * 32 + g * 8); KY[kk] = *(const LAS bf16x8*)(Ks + (kcol0 + 16 + fr) * 72 + kk * 32 + g * 8); }
    s16x4 VX[4], VY[4];
#pragma unroll
    for (int db = 0; db < 4; ++db) { VX[db] = *(const LAS s16x4*)(Vs + (16 * db + fr) * 72 + kcol0 + 4 * g); VY[db] = *(const LAS s16x4*)(Vs + (16 * db + fr) * 72 + kcol0 + 16 + 4 * g); }
    f32x4 sX = mfma16(KX[0], Qf[0], ciX); sX = mfma16(KX[1], Qf[1], sX);
    f32x4 sY = mfma16(KY[0], Qf[0], ciY); sY = mfma16(KY[1], Qf[1], sY);
    f32x4 pX, pY;
    if (MASKED) {
#pragma unroll
        for (int ii = 0; ii < 4; ++ii) {
            const float bx = *(const LAS float*)(rpb_base + dcb[ii]), by = *(const LAS float*)(rpb_base + dcb[4 + ii]);
            pX[ii] = __builtin_amdgcn_exp2f(sX[ii] + bx);
            pY[ii] = __builtin_amdgcn_exp2f(sY[ii] + by);
        }
    } else {
#pragma unroll
        for (int ii = 0; ii < 4; ++ii) { pX[ii] = __builtin_amdgcn_exp2f(sX[ii]); pY[ii] = __builtin_amdgcn_exp2f(sY[ii]); }
    }
    lsum += ((pX[0] + pX[1]) + (pX[2] + pX[3])) + ((pY[0] + pY[1]) + (pY[2] + pY[3]));
    const u32x4 pw = pg8::pack8(pX, pY);
    const bf16x8 Pf = __builtin_bit_cast(bf16x8, pw);
#pragma unroll
    for (int db = 0; db < 4; ++db) {
        bf16x8 Vf; Vf[0] = VX[db][0]; Vf[1] = VX[db][1]; Vf[2] = VX[db][2]; Vf[3] = VX[db][3]; Vf[4] = VY[db][0]; Vf[5] = VY[db][1]; Vf[6] = VY[db][2]; Vf[7] = VY[db][3];
        acc[db] = mfma16(Vf, Pf, acc[db]);
    }
}
__device__ __forceinline__ void attn_phase(const bf16_t* QK, const bf16_t* VT, bf16_t* O, const float* rpb, const float* sbound, LAS unsigned char* lds, int G, int c) {
    constexpr int RP_BYTES = 30720, TILE_B = 64 * 72 * 2, PAIR_B = 4 * TILE_B, NPAIR = 7;
    LAS float* rp = (LAS float*)lds;
    int tid = threadIdx.x; asm volatile("" : "+v"(tid));
    const int lane = tid & 63, wid = __builtin_amdgcn_readfirstlane(tid >> 6), fr = lane & 15, g = lane >> 4;
    for (int i = tid; i < 16 * 465; i += 512) rp[i] = rpb[i] * LOG2E;
    const float Mb = *sbound;
    const int nunits = (2048 - c + G - 1) / G;
    const int ND = nunits * NPAIR;
    const int trow = tid >> 3, tch = tid & 7;
    const int ldsoff = (trow * 72 + tch * 8) * 2;
#define ATT_DEC(L_, b_, h_, rp_) do { const int x_ = (L_) & 7, q_ = (L_) >> 3; rp_ = q_ & 31; const int bh_ = 8 * (q_ >> 5) + x_; b_ = bh_ >> 4; h_ = bh_ & 15; } while (0)
#define ATT_TOK(b_, rs0_, t_) ((t_) < 9 ? (b_) * 4096 + min((rs0_) + (t_), 63) * 64 : ML + (b_) * 256 + 64 * (min((t_), 12) - 9))
#define ATT_GLOAD(D_, R) do { const int u_ = (D_) / NPAIR, p_ = (D_) - u_ * NPAIR; int b_, h_, rp_; ATT_DEC(u_ * G + c, b_, h_, rp_); \
        const int rs0_ = min(max(2 * rp_ - 4, 0), 56); const int tk0_ = ATT_TOK(b_, rs0_, 2 * p_), tk1_ = ATT_TOK(b_, rs0_, 2 * p_ + 1); \
        const bf16_t* kb_ = QK + (size_t)trow * 2048 + 1024 + h_ * 64 + tch * 8; const bf16_t* vb_ = VT + (size_t)(h_ * 64 + trow) * MT + tch * 8; \
        R[0] = *(const u32x4*)(kb_ + (size_t)tk0_ * 2048); R[1] = *(const u32x4*)(vb_ + tk0_); R[2] = *(const u32x4*)(kb_ + (size_t)tk1_ * 2048); R[3] = *(const u32x4*)(vb_ + tk1_); } while (0)
#define ATT_LWRITE(slot_, R) do { _Pragma("unroll") for (int q_ = 0; q_ < 4; ++q_) *(LAS u32x4*)(lds + RP_BYTES + (slot_) * PAIR_B + q_ * TILE_B + ldsoff) = R[q_]; } while (0)
    u32x4 R0[4], R1[4];
    ATT_GLOAD(0, R0); ATT_LWRITE(0, R0);
    if (ND > 1) ATT_GLOAD(1, R1);
    if (ND > 2) ATT_GLOAD(2, R0);
    __syncthreads();
    int b = 0, h = 0, rpair = 0, r = 0, rs0 = 0, rsr = 0, qrow = 0;
    const int j = wid & 3, w0 = (j == 0) ? 0 : (j == 1) ? 8 : (j == 2) ? 24 : 32;
    int dcb[8]; f32x4 ciX, ciY, ciU;
    {
        const int cq = 16 * j + fr, cs = min(max(cq - 8, 0), 48), eX = w0 + 4 * g - cs, dX = w0 + 4 * g - cq + 15;
#pragma unroll
        for (int ii = 0; ii < 4; ++ii) {
            dcb[ii] = 4 * min(max(dX + ii, 0), 30); dcb[4 + ii] = 4 * min(max(dX + 16 + ii, 0), 30);
            ciX[ii] = ((unsigned)(eX + ii) < 16u) ? -Mb : -1.0e30f; ciY[ii] = ((unsigned)(eX + 16 + ii) < 16u) ? -Mb : -1.0e30f; ciU[ii] = -Mb;
        }
    }
    bf16x8 Qf[2], Qn[2]; f32x4 acc[4]; float lsum = 0.f;
    int p = 0, u = 0, D = 0;
#define ATT_QLOAD(dst, uu) do { int b_, h_, rp_; ATT_DEC((uu) * G + c, b_, h_, rp_); const int qr_ = b_ * 4096 + (2 * rp_ + (wid >> 2)) * 64 + 16 * j + fr; \
        _Pragma("unroll") for (int kk = 0; kk < 2; ++kk) dst[kk] = *(const bf16x8*)(QK + (size_t)qr_ * 2048 + h_ * 64 + 32 * kk + 8 * g); } while (0)
#define ATT_TILE(t_, toff_) do { \
        const LAS bf16_t* Ks = (const LAS bf16_t*)(lds + RP_BYTES + slot * PAIR_B + (toff_)); \
        const LAS bf16_t* Vs = (const LAS bf16_t*)(lds + RP_BYTES + slot * PAIR_B + (toff_) + TILE_B); \
        if ((t_) < 9) { \
            const int kr = rs0 + (t_), i = kr - rsr; \
            if (i >= 0 && i < 8) attn_block<true>(Ks, Vs, w0, fr, g, Qf, acc, lsum, (const LAS unsigned char*)rp + (h * 465 + (kr - r + 7) * 31) * 4, dcb, ciX, ciY); \
        } else if ((t_) < 13) { \
            attn_block<false>(Ks, Vs, 0, fr, g, Qf, acc, lsum, (const LAS unsigned char*)rp, dcb, ciU, ciU); \
            attn_block<false>(Ks, Vs, 32, fr, g, Qf, acc, lsum, (const LAS unsigned char*)rp, dcb, ciU, ciU); \
        } } while (0)
    ATT_QLOAD(Qn, 0);
#define ATT_ITER(R) do { \
        const int slot = D & 1; \
        if (D + 1 < ND) ATT_LWRITE(slot ^ 1, R); \
        if (D + 3 < ND) ATT_GLOAD(D + 3, R); \
        if (p == 0) { \
            ATT_DEC(u * G + c, b, h, rpair); \
            r = 2 * rpair + (wid >> 2); rs0 = min(max(2 * rpair - 4, 0), 56); rsr = min(max(r - 4, 0), 56); \
            qrow = b * 4096 + r * 64 + 16 * j + fr; \
            Qf[0] = Qn[0]; Qf[1] = Qn[1]; \
            _Pragma("unroll") for (int db = 0; db < 4; ++db) acc[db] = (f32x4){0.f, 0.f, 0.f, 0.f}; \
            lsum = 0.f; \
        } \
        if (p == 4 && u + 1 < nunits) ATT_QLOAD(Qn, u + 1); \
        { const int i0_ = rs0 + 2 * p - rsr, i1_ = i0_ + 1; \
          if (2 * p + 1 < 9 && i0_ >= 0 && i1_ < 8) {        \
            const LAS bf16_t* Ka = (const LAS bf16_t*)(lds + RP_BYTES + slot * PAIR_B); const LAS bf16_t* Va = (const LAS bf16_t*)(lds + RP_BYTES + slot * PAIR_B + TILE_B); \
            const LAS bf16_t* Kb = (const LAS bf16_t*)(lds + RP_BYTES + slot * PAIR_B + 2 * TILE_B); const LAS bf16_t* Vb = (const LAS bf16_t*)(lds + RP_BYTES + slot * PAIR_B + 3 * TILE_B); \
            const LAS unsigned char* rb_ = (const LAS unsigned char*)rp + (h * 465 + (rs0 + 2 * p - r + 7) * 31) * 4; \
            attn_block<true>(Ka, Va, w0, fr, g, Qf, acc, lsum, rb_, dcb, ciX, ciY); \
            attn_block<true>(Kb, Vb, w0, fr, g, Qf, acc, lsum, rb_ + 124, dcb, ciX, ciY); \
          } else { ATT_TILE(2 * p, 0); ATT_TILE(2 * p + 1, 2 * TILE_B); } } \
        if (p == NPAIR - 1) { \
            float ls = lsum; ls += __shfl_xor(ls, 16); ls += __shfl_xor(ls, 32); \
            const float inv = 1.0f / ls; \
            bf16_t* op = O + (size_t)qrow * 1024 + h * 64 + 4 * g; \
            _Pragma("unroll") for (int db = 0; db < 4; ++db) { u32x2 w; w.x = cvt_pk_bf16(acc[db][0] * inv, acc[db][1] * inv); w.y = cvt_pk_bf16(acc[db][2] * inv, acc[db][3] * inv); st8(op + 16 * db, w); } \
            p = 0; ++u; \
        } else ++p; \
        __syncthreads(); \
    } while (0)
    for (;;) {
        ATT_ITER(R1); if (++D >= ND) break;
        ATT_ITER(R0); if (++D >= ND) break;
    }
#undef ATT_ITER
#undef ATT_TILE
#undef ATT_QLOAD
#undef ATT_DEC
#undef ATT_TOK
#undef ATT_GLOAD
#undef ATT_LWRITE
}

__device__ __forceinline__ void s1_phase(const bf16_t* Z0, const bf16_t* Dg, bf16_t* Z1, LAS unsigned char* lds, int gw, int NGW) {
    constexpr int DP = 136;
    LAS bf16_t* Dl = (LAS bf16_t*)lds;
    int tid = threadIdx.x; asm volatile("" : "+v"(tid));
    const int lane = tid & 63, fr = lane & 15, g = lane >> 4;
    for (int i = tid; i < 128 * 16; i += 512) { const int row = i >> 4, ch = i & 15; *(LAS u32x4*)(Dl + row * DP + ch * 8) = *(const u32x4*)(Dg + row * 128 + ch * 8); }
    __syncthreads();
    for (int job = gw; job < 2048 + 64; job += NGW) {
        const bool part = job >= 2048;
        const int colM = part ? 2048 + ((job - 2048) >> 2) : job, ib0 = part ? ((job - 2048) & 3) : 0, nib = part ? 1 : 4;
        bf16x8 A[4][4];
#pragma unroll
        for (int ib = 0; ib < 4; ++ib) { const int ibr = part ? ib0 : ib;
#pragma unroll
            for (int kb = 0; kb < 4; ++kb) A[ib][kb] = *(const bf16x8*)(Z0 + ((size_t)colM * 64 + 16 * ibr + fr) * 128 + 32 * kb + 8 * g); }
#pragma unroll 2
        for (int jb = 0; jb < 8; ++jb) {
            bf16x8 Bf[4];
#pragma unroll
            for (int kb = 0; kb < 4; ++kb) Bf[kb] = *(const LAS bf16x8*)(Dl + (16 * jb + fr) * DP + 32 * kb + 8 * g);
            const int n = 16 * jb + fr, ka = n >> 1, rip = n & 1;
#pragma unroll
            for (int ib = 0; ib < 4; ++ib) {
                if (ib < nib) {
                    f32x4 a = (f32x4){0.f, 0.f, 0.f, 0.f};
#pragma unroll
                    for (int kb = 0; kb < 4; ++kb) a = mfma16(A[ib][kb], Bf[kb], a);
                    u32x2 w; w.x = cvt_pk_bf16(a[0], a[1]); w.y = cvt_pk_bf16(a[2], a[3]);
                    st8(Z1 + (((size_t)ka * pg8::NCOL + colM) * 2 + rip) * 64 + 16 * (part ? ib0 : ib) + 4 * g, w);
                }
            }
        }
    }
    __syncthreads();
}
__device__ __forceinline__ void s2_phase(const bf16_t* Z1, const bf16_t* Eg, bf16_t* F, int gw, int NGW, int lane) {
    const int fr = lane & 15, g = lane >> 4;
    for (int it = gw; it < 2048 + 64; it += NGW) {
        const bool special = it >= 2048;
        const int ka = special ? it - 2048 : (it & 63), q = it >> 6, bg = q >> 1, ib0 = special ? 0 : 4 * (q & 1), nib = special ? 1 : 4;
        bf16x8 Bf[4][4];
#pragma unroll
        for (int jb = 0; jb < 4; ++jb)
#pragma unroll
            for (int kb = 0; kb < 4; ++kb) Bf[jb][kb] = *(const bf16x8*)(Eg + ((size_t)ka * 64 + 16 * jb + fr) * 128 + 32 * kb + 8 * g);
        for (int ibb = 0; ibb < nib; ++ibb) {
            const int ib = ib0 + ibb;
            const int colM0 = special ? 2048 : bg * 128 + ib * 16;
            bf16x8 A[4];
#pragma unroll
            for (int kb = 0; kb < 4; ++kb) A[kb] = *(const bf16x8*)(Z1 + ((size_t)ka * pg8::NCOL + colM0 + fr) * 128 + 32 * kb + 8 * g);
            const int k2 = ib * 16 + 4 * g, b = bg >> 2, gg = bg & 3;
#pragma unroll
            for (int jb = 0; jb < 4; ++jb) {
                f32x4 a = (f32x4){0.f, 0.f, 0.f, 0.f};
#pragma unroll
                for (int kb = 0; kb < 4; ++kb) a = mfma16(A[kb], Bf[jb][kb], a);
                const int k = ka + 64 * (16 * jb + fr), km = (4096 - k) & 4095;
                u32x2 w; w.x = cvt_pk_bf16(a[0], a[1]); w.y = cvt_pk_bf16(a[2], a[3]);
                if (!special) {
                    st8(F + ((size_t)b * 4096 + k) * 1024 + gg * 256 + k2, w);
                    bf16_t* pm_ = F + ((size_t)b * 4096 + km) * 1024 + gg * 256 + 128 + k2;
                    if (k2 != 0) st8(pm_, w);
                    else { pm_[1] = (bf16_t)(w.x >> 16); *(unsigned*)(pm_ + 2) = w.y; }
                } else {
                    bf16_t* ps_ = F + ((size_t)g * 4096 + k) * 1024 + 128;
                    ps_[0] = (bf16_t)(w.x & 0xffffu); ps_[256] = (bf16_t)(w.x >> 16); ps_[512] = (bf16_t)(w.y & 0xffffu); ps_[768] = (bf16_t)(w.y >> 16);
                }
            }
        }
    }
}


#ifndef MK_DEBUG
#define MK_DEBUG 0
#endif
__device__ __forceinline__ void dbg_scan16(const bf16_t* p, size_t n, unsigned* flags, unsigned bit, int gt, int NT) {
    bool bad = false; for (size_t i = gt; i < n; i += NT) bad |= ((p[i] & 0x7f80u) == 0x7f80u);
    if (bad) atomicOr(flags, 1u << bit);
}
__device__ __forceinline__ void dbg_scan32(const float* p, size_t n, unsigned* flags, unsigned bit, int gt, int NT) {
    bool bad = false; for (size_t i = gt; i < n; i += NT) bad |= ((__float_as_uint(p[i]) & 0x7f800000u) == 0x7f800000u);
    if (bad) atomicOr(flags, 1u << bit);
}
struct Args { const float* in[15]; float* out; unsigned char* ws; int ph_lo, ph_hi, use_cg, pad; };
static_assert(sizeof(Args) == 15 * 8 + 8 + 8 + 16, "no padding");

__global__ void __launch_bounds__(512, 2) fwd_kernel(Args args) {
    extern __shared__ __attribute__((aligned(16))) unsigned char lds_raw[];
    LAS unsigned char* lds = (LAS unsigned char*)lds_raw;
    const int G = gridDim.x, c = blockIdx.x;
    const int vcu = (G % 8 == 0) ? (c % 8) * (G / 8) + c / 8 : c;
    const int NGW = G * 8;
#define PHASE_IDS int tid_ = threadIdx.x; asm volatile("" : "+v"(tid_)); const int lane = tid_ & 63, wid = __builtin_amdgcn_readfirstlane(tid_ >> 6); const int gw = vcu * 8 + wid; (void)lane; (void)gw
    unsigned char* ws = args.ws;
    const float* x = args.in[0]; const float* cvec = args.in[1]; const float* ctx = args.in[2]; const float* cctx = args.in[3];
    const float* ada_w = args.in[4]; const float* ada_b = args.in[5]; const float* norm_g = args.in[6];
    const float* wqkv = args.in[7]; const float* wo = args.in[8]; const float* gq = args.in[9]; const float* gk = args.in[10]; const float* rpb = args.in[11];
    const float* fw = args.in[12]; const float* w1 = args.in[13]; const float* w2 = args.in[14];
    float* out = args.out;
    float* mods = (float*)(ws + WS_MODS); float* sbound = (float*)(ws + WS_SB);
    bf16_t* CS = (bf16_t*)(ws + WS_CS); bf16_t* Dt = (bf16_t*)(ws + WS_D); bf16_t* Et = (bf16_t*)(ws + WS_E);
    bf16_t* WQK = (bf16_t*)(ws + WS_WQK); bf16_t* WV = (bf16_t*)(ws + WS_WV); bf16_t* WO = (bf16_t*)(ws + WS_WO); bf16_t* FWt = (bf16_t*)(ws + WS_FW);
    bf16_t* W1t = (bf16_t*)(ws + WS_W1); bf16_t* W2t = (bf16_t*)(ws + WS_W2);
    bf16_t* H = (bf16_t*)(ws + WS_H); bf16_t* QK = (bf16_t*)(ws + WS_QK); bf16_t* VT = (bf16_t*)(ws + WS_VT); bf16_t* O = (bf16_t*)(ws + WS_O);
    bf16_t* XS = (bf16_t*)(ws + WS_XS); bf16_t* HMID = (bf16_t*)(ws + WS_HMID); bf16_t* Z0 = (bf16_t*)(ws + WS_Z0); bf16_t* Z1 = (bf16_t*)(ws + WS_Z1); bf16_t* Fb = (bf16_t*)(ws + WS_F);
    float* SSQ = (float*)(ws + WS_SSQ); float* BV0 = (float*)(ws + WS_BV); float* BV1 = BV0 + 4 * 4096; float* BVF = BV1 + 4 * 4096; float* GM = BVF + 16 * 512;
    const int lo = args.ph_lo, hi = args.ph_hi;
    cg::grid_group grid = cg::this_grid();
#define IN(k) (lo <= (k) && (k) < hi)
#ifndef REP_SYNC
#define REP_SYNC 1
#endif
#ifndef REP_NORM
#define REP_NORM 1
#endif
#ifndef REP_S12
#define REP_S12 1
#endif
#ifndef REP_P0
#define REP_P0 1
#endif
#ifndef USE_XB
#define USE_XB 1
#endif
#define SEAM(k) do { if (IN(k) && IN((k) + 1)) { for (int r_ = 0; r_ < REP_SYNC; ++r_) { if (use_cg) grid.sync(); else xcd_barrier(xbar); } } } while (0)
    { volatile LAS unsigned* st_ = (volatile LAS unsigned*)(lds + LDS_BYTES - 64); if (threadIdx.x < 2) st_[threadIdx.x] = 0u; __syncthreads(); }
    XcdBarrier xbar; xbar.bar = (unsigned*)(ws + WS_BAR); xbar.x = 0; xbar.st = (volatile LAS unsigned*)(lds + LDS_BYTES - 64);
    const bool use_cg = (args.use_cg != 0);
    if (!use_cg && hi - lo > 1) xbar = xcd_barrier_post((unsigned*)(ws + WS_BAR), (volatile LAS unsigned*)(lds + LDS_BYTES - 64));

    unsigned* dflags = (unsigned*)(ws + WS_SB + 256);
#define DBG16(k, bit, p, n) do { if (MK_DEBUG && IN(k)) { int t_ = threadIdx.x; asm volatile("" : "+v"(t_)); dbg_scan16(p, n, dflags, bit, (vcu * 512) + t_, G * 512); } } while (0)
#define DBG32(k, bit, p, n) do { if (MK_DEBUG && IN(k)) { int t_ = threadIdx.x; asm volatile("" : "+v"(t_)); dbg_scan32(p, n, dflags, bit, (vcu * 512) + t_, G * 512); } } while (0)
    if (IN(0)) {
        PHASE_IDS;
        if (MK_DEBUG && c == 0 && tid_ == 0) *dflags = 0u;
        for (int r0_ = 0; r0_ < REP_P0; ++r0_) {
        for (int u = c; u < 192; u += G) p0_mods_unit(cvec, cctx, ada_w, ada_b, mods, lds, u);
        __syncthreads();
        {
            LAS float* scr = (LAS float*)(lds + wid * 16384);
            constexpr int I_QKV = 16 * 96, I_SQ = 16 * 32, I_1 = 16 * 128, I_2 = 64 * 32;
            constexpr int NITEMS = I_QKV + I_SQ + 2 * I_1;
            for (int it = NITEMS - 1 - gw; it >= 0; it -= NGW) {
                int r = it;
                if (r < I_QKV) { p0_transpose_item(wqkv, 1024, 3072, WQK, WV, 1, scr, r, lane); continue; } r -= I_QKV;
                if (r < I_SQ) { p0_transpose_item(wo, 1024, 1024, WO, nullptr, 0, scr, r, lane); continue; } r -= I_SQ;
                { const int l = r / I_1; p0_transpose_item(w1 + (size_t)l * 1024 * 4096, 1024, 4096, W1t + (size_t)l * 4096 * 1024, nullptr, 0, scr, r % I_1, lane); }
            }
        }
        {
            const int gt = gw * 64 + lane, NT = NGW * 64;
            for (int i = gt; i < 256 * 256; i += NT) { const int m = i >> 8, cc = i & 255, ri = m >> 7, k2 = m & 127; float sn, cs; sincospif(2.0f * (float)((cc * k2) & 255) / 256.0f, &sn, &cs);
                float v = (ri == 0 ? cs : -sn) * (1.0f / 16.0f); if (m == 128) v = (cc & 1) ? -(1.0f / 16.0f) : (1.0f / 16.0f);
                CS[i] = (bf16_t)(cvt_pk_bf16(v, 0.f) & 0xffffu); }
            for (int i = gt; i < 128 * 128; i += NT) { const int n = i >> 7, kp = i & 127, ka = n >> 1, rip = n & 1, ri = kp >> 6, a = kp & 63; float sn, cs; sincospif(2.0f * (float)((a * ka) & 63) / 64.0f, &sn, &cs);
                const float v = (rip == 0 ? (ri == 0 ? cs : sn) : (ri == 0 ? -sn : cs)) * 0.125f; Dt[i] = (bf16_t)(cvt_pk_bf16(v, 0.f) & 0xffffu); }
            for (int i = gt; i < 64 * 64 * 128; i += NT) { const int kp = i & 127, kbk = (i >> 7) & 63, ka = i >> 13, rip = kp >> 6, bp = kp & 63; float sn, cs; sincospif(2.0f * (float)((bp * (ka + 64 * kbk)) & 4095) / 4096.0f, &sn, &cs);
                const float v = (rip == 0 ? cs : sn) * 0.125f; Et[i] = (bf16_t)(cvt_pk_bf16(v, 0.f) & 0xffffu); }
        }
        if (c == G - 1 && wid == 7) {
            float mq = fabsf(gq[lane]), mk = fabsf(gk[lane]), mr = 0.f;
            for (int i = lane; i < 16 * 465; i += 64) mr = fmaxf(mr, fabsf(rpb[i]));
#pragma unroll
            for (int o = 1; o < 64; o <<= 1) { mq = fmaxf(mq, __shfl_xor(mq, o)); mk = fmaxf(mk, __shfl_xor(mk, o)); mr = fmaxf(mr, __shfl_xor(mr, o)); }
            if (lane == 0) *sbound = (8.0f * mq * mk + mr) * LOG2E;
        }
        __syncthreads();
        }
    }
    SEAM(0);
    const bool ctx_in_p1 = false;
    if (IN(1)) { PHASE_IDS;
        if (c == G - 1) {
            for (int i = tid_; i < 3 * 4096; i += 512) { const int idx = i >> 12, b = (i >> 10) & 3, col = i & 1023;
                const float gg = norm_g[(idx == 0 ? 1024 : idx == 1 ? 2048 : 3072) + col];
                const float sc = mods[(size_t)((idx == 0 ? 0 : 5) + b) * 6144 + (idx == 1 ? 1024 : 4096) + col];
                GM[i] = gg * (1.0f + sc); }
        }
        if (!ctx_in_p1) norm_rows(x, ctx, MT, norm_g, mods, 0, 1024, H, gw, NGW, lane);
        else if (c >= 32) norm_rows(x, ctx, ML, norm_g, mods, 0, 1024, H, (c - 32) * 8 + wid, (G - 32) * 8, lane);
        else {
            pg8::SchedOne S1u; const size_t ts = (size_t)256 * 1024 * 2; int tt;
            if (c < 16) { S1u.u.kind = 0; S1u.u.pm = 64 + (c & 3); S1u.u.pn = 4 + (c >> 2); tt = c & 3; S1u.u.a = (const char*)H + (size_t)S1u.u.pm * ts; S1u.u.b = (const char*)WQK + (size_t)S1u.u.pn * ts; }
            else { const int l2 = c - 16; S1u.u.kind = 1; S1u.u.pm = l2 & 3; S1u.u.pn = 64 + (l2 >> 2); tt = l2 >> 2; S1u.u.a = (const char*)WV + (size_t)S1u.u.pm * ts; S1u.u.b = (const char*)H + (size_t)S1u.u.pn * ts; }
            S1u.u.aux = 0;
            norm_rows(x, ctx, ML + tt * 256 + 256, norm_g, mods, 0, 1024, H, ML + tt * 256 + wid, 8, lane);
            asm volatile("s_waitcnt vmcnt(0)" ::: "memory"); __syncthreads();
            pg8::EpiQKV E{QK, VT, gq, gk};
            pg8::gemm_phase<pg8::EpiQKV, pg8::SchedOne, false>(lds, 1024, 1024, 1024, S1u, E);
        }
    }
    SEAM(1);
    DBG16(2, 0, H, (size_t)MT * 1024);
    if (IN(2)) { pg8::SchedQKV S{(const char*)H, (const char*)WQK, (const char*)WV, G, c, ctx_in_p1 ? 768 : 800}; pg8::EpiQKV E{QK, VT, gq, gk};
#ifndef REP_G2
#define REP_G2 1
#endif
        for (int r_ = 0; r_ < REP_G2; ++r_) pg8::gemm_phase<pg8::EpiQKV, pg8::SchedQKV, false>(lds, 1024, 1024, 1024, S, E);
        { PHASE_IDS;
          const bool part = (G > 32); const int w_ = part ? (c - 32) * 8 + wid : gw, nw_ = part ? (G - 32) * 8 : NGW;
          if (!part || c >= 32) {
              bias_items(W1t, CS, mods, BV0, BV1, BVF, w_, nw_, lane);
              LAS float* scr = (LAS float*)(lds + wid * 16384);
              constexpr int I_SQ = 16 * 32, I_2 = 64 * 32;
              for (int it = w_; it < I_SQ + 2 * I_2; it += nw_) {
                  if (it < I_SQ) p0_transpose_item(fw, 1024, 1024, FWt, nullptr, 2, scr, it, lane);
                  else { const int r2 = it - I_SQ, l = r2 / I_2; p0_transpose_item(w2 + (size_t)l * 4096 * 1024, 4096, 1024, W2t + (size_t)l * 1024 * 4096, nullptr, 0, scr, r2 % I_2, lane); }
              }
          } } }
    SEAM(2);
    DBG16(3, 1, QK, (size_t)ML * 2048); DBG16(3, 2, VT, (size_t)1024 * MT); DBG32(3, 13, mods, (size_t)10 * 6144);
#ifndef REP_ATT
#define REP_ATT 1
#endif
    if (IN(3)) { for (int rep = 0; rep < REP_ATT; ++rep) attn_phase(QK, VT, O, rpb, sbound, lds, G, c); }
    SEAM(3);
    DBG16(4, 3, O, (size_t)ML * 1024);
    if (IN(4)) { pg8::SchedStd S; S.init(O, WO, ML, 1024, 1024, 1024, G, c); pg8::EpiResF<false> E{x, XS, mods + 2048, GM, H, SSQ};
        pg8::gemm_phase<pg8::EpiResF<false>, pg8::SchedStd, false>(lds, 1024, 1024, 1024, S, E); }
    SEAM(4);
    DBG32(5, 4, out, (size_t)ML * 1024);
    if (IN(6)) { pg8::SchedStd S; S.init(H, W1t, ML, 4096, 1024, 1024, G, c); pg8::EpiRelu2F E{HMID, 4096, BV0, SSQ};
        pg8::gemm_phase<pg8::EpiRelu2F, pg8::SchedStd, false>(lds, 1024, 1024, 1024, S, E); }
    SEAM(6);
    DBG16(7, 5, HMID, (size_t)ML * 4096);
    if (IN(7)) { pg8::SchedStd S; S.init(HMID, W2t, ML, 1024, 64, 4096, G, c, (size_t)64 * 32768); pg8::EpiResF<true> E{XS, XS, mods + 5120, GM + 4096, H, SSQ};
        pg8::gemm_phase<pg8::EpiResF<true>, pg8::SchedStd, false>(lds, 4096, 64, 4096, S, E, 32768, 128); }
    SEAM(7);
    const float* mods1 = mods + 5 * 6144;
    DBG32(8, 6, out, (size_t)ML * 1024);
    if (IN(9)) { pg8::SchedF1 S{(const char*)CS, (const char*)H, G, c}; pg8::EpiZ0F E{Z0, BVF, SSQ};
        pg8::gemm_phase<pg8::EpiZ0F, pg8::SchedF1, true>(lds, 256, 256, 1024, S, E); }
    SEAM(9);
    DBG16(10, 7, Z0, (size_t)262144 * 128);
    if (IN(10)) { PHASE_IDS; for (int r_ = 0; r_ < REP_S12; ++r_) s1_phase(Z0, Dt, Z1, lds, gw, NGW); }
    SEAM(10);
    DBG16(11, 8, Z1, (size_t)262144 * 128);
    if (IN(11)) { PHASE_IDS; for (int r_ = 0; r_ < REP_S12; ++r_) s2_phase(Z1, Et, Fb, gw, NGW, lane); }
    SEAM(11);
    DBG16(12, 9, Fb, (size_t)ML * 1024);
    if (IN(12)) { pg8::SchedStd S; S.init(Fb, FWt, ML, 1024, 1024, 1024, G, c); pg8::EpiResF<true> E{XS, XS, mods1 + 2048, GM + 8192, H, SSQ};
        pg8::gemm_phase<pg8::EpiResF<true>, pg8::SchedStd, false>(lds, 1024, 1024, 1024, S, E); }
    SEAM(12);
    DBG32(13, 10, out, (size_t)ML * 1024);
    if (IN(14)) { pg8::SchedStd S; S.init(H, W1t + (size_t)4096 * 1024, ML, 4096, 1024, 1024, G, c); pg8::EpiRelu2F E{HMID, 4096, BV1, SSQ};
        pg8::gemm_phase<pg8::EpiRelu2F, pg8::SchedStd, false>(lds, 1024, 1024, 1024, S, E); }
    SEAM(14);
    DBG16(15, 11, HMID, (size_t)ML * 4096);
    if (IN(15)) { pg8::SchedStd S; S.init(HMID, W2t + (size_t)1024 * 4096, ML, 1024, 64, 4096, G, c, (size_t)64 * 32768); pg8::EpiRes E{XS, out, mods1 + 5120};
        pg8::gemm_phase<pg8::EpiRes, pg8::SchedStd, false>(lds, 4096, 64, 4096, S, E, 32768, 128); }
    SEAM(15);
    if (MK_DEBUG && IN(16)) {
        int t_ = threadIdx.x; asm volatile("" : "+v"(t_));
        bool bad = false;
        for (size_t i = (size_t)vcu * 512 + t_; i < (size_t)ML * 1024; i += (size_t)G * 512) { if ((__float_as_uint(out[i]) & 0x7f800000u) == 0x7f800000u) { bad = true; out[i] = 0.f; } }
        if (bad) atomicOr(dflags, 1u << 12);
    }
    SEAM(16);
    if (MK_DEBUG && IN(17)) {
        if (c == 0 && threadIdx.x == 0) { const unsigned f = *dflags; if (f) out[0] = 1.0e6f * (float)(__builtin_ctz(f) + 1) + 1.0e4f * (float)__builtin_popcount(f); }
    }
#undef IN
#undef SEAM
}

constexpr int NPHASE = MK_DEBUG ? 18 : 16;
#ifndef MK_USE_CG
#define MK_USE_CG 0
#endif
#ifndef MK_PER_PHASE
#define MK_PER_PHASE 0
#endif

extern "C" void kernel_launch(void* const* d_in, const int* in_sizes, int n_in, void* d_out, int out_size, void* d_ws, size_t ws_size, hipStream_t stream) {
    static int grid = 0;
    if (grid == 0) {
        if (n_in != 15 || out_size != ML * DM || ws_size < WS_END) { fprintf(stderr, "kernel_launch: unexpected shapes (n_in %d out %d ws %zu)\n", n_in, out_size, ws_size); grid = -1; return; }
        int dev = 0, cus = 0, per_cu = 0;
        hipGetDevice(&dev); hipDeviceGetAttribute(&cus, hipDeviceAttributeMultiprocessorCount, dev);
        hipFuncSetAttribute((const void*)fwd_kernel, hipFuncAttributeMaxDynamicSharedMemorySize, LDS_BYTES);
        if (hipOccupancyMaxActiveBlocksPerMultiprocessor(&per_cu, (const void*)fwd_kernel, 512, LDS_BYTES) != hipSuccess || per_cu < 1) { fprintf(stderr, "kernel_launch: occupancy query failed (%d)\n", per_cu); (void)hipGetLastError(); per_cu = 1; }
        grid = cus * 1;
        if (grid <= 0) grid = 256;
    }
    if (grid < 0) return;
    if (hipMemsetAsync((char*)d_ws + WS_BAR, 0, BAR_BYTES, stream) != hipSuccess) { fprintf(stderr, "kernel_launch: memset failed\n"); return; }
    Args a{};
    for (int i = 0; i < 15; ++i) a.in[i] = (const float*)d_in[i];
    a.out = (float*)d_out; a.ws = (unsigned char*)d_ws;
#if MK_PER_PHASE
    for (int p = 0; p < NPHASE; ++p) { a.ph_lo = p; a.ph_hi = p + 1; hipLaunchKernelGGL(fwd_kernel, dim3(grid), dim3(512), LDS_BYTES, stream, a); }
#else
    a.ph_lo = 0; a.ph_hi = NPHASE; a.use_cg = MK_USE_CG;
    void* kargs[] = {&a};
    hipError_t e = hipLaunchCooperativeKernel((const void*)fwd_kernel, dim3(grid), dim3(512), kargs, LDS_BYTES, stream);
    if (e != hipSuccess) fprintf(stderr, "cooperative launch failed: %s (grid %d)\n", hipGetErrorString(e), grid);
#endif
}
```

```cpp
#include <hip/hip_runtime.h>
#include <hip/hip_cooperative_groups.h>
#include <cstdio>
#include <cstdint>
namespace cg = cooperative_groups;

#define LAS __attribute__((address_space(3)))
typedef unsigned short bf16_t;
typedef short bf16x8 __attribute__((ext_vector_type(8)));
typedef short s16x4 __attribute__((ext_vector_type(4)));
typedef float f32x4 __attribute__((ext_vector_type(4)));
typedef unsigned u32x4 __attribute__((ext_vector_type(4)));
typedef unsigned u32x2 __attribute__((ext_vector_type(2)));

constexpr int DM = 1024, NB = 4, SEQ = 4096, CTXL = 256, FF = 4096;
constexpr int ML = NB * SEQ;
constexpr int MT = ML + NB * CTXL;
constexpr float LOG2E = 1.4426950408889634f;
constexpr float EPS = 1e-6f;

constexpr size_t MiB = 1u << 20;
constexpr size_t WS_MODS = 0;
constexpr size_t WS_SB = 512 * 1024;
constexpr size_t WS_BAR = 1 * MiB;
constexpr size_t BAR_BYTES = 16384;
constexpr size_t WS_CS = 2 * MiB;
constexpr size_t WS_D = 2 * MiB + 512 * 1024;
constexpr size_t WS_E = 3 * MiB;
constexpr size_t WS_WQK = 4 * MiB, WS_WV = 8 * MiB, WS_WO = 10 * MiB, WS_FW = 12 * MiB;
constexpr size_t WS_W1 = 14 * MiB;
constexpr size_t WS_W2 = 30 * MiB;
constexpr size_t WS_SSQ = 46 * MiB;
constexpr size_t WS_BV = 47 * MiB;
constexpr size_t WS_H = 48 * MiB;
constexpr size_t WS_R = 82 * MiB;
constexpr size_t WS_QK = WS_R;
constexpr size_t WS_VT = WS_R + 68 * MiB;
constexpr size_t WS_O = WS_R + 102 * MiB;
constexpr size_t WS_HMID = WS_R;
constexpr size_t WS_Z0 = WS_R;
constexpr size_t WS_Z1 = WS_R + 64 * MiB;
constexpr size_t WS_F = WS_R;
constexpr size_t WS_XS = WS_R + 134 * MiB;
constexpr size_t WS_END = 256 * MiB;
static_assert(WS_XS + 32 * MiB <= WS_END && WS_O + 32 * MiB <= WS_XS && WS_F + 32 * MiB <= WS_END && WS_HMID + 128 * MiB <= WS_END && WS_O + 32 * MiB <= WS_END, "ws map");

constexpr int LDS_BYTES = 147456;

typedef __bf16 bf16v2_t __attribute__((ext_vector_type(2)));
typedef float f32v2_t __attribute__((ext_vector_type(2)));
__device__ __forceinline__ unsigned cvt_pk_bf16(float lo, float hi) { const f32v2_t v = {lo, hi}; const bf16v2_t r = __builtin_convertvector(v, bf16v2_t); return __builtin_bit_cast(unsigned, r); }
__device__ __forceinline__ f32x4 mfma16(bf16x8 a, bf16x8 b, f32x4 c) { return __builtin_amdgcn_mfma_f32_16x16x32_bf16(a, b, c, 0, 0, 0); }


#ifndef MK_WT
#define MK_WT 0
#endif
__device__ __forceinline__ void st16(void* p, u32x4 v) {
#if MK_WT
    asm volatile("global_store_dwordx4 %0, %1, off sc1\n\ts_nop 1" :: "v"(p), "v"(v) : "memory");
#else
    *(u32x4*)p = v;
#endif
}
__device__ __forceinline__ void st16f(void* p, f32x4 v) {
#if MK_WT
    asm volatile("global_store_dwordx4 %0, %1, off sc1\n\ts_nop 1" :: "v"(p), "v"(v) : "memory");
#else
    *(f32x4*)p = v;
#endif
}
__device__ __forceinline__ void st8(void* p, u32x2 v) {
#if MK_WT
    asm volatile("global_store_dwordx2 %0, %1, off sc1\n\ts_nop 1" :: "v"(p), "v"(v) : "memory");
#else
    *(u32x2*)p = v;
#endif
}
namespace pg8 {
constexpr int BM = 256, BK = 64, HALF = 128, HTB = HALF * BK * 2, STAGE_BYTES = 8 * HTB;
__device__ __forceinline__ int lds_byte(int r, int c) { const int st = (r >> 4) * 2 + (c >> 5), rr = r & 15, cc = c & 31, ob = rr * 64 + cc * 2; return st * 1024 + (ob ^ (((ob >> 9) & 1) << 5)); }
__device__ __forceinline__ void stage_rc(int b, int& R, int& C) { const int st = b / 1024, sb = b % 1024, swz = sb ^ (((sb >> 9) & 1) << 5); R = (st >> 1) * 16 + swz / 64; C = (st & 1) * 32 + (swz % 64) / 2; }
__device__ __forceinline__ int perm32(int rho) { const int n = rho >> 4, i = rho & 15; return 8 * (i >> 2) + 4 * n + (i & 3); }

struct Unit { int pm, pn, kind, aux; const char* a; const char* b; };

template <class Epi, class Sched, bool BMAP>
__device__ __forceinline__ void gemm_phase(LAS unsigned char* lds, const int K, const int lda, const int ldb, const Sched& S, const Epi& E, const size_t kstepA = 128, const size_t kstepB = 128) {
    int tid = threadIdx.x; asm volatile("" : "+v"(tid));
    const int wid = __builtin_amdgcn_readfirstlane(tid >> 6), lane = tid & 63, wr = wid >> 2, wc = wid & 3, fr = lane & 15, fq = lane >> 4;
    int nt = K / BK; asm volatile("" : "+s"(nt));
    unsigned voffA[2], voffB[2];
#pragma unroll
    for (int i = 0; i < 2; ++i) { int R, C; stage_rc(tid * 16 + i * 8192, R, C); const int Rb = (R & ~31) + perm32(R & 31);
        voffA[i] = (unsigned)(R * lda + C) * 2u;
        voffB[i] = BMAP ? (unsigned)((64 * (Rb & 63) + (Rb >> 6)) * ldb + C) * 2u : (unsigned)(Rb * ldb + C) * 2u; }
    const size_t hstepA = (size_t)HALF * lda * 2;
    const size_t hstepB = BMAP ? (size_t)2 * ldb * 2 : (size_t)HALF * ldb * 2;
    const unsigned ldsw = (unsigned)wid * 1024u;
    const int aoff = lds_byte(wr * 64 + fr, fq * 8), boff = lds_byte(wc * 32 + fr, fq * 8);
#define PG8_SA(b, h) (((b) * 2 + (h)) * HTB)
#define PG8_SB(b, h) ((4 + (b) * 2 + (h)) * HTB)
#define PG8_STAGE(bufoff, gbase, voff) do { _Pragma("unroll") for (int _i = 0; _i < 2; ++_i) \
        __builtin_amdgcn_global_load_lds((const unsigned*)((const char*)(gbase) + (voff)[_i]), (LAS unsigned*)(lds + (bufoff) + ldsw + _i * 8192), 16, 0, 0); } while (0)
#define PG8_LDA(dst, b, h) do { _Pragma("unroll") for (int m = 0; m < 4; ++m) _Pragma("unroll") for (int k = 0; k < 2; ++k) dst[m][k] = *(const LAS bf16x8*)(lds + PG8_SA(b, h) + aoff + m * 2048 + k * 1024); } while (0)
#define PG8_LDB(dst, b, h) do { _Pragma("unroll") for (int n = 0; n < 2; ++n) _Pragma("unroll") for (int k = 0; k < 2; ++k) dst[n][k] = *(const LAS bf16x8*)(lds + PG8_SB(b, h) + boff + n * 2048 + k * 1024); } while (0)
#define PG8_MMA(ai, bj, At, Bt) do { __builtin_amdgcn_s_setprio(1); _Pragma("unroll") for (int m = 0; m < 4; ++m) _Pragma("unroll") for (int n = 0; n < 2; ++n) _Pragma("unroll") for (int k = 0; k < 2; ++k) \
        acc[ai][bj][m][n] = __builtin_amdgcn_mfma_f32_16x16x32_bf16(Bt[n][k], At[m][k], acc[ai][bj][m][n], 0, 0, 0); __builtin_amdgcn_s_setprio(0); } while (0)
#define PG8_WAIT_V(n) asm volatile("s_waitcnt vmcnt(" #n ")" ::: "memory")
#define PG8_WAIT_L(n) asm volatile("s_waitcnt lgkmcnt(" #n ")" ::: "memory")
#define PG8_BAR __builtin_amdgcn_s_barrier()
#define PG8_SCHED __builtin_amdgcn_sched_barrier(0)
    Unit cur, nxt; int ui = 0;
    if (!S.next(0, cur)) return;
    f32x4 acc[2][2][4][2];
#pragma unroll
    for (int a = 0; a < 2; ++a)
#pragma unroll
        for (int b = 0; b < 2; ++b)
#pragma unroll
            for (int m = 0; m < 4; ++m)
#pragma unroll
                for (int n = 0; n < 2; ++n) acc[a][b][m][n] = (f32x4){0.f, 0.f, 0.f, 0.f};
    bf16x8 At[4][2], B0[2][2], B1[2][2];
    const char* cA = cur.a; const char* cB = cur.b;
    if constexpr (Epi::PREP) E.prep(cur, lds, 0, tid);
    PG8_STAGE(PG8_SB(0, 0), cB, voffB); PG8_STAGE(PG8_SB(0, 1), cB + hstepB, voffB); PG8_STAGE(PG8_SA(0, 0), cA, voffA); PG8_STAGE(PG8_SA(0, 1), cA + hstepA, voffA);
    if (wr == 1) PG8_BAR;
    PG8_WAIT_V(2); PG8_BAR;
    PG8_STAGE(PG8_SB(1, 0), cB + kstepB, voffB); PG8_STAGE(PG8_SA(1, 0), cA + kstepA, voffA); PG8_STAGE(PG8_SB(1, 1), cB + hstepB + kstepB, voffB);
    PG8_WAIT_V(6); PG8_BAR;
    for (;;) {
        const bool has_next = S.next(ui + 1, nxt);
        const char* nA = has_next ? nxt.a : cA; const char* nB = has_next ? nxt.b : cB;
        for (int t = 0; t < nt; t += 2) {
            const bool last = (t == nt - 2);
            const char* a1 = cA + (size_t)(t + 1) * kstepA;
            const char* a2 = last ? nA : cA + (size_t)(t + 2) * kstepA; const char* b2 = last ? nB : cB + (size_t)(t + 2) * kstepB;
            const char* a3 = a2 + kstepA; const char* b3 = b2 + kstepB;
            PG8_LDB(B0, 0, 0); PG8_LDB(B1, 0, 1); PG8_SCHED; PG8_LDA(At, 0, 0); PG8_STAGE(PG8_SA(1, 1), a1 + hstepA, voffA);
            PG8_WAIT_V(8); PG8_WAIT_L(0); PG8_BAR; PG8_MMA(0, 0, At, B0); PG8_MMA(0, 1, At, B1); PG8_BAR; PG8_SCHED;
            PG8_LDA(At, 0, 1); PG8_STAGE(PG8_SB(0, 0), b2, voffB); PG8_STAGE(PG8_SB(0, 1), b2 + hstepB, voffB); PG8_STAGE(PG8_SA(0, 0), a2, voffA);
            PG8_WAIT_V(8); PG8_WAIT_L(0); PG8_BAR; PG8_MMA(1, 0, At, B0); PG8_MMA(1, 1, At, B1); PG8_BAR; PG8_SCHED;
            PG8_LDB(B0, 1, 0); PG8_LDB(B1, 1, 1); PG8_SCHED; PG8_LDA(At, 1, 0); PG8_STAGE(PG8_SA(0, 1), a2 + hstepA, voffA);
            PG8_WAIT_V(8); PG8_WAIT_L(0); PG8_BAR; PG8_MMA(0, 0, At, B0); PG8_MMA(0, 1, At, B1); PG8_BAR; PG8_SCHED;
            PG8_LDA(At, 1, 1); PG8_STAGE(PG8_SB(1, 0), b3, voffB); PG8_STAGE(PG8_SB(1, 1), b3 + hstepB, voffB); PG8_STAGE(PG8_SA(1, 0), a3, voffA);
            PG8_WAIT_V(8); PG8_WAIT_L(0); PG8_BAR; PG8_MMA(1, 0, At, B0); PG8_MMA(1, 1, At, B1); PG8_BAR; PG8_SCHED;
        }
        if (wr == 0) PG8_BAR;
        if constexpr (Epi::PREP) { if (has_next) E.prep(nxt, lds, (ui + 1) & 1, tid); }
        E(acc, cur, wr, wc, fr, fq, lds, ui & 1);
        if (!has_next) break;
#pragma unroll
        for (int a = 0; a < 2; ++a)
#pragma unroll
            for (int b = 0; b < 2; ++b)
#pragma unroll
                for (int m = 0; m < 4; ++m)
#pragma unroll
                    for (int n = 0; n < 2; ++n) acc[a][b][m][n] = (f32x4){0.f, 0.f, 0.f, 0.f};
        cur = nxt; cA = nA; cB = nB; ++ui;
        if (wr == 1) PG8_BAR;
    }
    PG8_WAIT_V(0);
    PG8_BAR;
#undef PG8_SA
#undef PG8_SB
#undef PG8_STAGE
#undef PG8_LDA
#undef PG8_LDB
#undef PG8_MMA
#undef PG8_WAIT_V
#undef PG8_WAIT_L
#undef PG8_BAR
#undef PG8_SCHED
}

struct SchedStd {
    const char* A; const char* Bt; size_t tsA, tsB; int nM, nN, nwg, G, c;
    __device__ void init(const void* A_, const void* Bt_, int M, int N, int lda, int ldb, int G_, int c_, size_t tsA_ = 0) { A = (const char*)A_; Bt = (const char*)Bt_; tsA = tsA_ ? tsA_ : (size_t)BM * lda * 2; tsB = (size_t)BM * ldb * 2; nM = M / BM; nN = N / BM; nwg = nM * nN; G = G_; c = c_; }
    __device__ bool next(int i, Unit& u) const {
        const long L = (long)i * G + c; if (L >= nwg) return false;
        int wgid = (int)L; { const int q = nwg / 8, r = nwg % 8, xcd = wgid % 8, off = wgid / 8; wgid = (xcd < r ? xcd * (q + 1) : r * (q + 1) + (xcd - r) * q) + off; }
        const int nig = 8 * nN, gid = wgid / nig, fm = gid * 8, gsz = (nM - fm) < 8 ? (nM - fm) : 8;
        u.pm = fm + ((wgid % nig) % gsz); u.pn = (wgid % nig) / gsz; u.kind = 0; u.aux = 0;
        u.a = A + (size_t)u.pm * tsA; u.b = Bt + (size_t)u.pn * tsB; return true;
    }
};
struct SchedQKV {
    const char* H; const char* Wqk; const char* Wv; int G, c, nunits;
    __device__ bool next(int i, Unit& u) const {
        const long Ll = (long)i * G + c; if (Ll >= nunits) return false;
        const int L = (int)Ll; const size_t ts = (size_t)BM * 1024 * 2; u.aux = 0;
        if (L < 512) { const int x = L & 7, off = L >> 3; u.kind = 0; u.pm = 8 * x + (off & 7); u.pn = off >> 3; }
        else if (L < 768) { const int l2 = L - 512, x = l2 & 7, off = l2 >> 3; u.kind = 1; u.pm = off & 3; u.pn = 8 * x + (off >> 2); }
        else if (L < 784) { const int l2 = L - 768; u.kind = 0; u.pm = 64 + (l2 & 3); u.pn = 4 + (l2 >> 2); }
        else { const int l2 = L - 784; u.kind = 1; u.pm = l2 & 3; u.pn = 64 + (l2 >> 2); }
        if (u.kind == 0) { u.a = H + (size_t)u.pm * ts; u.b = Wqk + (size_t)u.pn * ts; }
        else { u.a = Wv + (size_t)u.pm * ts; u.b = H + (size_t)u.pn * ts; }
        return true;
    }
};
struct SchedOne { Unit u;
    __device__ __forceinline__ bool next(int i, Unit& o) const { if (i > 0) return false; o = u; return true; }
};
struct SchedF1 {
    const char* CS; const char* H; int G, c;
    __device__ bool next(int i, Unit& u) const {
        const long Ll = (long)i * G + c; if (Ll >= 256) return false;
        const int L = (int)Ll; const int t = L & 15, b = (L >> 4) & 3, g = (L >> 6) & 3;
        u.pm = 0; u.pn = t; u.kind = g; u.aux = b;
        u.a = CS; u.b = H + ((size_t)(b * 4096 + 4 * t) * 1024 + g * 256) * 2; return true;
    }
};

typedef f32x4 Acc[2][2][4][2];
__device__ __forceinline__ u32x4 pack8(f32x4 v0, f32x4 v1) { u32x4 w; w.x = cvt_pk_bf16(v0[0], v0[1]); w.y = cvt_pk_bf16(v0[2], v0[3]); w.z = cvt_pk_bf16(v1[0], v1[1]); w.w = cvt_pk_bf16(v1[2], v1[3]); return w; }

__device__ __forceinline__ void unpack8(u32x4 w, f32x4& v0, f32x4& v1) {
    v0[0] = __uint_as_float(w.x << 16); v0[1] = __uint_as_float(w.x & 0xffff0000u); v0[2] = __uint_as_float(w.y << 16); v0[3] = __uint_as_float(w.y & 0xffff0000u);
    v1[0] = __uint_as_float(w.z << 16); v1[1] = __uint_as_float(w.z & 0xffff0000u); v1[2] = __uint_as_float(w.w << 16); v1[3] = __uint_as_float(w.w & 0xffff0000u);
}
struct EpiQKV { static constexpr bool PREP = true; bf16_t* QK; bf16_t* VT; const float* gq; const float* gk;
    __device__ __forceinline__ void prep(const Unit& u, LAS unsigned char* lds, int slot, int tid) const {
        if (u.kind == 0 && tid < 64) { const bool isq = u.pn < 4; ((LAS float*)(lds + 131072))[slot * 512 + tid] = isq ? gq[tid] * (0.125f * LOG2E) : gk[tid]; }
    }
    __device__ __forceinline__ void operator()(const Acc& acc, const Unit& u, int wr, int wc, int fr, int fq, LAS unsigned char* lds, int slot) const {
        if (u.kind == 0) {
            const LAS float* gp = (const LAS float*)(lds + 131072) + slot * 512;
            f32x4 gv[2][2];
#pragma unroll
            for (int bj = 0; bj < 2; ++bj)
#pragma unroll
                for (int n = 0; n < 2; ++n) gv[bj][n] = *(const LAS f32x4*)(gp + 32 * bj + 8 * fq + 4 * n);
#pragma unroll
            for (int ai = 0; ai < 2; ++ai)
#pragma unroll
                for (int m = 0; m < 4; ++m) {
                    const int row = u.pm * BM + ai * HALF + wr * 64 + m * 16 + fr;
                    float ss = 0.f;
#pragma unroll
                    for (int bj = 0; bj < 2; ++bj)
#pragma unroll
                        for (int n = 0; n < 2; ++n) { const f32x4 x = acc[ai][bj][m][n]; ss += (x[0] * x[0] + x[1] * x[1]) + (x[2] * x[2] + x[3] * x[3]); }
                    ss += __shfl_xor(ss, 16); ss += __shfl_xor(ss, 32);
                    const float rstd = rsqrtf(ss * (1.0f / 64.0f) + EPS);
                    bf16_t* rowp = QK + (size_t)row * 2048 + u.pn * 256 + wc * 64 + 8 * fq;
#pragma unroll
                    for (int bj = 0; bj < 2; ++bj) st16(rowp + 32 * bj, pack8(acc[ai][bj][m][0] * rstd * gv[bj][0], acc[ai][bj][m][1] * rstd * gv[bj][1]));
                }
        } else {
#pragma unroll
            for (int ai = 0; ai < 2; ++ai)
#pragma unroll
                for (int m = 0; m < 4; ++m) {
                    const int row = u.pm * BM + ai * HALF + wr * 64 + m * 16 + fr;
                    bf16_t* rowp = VT + (size_t)row * MT + u.pn * 256 + wc * 32 + 8 * fq;
#pragma unroll
                    for (int bj = 0; bj < 2; ++bj) st16(rowp + bj * HALF, pack8(acc[ai][bj][m][0], acc[ai][bj][m][1]));
                }
        }
    }
};
struct EpiRelu2 { static constexpr bool PREP = false; bf16_t* O; int ldc;
    __device__ __forceinline__ void operator()(const Acc& acc, const Unit& u, int wr, int wc, int fr, int fq, LAS unsigned char*, int) const {
#pragma unroll
        for (int ai = 0; ai < 2; ++ai)
#pragma unroll
            for (int m = 0; m < 4; ++m) {
                const int row = u.pm * BM + ai * HALF + wr * 64 + m * 16 + fr;
                bf16_t* rowp = O + (size_t)row * ldc + u.pn * 256 + wc * 32 + 8 * fq;
#pragma unroll
                for (int bj = 0; bj < 2; ++bj) { f32x4 v0 = acc[ai][bj][m][0], v1 = acc[ai][bj][m][1];
#pragma unroll
                    for (int e = 0; e < 4; ++e) { const float a = fmaxf(v0[e], 0.f), b = fmaxf(v1[e], 0.f); v0[e] = a * a; v1[e] = b * b; }
                    *(u32x4*)(rowp + bj * HALF) = pack8(v0, v1); }
            }
    }
};
struct EpiRes { static constexpr bool PREP = false; const bf16_t* base; float* out; const float* gate;
    __device__ __forceinline__ void operator()(const Acc& acc, const Unit& u, int wr, int wc, int fr, int fq, LAS unsigned char*, int) const {
        const int col0 = u.pn * 256 + wc * 32 + 8 * fq;
        const float* gp = gate + (size_t)(u.pm >> 4) * 6144 + col0;
        f32x4 gv[2][2];
#pragma unroll
        for (int bj = 0; bj < 2; ++bj)
#pragma unroll
            for (int n = 0; n < 2; ++n) gv[bj][n] = *(const f32x4*)(gp + bj * HALF + 4 * n);
#pragma unroll
        for (int ai = 0; ai < 2; ++ai)
#pragma unroll
          for (int mh = 0; mh < 2; ++mh) {
            u32x4 pre[2][2];
#pragma unroll
            for (int m2 = 0; m2 < 2; ++m2)
#pragma unroll
                for (int bj = 0; bj < 2; ++bj) pre[m2][bj] = __builtin_nontemporal_load((const u32x4*)(base + (size_t)(u.pm * BM + ai * HALF + wr * 64 + (2 * mh + m2) * 16 + fr) * 1024 + col0 + bj * HALF));
            asm volatile("" ::: "memory");
#pragma unroll
            for (int m2 = 0; m2 < 2; ++m2) { const int m = 2 * mh + m2;
                const size_t off = (size_t)(u.pm * BM + ai * HALF + wr * 64 + m * 16 + fr) * 1024 + col0;
#pragma unroll
                for (int bj = 0; bj < 2; ++bj) { f32x4 b0, b1; unpack8(pre[m2][bj], b0, b1);
                    *(f32x4*)(out + off + bj * HALF) = b0 + gv[bj][0] * acc[ai][bj][m][0]; *(f32x4*)(out + off + bj * HALF + 4) = b1 + gv[bj][1] * acc[ai][bj][m][1]; }
            }
            asm volatile("" ::: "memory");
          }
    }
};
struct EpiZ0 { static constexpr bool PREP = false; bf16_t* Z0;
    __device__ __forceinline__ void operator()(const Acc& acc, const Unit& u, int wr, int wc, int fr, int fq, LAS unsigned char*, int) const {
        const int ri = u.pm, t = u.pn, g = u.kind, b = u.aux;
        bf16_t* p0 = Z0 + ((size_t)(((b * 4 + g) * 256 + wr * 64 + fr) * 64 + 4 * t + (wc >> 1))) * 128 + ri * 64 + 32 * (wc & 1) + 8 * fq;
#pragma unroll
        for (int ai = 0; ai < 2; ++ai)
#pragma unroll
            for (int m = 0; m < 4; ++m) {
#pragma unroll
                for (int bj = 0; bj < 2; ++bj)
                    *(u32x4*)(p0 + (size_t)(ai * HALF + m * 16) * 8192 + bj * 256) = pack8(acc[ai][bj][m][0], acc[ai][bj][m][1]);
                asm volatile("" ::: "memory");
            }
    }
};

constexpr int AUX_OFF = 131072;
template <bool BASE16>
struct EpiResF { static constexpr bool PREP = false; const void* base; bf16_t* XS; const float* gate; const float* gm; bf16_t* XB; float* SSQ;
    __device__ __forceinline__ void operator()(const Acc& acc, const Unit& u, int wr, int wc, int fr, int fq, LAS unsigned char*, int) const {
        const int col0 = u.pn * 256 + wc * 32 + 8 * fq, b = u.pm >> 4;
        f32x4 gv[2][2], mv[2][2];
#pragma unroll
        for (int bj = 0; bj < 2; ++bj)
#pragma unroll
            for (int n = 0; n < 2; ++n) { gv[bj][n] = *(const f32x4*)(gate + (size_t)b * 6144 + col0 + bj * HALF + 4 * n); mv[bj][n] = *(const f32x4*)(gm + b * 1024 + col0 + bj * HALF + 4 * n); }
#pragma unroll
        for (int ai = 0; ai < 2; ++ai)
#pragma unroll
          for (int mh = 0; mh < 2; ++mh) {
            f32x4 pre[2][2][2];
#pragma unroll
            for (int m2 = 0; m2 < 2; ++m2) { const size_t off = (size_t)(u.pm * BM + ai * HALF + wr * 64 + (2 * mh + m2) * 16 + fr) * 1024 + col0;
#pragma unroll
                for (int bj = 0; bj < 2; ++bj) {
                    if (BASE16) { const u32x4 w = __builtin_nontemporal_load((const u32x4*)((const bf16_t*)base + off + bj * HALF)); unpack8(w, pre[m2][bj][0], pre[m2][bj][1]); }
                    else { pre[m2][bj][0] = __builtin_nontemporal_load((const f32x4*)((const float*)base + off + bj * HALF)); pre[m2][bj][1] = __builtin_nontemporal_load((const f32x4*)((const float*)base + off + bj * HALF + 4)); }
                } }
            asm volatile("" ::: "memory");
#pragma unroll
            for (int m2 = 0; m2 < 2; ++m2) {
                const int m = 2 * mh + m2;
                const int row = u.pm * BM + ai * HALF + wr * 64 + m * 16 + fr;
                const size_t off = (size_t)row * 1024 + col0;
                float ss = 0.f;
#pragma unroll
                for (int bj = 0; bj < 2; ++bj) {
                    const f32x4 v0 = pre[m2][bj][0] + gv[bj][0] * acc[ai][bj][m][0];
                    const f32x4 v1 = pre[m2][bj][1] + gv[bj][1] * acc[ai][bj][m][1];
                    st16(XS + off + bj * HALF, pack8(v0, v1));
                    ss += ((v0[0] * v0[0] + v0[1] * v0[1]) + (v0[2] * v0[2] + v0[3] * v0[3])) + ((v1[0] * v1[0] + v1[1] * v1[1]) + (v1[2] * v1[2] + v1[3] * v1[3]));
                    st16(XB + off + bj * HALF, pack8(v0 * mv[bj][0], v1 * mv[bj][1]));
                }
                ss += __shfl_xor(ss, 16); ss += __shfl_xor(ss, 32);
                if (fq == 0) SSQ[(size_t)row * 16 + u.pn * 4 + wc] = ss;
            }
            asm volatile("" ::: "memory");
          }
    }
};
__device__ __forceinline__ float ssq_rstd(const float* SSQ, int row, int half) {
    const f32x4 a = *(const f32x4*)(SSQ + (size_t)row * 16 + half * 8), b = *(const f32x4*)(SSQ + (size_t)row * 16 + half * 8 + 4);
    float s = ((a[0] + a[1]) + (a[2] + a[3])) + ((b[0] + b[1]) + (b[2] + b[3]));
    s += __shfl_xor(s, 1);
    return rsqrtf(s * (1.0f / 1024.0f) + EPS);
}
struct EpiRelu2F { static constexpr bool PREP = true; bf16_t* O; int ldc; const float* BV; const float* SSQ;
    __device__ __forceinline__ void prep(const Unit& u, LAS unsigned char* lds, int slot, int tid) const {
        const float r = ssq_rstd(SSQ, u.pm * BM + (tid >> 1), tid & 1);
        LAS float* aux = (LAS float*)(lds + AUX_OFF) + slot * 512;
        if (!(tid & 1)) aux[tid >> 1] = r;
        if (tid < 256) aux[256 + tid] = BV[(size_t)(u.pm >> 4) * 4096 + u.pn * 256 + tid];
    }
    __device__ __forceinline__ void operator()(const Acc& acc, const Unit& u, int wr, int wc, int fr, int fq, LAS unsigned char* lds, int slot) const {
        const LAS float* rt = (const LAS float*)(lds + AUX_OFF) + slot * 512;
        const int col0 = u.pn * 256 + wc * 32 + 8 * fq;
        f32x4 bv[2][2];
#pragma unroll
        for (int bj = 0; bj < 2; ++bj)
#pragma unroll
            for (int n = 0; n < 2; ++n) bv[bj][n] = *(const LAS f32x4*)(rt + 256 + wc * 32 + 8 * fq + bj * HALF + 4 * n);
#pragma unroll
        for (int ai = 0; ai < 2; ++ai)
#pragma unroll
            for (int m = 0; m < 4; ++m) {
                const int rl = ai * HALF + wr * 64 + m * 16 + fr; const float rs = rt[rl];
                bf16_t* rowp = O + ((size_t)(u.pm * 64 + u.pn * 4 + (wc >> 1)) * 256 + rl) * 64 + (wc & 1) * 32 + 8 * fq;
#pragma unroll
                for (int bj = 0; bj < 2; ++bj) { f32x4 v0 = acc[ai][bj][m][0] * rs + bv[bj][0], v1 = acc[ai][bj][m][1] * rs + bv[bj][1];
#pragma unroll
                    for (int e = 0; e < 4; ++e) { const float a = fmaxf(v0[e], 0.f), c2 = fmaxf(v1[e], 0.f); v0[e] = a * a; v1[e] = c2 * c2; }
                    st16(rowp + bj * 2 * 256 * 64, pack8(v0, v1)); }
            }
    }
};
constexpr int NCOL = 2064;
struct EpiZ0F { static constexpr bool PREP = true; bf16_t* Z0; const float* BVF; const float* SSQ;
    __device__ __forceinline__ void prep(const Unit& u, LAS unsigned char* lds, int slot, int tid) const {
        const int nl = tid >> 1, tok = u.aux * 4096 + 64 * (nl & 63) + 4 * u.pn + (nl >> 6);
        const float r = ssq_rstd(SSQ, tok, tid & 1);
        LAS float* aux = (LAS float*)(lds + AUX_OFF) + slot * 512;
        if (!(tid & 1)) aux[nl] = r;
        if (tid < 256) aux[256 + tid] = BVF[(size_t)(u.aux * 4 + u.kind) * 256 + tid];
    }
    __device__ __forceinline__ void operator()(const Acc& acc, const Unit& u, int wr, int wc, int fr, int fq, LAS unsigned char* lds, int slot) const {
        const LAS float* rt = (const LAS float*)(lds + AUX_OFF) + slot * 512;
        const int t = u.pn, g = u.kind, b = u.aux;
        f32x4 rs[2][2];
#pragma unroll
        for (int bj = 0; bj < 2; ++bj)
#pragma unroll
            for (int n = 0; n < 2; ++n) rs[bj][n] = *(const LAS f32x4*)(rt + bj * HALF + wc * 32 + 8 * fq + 4 * n);
        const LAS float* bz = rt + 256 + wr * 64 + fr;
        bf16_t* p0 = Z0 + ((size_t)(((b * 4 + g) * 128 + wr * 64 + fr) * 64 + 4 * t + (wc >> 1))) * 128 + 32 * (wc & 1) + 8 * fq;
        bf16_t* ps = Z0 + ((size_t)((2048 + b * 4 + g) * 64 + 4 * t + (wc >> 1))) * 128 + 32 * (wc & 1) + 8 * fq;
#pragma unroll
        for (int ai = 0; ai < 2; ++ai)
#pragma unroll
            for (int m = 0; m < 4; ++m) {
                const float bb = bz[ai * HALF + m * 16];
                const bool nyq = (ai == 1 && m == 0) && (wr == 0) && (fr == 0);
#pragma unroll
                for (int bj = 0; bj < 2; ++bj) {
                    const u32x4 v = pack8(acc[ai][bj][m][0] * rs[bj][0] + bb, acc[ai][bj][m][1] * rs[bj][1] + bb);
                    const u32x4 z = {0u, 0u, 0u, 0u};
                    st16(p0 + (size_t)(m * 16) * 8192 + ai * 64 + bj * 256, nyq ? z : v);
                    if (ai == 1 && m == 0) { if (nyq) { st16(ps + bj * 256, v); st16(ps + bj * 256 + 64, z); } }
                }
                asm volatile("" ::: "memory");
            }
    }
};
}


#define XB_TMO      128
#define XB_XCNT(j)  (256  + 64 * (j))
#define XB_XSUB(j)  (1280 + 64 * (j))
#define XB_XGEN(j)  (2304 + 64 * (j))
#define XB_TOP      3328
#define XB_TOPGEN   3392
#define XCD_BAR_WORDS 3456
#define XB_SPIN_CAP (1u << 18)
__device__ __forceinline__ unsigned xb_ld(unsigned* p)              { return __hip_atomic_load(p, __ATOMIC_RELAXED, __HIP_MEMORY_SCOPE_AGENT); }
__device__ __forceinline__ unsigned xb_add(unsigned* p, unsigned v) { return __hip_atomic_fetch_add(p, v, __ATOMIC_RELAXED, __HIP_MEMORY_SCOPE_AGENT); }
__device__ __forceinline__ unsigned xb_xcc_id() { return (unsigned)__builtin_amdgcn_s_getreg((3 << 11) | 20) & 0xFu; }
#define XB_SPIN(cond, bar) do { unsigned _sp = 0; while (cond) { __builtin_amdgcn_s_sleep(1); \
    if ((++_sp & 255u) == 0u) { if (xb_ld(&(bar)[XB_TMO])) break; if (_sp > XB_SPIN_CAP) { atomicAdd(&(bar)[XB_TMO], 1u); break; } } } } while (0)
struct XcdBarrier { unsigned* bar; unsigned x; volatile LAS unsigned* st; };
__device__ __forceinline__ XcdBarrier xcd_barrier_post(unsigned* bar, volatile LAS unsigned* st) {
    XcdBarrier b; b.bar = bar; b.x = xb_xcc_id(); b.st = st;
    if (threadIdx.x == 0) (void)xb_add(&bar[XB_XCNT(b.x)], 1u);
    return b;
}
__device__ __forceinline__ void xcd_barrier_complete(unsigned* bar, unsigned x, unsigned& nloc, unsigned& nx) {
    const unsigned G = gridDim.x * gridDim.y * gridDim.z;
    unsigned sum, cnt, mine, sp = 0u;
    for (;;) {
        sum = 0u; cnt = 0u; mine = 0u;
#pragma unroll
        for (unsigned j = 0; j < 16; ++j) { const unsigned c = xb_ld(&bar[XB_XCNT(j)]); sum += c; cnt += (c > 0u) ? 1u : 0u; mine = (j == x) ? c : mine; }
        if (sum == G) break;
        __builtin_amdgcn_s_sleep(1);
        if ((++sp & 255u) == 0u) { if (xb_ld(&bar[XB_TMO])) break; if (sp > XB_SPIN_CAP) { atomicAdd(&bar[XB_TMO], 1u); break; } }
    }
    nloc = mine > 0u ? mine : 1u; nx = cnt > 0u ? cnt : 1u;
}
__device__ __forceinline__ void xcd_barrier(const XcdBarrier& b) {
    asm volatile("s_waitcnt vmcnt(0)" ::: "memory");
    __syncthreads();
    if (threadIdx.x == 0) {
        unsigned* bar = b.bar;
        __builtin_amdgcn_s_waitcnt(0);
        unsigned nloc = b.st[0], nx = b.st[1];
        if (nloc == 0u) { xcd_barrier_complete(bar, b.x, nloc, nx); b.st[0] = nloc; b.st[1] = nx; }
        const unsigned old = xb_add(&bar[XB_XSUB(b.x)], 1u);
        const unsigned gen = old / nloc;
        if (old + 1u == (gen + 1u) * nloc) {
            __builtin_amdgcn_fence(__ATOMIC_RELEASE, "agent");
            asm volatile("s_waitcnt vmcnt(0)" ::: "memory");
            const unsigned og = xb_add(&bar[XB_TOP], 1u);
            const unsigned tg = og / nx;
            if (og + 1u == (tg + 1u) * nx) xb_add(&bar[XB_TOPGEN], 1u);
            else XB_SPIN(xb_ld(&bar[XB_TOPGEN]) == tg, bar);
            __builtin_amdgcn_fence(__ATOMIC_ACQUIRE, "agent");
            xb_add(&bar[XB_XGEN(b.x)], 1u);
            asm volatile("s_waitcnt vmcnt(0)" ::: "memory");
        } else {
            XB_SPIN(xb_ld(&bar[XB_XGEN(b.x)]) == gen, bar);
            __builtin_amdgcn_fence(__ATOMIC_ACQUIRE, "agent");
            asm volatile("s_waitcnt vmcnt(0)" ::: "memory");
        }
    }
    __syncthreads();
}
__device__ __forceinline__ void p0_mods_unit(const float* c, const float* cctx, const float* ada_w, const float* ada_b, float* mods, LAS unsigned char* lds, int unit) {
    LAS float* s = (LAS float*)lds;
    LAS float* red = s + 5 * 1024;
    int tid = threadIdx.x; asm volatile("" : "+v"(tid));
    for (int i = tid; i < 5 * 1024; i += 512) { const int v = i >> 10, k = i & 1023; const float x = v < 4 ? c[v * 1024 + k] : cctx[k]; s[i] = x / (1.0f + __expf(-x)); }
    __syncthreads();
    const int l = unit / 96, col0 = (unit % 96) * 64, kc = tid >> 6, cl = tid & 63;
    const float* w = ada_w + (size_t)l * 1024 * 6144 + col0 + cl;
    float a0 = 0.f, a1 = 0.f, a2 = 0.f, a3 = 0.f, a4 = 0.f;
    for (int k = kc * 128; k < kc * 128 + 128; k += 32) {
        float wv[32];
#pragma unroll
        for (int j = 0; j < 32; ++j) wv[j] = __builtin_nontemporal_load(w + (size_t)(k + j) * 6144);
#pragma unroll
        for (int j = 0; j < 32; ++j) { a0 += s[k + j] * wv[j]; a1 += s[1024 + k + j] * wv[j]; a2 += s[2048 + k + j] * wv[j]; a3 += s[3072 + k + j] * wv[j]; a4 += s[4096 + k + j] * wv[j]; }
    }
    red[(kc * 5 + 0) * 64 + cl] = a0; red[(kc * 5 + 1) * 64 + cl] = a1; red[(kc * 5 + 2) * 64 + cl] = a2; red[(kc * 5 + 3) * 64 + cl] = a3; red[(kc * 5 + 4) * 64 + cl] = a4;
    __syncthreads();
    if (tid < 320) { const int v = tid >> 6, cc = tid & 63; float t = 0.f;
#pragma unroll
        for (int kk = 0; kk < 8; ++kk) t += red[(kk * 5 + v) * 64 + cc];
        mods[(size_t)(l * 5 + v) * 6144 + col0 + cc] = t + ada_b[l * 6144 + col0 + cc]; }
    __syncthreads();
}

__device__ __forceinline__ void p0_transpose_item(const float* W, int K, int N, bf16_t* WT, bf16_t* WT2, int mode, LAS float* scr, int item, int lane) {
    const int nblk = N / 32, kb = item / nblk, nb = item % nblk, k0 = 64 * kb, n0 = 32 * nb;
    float wv_[32];
#pragma unroll
    for (int i = 0; i < 32; ++i) { int srow = k0 + 2 * i + (lane >> 5);
        if (mode == 2) { const int j = srow & 255; if (j > 128) srow = (srow & ~255) + 256 - (j - 128); }
        wv_[i] = __builtin_nontemporal_load(W + (size_t)srow * N + n0 + (lane & 31)); }
#pragma unroll
    for (int i = 0; i < 32; ++i) scr[(2 * i + (lane >> 5)) * 33 + (lane & 31)] = wv_[i];
    asm volatile("s_waitcnt lgkmcnt(0)" ::: "memory");
    const int cch = lane & 7;
#pragma unroll
    for (int j = 0; j < 4; ++j) { const int n = (lane >> 3) + 8 * j; const LAS float* s = scr + (8 * cch) * 33 + n;
        u32x4 o; o.x = cvt_pk_bf16(s[0 * 33], s[1 * 33]); o.y = cvt_pk_bf16(s[2 * 33], s[3 * 33]); o.z = cvt_pk_bf16(s[4 * 33], s[5 * 33]); o.w = cvt_pk_bf16(s[6 * 33], s[7 * 33]);
        const int ng = n0 + n; bf16_t* dst;
        if (mode != 1) dst = WT + (size_t)ng * K;
        else if (ng < 2048) { const int pn = ng >> 8, hh = (ng >> 6) & 3, d = ng & 63; const int tpos = (d >> 5) * 128 + hh * 32 + (d & 31); dst = WT + (size_t)(pn * 256 + tpos) * K; }
        else dst = WT2 + (size_t)(ng - 2048) * K;
        *(u32x4*)(dst + k0 + 8 * cch) = o; }
    asm volatile("s_waitcnt lgkmcnt(0)" ::: "memory");
}

__device__ __forceinline__ float wave_sum(float v) {
#pragma unroll
    for (int o = 1; o < 64; o <<= 1) v += __shfl_xor(v, o);
    return v;
}
__device__ __forceinline__ void norm_rows(const float* xlat, const float* xctx, int nrows, const float* g, const float* modsl, int sh_off, int sc_off, bf16_t* H, int gw, int NGW, int lane) {
    f32x4 gv[4];
#pragma unroll
    for (int j = 0; j < 4; ++j) gv[j] = *(const f32x4*)(g + lane * 4 + 256 * j);
    for (int row = gw; row < nrows; row += NGW) {
        const float* src = row < ML ? xlat + (size_t)row * 1024 : xctx + (size_t)(row - ML) * 1024;
        const int v = row < ML ? (row >> 12) : 4;
        const float* mp = modsl + (size_t)v * 6144;
        f32x4 x[4]; float ss = 0.f;
#pragma unroll
        for (int j = 0; j < 4; ++j) { x[j] = __builtin_nontemporal_load((const f32x4*)(src + lane * 4 + 256 * j)); ss += (x[j][0] * x[j][0] + x[j][1] * x[j][1]) + (x[j][2] * x[j][2] + x[j][3] * x[j][3]); }
        const float rstd = rsqrtf(wave_sum(ss) * (1.0f / 1024.0f) + EPS);
#pragma unroll
        for (int j = 0; j < 4; ++j) {
            const f32x4 sh = *(const f32x4*)(mp + sh_off + lane * 4 + 256 * j), sc = *(const f32x4*)(mp + sc_off + lane * 4 + 256 * j);
            const f32x4 y = (x[j] * rstd * gv[j]) * (sc + 1.0f) + sh;
            u32x2 w; w.x = cvt_pk_bf16(y[0], y[1]); w.y = cvt_pk_bf16(y[2], y[3]);
            *(u32x2*)(H + (size_t)row * 1024 + lane * 4 + 256 * j) = w;
        }
    }
}


__device__ __forceinline__ void bias_items(const bf16_t* W1t, const bf16_t* CS, const float* mods, float* BV0, float* BV1, float* BVF, int w, int NW, int lane) {
    for (int it = w; it < 8192 + 1024; it += NW) {
        float a0 = 0.f, a1 = 0.f, a2 = 0.f, a3 = 0.f; float* dst; int dstride;
        if (it < 8192) {
            const int l = it >> 12, n = it & 4095;
            const bf16_t* wr_ = W1t + (size_t)l * 4096 * 1024 + (size_t)n * 1024 + lane * 16;
            const u32x4 w0 = *(const u32x4*)wr_, w1 = *(const u32x4*)(wr_ + 8);
            const float* sh = mods + (size_t)l * 5 * 6144 + 3072 + lane * 16;
            float wf[16];
#pragma unroll
            for (int e = 0; e < 4; ++e) { wf[2 * e] = __uint_as_float(w0[e] << 16); wf[2 * e + 1] = __uint_as_float(w0[e] & 0xffff0000u); wf[8 + 2 * e] = __uint_as_float(w1[e] << 16); wf[8 + 2 * e + 1] = __uint_as_float(w1[e] & 0xffff0000u); }
#pragma unroll
            for (int q = 0; q < 4; ++q) {
                const f32x4 s0 = *(const f32x4*)(sh + 4 * q), s1 = *(const f32x4*)(sh + 6144 + 4 * q), s2 = *(const f32x4*)(sh + 2 * 6144 + 4 * q), s3 = *(const f32x4*)(sh + 3 * 6144 + 4 * q);
#pragma unroll
                for (int e = 0; e < 4; ++e) { a0 += s0[e] * wf[4 * q + e]; a1 += s1[e] * wf[4 * q + e]; a2 += s2[e] * wf[4 * q + e]; a3 += s3[e] * wf[4 * q + e]; }
            }
            dst = (l == 0 ? BV0 : BV1) + n; dstride = 4096;
        } else {
            const int idx = it - 8192, g = idx >> 8, m = idx & 255;
            const u32x2 w0 = *(const u32x2*)(CS + (size_t)m * 256 + lane * 4);
            const float wf0 = __uint_as_float(w0[0] << 16), wf1 = __uint_as_float(w0[0] & 0xffff0000u), wf2 = __uint_as_float(w0[1] << 16), wf3 = __uint_as_float(w0[1] & 0xffff0000u);
            const float* sh = mods + (size_t)5 * 6144 + g * 256 + lane * 4;
            const f32x4 s0 = *(const f32x4*)(sh), s1 = *(const f32x4*)(sh + 6144), s2 = *(const f32x4*)(sh + 2 * 6144), s3 = *(const f32x4*)(sh + 3 * 6144);
            a0 = s0[0] * wf0 + s0[1] * wf1 + s0[2] * wf2 + s0[3] * wf3; a1 = s1[0] * wf0 + s1[1] * wf1 + s1[2] * wf2 + s1[3] * wf3;
            a2 = s2[0] * wf0 + s2[1] * wf1 + s2[2] * wf2 + s2[3] * wf3; a3 = s3[0] * wf0 + s3[1] * wf1 + s3[2] * wf2 + s3[3] * wf3;
            dst = BVF + g * 256 + m; dstride = 1024;
        }
        a0 = wave_sum(a0); a1 = wave_sum(a1); a2 = wave_sum(a2); a3 = wave_sum(a3);
        if (lane == 0) { dst[0] = a0; dst[dstride] = a1; dst[2 * dstride] = a2; dst[3 * dstride] = a3; }
    }
}
template <bool MASKED>
__device__ __forceinline__ void attn_block(const LAS bf16_t* Ks, const LAS bf16_t* Vs, int kcol0, int fr, int g, const bf16x8 (&Qf)[2], f32x4 (&acc)[4], float& lsum,
                                           const LAS unsigned char* rpb_base  , const int (&dcb)[8], const f32x4& ciX, const f32x4& ciY) {
    bf16x8 KX[2], KY[2];
#pragma unroll
    for (int kk = 0; kk < 2; ++kk) { KX[kk] = *(const LAS bf16x8*)(Ks + (kcol0 + fr) * 72 + kk * 32 + g * 8); KY[kk] = *(const LAS bf16x8*)(Ks + (kcol0 + 16 + fr) * 72 + kk * 32 + g * 8); }
    s16x4 VX[4], VY[4];
#pragma unroll
    for (int db = 0; db < 4; ++db) { VX[db] = *(const LAS s16x4*)(Vs + (16 * db + fr) * 72 + kcol0 + 4 * g); VY[db] = *(const LAS s16x4*)(Vs + (16 * db + fr) * 72 + kcol0 + 16 + 4 * g); }
    f32x4 sX = mfma16(KX[0], Qf[0], ciX); sX = mfma16(KX[1], Qf[1], sX);
    f32x4 sY = mfma16(KY[0], Qf[0], ciY); sY = mfma16(KY[1], Qf[1], sY);
    f32x4 pX, pY;
    if (MASKED) {
#pragma unroll
        for (int ii = 0; ii < 4; ++ii) {
            const float bx = *(const LAS float*)(rpb_base + dcb[ii]), by = *(const LAS float*)(rpb_base + dcb[4 + ii]);
            pX[ii] = __builtin_amdgcn_exp2f(sX[ii] + bx);
            pY[ii] = __builtin_amdgcn_exp2f(sY[ii] + by);
        }
    } else {
#pragma unroll
        for (int ii = 0; ii < 4; ++ii) { pX[ii] = __builtin_amdgcn_exp2f(sX[ii]); pY[ii] = __builtin_amdgcn_exp2f(sY[ii]); }
    }
    lsum += ((pX[0] + pX[1]) + (pX[2] + pX[3])) + ((pY[0] + pY[1]) + (pY[2] + pY[3]));
    const u32x4 pw = pg8::pack8(pX, pY);
    const bf16x8 Pf = __builtin_bit_cast(bf16x8, pw);
#pragma unroll
    for (int db = 0; db < 4; ++db) {
        bf16x8 Vf; Vf[0] = VX[db][0]; Vf[1] = VX[db][1]; Vf[2] = VX[db][2]; Vf[3] = VX[db][3]; Vf[4] = VY[db][0]; Vf[5] = VY[db][1]; Vf[6] = VY[db][2]; Vf[7] = VY[db][3];
        acc[db] = mfma16(Vf, Pf, acc[db]);
    }
}
__device__ __forceinline__ void attn_phase(const bf16_t* QK, const bf16_t* VT, bf16_t* O, const float* rpb, const float* sbound, LAS unsigned char* lds, int G, int c) {
    constexpr int RP_BYTES = 30720, TILE_B = 64 * 72 * 2, PAIR_B = 4 * TILE_B, NPAIR = 7;
    LAS float* rp = (LAS float*)lds;
    int tid = threadIdx.x; asm volatile("" : "+v"(tid));
    const int lane = tid & 63, wid = __builtin_amdgcn_readfirstlane(tid >> 6), fr = lane & 15, g = lane >> 4;
    for (int i = tid; i < 16 * 465; i += 512) rp[i] = rpb[i] * LOG2E;
    const float Mb = *sbound;
    const int nunits = (2048 - c + G - 1) / G;
    const int ND = nunits * NPAIR;
    const int trow = tid >> 3, tch = tid & 7;
    const int ldsoff = (trow * 72 + tch * 8) * 2;
#define ATT_DEC(L_, b_, h_, rp_) do { const int x_ = (L_) & 7, q_ = (L_) >> 3; rp_ = q_ & 31; const int bh_ = 8 * (q_ >> 5) + x_; b_ = bh_ >> 4; h_ = bh_ & 15; } while (0)
#define ATT_TOK(b_, rs0_, t_) ((t_) < 9 ? (b_) * 4096 + min((rs0_) + (t_), 63) * 64 : ML + (b_) * 256 + 64 * (min((t_), 12) - 9))
#define ATT_GLOAD(D_, R) do { const int u_ = (D_) / NPAIR, p_ = (D_) - u_ * NPAIR; int b_, h_, rp_; ATT_DEC(u_ * G + c, b_, h_, rp_); \
        const int rs0_ = min(max(2 * rp_ - 4, 0), 56); const int tk0_ = ATT_TOK(b_, rs0_, 2 * p_), tk1_ = ATT_TOK(b_, rs0_, 2 * p_ + 1); \
        const bf16_t* kb_ = QK + (size_t)trow * 2048 + 1024 + h_ * 64 + tch * 8; const bf16_t* vb_ = VT + (size_t)(h_ * 64 + trow) * MT + tch * 8; \
        R[0] = *(const u32x4*)(kb_ + (size_t)tk0_ * 2048); R[1] = *(const u32x4*)(vb_ + tk0_); R[2] = *(const u32x4*)(kb_ + (size_t)tk1_ * 2048); R[3] = *(const u32x4*)(vb_ + tk1_); } while (0)
#define ATT_LWRITE(slot_, R) do { _Pragma("unroll") for (int q_ = 0; q_ < 4; ++q_) *(LAS u32x4*)(lds + RP_BYTES + (slot_) * PAIR_B + q_ * TILE_B + ldsoff) = R[q_]; } while (0)
    u32x4 R0[4], R1[4];
    ATT_GLOAD(0, R0); ATT_LWRITE(0, R0);
    if (ND > 1) ATT_GLOAD(1, R1);
    if (ND > 2) ATT_GLOAD(2, R0);
    __syncthreads();
    int b = 0, h = 0, rpair = 0, r = 0, rs0 = 0, rsr = 0, qrow = 0;
    const int j = wid & 3, w0 = (j == 0) ? 0 : (j == 1) ? 8 : (j == 2) ? 24 : 32;
    int dcb[8]; f32x4 ciX, ciY, ciU;
    {
        const int cq = 16 * j + fr, cs = min(max(cq - 8, 0), 48), eX = w0 + 4 * g - cs, dX = w0 + 4 * g - cq + 15;
#pragma unroll
        for (int ii = 0; ii < 4; ++ii) {
            dcb[ii] = 4 * min(max(dX + ii, 0), 30); dcb[4 + ii] = 4 * min(max(dX + 16 + ii, 0), 30);
            ciX[ii] = ((unsigned)(eX + ii) < 16u) ? -Mb : -1.0e30f; ciY[ii] = ((unsigned)(eX + 16 + ii) < 16u) ? -Mb : -1.0e30f; ciU[ii] = -Mb;
        }
    }
    bf16x8 Qf[2], Qn[2]; f32x4 acc[4]; float lsum = 0.f;
    int p = 0, u = 0, D = 0;
#define ATT_QLOAD(dst, uu) do { int b_, h_, rp_; ATT_DEC((uu) * G + c, b_, h_, rp_); const int qr_ = b_ * 4096 + (2 * rp_ + (wid >> 2)) * 64 + 16 * j + fr; \
        _Pragma("unroll") for (int kk = 0; kk < 2; ++kk) dst[kk] = *(const bf16x8*)(QK + (size_t)qr_ * 2048 + h_ * 64 + 32 * kk + 8 * g); } while (0)
#define ATT_TILE(t_, toff_) do { \
        const LAS bf16_t* Ks = (const LAS bf16_t*)(lds + RP_BYTES + slot * PAIR_B + (toff_)); \
        const LAS bf16_t* Vs = (const LAS bf16_t*)(lds + RP_BYTES + slot * PAIR_B + (toff_) + TILE_B); \
        if ((t_) < 9) { \
            const int kr = rs0 + (t_), i = kr - rsr; \
            if (i >= 0 && i < 8) attn_block<true>(Ks, Vs, w0, fr, g, Qf, acc, lsum, (const LAS unsigned char*)rp + (h * 465 + (kr - r + 7) * 31) * 4, dcb, ciX, ciY); \
        } else if ((t_) < 13) { \
            attn_block<false>(Ks, Vs, 0, fr, g, Qf, acc, lsum, (const LAS unsigned char*)rp, dcb, ciU, ciU); \
            attn_block<false>(Ks, Vs, 32, fr, g, Qf, acc, lsum, (const LAS unsigned char*)rp, dcb, ciU, ciU); \
        } } while (0)
    ATT_QLOAD(Qn, 0);
#define ATT_ITER(R) do { \
        const int slot = D & 1; \
        if (D + 1 < ND) ATT_LWRITE(slot ^ 1, R); \
        if (D + 3 < ND) ATT_GLOAD(D + 3, R); \
        if (p == 0) { \
            ATT_DEC(u * G + c, b, h, rpair); \
            r = 2 * rpair + (wid >> 2); rs0 = min(max(2 * rpair - 4, 0), 56); rsr = min(max(r - 4, 0), 56); \
            qrow = b * 4096 + r * 64 + 16 * j + fr; \
            Qf[0] = Qn[0]; Qf[1] = Qn[1]; \
            _Pragma("unroll") for (int db = 0; db < 4; ++db) acc[db] = (f32x4){0.f, 0.f, 0.f, 0.f}; \
            lsum = 0.f; \
        } \
        if (p == 4 && u + 1 < nunits) ATT_QLOAD(Qn, u + 1); \
        { const int i0_ = rs0 + 2 * p - rsr, i1_ = i0_ + 1; \
          if (2 * p + 1 < 9 && i0_ >= 0 && i1_ < 8) {        \
            const LAS bf16_t* Ka = (const LAS bf16_t*)(lds + RP_BYTES + slot * PAIR_B); const LAS bf16_t* Va = (const LAS bf16_t*)(lds + RP_BYTES + slot * PAIR_B + TILE_B); \
            const LAS bf16_t* Kb = (const LAS bf16_t*)(lds + RP_BYTES + slot * PAIR_B + 2 * TILE_B); const LAS bf16_t* Vb = (const LAS bf16_t*)(lds + RP_BYTES + slot * PAIR_B + 3 * TILE_B); \
            const LAS unsigned char* rb_ = (const LAS unsigned char*)rp + (h * 465 + (rs0 + 2 * p - r + 7) * 31) * 4; \
            attn_block<true>(Ka, Va, w0, fr, g, Qf, acc, lsum, rb_, dcb, ciX, ciY); \
            attn_block<true>(Kb, Vb, w0, fr, g, Qf, acc, lsum, rb_ + 124, dcb, ciX, ciY); \
          } else { ATT_TILE(2 * p, 0); ATT_TILE(2 * p + 1, 2 * TILE_B); } } \
        if (p == NPAIR - 1) { \
            float ls = lsum; ls += __shfl_xor(ls, 16); ls += __shfl_xor(ls, 32); \
            const float inv = 1.0f / ls; \
            bf16_t* op = O + (size_t)qrow * 1024 + h * 64 + 4 * g; \
            _Pragma("unroll") for (int db = 0; db < 4; ++db) { u32x2 w; w.x = cvt_pk_bf16(acc[db][0] * inv, acc[db][1] * inv); w.y = cvt_pk_bf16(acc[db][2] * inv, acc[db][3] * inv); st8(op + 16 * db, w); } \
            p = 0; ++u; \
        } else ++p; \
        __syncthreads(); \
    } while (0)
    for (;;) {
        ATT_ITER(R1); if (++D >= ND) break;
        ATT_ITER(R0); if (++D >= ND) break;
    }
#undef ATT_ITER
#undef ATT_TILE
#undef ATT_QLOAD
#undef ATT_DEC
#undef ATT_TOK
#undef ATT_GLOAD
#undef ATT_LWRITE
}

__device__ __forceinline__ void s1_phase(const bf16_t* Z0, const bf16_t* Dg, bf16_t* Z1, LAS unsigned char* lds, int gw, int NGW) {
    constexpr int DP = 136;
    LAS bf16_t* Dl = (LAS bf16_t*)lds;
    int tid = threadIdx.x; asm volatile("" : "+v"(tid));
    const int lane = tid & 63, fr = lane & 15, g = lane >> 4;
    for (int i = tid; i < 128 * 16; i += 512) { const int row = i >> 4, ch = i & 15; *(LAS u32x4*)(Dl + row * DP + ch * 8) = *(const u32x4*)(Dg + row * 128 + ch * 8); }
    __syncthreads();
    for (int job = gw; job < 2048 + 64; job += NGW) {
        const bool part = job >= 2048;
        const int colM = part ? 2048 + ((job - 2048) >> 2) : job, ib0 = part ? ((job - 2048) & 3) : 0, nib = part ? 1 : 4;
        bf16x8 A[4][4];
#pragma unroll
        for (int ib = 0; ib < 4; ++ib) { const int ibr = part ? ib0 : ib;
#pragma unroll
            for (int kb = 0; kb < 4; ++kb) A[ib][kb] = *(const bf16x8*)(Z0 + ((size_t)colM * 64 + 16 * ibr + fr) * 128 + 32 * kb + 8 * g); }
#pragma unroll 2
        for (int jb = 0; jb < 8; ++jb) {
            bf16x8 Bf[4];
#pragma unroll
            for (int kb = 0; kb < 4; ++kb) Bf[kb] = *(const LAS bf16x8*)(Dl + (16 * jb + fr) * DP + 32 * kb + 8 * g);
            const int n = 16 * jb + fr, ka = n >> 1, rip = n & 1;
#pragma unroll
            for (int ib = 0; ib < 4; ++ib) {
                if (ib < nib) {
                    f32x4 a = (f32x4){0.f, 0.f, 0.f, 0.f};
#pragma unroll
                    for (int kb = 0; kb < 4; ++kb) a = mfma16(A[ib][kb], Bf[kb], a);
                    u32x2 w; w.x = cvt_pk_bf16(a[0], a[1]); w.y = cvt_pk_bf16(a[2], a[3]);
                    st8(Z1 + (((size_t)ka * pg8::NCOL + colM) * 2 + rip) * 64 + 16 * (part ? ib0 : ib) + 4 * g, w);
                }
            }
        }
    }
    __syncthreads();
}
__device__ __forceinline__ void s2_phase(const bf16_t* Z1, const bf16_t* Eg, bf16_t* F, LAS unsigned char* lds, int G, int c) {
    constexpr int EP = 136;
    LAS bf16_t* El = (LAS bf16_t*)lds;
    int tid = threadIdx.x; asm volatile("" : "+v"(tid));
    const int lane = tid & 63, wid = __builtin_amdgcn_readfirstlane(tid >> 6), fr = lane & 15, g = lane >> 4;
    for (int wgi = c; wgi < 256; wgi += G) {
        const int ka = wgi & 63, part = wgi >> 6;
        for (int i = tid; i < 64 * 16; i += 512) { const int row = i >> 4, ch = i & 15; *(LAS u32x4*)(El + row * EP + ch * 8) = *(const u32x4*)(Eg + ((size_t)ka * 64 + row) * 128 + ch * 8); }
        __syncthreads();
        bf16x8 Bf[4][4];
#pragma unroll
        for (int jb = 0; jb < 4; ++jb)
#pragma unroll
            for (int kb = 0; kb < 4; ++kb) Bf[jb][kb] = *(const LAS bf16x8*)(El + (16 * jb + fr) * EP + 32 * kb + 8 * g);
        const int nrun = (part == 0 && wid == 0) ? 2 : 1;
        for (int run = 0; run < nrun; ++run) {
            const bool special = run == 1;
            const int q = part * 8 + wid, bg = q >> 1, ib0 = special ? 0 : 4 * (q & 1), nib = special ? 1 : 4;
            for (int ibb = 0; ibb < nib; ++ibb) {
                const int ib = ib0 + ibb;
                const int colM0 = special ? 2048 : bg * 128 + ib * 16;
                bf16x8 A[4];
#pragma unroll
                for (int kb = 0; kb < 4; ++kb) A[kb] = *(const bf16x8*)(Z1 + ((size_t)ka * pg8::NCOL + colM0 + fr) * 128 + 32 * kb + 8 * g);
                const int k2 = ib * 16 + 4 * g, b = bg >> 2, gg = bg & 3;
#pragma unroll
                for (int jb = 0; jb < 4; ++jb) {
                    f32x4 a = (f32x4){0.f, 0.f, 0.f, 0.f};
#pragma unroll
                    for (int kb = 0; kb < 4; ++kb) a = mfma16(A[kb], Bf[jb][kb], a);
                    const int k = ka + 64 * (16 * jb + fr), km = (4096 - k) & 4095;
                    u32x2 w; w.x = cvt_pk_bf16(a[0], a[1]); w.y = cvt_pk_bf16(a[2], a[3]);
                    if (!special) {
                        st8(F + ((size_t)b * 4096 + k) * 1024 + gg * 256 + k2, w);
                        bf16_t* pm_ = F + ((size_t)b * 4096 + km) * 1024 + gg * 256 + 128 + k2;
                        if (k2 != 0) st8(pm_, w);
                        else { pm_[1] = (bf16_t)(w.x >> 16); *(unsigned*)(pm_ + 2) = w.y; }
                    } else {
                        bf16_t* ps_ = F + ((size_t)g * 4096 + k) * 1024 + 128;
                        ps_[0] = (bf16_t)(w.x & 0xffffu); ps_[256] = (bf16_t)(w.x >> 16); ps_[512] = (bf16_t)(w.y & 0xffffu); ps_[768] = (bf16_t)(w.y >> 16);
                    }
                }
            }
        }
        __syncthreads();
    }
}


#ifndef MK_DEBUG
#define MK_DEBUG 0
#endif
__device__ __forceinline__ void dbg_scan16(const bf16_t* p, size_t n, unsigned* flags, unsigned bit, int gt, int NT) {
    bool bad = false; for (size_t i = gt; i < n; i += NT) bad |= ((p[i] & 0x7f80u) == 0x7f80u);
    if (bad) atomicOr(flags, 1u << bit);
}
__device__ __forceinline__ void dbg_scan32(const float* p, size_t n, unsigned* flags, unsigned bit, int gt, int NT) {
    bool bad = false; for (size_t i = gt; i < n; i += NT) bad |= ((__float_as_uint(p[i]) & 0x7f800000u) == 0x7f800000u);
    if (bad) atomicOr(flags, 1u << bit);
}
struct Args { const float* in[15]; float* out; unsigned char* ws; int ph_lo, ph_hi, use_cg, pad; };
static_assert(sizeof(Args) == 15 * 8 + 8 + 8 + 16, "no padding");

__global__ void __launch_bounds__(512, 2) fwd_kernel(Args args) {
    extern __shared__ __attribute__((aligned(16))) unsigned char lds_raw[];
    LAS unsigned char* lds = (LAS unsigned char*)lds_raw;
    const int G = gridDim.x, c = blockIdx.x;
    const int vcu = (G % 8 == 0) ? (c % 8) * (G / 8) + c / 8 : c;
    const int NGW = G * 8;
#define PHASE_IDS int tid_ = threadIdx.x; asm volatile("" : "+v"(tid_)); const int lane = tid_ & 63, wid = __builtin_amdgcn_readfirstlane(tid_ >> 6); const int gw = vcu * 8 + wid; (void)lane; (void)gw
    unsigned char* ws = args.ws;
    const float* x = args.in[0]; const float* cvec = args.in[1]; const float* ctx = args.in[2]; const float* cctx = args.in[3];
    const float* ada_w = args.in[4]; const float* ada_b = args.in[5]; const float* norm_g = args.in[6];
    const float* wqkv = args.in[7]; const float* wo = args.in[8]; const float* gq = args.in[9]; const float* gk = args.in[10]; const float* rpb = args.in[11];
    const float* fw = args.in[12]; const float* w1 = args.in[13]; const float* w2 = args.in[14];
    float* out = args.out;
    float* mods = (float*)(ws + WS_MODS); float* sbound = (float*)(ws + WS_SB);
    bf16_t* CS = (bf16_t*)(ws + WS_CS); bf16_t* Dt = (bf16_t*)(ws + WS_D); bf16_t* Et = (bf16_t*)(ws + WS_E);
    bf16_t* WQK = (bf16_t*)(ws + WS_WQK); bf16_t* WV = (bf16_t*)(ws + WS_WV); bf16_t* WO = (bf16_t*)(ws + WS_WO); bf16_t* FWt = (bf16_t*)(ws + WS_FW);
    bf16_t* W1t = (bf16_t*)(ws + WS_W1); bf16_t* W2t = (bf16_t*)(ws + WS_W2);
    bf16_t* H = (bf16_t*)(ws + WS_H); bf16_t* QK = (bf16_t*)(ws + WS_QK); bf16_t* VT = (bf16_t*)(ws + WS_VT); bf16_t* O = (bf16_t*)(ws + WS_O);
    bf16_t* XS = (bf16_t*)(ws + WS_XS); bf16_t* HMID = (bf16_t*)(ws + WS_HMID); bf16_t* Z0 = (bf16_t*)(ws + WS_Z0); bf16_t* Z1 = (bf16_t*)(ws + WS_Z1); bf16_t* Fb = (bf16_t*)(ws + WS_F);
    float* SSQ = (float*)(ws + WS_SSQ); float* BV0 = (float*)(ws + WS_BV); float* BV1 = BV0 + 4 * 4096; float* BVF = BV1 + 4 * 4096; float* GM = BVF + 16 * 512;
    const int lo = args.ph_lo, hi = args.ph_hi;
    cg::grid_group grid = cg::this_grid();
#define IN(k) (lo <= (k) && (k) < hi)
#ifndef REP_SYNC
#define REP_SYNC 1
#endif
#ifndef REP_NORM
#define REP_NORM 1
#endif
#ifndef REP_S12
#define REP_S12 1
#endif
#ifndef REP_P0
#define REP_P0 1
#endif
#ifndef USE_XB
#define USE_XB 1
#endif
#define SEAM(k) do { if (IN(k) && IN((k) + 1)) { for (int r_ = 0; r_ < REP_SYNC; ++r_) { if (use_cg) grid.sync(); else xcd_barrier(xbar); } } } while (0)
    { volatile LAS unsigned* st_ = (volatile LAS unsigned*)(lds + LDS_BYTES - 64); if (threadIdx.x < 2) st_[threadIdx.x] = 0u; __syncthreads(); }
    XcdBarrier xbar; xbar.bar = (unsigned*)(ws + WS_BAR); xbar.x = 0; xbar.st = (volatile LAS unsigned*)(lds + LDS_BYTES - 64);
    const bool use_cg = (args.use_cg != 0);
    if (!use_cg && hi - lo > 1) xbar = xcd_barrier_post((unsigned*)(ws + WS_BAR), (volatile LAS unsigned*)(lds + LDS_BYTES - 64));

    unsigned* dflags = (unsigned*)(ws + WS_SB + 256);
#define DBG16(k, bit, p, n) do { if (MK_DEBUG && IN(k)) { int t_ = threadIdx.x; asm volatile("" : "+v"(t_)); dbg_scan16(p, n, dflags, bit, (vcu * 512) + t_, G * 512); } } while (0)
#define DBG32(k, bit, p, n) do { if (MK_DEBUG && IN(k)) { int t_ = threadIdx.x; asm volatile("" : "+v"(t_)); dbg_scan32(p, n, dflags, bit, (vcu * 512) + t_, G * 512); } } while (0)
    if (IN(0)) {
        PHASE_IDS;
        if (MK_DEBUG && c == 0 && tid_ == 0) *dflags = 0u;
        for (int r0_ = 0; r0_ < REP_P0; ++r0_) {
        for (int u = c; u < 192; u += G) p0_mods_unit(cvec, cctx, ada_w, ada_b, mods, lds, u);
        __syncthreads();
        {
            LAS float* scr = (LAS float*)(lds + wid * 16384);
            constexpr int I_QKV = 16 * 96, I_SQ = 16 * 32, I_1 = 16 * 128, I_2 = 64 * 32;
            constexpr int NITEMS = I_QKV + I_SQ + 2 * I_1;
            for (int it = NITEMS - 1 - gw; it >= 0; it -= NGW) {
                int r = it;
                if (r < I_QKV) { p0_transpose_item(wqkv, 1024, 3072, WQK, WV, 1, scr, r, lane); continue; } r -= I_QKV;
                if (r < I_SQ) { p0_transpose_item(wo, 1024, 1024, WO, nullptr, 0, scr, r, lane); continue; } r -= I_SQ;
                { const int l = r / I_1; p0_transpose_item(w1 + (size_t)l * 1024 * 4096, 1024, 4096, W1t + (size_t)l * 4096 * 1024, nullptr, 0, scr, r % I_1, lane); }
            }
        }
        {
            const int gt = gw * 64 + lane, NT = NGW * 64;
            for (int i = gt; i < 256 * 256; i += NT) { const int m = i >> 8, cc = i & 255, ri = m >> 7, k2 = m & 127; float sn, cs; sincospif(2.0f * (float)((cc * k2) & 255) / 256.0f, &sn, &cs);
                float v = (ri == 0 ? cs : -sn) * (1.0f / 16.0f); if (m == 128) v = (cc & 1) ? -(1.0f / 16.0f) : (1.0f / 16.0f);
                CS[i] = (bf16_t)(cvt_pk_bf16(v, 0.f) & 0xffffu); }
            for (int i = gt; i < 128 * 128; i += NT) { const int n = i >> 7, kp = i & 127, ka = n >> 1, rip = n & 1, ri = kp >> 6, a = kp & 63; float sn, cs; sincospif(2.0f * (float)((a * ka) & 63) / 64.0f, &sn, &cs);
                const float v = (rip == 0 ? (ri == 0 ? cs : sn) : (ri == 0 ? -sn : cs)) * 0.125f; Dt[i] = (bf16_t)(cvt_pk_bf16(v, 0.f) & 0xffffu); }
            for (int i = gt; i < 64 * 64 * 128; i += NT) { const int kp = i & 127, kbk = (i >> 7) & 63, ka = i >> 13, rip = kp >> 6, bp = kp & 63; float sn, cs; sincospif(2.0f * (float)((bp * (ka + 64 * kbk)) & 4095) / 4096.0f, &sn, &cs);
                const float v = (rip == 0 ? cs : sn) * 0.125f; Et[i] = (bf16_t)(cvt_pk_bf16(v, 0.f) & 0xffffu); }
        }
        if (c == G - 1 && wid == 7) {
            float mq = fabsf(gq[lane]), mk = fabsf(gk[lane]), mr = 0.f;
            for (int i = lane; i < 16 * 465; i += 64) mr = fmaxf(mr, fabsf(rpb[i]));
#pragma unroll
            for (int o = 1; o < 64; o <<= 1) { mq = fmaxf(mq, __shfl_xor(mq, o)); mk = fmaxf(mk, __shfl_xor(mk, o)); mr = fmaxf(mr, __shfl_xor(mr, o)); }
            if (lane == 0) *sbound = (8.0f * mq * mk + mr) * LOG2E;
        }
        __syncthreads();
        }
    }
    SEAM(0);
    const bool ctx_in_p1 = false;
    if (IN(1)) { PHASE_IDS;
        if (c == G - 1) {
            for (int i = tid_; i < 3 * 4096; i += 512) { const int idx = i >> 12, b = (i >> 10) & 3, col = i & 1023;
                const float gg = norm_g[(idx == 0 ? 1024 : idx == 1 ? 2048 : 3072) + col];
                const float sc = mods[(size_t)((idx == 0 ? 0 : 5) + b) * 6144 + (idx == 1 ? 1024 : 4096) + col];
                GM[i] = gg * (1.0f + sc); }
        }
        if (!ctx_in_p1) norm_rows(x, ctx, MT, norm_g, mods, 0, 1024, H, gw, NGW, lane);
        else if (c >= 32) norm_rows(x, ctx, ML, norm_g, mods, 0, 1024, H, (c - 32) * 8 + wid, (G - 32) * 8, lane);
        else {
            pg8::SchedOne S1u; const size_t ts = (size_t)256 * 1024 * 2; int tt;
            if (c < 16) { S1u.u.kind = 0; S1u.u.pm = 64 + (c & 3); S1u.u.pn = 4 + (c >> 2); tt = c & 3; S1u.u.a = (const char*)H + (size_t)S1u.u.pm * ts; S1u.u.b = (const char*)WQK + (size_t)S1u.u.pn * ts; }
            else { const int l2 = c - 16; S1u.u.kind = 1; S1u.u.pm = l2 & 3; S1u.u.pn = 64 + (l2 >> 2); tt = l2 >> 2; S1u.u.a = (const char*)WV + (size_t)S1u.u.pm * ts; S1u.u.b = (const char*)H + (size_t)S1u.u.pn * ts; }
            S1u.u.aux = 0;
            norm_rows(x, ctx, ML + tt * 256 + 256, norm_g, mods, 0, 1024, H, ML + tt * 256 + wid, 8, lane);
            asm volatile("s_waitcnt vmcnt(0)" ::: "memory"); __syncthreads();
            pg8::EpiQKV E{QK, VT, gq, gk};
            pg8::gemm_phase<pg8::EpiQKV, pg8::SchedOne, false>(lds, 1024, 1024, 1024, S1u, E);
        }
    }
    SEAM(1);
    DBG16(2, 0, H, (size_t)MT * 1024);
    if (IN(2)) { pg8::SchedQKV S{(const char*)H, (const char*)WQK, (const char*)WV, G, c, ctx_in_p1 ? 768 : 800}; pg8::EpiQKV E{QK, VT, gq, gk};
#ifndef REP_G2
#define REP_G2 1
#endif
        for (int r_ = 0; r_ < REP_G2; ++r_) pg8::gemm_phase<pg8::EpiQKV, pg8::SchedQKV, false>(lds, 1024, 1024, 1024, S, E);
        { PHASE_IDS;
          const bool part = (G > 32); const int w_ = part ? (c - 32) * 8 + wid : gw, nw_ = part ? (G - 32) * 8 : NGW;
          if (!part || c >= 32) {
              bias_items(W1t, CS, mods, BV0, BV1, BVF, w_, nw_, lane);
              LAS float* scr = (LAS float*)(lds + wid * 16384);
              constexpr int I_SQ = 16 * 32, I_2 = 64 * 32;
              for (int it = w_; it < I_SQ + 2 * I_2; it += nw_) {
                  if (it < I_SQ) p0_transpose_item(fw, 1024, 1024, FWt, nullptr, 2, scr, it, lane);
                  else { const int r2 = it - I_SQ, l = r2 / I_2; p0_transpose_item(w2 + (size_t)l * 4096 * 1024, 4096, 1024, W2t + (size_t)l * 1024 * 4096, nullptr, 0, scr, r2 % I_2, lane); }
              }
          } } }
    SEAM(2);
    DBG16(3, 1, QK, (size_t)ML * 2048); DBG16(3, 2, VT, (size_t)1024 * MT); DBG32(3, 13, mods, (size_t)10 * 6144);
#ifndef REP_ATT
#define REP_ATT 1
#endif
    if (IN(3)) { for (int rep = 0; rep < REP_ATT; ++rep) attn_phase(QK, VT, O, rpb, sbound, lds, G, c); }
    SEAM(3);
    DBG16(4, 3, O, (size_t)ML * 1024);
    if (IN(4)) { pg8::SchedStd S; S.init(O, WO, ML, 1024, 1024, 1024, G, c); pg8::EpiResF<false> E{x, XS, mods + 2048, GM, H, SSQ};
        pg8::gemm_phase<pg8::EpiResF<false>, pg8::SchedStd, false>(lds, 1024, 1024, 1024, S, E); }
    SEAM(4);
    DBG32(5, 4, out, (size_t)ML * 1024);
    if (IN(6)) { pg8::SchedStd S; S.init(H, W1t, ML, 4096, 1024, 1024, G, c); pg8::EpiRelu2F E{HMID, 4096, BV0, SSQ};
        pg8::gemm_phase<pg8::EpiRelu2F, pg8::SchedStd, false>(lds, 1024, 1024, 1024, S, E); }
    SEAM(6);
    DBG16(7, 5, HMID, (size_t)ML * 4096);
    if (IN(7)) { pg8::SchedStd S; S.init(HMID, W2t, ML, 1024, 64, 4096, G, c, (size_t)64 * 32768); pg8::EpiResF<true> E{XS, XS, mods + 5120, GM + 4096, H, SSQ};
        pg8::gemm_phase<pg8::EpiResF<true>, pg8::SchedStd, false>(lds, 4096, 64, 4096, S, E, 32768, 128); }
    SEAM(7);
    const float* mods1 = mods + 5 * 6144;
    DBG32(8, 6, out, (size_t)ML * 1024);
    if (IN(9)) { pg8::SchedF1 S{(const char*)CS, (const char*)H, G, c}; pg8::EpiZ0F E{Z0, BVF, SSQ};
        pg8::gemm_phase<pg8::EpiZ0F, pg8::SchedF1, true>(lds, 256, 256, 1024, S, E); }
    SEAM(9);
    DBG16(10, 7, Z0, (size_t)262144 * 128);
    if (IN(10)) { PHASE_IDS; for (int r_ = 0; r_ < REP_S12; ++r_) s1_phase(Z0, Dt, Z1, lds, gw, NGW); }
    SEAM(10);
    DBG16(11, 8, Z1, (size_t)262144 * 128);
    if (IN(11)) { s2_phase(Z1, Et, Fb, lds, G, c); }
    SEAM(11);
    DBG16(12, 9, Fb, (size_t)ML * 1024);
    if (IN(12)) { pg8::SchedStd S; S.init(Fb, FWt, ML, 1024, 1024, 1024, G, c); pg8::EpiResF<true> E{XS, XS, mods1 + 2048, GM + 8192, H, SSQ};
        pg8::gemm_phase<pg8::EpiResF<true>, pg8::SchedStd, false>(lds, 1024, 1024, 1024, S, E); }
    SEAM(12);
    DBG32(13, 10, out, (size_t)ML * 1024);
    if (IN(14)) { pg8::SchedStd S; S.init(H, W1t + (size_t)4096 * 1024, ML, 4096, 1024, 1024, G, c); pg8::EpiRelu2F E{HMID, 4096, BV1, SSQ};
        pg8::gemm_phase<pg8::EpiRelu2F, pg8::SchedStd, false>(lds, 1024, 1024, 1024, S, E); }
    SEAM(14);
    DBG16(15, 11, HMID, (size_t)ML * 4096);
    if (IN(15)) { pg8::SchedStd S; S.init(HMID, W2t + (size_t)1024 * 4096, ML, 1024, 64, 4096, G, c, (size_t)64 * 32768); pg8::EpiRes E{XS, out, mods1 + 5120};
        pg8::gemm_phase<pg8::EpiRes, pg8::SchedStd, false>(lds, 4096, 64, 4096, S, E, 32768, 128); }
    SEAM(15);
    if (MK_DEBUG && IN(16)) {
        int t_ = threadIdx.x; asm volatile("" : "+v"(t_));
        bool bad = false;
        for (size_t i = (size_t)vcu * 512 + t_; i < (size_t)ML * 1024; i += (size_t)G * 512) { if ((__float_as_uint(out[i]) & 0x7f800000u) == 0x7f800000u) { bad = true; out[i] = 0.f; } }
        if (bad) atomicOr(dflags, 1u << 12);
    }
    SEAM(16);
    if (MK_DEBUG && IN(17)) {
        if (c == 0 && threadIdx.x == 0) { const unsigned f = *dflags; if (f) out[0] = 1.0e6f * (float)(__builtin_ctz(f) + 1) + 1.0e4f * (float)__builtin_popcount(f); }
    }
#undef IN
#undef SEAM
}

constexpr int NPHASE = MK_DEBUG ? 18 : 16;
#ifndef MK_USE_CG
#define MK_USE_CG 0
#endif
#ifndef MK_PER_PHASE
#define MK_PER_PHASE 0
#endif

extern "C" void kernel_launch(void* const* d_in, const int* in_sizes, int n_in, void* d_out, int out_size, void* d_ws, size_t ws_size, hipStream_t stream) {
    static int grid = 0;
    if (grid == 0) {
        if (n_in != 15 || out_size != ML * DM || ws_size < WS_END) { fprintf(stderr, "kernel_launch: unexpected shapes (n_in %d out %d ws %zu)\n", n_in, out_size, ws_size); grid = -1; return; }
        int dev = 0, cus = 0, per_cu = 0;
        hipGetDevice(&dev); hipDeviceGetAttribute(&cus, hipDeviceAttributeMultiprocessorCount, dev);
        hipFuncSetAttribute((const void*)fwd_kernel, hipFuncAttributeMaxDynamicSharedMemorySize, LDS_BYTES);
        if (hipOccupancyMaxActiveBlocksPerMultiprocessor(&per_cu, (const void*)fwd_kernel, 512, LDS_BYTES) != hipSuccess || per_cu < 1) { fprintf(stderr, "kernel_launch: occupancy query failed (%d)\n", per_cu); (void)hipGetLastError(); per_cu = 1; }
        grid = cus * 1;
        if (grid <= 0) grid = 256;
    }
    if (grid < 0) return;
    if (hipMemsetAsync((char*)d_ws + WS_BAR, 0, BAR_BYTES, stream) != hipSuccess) { fprintf(stderr, "kernel_launch: memset failed\n"); return; }
    Args a{};
    for (int i = 0; i < 15; ++i) a.in[i] = (const float*)d_in[i];
    a.out = (float*)d_out; a.ws = (unsigned char*)d_ws;
#if MK_PER_PHASE
    for (int p = 0; p < NPHASE; ++p) { a.ph_lo = p; a.ph_hi = p + 1; hipLaunchKernelGGL(fwd_kernel, dim3(grid), dim3(512), LDS_BYTES, stream, a); }
#else
    a.ph_lo = 0; a.ph_hi = NPHASE; a.use_cg = MK_USE_CG;
    void* kargs[] = {&a};
    hipError_t e = hipLaunchCooperativeKernel((const void*)fwd_kernel, dim3(grid), dim3(512), kargs, LDS_BYTES, stream);
    if (e != hipSuccess) fprintf(stderr, "cooperative launch failed: %s (grid %d)\n", hipGetErrorString(e), grid);
#endif
}
```

```cpp
#include <hip/hip_runtime.h>
#include <hip/hip_cooperative_groups.h>
#include <cstdio>
#include <cstdint>
namespace cg = cooperative_groups;

#define LAS __attribute__((address_space(3)))
typedef unsigned short bf16_t;
typedef short bf16x8 __attribute__((ext_vector_type(8)));
typedef short s16x4 __attribute__((ext_vector_type(4)));
typedef float f32x4 __attribute__((ext_vector_type(4)));
typedef unsigned u32x4 __attribute__((ext_vector_type(4)));
typedef unsigned u32x2 __attribute__((ext_vector_type(2)));

constexpr int DM = 1024, NB = 4, SEQ = 4096, CTXL = 256, FF = 4096;
constexpr int ML = NB * SEQ;
constexpr int MT = ML + NB * CTXL;
constexpr float LOG2E = 1.4426950408889634f;
constexpr float EPS = 1e-6f;

constexpr size_t MiB = 1u << 20;
constexpr size_t WS_MODS = 0;
constexpr size_t WS_SB = 512 * 1024;
constexpr size_t WS_BAR = 1 * MiB;
constexpr size_t BAR_BYTES = 16384;
constexpr size_t WS_CS = 2 * MiB;
constexpr size_t WS_D = 2 * MiB + 512 * 1024;
constexpr size_t WS_E = 3 * MiB;
constexpr size_t WS_WQK = 4 * MiB, WS_WV = 8 * MiB, WS_WO = 10 * MiB, WS_FW = 12 * MiB;
constexpr size_t WS_W1 = 14 * MiB;
constexpr size_t WS_W2 = 30 * MiB;
constexpr size_t WS_SSQ = 46 * MiB;
constexpr size_t WS_BV = 47 * MiB;
constexpr size_t WS_H = 48 * MiB;
constexpr size_t WS_R = 82 * MiB;
constexpr size_t WS_QK = WS_R;
constexpr size_t WS_VT = WS_R + 68 * MiB;
constexpr size_t WS_O = WS_R + 102 * MiB;
constexpr size_t WS_HMID = WS_R;
constexpr size_t WS_Z0 = WS_R;
constexpr size_t WS_Z1 = WS_R + 64 * MiB;
constexpr size_t WS_F = WS_R;
constexpr size_t WS_XS = WS_R + 134 * MiB;
constexpr size_t WS_END = 256 * MiB;
static_assert(WS_XS + 32 * MiB <= WS_END && WS_O + 32 * MiB <= WS_XS && WS_F + 32 * MiB <= WS_END && WS_HMID + 128 * MiB <= WS_END && WS_O + 32 * MiB <= WS_END, "ws map");

constexpr int LDS_BYTES = 147456;

typedef __bf16 bf16v2_t __attribute__((ext_vector_type(2)));
typedef float f32v2_t __attribute__((ext_vector_type(2)));
__device__ __forceinline__ unsigned cvt_pk_bf16(float lo, float hi) { const f32v2_t v = {lo, hi}; const bf16v2_t r = __builtin_convertvector(v, bf16v2_t); return __builtin_bit_cast(unsigned, r); }
__device__ __forceinline__ f32x4 mfma16(bf16x8 a, bf16x8 b, f32x4 c) { return __builtin_amdgcn_mfma_f32_16x16x32_bf16(a, b, c, 0, 0, 0); }


#ifndef MK_WT
#define MK_WT 0
#endif
__device__ __forceinline__ void st16(void* p, u32x4 v) {
#if MK_WT
    asm volatile("global_store_dwordx4 %0, %1, off sc1\n\ts_nop 1" :: "v"(p), "v"(v) : "memory");
#else
    *(u32x4*)p = v;
#endif
}
__device__ __forceinline__ void st16f(void* p, f32x4 v) {
#if MK_WT
    asm volatile("global_store_dwordx4 %0, %1, off sc1\n\ts_nop 1" :: "v"(p), "v"(v) : "memory");
#else
    *(f32x4*)p = v;
#endif
}
__device__ __forceinline__ void st8(void* p, u32x2 v) {
#if MK_WT
    asm volatile("global_store_dwordx2 %0, %1, off sc1\n\ts_nop 1" :: "v"(p), "v"(v) : "memory");
#else
    *(u32x2*)p = v;
#endif
}
namespace pg8 {
constexpr int BM = 256, BK = 64, HALF = 128, HTB = HALF * BK * 2, STAGE_BYTES = 8 * HTB;
__device__ __forceinline__ int lds_byte(int r, int c) { const int st = (r >> 4) * 2 + (c >> 5), rr = r & 15, cc = c & 31, ob = rr * 64 + cc * 2; return st * 1024 + (ob ^ (((ob >> 9) & 1) << 5)); }
__device__ __forceinline__ void stage_rc(int b, int& R, int& C) { const int st = b / 1024, sb = b % 1024, swz = sb ^ (((sb >> 9) & 1) << 5); R = (st >> 1) * 16 + swz / 64; C = (st & 1) * 32 + (swz % 64) / 2; }
__device__ __forceinline__ int perm32(int rho) { const int n = rho >> 4, i = rho & 15; return 8 * (i >> 2) + 4 * n + (i & 3); }

struct Unit { int pm, pn, kind, aux; const char* a; const char* b; };

template <class Epi, class Sched, bool BMAP>
__device__ __forceinline__ void gemm_phase(LAS unsigned char* lds, const int K, const int lda, const int ldb, const Sched& S, const Epi& E, const size_t kstepA = 128, const size_t kstepB = 128) {
    int tid = threadIdx.x; asm volatile("" : "+v"(tid));
    const int wid = __builtin_amdgcn_readfirstlane(tid >> 6), lane = tid & 63, wr = wid >> 2, wc = wid & 3, fr = lane & 15, fq = lane >> 4;
    int nt = K / BK; asm volatile("" : "+s"(nt));
    unsigned voffA[2], voffB[2];
#pragma unroll
    for (int i = 0; i < 2; ++i) { int R, C; stage_rc(tid * 16 + i * 8192, R, C); const int Rb = (R & ~31) + perm32(R & 31);
        voffA[i] = (unsigned)(R * lda + C) * 2u;
        voffB[i] = BMAP ? (unsigned)((64 * (Rb & 63) + (Rb >> 6)) * ldb + C) * 2u : (unsigned)(Rb * ldb + C) * 2u; }
    const size_t hstepA = (size_t)HALF * lda * 2;
    const size_t hstepB = BMAP ? (size_t)2 * ldb * 2 : (size_t)HALF * ldb * 2;
    const unsigned ldsw = (unsigned)wid * 1024u;
    const int aoff = lds_byte(wr * 64 + fr, fq * 8), boff = lds_byte(wc * 32 + fr, fq * 8);
#define PG8_SA(b, h) (((b) * 2 + (h)) * HTB)
#define PG8_SB(b, h) ((4 + (b) * 2 + (h)) * HTB)
#define PG8_STAGE(bufoff, gbase, voff) do { _Pragma("unroll") for (int _i = 0; _i < 2; ++_i) \
        __builtin_amdgcn_global_load_lds((const unsigned*)((const char*)(gbase) + (voff)[_i]), (LAS unsigned*)(lds + (bufoff) + ldsw + _i * 8192), 16, 0, 0); } while (0)
#define PG8_LDA(dst, b, h) do { _Pragma("unroll") for (int m = 0; m < 4; ++m) _Pragma("unroll") for (int k = 0; k < 2; ++k) dst[m][k] = *(const LAS bf16x8*)(lds + PG8_SA(b, h) + aoff + m * 2048 + k * 1024); } while (0)
#define PG8_LDB(dst, b, h) do { _Pragma("unroll") for (int n = 0; n < 2; ++n) _Pragma("unroll") for (int k = 0; k < 2; ++k) dst[n][k] = *(const LAS bf16x8*)(lds + PG8_SB(b, h) + boff + n * 2048 + k * 1024); } while (0)
#define PG8_MMA(ai, bj, At, Bt) do { __builtin_amdgcn_s_setprio(1); _Pragma("unroll") for (int m = 0; m < 4; ++m) _Pragma("unroll") for (int n = 0; n < 2; ++n) _Pragma("unroll") for (int k = 0; k < 2; ++k) \
        acc[ai][bj][m][n] = __builtin_amdgcn_mfma_f32_16x16x32_bf16(Bt[n][k], At[m][k], acc[ai][bj][m][n], 0, 0, 0); __builtin_amdgcn_s_setprio(0); } while (0)
#define PG8_WAIT_V(n) asm volatile("s_waitcnt vmcnt(" #n ")" ::: "memory")
#define PG8_WAIT_L(n) asm volatile("s_waitcnt lgkmcnt(" #n ")" ::: "memory")
#define PG8_BAR __builtin_amdgcn_s_barrier()
#define PG8_SCHED __builtin_amdgcn_sched_barrier(0)
    Unit cur, nxt; int ui = 0;
    if (!S.next(0, cur)) return;
    f32x4 acc[2][2][4][2];
#pragma unroll
    for (int a = 0; a < 2; ++a)
#pragma unroll
        for (int b = 0; b < 2; ++b)
#pragma unroll
            for (int m = 0; m < 4; ++m)
#pragma unroll
                for (int n = 0; n < 2; ++n) acc[a][b][m][n] = (f32x4){0.f, 0.f, 0.f, 0.f};
    bf16x8 At[4][2], B0[2][2], B1[2][2];
    const char* cA = cur.a; const char* cB = cur.b;
    if constexpr (Epi::PREP) E.prep(cur, lds, 0, tid);
    PG8_STAGE(PG8_SB(0, 0), cB, voffB); PG8_STAGE(PG8_SB(0, 1), cB + hstepB, voffB); PG8_STAGE(PG8_SA(0, 0), cA, voffA); PG8_STAGE(PG8_SA(0, 1), cA + hstepA, voffA);
    if (wr == 1) PG8_BAR;
    PG8_WAIT_V(2); PG8_BAR;
    PG8_STAGE(PG8_SB(1, 0), cB + kstepB, voffB); PG8_STAGE(PG8_SA(1, 0), cA + kstepA, voffA); PG8_STAGE(PG8_SB(1, 1), cB + hstepB + kstepB, voffB);
    PG8_WAIT_V(6); PG8_BAR;
    for (;;) {
        const bool has_next = S.next(ui + 1, nxt);
        const char* nA = has_next ? nxt.a : cA; const char* nB = has_next ? nxt.b : cB;
        for (int t = 0; t < nt; t += 2) {
            const bool last = (t == nt - 2);
            const char* a1 = cA + (size_t)(t + 1) * kstepA;
            const char* a2 = last ? nA : cA + (size_t)(t + 2) * kstepA; const char* b2 = last ? nB : cB + (size_t)(t + 2) * kstepB;
            const char* a3 = a2 + kstepA; const char* b3 = b2 + kstepB;
            PG8_LDB(B0, 0, 0); PG8_LDB(B1, 0, 1); PG8_SCHED; PG8_LDA(At, 0, 0); PG8_STAGE(PG8_SA(1, 1), a1 + hstepA, voffA);
            PG8_WAIT_V(8); PG8_WAIT_L(0); PG8_BAR; PG8_MMA(0, 0, At, B0); PG8_MMA(0, 1, At, B1); PG8_BAR; PG8_SCHED;
            PG8_LDA(At, 0, 1); PG8_STAGE(PG8_SB(0, 0), b2, voffB); PG8_STAGE(PG8_SB(0, 1), b2 + hstepB, voffB); PG8_STAGE(PG8_SA(0, 0), a2, voffA);
            PG8_WAIT_V(8); PG8_WAIT_L(0); PG8_BAR; PG8_MMA(1, 0, At, B0); PG8_MMA(1, 1, At, B1); PG8_BAR; PG8_SCHED;
            PG8_LDB(B0, 1, 0); PG8_LDB(B1, 1, 1); PG8_SCHED; PG8_LDA(At, 1, 0); PG8_STAGE(PG8_SA(0, 1), a2 + hstepA, voffA);
            PG8_WAIT_V(8); PG8_WAIT_L(0); PG8_BAR; PG8_MMA(0, 0, At, B0); PG8_MMA(0, 1, At, B1); PG8_BAR; PG8_SCHED;
            PG8_LDA(At, 1, 1); PG8_STAGE(PG8_SB(1, 0), b3, voffB); PG8_STAGE(PG8_SB(1, 1), b3 + hstepB, voffB); PG8_STAGE(PG8_SA(1, 0), a3, voffA);
            PG8_WAIT_V(8); PG8_WAIT_L(0); PG8_BAR; PG8_MMA(1, 0, At, B0); PG8_MMA(1, 1, At, B1); PG8_BAR; PG8_SCHED;
        }
        if (wr == 0) PG8_BAR;
        if constexpr (Epi::PREP) { if (has_next) E.prep(nxt, lds, (ui + 1) & 1, tid); }
        E(acc, cur, wr, wc, fr, fq, lds, ui & 1);
        if (!has_next) break;
#pragma unroll
        for (int a = 0; a < 2; ++a)
#pragma unroll
            for (int b = 0; b < 2; ++b)
#pragma unroll
                for (int m = 0; m < 4; ++m)
#pragma unroll
                    for (int n = 0; n < 2; ++n) acc[a][b][m][n] = (f32x4){0.f, 0.f, 0.f, 0.f};
        cur = nxt; cA = nA; cB = nB; ++ui;
        if (wr == 1) PG8_BAR;
    }
    PG8_WAIT_V(0);
    PG8_BAR;
#undef PG8_SA
#undef PG8_SB
#undef PG8_STAGE
#undef PG8_LDA
#undef PG8_LDB
#undef PG8_MMA
#undef PG8_WAIT_V
#undef PG8_WAIT_L
#undef PG8_BAR
#undef PG8_SCHED
}

struct SchedStd {
    const char* A; const char* Bt; size_t tsA, tsB; int nM, nN, nwg, G, c;
    __device__ void init(const void* A_, const void* Bt_, int M, int N, int lda, int ldb, int G_, int c_, size_t tsA_ = 0) { A = (const char*)A_; Bt = (const char*)Bt_; tsA = tsA_ ? tsA_ : (size_t)BM * lda * 2; tsB = (size_t)BM * ldb * 2; nM = M / BM; nN = N / BM; nwg = nM * nN; G = G_; c = c_; }
    __device__ bool next(int i, Unit& u) const {
        const long L = (long)i * G + c; if (L >= nwg) return false;
        int wgid = (int)L; { const int q = nwg / 8, r = nwg % 8, xcd = wgid % 8, off = wgid / 8; wgid = (xcd < r ? xcd * (q + 1) : r * (q + 1) + (xcd - r) * q) + off; }
        const int nig = 8 * nN, gid = wgid / nig, fm = gid * 8, gsz = (nM - fm) < 8 ? (nM - fm) : 8;
        u.pm = fm + ((wgid % nig) % gsz); u.pn = (wgid % nig) / gsz; u.kind = 0; u.aux = 0;
        u.a = A + (size_t)u.pm * tsA; u.b = Bt + (size_t)u.pn * tsB; return true;
    }
};
struct SchedQKV {
    const char* H; const char* Wqk; const char* Wv; int G, c, nunits;
    __device__ bool next(int i, Unit& u) const {
        const long Ll = (long)i * G + c; if (Ll >= nunits) return false;
        const int L = (int)Ll; const size_t ts = (size_t)BM * 1024 * 2; u.aux = 0;
        if (L < 512) { const int x = L & 7, off = L >> 3; u.kind = 0; u.pm = 8 * x + (off & 7); u.pn = off >> 3; }
        else if (L < 768) { const int l2 = L - 512, x = l2 & 7, off = l2 >> 3; u.kind = 1; u.pm = off & 3; u.pn = 8 * x + (off >> 2); }
        else if (L < 784) { const int l2 = L - 768; u.kind = 0; u.pm = 64 + (l2 & 3); u.pn = 4 + (l2 >> 2); }
        else { const int l2 = L - 784; u.kind = 1; u.pm = l2 & 3; u.pn = 64 + (l2 >> 2); }
        if (u.kind == 0) { u.a = H + (size_t)u.pm * ts; u.b = Wqk + (size_t)u.pn * ts; }
        else { u.a = Wv + (size_t)u.pm * ts; u.b = H + (size_t)u.pn * ts; }
        return true;
    }
};
struct SchedOne { Unit u;
    __device__ __forceinline__ bool next(int i, Unit& o) const { if (i > 0) return false; o = u; return true; }
};
struct SchedF1 {
    const char* CS; const char* H; int G, c;
    __device__ bool next(int i, Unit& u) const {
        const long Ll = (long)i * G + c; if (Ll >= 256) return false;
        const int L = (int)Ll; const int t = L & 15, b = (L >> 4) & 3, g = (L >> 6) & 3;
        u.pm = 0; u.pn = t; u.kind = g; u.aux = b;
        u.a = CS; u.b = H + ((size_t)(b * 4096 + 4 * t) * 1024 + g * 256) * 2; return true;
    }
};

typedef f32x4 Acc[2][2][4][2];
__device__ __forceinline__ u32x4 pack8(f32x4 v0, f32x4 v1) { u32x4 w; w.x = cvt_pk_bf16(v0[0], v0[1]); w.y = cvt_pk_bf16(v0[2], v0[3]); w.z = cvt_pk_bf16(v1[0], v1[1]); w.w = cvt_pk_bf16(v1[2], v1[3]); return w; }

__device__ __forceinline__ void unpack8(u32x4 w, f32x4& v0, f32x4& v1) {
    v0[0] = __uint_as_float(w.x << 16); v0[1] = __uint_as_float(w.x & 0xffff0000u); v0[2] = __uint_as_float(w.y << 16); v0[3] = __uint_as_float(w.y & 0xffff0000u);
    v1[0] = __uint_as_float(w.z << 16); v1[1] = __uint_as_float(w.z & 0xffff0000u); v1[2] = __uint_as_float(w.w << 16); v1[3] = __uint_as_float(w.w & 0xffff0000u);
}
struct EpiQKV { static constexpr bool PREP = true; bf16_t* QK; bf16_t* VT; const float* gq; const float* gk;
    __device__ __forceinline__ void prep(const Unit& u, LAS unsigned char* lds, int slot, int tid) const {
        if (u.kind == 0 && tid < 64) { const bool isq = u.pn < 4; ((LAS float*)(lds + 131072))[slot * 512 + tid] = isq ? gq[tid] * (0.125f * LOG2E) : gk[tid]; }
    }
    __device__ __forceinline__ void operator()(const Acc& acc, const Unit& u, int wr, int wc, int fr, int fq, LAS unsigned char* lds, int slot) const {
        if (u.kind == 0) {
            const LAS float* gp = (const LAS float*)(lds + 131072) + slot * 512;
            f32x4 gv[2][2];
#pragma unroll
            for (int bj = 0; bj < 2; ++bj)
#pragma unroll
                for (int n = 0; n < 2; ++n) gv[bj][n] = *(const LAS f32x4*)(gp + 32 * bj + 8 * fq + 4 * n);
#pragma unroll
            for (int ai = 0; ai < 2; ++ai)
#pragma unroll
                for (int m = 0; m < 4; ++m) {
                    const int row = u.pm * BM + ai * HALF + wr * 64 + m * 16 + fr;
                    float ss = 0.f;
#pragma unroll
                    for (int bj = 0; bj < 2; ++bj)
#pragma unroll
                        for (int n = 0; n < 2; ++n) { const f32x4 x = acc[ai][bj][m][n]; ss += (x[0] * x[0] + x[1] * x[1]) + (x[2] * x[2] + x[3] * x[3]); }
                    ss += __shfl_xor(ss, 16); ss += __shfl_xor(ss, 32);
                    const float rstd = rsqrtf(ss * (1.0f / 64.0f) + EPS);
                    bf16_t* rowp = QK + (size_t)row * 2048 + u.pn * 256 + wc * 64 + 8 * fq;
#pragma unroll
                    for (int bj = 0; bj < 2; ++bj) st16(rowp + 32 * bj, pack8(acc[ai][bj][m][0] * rstd * gv[bj][0], acc[ai][bj][m][1] * rstd * gv[bj][1]));
                }
        } else {
#pragma unroll
            for (int ai = 0; ai < 2; ++ai)
#pragma unroll
                for (int m = 0; m < 4; ++m) {
                    const int row = u.pm * BM + ai * HALF + wr * 64 + m * 16 + fr;
                    bf16_t* rowp = VT + (size_t)row * MT + u.pn * 256 + wc * 32 + 8 * fq;
#pragma unroll
                    for (int bj = 0; bj < 2; ++bj) st16(rowp + bj * HALF, pack8(acc[ai][bj][m][0], acc[ai][bj][m][1]));
                }
        }
    }
};
struct EpiRelu2 { static constexpr bool PREP = false; bf16_t* O; int ldc;
    __device__ __forceinline__ void operator()(const Acc& acc, const Unit& u, int wr, int wc, int fr, int fq, LAS unsigned char*, int) const {
#pragma unroll
        for (int ai = 0; ai < 2; ++ai)
#pragma unroll
            for (int m = 0; m < 4; ++m) {
                const int row = u.pm * BM + ai * HALF + wr * 64 + m * 16 + fr;
                bf16_t* rowp = O + (size_t)row * ldc + u.pn * 256 + wc * 32 + 8 * fq;
#pragma unroll
                for (int bj = 0; bj < 2; ++bj) { f32x4 v0 = acc[ai][bj][m][0], v1 = acc[ai][bj][m][1];
#pragma unroll
                    for (int e = 0; e < 4; ++e) { const float a = fmaxf(v0[e], 0.f), b = fmaxf(v1[e], 0.f); v0[e] = a * a; v1[e] = b * b; }
                    *(u32x4*)(rowp + bj * HALF) = pack8(v0, v1); }
            }
    }
};
struct EpiRes { static constexpr bool PREP = false; const bf16_t* base; float* out; const float* gate;
    __device__ __forceinline__ void operator()(const Acc& acc, const Unit& u, int wr, int wc, int fr, int fq, LAS unsigned char*, int) const {
        const int col0 = u.pn * 256 + wc * 32 + 8 * fq;
        const float* gp = gate + (size_t)(u.pm >> 4) * 6144 + col0;
        f32x4 gv[2][2];
#pragma unroll
        for (int bj = 0; bj < 2; ++bj)
#pragma unroll
            for (int n = 0; n < 2; ++n) gv[bj][n] = *(const f32x4*)(gp + bj * HALF + 4 * n);
#pragma unroll
        for (int ai = 0; ai < 2; ++ai)
#pragma unroll
          for (int mh = 0; mh < 2; ++mh) {
            u32x4 pre[2][2];
#pragma unroll
            for (int m2 = 0; m2 < 2; ++m2)
#pragma unroll
                for (int bj = 0; bj < 2; ++bj) pre[m2][bj] = __builtin_nontemporal_load((const u32x4*)(base + (size_t)(u.pm * BM + ai * HALF + wr * 64 + (2 * mh + m2) * 16 + fr) * 1024 + col0 + bj * HALF));
            asm volatile("" ::: "memory");
#pragma unroll
            for (int m2 = 0; m2 < 2; ++m2) { const int m = 2 * mh + m2;
                const size_t off = (size_t)(u.pm * BM + ai * HALF + wr * 64 + m * 16 + fr) * 1024 + col0;
#pragma unroll
                for (int bj = 0; bj < 2; ++bj) { f32x4 b0, b1; unpack8(pre[m2][bj], b0, b1);
                    *(f32x4*)(out + off + bj * HALF) = b0 + gv[bj][0] * acc[ai][bj][m][0]; *(f32x4*)(out + off + bj * HALF + 4) = b1 + gv[bj][1] * acc[ai][bj][m][1]; }
            }
            asm volatile("" ::: "memory");
          }
    }
};
struct EpiZ0 { static constexpr bool PREP = false; bf16_t* Z0;
    __device__ __forceinline__ void operator()(const Acc& acc, const Unit& u, int wr, int wc, int fr, int fq, LAS unsigned char*, int) const {
        const int ri = u.pm, t = u.pn, g = u.kind, b = u.aux;
        bf16_t* p0 = Z0 + ((size_t)(((b * 4 + g) * 256 + wr * 64 + fr) * 64 + 4 * t + (wc >> 1))) * 128 + ri * 64 + 32 * (wc & 1) + 8 * fq;
#pragma unroll
        for (int ai = 0; ai < 2; ++ai)
#pragma unroll
            for (int m = 0; m < 4; ++m) {
#pragma unroll
                for (int bj = 0; bj < 2; ++bj)
                    *(u32x4*)(p0 + (size_t)(ai * HALF + m * 16) * 8192 + bj * 256) = pack8(acc[ai][bj][m][0], acc[ai][bj][m][1]);
                asm volatile("" ::: "memory");
            }
    }
};

constexpr int AUX_OFF = 131072;
template <bool BASE16>
struct EpiResF { static constexpr bool PREP = false; const void* base; bf16_t* XS; const float* gate; const float* gm; bf16_t* XB; float* SSQ;
    __device__ __forceinline__ void operator()(const Acc& acc, const Unit& u, int wr, int wc, int fr, int fq, LAS unsigned char*, int) const {
        const int col0 = u.pn * 256 + wc * 32 + 8 * fq, b = u.pm >> 4;
        f32x4 gv[2][2], mv[2][2];
#pragma unroll
        for (int bj = 0; bj < 2; ++bj)
#pragma unroll
            for (int n = 0; n < 2; ++n) { gv[bj][n] = *(const f32x4*)(gate + (size_t)b * 6144 + col0 + bj * HALF + 4 * n); mv[bj][n] = *(const f32x4*)(gm + b * 1024 + col0 + bj * HALF + 4 * n); }
#pragma unroll
        for (int ai = 0; ai < 2; ++ai)
#pragma unroll
          for (int mh = 0; mh < 2; ++mh) {
            f32x4 pre[2][2][2];
#pragma unroll
            for (int m2 = 0; m2 < 2; ++m2) { const size_t off = (size_t)(u.pm * BM + ai * HALF + wr * 64 + (2 * mh + m2) * 16 + fr) * 1024 + col0;
#pragma unroll
                for (int bj = 0; bj < 2; ++bj) {
                    if (BASE16) { const u32x4 w = __builtin_nontemporal_load((const u32x4*)((const bf16_t*)base + off + bj * HALF)); unpack8(w, pre[m2][bj][0], pre[m2][bj][1]); }
                    else { pre[m2][bj][0] = __builtin_nontemporal_load((const f32x4*)((const float*)base + off + bj * HALF)); pre[m2][bj][1] = __builtin_nontemporal_load((const f32x4*)((const float*)base + off + bj * HALF + 4)); }
                } }
            asm volatile("" ::: "memory");
#pragma unroll
            for (int m2 = 0; m2 < 2; ++m2) {
                const int m = 2 * mh + m2;
                const int row = u.pm * BM + ai * HALF + wr * 64 + m * 16 + fr;
                const size_t off = (size_t)row * 1024 + col0;
                float ss = 0.f;
#pragma unroll
                for (int bj = 0; bj < 2; ++bj) {
                    const f32x4 v0 = pre[m2][bj][0] + gv[bj][0] * acc[ai][bj][m][0];
                    const f32x4 v1 = pre[m2][bj][1] + gv[bj][1] * acc[ai][bj][m][1];
                    st16(XS + off + bj * HALF, pack8(v0, v1));
                    ss += ((v0[0] * v0[0] + v0[1] * v0[1]) + (v0[2] * v0[2] + v0[3] * v0[3])) + ((v1[0] * v1[0] + v1[1] * v1[1]) + (v1[2] * v1[2] + v1[3] * v1[3]));
                    st16(XB + off + bj * HALF, pack8(v0 * mv[bj][0], v1 * mv[bj][1]));
                }
                ss += __shfl_xor(ss, 16); ss += __shfl_xor(ss, 32);
                if (fq == 0) SSQ[(size_t)row * 16 + u.pn * 4 + wc] = ss;
            }
            asm volatile("" ::: "memory");
          }
    }
};
__device__ __forceinline__ float ssq_rstd(const float* SSQ, int row, int half) {
    const f32x4 a = *(const f32x4*)(SSQ + (size_t)row * 16 + half * 8), b = *(const f32x4*)(SSQ + (size_t)row * 16 + half * 8 + 4);
    float s = ((a[0] + a[1]) + (a[2] + a[3])) + ((b[0] + b[1]) + (b[2] + b[3]));
    s += __shfl_xor(s, 1);
    return rsqrtf(s * (1.0f / 1024.0f) + EPS);
}
struct EpiRelu2F { static constexpr bool PREP = true; bf16_t* O; int ldc; const float* BV; const float* SSQ;
    __device__ __forceinline__ void prep(const Unit& u, LAS unsigned char* lds, int slot, int tid) const {
        const float r = ssq_rstd(SSQ, u.pm * BM + (tid >> 1), tid & 1);
        LAS float* aux = (LAS float*)(lds + AUX_OFF) + slot * 512;
        if (!(tid & 1)) aux[tid >> 1] = r;
        if (tid < 256) aux[256 + tid] = BV[(size_t)(u.pm >> 4) * 4096 + u.pn * 256 + tid];
    }
    __device__ __forceinline__ void operator()(const Acc& acc, const Unit& u, int wr, int wc, int fr, int fq, LAS unsigned char* lds, int slot) const {
        const LAS float* rt = (const LAS float*)(lds + AUX_OFF) + slot * 512;
        const int col0 = u.pn * 256 + wc * 32 + 8 * fq;
        f32x4 bv[2][2];
#pragma unroll
        for (int bj = 0; bj < 2; ++bj)
#pragma unroll
            for (int n = 0; n < 2; ++n) bv[bj][n] = *(const LAS f32x4*)(rt + 256 + wc * 32 + 8 * fq + bj * HALF + 4 * n);
#pragma unroll
        for (int ai = 0; ai < 2; ++ai)
#pragma unroll
            for (int m = 0; m < 4; ++m) {
                const int rl = ai * HALF + wr * 64 + m * 16 + fr; const float rs = rt[rl];
                bf16_t* rowp = O + ((size_t)(u.pm * 64 + u.pn * 4 + (wc >> 1)) * 256 + rl) * 64 + (wc & 1) * 32 + 8 * fq;
#pragma unroll
                for (int bj = 0; bj < 2; ++bj) { f32x4 v0 = acc[ai][bj][m][0] * rs + bv[bj][0], v1 = acc[ai][bj][m][1] * rs + bv[bj][1];
#pragma unroll
                    for (int e = 0; e < 4; ++e) { const float a = fmaxf(v0[e], 0.f), c2 = fmaxf(v1[e], 0.f); v0[e] = a * a; v1[e] = c2 * c2; }
                    st16(rowp + bj * 2 * 256 * 64, pack8(v0, v1)); }
            }
    }
};
constexpr int NCOL = 2064;
struct EpiZ0F { static constexpr bool PREP = true; bf16_t* Z0; const float* BVF; const float* SSQ;
    __device__ __forceinline__ void prep(const Unit& u, LAS unsigned char* lds, int slot, int tid) const {
        const int nl = tid >> 1, tok = u.aux * 4096 + 64 * (nl & 63) + 4 * u.pn + (nl >> 6);
        const float r = ssq_rstd(SSQ, tok, tid & 1);
        LAS float* aux = (LAS float*)(lds + AUX_OFF) + slot * 512;
        if (!(tid & 1)) aux[nl] = r;
        if (tid < 256) aux[256 + tid] = BVF[(size_t)(u.aux * 4 + u.kind) * 256 + tid];
    }
    __device__ __forceinline__ void operator()(const Acc& acc, const Unit& u, int wr, int wc, int fr, int fq, LAS unsigned char* lds, int slot) const {
        const LAS float* rt = (const LAS float*)(lds + AUX_OFF) + slot * 512;
        const int t = u.pn, g = u.kind, b = u.aux;
        f32x4 rs[2][2];
#pragma unroll
        for (int bj = 0; bj < 2; ++bj)
#pragma unroll
            for (int n = 0; n < 2; ++n) rs[bj][n] = *(const LAS f32x4*)(rt + bj * HALF + wc * 32 + 8 * fq + 4 * n);
        const LAS float* bz = rt + 256 + wr * 64 + fr;
        bf16_t* p0 = Z0 + ((size_t)(((b * 4 + g) * 128 + wr * 64 + fr) * 64 + 4 * t + (wc >> 1))) * 128 + 32 * (wc & 1) + 8 * fq;
        bf16_t* ps = Z0 + ((size_t)((2048 + b * 4 + g) * 64 + 4 * t + (wc >> 1))) * 128 + 32 * (wc & 1) + 8 * fq;
#pragma unroll
        for (int ai = 0; ai < 2; ++ai)
#pragma unroll
            for (int m = 0; m < 4; ++m) {
                const float bb = bz[ai * HALF + m * 16];
                const bool nyq = (ai == 1 && m == 0) && (wr == 0) && (fr == 0);
#pragma unroll
                for (int bj = 0; bj < 2; ++bj) {
                    const u32x4 v = pack8(acc[ai][bj][m][0] * rs[bj][0] + bb, acc[ai][bj][m][1] * rs[bj][1] + bb);
                    const u32x4 z = {0u, 0u, 0u, 0u};
                    st16(p0 + (size_t)(m * 16) * 8192 + ai * 64 + bj * 256, nyq ? z : v);
                    if (ai == 1 && m == 0) { if (nyq) { st16(ps + bj * 256, v); st16(ps + bj * 256 + 64, z); } }
                }
                asm volatile("" ::: "memory");
            }
    }
};
}


#define XB_TMO      128
#define XB_XCNT(j)  (256  + 64 * (j))
#define XB_XSUB(j)  (1280 + 64 * (j))
#define XB_XGEN(j)  (2304 + 64 * (j))
#define XB_TOP      3328
#define XB_TOPGEN   3392
#define XCD_BAR_WORDS 3456
#define XB_SPIN_CAP (1u << 18)
__device__ __forceinline__ unsigned xb_ld(unsigned* p)              { return __hip_atomic_load(p, __ATOMIC_RELAXED, __HIP_MEMORY_SCOPE_AGENT); }
__device__ __forceinline__ unsigned xb_add(unsigned* p, unsigned v) { return __hip_atomic_fetch_add(p, v, __ATOMIC_RELAXED, __HIP_MEMORY_SCOPE_AGENT); }
__device__ __forceinline__ unsigned xb_xcc_id() { return (unsigned)__builtin_amdgcn_s_getreg((3 << 11) | 20) & 0xFu; }
#define XB_SPIN(cond, bar) do { unsigned _sp = 0; while (cond) { __builtin_amdgcn_s_sleep(1); \
    if ((++_sp & 255u) == 0u) { if (xb_ld(&(bar)[XB_TMO])) break; if (_sp > XB_SPIN_CAP) { atomicAdd(&(bar)[XB_TMO], 1u); break; } } } } while (0)
struct XcdBarrier { unsigned* bar; unsigned x; volatile LAS unsigned* st; };
__device__ __forceinline__ XcdBarrier xcd_barrier_post(unsigned* bar, volatile LAS unsigned* st) {
    XcdBarrier b; b.bar = bar; b.x = xb_xcc_id(); b.st = st;
    if (threadIdx.x == 0) (void)xb_add(&bar[XB_XCNT(b.x)], 1u);
    return b;
}
__device__ __forceinline__ void xcd_barrier_complete(unsigned* bar, unsigned x, unsigned& nloc, unsigned& nx) {
    const unsigned G = gridDim.x * gridDim.y * gridDim.z;
    unsigned sum, cnt, mine, sp = 0u;
    for (;;) {
        sum = 0u; cnt = 0u; mine = 0u;
#pragma unroll
        for (unsigned j = 0; j < 16; ++j) { const unsigned c = xb_ld(&bar[XB_XCNT(j)]); sum += c; cnt += (c > 0u) ? 1u : 0u; mine = (j == x) ? c : mine; }
        if (sum == G) break;
        __builtin_amdgcn_s_sleep(1);
        if ((++sp & 255u) == 0u) { if (xb_ld(&bar[XB_TMO])) break; if (sp > XB_SPIN_CAP) { atomicAdd(&bar[XB_TMO], 1u); break; } }
    }
    nloc = mine > 0u ? mine : 1u; nx = cnt > 0u ? cnt : 1u;
}
__device__ __forceinline__ void xcd_barrier(const XcdBarrier& b) {
    asm volatile("s_waitcnt vmcnt(0)" ::: "memory");
    __syncthreads();
    if (threadIdx.x == 0) {
        unsigned* bar = b.bar;
        __builtin_amdgcn_s_waitcnt(0);
        unsigned nloc = b.st[0], nx = b.st[1];
        if (nloc == 0u) { xcd_barrier_complete(bar, b.x, nloc, nx); b.st[0] = nloc; b.st[1] = nx; }
        const unsigned old = xb_add(&bar[XB_XSUB(b.x)], 1u);
        const unsigned gen = old / nloc;
        if (old + 1u == (gen + 1u) * nloc) {
            __builtin_amdgcn_fence(__ATOMIC_RELEASE, "agent");
            asm volatile("s_waitcnt vmcnt(0)" ::: "memory");
            const unsigned og = xb_add(&bar[XB_TOP], 1u);
            const unsigned tg = og / nx;
            if (og + 1u == (tg + 1u) * nx) xb_add(&bar[XB_TOPGEN], 1u);
            else XB_SPIN(xb_ld(&bar[XB_TOPGEN]) == tg, bar);
            __builtin_amdgcn_fence(__ATOMIC_ACQUIRE, "agent");
            xb_add(&bar[XB_XGEN(b.x)], 1u);
            asm volatile("s_waitcnt vmcnt(0)" ::: "memory");
        } else {
            XB_SPIN(xb_ld(&bar[XB_XGEN(b.x)]) == gen, bar);
            __builtin_amdgcn_fence(__ATOMIC_ACQUIRE, "agent");
            asm volatile("s_waitcnt vmcnt(0)" ::: "memory");
        }
    }
    __syncthreads();
}
__device__ __forceinline__ void p0_mods_unit(const float* c, const float* cctx, const float* ada_w, const float* ada_b, float* mods, LAS unsigned char* lds, int unit) {
    LAS float* s = (LAS float*)lds;
    LAS float* red = s + 5 * 1024;
    int tid = threadIdx.x; asm volatile("" : "+v"(tid));
    for (int i = tid; i < 5 * 1024; i += 512) { const int v = i >> 10, k = i & 1023; const float x = v < 4 ? c[v * 1024 + k] : cctx[k]; s[i] = x / (1.0f + __expf(-x)); }
    __syncthreads();
    const int l = unit / 96, col0 = (unit % 96) * 64, kc = tid >> 6, cl = tid & 63;
    const float* w = ada_w + (size_t)l * 1024 * 6144 + col0 + cl;
    float a0 = 0.f, a1 = 0.f, a2 = 0.f, a3 = 0.f, a4 = 0.f;
    for (int k = kc * 128; k < kc * 128 + 128; k += 32) {
        float wv[32];
#pragma unroll
        for (int j = 0; j < 32; ++j) wv[j] = __builtin_nontemporal_load(w + (size_t)(k + j) * 6144);
#pragma unroll
        for (int j = 0; j < 32; ++j) { a0 += s[k + j] * wv[j]; a1 += s[1024 + k + j] * wv[j]; a2 += s[2048 + k + j] * wv[j]; a3 += s[3072 + k + j] * wv[j]; a4 += s[4096 + k + j] * wv[j]; }
    }
    red[(kc * 5 + 0) * 64 + cl] = a0; red[(kc * 5 + 1) * 64 + cl] = a1; red[(kc * 5 + 2) * 64 + cl] = a2; red[(kc * 5 + 3) * 64 + cl] = a3; red[(kc * 5 + 4) * 64 + cl] = a4;
    __syncthreads();
    if (tid < 320) { const int v = tid >> 6, cc = tid & 63; float t = 0.f;
#pragma unroll
        for (int kk = 0; kk < 8; ++kk) t += red[(kk * 5 + v) * 64 + cc];
        mods[(size_t)(l * 5 + v) * 6144 + col0 + cc] = t + ada_b[l * 6144 + col0 + cc]; }
    __syncthreads();
}

__device__ __forceinline__ void p0_transpose_item(const float* W, int K, int N, bf16_t* WT, bf16_t* WT2, int mode, LAS float* scr, int item, int lane) {
    const int nblk = N / 32, kb = item / nblk, nb = item % nblk, k0 = 64 * kb, n0 = 32 * nb;
    float wv_[32];
#pragma unroll
    for (int i = 0; i < 32; ++i) { int srow = k0 + 2 * i + (lane >> 5);
        if (mode == 2) { const int j = srow & 255; if (j > 128) srow = (srow & ~255) + 256 - (j - 128); }
        wv_[i] = __builtin_nontemporal_load(W + (size_t)srow * N + n0 + (lane & 31)); }
#pragma unroll
    for (int i = 0; i < 32; ++i) scr[(2 * i + (lane >> 5)) * 33 + (lane & 31)] = wv_[i];
    asm volatile("s_waitcnt lgkmcnt(0)" ::: "memory");
    const int cch = lane & 7;
#pragma unroll
    for (int j = 0; j < 4; ++j) { const int n = (lane >> 3) + 8 * j; const LAS float* s = scr + (8 * cch) * 33 + n;
        u32x4 o; o.x = cvt_pk_bf16(s[0 * 33], s[1 * 33]); o.y = cvt_pk_bf16(s[2 * 33], s[3 * 33]); o.z = cvt_pk_bf16(s[4 * 33], s[5 * 33]); o.w = cvt_pk_bf16(s[6 * 33], s[7 * 33]);
        const int ng = n0 + n; bf16_t* dst;
        if (mode != 1) dst = WT + (size_t)ng * K;
        else if (ng < 2048) { const int pn = ng >> 8, hh = (ng >> 6) & 3, d = ng & 63; const int tpos = (d >> 5) * 128 + hh * 32 + (d & 31); dst = WT + (size_t)(pn * 256 + tpos) * K; }
        else dst = WT2 + (size_t)(ng - 2048) * K;
        *(u32x4*)(dst + k0 + 8 * cch) = o; }
    asm volatile("s_waitcnt lgkmcnt(0)" ::: "memory");
}

__device__ __forceinline__ float wave_sum(float v) {
#pragma unroll
    for (int o = 1; o < 64; o <<= 1) v += __shfl_xor(v, o);
    return v;
}
__device__ __forceinline__ void norm_rows(const float* xlat, const float* xctx, int nrows, const float* g, const float* modsl, int sh_off, int sc_off, bf16_t* H, int gw, int NGW, int lane) {
    f32x4 gv[4];
#pragma unroll
    for (int j = 0; j < 4; ++j) gv[j] = *(const f32x4*)(g + lane * 4 + 256 * j);
    for (int row = gw; row < nrows; row += NGW) {
        const float* src = row < ML ? xlat + (size_t)row * 1024 : xctx + (size_t)(row - ML) * 1024;
        const int v = row < ML ? (row >> 12) : 4;
        const float* mp = modsl + (size_t)v * 6144;
        f32x4 x[4]; float ss = 0.f;
#pragma unroll
        for (int j = 0; j < 4; ++j) { x[j] = __builtin_nontemporal_load((const f32x4*)(src + lane * 4 + 256 * j)); ss += (x[j][0] * x[j][0] + x[j][1] * x[j][1]) + (x[j][2] * x[j][2] + x[j][3] * x[j][3]); }
        const float rstd = rsqrtf(wave_sum(ss) * (1.0f / 1024.0f) + EPS);
#pragma unroll
        for (int j = 0; j < 4; ++j) {
            const f32x4 sh = *(const f32x4*)(mp + sh_off + lane * 4 + 256 * j), sc = *(const f32x4*)(mp + sc_off + lane * 4 + 256 * j);
            const f32x4 y = (x[j] * rstd * gv[j]) * (sc + 1.0f) + sh;
            u32x2 w; w.x = cvt_pk_bf16(y[0], y[1]); w.y = cvt_pk_bf16(y[2], y[3]);
            *(u32x2*)(H + (size_t)row * 1024 + lane * 4 + 256 * j) = w;
        }
    }
}


__device__ __forceinline__ void norm_rows_lds(const float* xlat, const float* xctx, int nrows, const float* g, const float* modsl, bf16_t* H, int gw, int NGW, int lane, int tid, LAS unsigned char* lds) {
    LAS float* tab = (LAS float*)lds;
    for (int i = tid; i < 5 * 1024; i += 512) { const int v = i >> 10, k = i & 1023; tab[(v * 2) * 1024 + k] = g[k] * (1.0f + modsl[(size_t)v * 6144 + 1024 + k]); tab[(v * 2 + 1) * 1024 + k] = modsl[(size_t)v * 6144 + k]; }
    __syncthreads();
    for (int row = gw; row < nrows; row += NGW) {
        const float* src = row < ML ? xlat + (size_t)row * 1024 : xctx + (size_t)(row - ML) * 1024;
        const int v = row < ML ? (row >> 12) : 4;
        f32x4 x[4]; float ss = 0.f;
#pragma unroll
        for (int j = 0; j < 4; ++j) { x[j] = __builtin_nontemporal_load((const f32x4*)(src + lane * 4 + 256 * j)); ss += (x[j][0] * x[j][0] + x[j][1] * x[j][1]) + (x[j][2] * x[j][2] + x[j][3] * x[j][3]); }
        const float rstd = rsqrtf(wave_sum(ss) * (1.0f / 1024.0f) + EPS);
#pragma unroll
        for (int j = 0; j < 4; ++j) {
            const f32x4 gs = *(const LAS f32x4*)(tab + (v * 2) * 1024 + lane * 4 + 256 * j), sh = *(const LAS f32x4*)(tab + (v * 2 + 1) * 1024 + lane * 4 + 256 * j);
            const f32x4 y = (x[j] * rstd) * gs + sh;
            u32x2 w; w.x = cvt_pk_bf16(y[0], y[1]); w.y = cvt_pk_bf16(y[2], y[3]);
            *(u32x2*)(H + (size_t)row * 1024 + lane * 4 + 256 * j) = w;
        }
    }
    __syncthreads();
}
__device__ __forceinline__ void bias_items(const bf16_t* W1t, const bf16_t* CS, const float* mods, float* BV0, float* BV1, float* BVF, int w, int NW, int lane) {
    for (int it = w; it < 8192 + 1024; it += NW) {
        float a0 = 0.f, a1 = 0.f, a2 = 0.f, a3 = 0.f; float* dst; int dstride;
        if (it < 8192) {
            const int l = it >> 12, n = it & 4095;
            const bf16_t* wr_ = W1t + (size_t)l * 4096 * 1024 + (size_t)n * 1024 + lane * 16;
            const u32x4 w0 = *(const u32x4*)wr_, w1 = *(const u32x4*)(wr_ + 8);
            const float* sh = mods + (size_t)l * 5 * 6144 + 3072 + lane * 16;
            float wf[16];
#pragma unroll
            for (int e = 0; e < 4; ++e) { wf[2 * e] = __uint_as_float(w0[e] << 16); wf[2 * e + 1] = __uint_as_float(w0[e] & 0xffff0000u); wf[8 + 2 * e] = __uint_as_float(w1[e] << 16); wf[8 + 2 * e + 1] = __uint_as_float(w1[e] & 0xffff0000u); }
#pragma unroll
            for (int q = 0; q < 4; ++q) {
                const f32x4 s0 = *(const f32x4*)(sh + 4 * q), s1 = *(const f32x4*)(sh + 6144 + 4 * q), s2 = *(const f32x4*)(sh + 2 * 6144 + 4 * q), s3 = *(const f32x4*)(sh + 3 * 6144 + 4 * q);
#pragma unroll
                for (int e = 0; e < 4; ++e) { a0 += s0[e] * wf[4 * q + e]; a1 += s1[e] * wf[4 * q + e]; a2 += s2[e] * wf[4 * q + e]; a3 += s3[e] * wf[4 * q + e]; }
            }
            dst = (l == 0 ? BV0 : BV1) + n; dstride = 4096;
        } else {
            const int idx = it - 8192, g = idx >> 8, m = idx & 255;
            const u32x2 w0 = *(const u32x2*)(CS + (size_t)m * 256 + lane * 4);
            const float wf0 = __uint_as_float(w0[0] << 16), wf1 = __uint_as_float(w0[0] & 0xffff0000u), wf2 = __uint_as_float(w0[1] << 16), wf3 = __uint_as_float(w0[1] & 0xffff0000u);
            const float* sh = mods + (size_t)5 * 6144 + g * 256 + lane * 4;
            const f32x4 s0 = *(const f32x4*)(sh), s1 = *(const f32x4*)(sh + 6144), s2 = *(const f32x4*)(sh + 2 * 6144), s3 = *(const f32x4*)(sh + 3 * 6144);
            a0 = s0[0] * wf0 + s0[1] * wf1 + s0[2] * wf2 + s0[3] * wf3; a1 = s1[0] * wf0 + s1[1] * wf1 + s1[2] * wf2 + s1[3] * wf3;
            a2 = s2[0] * wf0 + s2[1] * wf1 + s2[2] * wf2 + s2[3] * wf3; a3 = s3[0] * wf0 + s3[1] * wf1 + s3[2] * wf2 + s3[3] * wf3;
            dst = BVF + g * 256 + m; dstride = 1024;
        }
        a0 = wave_sum(a0); a1 = wave_sum(a1); a2 = wave_sum(a2); a3 = wave_sum(a3);
        if (lane == 0) { dst[0] = a0; dst[dstride] = a1; dst[2 * dstride] = a2; dst[3 * dstride] = a3; }
    }
}
template <bool MASKED>
__device__ __forceinline__ void attn_block(const LAS bf16_t* Ks, const LAS bf16_t* Vs, int kcol0, int fr, int g, const bf16x8 (&Qf)[2], f32x4 (&acc)[4], float& lsum,
                                           const LAS unsigned char* rpb_base  , const int (&dcb)[8], const f32x4& ciX, const f32x4& ciY) {
    bf16x8 KX[2], KY[2];
#pragma unroll
    for (int kk = 0; kk < 2; ++kk) { KX[kk] = *(const LAS bf16x8*)(Ks + (kcol0 + fr) * 72 + kk * 32 + g * 8); KY[kk] = *(const LAS bf16x8*)(Ks + (kcol0 + 16 + fr) * 72 + kk * 32 + g * 8); }
    s16x4 VX[4], VY[4];
#pragma unroll
    for (int db = 0; db < 4; ++db) { VX[db] = *(const LAS s16x4*)(Vs + (16 * db + fr) * 72 + kcol0 + 4 * g); VY[db] = *(const LAS s16x4*)(Vs + (16 * db + fr) * 72 + kcol0 + 16 + 4 * g); }
    f32x4 sX = mfma16(KX[0], Qf[0], ciX); sX = mfma16(KX[1], Qf[1], sX);
    f32x4 sY = mfma16(KY[0], Qf[0], ciY); sY = mfma16(KY[1], Qf[1], sY);
    f32x4 pX, pY;
    if (MASKED) {
#pragma unroll
        for (int ii = 0; ii < 4; ++ii) {
            const float bx = *(const LAS float*)(rpb_base + dcb[ii]), by = *(const LAS float*)(rpb_base + dcb[4 + ii]);
            pX[ii] = __builtin_amdgcn_exp2f(sX[ii] + bx);
            pY[ii] = __builtin_amdgcn_exp2f(sY[ii] + by);
        }
    } else {
#pragma unroll
        for (int ii = 0; ii < 4; ++ii) { pX[ii] = __builtin_amdgcn_exp2f(sX[ii]); pY[ii] = __builtin_amdgcn_exp2f(sY[ii]); }
    }
    lsum += ((pX[0] + pX[1]) + (pX[2] + pX[3])) + ((pY[0] + pY[1]) + (pY[2] + pY[3]));
    const u32x4 pw = pg8::pack8(pX, pY);
    const bf16x8 Pf = __builtin_bit_cast(bf16x8, pw);
#pragma unroll
    for (int db = 0; db < 4; ++db) {
        bf16x8 Vf; Vf[0] = VX[db][0]; Vf[1] = VX[db][1]; Vf[2] = VX[db][2]; Vf[3] = VX[db][3]; Vf[4] = VY[db][0]; Vf[5] = VY[db][1]; Vf[6] = VY[db][2]; Vf[7] = VY[db][3];
        acc[db] = mfma16(Vf, Pf, acc[db]);
    }
}
__device__ __forceinline__ void attn_phase(const bf16_t* QK, const bf16_t* VT, bf16_t* O, const float* rpb, const float* sbound, LAS unsigned char* lds, int G, int c) {
    constexpr int RP_BYTES = 30720, TILE_B = 64 * 72 * 2, PAIR_B = 4 * TILE_B, NPAIR = 7;
    LAS float* rp = (LAS float*)lds;
    int tid = threadIdx.x; asm volatile("" : "+v"(tid));
    const int lane = tid & 63, wid = __builtin_amdgcn_readfirstlane(tid >> 6), fr = lane & 15, g = lane >> 4;
    for (int i = tid; i < 16 * 465; i += 512) rp[i] = rpb[i] * LOG2E;
    const float Mb = *sbound;
    const int nunits = (2048 - c + G - 1) / G;
    const int ND = nunits * NPAIR;
    const int trow = tid >> 3, tch = tid & 7;
    const int ldsoff = (trow * 72 + tch * 8) * 2;
#define ATT_DEC(L_, b_, h_, rp_) do { const int x_ = (L_) & 7, q_ = (L_) >> 3; rp_ = q_ & 31; const int bh_ = 8 * (q_ >> 5) + x_; b_ = bh_ >> 4; h_ = bh_ & 15; } while (0)
#define ATT_TOK(b_, rs0_, t_) ((t_) < 9 ? (b_) * 4096 + min((rs0_) + (t_), 63) * 64 : ML + (b_) * 256 + 64 * (min((t_), 12) - 9))
#define ATT_GLOAD(D_, R) do { const int u_ = (D_) / NPAIR, p_ = (D_) - u_ * NPAIR; int b_, h_, rp_; ATT_DEC(u_ * G + c, b_, h_, rp_); \
        const int rs0_ = min(max(2 * rp_ - 4, 0), 56); const int tk0_ = ATT_TOK(b_, rs0_, 2 * p_), tk1_ = ATT_TOK(b_, rs0_, 2 * p_ + 1); \
        const bf16_t* kb_ = QK + (size_t)trow * 2048 + 1024 + h_ * 64 + tch * 8; const bf16_t* vb_ = VT + (size_t)(h_ * 64 + trow) * MT + tch * 8; \
        R[0] = *(const u32x4*)(kb_ + (size_t)tk0_ * 2048); R[1] = *(const u32x4*)(vb_ + tk0_); R[2] = *(const u32x4*)(kb_ + (size_t)tk1_ * 2048); R[3] = *(const u32x4*)(vb_ + tk1_); } while (0)
#define ATT_LWRITE(slot_, R) do { _Pragma("unroll") for (int q_ = 0; q_ < 4; ++q_) *(LAS u32x4*)(lds + RP_BYTES + (slot_) * PAIR_B + q_ * TILE_B + ldsoff) = R[q_]; } while (0)
    u32x4 R0[4], R1[4];
    ATT_GLOAD(0, R0); ATT_LWRITE(0, R0);
    if (ND > 1) ATT_GLOAD(1, R1);
    if (ND > 2) ATT_GLOAD(2, R0);
    __syncthreads();
    int b = 0, h = 0, rpair = 0, r = 0, rs0 = 0, rsr = 0, qrow = 0;
    const int j = wid & 3, w0 = (j == 0) ? 0 : (j == 1) ? 8 : (j == 2) ? 24 : 32;
    int dcb[8]; f32x4 ciX, ciY, ciU;
    {
        const int cq = 16 * j + fr, cs = min(max(cq - 8, 0), 48), eX = w0 + 4 * g - cs, dX = w0 + 4 * g - cq + 15;
#pragma unroll
        for (int ii = 0; ii < 4; ++ii) {
            dcb[ii] = 4 * min(max(dX + ii, 0), 30); dcb[4 + ii] = 4 * min(max(dX + 16 + ii, 0), 30);
            ciX[ii] = ((unsigned)(eX + ii) < 16u) ? -Mb : -1.0e30f; ciY[ii] = ((unsigned)(eX + 16 + ii) < 16u) ? -Mb : -1.0e30f; ciU[ii] = -Mb;
        }
    }
    bf16x8 Qf[2], Qn[2]; f32x4 acc[4]; float lsum = 0.f;
    int p = 0, u = 0, D = 0;
#define ATT_QLOAD(dst, uu) do { int b_, h_, rp_; ATT_DEC((uu) * G + c, b_, h_, rp_); const int qr_ = b_ * 4096 + (2 * rp_ + (wid >> 2)) * 64 + 16 * j + fr; \
        _Pragma("unroll") for (int kk = 0; kk < 2; ++kk) dst[kk] = *(const bf16x8*)(QK + (size_t)qr_ * 2048 + h_ * 64 + 32 * kk + 8 * g); } while (0)
#define ATT_TILE(t_, toff_) do { \
        const LAS bf16_t* Ks = (const LAS bf16_t*)(lds + RP_BYTES + slot * PAIR_B + (toff_)); \
        const LAS bf16_t* Vs = (const LAS bf16_t*)(lds + RP_BYTES + slot * PAIR_B + (toff_) + TILE_B); \
        if ((t_) < 9) { \
            const int kr = rs0 + (t_), i = kr - rsr; \
            if (i >= 0 && i < 8) attn_block<true>(Ks, Vs, w0, fr, g, Qf, acc, lsum, (const LAS unsigned char*)rp + (h * 465 + (kr - r + 7) * 31) * 4, dcb, ciX, ciY); \
        } else if ((t_) < 13) { \
            attn_block<false>(Ks, Vs, 0, fr, g, Qf, acc, lsum, (const LAS unsigned char*)rp, dcb, ciU, ciU); \
            attn_block<false>(Ks, Vs, 32, fr, g, Qf, acc, lsum, (const LAS unsigned char*)rp, dcb, ciU, ciU); \
        } } while (0)
    ATT_QLOAD(Qn, 0);
#define ATT_ITER(R) do { \
        const int slot = D & 1; \
        if (D + 1 < ND) ATT_LWRITE(slot ^ 1, R); \
        if (D + 3 < ND) ATT_GLOAD(D + 3, R); \
        if (p == 0) { \
            ATT_DEC(u * G + c, b, h, rpair); \
            r = 2 * rpair + (wid >> 2); rs0 = min(max(2 * rpair - 4, 0), 56); rsr = min(max(r - 4, 0), 56); \
            qrow = b * 4096 + r * 64 + 16 * j + fr; \
            Qf[0] = Qn[0]; Qf[1] = Qn[1]; \
            _Pragma("unroll") for (int db = 0; db < 4; ++db) acc[db] = (f32x4){0.f, 0.f, 0.f, 0.f}; \
            lsum = 0.f; \
        } \
        if (p == 4 && u + 1 < nunits) ATT_QLOAD(Qn, u + 1); \
        { const int i0_ = rs0 + 2 * p - rsr, i1_ = i0_ + 1; \
          if (2 * p + 1 < 9 && i0_ >= 0 && i1_ < 8) {        \
            const LAS bf16_t* Ka = (const LAS bf16_t*)(lds + RP_BYTES + slot * PAIR_B); const LAS bf16_t* Va = (const LAS bf16_t*)(lds + RP_BYTES + slot * PAIR_B + TILE_B); \
            const LAS bf16_t* Kb = (const LAS bf16_t*)(lds + RP_BYTES + slot * PAIR_B + 2 * TILE_B); const LAS bf16_t* Vb = (const LAS bf16_t*)(lds + RP_BYTES + slot * PAIR_B + 3 * TILE_B); \
            const LAS unsigned char* rb_ = (const LAS unsigned char*)rp + (h * 465 + (rs0 + 2 * p - r + 7) * 31) * 4; \
            attn_block<true>(Ka, Va, w0, fr, g, Qf, acc, lsum, rb_, dcb, ciX, ciY); \
            attn_block<true>(Kb, Vb, w0, fr, g, Qf, acc, lsum, rb_ + 124, dcb, ciX, ciY); \
          } else { ATT_TILE(2 * p, 0); ATT_TILE(2 * p + 1, 2 * TILE_B); } } \
        if (p == NPAIR - 1) { \
            float ls = lsum; ls += __shfl_xor(ls, 16); ls += __shfl_xor(ls, 32); \
            const float inv = 1.0f / ls; \
            bf16_t* op = O + (size_t)qrow * 1024 + h * 64 + 4 * g; \
            _Pragma("unroll") for (int db = 0; db < 4; ++db) { u32x2 w; w.x = cvt_pk_bf16(acc[db][0] * inv, acc[db][1] * inv); w.y = cvt_pk_bf16(acc[db][2] * inv, acc[db][3] * inv); st8(op + 16 * db, w); } \
            p = 0; ++u; \
        } else ++p; \
        __syncthreads(); \
    } while (0)
    for (;;) {
        ATT_ITER(R1); if (++D >= ND) break;
        ATT_ITER(R0); if (++D >= ND) break;
    }
#undef ATT_ITER
#undef ATT_TILE
#undef ATT_QLOAD
#undef ATT_DEC
#undef ATT_TOK
#undef ATT_GLOAD
#undef ATT_LWRITE
}

__device__ __forceinline__ void s1_phase(const bf16_t* Z0, const bf16_t* Dg, bf16_t* Z1, LAS unsigned char* lds, int gw, int NGW) {
    constexpr int DP = 136;
    LAS bf16_t* Dl = (LAS bf16_t*)lds;
    int tid = threadIdx.x; asm volatile("" : "+v"(tid));
    const int lane = tid & 63, fr = lane & 15, g = lane >> 4;
    for (int i = tid; i < 128 * 16; i += 512) { const int row = i >> 4, ch = i & 15; *(LAS u32x4*)(Dl + row * DP + ch * 8) = *(const u32x4*)(Dg + row * 128 + ch * 8); }
    __syncthreads();
    for (int job = gw; job < 2048 + 64; job += NGW) {
        const bool part = job >= 2048;
        const int colM = part ? 2048 + ((job - 2048) >> 2) : job, ib0 = part ? ((job - 2048) & 3) : 0, nib = part ? 1 : 4;
        bf16x8 A[4][4];
#pragma unroll
        for (int ib = 0; ib < 4; ++ib) { const int ibr = part ? ib0 : ib;
#pragma unroll
            for (int kb = 0; kb < 4; ++kb) A[ib][kb] = *(const bf16x8*)(Z0 + ((size_t)colM * 64 + 16 * ibr + fr) * 128 + 32 * kb + 8 * g); }
#pragma unroll 2
        for (int jb = 0; jb < 8; ++jb) {
            bf16x8 Bf[4];
#pragma unroll
            for (int kb = 0; kb < 4; ++kb) Bf[kb] = *(const LAS bf16x8*)(Dl + (16 * jb + fr) * DP + 32 * kb + 8 * g);
            const int n = 16 * jb + fr, ka = n >> 1, rip = n & 1;
#pragma unroll
            for (int ib = 0; ib < 4; ++ib) {
                if (ib < nib) {
                    f32x4 a = (f32x4){0.f, 0.f, 0.f, 0.f};
#pragma unroll
                    for (int kb = 0; kb < 4; ++kb) a = mfma16(A[ib][kb], Bf[kb], a);
                    u32x2 w; w.x = cvt_pk_bf16(a[0], a[1]); w.y = cvt_pk_bf16(a[2], a[3]);
                    st8(Z1 + (((size_t)ka * pg8::NCOL + colM) * 2 + rip) * 64 + 16 * (part ? ib0 : ib) + 4 * g, w);
                }
            }
        }
    }
    __syncthreads();
}
__device__ __forceinline__ void s2_phase(const bf16_t* Z1, const bf16_t* Eg, bf16_t* F, LAS unsigned char* lds, int G, int c) {
    constexpr int EP = 136;
    LAS bf16_t* El = (LAS bf16_t*)lds;
    int tid = threadIdx.x; asm volatile("" : "+v"(tid));
    const int lane = tid & 63, wid = __builtin_amdgcn_readfirstlane(tid >> 6), fr = lane & 15, g = lane >> 4;
    for (int wgi = c; wgi < 256; wgi += G) {
        const int ka = wgi & 63, part = wgi >> 6;
        for (int i = tid; i < 64 * 16; i += 512) { const int row = i >> 4, ch = i & 15; *(LAS u32x4*)(El + row * EP + ch * 8) = *(const u32x4*)(Eg + ((size_t)ka * 64 + row) * 128 + ch * 8); }
        __syncthreads();
        bf16x8 Bf[4][4];
#pragma unroll
        for (int jb = 0; jb < 4; ++jb)
#pragma unroll
            for (int kb = 0; kb < 4; ++kb) Bf[jb][kb] = *(const LAS bf16x8*)(El + (16 * jb + fr) * EP + 32 * kb + 8 * g);
        const int nrun = (part == 0 && wid == 0) ? 2 : 1;
        for (int run = 0; run < nrun; ++run) {
            const bool special = run == 1;
            const int q = part * 8 + wid, bg = q >> 1, ib0 = special ? 0 : 4 * (q & 1), nib = special ? 1 : 4;
            for (int ibb = 0; ibb < nib; ++ibb) {
                const int ib = ib0 + ibb;
                const int colM0 = special ? 2048 : bg * 128 + ib * 16;
                bf16x8 A[4];
#pragma unroll
                for (int kb = 0; kb < 4; ++kb) A[kb] = *(const bf16x8*)(Z1 + ((size_t)ka * pg8::NCOL + colM0 + fr) * 128 + 32 * kb + 8 * g);
                const int k2 = ib * 16 + 4 * g, b = bg >> 2, gg = bg & 3;
#pragma unroll
                for (int jb = 0; jb < 4; ++jb) {
                    f32x4 a = (f32x4){0.f, 0.f, 0.f, 0.f};
#pragma unroll
                    for (int kb = 0; kb < 4; ++kb) a = mfma16(A[kb], Bf[jb][kb], a);
                    const int k = ka + 64 * (16 * jb + fr), km = (4096 - k) & 4095;
                    u32x2 w; w.x = cvt_pk_bf16(a[0], a[1]); w.y = cvt_pk_bf16(a[2], a[3]);
                    if (!special) {
                        st8(F + ((size_t)b * 4096 + k) * 1024 + gg * 256 + k2, w);
                        bf16_t* pm_ = F + ((size_t)b * 4096 + km) * 1024 + gg * 256 + 128 + k2;
                        if (k2 != 0) st8(pm_, w);
                        else { pm_[1] = (bf16_t)(w.x >> 16); *(unsigned*)(pm_ + 2) = w.y; }
                    } else {
                        bf16_t* ps_ = F + ((size_t)g * 4096 + k) * 1024 + 128;
                        ps_[0] = (bf16_t)(w.x & 0xffffu); ps_[256] = (bf16_t)(w.x >> 16); ps_[512] = (bf16_t)(w.y & 0xffffu); ps_[768] = (bf16_t)(w.y >> 16);
                    }
                }
            }
        }
        __syncthreads();
    }
}


#ifndef MK_DEBUG
#define MK_DEBUG 0
#endif
__device__ __forceinline__ void dbg_scan16(const bf16_t* p, size_t n, unsigned* flags, unsigned bit, int gt, int NT) {
    bool bad = false; for (size_t i = gt; i < n; i += NT) bad |= ((p[i] & 0x7f80u) == 0x7f80u);
    if (bad) atomicOr(flags, 1u << bit);
}
__device__ __forceinline__ void dbg_scan32(const float* p, size_t n, unsigned* flags, unsigned bit, int gt, int NT) {
    bool bad = false; for (size_t i = gt; i < n; i += NT) bad |= ((__float_as_uint(p[i]) & 0x7f800000u) == 0x7f800000u);
    if (bad) atomicOr(flags, 1u << bit);
}
struct Args { const float* in[15]; float* out; unsigned char* ws; int ph_lo, ph_hi, use_cg, pad; };
static_assert(sizeof(Args) == 15 * 8 + 8 + 8 + 16, "no padding");

__global__ void __launch_bounds__(512, 2) fwd_kernel(Args args) {
    extern __shared__ __attribute__((aligned(16))) unsigned char lds_raw[];
    LAS unsigned char* lds = (LAS unsigned char*)lds_raw;
    const int G = gridDim.x, c = blockIdx.x;
    const int vcu = (G % 8 == 0) ? (c % 8) * (G / 8) + c / 8 : c;
    const int NGW = G * 8;
#define PHASE_IDS int tid_ = threadIdx.x; asm volatile("" : "+v"(tid_)); const int lane = tid_ & 63, wid = __builtin_amdgcn_readfirstlane(tid_ >> 6); const int gw = vcu * 8 + wid; (void)lane; (void)gw
    unsigned char* ws = args.ws;
    const float* x = args.in[0]; const float* cvec = args.in[1]; const float* ctx = args.in[2]; const float* cctx = args.in[3];
    const float* ada_w = args.in[4]; const float* ada_b = args.in[5]; const float* norm_g = args.in[6];
    const float* wqkv = args.in[7]; const float* wo = args.in[8]; const float* gq = args.in[9]; const float* gk = args.in[10]; const float* rpb = args.in[11];
    const float* fw = args.in[12]; const float* w1 = args.in[13]; const float* w2 = args.in[14];
    float* out = args.out;
    float* mods = (float*)(ws + WS_MODS); float* sbound = (float*)(ws + WS_SB);
    bf16_t* CS = (bf16_t*)(ws + WS_CS); bf16_t* Dt = (bf16_t*)(ws + WS_D); bf16_t* Et = (bf16_t*)(ws + WS_E);
    bf16_t* WQK = (bf16_t*)(ws + WS_WQK); bf16_t* WV = (bf16_t*)(ws + WS_WV); bf16_t* WO = (bf16_t*)(ws + WS_WO); bf16_t* FWt = (bf16_t*)(ws + WS_FW);
    bf16_t* W1t = (bf16_t*)(ws + WS_W1); bf16_t* W2t = (bf16_t*)(ws + WS_W2);
    bf16_t* H = (bf16_t*)(ws + WS_H); bf16_t* QK = (bf16_t*)(ws + WS_QK); bf16_t* VT = (bf16_t*)(ws + WS_VT); bf16_t* O = (bf16_t*)(ws + WS_O);
    bf16_t* XS = (bf16_t*)(ws + WS_XS); bf16_t* HMID = (bf16_t*)(ws + WS_HMID); bf16_t* Z0 = (bf16_t*)(ws + WS_Z0); bf16_t* Z1 = (bf16_t*)(ws + WS_Z1); bf16_t* Fb = (bf16_t*)(ws + WS_F);
    float* SSQ = (float*)(ws + WS_SSQ); float* BV0 = (float*)(ws + WS_BV); float* BV1 = BV0 + 4 * 4096; float* BVF = BV1 + 4 * 4096; float* GM = BVF + 16 * 512;
    const int lo = args.ph_lo, hi = args.ph_hi;
    cg::grid_group grid = cg::this_grid();
#define IN(k) (lo <= (k) && (k) < hi)
#ifndef REP_SYNC
#define REP_SYNC 1
#endif
#ifndef REP_NORM
#define REP_NORM 1
#endif
#ifndef REP_S12
#define REP_S12 1
#endif
#ifndef REP_P0
#define REP_P0 1
#endif
#ifndef USE_XB
#define USE_XB 1
#endif
#define SEAM(k) do { if (IN(k) && IN((k) + 1)) { for (int r_ = 0; r_ < REP_SYNC; ++r_) { if (use_cg) grid.sync(); else xcd_barrier(xbar); } } } while (0)
    { volatile LAS unsigned* st_ = (volatile LAS unsigned*)(lds + LDS_BYTES - 64); if (threadIdx.x < 2) st_[threadIdx.x] = 0u; __syncthreads(); }
    XcdBarrier xbar; xbar.bar = (unsigned*)(ws + WS_BAR); xbar.x = 0; xbar.st = (volatile LAS unsigned*)(lds + LDS_BYTES - 64);
    const bool use_cg = (args.use_cg != 0);
    if (!use_cg && hi - lo > 1) xbar = xcd_barrier_post((unsigned*)(ws + WS_BAR), (volatile LAS unsigned*)(lds + LDS_BYTES - 64));

    unsigned* dflags = (unsigned*)(ws + WS_SB + 256);
#define DBG16(k, bit, p, n) do { if (MK_DEBUG && IN(k)) { int t_ = threadIdx.x; asm volatile("" : "+v"(t_)); dbg_scan16(p, n, dflags, bit, (vcu * 512) + t_, G * 512); } } while (0)
#define DBG32(k, bit, p, n) do { if (MK_DEBUG && IN(k)) { int t_ = threadIdx.x; asm volatile("" : "+v"(t_)); dbg_scan32(p, n, dflags, bit, (vcu * 512) + t_, G * 512); } } while (0)
    if (IN(0)) {
        PHASE_IDS;
        if (MK_DEBUG && c == 0 && tid_ == 0) *dflags = 0u;
        for (int r0_ = 0; r0_ < REP_P0; ++r0_) {
        for (int u = c; u < 192; u += G) p0_mods_unit(cvec, cctx, ada_w, ada_b, mods, lds, u);
        __syncthreads();
        {
            LAS float* scr = (LAS float*)(lds + wid * 16384);
            constexpr int I_QKV = 16 * 96, I_SQ = 16 * 32, I_1 = 16 * 128, I_2 = 64 * 32;
            constexpr int NITEMS = I_QKV + I_SQ + 2 * I_1;
            for (int it = NITEMS - 1 - gw; it >= 0; it -= NGW) {
                int r = it;
                if (r < I_QKV) { p0_transpose_item(wqkv, 1024, 3072, WQK, WV, 1, scr, r, lane); continue; } r -= I_QKV;
                if (r < I_SQ) { p0_transpose_item(wo, 1024, 1024, WO, nullptr, 0, scr, r, lane); continue; } r -= I_SQ;
                { const int l = r / I_1; p0_transpose_item(w1 + (size_t)l * 1024 * 4096, 1024, 4096, W1t + (size_t)l * 4096 * 1024, nullptr, 0, scr, r % I_1, lane); }
            }
        }
        {
            const int gt = gw * 64 + lane, NT = NGW * 64;
            for (int i = gt; i < 256 * 256; i += NT) { const int m = i >> 8, cc = i & 255, ri = m >> 7, k2 = m & 127; float sn, cs; sincospif(2.0f * (float)((cc * k2) & 255) / 256.0f, &sn, &cs);
                float v = (ri == 0 ? cs : -sn) * (1.0f / 16.0f); if (m == 128) v = (cc & 1) ? -(1.0f / 16.0f) : (1.0f / 16.0f);
                CS[i] = (bf16_t)(cvt_pk_bf16(v, 0.f) & 0xffffu); }
            for (int i = gt; i < 128 * 128; i += NT) { const int n = i >> 7, kp = i & 127, ka = n >> 1, rip = n & 1, ri = kp >> 6, a = kp & 63; float sn, cs; sincospif(2.0f * (float)((a * ka) & 63) / 64.0f, &sn, &cs);
                const float v = (rip == 0 ? (ri == 0 ? cs : sn) : (ri == 0 ? -sn : cs)) * 0.125f; Dt[i] = (bf16_t)(cvt_pk_bf16(v, 0.f) & 0xffffu); }
            for (int i = gt; i < 64 * 64 * 128; i += NT) { const int kp = i & 127, kbk = (i >> 7) & 63, ka = i >> 13, rip = kp >> 6, bp = kp & 63; float sn, cs; sincospif(2.0f * (float)((bp * (ka + 64 * kbk)) & 4095) / 4096.0f, &sn, &cs);
                const float v = (rip == 0 ? cs : sn) * 0.125f; Et[i] = (bf16_t)(cvt_pk_bf16(v, 0.f) & 0xffffu); }
        }
        if (c == G - 1 && wid == 7) {
            float mq = fabsf(gq[lane]), mk = fabsf(gk[lane]), mr = 0.f;
            for (int i = lane; i < 16 * 465; i += 64) mr = fmaxf(mr, fabsf(rpb[i]));
#pragma unroll
            for (int o = 1; o < 64; o <<= 1) { mq = fmaxf(mq, __shfl_xor(mq, o)); mk = fmaxf(mk, __shfl_xor(mk, o)); mr = fmaxf(mr, __shfl_xor(mr, o)); }
            if (lane == 0) *sbound = (8.0f * mq * mk + mr) * LOG2E;
        }
        __syncthreads();
        }
    }
    SEAM(0);
    const bool ctx_in_p1 = false;
    if (IN(1)) { PHASE_IDS;
        if (c == G - 1) {
            for (int i = tid_; i < 3 * 4096; i += 512) { const int idx = i >> 12, b = (i >> 10) & 3, col = i & 1023;
                const float gg = norm_g[(idx == 0 ? 1024 : idx == 1 ? 2048 : 3072) + col];
                const float sc = mods[(size_t)((idx == 0 ? 0 : 5) + b) * 6144 + (idx == 1 ? 1024 : 4096) + col];
                GM[i] = gg * (1.0f + sc); }
        }
        if (!ctx_in_p1) norm_rows_lds(x, ctx, MT, norm_g, mods, H, gw, NGW, lane, tid_, lds);
        else if (c >= 32) norm_rows(x, ctx, ML, norm_g, mods, 0, 1024, H, (c - 32) * 8 + wid, (G - 32) * 8, lane);
        else {
            pg8::SchedOne S1u; const size_t ts = (size_t)256 * 1024 * 2; int tt;
            if (c < 16) { S1u.u.kind = 0; S1u.u.pm = 64 + (c & 3); S1u.u.pn = 4 + (c >> 2); tt = c & 3; S1u.u.a = (const char*)H + (size_t)S1u.u.pm * ts; S1u.u.b = (const char*)WQK + (size_t)S1u.u.pn * ts; }
            else { const int l2 = c - 16; S1u.u.kind = 1; S1u.u.pm = l2 & 3; S1u.u.pn = 64 + (l2 >> 2); tt = l2 >> 2; S1u.u.a = (const char*)WV + (size_t)S1u.u.pm * ts; S1u.u.b = (const char*)H + (size_t)S1u.u.pn * ts; }
            S1u.u.aux = 0;
            norm_rows(x, ctx, ML + tt * 256 + 256, norm_g, mods, 0, 1024, H, ML + tt * 256 + wid, 8, lane);
            asm volatile("s_waitcnt vmcnt(0)" ::: "memory"); __syncthreads();
            pg8::EpiQKV E{QK, VT, gq, gk};
            pg8::gemm_phase<pg8::EpiQKV, pg8::SchedOne, false>(lds, 1024, 1024, 1024, S1u, E);
        }
    }
    SEAM(1);
    DBG16(2, 0, H, (size_t)MT * 1024);
    if (IN(2)) { pg8::SchedQKV S{(const char*)H, (const char*)WQK, (const char*)WV, G, c, ctx_in_p1 ? 768 : 800}; pg8::EpiQKV E{QK, VT, gq, gk};
#ifndef REP_G2
#define REP_G2 1
#endif
        for (int r_ = 0; r_ < REP_G2; ++r_) pg8::gemm_phase<pg8::EpiQKV, pg8::SchedQKV, false>(lds, 1024, 1024, 1024, S, E);
        { PHASE_IDS;
          const bool part = (G > 32); const int w_ = part ? (c - 32) * 8 + wid : gw, nw_ = part ? (G - 32) * 8 : NGW;
          if (!part || c >= 32) {
              bias_items(W1t, CS, mods, BV0, BV1, BVF, w_, nw_, lane);
              LAS float* scr = (LAS float*)(lds + wid * 16384);
              constexpr int I_SQ = 16 * 32, I_2 = 64 * 32;
              for (int it = w_; it < I_SQ + 2 * I_2; it += nw_) {
                  if (it < I_SQ) p0_transpose_item(fw, 1024, 1024, FWt, nullptr, 2, scr, it, lane);
                  else { const int r2 = it - I_SQ, l = r2 / I_2; p0_transpose_item(w2 + (size_t)l * 4096 * 1024, 4096, 1024, W2t + (size_t)l * 1024 * 4096, nullptr, 0, scr, r2 % I_2, lane); }
              }
          } } }
    SEAM(2);
    DBG16(3, 1, QK, (size_t)ML * 2048); DBG16(3, 2, VT, (size_t)1024 * MT); DBG32(3, 13, mods, (size_t)10 * 6144);
#ifndef REP_ATT
#define REP_ATT 1
#endif
    if (IN(3)) { for (int rep = 0; rep < REP_ATT; ++rep) attn_phase(QK, VT, O, rpb, sbound, lds, G, c); }
    SEAM(3);
    DBG16(4, 3, O, (size_t)ML * 1024);
    if (IN(4)) { pg8::SchedStd S; S.init(O, WO, ML, 1024, 1024, 1024, G, c); pg8::EpiResF<false> E{x, XS, mods + 2048, GM, H, SSQ};
        pg8::gemm_phase<pg8::EpiResF<false>, pg8::SchedStd, false>(lds, 1024, 1024, 1024, S, E); }
    SEAM(4);
    DBG32(5, 4, out, (size_t)ML * 1024);
    if (IN(6)) { pg8::SchedStd S; S.init(H, W1t, ML, 4096, 1024, 1024, G, c); pg8::EpiRelu2F E{HMID, 4096, BV0, SSQ};
        pg8::gemm_phase<pg8::EpiRelu2F, pg8::SchedStd, false>(lds, 1024, 1024, 1024, S, E); }
    SEAM(6);
    DBG16(7, 5, HMID, (size_t)ML * 4096);
    if (IN(7)) { pg8::SchedStd S; S.init(HMID, W2t, ML, 1024, 64, 4096, G, c, (size_t)64 * 32768); pg8::EpiResF<true> E{XS, XS, mods + 5120, GM + 4096, H, SSQ};
        pg8::gemm_phase<pg8::EpiResF<true>, pg8::SchedStd, false>(lds, 4096, 64, 4096, S, E, 32768, 128); }
    SEAM(7);
    const float* mods1 = mods + 5 * 6144;
    DBG32(8, 6, out, (size_t)ML * 1024);
    if (IN(9)) { pg8::SchedF1 S{(const char*)CS, (const char*)H, G, c}; pg8::EpiZ0F E{Z0, BVF, SSQ};
        pg8::gemm_phase<pg8::EpiZ0F, pg8::SchedF1, true>(lds, 256, 256, 1024, S, E); }
    SEAM(9);
    DBG16(10, 7, Z0, (size_t)262144 * 128);
    if (IN(10)) { PHASE_IDS; for (int r_ = 0; r_ < REP_S12; ++r_) s1_phase(Z0, Dt, Z1, lds, gw, NGW); }
    SEAM(10);
    DBG16(11, 8, Z1, (size_t)262144 * 128);
    if (IN(11)) { s2_phase(Z1, Et, Fb, lds, G, c); }
    SEAM(11);
    DBG16(12, 9, Fb, (size_t)ML * 1024);
    if (IN(12)) { pg8::SchedStd S; S.init(Fb, FWt, ML, 1024, 1024, 1024, G, c); pg8::EpiResF<true> E{XS, XS, mods1 + 2048, GM + 8192, H, SSQ};
        pg8::gemm_phase<pg8::EpiResF<true>, pg8::SchedStd, false>(lds, 1024, 1024, 1024, S, E); }
    SEAM(12);
    DBG32(13, 10, out, (size_t)ML * 1024);
    if (IN(14)) { pg8::SchedStd S; S.init(H, W1t + (size_t)4096 * 1024, ML, 4096, 1024, 1024, G, c); pg8::EpiRelu2F E{HMID, 4096, BV1, SSQ};
        pg8::gemm_phase<pg8::EpiRelu2F, pg8::SchedStd, false>(lds, 1024, 1024, 1024, S, E); }
    SEAM(14);
    DBG16(15, 11, HMID, (size_t)ML * 4096);
    if (IN(15)) { pg8::SchedStd S; S.init(HMID, W2t + (size_t)1024 * 4096, ML, 1024, 64, 4096, G, c, (size_t)64 * 32768); pg8::EpiRes E{XS, out, mods1 + 5120};
        pg8::gemm_phase<pg8::EpiRes, pg8::SchedStd, false>(lds, 4096, 64, 4096, S, E, 32768, 128); }
    SEAM(15);
    if (MK_DEBUG && IN(16)) {
        int t_ = threadIdx.x; asm volatile("" : "+v"(t_));
        bool bad = false;
        for (size_t i = (size_t)vcu * 512 + t_; i < (size_t)ML * 1024; i += (size_t)G * 512) { if ((__float_as_uint(out[i]) & 0x7f800000u) == 0x7f800000u) { bad = true; out[i] = 0.f; } }
        if (bad) atomicOr(dflags, 1u << 12);
    }
    SEAM(16);
    if (MK_DEBUG && IN(17)) {
        if (c == 0 && threadIdx.x == 0) { const unsigned f = *dflags; if (f) out[0] = 1.0e6f * (float)(__builtin_ctz(f) + 1) + 1.0e4f * (float)__builtin_popcount(f); }
    }
#undef IN
#undef SEAM
}

constexpr int NPHASE = MK_DEBUG ? 18 : 16;
#ifndef MK_USE_CG
#define MK_USE_CG 0
#endif
#ifndef MK_PER_PHASE
#define MK_PER_PHASE 0
#endif

extern "C" void kernel_launch(void* const* d_in, const int* in_sizes, int n_in, void* d_out, int out_size, void* d_ws, size_t ws_size, hipStream_t stream) {
    static int grid = 0;
    if (grid == 0) {
        if (n_in != 15 || out_size != ML * DM || ws_size < WS_END) { fprintf(stderr, "kernel_launch: unexpected shapes (n_in %d out %d ws %zu)\n", n_in, out_size, ws_size); grid = -1; return; }
        int dev = 0, cus = 0, per_cu = 0;
        hipGetDevice(&dev); hipDeviceGetAttribute(&cus, hipDeviceAttributeMultiprocessorCount, dev);
        hipFuncSetAttribute((const void*)fwd_kernel, hipFuncAttributeMaxDynamicSharedMemorySize, LDS_BYTES);
        if (hipOccupancyMaxActiveBlocksPerMultiprocessor(&per_cu, (const void*)fwd_kernel, 512, LDS_BYTES) != hipSuccess || per_cu < 1) { fprintf(stderr, "kernel_launch: occupancy query failed (%d)\n", per_cu); (void)hipGetLastError(); per_cu = 1; }
        grid = cus * 1;
        if (grid <= 0) grid = 256;
    }
    if (grid < 0) return;
    if (hipMemsetAsync((char*)d_ws + WS_BAR, 0, BAR_BYTES, stream) != hipSuccess) { fprintf(stderr, "kernel_launch: memset failed\n"); return; }
    Args a{};
    for (int i = 0; i < 15; ++i) a.in[i] = (const float*)d_in[i];
    a.out = (float*)d_out; a.ws = (unsigned char*)d_ws;
#if MK_PER_PHASE
    for (int p = 0; p < NPHASE; ++p) { a.ph_lo = p; a.ph_hi = p + 1; hipLaunchKernelGGL(fwd_kernel, dim3(grid), dim3(512), LDS_BYTES, stream, a); }
#else
    a.ph_lo = 0; a.ph_hi = NPHASE; a.use_cg = MK_USE_CG;
    void* kargs[] = {&a};
    hipError_t e = hipLaunchCooperativeKernel((const void*)fwd_kernel, dim3(grid), dim3(512), kargs, LDS_BYTES, stream);
    if (e != hipSuccess) fprintf(stderr, "cooperative launch failed: %s (grid %d)\n", hipGetErrorString(e), grid);
#endif
}
```

```cpp
#include <hip/hip_runtime.h>
#include <hip/hip_cooperative_groups.h>
#include <cstdio>
#include <cstdint>
namespace cg = cooperative_groups;

#define LAS __attribute__((address_space(3)))
typedef unsigned short bf16_t;
typedef short bf16x8 __attribute__((ext_vector_type(8)));
typedef short s16x4 __attribute__((ext_vector_type(4)));
typedef float f32x4 __attribute__((ext_vector_type(4)));
typedef unsigned u32x4 __attribute__((ext_vector_type(4)));
typedef unsigned u32x2 __attribute__((ext_vector_type(2)));

constexpr int DM = 1024, NB = 4, SEQ = 4096, CTXL = 256, FF = 4096;
constexpr int ML = NB * SEQ;
constexpr int MT = ML + NB * CTXL;
constexpr float LOG2E = 1.4426950408889634f;
constexpr float EPS = 1e-6f;

constexpr size_t MiB = 1u << 20;
constexpr size_t WS_MODS = 0;
constexpr size_t WS_SB = 512 * 1024;
constexpr size_t WS_BAR = 1 * MiB;
constexpr size_t BAR_BYTES = 16384;
constexpr size_t WS_CS = 2 * MiB;
constexpr size_t WS_D = 2 * MiB + 512 * 1024;
constexpr size_t WS_E = 3 * MiB;
constexpr size_t WS_WQK = 4 * MiB, WS_WV = 8 * MiB, WS_WO = 10 * MiB, WS_FW = 12 * MiB;
constexpr size_t WS_W1 = 14 * MiB;
constexpr size_t WS_W2 = 30 * MiB;
constexpr size_t WS_SSQ = 46 * MiB;
constexpr size_t WS_BV = 47 * MiB;
constexpr size_t WS_H = 48 * MiB;
constexpr size_t WS_R = 82 * MiB;
constexpr size_t WS_QK = WS_R;
constexpr size_t WS_VT = WS_R + 68 * MiB;
constexpr size_t WS_O = WS_R + 102 * MiB;
constexpr size_t WS_HMID = WS_R;
constexpr size_t WS_Z0 = WS_R;
constexpr size_t WS_Z1 = WS_R + 64 * MiB;
constexpr size_t WS_F = WS_R;
constexpr size_t WS_XS = WS_R + 134 * MiB;
constexpr size_t WS_END = 256 * MiB;
static_assert(WS_XS + 32 * MiB <= WS_END && WS_O + 32 * MiB <= WS_XS && WS_F + 32 * MiB <= WS_END && WS_HMID + 128 * MiB <= WS_END && WS_O + 32 * MiB <= WS_END, "ws map");

constexpr int LDS_BYTES = 147456;

typedef __bf16 bf16v2_t __attribute__((ext_vector_type(2)));
typedef float f32v2_t __attribute__((ext_vector_type(2)));
__device__ __forceinline__ unsigned cvt_pk_bf16(float lo, float hi) { const f32v2_t v = {lo, hi}; const bf16v2_t r = __builtin_convertvector(v, bf16v2_t); return __builtin_bit_cast(unsigned, r); }
__device__ __forceinline__ f32x4 mfma16(bf16x8 a, bf16x8 b, f32x4 c) { return __builtin_amdgcn_mfma_f32_16x16x32_bf16(a, b, c, 0, 0, 0); }


#ifndef MK_WT
#define MK_WT 0
#endif
__device__ __forceinline__ void st16(void* p, u32x4 v) {
#if MK_WT
    asm volatile("global_store_dwordx4 %0, %1, off sc1\n\ts_nop 1" :: "v"(p), "v"(v) : "memory");
#else
    *(u32x4*)p = v;
#endif
}
__device__ __forceinline__ void st16f(void* p, f32x4 v) {
#if MK_WT
    asm volatile("global_store_dwordx4 %0, %1, off sc1\n\ts_nop 1" :: "v"(p), "v"(v) : "memory");
#else
    *(f32x4*)p = v;
#endif
}
__device__ __forceinline__ void st8(void* p, u32x2 v) {
#if MK_WT
    asm volatile("global_store_dwordx2 %0, %1, off sc1\n\ts_nop 1" :: "v"(p), "v"(v) : "memory");
#else
    *(u32x2*)p = v;
#endif
}
namespace pg8 {
constexpr int BM = 256, BK = 64, HALF = 128, HTB = HALF * BK * 2, STAGE_BYTES = 8 * HTB;
__device__ __forceinline__ int lds_byte(int r, int c) { const int st = (r >> 4) * 2 + (c >> 5), rr = r & 15, cc = c & 31, ob = rr * 64 + cc * 2; return st * 1024 + (ob ^ (((ob >> 9) & 1) << 5)); }
__device__ __forceinline__ void stage_rc(int b, int& R, int& C) { const int st = b / 1024, sb = b % 1024, swz = sb ^ (((sb >> 9) & 1) << 5); R = (st >> 1) * 16 + swz / 64; C = (st & 1) * 32 + (swz % 64) / 2; }
__device__ __forceinline__ int perm32(int rho) { const int n = rho >> 4, i = rho & 15; return 8 * (i >> 2) + 4 * n + (i & 3); }

struct Unit { int pm, pn, kind, aux; const char* a; const char* b; };

template <class Epi, class Sched, bool BMAP>
__device__ __forceinline__ void gemm_phase(LAS unsigned char* lds, const int K, const int lda, const int ldb, const Sched& S, const Epi& E, const size_t kstepA = 128, const size_t kstepB = 128) {
    int tid = threadIdx.x; asm volatile("" : "+v"(tid));
    const int wid = __builtin_amdgcn_readfirstlane(tid >> 6), lane = tid & 63, wr = wid >> 2, wc = wid & 3, fr = lane & 15, fq = lane >> 4;
    int nt = K / BK; asm volatile("" : "+s"(nt));
    unsigned voffA[2], voffB[2];
#pragma unroll
    for (int i = 0; i < 2; ++i) { int R, C; stage_rc(tid * 16 + i * 8192, R, C); const int Rb = (R & ~31) + perm32(R & 31);
        voffA[i] = (unsigned)(R * lda + C) * 2u;
        voffB[i] = BMAP ? (unsigned)((64 * (Rb & 63) + (Rb >> 6)) * ldb + C) * 2u : (unsigned)(Rb * ldb + C) * 2u; }
    const size_t hstepA = (size_t)HALF * lda * 2;
    const size_t hstepB = BMAP ? (size_t)2 * ldb * 2 : (size_t)HALF * ldb * 2;
    const unsigned ldsw = (unsigned)wid * 1024u;
    const int aoff = lds_byte(wr * 64 + fr, fq * 8), boff = lds_byte(wc * 32 + fr, fq * 8);
#define PG8_SA(b, h) (((b) * 2 + (h)) * HTB)
#define PG8_SB(b, h) ((4 + (b) * 2 + (h)) * HTB)
#define PG8_STAGE(bufoff, gbase, voff) do { _Pragma("unroll") for (int _i = 0; _i < 2; ++_i) \
        __builtin_amdgcn_global_load_lds((const unsigned*)((const char*)(gbase) + (voff)[_i]), (LAS unsigned*)(lds + (bufoff) + ldsw + _i * 8192), 16, 0, 0); } while (0)
#define PG8_LDA(dst, b, h) do { _Pragma("unroll") for (int m = 0; m < 4; ++m) _Pragma("unroll") for (int k = 0; k < 2; ++k) dst[m][k] = *(const LAS bf16x8*)(lds + PG8_SA(b, h) + aoff + m * 2048 + k * 1024); } while (0)
#define PG8_LDB(dst, b, h) do { _Pragma("unroll") for (int n = 0; n < 2; ++n) _Pragma("unroll") for (int k = 0; k < 2; ++k) dst[n][k] = *(const LAS bf16x8*)(lds + PG8_SB(b, h) + boff + n * 2048 + k * 1024); } while (0)
#define PG8_MMA(ai, bj, At, Bt) do { __builtin_amdgcn_s_setprio(1); _Pragma("unroll") for (int m = 0; m < 4; ++m) _Pragma("unroll") for (int n = 0; n < 2; ++n) _Pragma("unroll") for (int k = 0; k < 2; ++k) \
        acc[ai][bj][m][n] = __builtin_amdgcn_mfma_f32_16x16x32_bf16(Bt[n][k], At[m][k], acc[ai][bj][m][n], 0, 0, 0); __builtin_amdgcn_s_setprio(0); } while (0)
#define PG8_WAIT_V(n) asm volatile("s_waitcnt vmcnt(" #n ")" ::: "memory")
#define PG8_WAIT_L(n) asm volatile("s_waitcnt lgkmcnt(" #n ")" ::: "memory")
#define PG8_BAR __builtin_amdgcn_s_barrier()
#define PG8_SCHED __builtin_amdgcn_sched_barrier(0)
    Unit cur, nxt; int ui = 0;
    if (!S.next(0, cur)) return;
    f32x4 acc[2][2][4][2];
#pragma unroll
    for (int a = 0; a < 2; ++a)
#pragma unroll
        for (int b = 0; b < 2; ++b)
#pragma unroll
            for (int m = 0; m < 4; ++m)
#pragma unroll
                for (int n = 0; n < 2; ++n) acc[a][b][m][n] = (f32x4){0.f, 0.f, 0.f, 0.f};
    bf16x8 At[4][2], B0[2][2], B1[2][2];
    const char* cA = cur.a; const char* cB = cur.b;
    if constexpr (Epi::PREP) E.prep(cur, lds, 0, tid);
    PG8_STAGE(PG8_SB(0, 0), cB, voffB); PG8_STAGE(PG8_SB(0, 1), cB + hstepB, voffB); PG8_STAGE(PG8_SA(0, 0), cA, voffA); PG8_STAGE(PG8_SA(0, 1), cA + hstepA, voffA);
    if (wr == 1) PG8_BAR;
    PG8_WAIT_V(2); PG8_BAR;
    PG8_STAGE(PG8_SB(1, 0), cB + kstepB, voffB); PG8_STAGE(PG8_SA(1, 0), cA + kstepA, voffA); PG8_STAGE(PG8_SB(1, 1), cB + hstepB + kstepB, voffB);
    PG8_WAIT_V(6); PG8_BAR;
    for (;;) {
        const bool has_next = S.next(ui + 1, nxt);
        const char* nA = has_next ? nxt.a : cA; const char* nB = has_next ? nxt.b : cB;
        for (int t = 0; t < nt; t += 2) {
            const bool last = (t == nt - 2);
            const char* a1 = cA + (size_t)(t + 1) * kstepA;
            const char* a2 = last ? nA : cA + (size_t)(t + 2) * kstepA; const char* b2 = last ? nB : cB + (size_t)(t + 2) * kstepB;
            const char* a3 = a2 + kstepA; const char* b3 = b2 + kstepB;
            PG8_LDB(B0, 0, 0); PG8_LDB(B1, 0, 1); PG8_SCHED; PG8_LDA(At, 0, 0); PG8_STAGE(PG8_SA(1, 1), a1 + hstepA, voffA);
            PG8_WAIT_V(8); PG8_WAIT_L(0); PG8_BAR; PG8_MMA(0, 0, At, B0); PG8_MMA(0, 1, At, B1); PG8_BAR; PG8_SCHED;
            PG8_LDA(At, 0, 1); PG8_STAGE(PG8_SB(0, 0), b2, voffB); PG8_STAGE(PG8_SB(0, 1), b2 + hstepB, voffB); PG8_STAGE(PG8_SA(0, 0), a2, voffA);
            PG8_WAIT_V(8); PG8_WAIT_L(0); PG8_BAR; PG8_MMA(1, 0, At, B0); PG8_MMA(1, 1, At, B1); PG8_BAR; PG8_SCHED;
            PG8_LDB(B0, 1, 0); PG8_LDB(B1, 1, 1); PG8_SCHED; PG8_LDA(At, 1, 0); PG8_STAGE(PG8_SA(0, 1), a2 + hstepA, voffA);
            PG8_WAIT_V(8); PG8_WAIT_L(0); PG8_BAR; PG8_MMA(0, 0, At, B0); PG8_MMA(0, 1, At, B1); PG8_BAR; PG8_SCHED;
            PG8_LDA(At, 1, 1); PG8_STAGE(PG8_SB(1, 0), b3, voffB); PG8_STAGE(PG8_SB(1, 1), b3 + hstepB, voffB); PG8_STAGE(PG8_SA(1, 0), a3, voffA);
            PG8_WAIT_V(8); PG8_WAIT_L(0); PG8_BAR; PG8_MMA(1, 0, At, B0); PG8_MMA(1, 1, At, B1); PG8_BAR; PG8_SCHED;
        }
        if (wr == 0) PG8_BAR;
        if constexpr (Epi::PREP) { if (has_next) E.prep(nxt, lds, (ui + 1) & 1, tid); }
        E(acc, cur, wr, wc, fr, fq, lds, ui & 1);
        if (!has_next) break;
#pragma unroll
        for (int a = 0; a < 2; ++a)
#pragma unroll
            for (int b = 0; b < 2; ++b)
#pragma unroll
                for (int m = 0; m < 4; ++m)
#pragma unroll
                    for (int n = 0; n < 2; ++n) acc[a][b][m][n] = (f32x4){0.f, 0.f, 0.f, 0.f};
        cur = nxt; cA = nA; cB = nB; ++ui;
        if (wr == 1) PG8_BAR;
    }
    PG8_WAIT_V(0);
    PG8_BAR;
#undef PG8_SA
#undef PG8_SB
#undef PG8_STAGE
#undef PG8_LDA
#undef PG8_LDB
#undef PG8_MMA
#undef PG8_WAIT_V
#undef PG8_WAIT_L
#undef PG8_BAR
#undef PG8_SCHED
}

struct SchedStd {
    const char* A; const char* Bt; size_t tsA, tsB; int nM, nN, nwg, G, c;
    __device__ void init(const void* A_, const void* Bt_, int M, int N, int lda, int ldb, int G_, int c_, size_t tsA_ = 0) { A = (const char*)A_; Bt = (const char*)Bt_; tsA = tsA_ ? tsA_ : (size_t)BM * lda * 2; tsB = (size_t)BM * ldb * 2; nM = M / BM; nN = N / BM; nwg = nM * nN; G = G_; c = c_; }
    __device__ bool next(int i, Unit& u) const {
        const long L = (long)i * G + c; if (L >= nwg) return false;
        int wgid = (int)L; { const int q = nwg / 8, r = nwg % 8, xcd = wgid % 8, off = wgid / 8; wgid = (xcd < r ? xcd * (q + 1) : r * (q + 1) + (xcd - r) * q) + off; }
        const int nig = 8 * nN, gid = wgid / nig, fm = gid * 8, gsz = (nM - fm) < 8 ? (nM - fm) : 8;
        u.pm = fm + ((wgid % nig) % gsz); u.pn = (wgid % nig) / gsz; u.kind = 0; u.aux = 0;
        u.a = A + (size_t)u.pm * tsA; u.b = Bt + (size_t)u.pn * tsB; return true;
    }
};
struct SchedQKV {
    const char* H; const char* Wqk; const char* Wv; int G, c, nunits;
    __device__ bool next(int i, Unit& u) const {
        const long Ll = (long)i * G + c; if (Ll >= nunits) return false;
        const int L = (int)Ll; const size_t ts = (size_t)BM * 1024 * 2; u.aux = 0;
        if (L < 512) { const int x = L & 7, off = L >> 3; u.kind = 0; u.pm = 8 * x + (off & 7); u.pn = off >> 3; }
        else if (L < 768) { const int l2 = L - 512, x = l2 & 7, off = l2 >> 3; u.kind = 1; u.pm = off & 3; u.pn = 8 * x + (off >> 2); }
        else if (L < 784) { const int l2 = L - 768; u.kind = 0; u.pm = 64 + (l2 & 3); u.pn = 4 + (l2 >> 2); }
        else { const int l2 = L - 784; u.kind = 1; u.pm = l2 & 3; u.pn = 64 + (l2 >> 2); }
        if (u.kind == 0) { u.a = H + (size_t)u.pm * ts; u.b = Wqk + (size_t)u.pn * ts; }
        else { u.a = Wv + (size_t)u.pm * ts; u.b = H + (size_t)u.pn * ts; }
        return true;
    }
};
struct SchedOne { Unit u;
    __device__ __forceinline__ bool next(int i, Unit& o) const { if (i > 0) return false; o = u; return true; }
};
struct SchedF1 {
    const char* CS; const char* H; int G, c;
    __device__ bool next(int i, Unit& u) const {
        const long Ll = (long)i * G + c; if (Ll >= 256) return false;
        const int L = (int)Ll; const int t = L & 15, b = (L >> 4) & 3, g = (L >> 6) & 3;
        u.pm = 0; u.pn = t; u.kind = g; u.aux = b;
        u.a = CS; u.b = H + ((size_t)(b * 4096 + 4 * t) * 1024 + g * 256) * 2; return true;
    }
};

typedef f32x4 Acc[2][2][4][2];
__device__ __forceinline__ u32x4 pack8(f32x4 v0, f32x4 v1) { u32x4 w; w.x = cvt_pk_bf16(v0[0], v0[1]); w.y = cvt_pk_bf16(v0[2], v0[3]); w.z = cvt_pk_bf16(v1[0], v1[1]); w.w = cvt_pk_bf16(v1[2], v1[3]); return w; }

__device__ __forceinline__ void unpack8(u32x4 w, f32x4& v0, f32x4& v1) {
    v0[0] = __uint_as_float(w.x << 16); v0[1] = __uint_as_float(w.x & 0xffff0000u); v0[2] = __uint_as_float(w.y << 16); v0[3] = __uint_as_float(w.y & 0xffff0000u);
    v1[0] = __uint_as_float(w.z << 16); v1[1] = __uint_as_float(w.z & 0xffff0000u); v1[2] = __uint_as_float(w.w << 16); v1[3] = __uint_as_float(w.w & 0xffff0000u);
}
struct EpiQKV { static constexpr bool PREP = true; bf16_t* QK; bf16_t* VT; const float* gq; const float* gk;
    __device__ __forceinline__ void prep(const Unit& u, LAS unsigned char* lds, int slot, int tid) const {
        if (u.kind == 0 && tid < 64) { const bool isq = u.pn < 4; ((LAS float*)(lds + 131072))[slot * 512 + tid] = isq ? gq[tid] * (0.125f * LOG2E) : gk[tid]; }
    }
    __device__ __forceinline__ void operator()(const Acc& acc, const Unit& u, int wr, int wc, int fr, int fq, LAS unsigned char* lds, int slot) const {
        if (u.kind == 0) {
            const LAS float* gp = (const LAS float*)(lds + 131072) + slot * 512;
            f32x4 gv[2][2];
#pragma unroll
            for (int bj = 0; bj < 2; ++bj)
#pragma unroll
                for (int n = 0; n < 2; ++n) gv[bj][n] = *(const LAS f32x4*)(gp + 32 * bj + 8 * fq + 4 * n);
#pragma unroll
            for (int ai = 0; ai < 2; ++ai)
#pragma unroll
                for (int m = 0; m < 4; ++m) {
                    const int row = u.pm * BM + ai * HALF + wr * 64 + m * 16 + fr;
                    float ss = 0.f;
#pragma unroll
                    for (int bj = 0; bj < 2; ++bj)
#pragma unroll
                        for (int n = 0; n < 2; ++n) { const f32x4 x = acc[ai][bj][m][n]; ss += (x[0] * x[0] + x[1] * x[1]) + (x[2] * x[2] + x[3] * x[3]); }
                    ss += __shfl_xor(ss, 16); ss += __shfl_xor(ss, 32);
                    const float rstd = rsqrtf(ss * (1.0f / 64.0f) + EPS);
                    bf16_t* rowp = QK + (size_t)row * 2048 + u.pn * 256 + wc * 64 + 8 * fq;
#pragma unroll
                    for (int bj = 0; bj < 2; ++bj) st16(rowp + 32 * bj, pack8(acc[ai][bj][m][0] * rstd * gv[bj][0], acc[ai][bj][m][1] * rstd * gv[bj][1]));
                }
        } else {
#pragma unroll
            for (int ai = 0; ai < 2; ++ai)
#pragma unroll
                for (int m = 0; m < 4; ++m) {
                    const int row = u.pm * BM + ai * HALF + wr * 64 + m * 16 + fr;
                    bf16_t* rowp = VT + (size_t)row * MT + u.pn * 256 + wc * 32 + 8 * fq;
#pragma unroll
                    for (int bj = 0; bj < 2; ++bj) st16(rowp + bj * HALF, pack8(acc[ai][bj][m][0], acc[ai][bj][m][1]));
                }
        }
    }
};
struct EpiRelu2 { static constexpr bool PREP = false; bf16_t* O; int ldc;
    __device__ __forceinline__ void operator()(const Acc& acc, const Unit& u, int wr, int wc, int fr, int fq, LAS unsigned char*, int) const {
#pragma unroll
        for (int ai = 0; ai < 2; ++ai)
#pragma unroll
            for (int m = 0; m < 4; ++m) {
                const int row = u.pm * BM + ai * HALF + wr * 64 + m * 16 + fr;
                bf16_t* rowp = O + (size_t)row * ldc + u.pn * 256 + wc * 32 + 8 * fq;
#pragma unroll
                for (int bj = 0; bj < 2; ++bj) { f32x4 v0 = acc[ai][bj][m][0], v1 = acc[ai][bj][m][1];
#pragma unroll
                    for (int e = 0; e < 4; ++e) { const float a = fmaxf(v0[e], 0.f), b = fmaxf(v1[e], 0.f); v0[e] = a * a; v1[e] = b * b; }
                    *(u32x4*)(rowp + bj * HALF) = pack8(v0, v1); }
            }
    }
};
struct EpiRes { static constexpr bool PREP = false; const bf16_t* base; float* out; const float* gate;
    __device__ __forceinline__ void operator()(const Acc& acc, const Unit& u, int wr, int wc, int fr, int fq, LAS unsigned char*, int) const {
        const int col0 = u.pn * 256 + wc * 32 + 8 * fq;
        const float* gp = gate + (size_t)(u.pm >> 4) * 6144 + col0;
        f32x4 gv[2][2];
#pragma unroll
        for (int bj = 0; bj < 2; ++bj)
#pragma unroll
            for (int n = 0; n < 2; ++n) gv[bj][n] = *(const f32x4*)(gp + bj * HALF + 4 * n);
#pragma unroll
        for (int ai = 0; ai < 2; ++ai)
#pragma unroll
          for (int mh = 0; mh < 2; ++mh) {
            u32x4 pre[2][2];
#pragma unroll
            for (int m2 = 0; m2 < 2; ++m2)
#pragma unroll
                for (int bj = 0; bj < 2; ++bj) pre[m2][bj] = __builtin_nontemporal_load((const u32x4*)(base + (size_t)(u.pm * BM + ai * HALF + wr * 64 + (2 * mh + m2) * 16 + fr) * 1024 + col0 + bj * HALF));
            asm volatile("" ::: "memory");
#pragma unroll
            for (int m2 = 0; m2 < 2; ++m2) { const int m = 2 * mh + m2;
                const size_t off = (size_t)(u.pm * BM + ai * HALF + wr * 64 + m * 16 + fr) * 1024 + col0;
#pragma unroll
                for (int bj = 0; bj < 2; ++bj) { f32x4 b0, b1; unpack8(pre[m2][bj], b0, b1);
                    *(f32x4*)(out + off + bj * HALF) = b0 + gv[bj][0] * acc[ai][bj][m][0]; *(f32x4*)(out + off + bj * HALF + 4) = b1 + gv[bj][1] * acc[ai][bj][m][1]; }
            }
            asm volatile("" ::: "memory");
          }
    }
};
struct EpiZ0 { static constexpr bool PREP = false; bf16_t* Z0;
    __device__ __forceinline__ void operator()(const Acc& acc, const Unit& u, int wr, int wc, int fr, int fq, LAS unsigned char*, int) const {
        const int ri = u.pm, t = u.pn, g = u.kind, b = u.aux;
        bf16_t* p0 = Z0 + ((size_t)(((b * 4 + g) * 256 + wr * 64 + fr) * 64 + 4 * t + (wc >> 1))) * 128 + ri * 64 + 32 * (wc & 1) + 8 * fq;
#pragma unroll
        for (int ai = 0; ai < 2; ++ai)
#pragma unroll
            for (int m = 0; m < 4; ++m) {
#pragma unroll
                for (int bj = 0; bj < 2; ++bj)
                    *(u32x4*)(p0 + (size_t)(ai * HALF + m * 16) * 8192 + bj * 256) = pack8(acc[ai][bj][m][0], acc[ai][bj][m][1]);
                asm volatile("" ::: "memory");
            }
    }
};

constexpr int AUX_OFF = 131072;
template <bool BASE16>
struct EpiResF { static constexpr bool PREP = false; const void* base; bf16_t* XS; const float* gate; const float* gm; bf16_t* XB; float* SSQ;
    __device__ __forceinline__ void operator()(const Acc& acc, const Unit& u, int wr, int wc, int fr, int fq, LAS unsigned char*, int) const {
        const int col0 = u.pn * 256 + wc * 32 + 8 * fq, b = u.pm >> 4;
        f32x4 gv[2][2], mv[2][2];
#pragma unroll
        for (int bj = 0; bj < 2; ++bj)
#pragma unroll
            for (int n = 0; n < 2; ++n) { gv[bj][n] = *(const f32x4*)(gate + (size_t)b * 6144 + col0 + bj * HALF + 4 * n); mv[bj][n] = *(const f32x4*)(gm + b * 1024 + col0 + bj * HALF + 4 * n); }
#pragma unroll
        for (int ai = 0; ai < 2; ++ai)
#pragma unroll
          for (int mh = 0; mh < 2; ++mh) {
            f32x4 pre[2][2][2];
#pragma unroll
            for (int m2 = 0; m2 < 2; ++m2) { const size_t off = (size_t)(u.pm * BM + ai * HALF + wr * 64 + (2 * mh + m2) * 16 + fr) * 1024 + col0;
#pragma unroll
                for (int bj = 0; bj < 2; ++bj) {
                    if (BASE16) { const u32x4 w = __builtin_nontemporal_load((const u32x4*)((const bf16_t*)base + off + bj * HALF)); unpack8(w, pre[m2][bj][0], pre[m2][bj][1]); }
                    else { pre[m2][bj][0] = __builtin_nontemporal_load((const f32x4*)((const float*)base + off + bj * HALF)); pre[m2][bj][1] = __builtin_nontemporal_load((const f32x4*)((const float*)base + off + bj * HALF + 4)); }
                } }
            asm volatile("" ::: "memory");
#pragma unroll
            for (int m2 = 0; m2 < 2; ++m2) {
                const int m = 2 * mh + m2;
                const int row = u.pm * BM + ai * HALF + wr * 64 + m * 16 + fr;
                const size_t off = (size_t)row * 1024 + col0;
                float ss = 0.f;
#pragma unroll
                for (int bj = 0; bj < 2; ++bj) {
                    const f32x4 v0 = pre[m2][bj][0] + gv[bj][0] * acc[ai][bj][m][0];
                    const f32x4 v1 = pre[m2][bj][1] + gv[bj][1] * acc[ai][bj][m][1];
                    st16(XS + off + bj * HALF, pack8(v0, v1));
                    ss += ((v0[0] * v0[0] + v0[1] * v0[1]) + (v0[2] * v0[2] + v0[3] * v0[3])) + ((v1[0] * v1[0] + v1[1] * v1[1]) + (v1[2] * v1[2] + v1[3] * v1[3]));
                    st16(XB + off + bj * HALF, pack8(v0 * mv[bj][0], v1 * mv[bj][1]));
                }
                ss += __shfl_xor(ss, 16); ss += __shfl_xor(ss, 32);
                if (fq == 0) SSQ[(size_t)row * 16 + u.pn * 4 + wc] = ss;
            }
            asm volatile("" ::: "memory");
          }
    }
};
__device__ __forceinline__ float ssq_rstd(const float* SSQ, int row, int half) {
    const f32x4 a = *(const f32x4*)(SSQ + (size_t)row * 16 + half * 8), b = *(const f32x4*)(SSQ + (size_t)row * 16 + half * 8 + 4);
    float s = ((a[0] + a[1]) + (a[2] + a[3])) + ((b[0] + b[1]) + (b[2] + b[3]));
    s += __shfl_xor(s, 1);
    return rsqrtf(s * (1.0f / 1024.0f) + EPS);
}
struct EpiRelu2F { static constexpr bool PREP = true; bf16_t* O; int ldc; const float* BV; const float* SSQ;
    __device__ __forceinline__ void prep(const Unit& u, LAS unsigned char* lds, int slot, int tid) const {
        const float r = ssq_rstd(SSQ, u.pm * BM + (tid >> 1), tid & 1);
        LAS float* aux = (LAS float*)(lds + AUX_OFF) + slot * 512;
        if (!(tid & 1)) aux[tid >> 1] = r;
        if (tid < 256) aux[256 + tid] = BV[(size_t)(u.pm >> 4) * 4096 + u.pn * 256 + tid];
    }
    __device__ __forceinline__ void operator()(const Acc& acc, const Unit& u, int wr, int wc, int fr, int fq, LAS unsigned char* lds, int slot) const {
        const LAS float* rt = (const LAS float*)(lds + AUX_OFF) + slot * 512;
        const int col0 = u.pn * 256 + wc * 32 + 8 * fq;
        f32x4 bv[2][2];
#pragma unroll
        for (int bj = 0; bj < 2; ++bj)
#pragma unroll
            for (int n = 0; n < 2; ++n) bv[bj][n] = *(const LAS f32x4*)(rt + 256 + wc * 32 + 8 * fq + bj * HALF + 4 * n);
#pragma unroll
        for (int ai = 0; ai < 2; ++ai)
#pragma unroll
            for (int m = 0; m < 4; ++m) {
                const int rl = ai * HALF + wr * 64 + m * 16 + fr; const float rs = rt[rl];
                bf16_t* rowp = O + ((size_t)(u.pm * 64 + u.pn * 4 + (wc >> 1)) * 256 + rl) * 64 + (wc & 1) * 32 + 8 * fq;
#pragma unroll
                for (int bj = 0; bj < 2; ++bj) { f32x4 v0 = acc[ai][bj][m][0] * rs + bv[bj][0], v1 = acc[ai][bj][m][1] * rs + bv[bj][1];
#pragma unroll
                    for (int e = 0; e < 4; ++e) { const float a = fmaxf(v0[e], 0.f), c2 = fmaxf(v1[e], 0.f); v0[e] = a * a; v1[e] = c2 * c2; }
                    st16(rowp + bj * 2 * 256 * 64, pack8(v0, v1)); }
            }
    }
};
constexpr int NCOL = 2064;
struct EpiZ0F { static constexpr bool PREP = true; bf16_t* Z0; const float* BVF; const float* SSQ;
    __device__ __forceinline__ void prep(const Unit& u, LAS unsigned char* lds, int slot, int tid) const {
        const int nl = tid >> 1, tok = u.aux * 4096 + 64 * (nl & 63) + 4 * u.pn + (nl >> 6);
        const float r = ssq_rstd(SSQ, tok, tid & 1);
        LAS float* aux = (LAS float*)(lds + AUX_OFF) + slot * 512;
        if (!(tid & 1)) aux[nl] = r;
        if (tid < 256) aux[256 + tid] = BVF[(size_t)(u.aux * 4 + u.kind) * 256 + tid];
    }
    __device__ __forceinline__ void operator()(const Acc& acc, const Unit& u, int wr, int wc, int fr, int fq, LAS unsigned char* lds, int slot) const {
        const LAS float* rt = (const LAS float*)(lds + AUX_OFF) + slot * 512;
        const int t = u.pn, g = u.kind, b = u.aux;
        f32x4 rs[2][2];
#pragma unroll
        for (int bj = 0; bj < 2; ++bj)
#pragma unroll
            for (int n = 0; n < 2; ++n) rs[bj][n] = *(const LAS f32x4*)(rt + bj * HALF + wc * 32 + 8 * fq + 4 * n);
        const LAS float* bz = rt + 256 + wr * 64 + fr;
        bf16_t* p0 = Z0 + ((size_t)(((b * 4 + g) * 128 + wr * 64 + fr) * 64 + 4 * t + (wc >> 1))) * 128 + 32 * (wc & 1) + 8 * fq;
        bf16_t* ps = Z0 + ((size_t)((2048 + b * 4 + g) * 64 + 4 * t + (wc >> 1))) * 128 + 32 * (wc & 1) + 8 * fq;
#pragma unroll
        for (int ai = 0; ai < 2; ++ai)
#pragma unroll
            for (int m = 0; m < 4; ++m) {
                const float bb = bz[ai * HALF + m * 16];
                const bool nyq = (ai == 1 && m == 0) && (wr == 0) && (fr == 0);
#pragma unroll
                for (int bj = 0; bj < 2; ++bj) {
                    const u32x4 v = pack8(acc[ai][bj][m][0] * rs[bj][0] + bb, acc[ai][bj][m][1] * rs[bj][1] + bb);
                    const u32x4 z = {0u, 0u, 0u, 0u};
                    st16(p0 + (size_t)(m * 16) * 8192 + ai * 64 + bj * 256, nyq ? z : v);
                    if (ai == 1 && m == 0) { if (nyq) { st16(ps + bj * 256, v); st16(ps + bj * 256 + 64, z); } }
                }
                asm volatile("" ::: "memory");
            }
    }
};
}


#define XB_TMO      128
#define XB_XCNT(j)  (256  + 64 * (j))
#define XB_XSUB(j)  (1280 + 64 * (j))
#define XB_XGEN(j)  (2304 + 64 * (j))
#define XB_TOP      3328
#define XB_TOPGEN   3392
#define XCD_BAR_WORDS 3456
#define XB_SPIN_CAP (1u << 18)
__device__ __forceinline__ unsigned xb_ld(unsigned* p)              { return __hip_atomic_load(p, __ATOMIC_RELAXED, __HIP_MEMORY_SCOPE_AGENT); }
__device__ __forceinline__ unsigned xb_add(unsigned* p, unsigned v) { return __hip_atomic_fetch_add(p, v, __ATOMIC_RELAXED, __HIP_MEMORY_SCOPE_AGENT); }
__device__ __forceinline__ unsigned xb_xcc_id() { return (unsigned)__builtin_amdgcn_s_getreg((3 << 11) | 20) & 0xFu; }
#define XB_SPIN(cond, bar) do { unsigned _sp = 0; while (cond) { __builtin_amdgcn_s_sleep(1); \
    if ((++_sp & 255u) == 0u) { if (xb_ld(&(bar)[XB_TMO])) break; if (_sp > XB_SPIN_CAP) { atomicAdd(&(bar)[XB_TMO], 1u); break; } } } } while (0)
struct XcdBarrier { unsigned* bar; unsigned x; volatile LAS unsigned* st; };
__device__ __forceinline__ XcdBarrier xcd_barrier_post(unsigned* bar, volatile LAS unsigned* st) {
    XcdBarrier b; b.bar = bar; b.x = xb_xcc_id(); b.st = st;
    if (threadIdx.x == 0) (void)xb_add(&bar[XB_XCNT(b.x)], 1u);
    return b;
}
__device__ __forceinline__ void xcd_barrier_complete(unsigned* bar, unsigned x, unsigned& nloc, unsigned& nx) {
    const unsigned G = gridDim.x * gridDim.y * gridDim.z;
    unsigned sum, cnt, mine, sp = 0u;
    for (;;) {
        sum = 0u; cnt = 0u; mine = 0u;
#pragma unroll
        for (unsigned j = 0; j < 16; ++j) { const unsigned c = xb_ld(&bar[XB_XCNT(j)]); sum += c; cnt += (c > 0u) ? 1u : 0u; mine = (j == x) ? c : mine; }
        if (sum == G) break;
        __builtin_amdgcn_s_sleep(1);
        if ((++sp & 255u) == 0u) { if (xb_ld(&bar[XB_TMO])) break; if (sp > XB_SPIN_CAP) { atomicAdd(&bar[XB_TMO], 1u); break; } }
    }
    nloc = mine > 0u ? mine : 1u; nx = cnt > 0u ? cnt : 1u;
}
__device__ __forceinline__ void xcd_barrier(const XcdBarrier& b) {
    asm volatile("s_waitcnt vmcnt(0)" ::: "memory");
    __syncthreads();
    if (threadIdx.x == 0) {
        unsigned* bar = b.bar;
        __builtin_amdgcn_s_waitcnt(0);
        unsigned nloc = b.st[0], nx = b.st[1];
        if (nloc == 0u) { xcd_barrier_complete(bar, b.x, nloc, nx); b.st[0] = nloc; b.st[1] = nx; }
        const unsigned old = xb_add(&bar[XB_XSUB(b.x)], 1u);
        const unsigned gen = old / nloc;
        if (old + 1u == (gen + 1u) * nloc) {
            __builtin_amdgcn_fence(__ATOMIC_RELEASE, "agent");
            asm volatile("s_waitcnt vmcnt(0)" ::: "memory");
            const unsigned og = xb_add(&bar[XB_TOP], 1u);
            const unsigned tg = og / nx;
            if (og + 1u == (tg + 1u) * nx) xb_add(&bar[XB_TOPGEN], 1u);
            else XB_SPIN(xb_ld(&bar[XB_TOPGEN]) == tg, bar);
            __builtin_amdgcn_fence(__ATOMIC_ACQUIRE, "agent");
            xb_add(&bar[XB_XGEN(b.x)], 1u);
            asm volatile("s_waitcnt vmcnt(0)" ::: "memory");
        } else {
            XB_SPIN(xb_ld(&bar[XB_XGEN(b.x)]) == gen, bar);
            __builtin_amdgcn_fence(__ATOMIC_ACQUIRE, "agent");
            asm volatile("s_waitcnt vmcnt(0)" ::: "memory");
        }
    }
    __syncthreads();
}
__device__ __forceinline__ void p0_mods_unit(const float* c, const float* cctx, const float* ada_w, const float* ada_b, float* mods, LAS unsigned char* lds, int unit) {
    LAS float* s = (LAS float*)lds;
    LAS float* red = s + 5 * 1024;
    int tid = threadIdx.x; asm volatile("" : "+v"(tid));
    for (int i = tid; i < 5 * 1024; i += 512) { const int v = i >> 10, k = i & 1023; const float x = v < 4 ? c[v * 1024 + k] : cctx[k]; s[i] = x / (1.0f + __expf(-x)); }
    __syncthreads();
    const int l = unit / 96, col0 = (unit % 96) * 64, kc = tid >> 6, cl = tid & 63;
    const float* w = ada_w + (size_t)l * 1024 * 6144 + col0 + cl;
    float a0 = 0.f, a1 = 0.f, a2 = 0.f, a3 = 0.f, a4 = 0.f;
    for (int k = kc * 128; k < kc * 128 + 128; k += 32) {
        float wv[32];
#pragma unroll
        for (int j = 0; j < 32; ++j) wv[j] = __builtin_nontemporal_load(w + (size_t)(k + j) * 6144);
#pragma unroll
        for (int j = 0; j < 32; ++j) { a0 += s[k + j] * wv[j]; a1 += s[1024 + k + j] * wv[j]; a2 += s[2048 + k + j] * wv[j]; a3 += s[3072 + k + j] * wv[j]; a4 += s[4096 + k + j] * wv[j]; }
    }
    red[(kc * 5 + 0) * 64 + cl] = a0; red[(kc * 5 + 1) * 64 + cl] = a1; red[(kc * 5 + 2) * 64 + cl] = a2; red[(kc * 5 + 3) * 64 + cl] = a3; red[(kc * 5 + 4) * 64 + cl] = a4;
    __syncthreads();
    if (tid < 320) { const int v = tid >> 6, cc = tid & 63; float t = 0.f;
#pragma unroll
        for (int kk = 0; kk < 8; ++kk) t += red[(kk * 5 + v) * 64 + cc];
        mods[(size_t)(l * 5 + v) * 6144 + col0 + cc] = t + ada_b[l * 6144 + col0 + cc]; }
    __syncthreads();
}

__device__ __forceinline__ void p0_transpose_item(const float* W, int K, int N, bf16_t* WT, bf16_t* WT2, int mode, LAS float* scr, int item, int lane) {
    const int nblk = N / 32, kb = item / nblk, nb = item % nblk, k0 = 64 * kb, n0 = 32 * nb;
    float wv_[32];
#pragma unroll
    for (int i = 0; i < 32; ++i) { int srow = k0 + 2 * i + (lane >> 5);
        if (mode == 2) { const int j = srow & 255; if (j > 128) srow = (srow & ~255) + 256 - (j - 128); }
        wv_[i] = __builtin_nontemporal_load(W + (size_t)srow * N + n0 + (lane & 31)); }
#pragma unroll
    for (int i = 0; i < 32; ++i) scr[(2 * i + (lane >> 5)) * 33 + (lane & 31)] = wv_[i];
    asm volatile("s_waitcnt lgkmcnt(0)" ::: "memory");
    const int cch = lane & 7;
#pragma unroll
    for (int j = 0; j < 4; ++j) { const int n = (lane >> 3) + 8 * j; const LAS float* s = scr + (8 * cch) * 33 + n;
        u32x4 o; o.x = cvt_pk_bf16(s[0 * 33], s[1 * 33]); o.y = cvt_pk_bf16(s[2 * 33], s[3 * 33]); o.z = cvt_pk_bf16(s[4 * 33], s[5 * 33]); o.w = cvt_pk_bf16(s[6 * 33], s[7 * 33]);
        const int ng = n0 + n; bf16_t* dst;
        if (mode != 1) dst = WT + (size_t)ng * K;
        else if (ng < 2048) { const int pn = ng >> 8, hh = (ng >> 6) & 3, d = ng & 63; const int tpos = (d >> 5) * 128 + hh * 32 + (d & 31); dst = WT + (size_t)(pn * 256 + tpos) * K; }
        else dst = WT2 + (size_t)(ng - 2048) * K;
        *(u32x4*)(dst + k0 + 8 * cch) = o; }
    asm volatile("s_waitcnt lgkmcnt(0)" ::: "memory");
}

__device__ __forceinline__ float wave_sum(float v) {
#pragma unroll
    for (int o = 1; o < 64; o <<= 1) v += __shfl_xor(v, o);
    return v;
}
__device__ __forceinline__ void norm_rows(const float* xlat, const float* xctx, int nrows, const float* g, const float* modsl, int sh_off, int sc_off, bf16_t* H, int gw, int NGW, int lane) {
    f32x4 gv[4];
#pragma unroll
    for (int j = 0; j < 4; ++j) gv[j] = *(const f32x4*)(g + lane * 4 + 256 * j);
    for (int row = gw; row < nrows; row += NGW) {
        const float* src = row < ML ? xlat + (size_t)row * 1024 : xctx + (size_t)(row - ML) * 1024;
        const int v = row < ML ? (row >> 12) : 4;
        const float* mp = modsl + (size_t)v * 6144;
        f32x4 x[4]; float ss = 0.f;
#pragma unroll
        for (int j = 0; j < 4; ++j) { x[j] = __builtin_nontemporal_load((const f32x4*)(src + lane * 4 + 256 * j)); ss += (x[j][0] * x[j][0] + x[j][1] * x[j][1]) + (x[j][2] * x[j][2] + x[j][3] * x[j][3]); }
        const float rstd = rsqrtf(wave_sum(ss) * (1.0f / 1024.0f) + EPS);
#pragma unroll
        for (int j = 0; j < 4; ++j) {
            const f32x4 sh = *(const f32x4*)(mp + sh_off + lane * 4 + 256 * j), sc = *(const f32x4*)(mp + sc_off + lane * 4 + 256 * j);
            const f32x4 y = (x[j] * rstd * gv[j]) * (sc + 1.0f) + sh;
            u32x2 w; w.x = cvt_pk_bf16(y[0], y[1]); w.y = cvt_pk_bf16(y[2], y[3]);
            *(u32x2*)(H + (size_t)row * 1024 + lane * 4 + 256 * j) = w;
        }
    }
}


__device__ __forceinline__ void norm_rows_lds(const float* xlat, const float* xctx, int nrows, const float* g, const float* modsl, bf16_t* H, int gw, int NGW, int lane, int tid, LAS unsigned char* lds) {
    LAS float* tab = (LAS float*)lds;
    for (int i = tid; i < 5 * 1024; i += 512) { const int v = i >> 10, k = i & 1023; tab[(v * 2) * 1024 + k] = g[k] * (1.0f + modsl[(size_t)v * 6144 + 1024 + k]); tab[(v * 2 + 1) * 1024 + k] = modsl[(size_t)v * 6144 + k]; }
    __syncthreads();
    for (int row = gw; row < nrows; row += NGW) {
        const float* src = row < ML ? xlat + (size_t)row * 1024 : xctx + (size_t)(row - ML) * 1024;
        const int v = row < ML ? (row >> 12) : 4;
        f32x4 x[4]; float ss = 0.f;
#pragma unroll
        for (int j = 0; j < 4; ++j) { x[j] = __builtin_nontemporal_load((const f32x4*)(src + lane * 4 + 256 * j)); ss += (x[j][0] * x[j][0] + x[j][1] * x[j][1]) + (x[j][2] * x[j][2] + x[j][3] * x[j][3]); }
        const float rstd = rsqrtf(wave_sum(ss) * (1.0f / 1024.0f) + EPS);
#pragma unroll
        for (int j = 0; j < 4; ++j) {
            const f32x4 gs = *(const LAS f32x4*)(tab + (v * 2) * 1024 + lane * 4 + 256 * j), sh = *(const LAS f32x4*)(tab + (v * 2 + 1) * 1024 + lane * 4 + 256 * j);
            const f32x4 y = (x[j] * rstd) * gs + sh;
            u32x2 w; w.x = cvt_pk_bf16(y[0], y[1]); w.y = cvt_pk_bf16(y[2], y[3]);
            *(u32x2*)(H + (size_t)row * 1024 + lane * 4 + 256 * j) = w;
        }
    }
    __syncthreads();
}
__device__ __forceinline__ void bias_items(const bf16_t* W1t, const bf16_t* CS, const float* mods, float* BV0, float* BV1, float* BVF, int w, int NW, int lane) {
    for (int it = w; it < 8192 + 1024; it += NW) {
        float a0 = 0.f, a1 = 0.f, a2 = 0.f, a3 = 0.f; float* dst; int dstride;
        if (it < 8192) {
            const int l = it >> 12, n = it & 4095;
            const bf16_t* wr_ = W1t + (size_t)l * 4096 * 1024 + (size_t)n * 1024 + lane * 16;
            const u32x4 w0 = *(const u32x4*)wr_, w1 = *(const u32x4*)(wr_ + 8);
            const float* sh = mods + (size_t)l * 5 * 6144 + 3072 + lane * 16;
            float wf[16];
#pragma unroll
            for (int e = 0; e < 4; ++e) { wf[2 * e] = __uint_as_float(w0[e] << 16); wf[2 * e + 1] = __uint_as_float(w0[e] & 0xffff0000u); wf[8 + 2 * e] = __uint_as_float(w1[e] << 16); wf[8 + 2 * e + 1] = __uint_as_float(w1[e] & 0xffff0000u); }
#pragma unroll
            for (int q = 0; q < 4; ++q) {
                const f32x4 s0 = *(const f32x4*)(sh + 4 * q), s1 = *(const f32x4*)(sh + 6144 + 4 * q), s2 = *(const f32x4*)(sh + 2 * 6144 + 4 * q), s3 = *(const f32x4*)(sh + 3 * 6144 + 4 * q);
#pragma unroll
                for (int e = 0; e < 4; ++e) { a0 += s0[e] * wf[4 * q + e]; a1 += s1[e] * wf[4 * q + e]; a2 += s2[e] * wf[4 * q + e]; a3 += s3[e] * wf[4 * q + e]; }
            }
            dst = (l == 0 ? BV0 : BV1) + n; dstride = 4096;
        } else {
            const int idx = it - 8192, g = idx >> 8, m = idx & 255;
            const u32x2 w0 = *(const u32x2*)(CS + (size_t)m * 256 + lane * 4);
            const float wf0 = __uint_as_float(w0[0] << 16), wf1 = __uint_as_float(w0[0] & 0xffff0000u), wf2 = __uint_as_float(w0[1] << 16), wf3 = __uint_as_float(w0[1] & 0xffff0000u);
            const float* sh = mods + (size_t)5 * 6144 + g * 256 + lane * 4;
            const f32x4 s0 = *(const f32x4*)(sh), s1 = *(const f32x4*)(sh + 6144), s2 = *(const f32x4*)(sh + 2 * 6144), s3 = *(const f32x4*)(sh + 3 * 6144);
            a0 = s0[0] * wf0 + s0[1] * wf1 + s0[2] * wf2 + s0[3] * wf3; a1 = s1[0] * wf0 + s1[1] * wf1 + s1[2] * wf2 + s1[3] * wf3;
            a2 = s2[0] * wf0 + s2[1] * wf1 + s2[2] * wf2 + s2[3] * wf3; a3 = s3[0] * wf0 + s3[1] * wf1 + s3[2] * wf2 + s3[3] * wf3;
            dst = BVF + g * 256 + m; dstride = 1024;
        }
        a0 = wave_sum(a0); a1 = wave_sum(a1); a2 = wave_sum(a2); a3 = wave_sum(a3);
        if (lane == 0) { dst[0] = a0; dst[dstride] = a1; dst[2 * dstride] = a2; dst[3 * dstride] = a3; }
    }
}
template <bool MASKED>
__device__ __forceinline__ void attn_block(const LAS bf16_t* Ks, const LAS bf16_t* Vs, int kcol0, int fr, int g, const bf16x8 (&Qf)[2], f32x4 (&acc)[4], float& lsum,
                                           const LAS unsigned char* rpb_base  , const int (&dcb)[8], const f32x4& ciX, const f32x4& ciY) {
    bf16x8 KX[2], KY[2];
#pragma unroll
    for (int kk = 0; kk < 2; ++kk) { KX[kk] = *(const LAS bf16x8*)(Ks + (kcol0 + fr) * 72 + kk * 32 + g * 8); KY[kk] = *(const LAS bf16x8*)(Ks + (kcol0 + 16 + fr) * 72 + kk * 32 + g * 8); }
    s16x4 VX[4], VY[4];
#pragma unroll
    for (int db = 0; db < 4; ++db) { VX[db] = *(const LAS s16x4*)(Vs + (16 * db + fr) * 72 + kcol0 + 4 * g); VY[db] = *(const LAS s16x4*)(Vs + (16 * db + fr) * 72 + kcol0 + 16 + 4 * g); }
    f32x4 sX = mfma16(KX[0], Qf[0], ciX); sX = mfma16(KX[1], Qf[1], sX);
    f32x4 sY = mfma16(KY[0], Qf[0], ciY); sY = mfma16(KY[1], Qf[1], sY);
    f32x4 pX, pY;
    if (MASKED) {
#pragma unroll
        for (int ii = 0; ii < 4; ++ii) {
            const float bx = *(const LAS float*)(rpb_base + dcb[ii]), by = *(const LAS float*)(rpb_base + dcb[4 + ii]);
            pX[ii] = __builtin_amdgcn_exp2f(sX[ii] + bx);
            pY[ii] = __builtin_amdgcn_exp2f(sY[ii] + by);
        }
    } else {
#pragma unroll
        for (int ii = 0; ii < 4; ++ii) { pX[ii] = __builtin_amdgcn_exp2f(sX[ii]); pY[ii] = __builtin_amdgcn_exp2f(sY[ii]); }
    }
    lsum += ((pX[0] + pX[1]) + (pX[2] + pX[3])) + ((pY[0] + pY[1]) + (pY[2] + pY[3]));
    const u32x4 pw = pg8::pack8(pX, pY);
    const bf16x8 Pf = __builtin_bit_cast(bf16x8, pw);
#pragma unroll
    for (int db = 0; db < 4; ++db) {
        bf16x8 Vf; Vf[0] = VX[db][0]; Vf[1] = VX[db][1]; Vf[2] = VX[db][2]; Vf[3] = VX[db][3]; Vf[4] = VY[db][0]; Vf[5] = VY[db][1]; Vf[6] = VY[db][2]; Vf[7] = VY[db][3];
        acc[db] = mfma16(Vf, Pf, acc[db]);
    }
}
__device__ __forceinline__ void attn_phase(const bf16_t* QK, const bf16_t* VT, bf16_t* O, const float* rpb, const float* sbound, LAS unsigned char* lds, int G, int c) {
    constexpr int RP_BYTES = 30720, TILE_B = 64 * 72 * 2, PAIR_B = 4 * TILE_B, NPAIR = 7;
    LAS float* rp = (LAS float*)lds;
    int tid = threadIdx.x; asm volatile("" : "+v"(tid));
    const int lane = tid & 63, wid = __builtin_amdgcn_readfirstlane(tid >> 6), fr = lane & 15, g = lane >> 4;
    for (int i = tid; i < 16 * 465; i += 512) rp[i] = rpb[i] * LOG2E;
    const float Mb = *sbound;
    const int nunits = (2048 - c + G - 1) / G;
    const int ND = nunits * NPAIR;
    const int trow = tid >> 3, tch = tid & 7;
    const int ldsoff = (trow * 72 + tch * 8) * 2;
#define ATT_DEC(L_, b_, h_, rp_) do { const int x_ = (L_) & 7, q_ = (L_) >> 3; rp_ = q_ & 31; const int bh_ = 8 * (q_ >> 5) + x_; b_ = bh_ >> 4; h_ = bh_ & 15; } while (0)
#define ATT_TOK(b_, rs0_, t_) ((t_) < 9 ? (b_) * 4096 + min((rs0_) + (t_), 63) * 64 : ML + (b_) * 256 + 64 * (min((t_), 12) - 9))
#define ATT_GLOAD(D_, R) do { const int u_ = (D_) / NPAIR, p_ = (D_) - u_ * NPAIR; int b_, h_, rp_; ATT_DEC(u_ * G + c, b_, h_, rp_); \
        const int rs0_ = min(max(2 * rp_ - 4, 0), 56); const int tk0_ = ATT_TOK(b_, rs0_, 2 * p_), tk1_ = ATT_TOK(b_, rs0_, 2 * p_ + 1); \
        const bf16_t* kb_ = QK + (size_t)trow * 2048 + 1024 + h_ * 64 + tch * 8; const bf16_t* vb_ = VT + (size_t)(h_ * 64 + trow) * MT + tch * 8; \
        R[0] = *(const u32x4*)(kb_ + (size_t)tk0_ * 2048); R[1] = *(const u32x4*)(vb_ + tk0_); R[2] = *(const u32x4*)(kb_ + (size_t)tk1_ * 2048); R[3] = *(const u32x4*)(vb_ + tk1_); } while (0)
#define ATT_LWRITE(slot_, R) do { _Pragma("unroll") for (int q_ = 0; q_ < 4; ++q_) *(LAS u32x4*)(lds + RP_BYTES + (slot_) * PAIR_B + q_ * TILE_B + ldsoff) = R[q_]; } while (0)
    u32x4 R0[4], R1[4];
    ATT_GLOAD(0, R0); ATT_LWRITE(0, R0);
    if (ND > 1) ATT_GLOAD(1, R1);
    if (ND > 2) ATT_GLOAD(2, R0);
    __syncthreads();
    int b = 0, h = 0, rpair = 0, r = 0, rs0 = 0, rsr = 0, qrow = 0;
    const int j = wid & 3, w0 = (j == 0) ? 0 : (j == 1) ? 8 : (j == 2) ? 24 : 32;
    int dcb[8]; f32x4 ciX, ciY, ciU;
    {
        const int cq = 16 * j + fr, cs = min(max(cq - 8, 0), 48), eX = w0 + 4 * g - cs, dX = w0 + 4 * g - cq + 15;
#pragma unroll
        for (int ii = 0; ii < 4; ++ii) {
            dcb[ii] = 4 * min(max(dX + ii, 0), 30); dcb[4 + ii] = 4 * min(max(dX + 16 + ii, 0), 30);
            ciX[ii] = ((unsigned)(eX + ii) < 16u) ? -Mb : -1.0e30f; ciY[ii] = ((unsigned)(eX + 16 + ii) < 16u) ? -Mb : -1.0e30f; ciU[ii] = -Mb;
        }
    }
    bf16x8 Qf[2], Qn[2]; f32x4 acc[4]; float lsum = 0.f;
    int p = 0, u = 0, D = 0;
#define ATT_QLOAD(dst, uu) do { int b_, h_, rp_; ATT_DEC((uu) * G + c, b_, h_, rp_); const int qr_ = b_ * 4096 + (2 * rp_ + (wid >> 2)) * 64 + 16 * j + fr; \
        _Pragma("unroll") for (int kk = 0; kk < 2; ++kk) dst[kk] = *(const bf16x8*)(QK + (size_t)qr_ * 2048 + h_ * 64 + 32 * kk + 8 * g); } while (0)
#define ATT_TILE(t_, toff_) do { \
        const LAS bf16_t* Ks = (const LAS bf16_t*)(lds + RP_BYTES + slot * PAIR_B + (toff_)); \
        const LAS bf16_t* Vs = (const LAS bf16_t*)(lds + RP_BYTES + slot * PAIR_B + (toff_) + TILE_B); \
        if ((t_) < 9) { \
            const int kr = rs0 + (t_), i = kr - rsr; \
            if (i >= 0 && i < 8) attn_block<true>(Ks, Vs, w0, fr, g, Qf, acc, lsum, (const LAS unsigned char*)rp + (h * 465 + (kr - r + 7) * 31) * 4, dcb, ciX, ciY); \
        } else if ((t_) < 13) { \
            attn_block<false>(Ks, Vs, 0, fr, g, Qf, acc, lsum, (const LAS unsigned char*)rp, dcb, ciU, ciU); \
            attn_block<false>(Ks, Vs, 32, fr, g, Qf, acc, lsum, (const LAS unsigned char*)rp, dcb, ciU, ciU); \
        } } while (0)
    ATT_QLOAD(Qn, 0);
#define ATT_ITER(R) do { \
        const int slot = D & 1; \
        if (D + 1 < ND) ATT_LWRITE(slot ^ 1, R); \
        if (D + 3 < ND) ATT_GLOAD(D + 3, R); \
        if (p == 0) { \
            ATT_DEC(u * G + c, b, h, rpair); \
            r = 2 * rpair + (wid >> 2); rs0 = min(max(2 * rpair - 4, 0), 56); rsr = min(max(r - 4, 0), 56); \
            qrow = b * 4096 + r * 64 + 16 * j + fr; \
            Qf[0] = Qn[0]; Qf[1] = Qn[1]; \
            _Pragma("unroll") for (int db = 0; db < 4; ++db) acc[db] = (f32x4){0.f, 0.f, 0.f, 0.f}; \
            lsum = 0.f; \
        } \
        if (p == 4 && u + 1 < nunits) ATT_QLOAD(Qn, u + 1); \
        { const int i0_ = rs0 + 2 * p - rsr, i1_ = i0_ + 1; \
          if (2 * p + 1 < 9 && i0_ >= 0 && i1_ < 8) {        \
            const LAS bf16_t* Ka = (const LAS bf16_t*)(lds + RP_BYTES + slot * PAIR_B); const LAS bf16_t* Va = (const LAS bf16_t*)(lds + RP_BYTES + slot * PAIR_B + TILE_B); \
            const LAS bf16_t* Kb = (const LAS bf16_t*)(lds + RP_BYTES + slot * PAIR_B + 2 * TILE_B); const LAS bf16_t* Vb = (const LAS bf16_t*)(lds + RP_BYTES + slot * PAIR_B + 3 * TILE_B); \
            const LAS unsigned char* rb_ = (const LAS unsigned char*)rp + (h * 465 + (rs0 + 2 * p - r + 7) * 31) * 4; \
            attn_block<true>(Ka, Va, w0, fr, g, Qf, acc, lsum, rb_, dcb, ciX, ciY); \
            attn_block<true>(Kb, Vb, w0, fr, g, Qf, acc, lsum, rb_ + 124, dcb, ciX, ciY); \
          } else { ATT_TILE(2 * p, 0); ATT_TILE(2 * p + 1, 2 * TILE_B); } } \
        if (p == NPAIR - 1) { \
            float ls = lsum; ls += __shfl_xor(ls, 16); ls += __shfl_xor(ls, 32); \
            const float inv = 1.0f / ls; \
            bf16_t* op = O + (size_t)qrow * 1024 + h * 64 + 4 * g; \
            _Pragma("unroll") for (int db = 0; db < 4; ++db) { u32x2 w; w.x = cvt_pk_bf16(acc[db][0] * inv, acc[db][1] * inv); w.y = cvt_pk_bf16(acc[db][2] * inv, acc[db][3] * inv); st8(op + 16 * db, w); } \
            p = 0; ++u; \
        } else ++p; \
        __syncthreads(); \
    } while (0)
    for (;;) {
        ATT_ITER(R1); if (++D >= ND) break;
        ATT_ITER(R0); if (++D >= ND) break;
    }
#undef ATT_ITER
#undef ATT_TILE
#undef ATT_QLOAD
#undef ATT_DEC
#undef ATT_TOK
#undef ATT_GLOAD
#undef ATT_LWRITE
}

__device__ __forceinline__ void s1_phase(const bf16_t* Z0, const bf16_t* Dg, bf16_t* Z1, LAS unsigned char* lds, int gw, int NGW) {
    constexpr int DP = 136;
    LAS bf16_t* Dl = (LAS bf16_t*)lds;
    int tid = threadIdx.x; asm volatile("" : "+v"(tid));
    const int lane = tid & 63, fr = lane & 15, g = lane >> 4;
    for (int i = tid; i < 128 * 16; i += 512) { const int row = i >> 4, ch = i & 15; *(LAS u32x4*)(Dl + row * DP + ch * 8) = *(const u32x4*)(Dg + row * 128 + ch * 8); }
    __syncthreads();
    for (int job = gw; job < 2048 + 64; job += NGW) {
        const bool part = job >= 2048;
        const int colM = part ? 2048 + ((job - 2048) >> 2) : job, ib0 = part ? ((job - 2048) & 3) : 0, nib = part ? 1 : 4;
        bf16x8 A[4][4];
#pragma unroll
        for (int ib = 0; ib < 4; ++ib) { const int ibr = part ? ib0 : ib;
#pragma unroll
            for (int kb = 0; kb < 4; ++kb) A[ib][kb] = *(const bf16x8*)(Z0 + ((size_t)colM * 64 + 16 * ibr + fr) * 128 + 32 * kb + 8 * g); }
#pragma unroll 2
        for (int jb = 0; jb < 8; ++jb) {
            bf16x8 Bf[4];
#pragma unroll
            for (int kb = 0; kb < 4; ++kb) Bf[kb] = *(const LAS bf16x8*)(Dl + (16 * jb + fr) * DP + 32 * kb + 8 * g);
            const int n = 16 * jb + fr, ka = n >> 1, rip = n & 1;
#pragma unroll
            for (int ib = 0; ib < 4; ++ib) {
                if (ib < nib) {
                    f32x4 a = (f32x4){0.f, 0.f, 0.f, 0.f};
#pragma unroll
                    for (int kb = 0; kb < 4; ++kb) a = mfma16(A[ib][kb], Bf[kb], a);
                    u32x2 w; w.x = cvt_pk_bf16(a[0], a[1]); w.y = cvt_pk_bf16(a[2], a[3]);
                    st8(Z1 + (((size_t)ka * pg8::NCOL + colM) * 2 + rip) * 64 + 16 * (part ? ib0 : ib) + 4 * g, w);
                }
            }
        }
    }
    __syncthreads();
}
__device__ __forceinline__ void s2_phase(const bf16_t* Z1, const bf16_t* Eg, bf16_t* F, LAS unsigned char* lds, int G, int c) {
    constexpr int EP = 136;
    LAS bf16_t* El = (LAS bf16_t*)lds;
    int tid = threadIdx.x; asm volatile("" : "+v"(tid));
    const int lane = tid & 63, wid = __builtin_amdgcn_readfirstlane(tid >> 6), fr = lane & 15, g = lane >> 4;
    for (int wgi = c; wgi < 256; wgi += G) {
        const int ka = wgi & 63, part = wgi >> 6;
        for (int i = tid; i < 64 * 16; i += 512) { const int row = i >> 4, ch = i & 15; *(LAS u32x4*)(El + row * EP + ch * 8) = *(const u32x4*)(Eg + ((size_t)ka * 64 + row) * 128 + ch * 8); }
        __syncthreads();
        bf16x8 Bf[4][4];
#pragma unroll
        for (int jb = 0; jb < 4; ++jb)
#pragma unroll
            for (int kb = 0; kb < 4; ++kb) Bf[jb][kb] = *(const LAS bf16x8*)(El + (16 * jb + fr) * EP + 32 * kb + 8 * g);
        const int nrun = (part == 0 && wid == 0) ? 2 : 1;
        for (int run = 0; run < nrun; ++run) {
            const bool special = run == 1;
            const int q = part * 8 + wid, bg = q >> 1, ib0 = special ? 0 : 4 * (q & 1), nib = special ? 1 : 4;
            for (int ibb = 0; ibb < nib; ++ibb) {
                const int ib = ib0 + ibb;
                const int colM0 = special ? 2048 : bg * 128 + ib * 16;
                bf16x8 A[4];
#pragma unroll
                for (int kb = 0; kb < 4; ++kb) A[kb] = *(const bf16x8*)(Z1 + ((size_t)ka * pg8::NCOL + colM0 + fr) * 128 + 32 * kb + 8 * g);
                const int k2 = ib * 16 + 4 * g, b = bg >> 2, gg = bg & 3;
#pragma unroll
                for (int jb = 0; jb < 4; ++jb) {
                    f32x4 a = (f32x4){0.f, 0.f, 0.f, 0.f};
#pragma unroll
                    for (int kb = 0; kb < 4; ++kb) a = mfma16(A[kb], Bf[jb][kb], a);
                    const int k = ka + 64 * (16 * jb + fr), km = (4096 - k) & 4095;
                    u32x2 w; w.x = cvt_pk_bf16(a[0], a[1]); w.y = cvt_pk_bf16(a[2], a[3]);
                    if (!special) {
                        st8(F + ((size_t)b * 4096 + k) * 1024 + gg * 256 + k2, w);
                        bf16_t* pm_ = F + ((size_t)b * 4096 + km) * 1024 + gg * 256 + 128 + k2;
                        if (k2 != 0) st8(pm_, w);
                        else { pm_[1] = (bf16_t)(w.x >> 16); *(unsigned*)(pm_ + 2) = w.y; }
                    } else {
                        bf16_t* ps_ = F + ((size_t)g * 4096 + k) * 1024 + 128;
                        ps_[0] = (bf16_t)(w.x & 0xffffu); ps_[256] = (bf16_t)(w.x >> 16); ps_[512] = (bf16_t)(w.y & 0xffffu); ps_[768] = (bf16_t)(w.y >> 16);
                    }
                }
            }
        }
        __syncthreads();
    }
}


#ifndef MK_DEBUG
#define MK_DEBUG 0
#endif
__device__ __forceinline__ void dbg_scan16(const bf16_t* p, size_t n, unsigned* flags, unsigned bit, int gt, int NT) {
    bool bad = false; for (size_t i = gt; i < n; i += NT) bad |= ((p[i] & 0x7f80u) == 0x7f80u);
    if (bad) atomicOr(flags, 1u << bit);
}
__device__ __forceinline__ void dbg_scan32(const float* p, size_t n, unsigned* flags, unsigned bit, int gt, int NT) {
    bool bad = false; for (size_t i = gt; i < n; i += NT) bad |= ((__float_as_uint(p[i]) & 0x7f800000u) == 0x7f800000u);
    if (bad) atomicOr(flags, 1u << bit);
}
struct Args { const float* in[15]; float* out; unsigned char* ws; int ph_lo, ph_hi, use_cg, pad; };
static_assert(sizeof(Args) == 15 * 8 + 8 + 8 + 16, "no padding");

__global__ void __launch_bounds__(512, 2) fwd_kernel(Args args) {
    extern __shared__ __attribute__((aligned(16))) unsigned char lds_raw[];
    LAS unsigned char* lds = (LAS unsigned char*)lds_raw;
    const int G = gridDim.x, c = blockIdx.x;
    const int vcu = (G % 8 == 0) ? (c % 8) * (G / 8) + c / 8 : c;
    const int NGW = G * 8;
#define PHASE_IDS int tid_ = threadIdx.x; asm volatile("" : "+v"(tid_)); const int lane = tid_ & 63, wid = __builtin_amdgcn_readfirstlane(tid_ >> 6); const int gw = vcu * 8 + wid; (void)lane; (void)gw
    unsigned char* ws = args.ws;
    const float* x = args.in[0]; const float* cvec = args.in[1]; const float* ctx = args.in[2]; const float* cctx = args.in[3];
    const float* ada_w = args.in[4]; const float* ada_b = args.in[5]; const float* norm_g = args.in[6];
    const float* wqkv = args.in[7]; const float* wo = args.in[8]; const float* gq = args.in[9]; const float* gk = args.in[10]; const float* rpb = args.in[11];
    const float* fw = args.in[12]; const float* w1 = args.in[13]; const float* w2 = args.in[14];
    float* out = args.out;
    float* mods = (float*)(ws + WS_MODS); float* sbound = (float*)(ws + WS_SB);
    bf16_t* CS = (bf16_t*)(ws + WS_CS); bf16_t* Dt = (bf16_t*)(ws + WS_D); bf16_t* Et = (bf16_t*)(ws + WS_E);
    bf16_t* WQK = (bf16_t*)(ws + WS_WQK); bf16_t* WV = (bf16_t*)(ws + WS_WV); bf16_t* WO = (bf16_t*)(ws + WS_WO); bf16_t* FWt = (bf16_t*)(ws + WS_FW);
    bf16_t* W1t = (bf16_t*)(ws + WS_W1); bf16_t* W2t = (bf16_t*)(ws + WS_W2);
    bf16_t* H = (bf16_t*)(ws + WS_H); bf16_t* QK = (bf16_t*)(ws + WS_QK); bf16_t* VT = (bf16_t*)(ws + WS_VT); bf16_t* O = (bf16_t*)(ws + WS_O);
    bf16_t* XS = (bf16_t*)(ws + WS_XS); bf16_t* HMID = (bf16_t*)(ws + WS_HMID); bf16_t* Z0 = (bf16_t*)(ws + WS_Z0); bf16_t* Z1 = (bf16_t*)(ws + WS_Z1); bf16_t* Fb = (bf16_t*)(ws + WS_F);
    float* SSQ = (float*)(ws + WS_SSQ); float* BV0 = (float*)(ws + WS_BV); float* BV1 = BV0 + 4 * 4096; float* BVF = BV1 + 4 * 4096; float* GM = BVF + 16 * 512;
    const int lo = args.ph_lo, hi = args.ph_hi;
    cg::grid_group grid = cg::this_grid();
#define IN(k) (lo <= (k) && (k) < hi)
#ifndef REP_SYNC
#define REP_SYNC 1
#endif
#ifndef REP_NORM
#define REP_NORM 1
#endif
#ifndef REP_S12
#define REP_S12 1
#endif
#ifndef REP_P0
#define REP_P0 1
#endif
#ifndef USE_XB
#define USE_XB 1
#endif
#define SEAM(k) do { if (IN(k) && IN((k) + 1)) { for (int r_ = 0; r_ < REP_SYNC; ++r_) { if (use_cg) grid.sync(); else xcd_barrier(xbar); } } } while (0)
    { volatile LAS unsigned* st_ = (volatile LAS unsigned*)(lds + LDS_BYTES - 64); if (threadIdx.x < 2) st_[threadIdx.x] = 0u; __syncthreads(); }
    XcdBarrier xbar; xbar.bar = (unsigned*)(ws + WS_BAR); xbar.x = 0; xbar.st = (volatile LAS unsigned*)(lds + LDS_BYTES - 64);
    const bool use_cg = (args.use_cg != 0);
    if (!use_cg && hi - lo > 1) xbar = xcd_barrier_post((unsigned*)(ws + WS_BAR), (volatile LAS unsigned*)(lds + LDS_BYTES - 64));

    unsigned* dflags = (unsigned*)(ws + WS_SB + 256);
#define DBG16(k, bit, p, n) do { if (MK_DEBUG && IN(k)) { int t_ = threadIdx.x; asm volatile("" : "+v"(t_)); dbg_scan16(p, n, dflags, bit, (vcu * 512) + t_, G * 512); } } while (0)
#define DBG32(k, bit, p, n) do { if (MK_DEBUG && IN(k)) { int t_ = threadIdx.x; asm volatile("" : "+v"(t_)); dbg_scan32(p, n, dflags, bit, (vcu * 512) + t_, G * 512); } } while (0)
    if (IN(0)) {
        PHASE_IDS;
        if (MK_DEBUG && c == 0 && tid_ == 0) *dflags = 0u;
        for (int r0_ = 0; r0_ < REP_P0; ++r0_) {
        for (int u = c; u < 192; u += G) p0_mods_unit(cvec, cctx, ada_w, ada_b, mods, lds, u);
        __syncthreads();
        {
            LAS float* scr = (LAS float*)(lds + wid * 16384);
            constexpr int I_QKV = 16 * 96, I_SQ = 16 * 32, I_1 = 16 * 128, I_2 = 64 * 32;
            constexpr int NITEMS = I_QKV + I_SQ + 2 * I_1;
            for (int it = NITEMS - 1 - gw; it >= 0; it -= NGW) {
                int r = it;
                if (r < I_QKV) { p0_transpose_item(wqkv, 1024, 3072, WQK, WV, 1, scr, r, lane); continue; } r -= I_QKV;
                if (r < I_SQ) { p0_transpose_item(wo, 1024, 1024, WO, nullptr, 0, scr, r, lane); continue; } r -= I_SQ;
                { const int l = r / I_1; p0_transpose_item(w1 + (size_t)l * 1024 * 4096, 1024, 4096, W1t + (size_t)l * 4096 * 1024, nullptr, 0, scr, r % I_1, lane); }
            }
        }
        {
            const int gt = gw * 64 + lane, NT = NGW * 64;
            for (int i = gt; i < 256 * 256; i += NT) { const int m = i >> 8, cc = i & 255, ri = m >> 7, k2 = m & 127; float sn, cs; sincospif(2.0f * (float)((cc * k2) & 255) / 256.0f, &sn, &cs);
                float v = (ri == 0 ? cs : -sn) * (1.0f / 16.0f); if (m == 128) v = (cc & 1) ? -(1.0f / 16.0f) : (1.0f / 16.0f);
                CS[i] = (bf16_t)(cvt_pk_bf16(v, 0.f) & 0xffffu); }
            for (int i = gt; i < 128 * 128; i += NT) { const int n = i >> 7, kp = i & 127, ka = n >> 1, rip = n & 1, ri = kp >> 6, a = kp & 63; float sn, cs; sincospif(2.0f * (float)((a * ka) & 63) / 64.0f, &sn, &cs);
                const float v = (rip == 0 ? (ri == 0 ? cs : sn) : (ri == 0 ? -sn : cs)) * 0.125f; Dt[i] = (bf16_t)(cvt_pk_bf16(v, 0.f) & 0xffffu); }
            for (int i = gt; i < 64 * 64 * 128; i += NT) { const int kp = i & 127, kbk = (i >> 7) & 63, ka = i >> 13, rip = kp >> 6, bp = kp & 63; float sn, cs; sincospif(2.0f * (float)((bp * (ka + 64 * kbk)) & 4095) / 4096.0f, &sn, &cs);
                const float v = (rip == 0 ? cs : sn) * 0.125f; Et[i] = (bf16_t)(cvt_pk_bf16(v, 0.f) & 0xffffu); }
        }
        if (c == G - 1) {
            float mr = 0.f;
#pragma unroll 5
            for (int i = tid_; i < 16 * 465; i += 512) mr = fmaxf(mr, fabsf(rpb[i]));
#pragma unroll
            for (int o = 1; o < 64; o <<= 1) mr = fmaxf(mr, __shfl_xor(mr, o));
            LAS float* red_ = (LAS float*)(lds + 131072);
            if (lane == 0) red_[wid] = mr;
            __syncthreads();
            if (wid == 0) {
                float mq = fabsf(gq[lane]), mk = fabsf(gk[lane]); mr = red_[lane & 7];
#pragma unroll
                for (int o = 1; o < 64; o <<= 1) { mq = fmaxf(mq, __shfl_xor(mq, o)); mk = fmaxf(mk, __shfl_xor(mk, o)); mr = fmaxf(mr, __shfl_xor(mr, o)); }
                if (lane == 0) *sbound = (8.0f * mq * mk + mr) * LOG2E;
            }
        }
        __syncthreads();
        }
    }
    SEAM(0);
    const bool ctx_in_p1 = false;
    if (IN(1)) { PHASE_IDS;
        if (!ctx_in_p1) norm_rows_lds(x, ctx, MT, norm_g, mods, H, gw, NGW, lane, tid_, lds);
        else if (c >= 32) norm_rows(x, ctx, ML, norm_g, mods, 0, 1024, H, (c - 32) * 8 + wid, (G - 32) * 8, lane);
        else {
            pg8::SchedOne S1u; const size_t ts = (size_t)256 * 1024 * 2; int tt;
            if (c < 16) { S1u.u.kind = 0; S1u.u.pm = 64 + (c & 3); S1u.u.pn = 4 + (c >> 2); tt = c & 3; S1u.u.a = (const char*)H + (size_t)S1u.u.pm * ts; S1u.u.b = (const char*)WQK + (size_t)S1u.u.pn * ts; }
            else { const int l2 = c - 16; S1u.u.kind = 1; S1u.u.pm = l2 & 3; S1u.u.pn = 64 + (l2 >> 2); tt = l2 >> 2; S1u.u.a = (const char*)WV + (size_t)S1u.u.pm * ts; S1u.u.b = (const char*)H + (size_t)S1u.u.pn * ts; }
            S1u.u.aux = 0;
            norm_rows(x, ctx, ML + tt * 256 + 256, norm_g, mods, 0, 1024, H, ML + tt * 256 + wid, 8, lane);
            asm volatile("s_waitcnt vmcnt(0)" ::: "memory"); __syncthreads();
            pg8::EpiQKV E{QK, VT, gq, gk};
            pg8::gemm_phase<pg8::EpiQKV, pg8::SchedOne, false>(lds, 1024, 1024, 1024, S1u, E);
        }
    }
    SEAM(1);
    DBG16(2, 0, H, (size_t)MT * 1024);
    if (IN(2)) { pg8::SchedQKV S{(const char*)H, (const char*)WQK, (const char*)WV, G, c, ctx_in_p1 ? 768 : 800}; pg8::EpiQKV E{QK, VT, gq, gk};
#ifndef REP_G2
#define REP_G2 1
#endif
        for (int r_ = 0; r_ < REP_G2; ++r_) pg8::gemm_phase<pg8::EpiQKV, pg8::SchedQKV, false>(lds, 1024, 1024, 1024, S, E);
        { PHASE_IDS;
          const bool part = (G > 32); const int w_ = part ? (c - 32) * 8 + wid : gw, nw_ = part ? (G - 32) * 8 : NGW;
          if (!part || c >= 32) {
              for (int i = w_ * 64 + lane; i < 3 * 4096; i += nw_ * 64) { const int idx = i >> 12, b = (i >> 10) & 3, col = i & 1023;
                  const float gg = norm_g[(idx == 0 ? 1024 : idx == 1 ? 2048 : 3072) + col];
                  const float sc = mods[(size_t)((idx == 0 ? 0 : 5) + b) * 6144 + (idx == 1 ? 1024 : 4096) + col];
                  GM[i] = gg * (1.0f + sc); }
              bias_items(W1t, CS, mods, BV0, BV1, BVF, w_, nw_, lane);
              LAS float* scr = (LAS float*)(lds + wid * 16384);
              constexpr int I_SQ = 16 * 32, I_2 = 64 * 32;
              for (int it = w_; it < I_SQ + 2 * I_2; it += nw_) {
                  if (it < I_SQ) p0_transpose_item(fw, 1024, 1024, FWt, nullptr, 2, scr, it, lane);
                  else { const int r2 = it - I_SQ, l = r2 / I_2; p0_transpose_item(w2 + (size_t)l * 4096 * 1024, 4096, 1024, W2t + (size_t)l * 1024 * 4096, nullptr, 0, scr, r2 % I_2, lane); }
              }
          } } }
    SEAM(2);
    DBG16(3, 1, QK, (size_t)ML * 2048); DBG16(3, 2, VT, (size_t)1024 * MT); DBG32(3, 13, mods, (size_t)10 * 6144);
#ifndef REP_ATT
#define REP_ATT 1
#endif
    if (IN(3)) { for (int rep = 0; rep < REP_ATT; ++rep) attn_phase(QK, VT, O, rpb, sbound, lds, G, c); }
    SEAM(3);
    DBG16(4, 3, O, (size_t)ML * 1024);
    if (IN(4)) { pg8::SchedStd S; S.init(O, WO, ML, 1024, 1024, 1024, G, c); pg8::EpiResF<false> E{x, XS, mods + 2048, GM, H, SSQ};
        pg8::gemm_phase<pg8::EpiResF<false>, pg8::SchedStd, false>(lds, 1024, 1024, 1024, S, E); }
    SEAM(4);
    DBG32(5, 4, out, (size_t)ML * 1024);
    if (IN(6)) { pg8::SchedStd S; S.init(H, W1t, ML, 4096, 1024, 1024, G, c); pg8::EpiRelu2F E{HMID, 4096, BV0, SSQ};
        pg8::gemm_phase<pg8::EpiRelu2F, pg8::SchedStd, false>(lds, 1024, 1024, 1024, S, E); }
    SEAM(6);
    DBG16(7, 5, HMID, (size_t)ML * 4096);
    if (IN(7)) { pg8::SchedStd S; S.init(HMID, W2t, ML, 1024, 64, 4096, G, c, (size_t)64 * 32768); pg8::EpiResF<true> E{XS, XS, mods + 5120, GM + 4096, H, SSQ};
        pg8::gemm_phase<pg8::EpiResF<true>, pg8::SchedStd, false>(lds, 4096, 64, 4096, S, E, 32768, 128); }
    SEAM(7);
    const float* mods1 = mods + 5 * 6144;
    DBG32(8, 6, out, (size_t)ML * 1024);
    if (IN(9)) { pg8::SchedF1 S{(const char*)CS, (const char*)H, G, c}; pg8::EpiZ0F E{Z0, BVF, SSQ};
        pg8::gemm_phase<pg8::EpiZ0F, pg8::SchedF1, true>(lds, 256, 256, 1024, S, E); }
    SEAM(9);
    DBG16(10, 7, Z0, (size_t)262144 * 128);
    if (IN(10)) { PHASE_IDS; for (int r_ = 0; r_ < REP_S12; ++r_) s1_phase(Z0, Dt, Z1, lds, gw, NGW); }
    SEAM(10);
    DBG16(11, 8, Z1, (size_t)262144 * 128);
    if (IN(11)) { s2_phase(Z1, Et, Fb, lds, G, c); }
    SEAM(11);
    DBG16(12, 9, Fb, (size_t)ML * 1024);
    if (IN(12)) { pg8::SchedStd S; S.init(Fb, FWt, ML, 1024, 1024, 1024, G, c); pg8::EpiResF<true> E{XS, XS, mods1 + 2048, GM + 8192, H, SSQ};
        pg8::gemm_phase<pg8::EpiResF<true>, pg8::SchedStd, false>(lds, 1024, 1024, 1024, S, E); }
    SEAM(12);
    DBG32(13, 10, out, (size_t)ML * 1024);
    if (IN(14)) { pg8::SchedStd S; S.init(H, W1t + (size_t)4096 * 1024, ML, 4096, 1024, 1024, G, c); pg8::EpiRelu2F E{HMID, 4096, BV1, SSQ};
        pg8::gemm_phase<pg8::EpiRelu2F, pg8::SchedStd, false>(lds, 1024, 1024, 1024, S, E); }
    SEAM(14);
    DBG16(15, 11, HMID, (size_t)ML * 4096);
    if (IN(15)) { pg8::SchedStd S; S.init(HMID, W2t + (size_t)1024 * 4096, ML, 1024, 64, 4096, G, c, (size_t)64 * 32768); pg8::EpiRes E{XS, out, mods1 + 5120};
        pg8::gemm_phase<pg8::EpiRes, pg8::SchedStd, false>(lds, 4096, 64, 4096, S, E, 32768, 128); }
    SEAM(15);
    if (MK_DEBUG && IN(16)) {
        int t_ = threadIdx.x; asm volatile("" : "+v"(t_));
        bool bad = false;
        for (size_t i = (size_t)vcu * 512 + t_; i < (size_t)ML * 1024; i += (size_t)G * 512) { if ((__float_as_uint(out[i]) & 0x7f800000u) == 0x7f800000u) { bad = true; out[i] = 0.f; } }
        if (bad) atomicOr(dflags, 1u << 12);
    }
    SEAM(16);
    if (MK_DEBUG && IN(17)) {
        if (c == 0 && threadIdx.x == 0) { const unsigned f = *dflags; if (f) out[0] = 1.0e6f * (float)(__builtin_ctz(f) + 1) + 1.0e4f * (float)__builtin_popcount(f); }
    }
#undef IN
#undef SEAM
}

constexpr int NPHASE = MK_DEBUG ? 18 : 16;
#ifndef MK_USE_CG
#define MK_USE_CG 0
#endif
#ifndef MK_PER_PHASE
#define MK_PER_PHASE 0
#endif

extern "C" void kernel_launch(void* const* d_in, const int* in_sizes, int n_in, void* d_out, int out_size, void* d_ws, size_t ws_size, hipStream_t stream) {
    static int grid = 0;
    if (grid == 0) {
        if (n_in != 15 || out_size != ML * DM || ws_size < WS_END) { fprintf(stderr, "kernel_launch: unexpected shapes (n_in %d out %d ws %zu)\n", n_in, out_size, ws_size); grid = -1; return; }
        int dev = 0, cus = 0, per_cu = 0;
        hipGetDevice(&dev); hipDeviceGetAttribute(&cus, hipDeviceAttributeMultiprocessorCount, dev);
        hipFuncSetAttribute((const void*)fwd_kernel, hipFuncAttributeMaxDynamicSharedMemorySize, LDS_BYTES);
        if (hipOccupancyMaxActiveBlocksPerMultiprocessor(&per_cu, (const void*)fwd_kernel, 512, LDS_BYTES) != hipSuccess || per_cu < 1) { fprintf(stderr, "kernel_launch: occupancy query failed (%d)\n", per_cu); (void)hipGetLastError(); per_cu = 1; }
        grid = cus * 1;
        if (grid <= 0) grid = 256;
    }
    if (grid < 0) return;
    if (hipMemsetAsync((char*)d_ws + WS_BAR, 0, BAR_BYTES, stream) != hipSuccess) { fprintf(stderr, "kernel_launch: memset failed\n"); return; }
    Args a{};
    for (int i = 0; i < 15; ++i) a.in[i] = (const float*)d_in[i];
    a.out = (float*)d_out; a.ws = (unsigned char*)d_ws;
#if MK_PER_PHASE
    for (int p = 0; p < NPHASE; ++p) { a.ph_lo = p; a.ph_hi = p + 1; hipLaunchKernelGGL(fwd_kernel, dim3(grid), dim3(512), LDS_BYTES, stream, a); }
#else
    a.ph_lo = 0; a.ph_hi = NPHASE; a.use_cg = MK_USE_CG;
    void* kargs[] = {&a};
    hipError_t e = hipLaunchCooperativeKernel((const void*)fwd_kernel, dim3(grid), dim3(512), kargs, LDS_BYTES, stream);
    if (e != hipSuccess) fprintf(stderr, "cooperative launch failed: %s (grid %d)\n", hipGetErrorString(e), grid);
#endif
}
```

```cpp
#include <hip/hip_runtime.h>
#include <hip/hip_cooperative_groups.h>
#include <cstdio>
#include <cstdint>
namespace cg = cooperative_groups;

#define LAS __attribute__((address_space(3)))
typedef unsigned short bf16_t;
typedef short bf16x8 __attribute__((ext_vector_type(8)));
typedef short s16x4 __attribute__((ext_vector_type(4)));
typedef float f32x4 __attribute__((ext_vector_type(4)));
typedef unsigned u32x4 __attribute__((ext_vector_type(4)));
typedef unsigned u32x2 __attribute__((ext_vector_type(2)));

constexpr int DM = 1024, NB = 4, SEQ = 4096, CTXL = 256, FF = 4096;
constexpr int ML = NB * SEQ;
constexpr int MT = ML + NB * CTXL;
constexpr float LOG2E = 1.4426950408889634f;
constexpr float EPS = 1e-6f;

constexpr size_t MiB = 1u << 20;
constexpr size_t WS_MODS = 0;
constexpr size_t WS_SB = 512 * 1024;
constexpr size_t WS_BAR = 1 * MiB;
constexpr size_t BAR_BYTES = 16384;
constexpr size_t WS_CS = 2 * MiB;
constexpr size_t WS_D = 2 * MiB + 512 * 1024;
constexpr size_t WS_E = 3 * MiB;
constexpr size_t WS_WQK = 4 * MiB, WS_WV = 8 * MiB, WS_WO = 10 * MiB, WS_FW = 12 * MiB;
constexpr size_t WS_W1 = 14 * MiB;
constexpr size_t WS_W2 = 30 * MiB;
constexpr size_t WS_SSQ = 46 * MiB;
constexpr size_t WS_BV = 47 * MiB;
constexpr size_t WS_H = 48 * MiB;
constexpr size_t WS_R = 82 * MiB;
constexpr size_t WS_QK = WS_R;
constexpr size_t WS_VT = WS_R + 68 * MiB;
constexpr size_t WS_O = WS_R + 102 * MiB;
constexpr size_t WS_HMID = WS_R;
constexpr size_t WS_Z0 = WS_R;
constexpr size_t WS_Z1 = WS_R + 64 * MiB;
constexpr size_t WS_F = WS_R;
constexpr size_t WS_XS = WS_R + 134 * MiB;
constexpr size_t WS_END = 256 * MiB;
static_assert(WS_XS + 32 * MiB <= WS_END && WS_O + 32 * MiB <= WS_XS && WS_F + 32 * MiB <= WS_END && WS_HMID + 128 * MiB <= WS_END && WS_O + 32 * MiB <= WS_END, "ws map");

constexpr int LDS_BYTES = 147456;

typedef __bf16 bf16v2_t __attribute__((ext_vector_type(2)));
typedef float f32v2_t __attribute__((ext_vector_type(2)));
__device__ __forceinline__ unsigned cvt_pk_bf16(float lo, float hi) { const f32v2_t v = {lo, hi}; const bf16v2_t r = __builtin_convertvector(v, bf16v2_t); return __builtin_bit_cast(unsigned, r); }
__device__ __forceinline__ f32x4 mfma16(bf16x8 a, bf16x8 b, f32x4 c) { return __builtin_amdgcn_mfma_f32_16x16x32_bf16(a, b, c, 0, 0, 0); }


#ifndef MK_WT
#define MK_WT 0
#endif
__device__ __forceinline__ void st16(void* p, u32x4 v) {
#if MK_WT
    asm volatile("global_store_dwordx4 %0, %1, off sc1\n\ts_nop 1" :: "v"(p), "v"(v) : "memory");
#else
    *(u32x4*)p = v;
#endif
}
__device__ __forceinline__ void st16f(void* p, f32x4 v) {
#if MK_WT
    asm volatile("global_store_dwordx4 %0, %1, off sc1\n\ts_nop 1" :: "v"(p), "v"(v) : "memory");
#else
    *(f32x4*)p = v;
#endif
}
__device__ __forceinline__ void st8(void* p, u32x2 v) {
#if MK_WT
    asm volatile("global_store_dwordx2 %0, %1, off sc1\n\ts_nop 1" :: "v"(p), "v"(v) : "memory");
#else
    *(u32x2*)p = v;
#endif
}
namespace pg8 {
constexpr int BM = 256, BK = 64, HALF = 128, HTB = HALF * BK * 2, STAGE_BYTES = 8 * HTB;
__device__ __forceinline__ int lds_byte(int r, int c) { const int st = (r >> 4) * 2 + (c >> 5), rr = r & 15, cc = c & 31, ob = rr * 64 + cc * 2; return st * 1024 + (ob ^ (((ob >> 9) & 1) << 5)); }
__device__ __forceinline__ void stage_rc(int b, int& R, int& C) { const int st = b / 1024, sb = b % 1024, swz = sb ^ (((sb >> 9) & 1) << 5); R = (st >> 1) * 16 + swz / 64; C = (st & 1) * 32 + (swz % 64) / 2; }
__device__ __forceinline__ int perm32(int rho) { const int n = rho >> 4, i = rho & 15; return 8 * (i >> 2) + 4 * n + (i & 3); }

struct Unit { int pm, pn, kind, aux; const char* a; const char* b; };

template <class Epi, class Sched, bool BMAP>
__device__ __forceinline__ void gemm_phase(LAS unsigned char* lds, const int K, const int lda, const int ldb, const Sched& S, const Epi& E, const size_t kstepA = 128, const size_t kstepB = 128) {
    int tid = threadIdx.x; asm volatile("" : "+v"(tid));
    const int wid = __builtin_amdgcn_readfirstlane(tid >> 6), lane = tid & 63, wr = wid >> 2, wc = wid & 3, fr = lane & 15, fq = lane >> 4;
    int nt = K / BK; asm volatile("" : "+s"(nt));
    unsigned voffA[2], voffB[2];
#pragma unroll
    for (int i = 0; i < 2; ++i) { int R, C; stage_rc(tid * 16 + i * 8192, R, C); const int Rb = (R & ~31) + perm32(R & 31);
        voffA[i] = (unsigned)(R * lda + C) * 2u;
        voffB[i] = BMAP ? (unsigned)((64 * (Rb & 63) + (Rb >> 6)) * ldb + C) * 2u : (unsigned)(Rb * ldb + C) * 2u; }
    const size_t hstepA = (size_t)HALF * lda * 2;
    const size_t hstepB = BMAP ? (size_t)2 * ldb * 2 : (size_t)HALF * ldb * 2;
    const unsigned ldsw = (unsigned)wid * 1024u;
    const int aoff = lds_byte(wr * 64 + fr, fq * 8), boff = lds_byte(wc * 32 + fr, fq * 8);
#define PG8_SA(b, h) (((b) * 2 + (h)) * HTB)
#define PG8_SB(b, h) ((4 + (b) * 2 + (h)) * HTB)
#define PG8_STAGE(bufoff, gbase, voff) do { _Pragma("unroll") for (int _i = 0; _i < 2; ++_i) \
        __builtin_amdgcn_global_load_lds((const unsigned*)((const char*)(gbase) + (voff)[_i]), (LAS unsigned*)(lds + (bufoff) + ldsw + _i * 8192), 16, 0, 0); } while (0)
#define PG8_LDA(dst, b, h) do { _Pragma("unroll") for (int m = 0; m < 4; ++m) _Pragma("unroll") for (int k = 0; k < 2; ++k) dst[m][k] = *(const LAS bf16x8*)(lds + PG8_SA(b, h) + aoff + m * 2048 + k * 1024); } while (0)
#define PG8_LDB(dst, b, h) do { _Pragma("unroll") for (int n = 0; n < 2; ++n) _Pragma("unroll") for (int k = 0; k < 2; ++k) dst[n][k] = *(const LAS bf16x8*)(lds + PG8_SB(b, h) + boff + n * 2048 + k * 1024); } while (0)
#define PG8_MMA(ai, bj, At, Bt) do { __builtin_amdgcn_s_setprio(1); _Pragma("unroll") for (int m = 0; m < 4; ++m) _Pragma("unroll") for (int n = 0; n < 2; ++n) _Pragma("unroll") for (int k = 0; k < 2; ++k) \
        acc[ai][bj][m][n] = __builtin_amdgcn_mfma_f32_16x16x32_bf16(Bt[n][k], At[m][k], acc[ai][bj][m][n], 0, 0, 0); __builtin_amdgcn_s_setprio(0); } while (0)
#define PG8_WAIT_V(n) asm volatile("s_waitcnt vmcnt(" #n ")" ::: "memory")
#define PG8_WAIT_L(n) asm volatile("s_waitcnt lgkmcnt(" #n ")" ::: "memory")
#define PG8_BAR __builtin_amdgcn_s_barrier()
#define PG8_SCHED __builtin_amdgcn_sched_barrier(0)
    Unit cur, nxt; int ui = 0;
    if (!S.next(0, cur)) return;
    f32x4 acc[2][2][4][2];
#pragma unroll
    for (int a = 0; a < 2; ++a)
#pragma unroll
        for (int b = 0; b < 2; ++b)
#pragma unroll
            for (int m = 0; m < 4; ++m)
#pragma unroll
                for (int n = 0; n < 2; ++n) acc[a][b][m][n] = (f32x4){0.f, 0.f, 0.f, 0.f};
    bf16x8 At[4][2], B0[2][2], B1[2][2];
    const char* cA = cur.a; const char* cB = cur.b;
    if constexpr (Epi::PREP) E.prep(cur, lds, 0, tid);
    PG8_STAGE(PG8_SB(0, 0), cB, voffB); PG8_STAGE(PG8_SB(0, 1), cB + hstepB, voffB); PG8_STAGE(PG8_SA(0, 0), cA, voffA); PG8_STAGE(PG8_SA(0, 1), cA + hstepA, voffA);
    if (wr == 1) PG8_BAR;
    PG8_WAIT_V(2); PG8_BAR;
    PG8_STAGE(PG8_SB(1, 0), cB + kstepB, voffB); PG8_STAGE(PG8_SA(1, 0), cA + kstepA, voffA); PG8_STAGE(PG8_SB(1, 1), cB + hstepB + kstepB, voffB);
    PG8_WAIT_V(6); PG8_BAR;
    for (;;) {
        const bool has_next = S.next(ui + 1, nxt);
        const char* nA = has_next ? nxt.a : cA; const char* nB = has_next ? nxt.b : cB;
        for (int t = 0; t < nt; t += 2) {
            const bool last = (t == nt - 2);
            const char* a1 = cA + (size_t)(t + 1) * kstepA;
            const char* a2 = last ? nA : cA + (size_t)(t + 2) * kstepA; const char* b2 = last ? nB : cB + (size_t)(t + 2) * kstepB;
            const char* a3 = a2 + kstepA; const char* b3 = b2 + kstepB;
            PG8_LDB(B0, 0, 0); PG8_LDB(B1, 0, 1); PG8_SCHED; PG8_LDA(At, 0, 0); PG8_STAGE(PG8_SA(1, 1), a1 + hstepA, voffA);
            PG8_WAIT_V(8); PG8_WAIT_L(0); PG8_BAR; PG8_MMA(0, 0, At, B0); PG8_MMA(0, 1, At, B1); PG8_BAR; PG8_SCHED;
            PG8_LDA(At, 0, 1); PG8_STAGE(PG8_SB(0, 0), b2, voffB); PG8_STAGE(PG8_SB(0, 1), b2 + hstepB, voffB); PG8_STAGE(PG8_SA(0, 0), a2, voffA);
            PG8_WAIT_V(8); PG8_WAIT_L(0); PG8_BAR; PG8_MMA(1, 0, At, B0); PG8_MMA(1, 1, At, B1); PG8_BAR; PG8_SCHED;
            PG8_LDB(B0, 1, 0); PG8_LDB(B1, 1, 1); PG8_SCHED; PG8_LDA(At, 1, 0); PG8_STAGE(PG8_SA(0, 1), a2 + hstepA, voffA);
            PG8_WAIT_V(8); PG8_WAIT_L(0); PG8_BAR; PG8_MMA(0, 0, At, B0); PG8_MMA(0, 1, At, B1); PG8_BAR; PG8_SCHED;
            PG8_LDA(At, 1, 1); PG8_STAGE(PG8_SB(1, 0), b3, voffB); PG8_STAGE(PG8_SB(1, 1), b3 + hstepB, voffB); PG8_STAGE(PG8_SA(1, 0), a3, voffA);
            PG8_WAIT_V(8); PG8_WAIT_L(0); PG8_BAR; PG8_MMA(1, 0, At, B0); PG8_MMA(1, 1, At, B1); PG8_BAR; PG8_SCHED;
        }
        if (wr == 0) PG8_BAR;
        if constexpr (Epi::PREP) { if (has_next) E.prep(nxt, lds, (ui + 1) & 1, tid); }
        E(acc, cur, wr, wc, fr, fq, lds, ui & 1);
        if (!has_next) break;
#pragma unroll
        for (int a = 0; a < 2; ++a)
#pragma unroll
            for (int b = 0; b < 2; ++b)
#pragma unroll
                for (int m = 0; m < 4; ++m)
#pragma unroll
                    for (int n = 0; n < 2; ++n) acc[a][b][m][n] = (f32x4){0.f, 0.f, 0.f, 0.f};
        cur = nxt; cA = nA; cB = nB; ++ui;
        if (wr == 1) PG8_BAR;
    }
    PG8_WAIT_V(0);
    PG8_BAR;
#undef PG8_SA
#undef PG8_SB
#undef PG8_STAGE
#undef PG8_LDA
#undef PG8_LDB
#undef PG8_MMA
#undef PG8_WAIT_V
#undef PG8_WAIT_L
#undef PG8_BAR
#undef PG8_SCHED
}

struct SchedStd {
    const char* A; const char* Bt; size_t tsA, tsB; int nM, nN, nwg, G, c;
    __device__ void init(const void* A_, const void* Bt_, int M, int N, int lda, int ldb, int G_, int c_, size_t tsA_ = 0) { A = (const char*)A_; Bt = (const char*)Bt_; tsA = tsA_ ? tsA_ : (size_t)BM * lda * 2; tsB = (size_t)BM * ldb * 2; nM = M / BM; nN = N / BM; nwg = nM * nN; G = G_; c = c_; }
    __device__ bool next(int i, Unit& u) const {
        const long L = (long)i * G + c; if (L >= nwg) return false;
        int wgid = (int)L; { const int q = nwg / 8, r = nwg % 8, xcd = wgid % 8, off = wgid / 8; wgid = (xcd < r ? xcd * (q + 1) : r * (q + 1) + (xcd - r) * q) + off; }
        const int nig = 8 * nN, gid = wgid / nig, fm = gid * 8, gsz = (nM - fm) < 8 ? (nM - fm) : 8;
        u.pm = fm + ((wgid % nig) % gsz); u.pn = (wgid % nig) / gsz; u.kind = 0; u.aux = 0;
        u.a = A + (size_t)u.pm * tsA; u.b = Bt + (size_t)u.pn * tsB; return true;
    }
};
struct SchedQKV {
    const char* H; const char* Wqk; const char* Wv; int G, c, nunits;
    __device__ bool next(int i, Unit& u) const {
        const long Ll = (long)i * G + c; if (Ll >= nunits) return false;
        const int L = (int)Ll; const size_t ts = (size_t)BM * 1024 * 2; u.aux = 0;
        if (L < 512) { const int x = L & 7, off = L >> 3; u.kind = 0; u.pm = 8 * x + (off & 7); u.pn = off >> 3; }
        else if (L < 768) { const int l2 = L - 512, x = l2 & 7, off = l2 >> 3; u.kind = 1; u.pm = off & 3; u.pn = 8 * x + (off >> 2); }
        else if (L < 784) { const int l2 = L - 768; u.kind = 0; u.pm = 64 + (l2 & 3); u.pn = 4 + (l2 >> 2); }
        else { const int l2 = L - 784; u.kind = 1; u.pm = l2 & 3; u.pn = 64 + (l2 >> 2); }
        if (u.kind == 0) { u.a = H + (size_t)u.pm * ts; u.b = Wqk + (size_t)u.pn * ts; }
        else { u.a = Wv + (size_t)u.pm * ts; u.b = H + (size_t)u.pn * ts; }
        return true;
    }
};
struct SchedOne { Unit u;
    __device__ __forceinline__ bool next(int i, Unit& o) const { if (i > 0) return false; o = u; return true; }
};
struct SchedF1 {
    const char* CS; const char* H; int G, c;
    __device__ bool next(int i, Unit& u) const {
        const long Ll = (long)i * G + c; if (Ll >= 256) return false;
        const int L = (int)Ll; const int t = L & 15, b = (L >> 4) & 3, g = (L >> 6) & 3;
        u.pm = 0; u.pn = t; u.kind = g; u.aux = b;
        u.a = CS; u.b = H + ((size_t)(b * 4096 + 4 * t) * 1024 + g * 256) * 2; return true;
    }
};

typedef f32x4 Acc[2][2][4][2];
__device__ __forceinline__ u32x4 pack8(f32x4 v0, f32x4 v1) { u32x4 w; w.x = cvt_pk_bf16(v0[0], v0[1]); w.y = cvt_pk_bf16(v0[2], v0[3]); w.z = cvt_pk_bf16(v1[0], v1[1]); w.w = cvt_pk_bf16(v1[2], v1[3]); return w; }

__device__ __forceinline__ void unpack8(u32x4 w, f32x4& v0, f32x4& v1) {
    v0[0] = __uint_as_float(w.x << 16); v0[1] = __uint_as_float(w.x & 0xffff0000u); v0[2] = __uint_as_float(w.y << 16); v0[3] = __uint_as_float(w.y & 0xffff0000u);
    v1[0] = __uint_as_float(w.z << 16); v1[1] = __uint_as_float(w.z & 0xffff0000u); v1[2] = __uint_as_float(w.w << 16); v1[3] = __uint_as_float(w.w & 0xffff0000u);
}
struct EpiQKV { static constexpr bool PREP = true; bf16_t* QK; bf16_t* VT; const float* gq; const float* gk;
    __device__ __forceinline__ void prep(const Unit& u, LAS unsigned char* lds, int slot, int tid) const {
        if (u.kind == 0 && tid < 64) { const bool isq = u.pn < 4; ((LAS float*)(lds + 131072))[slot * 512 + tid] = isq ? gq[tid] * (0.125f * LOG2E) : gk[tid]; }
    }
    __device__ __forceinline__ void operator()(const Acc& acc, const Unit& u, int wr, int wc, int fr, int fq, LAS unsigned char* lds, int slot) const {
        if (u.kind == 0) {
            const LAS float* gp = (const LAS float*)(lds + 131072) + slot * 512;
            f32x4 gv[2][2];
#pragma unroll
            for (int bj = 0; bj < 2; ++bj)
#pragma unroll
                for (int n = 0; n < 2; ++n) gv[bj][n] = *(const LAS f32x4*)(gp + 32 * bj + 8 * fq + 4 * n);
#pragma unroll
            for (int ai = 0; ai < 2; ++ai)
#pragma unroll
                for (int m = 0; m < 4; ++m) {
                    const int row = u.pm * BM + ai * HALF + wr * 64 + m * 16 + fr;
                    float ss = 0.f;
#pragma unroll
                    for (int bj = 0; bj < 2; ++bj)
#pragma unroll
                        for (int n = 0; n < 2; ++n) { const f32x4 x = acc[ai][bj][m][n]; ss += (x[0] * x[0] + x[1] * x[1]) + (x[2] * x[2] + x[3] * x[3]); }
                    ss += __shfl_xor(ss, 16); ss += __shfl_xor(ss, 32);
                    const float rstd = rsqrtf(ss * (1.0f / 64.0f) + EPS);
                    bf16_t* rowp = QK + (size_t)row * 2048 + u.pn * 256 + wc * 64 + 8 * fq;
#pragma unroll
                    for (int bj = 0; bj < 2; ++bj) st16(rowp + 32 * bj, pack8(acc[ai][bj][m][0] * rstd * gv[bj][0], acc[ai][bj][m][1] * rstd * gv[bj][1]));
                }
        } else {
#pragma unroll
            for (int ai = 0; ai < 2; ++ai)
#pragma unroll
                for (int m = 0; m < 4; ++m) {
                    const int row = u.pm * BM + ai * HALF + wr * 64 + m * 16 + fr;
                    bf16_t* rowp = VT + (size_t)row * MT + u.pn * 256 + wc * 32 + 8 * fq;
#pragma unroll
                    for (int bj = 0; bj < 2; ++bj) st16(rowp + bj * HALF, pack8(acc[ai][bj][m][0], acc[ai][bj][m][1]));
                }
        }
    }
};
struct EpiRelu2 { static constexpr bool PREP = false; bf16_t* O; int ldc;
    __device__ __forceinline__ void operator()(const Acc& acc, const Unit& u, int wr, int wc, int fr, int fq, LAS unsigned char*, int) const {
#pragma unroll
        for (int ai = 0; ai < 2; ++ai)
#pragma unroll
            for (int m = 0; m < 4; ++m) {
                const int row = u.pm * BM + ai * HALF + wr * 64 + m * 16 + fr;
                bf16_t* rowp = O + (size_t)row * ldc + u.pn * 256 + wc * 32 + 8 * fq;
#pragma unroll
                for (int bj = 0; bj < 2; ++bj) { f32x4 v0 = acc[ai][bj][m][0], v1 = acc[ai][bj][m][1];
#pragma unroll
                    for (int e = 0; e < 4; ++e) { const float a = fmaxf(v0[e], 0.f), b = fmaxf(v1[e], 0.f); v0[e] = a * a; v1[e] = b * b; }
                    *(u32x4*)(rowp + bj * HALF) = pack8(v0, v1); }
            }
    }
};
struct EpiRes { static constexpr bool PREP = false; const bf16_t* base; float* out; const float* gate;
    __device__ __forceinline__ void operator()(const Acc& acc, const Unit& u, int wr, int wc, int fr, int fq, LAS unsigned char*, int) const {
        const int col0 = u.pn * 256 + wc * 32 + 8 * fq;
        const float* gp = gate + (size_t)(u.pm >> 4) * 6144 + col0;
        f32x4 gv[2][2];
#pragma unroll
        for (int bj = 0; bj < 2; ++bj)
#pragma unroll
            for (int n = 0; n < 2; ++n) gv[bj][n] = *(const f32x4*)(gp + bj * HALF + 4 * n);
#pragma unroll
        for (int ai = 0; ai < 2; ++ai)
#pragma unroll
          for (int mh = 0; mh < 2; ++mh) {
            u32x4 pre[2][2];
#pragma unroll
            for (int m2 = 0; m2 < 2; ++m2)
#pragma unroll
                for (int bj = 0; bj < 2; ++bj) pre[m2][bj] = __builtin_nontemporal_load((const u32x4*)(base + (size_t)(u.pm * BM + ai * HALF + wr * 64 + (2 * mh + m2) * 16 + fr) * 1024 + col0 + bj * HALF));
            asm volatile("" ::: "memory");
#pragma unroll
            for (int m2 = 0; m2 < 2; ++m2) { const int m = 2 * mh + m2;
                const size_t off = (size_t)(u.pm * BM + ai * HALF + wr * 64 + m * 16 + fr) * 1024 + col0;
#pragma unroll
                for (int bj = 0; bj < 2; ++bj) { f32x4 b0, b1; unpack8(pre[m2][bj], b0, b1);
                    *(f32x4*)(out + off + bj * HALF) = b0 + gv[bj][0] * acc[ai][bj][m][0]; *(f32x4*)(out + off + bj * HALF + 4) = b1 + gv[bj][1] * acc[ai][bj][m][1]; }
            }
            asm volatile("" ::: "memory");
          }
    }
};
struct EpiZ0 { static constexpr bool PREP = false; bf16_t* Z0;
    __device__ __forceinline__ void operator()(const Acc& acc, const Unit& u, int wr, int wc, int fr, int fq, LAS unsigned char*, int) const {
        const int ri = u.pm, t = u.pn, g = u.kind, b = u.aux;
        bf16_t* p0 = Z0 + ((size_t)(((b * 4 + g) * 256 + wr * 64 + fr) * 64 + 4 * t + (wc >> 1))) * 128 + ri * 64 + 32 * (wc & 1) + 8 * fq;
#pragma unroll
        for (int ai = 0; ai < 2; ++ai)
#pragma unroll
            for (int m = 0; m < 4; ++m) {
#pragma unroll
                for (int bj = 0; bj < 2; ++bj)
                    *(u32x4*)(p0 + (size_t)(ai * HALF + m * 16) * 8192 + bj * 256) = pack8(acc[ai][bj][m][0], acc[ai][bj][m][1]);
                asm volatile("" ::: "memory");
            }
    }
};

constexpr int AUX_OFF = 131072;
template <bool BASE16>
struct EpiResF { static constexpr bool PREP = false; const void* base; bf16_t* XS; const float* gate; const float* gm; bf16_t* XB; float* SSQ;
    __device__ __forceinline__ void operator()(const Acc& acc, const Unit& u, int wr, int wc, int fr, int fq, LAS unsigned char*, int) const {
        const int col0 = u.pn * 256 + wc * 32 + 8 * fq, b = u.pm >> 4;
        f32x4 gv[2][2], mv[2][2];
#pragma unroll
        for (int bj = 0; bj < 2; ++bj)
#pragma unroll
            for (int n = 0; n < 2; ++n) { gv[bj][n] = *(const f32x4*)(gate + (size_t)b * 6144 + col0 + bj * HALF + 4 * n); mv[bj][n] = *(const f32x4*)(gm + b * 1024 + col0 + bj * HALF + 4 * n); }
#pragma unroll
        for (int ai = 0; ai < 2; ++ai)
#pragma unroll
          for (int mh = 0; mh < 2; ++mh) {
            f32x4 pre[2][2][2];
#pragma unroll
            for (int m2 = 0; m2 < 2; ++m2) { const size_t off = (size_t)(u.pm * BM + ai * HALF + wr * 64 + (2 * mh + m2) * 16 + fr) * 1024 + col0;
#pragma unroll
                for (int bj = 0; bj < 2; ++bj) {
                    if (BASE16) { const u32x4 w = __builtin_nontemporal_load((const u32x4*)((const bf16_t*)base + off + bj * HALF)); unpack8(w, pre[m2][bj][0], pre[m2][bj][1]); }
                    else { pre[m2][bj][0] = __builtin_nontemporal_load((const f32x4*)((const float*)base + off + bj * HALF)); pre[m2][bj][1] = __builtin_nontemporal_load((const f32x4*)((const float*)base + off + bj * HALF + 4)); }
                } }
            asm volatile("" ::: "memory");
#pragma unroll
            for (int m2 = 0; m2 < 2; ++m2) {
                const int m = 2 * mh + m2;
                const int row = u.pm * BM + ai * HALF + wr * 64 + m * 16 + fr;
                const size_t off = (size_t)row * 1024 + col0;
                float ss = 0.f;
#pragma unroll
                for (int bj = 0; bj < 2; ++bj) {
                    const f32x4 v0 = pre[m2][bj][0] + gv[bj][0] * acc[ai][bj][m][0];
                    const f32x4 v1 = pre[m2][bj][1] + gv[bj][1] * acc[ai][bj][m][1];
                    st16(XS + off + bj * HALF, pack8(v0, v1));
                    ss += ((v0[0] * v0[0] + v0[1] * v0[1]) + (v0[2] * v0[2] + v0[3] * v0[3])) + ((v1[0] * v1[0] + v1[1] * v1[1]) + (v1[2] * v1[2] + v1[3] * v1[3]));
                    st16(XB + off + bj * HALF, pack8(v0 * mv[bj][0], v1 * mv[bj][1]));
                }
                ss += __shfl_xor(ss, 16); ss += __shfl_xor(ss, 32);
                if (fq == 0) SSQ[(size_t)row * 16 + u.pn * 4 + wc] = ss;
            }
            asm volatile("" ::: "memory");
          }
    }
};
__device__ __forceinline__ float ssq_rstd(const float* SSQ, int row, int half) {
    const f32x4 a = *(const f32x4*)(SSQ + (size_t)row * 16 + half * 8), b = *(const f32x4*)(SSQ + (size_t)row * 16 + half * 8 + 4);
    float s = ((a[0] + a[1]) + (a[2] + a[3])) + ((b[0] + b[1]) + (b[2] + b[3]));
    s += __shfl_xor(s, 1);
    return rsqrtf(s * (1.0f / 1024.0f) + EPS);
}
struct EpiRelu2F { static constexpr bool PREP = true; bf16_t* O; int ldc; const float* BV; const float* SSQ;
    __device__ __forceinline__ void prep(const Unit& u, LAS unsigned char* lds, int slot, int tid) const {
        const float r = ssq_rstd(SSQ, u.pm * BM + (tid >> 1), tid & 1);
        LAS float* aux = (LAS float*)(lds + AUX_OFF) + slot * 512;
        if (!(tid & 1)) aux[tid >> 1] = r;
        if (tid < 256) aux[256 + tid] = BV[(size_t)(u.pm >> 4) * 4096 + u.pn * 256 + tid];
    }
    __device__ __forceinline__ void operator()(const Acc& acc, const Unit& u, int wr, int wc, int fr, int fq, LAS unsigned char* lds, int slot) const {
        const LAS float* rt = (const LAS float*)(lds + AUX_OFF) + slot * 512;
        const int col0 = u.pn * 256 + wc * 32 + 8 * fq;
        f32x4 bv[2][2];
#pragma unroll
        for (int bj = 0; bj < 2; ++bj)
#pragma unroll
            for (int n = 0; n < 2; ++n) bv[bj][n] = *(const LAS f32x4*)(rt + 256 + wc * 32 + 8 * fq + bj * HALF + 4 * n);
#pragma unroll
        for (int ai = 0; ai < 2; ++ai)
#pragma unroll
            for (int m = 0; m < 4; ++m) {
                const int rl = ai * HALF + wr * 64 + m * 16 + fr; const float rs = rt[rl];
                bf16_t* rowp = O + ((size_t)(u.pm * 64 + u.pn * 4 + (wc >> 1)) * 256 + rl) * 64 + (wc & 1) * 32 + 8 * fq;
#pragma unroll
                for (int bj = 0; bj < 2; ++bj) { f32x4 v0 = acc[ai][bj][m][0] * rs + bv[bj][0], v1 = acc[ai][bj][m][1] * rs + bv[bj][1];
#pragma unroll
                    for (int e = 0; e < 4; ++e) { const float a = fmaxf(v0[e], 0.f), c2 = fmaxf(v1[e], 0.f); v0[e] = a * a; v1[e] = c2 * c2; }
                    st16(rowp + bj * 2 * 256 * 64, pack8(v0, v1)); }
            }
    }
};
constexpr int NCOL = 2064;
struct EpiZ0F { static constexpr bool PREP = true; bf16_t* Z0; const float* BVF; const float* SSQ;
    __device__ __forceinline__ void prep(const Unit& u, LAS unsigned char* lds, int slot, int tid) const {
        const int nl = tid >> 1, tok = u.aux * 4096 + 64 * (nl & 63) + 4 * u.pn + (nl >> 6);
        const float r = ssq_rstd(SSQ, tok, tid & 1);
        LAS float* aux = (LAS float*)(lds + AUX_OFF) + slot * 512;
        if (!(tid & 1)) aux[nl] = r;
        if (tid < 256) aux[256 + tid] = BVF[(size_t)(u.aux * 4 + u.kind) * 256 + tid];
    }
    __device__ __forceinline__ void operator()(const Acc& acc, const Unit& u, int wr, int wc, int fr, int fq, LAS unsigned char* lds, int slot) const {
        const LAS float* rt = (const LAS float*)(lds + AUX_OFF) + slot * 512;
        const int t = u.pn, g = u.kind, b = u.aux;
        f32x4 rs[2][2];
#pragma unroll
        for (int bj = 0; bj < 2; ++bj)
#pragma unroll
            for (int n = 0; n < 2; ++n) rs[bj][n] = *(const LAS f32x4*)(rt + bj * HALF + wc * 32 + 8 * fq + 4 * n);
        const LAS float* bz = rt + 256 + wr * 64 + fr;
        bf16_t* p0 = Z0 + ((size_t)(((b * 4 + g) * 128 + wr * 64 + fr) * 64 + 4 * t + (wc >> 1))) * 128 + 32 * (wc & 1) + 8 * fq;
        bf16_t* ps = Z0 + ((size_t)((2048 + b * 4 + g) * 64 + 4 * t + (wc >> 1))) * 128 + 32 * (wc & 1) + 8 * fq;
#pragma unroll
        for (int ai = 0; ai < 2; ++ai)
#pragma unroll
            for (int m = 0; m < 4; ++m) {
                const float bb = bz[ai * HALF + m * 16];
                const bool nyq = (ai == 1 && m == 0) && (wr == 0) && (fr == 0);
#pragma unroll
                for (int bj = 0; bj < 2; ++bj) {
                    const u32x4 v = pack8(acc[ai][bj][m][0] * rs[bj][0] + bb, acc[ai][bj][m][1] * rs[bj][1] + bb);
                    const u32x4 z = {0u, 0u, 0u, 0u};
                    st16(p0 + (size_t)(m * 16) * 8192 + ai * 64 + bj * 256, nyq ? z : v);
                    if (ai == 1 && m == 0) { if (nyq) { st16(ps + bj * 256, v); st16(ps + bj * 256 + 64, z); } }
                }
                asm volatile("" ::: "memory");
            }
    }
};
}


#define XB_TMO      128
#define XB_XCNT(j)  (256  + 64 * (j))
#define XB_XSUB(j)  (1280 + 64 * (j))
#define XB_XGEN(j)  (2304 + 64 * (j))
#define XB_TOP      3328
#define XB_TOPGEN   3392
#define XCD_BAR_WORDS 3456
#define XB_SPIN_CAP (1u << 18)
__device__ __forceinline__ unsigned xb_ld(unsigned* p)              { return __hip_atomic_load(p, __ATOMIC_RELAXED, __HIP_MEMORY_SCOPE_AGENT); }
__device__ __forceinline__ unsigned xb_add(unsigned* p, unsigned v) { return __hip_atomic_fetch_add(p, v, __ATOMIC_RELAXED, __HIP_MEMORY_SCOPE_AGENT); }
__device__ __forceinline__ unsigned xb_xcc_id() { return (unsigned)__builtin_amdgcn_s_getreg((3 << 11) | 20) & 0xFu; }
#define XB_SPIN(cond, bar) do { unsigned _sp = 0; while (cond) { __builtin_amdgcn_s_sleep(1); \
    if ((++_sp & 255u) == 0u) { if (xb_ld(&(bar)[XB_TMO])) break; if (_sp > XB_SPIN_CAP) { atomicAdd(&(bar)[XB_TMO], 1u); break; } } } } while (0)
struct XcdBarrier { unsigned* bar; unsigned x; volatile LAS unsigned* st; };
__device__ __forceinline__ XcdBarrier xcd_barrier_post(unsigned* bar, volatile LAS unsigned* st) {
    XcdBarrier b; b.bar = bar; b.x = xb_xcc_id(); b.st = st;
    if (threadIdx.x == 0) (void)xb_add(&bar[XB_XCNT(b.x)], 1u);
    return b;
}
__device__ __forceinline__ void xcd_barrier_complete(unsigned* bar, unsigned x, unsigned& nloc, unsigned& nx) {
    const unsigned G = gridDim.x * gridDim.y * gridDim.z;
    unsigned sum, cnt, mine, sp = 0u;
    for (;;) {
        sum = 0u; cnt = 0u; mine = 0u;
#pragma unroll
        for (unsigned j = 0; j < 16; ++j) { const unsigned c = xb_ld(&bar[XB_XCNT(j)]); sum += c; cnt += (c > 0u) ? 1u : 0u; mine = (j == x) ? c : mine; }
        if (sum == G) break;
        __builtin_amdgcn_s_sleep(1);
        if ((++sp & 255u) == 0u) { if (xb_ld(&bar[XB_TMO])) break; if (sp > XB_SPIN_CAP) { atomicAdd(&bar[XB_TMO], 1u); break; } }
    }
    nloc = mine > 0u ? mine : 1u; nx = cnt > 0u ? cnt : 1u;
}
__device__ __forceinline__ void xcd_barrier(const XcdBarrier& b) {
    asm volatile("s_waitcnt vmcnt(0)" ::: "memory");
    __syncthreads();
    if (threadIdx.x == 0) {
        unsigned* bar = b.bar;
        __builtin_amdgcn_s_waitcnt(0);
        unsigned nloc = b.st[0], nx = b.st[1];
        if (nloc == 0u) { xcd_barrier_complete(bar, b.x, nloc, nx); b.st[0] = nloc; b.st[1] = nx; }
        const unsigned old = xb_add(&bar[XB_XSUB(b.x)], 1u);
        const unsigned gen = old / nloc;
        if (old + 1u == (gen + 1u) * nloc) {
            __builtin_amdgcn_fence(__ATOMIC_RELEASE, "agent");
            asm volatile("s_waitcnt vmcnt(0)" ::: "memory");
            const unsigned og = xb_add(&bar[XB_TOP], 1u);
            const unsigned tg = og / nx;
            if (og + 1u == (tg + 1u) * nx) xb_add(&bar[XB_TOPGEN], 1u);
            else XB_SPIN(xb_ld(&bar[XB_TOPGEN]) == tg, bar);
            __builtin_amdgcn_fence(__ATOMIC_ACQUIRE, "agent");
            xb_add(&bar[XB_XGEN(b.x)], 1u);
            asm volatile("s_waitcnt vmcnt(0)" ::: "memory");
        } else {
            XB_SPIN(xb_ld(&bar[XB_XGEN(b.x)]) == gen, bar);
            __builtin_amdgcn_fence(__ATOMIC_ACQUIRE, "agent");
            asm volatile("s_waitcnt vmcnt(0)" ::: "memory");
        }
    }
    __syncthreads();
}
__device__ __forceinline__ void p0_mods_unit(const float* c, const float* cctx, const float* ada_w, const float* ada_b, float* mods, LAS unsigned char* lds, int unit) {
    LAS float* s = (LAS float*)lds;
    LAS float* red = s + 5 * 1024;
    int tid = threadIdx.x; asm volatile("" : "+v"(tid));
    for (int i = tid; i < 5 * 1024; i += 512) { const int v = i >> 10, k = i & 1023; const float x = v < 4 ? c[v * 1024 + k] : cctx[k]; s[i] = x / (1.0f + __expf(-x)); }
    __syncthreads();
    const int l = unit / 96, col0 = (unit % 96) * 64, kc = tid >> 6, cl = tid & 63;
    const float* w = ada_w + (size_t)l * 1024 * 6144 + col0 + cl;
    float a0 = 0.f, a1 = 0.f, a2 = 0.f, a3 = 0.f, a4 = 0.f;
    for (int k = kc * 128; k < kc * 128 + 128; k += 32) {
        float wv[32];
#pragma unroll
        for (int j = 0; j < 32; ++j) wv[j] = __builtin_nontemporal_load(w + (size_t)(k + j) * 6144);
#pragma unroll
        for (int j = 0; j < 32; ++j) { a0 += s[k + j] * wv[j]; a1 += s[1024 + k + j] * wv[j]; a2 += s[2048 + k + j] * wv[j]; a3 += s[3072 + k + j] * wv[j]; a4 += s[4096 + k + j] * wv[j]; }
    }
    red[(kc * 5 + 0) * 64 + cl] = a0; red[(kc * 5 + 1) * 64 + cl] = a1; red[(kc * 5 + 2) * 64 + cl] = a2; red[(kc * 5 + 3) * 64 + cl] = a3; red[(kc * 5 + 4) * 64 + cl] = a4;
    __syncthreads();
    if (tid < 320) { const int v = tid >> 6, cc = tid & 63; float t = 0.f;
#pragma unroll
        for (int kk = 0; kk < 8; ++kk) t += red[(kk * 5 + v) * 64 + cc];
        mods[(size_t)(l * 5 + v) * 6144 + col0 + cc] = t + ada_b[l * 6144 + col0 + cc]; }
    __syncthreads();
}

__device__ __forceinline__ void p0_transpose_item(const float* W, int K, int N, bf16_t* WT, bf16_t* WT2, int mode, LAS float* scr, int item, int lane) {
    const int nblk = N / 32, kb = item / nblk, nb = item % nblk, k0 = 64 * kb, n0 = 32 * nb;
    float wv_[32];
#pragma unroll
    for (int i = 0; i < 32; ++i) { int srow = k0 + 2 * i + (lane >> 5);
        if (mode == 2) { const int j = srow & 255; if (j > 128) srow = (srow & ~255) + 256 - (j - 128); }
        wv_[i] = __builtin_nontemporal_load(W + (size_t)srow * N + n0 + (lane & 31)); }
#pragma unroll
    for (int i = 0; i < 32; ++i) scr[(2 * i + (lane >> 5)) * 33 + (lane & 31)] = wv_[i];
    asm volatile("s_waitcnt lgkmcnt(0)" ::: "memory");
    const int cch = lane & 7;
#pragma unroll
    for (int j = 0; j < 4; ++j) { const int n = (lane >> 3) + 8 * j; const LAS float* s = scr + (8 * cch) * 33 + n;
        u32x4 o; o.x = cvt_pk_bf16(s[0 * 33], s[1 * 33]); o.y = cvt_pk_bf16(s[2 * 33], s[3 * 33]); o.z = cvt_pk_bf16(s[4 * 33], s[5 * 33]); o.w = cvt_pk_bf16(s[6 * 33], s[7 * 33]);
        const int ng = n0 + n; bf16_t* dst;
        if (mode != 1) dst = WT + (size_t)ng * K;
        else if (ng < 2048) { const int pn = ng >> 8, hh = (ng >> 6) & 3, d = ng & 63; const int tpos = (d >> 5) * 128 + hh * 32 + (d & 31); dst = WT + (size_t)(pn * 256 + tpos) * K; }
        else dst = WT2 + (size_t)(ng - 2048) * K;
        *(u32x4*)(dst + k0 + 8 * cch) = o; }
    asm volatile("s_waitcnt lgkmcnt(0)" ::: "memory");
}

__device__ __forceinline__ float wave_sum(float v) {
#pragma unroll
    for (int o = 1; o < 64; o <<= 1) v += __shfl_xor(v, o);
    return v;
}
__device__ __forceinline__ void norm_rows(const float* xlat, const float* xctx, int nrows, const float* g, const float* modsl, int sh_off, int sc_off, bf16_t* H, int gw, int NGW, int lane) {
    f32x4 gv[4];
#pragma unroll
    for (int j = 0; j < 4; ++j) gv[j] = *(const f32x4*)(g + lane * 4 + 256 * j);
    for (int row = gw; row < nrows; row += NGW) {
        const float* src = row < ML ? xlat + (size_t)row * 1024 : xctx + (size_t)(row - ML) * 1024;
        const int v = row < ML ? (row >> 12) : 4;
        const float* mp = modsl + (size_t)v * 6144;
        f32x4 x[4]; float ss = 0.f;
#pragma unroll
        for (int j = 0; j < 4; ++j) { x[j] = __builtin_nontemporal_load((const f32x4*)(src + lane * 4 + 256 * j)); ss += (x[j][0] * x[j][0] + x[j][1] * x[j][1]) + (x[j][2] * x[j][2] + x[j][3] * x[j][3]); }
        const float rstd = rsqrtf(wave_sum(ss) * (1.0f / 1024.0f) + EPS);
#pragma unroll
        for (int j = 0; j < 4; ++j) {
            const f32x4 sh = *(const f32x4*)(mp + sh_off + lane * 4 + 256 * j), sc = *(const f32x4*)(mp + sc_off + lane * 4 + 256 * j);
            const f32x4 y = (x[j] * rstd * gv[j]) * (sc + 1.0f) + sh;
            u32x2 w; w.x = cvt_pk_bf16(y[0], y[1]); w.y = cvt_pk_bf16(y[2], y[3]);
            *(u32x2*)(H + (size_t)row * 1024 + lane * 4 + 256 * j) = w;
        }
    }
}


__device__ __forceinline__ void norm_rows_lds(const float* xlat, const float* xctx, int nrows, const float* g, const float* modsl, bf16_t* H, int gw, int NGW, int lane, int tid, LAS unsigned char* lds) {
    LAS float* tab = (LAS float*)lds;
    for (int i = tid; i < 5 * 1024; i += 512) { const int v = i >> 10, k = i & 1023; tab[(v * 2) * 1024 + k] = g[k] * (1.0f + modsl[(size_t)v * 6144 + 1024 + k]); tab[(v * 2 + 1) * 1024 + k] = modsl[(size_t)v * 6144 + k]; }
    __syncthreads();
    for (int row = gw; row < nrows; row += NGW) {
        const float* src = row < ML ? xlat + (size_t)row * 1024 : xctx + (size_t)(row - ML) * 1024;
        const int v = row < ML ? (row >> 12) : 4;
        f32x4 x[4]; float ss = 0.f;
#pragma unroll
        for (int j = 0; j < 4; ++j) { x[j] = __builtin_nontemporal_load((const f32x4*)(src + lane * 4 + 256 * j)); ss += (x[j][0] * x[j][0] + x[j][1] * x[j][1]) + (x[j][2] * x[j][2] + x[j][3] * x[j][3]); }
        const float rstd = rsqrtf(wave_sum(ss) * (1.0f / 1024.0f) + EPS);
#pragma unroll
        for (int j = 0; j < 4; ++j) {
            const f32x4 gs = *(const LAS f32x4*)(tab + (v * 2) * 1024 + lane * 4 + 256 * j), sh = *(const LAS f32x4*)(tab + (v * 2 + 1) * 1024 + lane * 4 + 256 * j);
            const f32x4 y = (x[j] * rstd) * gs + sh;
            u32x2 w; w.x = cvt_pk_bf16(y[0], y[1]); w.y = cvt_pk_bf16(y[2], y[3]);
            *(u32x2*)(H + (size_t)row * 1024 + lane * 4 + 256 * j) = w;
        }
    }
    __syncthreads();
}
__device__ __forceinline__ void bias_items(const bf16_t* W1t, const bf16_t* CS, const float* mods, float* BV0, float* BV1, float* BVF, int w, int NW, int lane) {
    for (int it = w; it < 8192 + 1024; it += NW) {
        float a0 = 0.f, a1 = 0.f, a2 = 0.f, a3 = 0.f; float* dst; int dstride;
        if (it < 8192) {
            const int l = it >> 12, n = it & 4095;
            const bf16_t* wr_ = W1t + (size_t)l * 4096 * 1024 + (size_t)n * 1024 + lane * 16;
            const u32x4 w0 = *(const u32x4*)wr_, w1 = *(const u32x4*)(wr_ + 8);
            const float* sh = mods + (size_t)l * 5 * 6144 + 3072 + lane * 16;
            float wf[16];
#pragma unroll
            for (int e = 0; e < 4; ++e) { wf[2 * e] = __uint_as_float(w0[e] << 16); wf[2 * e + 1] = __uint_as_float(w0[e] & 0xffff0000u); wf[8 + 2 * e] = __uint_as_float(w1[e] << 16); wf[8 + 2 * e + 1] = __uint_as_float(w1[e] & 0xffff0000u); }
#pragma unroll
            for (int q = 0; q < 4; ++q) {
                const f32x4 s0 = *(const f32x4*)(sh + 4 * q), s1 = *(const f32x4*)(sh + 6144 + 4 * q), s2 = *(const f32x4*)(sh + 2 * 6144 + 4 * q), s3 = *(const f32x4*)(sh + 3 * 6144 + 4 * q);
#pragma unroll
                for (int e = 0; e < 4; ++e) { a0 += s0[e] * wf[4 * q + e]; a1 += s1[e] * wf[4 * q + e]; a2 += s2[e] * wf[4 * q + e]; a3 += s3[e] * wf[4 * q + e]; }
            }
            dst = (l == 0 ? BV0 : BV1) + n; dstride = 4096;
        } else {
            const int idx = it - 8192, g = idx >> 8, m = idx & 255;
            const u32x2 w0 = *(const u32x2*)(CS + (size_t)m * 256 + lane * 4);
            const float wf0 = __uint_as_float(w0[0] << 16), wf1 = __uint_as_float(w0[0] & 0xffff0000u), wf2 = __uint_as_float(w0[1] << 16), wf3 = __uint_as_float(w0[1] & 0xffff0000u);
            const float* sh = mods + (size_t)5 * 6144 + g * 256 + lane * 4;
            const f32x4 s0 = *(const f32x4*)(sh), s1 = *(const f32x4*)(sh + 6144), s2 = *(const f32x4*)(sh + 2 * 6144), s3 = *(const f32x4*)(sh + 3 * 6144);
            a0 = s0[0] * wf0 + s0[1] * wf1 + s0[2] * wf2 + s0[3] * wf3; a1 = s1[0] * wf0 + s1[1] * wf1 + s1[2] * wf2 + s1[3] * wf3;
            a2 = s2[0] * wf0 + s2[1] * wf1 + s2[2] * wf2 + s2[3] * wf3; a3 = s3[0] * wf0 + s3[1] * wf1 + s3[2] * wf2 + s3[3] * wf3;
            dst = BVF + g * 256 + m; dstride = 1024;
        }
        a0 = wave_sum(a0); a1 = wave_sum(a1); a2 = wave_sum(a2); a3 = wave_sum(a3);
        if (lane == 0) { dst[0] = a0; dst[dstride] = a1; dst[2 * dstride] = a2; dst[3 * dstride] = a3; }
    }
}
template <bool MASKED>
__device__ __forceinline__ void attn_block(const LAS bf16_t* Ks, const LAS bf16_t* Vs, int kcol0, int fr, int g, const bf16x8 (&Qf)[2], f32x4 (&acc)[4], float& lsum,
                                           const LAS unsigned char* rpb_base  , const int (&dcb)[8], const f32x4& ciX, const f32x4& ciY) {
    bf16x8 KX[2], KY[2];
#pragma unroll
    for (int kk = 0; kk < 2; ++kk) { KX[kk] = *(const LAS bf16x8*)(Ks + (kcol0 + fr) * 72 + kk * 32 + g * 8); KY[kk] = *(const LAS bf16x8*)(Ks + (kcol0 + 16 + fr) * 72 + kk * 32 + g * 8); }
    s16x4 VX[4], VY[4];
#pragma unroll
    for (int db = 0; db < 4; ++db) { VX[db] = *(const LAS s16x4*)(Vs + (16 * db + fr) * 72 + kcol0 + 4 * g); VY[db] = *(const LAS s16x4*)(Vs + (16 * db + fr) * 72 + kcol0 + 16 + 4 * g); }
    f32x4 sX = mfma16(KX[0], Qf[0], ciX); sX = mfma16(KX[1], Qf[1], sX);
    f32x4 sY = mfma16(KY[0], Qf[0], ciY); sY = mfma16(KY[1], Qf[1], sY);
    f32x4 pX, pY;
    if (MASKED) {
#pragma unroll
        for (int ii = 0; ii < 4; ++ii) {
            const float bx = *(const LAS float*)(rpb_base + dcb[ii]), by = *(const LAS float*)(rpb_base + dcb[4 + ii]);
            pX[ii] = __builtin_amdgcn_exp2f(sX[ii] + bx);
            pY[ii] = __builtin_amdgcn_exp2f(sY[ii] + by);
        }
    } else {
#pragma unroll
        for (int ii = 0; ii < 4; ++ii) { pX[ii] = __builtin_amdgcn_exp2f(sX[ii]); pY[ii] = __builtin_amdgcn_exp2f(sY[ii]); }
    }
    lsum += ((pX[0] + pX[1]) + (pX[2] + pX[3])) + ((pY[0] + pY[1]) + (pY[2] + pY[3]));
    const u32x4 pw = pg8::pack8(pX, pY);
    const bf16x8 Pf = __builtin_bit_cast(bf16x8, pw);
#pragma unroll
    for (int db = 0; db < 4; ++db) {
        bf16x8 Vf; Vf[0] = VX[db][0]; Vf[1] = VX[db][1]; Vf[2] = VX[db][2]; Vf[3] = VX[db][3]; Vf[4] = VY[db][0]; Vf[5] = VY[db][1]; Vf[6] = VY[db][2]; Vf[7] = VY[db][3];
        acc[db] = mfma16(Vf, Pf, acc[db]);
    }
}
__device__ __forceinline__ void attn_phase(const bf16_t* QK, const bf16_t* VT, bf16_t* O, const float* rpb, const float* sbound, LAS unsigned char* lds, int G, int c) {
    constexpr int RP_BYTES = 30720, TILE_B = 64 * 72 * 2, PAIR_B = 4 * TILE_B, NPAIR = 7;
    LAS float* rp = (LAS float*)lds;
    int tid = threadIdx.x; asm volatile("" : "+v"(tid));
    const int lane = tid & 63, wid = __builtin_amdgcn_readfirstlane(tid >> 6), fr = lane & 15, g = lane >> 4;
    for (int i = tid; i < 16 * 465; i += 512) rp[i] = rpb[i] * LOG2E;
    const float Mb = *sbound;
    const int nunits = (2048 - c + G - 1) / G;
    const int ND = nunits * NPAIR;
    const int trow = tid >> 3, tch = tid & 7;
    const int ldsoff = (trow * 72 + tch * 8) * 2;
#define ATT_DEC(L_, b_, h_, rp_) do { const int x_ = (L_) & 7, q_ = (L_) >> 3; rp_ = q_ & 31; const int bh_ = 8 * (q_ >> 5) + x_; b_ = bh_ >> 4; h_ = bh_ & 15; } while (0)
#define ATT_TOK(b_, rs0_, t_) ((t_) < 9 ? (b_) * 4096 + min((rs0_) + (t_), 63) * 64 : ML + (b_) * 256 + 64 * (min((t_), 12) - 9))
#define ATT_GLOAD(D_, R) do { const int u_ = (D_) / NPAIR, p_ = (D_) - u_ * NPAIR; int b_, h_, rp_; ATT_DEC(u_ * G + c, b_, h_, rp_); \
        const int rs0_ = min(max(2 * rp_ - 4, 0), 56); const int tk0_ = ATT_TOK(b_, rs0_, 2 * p_), tk1_ = ATT_TOK(b_, rs0_, 2 * p_ + 1); \
        const bf16_t* kb_ = QK + (size_t)trow * 2048 + 1024 + h_ * 64 + tch * 8; const bf16_t* vb_ = VT + (size_t)(h_ * 64 + trow) * MT + tch * 8; \
        R[0] = *(const u32x4*)(kb_ + (size_t)tk0_ * 2048); R[1] = *(const u32x4*)(vb_ + tk0_); R[2] = *(const u32x4*)(kb_ + (size_t)tk1_ * 2048); R[3] = *(const u32x4*)(vb_ + tk1_); } while (0)
#define ATT_LWRITE(slot_, R) do { _Pragma("unroll") for (int q_ = 0; q_ < 4; ++q_) *(LAS u32x4*)(lds + RP_BYTES + (slot_) * PAIR_B + q_ * TILE_B + ldsoff) = R[q_]; } while (0)
    u32x4 R0[4], R1[4];
    ATT_GLOAD(0, R0); ATT_LWRITE(0, R0);
    if (ND > 1) ATT_GLOAD(1, R1);
    if (ND > 2) ATT_GLOAD(2, R0);
    __syncthreads();
    int b = 0, h = 0, rpair = 0, r = 0, rs0 = 0, rsr = 0, qrow = 0;
    const int j = wid & 3, w0 = (j == 0) ? 0 : (j == 1) ? 8 : (j == 2) ? 24 : 32;
    int dcb[8]; f32x4 ciX, ciY, ciU;
    {
        const int cq = 16 * j + fr, cs = min(max(cq - 8, 0), 48), eX = w0 + 4 * g - cs, dX = w0 + 4 * g - cq + 15;
#pragma unroll
        for (int ii = 0; ii < 4; ++ii) {
            dcb[ii] = 4 * min(max(dX + ii, 0), 30); dcb[4 + ii] = 4 * min(max(dX + 16 + ii, 0), 30);
            ciX[ii] = ((unsigned)(eX + ii) < 16u) ? -Mb : -1.0e30f; ciY[ii] = ((unsigned)(eX + 16 + ii) < 16u) ? -Mb : -1.0e30f; ciU[ii] = -Mb;
        }
    }
    bf16x8 Qf[2], Qn[2]; f32x4 acc[4]; float lsum = 0.f;
    int p = 0, u = 0, D = 0;
#define ATT_QLOAD(dst, uu) do { int b_, h_, rp_; ATT_DEC((uu) * G + c, b_, h_, rp_); const int qr_ = b_ * 4096 + (2 * rp_ + (wid >> 2)) * 64 + 16 * j + fr; \
        _Pragma("unroll") for (int kk = 0; kk < 2; ++kk) dst[kk] = *(const bf16x8*)(QK + (size_t)qr_ * 2048 + h_ * 64 + 32 * kk + 8 * g); } while (0)
#define ATT_TILE(t_, toff_) do { \
        const LAS bf16_t* Ks = (const LAS bf16_t*)(lds + RP_BYTES + slot * PAIR_B + (toff_)); \
        const LAS bf16_t* Vs = (const LAS bf16_t*)(lds + RP_BYTES + slot * PAIR_B + (toff_) + TILE_B); \
        if ((t_) < 9) { \
            const int kr = rs0 + (t_), i = kr - rsr; \
            if (i >= 0 && i < 8) attn_block<true>(Ks, Vs, w0, fr, g, Qf, acc, lsum, (const LAS unsigned char*)rp + (h * 465 + (kr - r + 7) * 31) * 4, dcb, ciX, ciY); \
        } else if ((t_) < 13) { \
            attn_block<false>(Ks, Vs, 0, fr, g, Qf, acc, lsum, (const LAS unsigned char*)rp, dcb, ciU, ciU); \
            attn_block<false>(Ks, Vs, 32, fr, g, Qf, acc, lsum, (const LAS unsigned char*)rp, dcb, ciU, ciU); \
        } } while (0)
    ATT_QLOAD(Qn, 0);
#define ATT_ITER(R) do { \
        const int slot = D & 1; \
        if (D + 1 < ND) ATT_LWRITE(slot ^ 1, R); \
        if (D + 3 < ND) ATT_GLOAD(D + 3, R); \
        if (p == 0) { \
            ATT_DEC(u * G + c, b, h, rpair); \
            r = 2 * rpair + (wid >> 2); rs0 = min(max(2 * rpair - 4, 0), 56); rsr = min(max(r - 4, 0), 56); \
            qrow = b * 4096 + r * 64 + 16 * j + fr; \
            Qf[0] = Qn[0]; Qf[1] = Qn[1]; \
            _Pragma("unroll") for (int db = 0; db < 4; ++db) acc[db] = (f32x4){0.f, 0.f, 0.f, 0.f}; \
            lsum = 0.f; \
        } \
        if (p == 4 && u + 1 < nunits) ATT_QLOAD(Qn, u + 1); \
        { const int i0_ = rs0 + 2 * p - rsr, i1_ = i0_ + 1; \
          if (2 * p + 1 < 9 && i0_ >= 0 && i1_ < 8) {        \
            const LAS bf16_t* Ka = (const LAS bf16_t*)(lds + RP_BYTES + slot * PAIR_B); const LAS bf16_t* Va = (const LAS bf16_t*)(lds + RP_BYTES + slot * PAIR_B + TILE_B); \
            const LAS bf16_t* Kb = (const LAS bf16_t*)(lds + RP_BYTES + slot * PAIR_B + 2 * TILE_B); const LAS bf16_t* Vb = (const LAS bf16_t*)(lds + RP_BYTES + slot * PAIR_B + 3 * TILE_B); \
            const LAS unsigned char* rb_ = (const LAS unsigned char*)rp + (h * 465 + (rs0 + 2 * p - r + 7) * 31) * 4; \
            attn_block<true>(Ka, Va, w0, fr, g, Qf, acc, lsum, rb_, dcb, ciX, ciY); \
            attn_block<true>(Kb, Vb, w0, fr, g, Qf, acc, lsum, rb_ + 124, dcb, ciX, ciY); \
          } else { ATT_TILE(2 * p, 0); ATT_TILE(2 * p + 1, 2 * TILE_B); } } \
        if (p == NPAIR - 1) { \
            float ls = lsum; ls += __shfl_xor(ls, 16); ls += __shfl_xor(ls, 32); \
            const float inv = 1.0f / ls; \
            bf16_t* op = O + (size_t)qrow * 1024 + h * 64 + 4 * g; \
            _Pragma("unroll") for (int db = 0; db < 4; ++db) { u32x2 w; w.x = cvt_pk_bf16(acc[db][0] * inv, acc[db][1] * inv); w.y = cvt_pk_bf16(acc[db][2] * inv, acc[db][3] * inv); st8(op + 16 * db, w); } \
            p = 0; ++u; \
        } else ++p; \
        __syncthreads(); \
    } while (0)
    for (;;) {
        ATT_ITER(R1); if (++D >= ND) break;
        ATT_ITER(R0); if (++D >= ND) break;
    }
#undef ATT_ITER
#undef ATT_TILE
#undef ATT_QLOAD
#undef ATT_DEC
#undef ATT_TOK
#undef ATT_GLOAD
#undef ATT_LWRITE
}

__device__ __forceinline__ void s1_phase(const bf16_t* Z0, const bf16_t* Dg, bf16_t* Z1, LAS unsigned char* lds, int gw, int NGW) {
    constexpr int DP = 136;
    LAS bf16_t* Dl = (LAS bf16_t*)lds;
    int tid = threadIdx.x; asm volatile("" : "+v"(tid));
    const int lane = tid & 63, fr = lane & 15, g = lane >> 4;
    for (int i = tid; i < 128 * 16; i += 512) { const int row = i >> 4, ch = i & 15; *(LAS u32x4*)(Dl + row * DP + ch * 8) = *(const u32x4*)(Dg + row * 128 + ch * 8); }
    __syncthreads();
    for (int job = gw; job < 2048 + 64; job += NGW) {
        const bool part = job >= 2048;
        const int colM = part ? 2048 + ((job - 2048) >> 2) : job, ib0 = part ? ((job - 2048) & 3) : 0, nib = part ? 1 : 4;
        bf16x8 A[4][4];
#pragma unroll
        for (int ib = 0; ib < 4; ++ib) { const int ibr = part ? ib0 : ib;
#pragma unroll
            for (int kb = 0; kb < 4; ++kb) A[ib][kb] = *(const bf16x8*)(Z0 + ((size_t)colM * 64 + 16 * ibr + fr) * 128 + 32 * kb + 8 * g); }
#pragma unroll 2
        for (int jb = 0; jb < 8; ++jb) {
            bf16x8 Bf[4];
#pragma unroll
            for (int kb = 0; kb < 4; ++kb) Bf[kb] = *(const LAS bf16x8*)(Dl + (16 * jb + fr) * DP + 32 * kb + 8 * g);
            const int n = 16 * jb + fr, ka = n >> 1, rip = n & 1;
#pragma unroll
            for (int ib = 0; ib < 4; ++ib) {
                if (ib < nib) {
                    f32x4 a = (f32x4){0.f, 0.f, 0.f, 0.f};
#pragma unroll
                    for (int kb = 0; kb < 4; ++kb) a = mfma16(A[ib][kb], Bf[kb], a);
                    u32x2 w; w.x = cvt_pk_bf16(a[0], a[1]); w.y = cvt_pk_bf16(a[2], a[3]);
                    st8(Z1 + (((size_t)ka * pg8::NCOL + colM) * 2 + rip) * 64 + 16 * (part ? ib0 : ib) + 4 * g, w);
                }
            }
        }
    }
    __syncthreads();
}
__device__ __forceinline__ void s2_phase(const bf16_t* Z1, const bf16_t* Eg, bf16_t* F, LAS unsigned char* lds, int G, int c) {
    constexpr int EP = 136;
    LAS bf16_t* El = (LAS bf16_t*)lds;
    int tid = threadIdx.x; asm volatile("" : "+v"(tid));
    const int lane = tid & 63, wid = __builtin_amdgcn_readfirstlane(tid >> 6), fr = lane & 15, g = lane >> 4;
    for (int wgi = c; wgi < 256; wgi += G) {
        const int ka = wgi & 63, part = wgi >> 6;
        for (int i = tid; i < 64 * 16; i += 512) { const int row = i >> 4, ch = i & 15; *(LAS u32x4*)(El + row * EP + ch * 8) = *(const u32x4*)(Eg + ((size_t)ka * 64 + row) * 128 + ch * 8); }
        __syncthreads();
        bf16x8 Bf[4][4];
#pragma unroll
        for (int jb = 0; jb < 4; ++jb)
#pragma unroll
            for (int kb = 0; kb < 4; ++kb) Bf[jb][kb] = *(const LAS bf16x8*)(El + (16 * jb + fr) * EP + 32 * kb + 8 * g);
        const int nrun = (part == 0 && wid == 0) ? 2 : 1;
        for (int run = 0; run < nrun; ++run) {
            const bool special = run == 1;
            const int q = part * 8 + wid, bg = q >> 1, ib0 = special ? 0 : 4 * (q & 1), nib = special ? 1 : 4;
            for (int ibb = 0; ibb < nib; ++ibb) {
                const int ib = ib0 + ibb;
                const int colM0 = special ? 2048 : bg * 128 + ib * 16;
                bf16x8 A[4];
#pragma unroll
                for (int kb = 0; kb < 4; ++kb) A[kb] = *(const bf16x8*)(Z1 + ((size_t)ka * pg8::NCOL + colM0 + fr) * 128 + 32 * kb + 8 * g);
                const int k2 = ib * 16 + 4 * g, b = bg >> 2, gg = bg & 3;
#pragma unroll
                for (int jb = 0; jb < 4; ++jb) {
                    f32x4 a = (f32x4){0.f, 0.f, 0.f, 0.f};
#pragma unroll
                    for (int kb = 0; kb < 4; ++kb) a = mfma16(A[kb], Bf[jb][kb], a);
                    const int k = ka + 64 * (16 * jb + fr), km = (4096 - k) & 4095;
                    u32x2 w; w.x = cvt_pk_bf16(a[0], a[1]); w.y = cvt_pk_bf16(a[2], a[3]);
                    if (!special) {
                        st8(F + ((size_t)b * 4096 + k) * 1024 + gg * 256 + k2, w);
                        bf16_t* pm_ = F + ((size_t)b * 4096 + km) * 1024 + gg * 256 + 128 + k2;
                        if (k2 != 0) st8(pm_, w);
                        else { pm_[1] = (bf16_t)(w.x >> 16); *(unsigned*)(pm_ + 2) = w.y; }
                    } else {
                        bf16_t* ps_ = F + ((size_t)g * 4096 + k) * 1024 + 128;
                        ps_[0] = (bf16_t)(w.x & 0xffffu); ps_[256] = (bf16_t)(w.x >> 16); ps_[512] = (bf16_t)(w.y & 0xffffu); ps_[768] = (bf16_t)(w.y >> 16);
                    }
                }
            }
        }
        __syncthreads();
    }
}


#ifndef MK_DEBUG
#define MK_DEBUG 0
#endif
__device__ __forceinline__ void dbg_scan16(const bf16_t* p, size_t n, unsigned* flags, unsigned bit, int gt, int NT) {
    bool bad = false; for (size_t i = gt; i < n; i += NT) bad |= ((p[i] & 0x7f80u) == 0x7f80u);
    if (bad) atomicOr(flags, 1u << bit);
}
__device__ __forceinline__ void dbg_scan32(const float* p, size_t n, unsigned* flags, unsigned bit, int gt, int NT) {
    bool bad = false; for (size_t i = gt; i < n; i += NT) bad |= ((__float_as_uint(p[i]) & 0x7f800000u) == 0x7f800000u);
    if (bad) atomicOr(flags, 1u << bit);
}
struct Args { const float* in[15]; float* out; unsigned char* ws; int ph_lo, ph_hi, use_cg, pad; };
static_assert(sizeof(Args) == 15 * 8 + 8 + 8 + 16, "no padding");

__global__ void __launch_bounds__(512, 2) fwd_kernel(Args args) {
    extern __shared__ __attribute__((aligned(16))) unsigned char lds_raw[];
    LAS unsigned char* lds = (LAS unsigned char*)lds_raw;
    const int G = gridDim.x, c = blockIdx.x;
    const int vcu = (G % 8 == 0) ? (c % 8) * (G / 8) + c / 8 : c;
    const int NGW = G * 8;
#define PHASE_IDS int tid_ = threadIdx.x; asm volatile("" : "+v"(tid_)); const int lane = tid_ & 63, wid = __builtin_amdgcn_readfirstlane(tid_ >> 6); const int gw = vcu * 8 + wid; (void)lane; (void)gw
    unsigned char* ws = args.ws;
    const float* x = args.in[0]; const float* cvec = args.in[1]; const float* ctx = args.in[2]; const float* cctx = args.in[3];
    const float* ada_w = args.in[4]; const float* ada_b = args.in[5]; const float* norm_g = args.in[6];
    const float* wqkv = args.in[7]; const float* wo = args.in[8]; const float* gq = args.in[9]; const float* gk = args.in[10]; const float* rpb = args.in[11];
    const float* fw = args.in[12]; const float* w1 = args.in[13]; const float* w2 = args.in[14];
    float* out = args.out;
    float* mods = (float*)(ws + WS_MODS); float* sbound = (float*)(ws + WS_SB);
    bf16_t* CS = (bf16_t*)(ws + WS_CS); bf16_t* Dt = (bf16_t*)(ws + WS_D); bf16_t* Et = (bf16_t*)(ws + WS_E);
    bf16_t* WQK = (bf16_t*)(ws + WS_WQK); bf16_t* WV = (bf16_t*)(ws + WS_WV); bf16_t* WO = (bf16_t*)(ws + WS_WO); bf16_t* FWt = (bf16_t*)(ws + WS_FW);
    bf16_t* W1t = (bf16_t*)(ws + WS_W1); bf16_t* W2t = (bf16_t*)(ws + WS_W2);
    bf16_t* H = (bf16_t*)(ws + WS_H); bf16_t* QK = (bf16_t*)(ws + WS_QK); bf16_t* VT = (bf16_t*)(ws + WS_VT); bf16_t* O = (bf16_t*)(ws + WS_O);
    bf16_t* XS = (bf16_t*)(ws + WS_XS); bf16_t* HMID = (bf16_t*)(ws + WS_HMID); bf16_t* Z0 = (bf16_t*)(ws + WS_Z0); bf16_t* Z1 = (bf16_t*)(ws + WS_Z1); bf16_t* Fb = (bf16_t*)(ws + WS_F);
    float* SSQ = (float*)(ws + WS_SSQ); float* BV0 = (float*)(ws + WS_BV); float* BV1 = BV0 + 4 * 4096; float* BVF = BV1 + 4 * 4096; float* GM = BVF + 16 * 512;
    const int lo = args.ph_lo, hi = args.ph_hi;
    cg::grid_group grid = cg::this_grid();
#define IN(k) (lo <= (k) && (k) < hi)
#ifndef REP_SYNC
#define REP_SYNC 1
#endif
#ifndef REP_NORM
#define REP_NORM 1
#endif
#ifndef REP_S12
#define REP_S12 1
#endif
#ifndef REP_P0
#define REP_P0 1
#endif
#ifndef USE_XB
#define USE_XB 1
#endif
#define SEAM(k) do { if (IN(k) && IN((k) + 1)) { for (int r_ = 0; r_ < REP_SYNC; ++r_) { if (use_cg) grid.sync(); else xcd_barrier(xbar); } } } while (0)
    { volatile LAS unsigned* st_ = (volatile LAS unsigned*)(lds + LDS_BYTES - 64); if (threadIdx.x < 2) st_[threadIdx.x] = 0u; __syncthreads(); }
    XcdBarrier xbar; xbar.bar = (unsigned*)(ws + WS_BAR); xbar.x = 0; xbar.st = (volatile LAS unsigned*)(lds + LDS_BYTES - 64);
    const bool use_cg = (args.use_cg != 0);
    if (!use_cg && hi - lo > 1) xbar = xcd_barrier_post((unsigned*)(ws + WS_BAR), (volatile LAS unsigned*)(lds + LDS_BYTES - 64));

    unsigned* dflags = (unsigned*)(ws + WS_SB + 256);
#define DBG16(k, bit, p, n) do { if (MK_DEBUG && IN(k)) { int t_ = threadIdx.x; asm volatile("" : "+v"(t_)); dbg_scan16(p, n, dflags, bit, (vcu * 512) + t_, G * 512); } } while (0)
#define DBG32(k, bit, p, n) do { if (MK_DEBUG && IN(k)) { int t_ = threadIdx.x; asm volatile("" : "+v"(t_)); dbg_scan32(p, n, dflags, bit, (vcu * 512) + t_, G * 512); } } while (0)
    if (IN(0)) {
        PHASE_IDS;
        if (MK_DEBUG && c == 0 && tid_ == 0) *dflags = 0u;
        for (int r0_ = 0; r0_ < REP_P0; ++r0_) {
        for (int u = c; u < 192; u += G) {
            p0_mods_unit(cvec, cctx, ada_w, ada_b, mods, lds, u);
            if (u < 32 && !use_cg && hi - lo > 1) {
                asm volatile("s_waitcnt vmcnt(0)" ::: "memory"); __syncthreads();
                if (tid_ == 0) { __builtin_amdgcn_fence(__ATOMIC_RELEASE, "agent"); asm volatile("s_waitcnt vmcnt(0)" ::: "memory"); (void)xb_add((unsigned*)(ws + WS_BAR) + 64, 1u); }
            }
        }
        __syncthreads();
        {
            LAS float* scr = (LAS float*)(lds + wid * 16384);
            constexpr int I_QKV = 16 * 96, I_SQ = 16 * 32, I_1 = 16 * 128, I_2 = 64 * 32;
            constexpr int NITEMS = I_QKV + I_SQ + 2 * I_1;
            for (int it = NITEMS - 1 - gw; it >= 0; it -= NGW) {
                int r = it;
                if (r < I_QKV) { p0_transpose_item(wqkv, 1024, 3072, WQK, WV, 1, scr, r, lane); continue; } r -= I_QKV;
                if (r < I_SQ) { p0_transpose_item(wo, 1024, 1024, WO, nullptr, 0, scr, r, lane); continue; } r -= I_SQ;
                { const int l = r / I_1; p0_transpose_item(w1 + (size_t)l * 1024 * 4096, 1024, 4096, W1t + (size_t)l * 4096 * 1024, nullptr, 0, scr, r % I_1, lane); }
            }
        }
        {
            const int gt = gw * 64 + lane, NT = NGW * 64;
            for (int i = gt; i < 256 * 256; i += NT) { const int m = i >> 8, cc = i & 255, ri = m >> 7, k2 = m & 127; float sn, cs; sincospif(2.0f * (float)((cc * k2) & 255) / 256.0f, &sn, &cs);
                float v = (ri == 0 ? cs : -sn) * (1.0f / 16.0f); if (m == 128) v = (cc & 1) ? -(1.0f / 16.0f) : (1.0f / 16.0f);
                CS[i] = (bf16_t)(cvt_pk_bf16(v, 0.f) & 0xffffu); }
            for (int i = gt; i < 128 * 128; i += NT) { const int n = i >> 7, kp = i & 127, ka = n >> 1, rip = n & 1, ri = kp >> 6, a = kp & 63; float sn, cs; sincospif(2.0f * (float)((a * ka) & 63) / 64.0f, &sn, &cs);
                const float v = (rip == 0 ? (ri == 0 ? cs : sn) : (ri == 0 ? -sn : cs)) * 0.125f; Dt[i] = (bf16_t)(cvt_pk_bf16(v, 0.f) & 0xffffu); }
            for (int i = gt; i < 64 * 64 * 128; i += NT) { const int kp = i & 127, kbk = (i >> 7) & 63, ka = i >> 13, rip = kp >> 6, bp = kp & 63; float sn, cs; sincospif(2.0f * (float)((bp * (ka + 64 * kbk)) & 4095) / 4096.0f, &sn, &cs);
                const float v = (rip == 0 ? cs : sn) * 0.125f; Et[i] = (bf16_t)(cvt_pk_bf16(v, 0.f) & 0xffffu); }
        }
        if (c == G - 1) {
            float mr = 0.f;
#pragma unroll 5
            for (int i = tid_; i < 16 * 465; i += 512) mr = fmaxf(mr, fabsf(rpb[i]));
#pragma unroll
            for (int o = 1; o < 64; o <<= 1) mr = fmaxf(mr, __shfl_xor(mr, o));
            LAS float* red_ = (LAS float*)(lds + 131072);
            if (lane == 0) red_[wid] = mr;
            __syncthreads();
            if (wid == 0) {
                float mq = fabsf(gq[lane]), mk = fabsf(gk[lane]); mr = red_[lane & 7];
#pragma unroll
                for (int o = 1; o < 64; o <<= 1) { mq = fmaxf(mq, __shfl_xor(mq, o)); mk = fmaxf(mk, __shfl_xor(mk, o)); mr = fmaxf(mr, __shfl_xor(mr, o)); }
                if (lane == 0) *sbound = (8.0f * mq * mk + mr) * LOG2E;
            }
        }
        __syncthreads();
        }
    }
    if (use_cg || hi - lo <= 1) { SEAM(0); }
    else if (IN(0) && IN(1)) {
        if (threadIdx.x == 0) { unsigned* fl = (unsigned*)(ws + WS_BAR) + 64; XB_SPIN(xb_ld(fl) < 32u, (unsigned*)(ws + WS_BAR)); __builtin_amdgcn_fence(__ATOMIC_ACQUIRE, "agent"); asm volatile("s_waitcnt vmcnt(0)" ::: "memory"); }
        __syncthreads();
    }
    const bool ctx_in_p1 = false;
    if (IN(1)) { PHASE_IDS;
        if (!ctx_in_p1) norm_rows_lds(x, ctx, MT, norm_g, mods, H, gw, NGW, lane, tid_, lds);
        else if (c >= 32) norm_rows(x, ctx, ML, norm_g, mods, 0, 1024, H, (c - 32) * 8 + wid, (G - 32) * 8, lane);
        else {
            pg8::SchedOne S1u; const size_t ts = (size_t)256 * 1024 * 2; int tt;
            if (c < 16) { S1u.u.kind = 0; S1u.u.pm = 64 + (c & 3); S1u.u.pn = 4 + (c >> 2); tt = c & 3; S1u.u.a = (const char*)H + (size_t)S1u.u.pm * ts; S1u.u.b = (const char*)WQK + (size_t)S1u.u.pn * ts; }
            else { const int l2 = c - 16; S1u.u.kind = 1; S1u.u.pm = l2 & 3; S1u.u.pn = 64 + (l2 >> 2); tt = l2 >> 2; S1u.u.a = (const char*)WV + (size_t)S1u.u.pm * ts; S1u.u.b = (const char*)H + (size_t)S1u.u.pn * ts; }
            S1u.u.aux = 0;
            norm_rows(x, ctx, ML + tt * 256 + 256, norm_g, mods, 0, 1024, H, ML + tt * 256 + wid, 8, lane);
            asm volatile("s_waitcnt vmcnt(0)" ::: "memory"); __syncthreads();
            pg8::EpiQKV E{QK, VT, gq, gk};
            pg8::gemm_phase<pg8::EpiQKV, pg8::SchedOne, false>(lds, 1024, 1024, 1024, S1u, E);
        }
    }
    SEAM(1);
    DBG16(2, 0, H, (size_t)MT * 1024);
    if (IN(2)) { pg8::SchedQKV S{(const char*)H, (const char*)WQK, (const char*)WV, G, c, ctx_in_p1 ? 768 : 800}; pg8::EpiQKV E{QK, VT, gq, gk};
#ifndef REP_G2
#define REP_G2 1
#endif
        for (int r_ = 0; r_ < REP_G2; ++r_) pg8::gemm_phase<pg8::EpiQKV, pg8::SchedQKV, false>(lds, 1024, 1024, 1024, S, E);
        { PHASE_IDS;
          const bool part = (G > 32); const int w_ = part ? (c - 32) * 8 + wid : gw, nw_ = part ? (G - 32) * 8 : NGW;
          if (!part || c >= 32) {
              for (int i = w_ * 64 + lane; i < 3 * 4096; i += nw_ * 64) { const int idx = i >> 12, b = (i >> 10) & 3, col = i & 1023;
                  const float gg = norm_g[(idx == 0 ? 1024 : idx == 1 ? 2048 : 3072) + col];
                  const float sc = mods[(size_t)((idx == 0 ? 0 : 5) + b) * 6144 + (idx == 1 ? 1024 : 4096) + col];
                  GM[i] = gg * (1.0f + sc); }
              bias_items(W1t, CS, mods, BV0, BV1, BVF, w_, nw_, lane);
              LAS float* scr = (LAS float*)(lds + wid * 16384);
              constexpr int I_SQ = 16 * 32, I_2 = 64 * 32;
              for (int it = w_; it < I_SQ + 2 * I_2; it += nw_) {
                  if (it < I_SQ) p0_transpose_item(fw, 1024, 1024, FWt, nullptr, 2, scr, it, lane);
                  else { const int r2 = it - I_SQ, l = r2 / I_2; p0_transpose_item(w2 + (size_t)l * 4096 * 1024, 4096, 1024, W2t + (size_t)l * 1024 * 4096, nullptr, 0, scr, r2 % I_2, lane); }
              }
          } } }
    SEAM(2);
    DBG16(3, 1, QK, (size_t)ML * 2048); DBG16(3, 2, VT, (size_t)1024 * MT); DBG32(3, 13, mods, (size_t)10 * 6144);
#ifndef REP_ATT
#define REP_ATT 1
#endif
    if (IN(3)) { for (int rep = 0; rep < REP_ATT; ++rep) attn_phase(QK, VT, O, rpb, sbound, lds, G, c); }
    SEAM(3);
    DBG16(4, 3, O, (size_t)ML * 1024);
    if (IN(4)) { pg8::SchedStd S; S.init(O, WO, ML, 1024, 1024, 1024, G, c); pg8::EpiResF<false> E{x, XS, mods + 2048, GM, H, SSQ};
        pg8::gemm_phase<pg8::EpiResF<false>, pg8::SchedStd, false>(lds, 1024, 1024, 1024, S, E); }
    SEAM(4);
    DBG32(5, 4, out, (size_t)ML * 1024);
    if (IN(6)) { pg8::SchedStd S; S.init(H, W1t, ML, 4096, 1024, 1024, G, c); pg8::EpiRelu2F E{HMID, 4096, BV0, SSQ};
        pg8::gemm_phase<pg8::EpiRelu2F, pg8::SchedStd, false>(lds, 1024, 1024, 1024, S, E); }
    SEAM(6);
    DBG16(7, 5, HMID, (size_t)ML * 4096);
    if (IN(7)) { pg8::SchedStd S; S.init(HMID, W2t, ML, 1024, 64, 4096, G, c, (size_t)64 * 32768); pg8::EpiResF<true> E{XS, XS, mods + 5120, GM + 4096, H, SSQ};
        pg8::gemm_phase<pg8::EpiResF<true>, pg8::SchedStd, false>(lds, 4096, 64, 4096, S, E, 32768, 128); }
    SEAM(7);
    const float* mods1 = mods + 5 * 6144;
    DBG32(8, 6, out, (size_t)ML * 1024);
    if (IN(9)) { pg8::SchedF1 S{(const char*)CS, (const char*)H, G, c}; pg8::EpiZ0F E{Z0, BVF, SSQ};
        pg8::gemm_phase<pg8::EpiZ0F, pg8::SchedF1, true>(lds, 256, 256, 1024, S, E); }
    SEAM(9);
    DBG16(10, 7, Z0, (size_t)262144 * 128);
    if (IN(10)) { PHASE_IDS; for (int r_ = 0; r_ < REP_S12; ++r_) s1_phase(Z0, Dt, Z1, lds, gw, NGW); }
    SEAM(10);
    DBG16(11, 8, Z1, (size_t)262144 * 128);
    if (IN(11)) { s2_phase(Z1, Et, Fb, lds, G, c); }
    SEAM(11);
    DBG16(12, 9, Fb, (size_t)ML * 1024);
    if (IN(12)) { pg8::SchedStd S; S.init(Fb, FWt, ML, 1024, 1024, 1024, G, c); pg8::EpiResF<true> E{XS, XS, mods1 + 2048, GM + 8192, H, SSQ};
        pg8::gemm_phase<pg8::EpiResF<true>, pg8::SchedStd, false>(lds, 1024, 1024, 1024, S, E); }
    SEAM(12);
    DBG32(13, 10, out, (size_t)ML * 1024);
    if (IN(14)) { pg8::SchedStd S; S.init(H, W1t + (size_t)4096 * 1024, ML, 4096, 1024, 1024, G, c); pg8::EpiRelu2F E{HMID, 4096, BV1, SSQ};
        pg8::gemm_phase<pg8::EpiRelu2F, pg8::SchedStd, false>(lds, 1024, 1024, 1024, S, E); }
    SEAM(14);
    DBG16(15, 11, HMID, (size_t)ML * 4096);
    if (IN(15)) { pg8::SchedStd S; S.init(HMID, W2t + (size_t)1024 * 4096, ML, 1024, 64, 4096, G, c, (size_t)64 * 32768); pg8::EpiRes E{XS, out, mods1 + 5120};
        pg8::gemm_phase<pg8::EpiRes, pg8::SchedStd, false>(lds, 4096, 64, 4096, S, E, 32768, 128); }
    SEAM(15);
    if (MK_DEBUG && IN(16)) {
        int t_ = threadIdx.x; asm volatile("" : "+v"(t_));
        bool bad = false;
        for (size_t i = (size_t)vcu * 512 + t_; i < (size_t)ML * 1024; i += (size_t)G * 512) { if ((__float_as_uint(out[i]) & 0x7f800000u) == 0x7f800000u) { bad = true; out[i] = 0.f; } }
        if (bad) atomicOr(dflags, 1u << 12);
    }
    SEAM(16);
    if (MK_DEBUG && IN(17)) {
        if (c == 0 && threadIdx.x == 0) { const unsigned f = *dflags; if (f) out[0] = 1.0e6f * (float)(__builtin_ctz(f) + 1) + 1.0e4f * (float)__builtin_popcount(f); }
    }
#undef IN
#undef SEAM
}

constexpr int NPHASE = MK_DEBUG ? 18 : 16;
#ifndef MK_USE_CG
#define MK_USE_CG 0
#endif
#ifndef MK_PER_PHASE
#define MK_PER_PHASE 0
#endif

extern "C" void kernel_launch(void* const* d_in, const int* in_sizes, int n_in, void* d_out, int out_size, void* d_ws, size_t ws_size, hipStream_t stream) {
    static int grid = 0;
    if (grid == 0) {
        if (n_in != 15 || out_size != ML * DM || ws_size < WS_END) { fprintf(stderr, "kernel_launch: unexpected shapes (n_in %d out %d ws %zu)\n", n_in, out_size, ws_size); grid = -1; return; }
        int dev = 0, cus = 0, per_cu = 0;
        hipGetDevice(&dev); hipDeviceGetAttribute(&cus, hipDeviceAttributeMultiprocessorCount, dev);
        hipFuncSetAttribute((const void*)fwd_kernel, hipFuncAttributeMaxDynamicSharedMemorySize, LDS_BYTES);
        if (hipOccupancyMaxActiveBlocksPerMultiprocessor(&per_cu, (const void*)fwd_kernel, 512, LDS_BYTES) != hipSuccess || per_cu < 1) { fprintf(stderr, "kernel_launch: occupancy query failed (%d)\n", per_cu); (void)hipGetLastError(); per_cu = 1; }
        grid = cus * 1;
        if (grid <= 0) grid = 256;
    }
    if (grid < 0) return;
    if (hipMemsetAsync((char*)d_ws + WS_BAR, 0, BAR_BYTES, stream) != hipSuccess) { fprintf(stderr, "kernel_launch: memset failed\n"); return; }
    Args a{};
    for (int i = 0; i < 15; ++i) a.in[i] = (const float*)d_in[i];
    a.out = (float*)d_out; a.ws = (unsigned char*)d_ws;
#if MK_PER_PHASE
    for (int p = 0; p < NPHASE; ++p) { a.ph_lo = p; a.ph_hi = p + 1; hipLaunchKernelGGL(fwd_kernel, dim3(grid), dim3(512), LDS_BYTES, stream, a); }
#else
    a.ph_lo = 0; a.ph_hi = NPHASE; a.use_cg = MK_USE_CG;
    void* kargs[] = {&a};
    hipError_t e = hipLaunchCooperativeKernel((const void*)fwd_kernel, dim3(grid), dim3(512), kargs, LDS_BYTES, stream);
    if (e != hipSuccess) fprintf(stderr, "cooperative launch failed: %s (grid %d)\n", hipGetErrorString(e), grid);
#endif
}
```

```cpp
#include <hip/hip_runtime.h>
#include <hip/hip_cooperative_groups.h>
#include <cstdio>
#include <cstdint>
namespace cg = cooperative_groups;

#define LAS __attribute__((address_space(3)))
typedef unsigned short bf16_t;
typedef short bf16x8 __attribute__((ext_vector_type(8)));
typedef short s16x4 __attribute__((ext_vector_type(4)));
typedef float f32x4 __attribute__((ext_vector_type(4)));
typedef unsigned u32x4 __attribute__((ext_vector_type(4)));
typedef unsigned u32x2 __attribute__((ext_vector_type(2)));

constexpr int DM = 1024, NB = 4, SEQ = 4096, CTXL = 256, FF = 4096;
constexpr int ML = NB * SEQ;
constexpr int MT = ML + NB * CTXL;
constexpr float LOG2E = 1.4426950408889634f;
constexpr float EPS = 1e-6f;

constexpr size_t MiB = 1u << 20;
constexpr size_t WS_MODS = 0;
constexpr size_t WS_SB = 512 * 1024;
constexpr size_t WS_BAR = 1 * MiB;
constexpr size_t BAR_BYTES = 16384;
constexpr size_t WS_CS = 2 * MiB;
constexpr size_t WS_D = 2 * MiB + 512 * 1024;
constexpr size_t WS_E = 3 * MiB;
constexpr size_t WS_WQK = 4 * MiB, WS_WV = 8 * MiB, WS_WO = 10 * MiB, WS_FW = 12 * MiB;
constexpr size_t WS_W1 = 14 * MiB;
constexpr size_t WS_W2 = 30 * MiB;
constexpr size_t WS_SSQ = 46 * MiB;
constexpr size_t WS_BV = 47 * MiB;
constexpr size_t WS_H = 48 * MiB;
constexpr size_t WS_R = 82 * MiB;
constexpr size_t WS_QK = WS_R;
constexpr size_t WS_VT = WS_R + 68 * MiB;
constexpr size_t WS_O = WS_R + 102 * MiB;
constexpr size_t WS_HMID = WS_R;
constexpr size_t WS_Z0 = WS_R;
constexpr size_t WS_Z1 = WS_R + 64 * MiB;
constexpr size_t WS_F = WS_R;
constexpr size_t WS_XS = WS_R + 134 * MiB;
constexpr size_t WS_END = 256 * MiB;
static_assert(WS_XS + 32 * MiB <= WS_END && WS_O + 32 * MiB <= WS_XS && WS_F + 32 * MiB <= WS_END && WS_HMID + 128 * MiB <= WS_END && WS_O + 32 * MiB <= WS_END, "ws map");

constexpr int LDS_BYTES = 147456;

typedef __bf16 bf16v2_t __attribute__((ext_vector_type(2)));
typedef float f32v2_t __attribute__((ext_vector_type(2)));
__device__ __forceinline__ unsigned cvt_pk_bf16(float lo, float hi) { const f32v2_t v = {lo, hi}; const bf16v2_t r = __builtin_convertvector(v, bf16v2_t); return __builtin_bit_cast(unsigned, r); }
__device__ __forceinline__ f32x4 mfma16(bf16x8 a, bf16x8 b, f32x4 c) { return __builtin_amdgcn_mfma_f32_16x16x32_bf16(a, b, c, 0, 0, 0); }


#ifndef MK_WT
#define MK_WT 0
#endif
__device__ __forceinline__ void st16(void* p, u32x4 v) {
#if MK_WT
    asm volatile("global_store_dwordx4 %0, %1, off sc1\n\ts_nop 1" :: "v"(p), "v"(v) : "memory");
#else
    *(u32x4*)p = v;
#endif
}
__device__ __forceinline__ void st16f(void* p, f32x4 v) {
#if MK_WT
    asm volatile("global_store_dwordx4 %0, %1, off sc1\n\ts_nop 1" :: "v"(p), "v"(v) : "memory");
#else
    *(f32x4*)p = v;
#endif
}
__device__ __forceinline__ void st8(void* p, u32x2 v) {
#if MK_WT
    asm volatile("global_store_dwordx2 %0, %1, off sc1\n\ts_nop 1" :: "v"(p), "v"(v) : "memory");
#else
    *(u32x2*)p = v;
#endif
}
namespace pg8 {
constexpr int BM = 256, BK = 64, HALF = 128, HTB = HALF * BK * 2, STAGE_BYTES = 8 * HTB;
__device__ __forceinline__ int lds_byte(int r, int c) { const int st = (r >> 4) * 2 + (c >> 5), rr = r & 15, cc = c & 31, ob = rr * 64 + cc * 2; return st * 1024 + (ob ^ (((ob >> 9) & 1) << 5)); }
__device__ __forceinline__ void stage_rc(int b, int& R, int& C) { const int st = b / 1024, sb = b % 1024, swz = sb ^ (((sb >> 9) & 1) << 5); R = (st >> 1) * 16 + swz / 64; C = (st & 1) * 32 + (swz % 64) / 2; }
__device__ __forceinline__ int perm32(int rho) { const int n = rho >> 4, i = rho & 15; return 8 * (i >> 2) + 4 * n + (i & 3); }

struct Unit { int pm, pn, kind, aux; const char* a; const char* b; };

template <class Epi, class Sched, bool BMAP>
__device__ __forceinline__ void gemm_phase(LAS unsigned char* lds, const int K, const int lda, const int ldb, const Sched& S, const Epi& E, const size_t kstepA = 128, const size_t kstepB = 128) {
    int tid = threadIdx.x; asm volatile("" : "+v"(tid));
    const int wid = __builtin_amdgcn_readfirstlane(tid >> 6), lane = tid & 63, wr = wid >> 2, wc = wid & 3, fr = lane & 15, fq = lane >> 4;
    int nt = K / BK; asm volatile("" : "+s"(nt));
    unsigned voffA[2], voffB[2];
#pragma unroll
    for (int i = 0; i < 2; ++i) { int R, C; stage_rc(tid * 16 + i * 8192, R, C); const int Rb = (R & ~31) + perm32(R & 31);
        voffA[i] = (unsigned)(R * lda + C) * 2u;
        voffB[i] = BMAP ? (unsigned)((64 * (Rb & 63) + (Rb >> 6)) * ldb + C) * 2u : (unsigned)(Rb * ldb + C) * 2u; }
    const size_t hstepA = (size_t)HALF * lda * 2;
    const size_t hstepB = BMAP ? (size_t)2 * ldb * 2 : (size_t)HALF * ldb * 2;
    const unsigned ldsw = (unsigned)wid * 1024u;
    const int aoff = lds_byte(wr * 64 + fr, fq * 8), boff = lds_byte(wc * 32 + fr, fq * 8);
#define PG8_SA(b, h) (((b) * 2 + (h)) * HTB)
#define PG8_SB(b, h) ((4 + (b) * 2 + (h)) * HTB)
#define PG8_STAGE(bufoff, gbase, voff) do { _Pragma("unroll") for (int _i = 0; _i < 2; ++_i) \
        __builtin_amdgcn_global_load_lds((const unsigned*)((const char*)(gbase) + (voff)[_i]), (LAS unsigned*)(lds + (bufoff) + ldsw + _i * 8192), 16, 0, 0); } while (0)
#define PG8_LDA(dst, b, h) do { _Pragma("unroll") for (int m = 0; m < 4; ++m) _Pragma("unroll") for (int k = 0; k < 2; ++k) dst[m][k] = *(const LAS bf16x8*)(lds + PG8_SA(b, h) + aoff + m * 2048 + k * 1024); } while (0)
#define PG8_LDB(dst, b, h) do { _Pragma("unroll") for (int n = 0; n < 2; ++n) _Pragma("unroll") for (int k = 0; k < 2; ++k) dst[n][k] = *(const LAS bf16x8*)(lds + PG8_SB(b, h) + boff + n * 2048 + k * 1024); } while (0)
#define PG8_MMA(ai, bj, At, Bt) do { __builtin_amdgcn_s_setprio(1); _Pragma("unroll") for (int m = 0; m < 4; ++m) _Pragma("unroll") for (int n = 0; n < 2; ++n) _Pragma("unroll") for (int k = 0; k < 2; ++k) \
        acc[ai][bj][m][n] = __builtin_amdgcn_mfma_f32_16x16x32_bf16(Bt[n][k], At[m][k], acc[ai][bj][m][n], 0, 0, 0); __builtin_amdgcn_s_setprio(0); } while (0)
#define PG8_WAIT_V(n) asm volatile("s_waitcnt vmcnt(" #n ")" ::: "memory")
#define PG8_WAIT_L(n) asm volatile("s_waitcnt lgkmcnt(" #n ")" ::: "memory")
#define PG8_BAR __builtin_amdgcn_s_barrier()
#define PG8_SCHED __builtin_amdgcn_sched_barrier(0)
    Unit cur, nxt; int ui = 0;
    if (!S.next(0, cur)) return;
    f32x4 acc[2][2][4][2];
#pragma unroll
    for (int a = 0; a < 2; ++a)
#pragma unroll
        for (int b = 0; b < 2; ++b)
#pragma unroll
            for (int m = 0; m < 4; ++m)
#pragma unroll
                for (int n = 0; n < 2; ++n) acc[a][b][m][n] = (f32x4){0.f, 0.f, 0.f, 0.f};
    bf16x8 At[4][2], B0[2][2], B1[2][2];
    const char* cA = cur.a; const char* cB = cur.b;
    if constexpr (Epi::PREP) E.prep(cur, lds, 0, tid);
    PG8_STAGE(PG8_SB(0, 0), cB, voffB); PG8_STAGE(PG8_SB(0, 1), cB + hstepB, voffB); PG8_STAGE(PG8_SA(0, 0), cA, voffA); PG8_STAGE(PG8_SA(0, 1), cA + hstepA, voffA);
    if (wr == 1) PG8_BAR;
    PG8_WAIT_V(2); PG8_BAR;
    PG8_STAGE(PG8_SB(1, 0), cB + kstepB, voffB); PG8_STAGE(PG8_SA(1, 0), cA + kstepA, voffA); PG8_STAGE(PG8_SB(1, 1), cB + hstepB + kstepB, voffB);
    PG8_WAIT_V(6); PG8_BAR;
    for (;;) {
        const bool has_next = S.next(ui + 1, nxt);
        const char* nA = has_next ? nxt.a : cA; const char* nB = has_next ? nxt.b : cB;
        for (int t = 0; t < nt; t += 2) {
            const bool last = (t == nt - 2);
            const char* a1 = cA + (size_t)(t + 1) * kstepA;
            const char* a2 = last ? nA : cA + (size_t)(t + 2) * kstepA; const char* b2 = last ? nB : cB + (size_t)(t + 2) * kstepB;
            const char* a3 = a2 + kstepA; const char* b3 = b2 + kstepB;
            PG8_LDB(B0, 0, 0); PG8_LDB(B1, 0, 1); PG8_SCHED; PG8_LDA(At, 0, 0); PG8_STAGE(PG8_SA(1, 1), a1 + hstepA, voffA);
            PG8_WAIT_V(8); PG8_WAIT_L(0); PG8_BAR; PG8_MMA(0, 0, At, B0); PG8_MMA(0, 1, At, B1); PG8_BAR; PG8_SCHED;
            PG8_LDA(At, 0, 1); PG8_STAGE(PG8_SB(0, 0), b2, voffB); PG8_STAGE(PG8_SB(0, 1), b2 + hstepB, voffB); PG8_STAGE(PG8_SA(0, 0), a2, voffA);
            PG8_WAIT_V(8); PG8_WAIT_L(0); PG8_BAR; PG8_MMA(1, 0, At, B0); PG8_MMA(1, 1, At, B1); PG8_BAR; PG8_SCHED;
            PG8_LDB(B0, 1, 0); PG8_LDB(B1, 1, 1); PG8_SCHED; PG8_LDA(At, 1, 0); PG8_STAGE(PG8_SA(0, 1), a2 + hstepA, voffA);
            PG8_WAIT_V(8); PG8_WAIT_L(0); PG8_BAR; PG8_MMA(0, 0, At, B0); PG8_MMA(0, 1, At, B1); PG8_BAR; PG8_SCHED;
            PG8_LDA(At, 1, 1); PG8_STAGE(PG8_SB(1, 0), b3, voffB); PG8_STAGE(PG8_SB(1, 1), b3 + hstepB, voffB); PG8_STAGE(PG8_SA(1, 0), a3, voffA);
            PG8_WAIT_V(8); PG8_WAIT_L(0); PG8_BAR; PG8_MMA(1, 0, At, B0); PG8_MMA(1, 1, At, B1); PG8_BAR; PG8_SCHED;
        }
        if (wr == 0) PG8_BAR;
        if constexpr (Epi::PREP) { if (has_next) E.prep(nxt, lds, (ui + 1) & 1, tid); }
        E(acc, cur, wr, wc, fr, fq, lds, ui & 1);
        if (!has_next) break;
#pragma unroll
        for (int a = 0; a < 2; ++a)
#pragma unroll
            for (int b = 0; b < 2; ++b)
#pragma unroll
                for (int m = 0; m < 4; ++m)
#pragma unroll
                    for (int n = 0; n < 2; ++n) acc[a][b][m][n] = (f32x4){0.f, 0.f, 0.f, 0.f};
        cur = nxt; cA = nA; cB = nB; ++ui;
        if (wr == 1) PG8_BAR;
    }
    PG8_WAIT_V(0);
    PG8_BAR;
#undef PG8_SA
#undef PG8_SB
#undef PG8_STAGE
#undef PG8_LDA
#undef PG8_LDB
#undef PG8_MMA
#undef PG8_WAIT_V
#undef PG8_WAIT_L
#undef PG8_BAR
#undef PG8_SCHED
}

struct SchedStd {
    const char* A; const char* Bt; size_t tsA, tsB; int nM, nN, nwg, G, c;
    __device__ void init(const void* A_, const void* Bt_, int M, int N, int lda, int ldb, int G_, int c_, size_t tsA_ = 0) { A = (const char*)A_; Bt = (const char*)Bt_; tsA = tsA_ ? tsA_ : (size_t)BM * lda * 2; tsB = (size_t)BM * ldb * 2; nM = M / BM; nN = N / BM; nwg = nM * nN; G = G_; c = c_; }
    __device__ bool next(int i, Unit& u) const {
        const long L = (long)i * G + c; if (L >= nwg) return false;
        int wgid = (int)L; { const int q = nwg / 8, r = nwg % 8, xcd = wgid % 8, off = wgid / 8; wgid = (xcd < r ? xcd * (q + 1) : r * (q + 1) + (xcd - r) * q) + off; }
        const int nig = 8 * nN, gid = wgid / nig, fm = gid * 8, gsz = (nM - fm) < 8 ? (nM - fm) : 8;
        u.pm = fm + ((wgid % nig) % gsz); u.pn = (wgid % nig) / gsz; u.kind = 0; u.aux = 0;
        u.a = A + (size_t)u.pm * tsA; u.b = Bt + (size_t)u.pn * tsB; return true;
    }
};
struct SchedQKV {
    const char* H; const char* Wqk; const char* Wv; int G, c, nunits;
    __device__ bool next(int i, Unit& u) const {
        const long Ll = (long)i * G + c; if (Ll >= nunits) return false;
        const int L = (int)Ll; const size_t ts = (size_t)BM * 1024 * 2; u.aux = 0;
        if (L < 512) { const int x = L & 7, off = L >> 3; u.kind = 0; u.pm = 8 * x + (off & 7); u.pn = off >> 3; }
        else if (L < 768) { const int l2 = L - 512, x = l2 & 7, off = l2 >> 3; u.kind = 1; u.pm = off & 3; u.pn = 8 * x + (off >> 2); }
        else if (L < 784) { const int l2 = L - 768; u.kind = 0; u.pm = 64 + (l2 & 3); u.pn = 4 + (l2 >> 2); }
        else { const int l2 = L - 784; u.kind = 1; u.pm = l2 & 3; u.pn = 64 + (l2 >> 2); }
        if (u.kind == 0) { u.a = H + (size_t)u.pm * ts; u.b = Wqk + (size_t)u.pn * ts; }
        else { u.a = Wv + (size_t)u.pm * ts; u.b = H + (size_t)u.pn * ts; }
        return true;
    }
};
struct SchedOne { Unit u;
    __device__ __forceinline__ bool next(int i, Unit& o) const { if (i > 0) return false; o = u; return true; }
};
struct SchedF1 {
    const char* CS; const char* H; int G, c;
    __device__ bool next(int i, Unit& u) const {
        const long Ll = (long)i * G + c; if (Ll >= 256) return false;
        const int L = (int)Ll; const int t = L & 15, b = (L >> 4) & 3, g = (L >> 6) & 3;
        u.pm = 0; u.pn = t; u.kind = g; u.aux = b;
        u.a = CS; u.b = H + ((size_t)(b * 4096 + 4 * t) * 1024 + g * 256) * 2; return true;
    }
};

typedef f32x4 Acc[2][2][4][2];
__device__ __forceinline__ u32x4 pack8(f32x4 v0, f32x4 v1) { u32x4 w; w.x = cvt_pk_bf16(v0[0], v0[1]); w.y = cvt_pk_bf16(v0[2], v0[3]); w.z = cvt_pk_bf16(v1[0], v1[1]); w.w = cvt_pk_bf16(v1[2], v1[3]); return w; }

__device__ __forceinline__ void unpack8(u32x4 w, f32x4& v0, f32x4& v1) {
    v0[0] = __uint_as_float(w.x << 16); v0[1] = __uint_as_float(w.x & 0xffff0000u); v0[2] = __uint_as_float(w.y << 16); v0[3] = __uint_as_float(w.y & 0xffff0000u);
    v1[0] = __uint_as_float(w.z << 16); v1[1] = __uint_as_float(w.z & 0xffff0000u); v1[2] = __uint_as_float(w.w << 16); v1[3] = __uint_as_float(w.w & 0xffff0000u);
}
struct EpiQKV { static constexpr bool PREP = true; bf16_t* QK; bf16_t* VT; const float* gq; const float* gk;
    __device__ __forceinline__ void prep(const Unit& u, LAS unsigned char* lds, int slot, int tid) const {
        if (u.kind == 0 && tid < 64) { const bool isq = u.pn < 4; ((LAS float*)(lds + 131072))[slot * 512 + tid] = isq ? gq[tid] * (0.125f * LOG2E) : gk[tid]; }
    }
    __device__ __forceinline__ void operator()(const Acc& acc, const Unit& u, int wr, int wc, int fr, int fq, LAS unsigned char* lds, int slot) const {
        if (u.kind == 0) {
            const LAS float* gp = (const LAS float*)(lds + 131072) + slot * 512;
            f32x4 gv[2][2];
#pragma unroll
            for (int bj = 0; bj < 2; ++bj)
#pragma unroll
                for (int n = 0; n < 2; ++n) gv[bj][n] = *(const LAS f32x4*)(gp + 32 * bj + 8 * fq + 4 * n);
#pragma unroll
            for (int ai = 0; ai < 2; ++ai)
#pragma unroll
                for (int m = 0; m < 4; ++m) {
                    const int row = u.pm * BM + ai * HALF + wr * 64 + m * 16 + fr;
                    float ss = 0.f;
#pragma unroll
                    for (int bj = 0; bj < 2; ++bj)
#pragma unroll
                        for (int n = 0; n < 2; ++n) { const f32x4 x = acc[ai][bj][m][n]; ss += (x[0] * x[0] + x[1] * x[1]) + (x[2] * x[2] + x[3] * x[3]); }
                    ss += __shfl_xor(ss, 16); ss += __shfl_xor(ss, 32);
                    const float rstd = rsqrtf(ss * (1.0f / 64.0f) + EPS);
                    bf16_t* rowp = QK + (size_t)row * 2048 + u.pn * 256 + wc * 64 + 8 * fq;
#pragma unroll
                    for (int bj = 0; bj < 2; ++bj) st16(rowp + 32 * bj, pack8(acc[ai][bj][m][0] * rstd * gv[bj][0], acc[ai][bj][m][1] * rstd * gv[bj][1]));
                }
        } else {
#pragma unroll
            for (int ai = 0; ai < 2; ++ai)
#pragma unroll
                for (int m = 0; m < 4; ++m) {
                    const int row = u.pm * BM + ai * HALF + wr * 64 + m * 16 + fr;
                    bf16_t* rowp = VT + (size_t)row * MT + u.pn * 256 + wc * 32 + 8 * fq;
#pragma unroll
                    for (int bj = 0; bj < 2; ++bj) st16(rowp + bj * HALF, pack8(acc[ai][bj][m][0], acc[ai][bj][m][1]));
                }
        }
    }
};
struct EpiRelu2 { static constexpr bool PREP = false; bf16_t* O; int ldc;
    __device__ __forceinline__ void operator()(const Acc& acc, const Unit& u, int wr, int wc, int fr, int fq, LAS unsigned char*, int) const {
#pragma unroll
        for (int ai = 0; ai < 2; ++ai)
#pragma unroll
            for (int m = 0; m < 4; ++m) {
                const int row = u.pm * BM + ai * HALF + wr * 64 + m * 16 + fr;
                bf16_t* rowp = O + (size_t)row * ldc + u.pn * 256 + wc * 32 + 8 * fq;
#pragma unroll
                for (int bj = 0; bj < 2; ++bj) { f32x4 v0 = acc[ai][bj][m][0], v1 = acc[ai][bj][m][1];
#pragma unroll
                    for (int e = 0; e < 4; ++e) { const float a = fmaxf(v0[e], 0.f), b = fmaxf(v1[e], 0.f); v0[e] = a * a; v1[e] = b * b; }
                    *(u32x4*)(rowp + bj * HALF) = pack8(v0, v1); }
            }
    }
};
struct EpiRes { static constexpr bool PREP = false; const bf16_t* base; float* out; const float* gate;
    __device__ __forceinline__ void operator()(const Acc& acc, const Unit& u, int wr, int wc, int fr, int fq, LAS unsigned char*, int) const {
        const int col0 = u.pn * 256 + wc * 32 + 8 * fq;
        const float* gp = gate + (size_t)(u.pm >> 4) * 6144 + col0;
        f32x4 gv[2][2];
#pragma unroll
        for (int bj = 0; bj < 2; ++bj)
#pragma unroll
            for (int n = 0; n < 2; ++n) gv[bj][n] = *(const f32x4*)(gp + bj * HALF + 4 * n);
#pragma unroll
        for (int ai = 0; ai < 2; ++ai)
#pragma unroll
          for (int mh = 0; mh < 2; ++mh) {
            u32x4 pre[2][2];
#pragma unroll
            for (int m2 = 0; m2 < 2; ++m2)
#pragma unroll
                for (int bj = 0; bj < 2; ++bj) pre[m2][bj] = __builtin_nontemporal_load((const u32x4*)(base + (size_t)(u.pm * BM + ai * HALF + wr * 64 + (2 * mh + m2) * 16 + fr) * 1024 + col0 + bj * HALF));
            asm volatile("" ::: "memory");
#pragma unroll
            for (int m2 = 0; m2 < 2; ++m2) { const int m = 2 * mh + m2;
                const size_t off = (size_t)(u.pm * BM + ai * HALF + wr * 64 + m * 16 + fr) * 1024 + col0;
#pragma unroll
                for (int bj = 0; bj < 2; ++bj) { f32x4 b0, b1; unpack8(pre[m2][bj], b0, b1);
                    *(f32x4*)(out + off + bj * HALF) = b0 + gv[bj][0] * acc[ai][bj][m][0]; *(f32x4*)(out + off + bj * HALF + 4) = b1 + gv[bj][1] * acc[ai][bj][m][1]; }
            }
            asm volatile("" ::: "memory");
          }
    }
};
struct EpiZ0 { static constexpr bool PREP = false; bf16_t* Z0;
    __device__ __forceinline__ void operator()(const Acc& acc, const Unit& u, int wr, int wc, int fr, int fq, LAS unsigned char*, int) const {
        const int ri = u.pm, t = u.pn, g = u.kind, b = u.aux;
        bf16_t* p0 = Z0 + ((size_t)(((b * 4 + g) * 256 + wr * 64 + fr) * 64 + 4 * t + (wc >> 1))) * 128 + ri * 64 + 32 * (wc & 1) + 8 * fq;
#pragma unroll
        for (int ai = 0; ai < 2; ++ai)
#pragma unroll
            for (int m = 0; m < 4; ++m) {
#pragma unroll
                for (int bj = 0; bj < 2; ++bj)
                    *(u32x4*)(p0 + (size_t)(ai * HALF + m * 16) * 8192 + bj * 256) = pack8(acc[ai][bj][m][0], acc[ai][bj][m][1]);
                asm volatile("" ::: "memory");
            }
    }
};

constexpr int AUX_OFF = 131072;
template <bool BASE16>
struct EpiResF { static constexpr bool PREP = false; const void* base; bf16_t* XS; const float* gate; const float* gm; bf16_t* XB; float* SSQ;
    __device__ __forceinline__ void operator()(const Acc& acc, const Unit& u, int wr, int wc, int fr, int fq, LAS unsigned char*, int) const {
        const int col0 = u.pn * 256 + wc * 32 + 8 * fq, b = u.pm >> 4;
        f32x4 gv[2][2], mv[2][2];
#pragma unroll
        for (int bj = 0; bj < 2; ++bj)
#pragma unroll
            for (int n = 0; n < 2; ++n) { gv[bj][n] = *(const f32x4*)(gate + (size_t)b * 6144 + col0 + bj * HALF + 4 * n); mv[bj][n] = *(const f32x4*)(gm + b * 1024 + col0 + bj * HALF + 4 * n); }
#pragma unroll
        for (int ai = 0; ai < 2; ++ai)
#pragma unroll
          for (int mh = 0; mh < 2; ++mh) {
            f32x4 pre[2][2][2];
#pragma unroll
            for (int m2 = 0; m2 < 2; ++m2) { const size_t off = (size_t)(u.pm * BM + ai * HALF + wr * 64 + (2 * mh + m2) * 16 + fr) * 1024 + col0;
#pragma unroll
                for (int bj = 0; bj < 2; ++bj) {
                    if (BASE16) { const u32x4 w = __builtin_nontemporal_load((const u32x4*)((const bf16_t*)base + off + bj * HALF)); unpack8(w, pre[m2][bj][0], pre[m2][bj][1]); }
                    else { pre[m2][bj][0] = __builtin_nontemporal_load((const f32x4*)((const float*)base + off + bj * HALF)); pre[m2][bj][1] = __builtin_nontemporal_load((const f32x4*)((const float*)base + off + bj * HALF + 4)); }
                } }
            asm volatile("" ::: "memory");
#pragma unroll
            for (int m2 = 0; m2 < 2; ++m2) {
                const int m = 2 * mh + m2;
                const int row = u.pm * BM + ai * HALF + wr * 64 + m * 16 + fr;
                const size_t off = (size_t)row * 1024 + col0;
                float ss = 0.f;
#pragma unroll
                for (int bj = 0; bj < 2; ++bj) {
                    const f32x4 v0 = pre[m2][bj][0] + gv[bj][0] * acc[ai][bj][m][0];
                    const f32x4 v1 = pre[m2][bj][1] + gv[bj][1] * acc[ai][bj][m][1];
                    st16(XS + off + bj * HALF, pack8(v0, v1));
                    ss += ((v0[0] * v0[0] + v0[1] * v0[1]) + (v0[2] * v0[2] + v0[3] * v0[3])) + ((v1[0] * v1[0] + v1[1] * v1[1]) + (v1[2] * v1[2] + v1[3] * v1[3]));
                    st16(XB + off + bj * HALF, pack8(v0 * mv[bj][0], v1 * mv[bj][1]));
                }
                ss += __shfl_xor(ss, 16); ss += __shfl_xor(ss, 32);
                if (fq == 0) SSQ[(size_t)row * 16 + u.pn * 4 + wc] = ss;
            }
            asm volatile("" ::: "memory");
          }
    }
};
__device__ __forceinline__ float ssq_rstd(const float* SSQ, int row, int half) {
    const f32x4 a = *(const f32x4*)(SSQ + (size_t)row * 16 + half * 8), b = *(const f32x4*)(SSQ + (size_t)row * 16 + half * 8 + 4);
    float s = ((a[0] + a[1]) + (a[2] + a[3])) + ((b[0] + b[1]) + (b[2] + b[3]));
    s += __shfl_xor(s, 1);
    return rsqrtf(s * (1.0f / 1024.0f) + EPS);
}
struct EpiRelu2F { static constexpr bool PREP = true; bf16_t* O; int ldc; const float* BV; const float* SSQ;
    __device__ __forceinline__ void prep(const Unit& u, LAS unsigned char* lds, int slot, int tid) const {
        const float r = ssq_rstd(SSQ, u.pm * BM + (tid >> 1), tid & 1);
        LAS float* aux = (LAS float*)(lds + AUX_OFF) + slot * 512;
        if (!(tid & 1)) aux[tid >> 1] = r;
        if (tid < 256) aux[256 + tid] = BV[(size_t)(u.pm >> 4) * 4096 + u.pn * 256 + tid];
    }
    __device__ __forceinline__ void operator()(const Acc& acc, const Unit& u, int wr, int wc, int fr, int fq, LAS unsigned char* lds, int slot) const {
        const LAS float* rt = (const LAS float*)(lds + AUX_OFF) + slot * 512;
        const int col0 = u.pn * 256 + wc * 32 + 8 * fq;
        f32x4 bv[2][2];
#pragma unroll
        for (int bj = 0; bj < 2; ++bj)
#pragma unroll
            for (int n = 0; n < 2; ++n) bv[bj][n] = *(const LAS f32x4*)(rt + 256 + wc * 32 + 8 * fq + bj * HALF + 4 * n);
#pragma unroll
        for (int ai = 0; ai < 2; ++ai)
#pragma unroll
            for (int m = 0; m < 4; ++m) {
                const int rl = ai * HALF + wr * 64 + m * 16 + fr; const float rs = rt[rl];
                bf16_t* rowp = O + ((size_t)(u.pm * 64 + u.pn * 4 + (wc >> 1)) * 256 + rl) * 64 + (wc & 1) * 32 + 8 * fq;
#pragma unroll
                for (int bj = 0; bj < 2; ++bj) { f32x4 v0 = acc[ai][bj][m][0] * rs + bv[bj][0], v1 = acc[ai][bj][m][1] * rs + bv[bj][1];
#pragma unroll
                    for (int e = 0; e < 4; ++e) { const float a = fmaxf(v0[e], 0.f), c2 = fmaxf(v1[e], 0.f); v0[e] = a * a; v1[e] = c2 * c2; }
                    st16(rowp + bj * 2 * 256 * 64, pack8(v0, v1)); }
            }
    }
};
constexpr int NCOL = 2064;
struct EpiZ0F { static constexpr bool PREP = true; bf16_t* Z0; const float* BVF; const float* SSQ;
    __device__ __forceinline__ void prep(const Unit& u, LAS unsigned char* lds, int slot, int tid) const {
        const int nl = tid >> 1, tok = u.aux * 4096 + 64 * (nl & 63) + 4 * u.pn + (nl >> 6);
        const float r = ssq_rstd(SSQ, tok, tid & 1);
        LAS float* aux = (LAS float*)(lds + AUX_OFF) + slot * 512;
        if (!(tid & 1)) aux[nl] = r;
        if (tid < 256) aux[256 + tid] = BVF[(size_t)(u.aux * 4 + u.kind) * 256 + tid];
    }
    __device__ __forceinline__ void operator()(const Acc& acc, const Unit& u, int wr, int wc, int fr, int fq, LAS unsigned char* lds, int slot) const {
        const LAS float* rt = (const LAS float*)(lds + AUX_OFF) + slot * 512;
        const int t = u.pn, g = u.kind, b = u.aux;
        f32x4 rs[2][2];
#pragma unroll
        for (int bj = 0; bj < 2; ++bj)
#pragma unroll
            for (int n = 0; n < 2; ++n) rs[bj][n] = *(const LAS f32x4*)(rt + bj * HALF + wc * 32 + 8 * fq + 4 * n);
        const LAS float* bz = rt + 256 + wr * 64 + fr;
        bf16_t* p0 = Z0 + ((size_t)(((b * 4 + g) * 128 + wr * 64 + fr) * 64 + 4 * t + (wc >> 1))) * 128 + 32 * (wc & 1) + 8 * fq;
        bf16_t* ps = Z0 + ((size_t)((2048 + b * 4 + g) * 64 + 4 * t + (wc >> 1))) * 128 + 32 * (wc & 1) + 8 * fq;
#pragma unroll
        for (int ai = 0; ai < 2; ++ai)
#pragma unroll
            for (int m = 0; m < 4; ++m) {
                const float bb = bz[ai * HALF + m * 16];
                const bool nyq = (ai == 1 && m == 0) && (wr == 0) && (fr == 0);
#pragma unroll
                for (int bj = 0; bj < 2; ++bj) {
                    const u32x4 v = pack8(acc[ai][bj][m][0] * rs[bj][0] + bb, acc[ai][bj][m][1] * rs[bj][1] + bb);
                    const u32x4 z = {0u, 0u, 0u, 0u};
                    st16(p0 + (size_t)(m * 16) * 8192 + ai * 64 + bj * 256, nyq ? z : v);
                    if (ai == 1 && m == 0) { if (nyq) { st16(ps + bj * 256, v); st16(ps + bj * 256 + 64, z); } }
                }
                asm volatile("" ::: "memory");
            }
    }
};
}


#define XB_TMO      128
#define XB_XCNT(j)  (256  + 64 * (j))
#define XB_XSUB(j)  (1280 + 64 * (j))
#define XB_XGEN(j)  (2304 + 64 * (j))
#define XB_TOP      3328
#define XB_TOPGEN   3392
#define XCD_BAR_WORDS 3456
#define XB_SPIN_CAP (1u << 18)
__device__ __forceinline__ unsigned xb_ld(unsigned* p)              { return __hip_atomic_load(p, __ATOMIC_RELAXED, __HIP_MEMORY_SCOPE_AGENT); }
__device__ __forceinline__ unsigned xb_add(unsigned* p, unsigned v) { return __hip_atomic_fetch_add(p, v, __ATOMIC_RELAXED, __HIP_MEMORY_SCOPE_AGENT); }
__device__ __forceinline__ unsigned xb_xcc_id() { return (unsigned)__builtin_amdgcn_s_getreg((3 << 11) | 20) & 0xFu; }
#define XB_SPIN(cond, bar) do { unsigned _sp = 0; while (cond) { __builtin_amdgcn_s_sleep(1); \
    if ((++_sp & 255u) == 0u) { if (xb_ld(&(bar)[XB_TMO])) break; if (_sp > XB_SPIN_CAP) { atomicAdd(&(bar)[XB_TMO], 1u); break; } } } } while (0)
struct XcdBarrier { unsigned* bar; unsigned x; volatile LAS unsigned* st; };
__device__ __forceinline__ XcdBarrier xcd_barrier_post(unsigned* bar, volatile LAS unsigned* st) {
    XcdBarrier b; b.bar = bar; b.x = xb_xcc_id(); b.st = st;
    if (threadIdx.x == 0) (void)xb_add(&bar[XB_XCNT(b.x)], 1u);
    return b;
}
__device__ __forceinline__ void xcd_barrier_complete(unsigned* bar, unsigned x, unsigned& nloc, unsigned& nx) {
    const unsigned G = gridDim.x * gridDim.y * gridDim.z;
    unsigned sum, cnt, mine, sp = 0u;
    for (;;) {
        sum = 0u; cnt = 0u; mine = 0u;
#pragma unroll
        for (unsigned j = 0; j < 16; ++j) { const unsigned c = xb_ld(&bar[XB_XCNT(j)]); sum += c; cnt += (c > 0u) ? 1u : 0u; mine = (j == x) ? c : mine; }
        if (sum == G) break;
        __builtin_amdgcn_s_sleep(1);
        if ((++sp & 255u) == 0u) { if (xb_ld(&bar[XB_TMO])) break; if (sp > XB_SPIN_CAP) { atomicAdd(&bar[XB_TMO], 1u); break; } }
    }
    nloc = mine > 0u ? mine : 1u; nx = cnt > 0u ? cnt : 1u;
}
__device__ __forceinline__ void xcd_barrier(const XcdBarrier& b) {
    asm volatile("s_waitcnt vmcnt(0)" ::: "memory");
    __syncthreads();
    if (threadIdx.x == 0) {
        unsigned* bar = b.bar;
        __builtin_amdgcn_s_waitcnt(0);
        unsigned nloc = b.st[0], nx = b.st[1];
        if (nloc == 0u) { xcd_barrier_complete(bar, b.x, nloc, nx); b.st[0] = nloc; b.st[1] = nx; }
        const unsigned old = xb_add(&bar[XB_XSUB(b.x)], 1u);
        const unsigned gen = old / nloc;
        if (old + 1u == (gen + 1u) * nloc) {
            __builtin_amdgcn_fence(__ATOMIC_RELEASE, "agent");
            asm volatile("s_waitcnt vmcnt(0)" ::: "memory");
            const unsigned og = xb_add(&bar[XB_TOP], 1u);
            const unsigned tg = og / nx;
            if (og + 1u == (tg + 1u) * nx) xb_add(&bar[XB_TOPGEN], 1u);
            else XB_SPIN(xb_ld(&bar[XB_TOPGEN]) == tg, bar);
            __builtin_amdgcn_fence(__ATOMIC_ACQUIRE, "agent");
            xb_add(&bar[XB_XGEN(b.x)], 1u);
            asm volatile("s_waitcnt vmcnt(0)" ::: "memory");
        } else {
            XB_SPIN(xb_ld(&bar[XB_XGEN(b.x)]) == gen, bar);
            __builtin_amdgcn_fence(__ATOMIC_ACQUIRE, "agent");
            asm volatile("s_waitcnt vmcnt(0)" ::: "memory");
        }
    }
    __syncthreads();
}
__device__ __forceinline__ void p0_mods_unit(const float* c, const float* cctx, const float* ada_w, const float* ada_b, float* mods, LAS unsigned char* lds, int unit) {
    LAS float* s = (LAS float*)lds;
    LAS float* red = s + 5 * 1024;
    int tid = threadIdx.x; asm volatile("" : "+v"(tid));
#pragma unroll
    for (int i = tid; i < 5 * 1024; i += 512) { const int v = i >> 10, k = i & 1023; const float x = v < 4 ? c[v * 1024 + k] : cctx[k]; s[i] = x / (1.0f + __expf(-x)); }
    __syncthreads();
    const int l = unit / 96, col0 = (unit % 96) * 64, kc = tid >> 6, cl = tid & 63;
    const float* w = ada_w + (size_t)l * 1024 * 6144 + col0 + cl;
    float a0 = 0.f, a1 = 0.f, a2 = 0.f, a3 = 0.f, a4 = 0.f;
    for (int k = kc * 128; k < kc * 128 + 128; k += 32) {
        float wv[32];
#pragma unroll
        for (int j = 0; j < 32; ++j) wv[j] = __builtin_nontemporal_load(w + (size_t)(k + j) * 6144);
#pragma unroll
        for (int j = 0; j < 32; ++j) { a0 += s[k + j] * wv[j]; a1 += s[1024 + k + j] * wv[j]; a2 += s[2048 + k + j] * wv[j]; a3 += s[3072 + k + j] * wv[j]; a4 += s[4096 + k + j] * wv[j]; }
    }
    red[(kc * 5 + 0) * 64 + cl] = a0; red[(kc * 5 + 1) * 64 + cl] = a1; red[(kc * 5 + 2) * 64 + cl] = a2; red[(kc * 5 + 3) * 64 + cl] = a3; red[(kc * 5 + 4) * 64 + cl] = a4;
    __syncthreads();
    if (tid < 320) { const int v = tid >> 6, cc = tid & 63; float t = 0.f;
#pragma unroll
        for (int kk = 0; kk < 8; ++kk) t += red[(kk * 5 + v) * 64 + cc];
        mods[(size_t)(l * 5 + v) * 6144 + col0 + cc] = t + ada_b[l * 6144 + col0 + cc]; }
    __syncthreads();
}

__device__ __forceinline__ void p0_transpose_item(const float* W, int K, int N, bf16_t* WT, bf16_t* WT2, int mode, LAS float* scr, int item, int lane) {
    const int nblk = N / 32, kb = item / nblk, nb = item % nblk, k0 = 64 * kb, n0 = 32 * nb;
    float wv_[32];
#pragma unroll
    for (int i = 0; i < 32; ++i) { int srow = k0 + 2 * i + (lane >> 5);
        if (mode == 2) { const int j = srow & 255; if (j > 128) srow = (srow & ~255) + 256 - (j - 128); }
        wv_[i] = __builtin_nontemporal_load(W + (size_t)srow * N + n0 + (lane & 31)); }
#pragma unroll
    for (int i = 0; i < 32; ++i) scr[(2 * i + (lane >> 5)) * 33 + (lane & 31)] = wv_[i];
    asm volatile("s_waitcnt lgkmcnt(0)" ::: "memory");
    const int cch = lane & 7;
#pragma unroll
    for (int j = 0; j < 4; ++j) { const int n = (lane >> 3) + 8 * j; const LAS float* s = scr + (8 * cch) * 33 + n;
        u32x4 o; o.x = cvt_pk_bf16(s[0 * 33], s[1 * 33]); o.y = cvt_pk_bf16(s[2 * 33], s[3 * 33]); o.z = cvt_pk_bf16(s[4 * 33], s[5 * 33]); o.w = cvt_pk_bf16(s[6 * 33], s[7 * 33]);
        const int ng = n0 + n; bf16_t* dst;
        if (mode != 1) dst = WT + (size_t)ng * K;
        else if (ng < 2048) { const int pn = ng >> 8, hh = (ng >> 6) & 3, d = ng & 63; const int tpos = (d >> 5) * 128 + hh * 32 + (d & 31); dst = WT + (size_t)(pn * 256 + tpos) * K; }
        else dst = WT2 + (size_t)(ng - 2048) * K;
        *(u32x4*)(dst + k0 + 8 * cch) = o; }
    asm volatile("s_waitcnt lgkmcnt(0)" ::: "memory");
}

__device__ __forceinline__ float wave_sum(float v) {
#pragma unroll
    for (int o = 1; o < 64; o <<= 1) v += __shfl_xor(v, o);
    return v;
}
__device__ __forceinline__ void norm_rows(const float* xlat, const float* xctx, int nrows, const float* g, const float* modsl, int sh_off, int sc_off, bf16_t* H, int gw, int NGW, int lane) {
    f32x4 gv[4];
#pragma unroll
    for (int j = 0; j < 4; ++j) gv[j] = *(const f32x4*)(g + lane * 4 + 256 * j);
    for (int row = gw; row < nrows; row += NGW) {
        const float* src = row < ML ? xlat + (size_t)row * 1024 : xctx + (size_t)(row - ML) * 1024;
        const int v = row < ML ? (row >> 12) : 4;
        const float* mp = modsl + (size_t)v * 6144;
        f32x4 x[4]; float ss = 0.f;
#pragma unroll
        for (int j = 0; j < 4; ++j) { x[j] = __builtin_nontemporal_load((const f32x4*)(src + lane * 4 + 256 * j)); ss += (x[j][0] * x[j][0] + x[j][1] * x[j][1]) + (x[j][2] * x[j][2] + x[j][3] * x[j][3]); }
        const float rstd = rsqrtf(wave_sum(ss) * (1.0f / 1024.0f) + EPS);
#pragma unroll
        for (int j = 0; j < 4; ++j) {
            const f32x4 sh = *(const f32x4*)(mp + sh_off + lane * 4 + 256 * j), sc = *(const f32x4*)(mp + sc_off + lane * 4 + 256 * j);
            const f32x4 y = (x[j] * rstd * gv[j]) * (sc + 1.0f) + sh;
            u32x2 w; w.x = cvt_pk_bf16(y[0], y[1]); w.y = cvt_pk_bf16(y[2], y[3]);
            *(u32x2*)(H + (size_t)row * 1024 + lane * 4 + 256 * j) = w;
        }
    }
}


__device__ __forceinline__ void norm_rows_lds(const float* xlat, const float* xctx, int nrows, const float* g, const float* modsl, bf16_t* H, int gw, int NGW, int lane, int tid, LAS unsigned char* lds) {
    LAS float* tab = (LAS float*)lds;
#pragma unroll
    for (int i = tid; i < 5 * 1024; i += 512) { const int v = i >> 10, k = i & 1023; tab[(v * 2) * 1024 + k] = g[k] * (1.0f + modsl[(size_t)v * 6144 + 1024 + k]); tab[(v * 2 + 1) * 1024 + k] = modsl[(size_t)v * 6144 + k]; }
    __syncthreads();
    for (int row = gw; row < nrows; row += NGW) {
        const float* src = row < ML ? xlat + (size_t)row * 1024 : xctx + (size_t)(row - ML) * 1024;
        const int v = row < ML ? (row >> 12) : 4;
        f32x4 x[4]; float ss = 0.f;
#pragma unroll
        for (int j = 0; j < 4; ++j) { x[j] = __builtin_nontemporal_load((const f32x4*)(src + lane * 4 + 256 * j)); ss += (x[j][0] * x[j][0] + x[j][1] * x[j][1]) + (x[j][2] * x[j][2] + x[j][3] * x[j][3]); }
        const float rstd = rsqrtf(wave_sum(ss) * (1.0f / 1024.0f) + EPS);
#pragma unroll
        for (int j = 0; j < 4; ++j) {
            const f32x4 gs = *(const LAS f32x4*)(tab + (v * 2) * 1024 + lane * 4 + 256 * j), sh = *(const LAS f32x4*)(tab + (v * 2 + 1) * 1024 + lane * 4 + 256 * j);
            const f32x4 y = (x[j] * rstd) * gs + sh;
            u32x2 w; w.x = cvt_pk_bf16(y[0], y[1]); w.y = cvt_pk_bf16(y[2], y[3]);
            *(u32x2*)(H + (size_t)row * 1024 + lane * 4 + 256 * j) = w;
        }
    }
    __syncthreads();
}
__device__ __forceinline__ void bias_items(const bf16_t* W1t, const bf16_t* CS, const float* mods, float* BV0, float* BV1, float* BVF, int w, int NW, int lane) {
    for (int it = w; it < 8192 + 1024; it += NW) {
        float a0 = 0.f, a1 = 0.f, a2 = 0.f, a3 = 0.f; float* dst; int dstride;
        if (it < 8192) {
            const int l = it >> 12, n = it & 4095;
            const bf16_t* wr_ = W1t + (size_t)l * 4096 * 1024 + (size_t)n * 1024 + lane * 16;
            const u32x4 w0 = *(const u32x4*)wr_, w1 = *(const u32x4*)(wr_ + 8);
            const float* sh = mods + (size_t)l * 5 * 6144 + 3072 + lane * 16;
            float wf[16];
#pragma unroll
            for (int e = 0; e < 4; ++e) { wf[2 * e] = __uint_as_float(w0[e] << 16); wf[2 * e + 1] = __uint_as_float(w0[e] & 0xffff0000u); wf[8 + 2 * e] = __uint_as_float(w1[e] << 16); wf[8 + 2 * e + 1] = __uint_as_float(w1[e] & 0xffff0000u); }
#pragma unroll
            for (int q = 0; q < 4; ++q) {
                const f32x4 s0 = *(const f32x4*)(sh + 4 * q), s1 = *(const f32x4*)(sh + 6144 + 4 * q), s2 = *(const f32x4*)(sh + 2 * 6144 + 4 * q), s3 = *(const f32x4*)(sh + 3 * 6144 + 4 * q);
#pragma unroll
                for (int e = 0; e < 4; ++e) { a0 += s0[e] * wf[4 * q + e]; a1 += s1[e] * wf[4 * q + e]; a2 += s2[e] * wf[4 * q + e]; a3 += s3[e] * wf[4 * q + e]; }
            }
            dst = (l == 0 ? BV0 : BV1) + n; dstride = 4096;
        } else {
            const int idx = it - 8192, g = idx >> 8, m = idx & 255;
            const u32x2 w0 = *(const u32x2*)(CS + (size_t)m * 256 + lane * 4);
            const float wf0 = __uint_as_float(w0[0] << 16), wf1 = __uint_as_float(w0[0] & 0xffff0000u), wf2 = __uint_as_float(w0[1] << 16), wf3 = __uint_as_float(w0[1] & 0xffff0000u);
            const float* sh = mods + (size_t)5 * 6144 + g * 256 + lane * 4;
            const f32x4 s0 = *(const f32x4*)(sh), s1 = *(const f32x4*)(sh + 6144), s2 = *(const f32x4*)(sh + 2 * 6144), s3 = *(const f32x4*)(sh + 3 * 6144);
            a0 = s0[0] * wf0 + s0[1] * wf1 + s0[2] * wf2 + s0[3] * wf3; a1 = s1[0] * wf0 + s1[1] * wf1 + s1[2] * wf2 + s1[3] * wf3;
            a2 = s2[0] * wf0 + s2[1] * wf1 + s2[2] * wf2 + s2[3] * wf3; a3 = s3[0] * wf0 + s3[1] * wf1 + s3[2] * wf2 + s3[3] * wf3;
            dst = BVF + g * 256 + m; dstride = 1024;
        }
        a0 = wave_sum(a0); a1 = wave_sum(a1); a2 = wave_sum(a2); a3 = wave_sum(a3);
        if (lane == 0) { dst[0] = a0; dst[dstride] = a1; dst[2 * dstride] = a2; dst[3 * dstride] = a3; }
    }
}
template <bool MASKED>
__device__ __forceinline__ void attn_block(const LAS bf16_t* Ks, const LAS bf16_t* Vs, int kcol0, int fr, int g, const bf16x8 (&Qf)[2], f32x4 (&acc)[4], float& lsum,
                                           const LAS unsigned char* rpb_base  , const int (&dcb)[8], const f32x4& ciX, const f32x4& ciY) {
    bf16x8 KX[2], KY[2];
#pragma unroll
    for (int kk = 0; kk < 2; ++kk) { KX[kk] = *(const LAS bf16x8*)(Ks + (kcol0 + fr) * 72 + kk * 32 + g * 8); KY[kk] = *(const LAS bf16x8*)(Ks + (kcol0 + 16 + fr) * 72 + kk * 32 + g * 8); }
    s16x4 VX[4], VY[4];
#pragma unroll
    for (int db = 0; db < 4; ++db) { VX[db] = *(const LAS s16x4*)(Vs + (16 * db + fr) * 72 + kcol0 + 4 * g); VY[db] = *(const LAS s16x4*)(Vs + (16 * db + fr) * 72 + kcol0 + 16 + 4 * g); }
    f32x4 sX = mfma16(KX[0], Qf[0], ciX); sX = mfma16(KX[1], Qf[1], sX);
    f32x4 sY = mfma16(KY[0], Qf[0], ciY); sY = mfma16(KY[1], Qf[1], sY);
    f32x4 pX, pY;
    if (MASKED) {
#pragma unroll
        for (int ii = 0; ii < 4; ++ii) {
            const float bx = *(const LAS float*)(rpb_base + dcb[ii]), by = *(const LAS float*)(rpb_base + dcb[4 + ii]);
            pX[ii] = __builtin_amdgcn_exp2f(sX[ii] + bx);
            pY[ii] = __builtin_amdgcn_exp2f(sY[ii] + by);
        }
    } else {
#pragma unroll
        for (int ii = 0; ii < 4; ++ii) { pX[ii] = __builtin_amdgcn_exp2f(sX[ii]); pY[ii] = __builtin_amdgcn_exp2f(sY[ii]); }
    }
    lsum += ((pX[0] + pX[1]) + (pX[2] + pX[3])) + ((pY[0] + pY[1]) + (pY[2] + pY[3]));
    const u32x4 pw = pg8::pack8(pX, pY);
    const bf16x8 Pf = __builtin_bit_cast(bf16x8, pw);
#pragma unroll
    for (int db = 0; db < 4; ++db) {
        bf16x8 Vf; Vf[0] = VX[db][0]; Vf[1] = VX[db][1]; Vf[2] = VX[db][2]; Vf[3] = VX[db][3]; Vf[4] = VY[db][0]; Vf[5] = VY[db][1]; Vf[6] = VY[db][2]; Vf[7] = VY[db][3];
        acc[db] = mfma16(Vf, Pf, acc[db]);
    }
}
__device__ __forceinline__ void attn_phase(const bf16_t* QK, const bf16_t* VT, bf16_t* O, const float* rpb, const float* sbound, LAS unsigned char* lds, int G, int c) {
    constexpr int RP_BYTES = 30720, TILE_B = 64 * 72 * 2, PAIR_B = 4 * TILE_B, NPAIR = 7;
    LAS float* rp = (LAS float*)lds;
    int tid = threadIdx.x; asm volatile("" : "+v"(tid));
    const int lane = tid & 63, wid = __builtin_amdgcn_readfirstlane(tid >> 6), fr = lane & 15, g = lane >> 4;
#pragma unroll 5
    for (int i = tid; i < 16 * 465; i += 512) rp[i] = rpb[i] * LOG2E;
    const float Mb = *sbound;
    const int nunits = (2048 - c + G - 1) / G;
    const int ND = nunits * NPAIR;
    const int trow = tid >> 3, tch = tid & 7;
    const int ldsoff = (trow * 72 + tch * 8) * 2;
#define ATT_DEC(L_, b_, h_, rp_) do { const int x_ = (L_) & 7, q_ = (L_) >> 3; rp_ = q_ & 31; const int bh_ = 8 * (q_ >> 5) + x_; b_ = bh_ >> 4; h_ = bh_ & 15; } while (0)
#define ATT_TOK(b_, rs0_, t_) ((t_) < 9 ? (b_) * 4096 + min((rs0_) + (t_), 63) * 64 : ML + (b_) * 256 + 64 * (min((t_), 12) - 9))
#define ATT_GLOAD(D_, R) do { const int u_ = (D_) / NPAIR, p_ = (D_) - u_ * NPAIR; int b_, h_, rp_; ATT_DEC(u_ * G + c, b_, h_, rp_); \
        const int rs0_ = min(max(2 * rp_ - 4, 0), 56); const int tk0_ = ATT_TOK(b_, rs0_, 2 * p_), tk1_ = ATT_TOK(b_, rs0_, 2 * p_ + 1); \
        const bf16_t* kb_ = QK + (size_t)trow * 2048 + 1024 + h_ * 64 + tch * 8; const bf16_t* vb_ = VT + (size_t)(h_ * 64 + trow) * MT + tch * 8; \
        R[0] = *(const u32x4*)(kb_ + (size_t)tk0_ * 2048); R[1] = *(const u32x4*)(vb_ + tk0_); R[2] = *(const u32x4*)(kb_ + (size_t)tk1_ * 2048); R[3] = *(const u32x4*)(vb_ + tk1_); } while (0)
#define ATT_LWRITE(slot_, R) do { _Pragma("unroll") for (int q_ = 0; q_ < 4; ++q_) *(LAS u32x4*)(lds + RP_BYTES + (slot_) * PAIR_B + q_ * TILE_B + ldsoff) = R[q_]; } while (0)
    u32x4 R0[4], R1[4];
    ATT_GLOAD(0, R0); ATT_LWRITE(0, R0);
    if (ND > 1) ATT_GLOAD(1, R1);
    if (ND > 2) ATT_GLOAD(2, R0);
    __syncthreads();
    int b = 0, h = 0, rpair = 0, r = 0, rs0 = 0, rsr = 0, qrow = 0;
    const int j = wid & 3, w0 = (j == 0) ? 0 : (j == 1) ? 8 : (j == 2) ? 24 : 32;
    int dcb[8]; f32x4 ciX, ciY, ciU;
    {
        const int cq = 16 * j + fr, cs = min(max(cq - 8, 0), 48), eX = w0 + 4 * g - cs, dX = w0 + 4 * g - cq + 15;
#pragma unroll
        for (int ii = 0; ii < 4; ++ii) {
            dcb[ii] = 4 * min(max(dX + ii, 0), 30); dcb[4 + ii] = 4 * min(max(dX + 16 + ii, 0), 30);
            ciX[ii] = ((unsigned)(eX + ii) < 16u) ? -Mb : -1.0e30f; ciY[ii] = ((unsigned)(eX + 16 + ii) < 16u) ? -Mb : -1.0e30f; ciU[ii] = -Mb;
        }
    }
    bf16x8 Qf[2], Qn[2]; f32x4 acc[4]; float lsum = 0.f;
    int p = 0, u = 0, D = 0;
#define ATT_QLOAD(dst, uu) do { int b_, h_, rp_; ATT_DEC((uu) * G + c, b_, h_, rp_); const int qr_ = b_ * 4096 + (2 * rp_ + (wid >> 2)) * 64 + 16 * j + fr; \
        _Pragma("unroll") for (int kk = 0; kk < 2; ++kk) dst[kk] = *(const bf16x8*)(QK + (size_t)qr_ * 2048 + h_ * 64 + 32 * kk + 8 * g); } while (0)
#define ATT_TILE(t_, toff_) do { \
        const LAS bf16_t* Ks = (const LAS bf16_t*)(lds + RP_BYTES + slot * PAIR_B + (toff_)); \
        const LAS bf16_t* Vs = (const LAS bf16_t*)(lds + RP_BYTES + slot * PAIR_B + (toff_) + TILE_B); \
        if ((t_) < 9) { \
            const int kr = rs0 + (t_), i = kr - rsr; \
            if (i >= 0 && i < 8) attn_block<true>(Ks, Vs, w0, fr, g, Qf, acc, lsum, (const LAS unsigned char*)rp + (h * 465 + (kr - r + 7) * 31) * 4, dcb, ciX, ciY); \
        } else if ((t_) < 13) { \
            attn_block<false>(Ks, Vs, 0, fr, g, Qf, acc, lsum, (const LAS unsigned char*)rp, dcb, ciU, ciU); \
            attn_block<false>(Ks, Vs, 32, fr, g, Qf, acc, lsum, (const LAS unsigned char*)rp, dcb, ciU, ciU); \
        } } while (0)
    ATT_QLOAD(Qn, 0);
#define ATT_ITER(R) do { \
        const int slot = D & 1; \
        if (D + 1 < ND) ATT_LWRITE(slot ^ 1, R); \
        if (D + 3 < ND) ATT_GLOAD(D + 3, R); \
        if (p == 0) { \
            ATT_DEC(u * G + c, b, h, rpair); \
            r = 2 * rpair + (wid >> 2); rs0 = min(max(2 * rpair - 4, 0), 56); rsr = min(max(r - 4, 0), 56); \
            qrow = b * 4096 + r * 64 + 16 * j + fr; \
            Qf[0] = Qn[0]; Qf[1] = Qn[1]; \
            _Pragma("unroll") for (int db = 0; db < 4; ++db) acc[db] = (f32x4){0.f, 0.f, 0.f, 0.f}; \
            lsum = 0.f; \
        } \
        if (p == 4 && u + 1 < nunits) ATT_QLOAD(Qn, u + 1); \
        { const int i0_ = rs0 + 2 * p - rsr, i1_ = i0_ + 1; \
          if (2 * p + 1 < 9 && i0_ >= 0 && i1_ < 8) {        \
            const LAS bf16_t* Ka = (const LAS bf16_t*)(lds + RP_BYTES + slot * PAIR_B); const LAS bf16_t* Va = (const LAS bf16_t*)(lds + RP_BYTES + slot * PAIR_B + TILE_B); \
            const LAS bf16_t* Kb = (const LAS bf16_t*)(lds + RP_BYTES + slot * PAIR_B + 2 * TILE_B); const LAS bf16_t* Vb = (const LAS bf16_t*)(lds + RP_BYTES + slot * PAIR_B + 3 * TILE_B); \
            const LAS unsigned char* rb_ = (const LAS unsigned char*)rp + (h * 465 + (rs0 + 2 * p - r + 7) * 31) * 4; \
            attn_block<true>(Ka, Va, w0, fr, g, Qf, acc, lsum, rb_, dcb, ciX, ciY); \
            attn_block<true>(Kb, Vb, w0, fr, g, Qf, acc, lsum, rb_ + 124, dcb, ciX, ciY); \
          } else { ATT_TILE(2 * p, 0); ATT_TILE(2 * p + 1, 2 * TILE_B); } } \
        if (p == NPAIR - 1) { \
            float ls = lsum; ls += __shfl_xor(ls, 16); ls += __shfl_xor(ls, 32); \
            const float inv = 1.0f / ls; \
            bf16_t* op = O + (size_t)qrow * 1024 + h * 64 + 4 * g; \
            _Pragma("unroll") for (int db = 0; db < 4; ++db) { u32x2 w; w.x = cvt_pk_bf16(acc[db][0] * inv, acc[db][1] * inv); w.y = cvt_pk_bf16(acc[db][2] * inv, acc[db][3] * inv); st8(op + 16 * db, w); } \
            p = 0; ++u; \
        } else ++p; \
        __syncthreads(); \
    } while (0)
    for (;;) {
        ATT_ITER(R1); if (++D >= ND) break;
        ATT_ITER(R0); if (++D >= ND) break;
    }
#undef ATT_ITER
#undef ATT_TILE
#undef ATT_QLOAD
#undef ATT_DEC
#undef ATT_TOK
#undef ATT_GLOAD
#undef ATT_LWRITE
}

__device__ __forceinline__ void s1_phase(const bf16_t* Z0, const bf16_t* Dg, bf16_t* Z1, LAS unsigned char* lds, int gw, int NGW) {
    constexpr int DP = 136;
    LAS bf16_t* Dl = (LAS bf16_t*)lds;
    int tid = threadIdx.x; asm volatile("" : "+v"(tid));
    const int lane = tid & 63, fr = lane & 15, g = lane >> 4;
    for (int i = tid; i < 128 * 16; i += 512) { const int row = i >> 4, ch = i & 15; *(LAS u32x4*)(Dl + row * DP + ch * 8) = *(const u32x4*)(Dg + row * 128 + ch * 8); }
    __syncthreads();
    for (int job = gw; job < 2048 + 64; job += NGW) {
        const bool part = job >= 2048;
        const int colM = part ? 2048 + ((job - 2048) >> 2) : job, ib0 = part ? ((job - 2048) & 3) : 0, nib = part ? 1 : 4;
        bf16x8 A[4][4];
#pragma unroll
        for (int ib = 0; ib < 4; ++ib) { const int ibr = part ? ib0 : ib;
#pragma unroll
            for (int kb = 0; kb < 4; ++kb) A[ib][kb] = *(const bf16x8*)(Z0 + ((size_t)colM * 64 + 16 * ibr + fr) * 128 + 32 * kb + 8 * g); }
#pragma unroll 2
        for (int jb = 0; jb < 8; ++jb) {
            bf16x8 Bf[4];
#pragma unroll
            for (int kb = 0; kb < 4; ++kb) Bf[kb] = *(const LAS bf16x8*)(Dl + (16 * jb + fr) * DP + 32 * kb + 8 * g);
            const int n = 16 * jb + fr, ka = n >> 1, rip = n & 1;
#pragma unroll
            for (int ib = 0; ib < 4; ++ib) {
                if (ib < nib) {
                    f32x4 a = (f32x4){0.f, 0.f, 0.f, 0.f};
#pragma unroll
                    for (int kb = 0; kb < 4; ++kb) a = mfma16(A[ib][kb], Bf[kb], a);
                    u32x2 w; w.x = cvt_pk_bf16(a[0], a[1]); w.y = cvt_pk_bf16(a[2], a[3]);
                    st8(Z1 + (((size_t)ka * pg8::NCOL + colM) * 2 + rip) * 64 + 16 * (part ? ib0 : ib) + 4 * g, w);
                }
            }
        }
    }
    __syncthreads();
}
__device__ __forceinline__ void s2_phase(const bf16_t* Z1, const bf16_t* Eg, bf16_t* F, LAS unsigned char* lds, int G, int c) {
    constexpr int EP = 136;
    LAS bf16_t* El = (LAS bf16_t*)lds;
    int tid = threadIdx.x; asm volatile("" : "+v"(tid));
    const int lane = tid & 63, wid = __builtin_amdgcn_readfirstlane(tid >> 6), fr = lane & 15, g = lane >> 4;
    for (int wgi = c; wgi < 256; wgi += G) {
        const int ka = wgi & 63, part = wgi >> 6;
        for (int i = tid; i < 64 * 16; i += 512) { const int row = i >> 4, ch = i & 15; *(LAS u32x4*)(El + row * EP + ch * 8) = *(const u32x4*)(Eg + ((size_t)ka * 64 + row) * 128 + ch * 8); }
        __syncthreads();
        bf16x8 Bf[4][4];
#pragma unroll
        for (int jb = 0; jb < 4; ++jb)
#pragma unroll
            for (int kb = 0; kb < 4; ++kb) Bf[jb][kb] = *(const LAS bf16x8*)(El + (16 * jb + fr) * EP + 32 * kb + 8 * g);
        const int nrun = (part == 0 && wid == 0) ? 2 : 1;
        for (int run = 0; run < nrun; ++run) {
            const bool special = run == 1;
            const int q = part * 8 + wid, bg = q >> 1, ib0 = special ? 0 : 4 * (q & 1), nib = special ? 1 : 4;
            for (int ibb = 0; ibb < nib; ++ibb) {
                const int ib = ib0 + ibb;
                const int colM0 = special ? 2048 : bg * 128 + ib * 16;
                bf16x8 A[4];
#pragma unroll
                for (int kb = 0; kb < 4; ++kb) A[kb] = *(const bf16x8*)(Z1 + ((size_t)ka * pg8::NCOL + colM0 + fr) * 128 + 32 * kb + 8 * g);
                const int k2 = ib * 16 + 4 * g, b = bg >> 2, gg = bg & 3;
#pragma unroll
                for (int jb = 0; jb < 4; ++jb) {
                    f32x4 a = (f32x4){0.f, 0.f, 0.f, 0.f};
#pragma unroll
                    for (int kb = 0; kb < 4; ++kb) a = mfma16(A[kb], Bf[jb][kb], a);
                    const int k = ka + 64 * (16 * jb + fr), km = (4096 - k) & 4095;
                    u32x2 w; w.x = cvt_pk_bf16(a[0], a[1]); w.y = cvt_pk_bf16(a[2], a[3]);
                    if (!special) {
                        st8(F + ((size_t)b * 4096 + k) * 1024 + gg * 256 + k2, w);
                        bf16_t* pm_ = F + ((size_t)b * 4096 + km) * 1024 + gg * 256 + 128 + k2;
                        if (k2 != 0) st8(pm_, w);
                        else { pm_[1] = (bf16_t)(w.x >> 16); *(unsigned*)(pm_ + 2) = w.y; }
                    } else {
                        bf16_t* ps_ = F + ((size_t)g * 4096 + k) * 1024 + 128;
                        ps_[0] = (bf16_t)(w.x & 0xffffu); ps_[256] = (bf16_t)(w.x >> 16); ps_[512] = (bf16_t)(w.y & 0xffffu); ps_[768] = (bf16_t)(w.y >> 16);
                    }
                }
            }
        }
        __syncthreads();
    }
}


#ifndef MK_DEBUG
#define MK_DEBUG 0
#endif
__device__ __forceinline__ void dbg_scan16(const bf16_t* p, size_t n, unsigned* flags, unsigned bit, int gt, int NT) {
    bool bad = false; for (size_t i = gt; i < n; i += NT) bad |= ((p[i] & 0x7f80u) == 0x7f80u);
    if (bad) atomicOr(flags, 1u << bit);
}
__device__ __forceinline__ void dbg_scan32(const float* p, size_t n, unsigned* flags, unsigned bit, int gt, int NT) {
    bool bad = false; for (size_t i = gt; i < n; i += NT) bad |= ((__float_as_uint(p[i]) & 0x7f800000u) == 0x7f800000u);
    if (bad) atomicOr(flags, 1u << bit);
}
struct Args { const float* in[15]; float* out; unsigned char* ws; int ph_lo, ph_hi, use_cg, pad; };
static_assert(sizeof(Args) == 15 * 8 + 8 + 8 + 16, "no padding");

__global__ void __launch_bounds__(512, 2) fwd_kernel(Args args) {
    extern __shared__ __attribute__((aligned(16))) unsigned char lds_raw[];
    LAS unsigned char* lds = (LAS unsigned char*)lds_raw;
    const int G = gridDim.x, c = blockIdx.x;
    const int vcu = (G % 8 == 0) ? (c % 8) * (G / 8) + c / 8 : c;
    const int NGW = G * 8;
#define PHASE_IDS int tid_ = threadIdx.x; asm volatile("" : "+v"(tid_)); const int lane = tid_ & 63, wid = __builtin_amdgcn_readfirstlane(tid_ >> 6); const int gw = vcu * 8 + wid; (void)lane; (void)gw
    unsigned char* ws = args.ws;
    const float* x = args.in[0]; const float* cvec = args.in[1]; const float* ctx = args.in[2]; const float* cctx = args.in[3];
    const float* ada_w = args.in[4]; const float* ada_b = args.in[5]; const float* norm_g = args.in[6];
    const float* wqkv = args.in[7]; const float* wo = args.in[8]; const float* gq = args.in[9]; const float* gk = args.in[10]; const float* rpb = args.in[11];
    const float* fw = args.in[12]; const float* w1 = args.in[13]; const float* w2 = args.in[14];
    float* out = args.out;
    float* mods = (float*)(ws + WS_MODS); float* sbound = (float*)(ws + WS_SB);
    bf16_t* CS = (bf16_t*)(ws + WS_CS); bf16_t* Dt = (bf16_t*)(ws + WS_D); bf16_t* Et = (bf16_t*)(ws + WS_E);
    bf16_t* WQK = (bf16_t*)(ws + WS_WQK); bf16_t* WV = (bf16_t*)(ws + WS_WV); bf16_t* WO = (bf16_t*)(ws + WS_WO); bf16_t* FWt = (bf16_t*)(ws + WS_FW);
    bf16_t* W1t = (bf16_t*)(ws + WS_W1); bf16_t* W2t = (bf16_t*)(ws + WS_W2);
    bf16_t* H = (bf16_t*)(ws + WS_H); bf16_t* QK = (bf16_t*)(ws + WS_QK); bf16_t* VT = (bf16_t*)(ws + WS_VT); bf16_t* O = (bf16_t*)(ws + WS_O);
    bf16_t* XS = (bf16_t*)(ws + WS_XS); bf16_t* HMID = (bf16_t*)(ws + WS_HMID); bf16_t* Z0 = (bf16_t*)(ws + WS_Z0); bf16_t* Z1 = (bf16_t*)(ws + WS_Z1); bf16_t* Fb = (bf16_t*)(ws + WS_F);
    float* SSQ = (float*)(ws + WS_SSQ); float* BV0 = (float*)(ws + WS_BV); float* BV1 = BV0 + 4 * 4096; float* BVF = BV1 + 4 * 4096; float* GM = BVF + 16 * 512;
    const int lo = args.ph_lo, hi = args.ph_hi;
    cg::grid_group grid = cg::this_grid();
#define IN(k) (lo <= (k) && (k) < hi)
#ifndef REP_SYNC
#define REP_SYNC 1
#endif
#ifndef REP_NORM
#define REP_NORM 1
#endif
#ifndef REP_S12
#define REP_S12 1
#endif
#ifndef REP_P0
#define REP_P0 1
#endif
#ifndef USE_XB
#define USE_XB 1
#endif
#define SEAM(k) do { if (IN(k) && IN((k) + 1)) { for (int r_ = 0; r_ < REP_SYNC; ++r_) { if (use_cg) grid.sync(); else xcd_barrier(xbar); } } } while (0)
    { volatile LAS unsigned* st_ = (volatile LAS unsigned*)(lds + LDS_BYTES - 64); if (threadIdx.x < 2) st_[threadIdx.x] = 0u; __syncthreads(); }
    XcdBarrier xbar; xbar.bar = (unsigned*)(ws + WS_BAR); xbar.x = 0; xbar.st = (volatile LAS unsigned*)(lds + LDS_BYTES - 64);
    const bool use_cg = (args.use_cg != 0);
    if (!use_cg && hi - lo > 1) xbar = xcd_barrier_post((unsigned*)(ws + WS_BAR), (volatile LAS unsigned*)(lds + LDS_BYTES - 64));

    unsigned* dflags = (unsigned*)(ws + WS_SB + 256);
#define DBG16(k, bit, p, n) do { if (MK_DEBUG && IN(k)) { int t_ = threadIdx.x; asm volatile("" : "+v"(t_)); dbg_scan16(p, n, dflags, bit, (vcu * 512) + t_, G * 512); } } while (0)
#define DBG32(k, bit, p, n) do { if (MK_DEBUG && IN(k)) { int t_ = threadIdx.x; asm volatile("" : "+v"(t_)); dbg_scan32(p, n, dflags, bit, (vcu * 512) + t_, G * 512); } } while (0)
    if (IN(0)) {
        PHASE_IDS;
        if (MK_DEBUG && c == 0 && tid_ == 0) *dflags = 0u;
        for (int r0_ = 0; r0_ < REP_P0; ++r0_) {
        for (int u = c; u < 192; u += G) p0_mods_unit(cvec, cctx, ada_w, ada_b, mods, lds, u);
        __syncthreads();
        {
            LAS float* scr = (LAS float*)(lds + wid * 16384);
            constexpr int I_QKV = 16 * 96, I_SQ = 16 * 32, I_1 = 16 * 128, I_2 = 64 * 32;
            constexpr int NITEMS = I_QKV + I_SQ + 2 * I_1;
            for (int it = NITEMS - 1 - gw; it >= 0; it -= NGW) {
                int r = it;
                if (r < I_QKV) { p0_transpose_item(wqkv, 1024, 3072, WQK, WV, 1, scr, r, lane); continue; } r -= I_QKV;
                if (r < I_SQ) { p0_transpose_item(wo, 1024, 1024, WO, nullptr, 0, scr, r, lane); continue; } r -= I_SQ;
                { const int l = r / I_1; p0_transpose_item(w1 + (size_t)l * 1024 * 4096, 1024, 4096, W1t + (size_t)l * 4096 * 1024, nullptr, 0, scr, r % I_1, lane); }
            }
        }
        {
            const int gt = gw * 64 + lane, NT = NGW * 64;
            for (int i = gt; i < 256 * 256; i += NT) { const int m = i >> 8, cc = i & 255, ri = m >> 7, k2 = m & 127; float sn, cs; sincospif(2.0f * (float)((cc * k2) & 255) / 256.0f, &sn, &cs);
                float v = (ri == 0 ? cs : -sn) * (1.0f / 16.0f); if (m == 128) v = (cc & 1) ? -(1.0f / 16.0f) : (1.0f / 16.0f);
                CS[i] = (bf16_t)(cvt_pk_bf16(v, 0.f) & 0xffffu); }
            for (int i = gt; i < 128 * 128; i += NT) { const int n = i >> 7, kp = i & 127, ka = n >> 1, rip = n & 1, ri = kp >> 6, a = kp & 63; float sn, cs; sincospif(2.0f * (float)((a * ka) & 63) / 64.0f, &sn, &cs);
                const float v = (rip == 0 ? (ri == 0 ? cs : sn) : (ri == 0 ? -sn : cs)) * 0.125f; Dt[i] = (bf16_t)(cvt_pk_bf16(v, 0.f) & 0xffffu); }
            for (int i = gt; i < 64 * 64 * 128; i += NT) { const int kp = i & 127, kbk = (i >> 7) & 63, ka = i >> 13, rip = kp >> 6, bp = kp & 63; float sn, cs; sincospif(2.0f * (float)((bp * (ka + 64 * kbk)) & 4095) / 4096.0f, &sn, &cs);
                const float v = (rip == 0 ? cs : sn) * 0.125f; Et[i] = (bf16_t)(cvt_pk_bf16(v, 0.f) & 0xffffu); }
        }
        if (c == G - 1) {
            float mr = 0.f;
#pragma unroll 5
            for (int i = tid_; i < 16 * 465; i += 512) mr = fmaxf(mr, fabsf(rpb[i]));
#pragma unroll
            for (int o = 1; o < 64; o <<= 1) mr = fmaxf(mr, __shfl_xor(mr, o));
            LAS float* red_ = (LAS float*)(lds + 131072);
            if (lane == 0) red_[wid] = mr;
            __syncthreads();
            if (wid == 0) {
                float mq = fabsf(gq[lane]), mk = fabsf(gk[lane]); mr = red_[lane & 7];
#pragma unroll
                for (int o = 1; o < 64; o <<= 1) { mq = fmaxf(mq, __shfl_xor(mq, o)); mk = fmaxf(mk, __shfl_xor(mk, o)); mr = fmaxf(mr, __shfl_xor(mr, o)); }
                if (lane == 0) *sbound = (8.0f * mq * mk + mr) * LOG2E;
            }
        }
        __syncthreads();
        }
    }
    SEAM(0);
    const bool ctx_in_p1 = false;
    if (IN(1)) { PHASE_IDS;
        if (!ctx_in_p1) norm_rows_lds(x, ctx, MT, norm_g, mods, H, gw, NGW, lane, tid_, lds);
        else if (c >= 32) norm_rows(x, ctx, ML, norm_g, mods, 0, 1024, H, (c - 32) * 8 + wid, (G - 32) * 8, lane);
        else {
            pg8::SchedOne S1u; const size_t ts = (size_t)256 * 1024 * 2; int tt;
            if (c < 16) { S1u.u.kind = 0; S1u.u.pm = 64 + (c & 3); S1u.u.pn = 4 + (c >> 2); tt = c & 3; S1u.u.a = (const char*)H + (size_t)S1u.u.pm * ts; S1u.u.b = (const char*)WQK + (size_t)S1u.u.pn * ts; }
            else { const int l2 = c - 16; S1u.u.kind = 1; S1u.u.pm = l2 & 3; S1u.u.pn = 64 + (l2 >> 2); tt = l2 >> 2; S1u.u.a = (const char*)WV + (size_t)S1u.u.pm * ts; S1u.u.b = (const char*)H + (size_t)S1u.u.pn * ts; }
            S1u.u.aux = 0;
            norm_rows(x, ctx, ML + tt * 256 + 256, norm_g, mods, 0, 1024, H, ML + tt * 256 + wid, 8, lane);
            asm volatile("s_waitcnt vmcnt(0)" ::: "memory"); __syncthreads();
            pg8::EpiQKV E{QK, VT, gq, gk};
            pg8::gemm_phase<pg8::EpiQKV, pg8::SchedOne, false>(lds, 1024, 1024, 1024, S1u, E);
        }
    }
    SEAM(1);
    DBG16(2, 0, H, (size_t)MT * 1024);
    if (IN(2)) { pg8::SchedQKV S{(const char*)H, (const char*)WQK, (const char*)WV, G, c, ctx_in_p1 ? 768 : 800}; pg8::EpiQKV E{QK, VT, gq, gk};
#ifndef REP_G2
#define REP_G2 1
#endif
        for (int r_ = 0; r_ < REP_G2; ++r_) pg8::gemm_phase<pg8::EpiQKV, pg8::SchedQKV, false>(lds, 1024, 1024, 1024, S, E);
        { PHASE_IDS;
          const bool part = (G > 32); const int w_ = part ? (c - 32) * 8 + wid : gw, nw_ = part ? (G - 32) * 8 : NGW;
          if (!part || c >= 32) {
              for (int i = w_ * 64 + lane; i < 3 * 4096; i += nw_ * 64) { const int idx = i >> 12, b = (i >> 10) & 3, col = i & 1023;
                  const float gg = norm_g[(idx == 0 ? 1024 : idx == 1 ? 2048 : 3072) + col];
                  const float sc = mods[(size_t)((idx == 0 ? 0 : 5) + b) * 6144 + (idx == 1 ? 1024 : 4096) + col];
                  GM[i] = gg * (1.0f + sc); }
              bias_items(W1t, CS, mods, BV0, BV1, BVF, w_, nw_, lane);
              LAS float* scr = (LAS float*)(lds + wid * 16384);
              constexpr int I_SQ = 16 * 32, I_2 = 64 * 32;
              for (int it = w_; it < I_SQ + 2 * I_2; it += nw_) {
                  if (it < I_SQ) p0_transpose_item(fw, 1024, 1024, FWt, nullptr, 2, scr, it, lane);
                  else { const int r2 = it - I_SQ, l = r2 / I_2; p0_transpose_item(w2 + (size_t)l * 4096 * 1024, 4096, 1024, W2t + (size_t)l * 1024 * 4096, nullptr, 0, scr, r2 % I_2, lane); }
              }
          } } }
    SEAM(2);
    DBG16(3, 1, QK, (size_t)ML * 2048); DBG16(3, 2, VT, (size_t)1024 * MT); DBG32(3, 13, mods, (size_t)10 * 6144);
#ifndef REP_ATT
#define REP_ATT 1
#endif
    if (IN(3)) { for (int rep = 0; rep < REP_ATT; ++rep) attn_phase(QK, VT, O, rpb, sbound, lds, G, c); }
    SEAM(3);
    DBG16(4, 3, O, (size_t)ML * 1024);
    if (IN(4)) { pg8::SchedStd S; S.init(O, WO, ML, 1024, 1024, 1024, G, c); pg8::EpiResF<false> E{x, XS, mods + 2048, GM, H, SSQ};
        pg8::gemm_phase<pg8::EpiResF<false>, pg8::SchedStd, false>(lds, 1024, 1024, 1024, S, E); }
    SEAM(4);
    DBG32(5, 4, out, (size_t)ML * 1024);
    if (IN(6)) { pg8::SchedStd S; S.init(H, W1t, ML, 4096, 1024, 1024, G, c); pg8::EpiRelu2F E{HMID, 4096, BV0, SSQ};
        pg8::gemm_phase<pg8::EpiRelu2F, pg8::SchedStd, false>(lds, 1024, 1024, 1024, S, E); }
    SEAM(6);
    DBG16(7, 5, HMID, (size_t)ML * 4096);
    if (IN(7)) { pg8::SchedStd S; S.init(HMID, W2t, ML, 1024, 64, 4096, G, c, (size_t)64 * 32768); pg8::EpiResF<true> E{XS, XS, mods + 5120, GM + 4096, H, SSQ};
        pg8::gemm_phase<pg8::EpiResF<true>, pg8::SchedStd, false>(lds, 4096, 64, 4096, S, E, 32768, 128); }
    SEAM(7);
    const float* mods1 = mods + 5 * 6144;
    DBG32(8, 6, out, (size_t)ML * 1024);
    if (IN(9)) { pg8::SchedF1 S{(const char*)CS, (const char*)H, G, c}; pg8::EpiZ0F E{Z0, BVF, SSQ};
        pg8::gemm_phase<pg8::EpiZ0F, pg8::SchedF1, true>(lds, 256, 256, 1024, S, E); }
    SEAM(9);
    DBG16(10, 7, Z0, (size_t)262144 * 128);
    if (IN(10)) { PHASE_IDS; for (int r_ = 0; r_ < REP_S12; ++r_) s1_phase(Z0, Dt, Z1, lds, gw, NGW); }
    SEAM(10);
    DBG16(11, 8, Z1, (size_t)262144 * 128);
    if (IN(11)) { s2_phase(Z1, Et, Fb, lds, G, c); }
    SEAM(11);
    DBG16(12, 9, Fb, (size_t)ML * 1024);
    if (IN(12)) { pg8::SchedStd S; S.init(Fb, FWt, ML, 1024, 1024, 1024, G, c); pg8::EpiResF<true> E{XS, XS, mods1 + 2048, GM + 8192, H, SSQ};
        pg8::gemm_phase<pg8::EpiResF<true>, pg8::SchedStd, false>(lds, 1024, 1024, 1024, S, E); }
    SEAM(12);
    DBG32(13, 10, out, (size_t)ML * 1024);
    if (IN(14)) { pg8::SchedStd S; S.init(H, W1t + (size_t)4096 * 1024, ML, 4096, 1024, 1024, G, c); pg8::EpiRelu2F E{HMID, 4096, BV1, SSQ};
        pg8::gemm_phase<pg8::EpiRelu2F, pg8::SchedStd, false>(lds, 1024, 1024, 1024, S, E); }
    SEAM(14);
    DBG16(15, 11, HMID, (size_t)ML * 4096);
    if (IN(15)) { pg8::SchedStd S; S.init(HMID, W2t + (size_t)1024 * 4096, ML, 1024, 64, 4096, G, c, (size_t)64 * 32768); pg8::EpiRes E{XS, out, mods1 + 5120};
        pg8::gemm_phase<pg8::EpiRes, pg8::SchedStd, false>(lds, 4096, 64, 4096, S, E, 32768, 128); }
    SEAM(15);
    if (MK_DEBUG && IN(16)) {
        int t_ = threadIdx.x; asm volatile("" : "+v"(t_));
        bool bad = false;
        for (size_t i = (size_t)vcu * 512 + t_; i < (size_t)ML * 1024; i += (size_t)G * 512) { if ((__float_as_uint(out[i]) & 0x7f800000u) == 0x7f800000u) { bad = true; out[i] = 0.f; } }
        if (bad) atomicOr(dflags, 1u << 12);
    }
    SEAM(16);
    if (MK_DEBUG && IN(17)) {
        if (c == 0 && threadIdx.x == 0) { const unsigned f = *dflags; if (f) out[0] = 1.0e6f * (float)(__builtin_ctz(f) + 1) + 1.0e4f * (float)__builtin_popcount(f); }
    }
#undef IN
#undef SEAM
}

constexpr int NPHASE = MK_DEBUG ? 18 : 16;
#ifndef MK_USE_CG
#define MK_USE_CG 0
#endif
#ifndef MK_PER_PHASE
#define MK_PER_PHASE 0
#endif

extern "C" void kernel_launch(void* const* d_in, const int* in_sizes, int n_in, void* d_out, int out_size, void* d_ws, size_t ws_size, hipStream_t stream) {
    static int grid = 0;
    if (grid == 0) {
        if (n_in != 15 || out_size != ML * DM || ws_size < WS_END) { fprintf(stderr, "kernel_launch: unexpected shapes (n_in %d out %d ws %zu)\n", n_in, out_size, ws_size); grid = -1; return; }
        int dev = 0, cus = 0, per_cu = 0;
        hipGetDevice(&dev); hipDeviceGetAttribute(&cus, hipDeviceAttributeMultiprocessorCount, dev);
        hipFuncSetAttribute((const void*)fwd_kernel, hipFuncAttributeMaxDynamicSharedMemorySize, LDS_BYTES);
        if (hipOccupancyMaxActiveBlocksPerMultiprocessor(&per_cu, (const void*)fwd_kernel, 512, LDS_BYTES) != hipSuccess || per_cu < 1) { fprintf(stderr, "kernel_launch: occupancy query failed (%d)\n", per_cu); (void)hipGetLastError(); per_cu = 1; }
        grid = cus * 1;
        if (grid <= 0) grid = 256;
    }
    if (grid < 0) return;
    if (hipMemsetAsync((char*)d_ws + WS_BAR, 0, BAR_BYTES, stream) != hipSuccess) { fprintf(stderr, "kernel_launch: memset failed\n"); return; }
    Args a{};
    for (int i = 0; i < 15; ++i) a.in[i] = (const float*)d_in[i];
    a.out = (float*)d_out; a.ws = (unsigned char*)d_ws;
#if MK_PER_PHASE
    for (int p = 0; p < NPHASE; ++p) { a.ph_lo = p; a.ph_hi = p + 1; hipLaunchKernelGGL(fwd_kernel, dim3(grid), dim3(512), LDS_BYTES, stream, a); }
#else
    a.ph_lo = 0; a.ph_hi = NPHASE; a.use_cg = MK_USE_CG;
    void* kargs[] = {&a};
    hipError_t e = hipLaunchCooperativeKernel((const void*)fwd_kernel, dim3(grid), dim3(512), kargs, LDS_BYTES, stream);
    if (e != hipSuccess) fprintf(stderr, "cooperative launch failed: %s (grid %d)\n", hipGetErrorString(e), grid);
#endif
}
```
